# Optimizing an MI355X kernel written in HIP

```python
import jax, jax.numpy as jnp
from jax import lax
import numpy as np

D_MODEL = 2048
BATCH = 1
SEQ = 16384
DEPTH = 1

HG_HEADS = 8
HG_DK = 128
HG_DV = 128
GD_HEADS = 8
GD_DK = 128
GD_DV = 128
CONV_WIDTH = 4
CHUNK = 64
N_EXPERTS = 64
N_GROUPS = 8
EXPERTS_PER_GROUP = N_EXPERTS // N_GROUPS
TOPK_GROUPS = 4
TOP_K = 8
EXPERT_FF = 512
SHARED_FF = 512
ROUTED_SCALE = 2.5
EXPERT_BLOCK = 256
NORM_EPS = 1e-6

HG_KEY = HG_HEADS * HG_DK
HG_VAL = HG_HEADS * HG_DV
GD_KEY = GD_HEADS * GD_DK
GD_VAL = GD_HEADS * GD_DV
IN_SPLITS = (HG_KEY, HG_KEY, HG_VAL, HG_VAL, GD_KEY + GD_KEY + GD_VAL, GD_HEADS, GD_HEADS, GD_VAL, D_MODEL, D_MODEL)
IN_WIDTH = sum(IN_SPLITS)

kernel_name = 'hybrid_hgrn2_gdn_moe_adaln_block'


def rms_norm(x, g):
    xf = x.astype(jnp.float32)
    y = xf * lax.rsqrt(jnp.mean(xf * xf, axis=-1, keepdims=True) + NORM_EPS)
    return (y * g.astype(jnp.float32)).astype(x.dtype)


def l2_normalize(x):
    return x * lax.rsqrt(jnp.sum(x * x, axis=-1, keepdims=True) + 1e-6)


def to_chunks(t):
    b, s, h = t.shape[:3]
    t = t.reshape((b, s // CHUNK, CHUNK, h) + t.shape[3:])
    return jnp.moveaxis(t, 3, 1)


def from_chunks(t):
    b, h, n, c = t.shape[:4]
    return jnp.moveaxis(t, 1, 3).reshape((b, n * c, h) + t.shape[4:])


def causal_depthwise_conv(x, w):
    ch = x.shape[-1]
    return lax.conv_general_dilated(x, w[:, None, :].astype(x.dtype), window_strides=(1,),
                                    padding=[(CONV_WIDTH - 1, 0)],
                                    dimension_numbers=('NWC', 'WIO', 'NWC'),
                                    feature_group_count=ch)


def hgrn2_branch(q, f_logit, i, g, lb, onorm_g):
    f32 = jnp.float32
    B, S, _ = q.shape
    causal = jnp.tril(jnp.ones((CHUNK, CHUNK), bool))
    lb = lb.reshape(HG_HEADS, HG_DK)
    f = lb + (1.0 - lb) * jax.nn.sigmoid(f_logit.reshape(B, S, HG_HEADS, HG_DK).astype(f32))
    log_f = jnp.log(f)
    k = 1.0 - f
    q = jax.nn.silu(q.reshape(B, S, HG_HEADS, HG_DK).astype(f32)) * (HG_DK ** -0.5)
    v = i.reshape(B, S, HG_HEADS, HG_DV).astype(f32)
    qc, kc, vc, lc = to_chunks(q), to_chunks(k), to_chunks(v), to_chunks(log_f)
    b = jnp.cumsum(lc, axis=3)
    b_mid = b[:, :, :, CHUNK // 2:CHUNK // 2 + 1]
    b_last = b[:, :, :, -1:]
    scores = jnp.einsum('bhncd,bhnsd->bhncs', qc * jnp.exp(b - b_mid), kc * jnp.exp(b_mid - b))
    scores = jnp.where(causal, scores, 0.0)
    o_intra = jnp.einsum('bhncs,bhnsv->bhncv', scores, vc)
    q_inter = qc * jnp.exp(b)
    k_upd = kc * jnp.exp(b_last - b)
    decay = jnp.exp(b_last[:, :, :, 0])

    def step(state, inp):
        q_n, k_n, v_n, d_n = inp
        o_n = jnp.einsum('bhcd,bhdv->bhcv', q_n, state)
        state = d_n[..., None] * state + jnp.einsum('bhcd,bhcv->bhdv', k_n, v_n)
        return state, o_n

    s0 = jnp.zeros((B, HG_HEADS, HG_DK, HG_DV), f32)
    xs = tuple(jnp.moveaxis(t, 2, 0) for t in (q_inter, k_upd, vc, decay))
    _, o_inter = lax.scan(step, s0, xs)
    o = from_chunks(o_intra + jnp.moveaxis(o_inter, 0, 2))
    o = rms_norm(o, onorm_g) * jax.nn.silu(g.reshape(B, S, HG_HEADS, HG_DV).astype(f32))
    return o.reshape(B, S, HG_VAL)


def gated_deltanet_branch(qkv, a_logit, b_logit, g, conv_w, a_log, dt_bias, onorm_g):
    f32 = jnp.float32
    B, S, _ = qkv.shape
    causal = jnp.tril(jnp.ones((CHUNK, CHUNK), bool))
    strict = jnp.tril(jnp.ones((CHUNK, CHUNK), bool), -1)
    qkv = jax.nn.silu(causal_depthwise_conv(qkv, conv_w)).astype(f32)
    q, k, v = jnp.split(qkv, [GD_KEY, 2 * GD_KEY], axis=-1)
    q = l2_normalize(q.reshape(B, S, GD_HEADS, GD_DK)) * (GD_DK ** -0.5)
    k = l2_normalize(k.reshape(B, S, GD_HEADS, GD_DK))
    v = v.reshape(B, S, GD_HEADS, GD_DV)
    beta = jax.nn.sigmoid(b_logit.astype(f32))
    log_decay = -jnp.exp(a_log.astype(f32)) * jax.nn.softplus(a_logit.astype(f32) + dt_bias.astype(f32))
    qc, kc, vc = to_chunks(q), to_chunks(k), to_chunks(v)
    betac = to_chunks(beta)
    gcum = jnp.cumsum(to_chunks(log_decay), axis=-1)
    diff = gcum[..., :, None] - gcum[..., None, :]
    decay_mat = jnp.where(causal, jnp.exp(jnp.where(causal, diff, 0.0)), 0.0)
    kb = kc * betac[..., None]
    a_mat = jnp.where(strict, jnp.einsum('bhncd,bhnsd->bhncs', kb, kc) * decay_mat, 0.0)
    lhs = a_mat + jnp.eye(CHUNK, dtype=f32)
    rhs = jnp.concatenate([vc * betac[..., None], kb * jnp.exp(gcum)[..., None]], axis=-1)
    sol = lax.linalg.triangular_solve(lhs, rhs, left_side=True, lower=True, unit_diagonal=True)
    u, w = sol[..., :GD_DV], sol[..., GD_DV:]
    attn = jnp.where(causal, jnp.einsum('bhncd,bhnsd->bhncs', qc, kc) * decay_mat, 0.0)
    q_dec = qc * jnp.exp(gcum)[..., None]
    k_upd = kc * jnp.exp(gcum[..., -1:] - gcum)[..., None]
    decay_last = jnp.exp(gcum[..., -1])

    def step(state, inp):
        u_n, w_n, attn_n, q_n, k_n, d_n = inp
        v_new = u_n - jnp.einsum('bhcd,bhdv->bhcv', w_n, state)
        o_n = jnp.einsum('bhcd,bhdv->bhcv', q_n, state) + jnp.einsum('bhcs,bhsv->bhcv', attn_n, v_new)
        state = d_n[..., None, None] * state + jnp.einsum('bhcd,bhcv->bhdv', k_n, v_new)
        return state, o_n

    s0 = jnp.zeros((B, GD_HEADS, GD_DK, GD_DV), f32)
    xs = tuple(jnp.moveaxis(t, 2, 0) for t in (u, w, attn, q_dec, k_upd, decay_last))
    _, o = lax.scan(step, s0, xs)
    o = from_chunks(jnp.moveaxis(o, 0, 2))
    o = rms_norm(o, onorm_g) * jax.nn.silu(g.reshape(B, S, GD_HEADS, GD_DV).astype(f32))
    return o.reshape(B, S, GD_VAL)


def hybrid_mixer(h, w_in, lb, hgrn_onorm_g, gdn_conv_w, gdn_a_log, gdn_dt_bias, gdn_onorm_g,
                 w_branch_hgrn, w_branch_gdn, w_out):
    proj = h @ w_in
    (hq, hf, hi, hg, gqkv, ga, gb, gg, mg_a, mg_b) = jnp.split(
        proj, np.cumsum(IN_SPLITS)[:-1].tolist(), axis=-1)
    o_a = hgrn2_branch(hq, hf, hi, hg, lb, hgrn_onorm_g).astype(h.dtype)
    o_b = gated_deltanet_branch(gqkv, ga, gb, gg, gdn_conv_w, gdn_a_log, gdn_dt_bias,
                                gdn_onorm_g).astype(h.dtype)
    merged = jax.nn.sigmoid(mg_a) * (o_a @ w_branch_hgrn) + jax.nn.sigmoid(mg_b) * (o_b @ w_branch_gdn)
    return merged @ w_out


def moe_ffn(h, w_router, router_bias, w_exp_gate, w_exp_up, w_exp_down, w_sh_gate, w_sh_up, w_sh_down):
    B, S, D = h.shape
    T = B * S
    TK = T * TOP_K
    hf = h.reshape(T, D)
    scores = jax.nn.sigmoid((hf @ w_router).astype(jnp.float32))
    biased = scores + router_bias.astype(jnp.float32)
    grp_score = lax.top_k(biased.reshape(T, N_GROUPS, EXPERTS_PER_GROUP), 2)[0].sum(-1)
    _, grp_idx = lax.top_k(grp_score, TOPK_GROUPS)
    grp_mask = jnp.zeros((T, N_GROUPS), bool).at[jnp.arange(T)[:, None], grp_idx].set(True)
    exp_mask = jnp.repeat(grp_mask, EXPERTS_PER_GROUP, axis=1)
    _, idx = lax.top_k(jnp.where(exp_mask, biased, -jnp.inf), TOP_K)
    wts = jnp.take_along_axis(scores, idx, axis=1)
    wts = wts / jnp.sum(wts, axis=-1, keepdims=True) * ROUTED_SCALE
    n_blocks = -(-(TK + N_EXPERTS * (EXPERT_BLOCK - 1)) // EXPERT_BLOCK)
    P = n_blocks * EXPERT_BLOCK
    flat_e = idx.reshape(-1)
    flat_w = wts.reshape(-1)
    order = jnp.argsort(flat_e, stable=True)
    e_sorted = flat_e[order]
    counts = jnp.bincount(flat_e, length=N_EXPERTS)
    padded = (counts + EXPERT_BLOCK - 1) // EXPERT_BLOCK * EXPERT_BLOCK
    start = jnp.cumsum(counts) - counts
    pend = jnp.cumsum(padded)
    pstart = pend - padded
    dest = pstart[e_sorted] + jnp.arange(TK, dtype=jnp.int32) - start[e_sorted]
    buf_tok = jnp.zeros((P,), jnp.int32).at[dest].set((order // TOP_K).astype(jnp.int32))
    buf_w = jnp.zeros((P,), jnp.float32).at[dest].set(flat_w[order])
    block_e = jnp.minimum(jnp.searchsorted(pend, jnp.arange(n_blocks) * EXPERT_BLOCK, side='right'),
                          N_EXPERTS - 1).astype(jnp.int32)

    def expert_block(acc, blk):
        tok, wt, e = blk
        xb = hf[tok]
        hid = jax.nn.silu(xb @ w_exp_gate[e]) * (xb @ w_exp_up[e])
        yb = (hid @ w_exp_down[e]) * wt[:, None].astype(h.dtype)
        return acc.at[tok].add(yb), None

    routed, _ = lax.scan(expert_block, jnp.zeros((T, D), h.dtype),
                         (buf_tok.reshape(n_blocks, EXPERT_BLOCK),
                          buf_w.reshape(n_blocks, EXPERT_BLOCK), block_e))
    shared = (jax.nn.silu(hf @ w_sh_gate) * (hf @ w_sh_up)) @ w_sh_down
    return (routed + shared).reshape(B, S, D)


def setup_inputs(seed: int = 0) -> dict:
    key = jax.random.key(seed)
    ks = jax.random.split(key, 24)
    D, L = D_MODEL, DEPTH
    nrm = jax.random.normal
    dt = jnp.exp(jax.random.uniform(ks[11], (L, GD_HEADS)) * (np.log(0.1) - np.log(0.001)) + np.log(0.001))
    return {
        'x': nrm(ks[0], (BATCH, SEQ, D), jnp.float32),
        'c': nrm(ks[1], (BATCH, D), jnp.float32),
        'w_ada': nrm(ks[2], (L, D, 6 * D)) * (0.5 * D ** -0.5),
        'b_ada': nrm(ks[3], (L, 6 * D)) * 0.02,
        'norm1_g': 1.0 + 0.02 * nrm(ks[4], (L, D)),
        'norm2_g': 1.0 + 0.02 * nrm(ks[5], (L, D)),
        'w_in': nrm(ks[6], (L, D, IN_WIDTH)) * D ** -0.5,
        'hgrn_lb_table': 0.1 * nrm(ks[7], (L + 1, HG_KEY)),
        'hgrn_onorm_g': 1.0 + 0.02 * nrm(ks[8], (L, HG_DV)),
        'gdn_conv_w': nrm(ks[9], (L, CONV_WIDTH, 2 * GD_KEY + GD_VAL)) * 0.5,
        'gdn_a_log': jnp.log(jax.random.uniform(ks[10], (L, GD_HEADS), minval=1.0, maxval=16.0)),
        'gdn_dt_bias': dt + jnp.log(-jnp.expm1(-dt)),
        'gdn_onorm_g': 1.0 + 0.02 * nrm(ks[12], (L, GD_DV)),
        'w_branch_hgrn': nrm(ks[13], (L, HG_VAL, D)) * HG_VAL ** -0.5,
        'w_branch_gdn': nrm(ks[14], (L, GD_VAL, D)) * GD_VAL ** -0.5,
        'w_out': nrm(ks[15], (L, D, D)) * D ** -0.5,
        'w_router': nrm(ks[16], (L, D, N_EXPERTS)) * D ** -0.5,
        'router_bias': 0.01 * nrm(ks[17], (L, N_EXPERTS)),
        'w_exp_gate': nrm(ks[18], (L, N_EXPERTS, D, EXPERT_FF)) * D ** -0.5,
        'w_exp_up': nrm(ks[19], (L, N_EXPERTS, D, EXPERT_FF)) * D ** -0.5,
        'w_exp_down': nrm(ks[20], (L, N_EXPERTS, EXPERT_FF, D)) * EXPERT_FF ** -0.5,
        'w_sh_gate': nrm(ks[21], (L, D, SHARED_FF)) * D ** -0.5,
        'w_sh_up': nrm(ks[22], (L, D, SHARED_FF)) * D ** -0.5,
        'w_sh_down': nrm(ks[23], (L, SHARED_FF, D)) * SHARED_FF ** -0.5,
        'normf_g': 1.0 + 0.02 * nrm(jax.random.fold_in(key, 99), (D,)),
    }


def reference(x, c, w_ada, b_ada, norm1_g, norm2_g, w_in, hgrn_lb_table, hgrn_onorm_g, gdn_conv_w,
              gdn_a_log, gdn_dt_bias, gdn_onorm_g, w_branch_hgrn, w_branch_gdn, w_out, w_router,
              router_bias, w_exp_gate, w_exp_up, w_exp_down, w_sh_gate, w_sh_up, w_sh_down, normf_g):
    lb_all = jnp.cumsum(jax.nn.softmax(hgrn_lb_table.astype(jnp.float32), axis=0), axis=0)
    cond = jax.nn.silu(c)
    for l in range(DEPTH):
        mod = (cond @ w_ada[l] + b_ada[l])[:, None, :]
        sh1, sc1, gt1, sh2, sc2, gt2 = jnp.split(mod, 6, axis=-1)
        h = rms_norm(x, norm1_g[l]) * (1.0 + sc1) + sh1
        x = x + gt1 * hybrid_mixer(h, w_in[l], lb_all[l], hgrn_onorm_g[l], gdn_conv_w[l], gdn_a_log[l],
                                   gdn_dt_bias[l], gdn_onorm_g[l], w_branch_hgrn[l], w_branch_gdn[l], w_out[l])
        h = rms_norm(x, norm2_g[l]) * (1.0 + sc2) + sh2
        x = x + gt2 * moe_ffn(h, w_router[l], router_bias[l], w_exp_gate[l], w_exp_up[l], w_exp_down[l],
                              w_sh_gate[l], w_sh_up[l], w_sh_down[l])
    return rms_norm(x, normf_g)
```

```cpp
#include <hip/hip_runtime.h>
#include <stdint.h>
#include <stdio.h>

constexpr int S = 16384, D = 2048, INW = 12304, NE = 64, TOPK = 8, TK = S * TOPK, FF = 512;
constexpr int C_HQ = 0, C_HF = 1024, C_HI = 2048, C_HG = 3072, C_GQKV = 4096, C_GA = 7168, C_GB = 7176, C_GG = 7184, C_MGA = 8208, C_MGB = 10256;

__device__ __forceinline__ float sigmoidf_(float x) { return 1.f / (1.f + __expf(-x)); }
__device__ __forceinline__ float siluf_(float x) { return x / (1.f + __expf(-x)); }
__device__ __forceinline__ float softplusf_(float x) { return x > 20.f ? x : log1pf(expf(x)); }

__device__ __forceinline__ float wave_sum(float v) {
#pragma unroll
    for (int o = 32; o >= 1; o >>= 1) v += __shfl_xor(v, o);
    return v;
}

__global__ void __launch_bounds__(256) k_mod(const float* __restrict__ c, const float* __restrict__ w_ada, const float* __restrict__ b_ada, float* __restrict__ mod) {
    __shared__ float sc[D];
    for (int i = threadIdx.x; i < D; i += 256) sc[i] = siluf_(c[i]);
    __syncthreads();
    const int j = blockIdx.x * 256 + threadIdx.x;
    float acc = b_ada[j];
    for (int i = 0; i < D; ++i) acc += sc[i] * w_ada[(size_t)i * (6 * D) + j];
    mod[j] = acc;
}
__global__ void k_lb(const float* __restrict__ tab, float* __restrict__ lb) {
    const int j = blockIdx.x * blockDim.x + threadIdx.x;
    if (j < 1024) lb[j] = 1.f / (1.f + expf(tab[1024 + j] - tab[j]));
}
__global__ void __launch_bounds__(256) k_norm_mod(const float* x, const float* __restrict__ g, const float* __restrict__ sc, const float* __restrict__ sh, float* out) {
    __shared__ float red[4];
    const int t = blockIdx.x; const float* xr = x + (size_t)t * D; float v[8]; float ss = 0.f;
#pragma unroll
    for (int i = 0; i < 8; ++i) { v[i] = xr[threadIdx.x + 256 * i]; ss += v[i] * v[i]; }
    ss = wave_sum(ss); if ((threadIdx.x & 63) == 0) red[threadIdx.x >> 6] = ss; __syncthreads();
    const float r = rsqrtf((red[0] + red[1] + red[2] + red[3]) * (1.f / D) + 1e-6f);
#pragma unroll
    for (int i = 0; i < 8; ++i) { const int j = threadIdx.x + 256 * i; float y = v[i] * r * g[j]; if (sc) y = y * (1.f + sc[j]) + sh[j]; out[(size_t)t * D + j] = y; }
}
__global__ void __launch_bounds__(256) k_final(const float* x1, const float* __restrict__ acc, const float* __restrict__ gt2, const float* __restrict__ gf, float* out) {
    __shared__ float red[4];
    const int t = blockIdx.x; float v[8]; float ss = 0.f;
#pragma unroll
    for (int i = 0; i < 8; ++i) { const int j = threadIdx.x + 256 * i; v[i] = x1[(size_t)t * D + j] + gt2[j] * acc[(size_t)t * D + j]; ss += v[i] * v[i]; }
    ss = wave_sum(ss); if ((threadIdx.x & 63) == 0) red[threadIdx.x >> 6] = ss; __syncthreads();
    const float r = rsqrtf((red[0] + red[1] + red[2] + red[3]) * (1.f / D) + 1e-6f);
#pragma unroll
    for (int i = 0; i < 8; ++i) { const int j = threadIdx.x + 256 * i; out[(size_t)t * D + j] = v[i] * r * gf[j]; }
}

struct RowId { __device__ int operator()(int i) const { return i; } };
struct RowGather { const int* idx; __device__ int operator()(int i) const { return idx[i]; } };

typedef float f4 __attribute__((ext_vector_type(4)));
template <bool DUAL, class RowMap, class Epi>
__device__ __forceinline__ void ngemm_tile(const float* __restrict__ A, int lda, const float* __restrict__ B, const float* __restrict__ B2, int ldb, int M, int N, int K, int tm, int tn, RowMap rm, Epi epi) {
    __shared__ float As[16][68]; __shared__ float Bs[16][64]; __shared__ float Bs2[DUAL ? 16 : 1][64];
    const int tid = threadIdx.x, tx = tid & 15, ty = tid >> 4;
    float acc[4][4], acc2[4][4];
#pragma unroll
    for (int r = 0; r < 4; ++r)
#pragma unroll
        for (int c = 0; c < 4; ++c) { acc[r][c] = 0.f; acc2[r][c] = 0.f; }
    const int arow = tm * 64 + (tid >> 2), ak = (tid & 3) * 4;
    const bool aok = arow < M; const float* ap = A + (size_t)(aok ? rm(arow) : 0) * lda + ak;
    const int bk = tid >> 4, bc = tn * 64 + (tid & 15) * 4; const bool bok = bc < N;
    const float amul = aok ? 1.f : 0.f;
    const float* bp = B + (bok ? bc : 0); const float* bp2 = DUAL ? B2 + (bok ? bc : 0) : nullptr; const float bmul = bok ? 1.f : 0.f;
    for (int k0 = 0; k0 < K; k0 += 16) {
        const f4 av = *(const f4*)(ap + k0) * amul;
        const f4 bv = *(const f4*)(bp + (size_t)(k0 + bk) * ldb) * bmul;
        f4 bv2 = bv;
        if (DUAL) bv2 = *(const f4*)(bp2 + (size_t)(k0 + bk) * ldb) * bmul;
        __syncthreads();
        As[ak + 0][tid >> 2] = av.x; As[ak + 1][tid >> 2] = av.y; As[ak + 2][tid >> 2] = av.z; As[ak + 3][tid >> 2] = av.w;
        *(f4*)&Bs[bk][(tid & 15) * 4] = bv;
        if (DUAL) *(f4*)&Bs2[bk][(tid & 15) * 4] = bv2;
        __syncthreads();
#pragma unroll
        for (int kk = 0; kk < 16; ++kk) {
            const f4 a = *(const f4*)&As[kk][ty * 4]; const f4 b = *(const f4*)&Bs[kk][tx * 4];
#define NG_ROW(r, av) acc[r][0] += av * b.x; acc[r][1] += av * b.y; acc[r][2] += av * b.z; acc[r][3] += av * b.w;
            NG_ROW(0, a.x) NG_ROW(1, a.y) NG_ROW(2, a.z) NG_ROW(3, a.w)
#undef NG_ROW
            if (DUAL) { const f4 b2 = *(const f4*)&Bs2[kk][tx * 4];
#define NG_ROW(r, av) acc2[r][0] += av * b2.x; acc2[r][1] += av * b2.y; acc2[r][2] += av * b2.z; acc2[r][3] += av * b2.w;
                NG_ROW(0, a.x) NG_ROW(1, a.y) NG_ROW(2, a.z) NG_ROW(3, a.w)
#undef NG_ROW
            }
        }
    }
#pragma unroll
    for (int r = 0; r < 4; ++r)
#pragma unroll
        for (int c = 0; c < 4; ++c) { const int i = tm * 64 + ty * 4 + r, j = tn * 64 + tx * 4 + c; if (i < M && j < N) epi(i, j, acc[r][c], acc2[r][c]); }
}
struct EStore { float* C; int ldc; __device__ void operator()(int i, int j, float v, float) const { C[(size_t)i * ldc + j] = v; } };
struct EMergeA { float* mg; const float* proj; __device__ void operator()(int i, int j, float v, float) const { mg[(size_t)i * D + j] = sigmoidf_(proj[(size_t)i * INW + C_MGA + j]) * v; } };
struct EMergeB { float* mg; const float* proj; __device__ void operator()(int i, int j, float v, float) const { mg[(size_t)i * D + j] += sigmoidf_(proj[(size_t)i * INW + C_MGB + j]) * v; } };
struct EResid { const float* x; const float* gt; float* out; __device__ void operator()(int i, int j, float v, float) const { out[(size_t)i * D + j] = x[(size_t)i * D + j] + gt[j] * v; } };
struct ESwiglu { float* hid; __device__ void operator()(int i, int j, float v, float v2) const { hid[(size_t)i * FF + j] = siluf_(v) * v2; } };
struct EDownAtomic { float* acc; const int* tok; const float* w; __device__ void operator()(int i, int j, float v, float) const { atomicAdd(&acc[(size_t)tok[i] * D + j], w[i] * v); } };

template <bool DUAL, class Epi>
__global__ void __launch_bounds__(256) k_ngemm(const float* A, int lda, const float* B, const float* B2, int ldb, int M, int N, int K, Epi epi) {
    ngemm_tile<DUAL>(A, lda, B, B2, ldb, M, N, K, blockIdx.y, blockIdx.x, RowId(), epi);
}
__global__ void __launch_bounds__(256) k_moe_gateup(const float* h2, const float* Wg, const float* Wu, const int* cnt, const int* off, const int* tok_sorted, float* hid) {
    const int e = blockIdx.z, Me = cnt[e]; if ((int)blockIdx.y * 64 >= Me) return;
    const int o = off[e];
    ngemm_tile<true>(h2, D, Wg + (size_t)e * D * FF, Wu + (size_t)e * D * FF, FF, Me, FF, D, blockIdx.y, blockIdx.x, RowGather{tok_sorted + o}, ESwiglu{hid + (size_t)o * FF});
}
__global__ void __launch_bounds__(256) k_moe_down(const float* hid, const float* Wd, const int* cnt, const int* off, const int* tok_sorted, const float* w_sorted, float* acc) {
    const int e = blockIdx.z, Me = cnt[e]; if ((int)blockIdx.y * 64 >= Me) return;
    const int o = off[e];
    ngemm_tile<false>(hid + (size_t)o * FF, FF, Wd + (size_t)e * FF * D, nullptr, D, Me, D, FF, blockIdx.y, blockIdx.x, RowId(), EDownAtomic{acc, tok_sorted + o, w_sorted + o});
}

__global__ void __launch_bounds__(128) k_hgrn(const float* __restrict__ proj, const float* __restrict__ lb, float* __restrict__ oraw) {
    constexpr int TB = 8;
    __shared__ float sq[TB][128], sf[TB][128], sk[TB][128], sv[TB][128];
    const int h = blockIdx.x, tid = threadIdx.x; const float lbv = lb[h * 128 + tid];
    float st[128];
#pragma unroll
    for (int d = 0; d < 128; ++d) st[d] = 0.f;
    for (int t0 = 0; t0 < S; t0 += TB) {
        for (int tt = 0; tt < TB; ++tt) {
            const float* base = proj + (size_t)(t0 + tt) * INW + h * 128 + tid;
            const float f = lbv + (1.f - lbv) * sigmoidf_(base[C_HF]);
            sq[tt][tid] = siluf_(base[C_HQ]) * 0.08838834764831845f; sf[tt][tid] = f; sk[tt][tid] = 1.f - f; sv[tt][tid] = base[C_HI];
        }
        __syncthreads();
#pragma unroll 1
        for (int tt = 0; tt < TB; ++tt) {
            float o = 0.f; const float vv = sv[tt][tid];
#pragma unroll
            for (int d = 0; d < 128; d += 4) {
                const float4 q4 = *(const float4*)&sq[tt][d], f4 = *(const float4*)&sf[tt][d], k4 = *(const float4*)&sk[tt][d];
                st[d] = f4.x * st[d] + k4.x * vv; o += q4.x * st[d];
                st[d + 1] = f4.y * st[d + 1] + k4.y * vv; o += q4.y * st[d + 1];
                st[d + 2] = f4.z * st[d + 2] + k4.z * vv; o += q4.z * st[d + 2];
                st[d + 3] = f4.w * st[d + 3] + k4.w * vv; o += q4.w * st[d + 3];
            }
            oraw[(size_t)(t0 + tt) * 1024 + h * 128 + tid] = o;
        }
        __syncthreads();
    }
}
__device__ __forceinline__ float half_sum128(float v, float* red) {
    v = wave_sum(v); const int w = threadIdx.x >> 6;
    __syncthreads(); if ((threadIdx.x & 63) == 0) red[w] = v; __syncthreads();
    return red[w & ~1] + red[w | 1];
}
__global__ void __launch_bounds__(256) k_gdn_pre(const float* __restrict__ proj, const float* __restrict__ cw, const float* __restrict__ a_log, const float* __restrict__ dt_bias,
                                                 float* gq, float* gk, float* gv, float* gbeta, float* gdec) {
    __shared__ float red[4];
    const int t = blockIdx.x, tid = threadIdx.x;
    for (int grp = 0; grp < 12; ++grp) {
        const int ch = grp * 256 + tid; float acc = 0.f;
#pragma unroll
        for (int j = 0; j < 4; ++j) { const int tt = t - 3 + j; if (tt >= 0) acc += cw[j * 3072 + ch] * proj[(size_t)tt * INW + C_GQKV + ch]; }
        const float val = siluf_(acc);
        if (grp < 8) {
            const float ss = half_sum128(val * val, red); const float n = val * rsqrtf(ss + 1e-6f);
            if (grp < 4) gq[(size_t)t * 1024 + ch] = n * 0.08838834764831845f; else gk[(size_t)t * 1024 + ch - 1024] = n;
        } else gv[(size_t)t * 1024 + ch - 2048] = val;
    }
    if (tid < 8) {
        const float ga = proj[(size_t)t * INW + C_GA + tid], gb = proj[(size_t)t * INW + C_GB + tid];
        gbeta[t * 8 + tid] = sigmoidf_(gb); gdec[t * 8 + tid] = expf(-expf(a_log[tid]) * softplusf_(ga + dt_bias[tid]));
    }
}
__global__ void __launch_bounds__(128) k_gdn(const float* __restrict__ gq, const float* __restrict__ gk, const float* __restrict__ gv, const float* __restrict__ gbeta, const float* __restrict__ gdec, float* __restrict__ oraw) {
    constexpr int TB = 8;
    __shared__ float sq[TB][128], sk[TB][128], sv[TB][128], sb[TB], sa[TB];
    const int h = blockIdx.x, tid = threadIdx.x;
    float st[128];
#pragma unroll
    for (int d = 0; d < 128; ++d) st[d] = 0.f;
    for (int t0 = 0; t0 < S; t0 += TB) {
        for (int tt = 0; tt < TB; ++tt) {
            const size_t o = (size_t)(t0 + tt) * 1024 + h * 128 + tid;
            sq[tt][tid] = gq[o]; sk[tt][tid] = gk[o]; sv[tt][tid] = gv[o];
        }
        if (tid < TB) { sb[tid] = gbeta[(t0 + tid) * 8 + h]; sa[tid] = gdec[(t0 + tid) * 8 + h]; }
        __syncthreads();
#pragma unroll 1
        for (int tt = 0; tt < TB; ++tt) {
            const float a = sa[tt], be = sb[tt]; float kd = 0.f;
#pragma unroll
            for (int d = 0; d < 128; d += 4) { const float4 k4 = *(const float4*)&sk[tt][d]; kd += k4.x * st[d] + k4.y * st[d + 1] + k4.z * st[d + 2] + k4.w * st[d + 3]; }
            const float c1 = be * (sv[tt][tid] - a * kd); float o = 0.f;
#pragma unroll
            for (int d = 0; d < 128; d += 4) {
                const float4 k4 = *(const float4*)&sk[tt][d], q4 = *(const float4*)&sq[tt][d];
                st[d] = a * st[d] + c1 * k4.x; o += q4.x * st[d];
                st[d + 1] = a * st[d + 1] + c1 * k4.y; o += q4.y * st[d + 1];
                st[d + 2] = a * st[d + 2] + c1 * k4.z; o += q4.z * st[d + 2];
                st[d + 3] = a * st[d + 3] + c1 * k4.w; o += q4.w * st[d + 3];
            }
            oraw[(size_t)(t0 + tt) * 1024 + h * 128 + tid] = o;
        }
        __syncthreads();
    }
}
__global__ void __launch_bounds__(256) k_onorm(const float* oraw, const float* __restrict__ proj, int gate_col, const float* __restrict__ g, float* out) {
    __shared__ float red[4];
    const int t = blockIdx.x, tid = threadIdx.x;
    for (int i = 0; i < 4; ++i) {
        const int ch = i * 256 + tid; const float v = oraw[(size_t)t * 1024 + ch];
        const float ss = half_sum128(v * v, red);
        out[(size_t)t * 1024 + ch] = v * rsqrtf(ss * (1.f / 128.f) + 1e-6f) * g[ch & 127] * siluf_(proj[(size_t)t * INW + gate_col + ch]);
    }
}
__global__ void __launch_bounds__(256) k_router(const float* __restrict__ h2, const float* __restrict__ wr, const float* __restrict__ rbias, int* __restrict__ idx, float* __restrict__ wts) {
    const int lane = threadIdx.x & 63, t = blockIdx.x * 4 + (threadIdx.x >> 6);
    const float* hr = h2 + (size_t)t * D; float acc = 0.f;
    for (int i = 0; i < D; ++i) acc += hr[i] * wr[i * 64 + lane];
    const float s = sigmoidf_(acc), b = s + rbias[lane];
    int rk = 0;
#pragma unroll
    for (int x = 1; x < 8; ++x) { const float ob = __shfl_xor(b, x); const int ol = lane ^ x; rk += (ob > b || (ob == b && ol < lane)) ? 1 : 0; }
    float gs = rk < 2 ? b : 0.f; gs += __shfl_xor(gs, 1); gs += __shfl_xor(gs, 2); gs += __shfl_xor(gs, 4);
    int grk = 0;
#pragma unroll
    for (int x = 8; x < 64; x += 8) { const float og = __shfl_xor(gs, x); const int ol = lane ^ x; grk += (og > gs || (og == gs && ol < lane)) ? 1 : 0; }
    float mb = grk < 4 ? b : -INFINITY;
    float wsum = 0.f; int myk = -1;
    for (int k = 0; k < TOPK; ++k) {
        float m = mb;
#pragma unroll
        for (int o = 32; o >= 1; o >>= 1) m = fmaxf(m, __shfl_xor(m, o));
        const unsigned long long bal = __ballot(mb == m); const int win = __ffsll((long long)bal) - 1;
        const float sw = __shfl(s, win); wsum += sw;
        if (lane == win) { mb = -INFINITY; myk = k; }
    }
    if (myk >= 0) { idx[t * TOPK + myk] = lane; wts[t * TOPK + myk] = s / wsum * 2.5f; }
}
__global__ void __launch_bounds__(256) k_count(const int* __restrict__ idx, int* cnt) {
    __shared__ int red[4]; const int e = blockIdx.x; int c = 0;
    for (int p = threadIdx.x; p < TK; p += 256) c += (idx[p] == e) ? 1 : 0;
#pragma unroll
    for (int o = 32; o >= 1; o >>= 1) c += __shfl_xor(c, o);
    if ((threadIdx.x & 63) == 0) red[threadIdx.x >> 6] = c; __syncthreads();
    if (threadIdx.x == 0) cnt[e] = red[0] + red[1] + red[2] + red[3];
}
__global__ void __launch_bounds__(256) k_scatter(const int* __restrict__ idx, const float* __restrict__ wts, const int* __restrict__ cnt, int* off, int* tok_sorted, float* w_sorted) {
    __shared__ int wsum[4]; __shared__ int base;
    const int e = blockIdx.x, tid = threadIdx.x, lane = tid & 63, w = tid >> 6;
    if (tid == 0) { int o = 0; for (int i = 0; i < e; ++i) o += cnt[i]; base = o; off[e] = o; }
    __syncthreads();
    int run = base;
    for (int p0 = 0; p0 < TK; p0 += 256) {
        const int p = p0 + tid; const bool f = idx[p] == e;
        const unsigned long long bal = __ballot(f); const int pre = __popcll(bal & ((1ull << lane) - 1ull));
        if (lane == 0) wsum[w] = __popcll(bal);
        __syncthreads();
        int wo = 0; for (int i = 0; i < w; ++i) wo += wsum[i];
        const int tot = wsum[0] + wsum[1] + wsum[2] + wsum[3];
        if (f) { tok_sorted[run + wo + pre] = p / TOPK; w_sorted[run + wo + pre] = wts[p]; }
        run += tot;
        __syncthreads();
    }
}

extern "C" void kernel_launch(void* const* d_in, const int* in_sizes, int n_in, void* d_out, int out_size, void* d_ws, size_t ws_size, hipStream_t stream) {
    const float* x = (const float*)d_in[0]; const float* c = (const float*)d_in[1]; const float* w_ada = (const float*)d_in[2]; const float* b_ada = (const float*)d_in[3];
    const float* norm1_g = (const float*)d_in[4]; const float* norm2_g = (const float*)d_in[5]; const float* w_in = (const float*)d_in[6]; const float* lb_table = (const float*)d_in[7];
    const float* hgrn_onorm_g = (const float*)d_in[8]; const float* conv_w = (const float*)d_in[9]; const float* a_log = (const float*)d_in[10]; const float* dt_bias = (const float*)d_in[11];
    const float* gdn_onorm_g = (const float*)d_in[12]; const float* w_bh = (const float*)d_in[13]; const float* w_bg = (const float*)d_in[14]; const float* w_out = (const float*)d_in[15];
    const float* w_router = (const float*)d_in[16]; const float* router_bias = (const float*)d_in[17]; const float* w_eg = (const float*)d_in[18]; const float* w_eu = (const float*)d_in[19];
    const float* w_ed = (const float*)d_in[20]; const float* w_sg = (const float*)d_in[21]; const float* w_su = (const float*)d_in[22]; const float* w_sd = (const float*)d_in[23]; const float* normf_g = (const float*)d_in[24];
    float* out = (float*)d_out;
    char* ws = (char*)d_ws;
    constexpr size_t MB = 1024 * 1024;
    float* mod = (float*)(ws + 0);
    float* lb = (float*)(ws + 64 * 1024);
    int* cnt = (int*)(ws + 80 * 1024); int* off = (int*)(ws + 84 * 1024);
    int* idx = (int*)(ws + 1 * MB); float* wts = (float*)(ws + 2 * MB); int* tok_sorted = (int*)(ws + 3 * MB); float* w_sorted = (float*)(ws + 4 * MB);
    char* big0 = ws + 16 * MB;
    const size_t projB = (size_t)S * INW * 4;
    float* proj = (float*)big0;
    char* big1 = big0 + ((projB + 255) & ~(size_t)255);
    const size_t r1k = (size_t)S * 1024 * 4;
    float* h1 = (float*)big1;
    float* gq = (float*)big1; float* gk = (float*)(big1 + r1k); float* gv = (float*)(big1 + 2 * r1k); float* oa = (float*)(big1 + 3 * r1k); float* ob = (float*)(big1 + 4 * r1k);
    float* gbeta = (float*)(ws + 5 * MB); float* gdec = (float*)(ws + 6 * MB);
    float* merged = (float*)big1;
    const size_t need = (size_t)(big1 - ws) + 5 * r1k;
    if (ws_size < need) { fprintf(stderr, "kernel_launch: workspace too small: %zu < %zu\n", ws_size, need); return; }
    float* h2 = (float*)big0; float* hid = (float*)(big0 + 2 * r1k); float* acc = (float*)(big0 + 2 * r1k + (size_t)TK * FF * 4); float* hidsh = (float*)(big0 + 4 * r1k + (size_t)TK * FF * 4);
    const float *sh1 = mod, *sc1 = mod + D, *gt1 = mod + 2 * D, *sh2 = mod + 3 * D, *sc2 = mod + 4 * D, *gt2 = mod + 5 * D;

    k_mod<<<48, 256, 0, stream>>>(c, w_ada, b_ada, mod);
    k_lb<<<4, 256, 0, stream>>>(lb_table, lb);
    k_norm_mod<<<S, 256, 0, stream>>>(x, norm1_g, sc1, sh1, h1);
    k_ngemm<false><<<dim3((INW + 63) / 64, S / 64), 256, 0, stream>>>(h1, D, w_in, nullptr, INW, S, INW, D, EStore{proj, INW});
    k_hgrn<<<8, 128, 0, stream>>>(proj, lb, oa);
    k_gdn_pre<<<S, 256, 0, stream>>>(proj, conv_w, a_log, dt_bias, gq, gk, gv, gbeta, gdec);
    k_gdn<<<8, 128, 0, stream>>>(gq, gk, gv, gbeta, gdec, ob);
    k_onorm<<<S, 256, 0, stream>>>(oa, proj, C_HG, hgrn_onorm_g, oa);
    k_onorm<<<S, 256, 0, stream>>>(ob, proj, C_GG, gdn_onorm_g, ob);
    k_ngemm<false><<<dim3(D / 64, S / 64), 256, 0, stream>>>(oa, 1024, w_bh, nullptr, D, S, D, 1024, EMergeA{merged, proj});
    k_ngemm<false><<<dim3(D / 64, S / 64), 256, 0, stream>>>(ob, 1024, w_bg, nullptr, D, S, D, 1024, EMergeB{merged, proj});
    k_ngemm<false><<<dim3(D / 64, S / 64), 256, 0, stream>>>(merged, D, w_out, nullptr, D, S, D, D, EResid{x, gt1, out});
    k_norm_mod<<<S, 256, 0, stream>>>(out, norm2_g, sc2, sh2, h2);
    k_router<<<S / 4, 256, 0, stream>>>(h2, w_router, router_bias, idx, wts);
    k_count<<<NE, 256, 0, stream>>>(idx, cnt);
    k_scatter<<<NE, 256, 0, stream>>>(idx, wts, cnt, off, tok_sorted, w_sorted);
    k_ngemm<true><<<dim3(FF / 64, S / 64), 256, 0, stream>>>(h2, D, w_sg, w_su, FF, S, FF, D, ESwiglu{hidsh});
    k_ngemm<false><<<dim3(D / 64, S / 64), 256, 0, stream>>>(hidsh, FF, w_sd, nullptr, D, S, D, FF, EStore{acc, D});
    k_moe_gateup<<<dim3(FF / 64, S / 64, NE), 256, 0, stream>>>(h2, w_eg, w_eu, cnt, off, tok_sorted, hid);
    k_moe_down<<<dim3(D / 64, S / 64, NE), 256, 0, stream>>>(hid, w_ed, cnt, off, tok_sorted, w_sorted, acc);
    k_final<<<S, 256, 0, stream>>>(out, acc, gt2, normf_g, out);
}
```

```cpp
#include <hip/hip_runtime.h>
#include <stdint.h>
#include <stdio.h>

#define LAS __attribute__((address_space(3)))
typedef unsigned short bf16_t;
typedef short bf16x8 __attribute__((ext_vector_type(8)));
typedef float f32x4 __attribute__((ext_vector_type(4)));
typedef unsigned u32x4 __attribute__((ext_vector_type(4)));
typedef unsigned u32x2 __attribute__((ext_vector_type(2)));

constexpr int S = 16384, D = 2048, INW = 12304, PW = 12288, NE = 64, TOPK = 8, TK = S * TOPK, FF = 512;
constexpr int NEX = NE + 1;
constexpr int PROUTED = 147456, PTOT = PROUTED + S, NBLK_MAX = PROUTED / 256;
constexpr int C_HQ = 0, C_HF = 1024, C_HI = 2048, C_HG = 3072, C_GQKV = 4096, C_GG = 7168, C_MGA = 8192, C_MGB = 10240;
constexpr int WIN_GAB = 7168;

__device__ __forceinline__ float sigmoidf_(float x) { return 1.f / (1.f + __expf(-x)); }
__device__ __forceinline__ float siluf_(float x) { return x / (1.f + __expf(-x)); }
__device__ __forceinline__ float softplusf_(float x) { return x > 20.f ? x : log1pf(expf(x)); }
__device__ __forceinline__ float bf2f(bf16_t b) { return __uint_as_float(((unsigned)b) << 16); }
__device__ __forceinline__ float bflo(unsigned w) { return __uint_as_float(w << 16); }
__device__ __forceinline__ float bfhi(unsigned w) { return __uint_as_float(w & 0xffff0000u); }
__device__ __forceinline__ unsigned cvt_pk_bf16(float lo, float hi) { unsigned r; asm volatile("v_cvt_pk_bf16_f32 %0, %1, %2" : "=v"(r) : "v"(lo), "v"(hi)); return r; }
__device__ __forceinline__ float wave_sum(float v) {
#pragma unroll
    for (int o = 32; o >= 1; o >>= 1) v += __shfl_xor(v, o);
    return v;
}

namespace gm {
constexpr int BM = 256, BK = 64, HALF = 128, HTB = HALF * BK * 2, STAGE_BYTES = 8 * HTB;
__host__ __device__ __forceinline__ int lds_byte(int r, int c) { const int st = (r >> 4) * 2 + (c >> 5), rr = r & 15, cc = c & 31, ob = rr * 64 + cc * 2; return st * 1024 + (ob ^ (((ob >> 9) & 1) << 5)); }
__host__ __device__ __forceinline__ void stage_rc(int b, int& R, int& C) { const int st = b / 1024, sb = b % 1024, swz = sb ^ (((sb >> 9) & 1) << 5); R = (st >> 1) * 16 + swz / 64; C = (st & 1) * 32 + (swz % 64) / 2; }
__host__ __device__ __forceinline__ int perm32(int rho) { const int n = rho >> 4, i = rho & 15; return 8 * (i >> 2) + 4 * n + (i & 3); }

struct Unit { int pm, pn, aux; const char* Bp; unsigned a00, a01, a10, a11; };

template <class Epi, class Sched>
__device__ __forceinline__ void gphase(LAS unsigned char* lds, const char* Abase, const int K, Sched& S, Epi& E) {
    const int tid = threadIdx.x, wid = __builtin_amdgcn_readfirstlane(tid >> 6), lane = tid & 63, wr = wid >> 2, wc = wid & 3, fr = lane & 15, fq = lane >> 4;
    const int nt = K / BK;
    unsigned voffB[2];
#pragma unroll
    for (int i = 0; i < 2; ++i) { int R, C; stage_rc(tid * 16 + i * 8192, R, C); const int Rb = Epi::PERM ? ((R & ~31) + perm32(R & 31)) : R; voffB[i] = (unsigned)(Rb * K + C) * 2u; }
    const size_t hstepB = (size_t)HALF * K * 2;
    const unsigned ldsw = (unsigned)wid * 1024u;
    const int aoff = lds_byte(wr * 64 + fr, fq * 8), boff = lds_byte(wc * 32 + fr, fq * 8);
#define G_SA(b, h) (((b) * 2 + (h)) * HTB)
#define G_SB(b, h) ((4 + (b) * 2 + (h)) * HTB)
#define G_STAGE_A(bufoff, o0, o1, kb) do { \
        __builtin_amdgcn_global_load_lds((const unsigned*)(Abase + (o0) + (kb)), (LAS unsigned*)(lds + (bufoff) + ldsw), 16, 0, 0); \
        __builtin_amdgcn_global_load_lds((const unsigned*)(Abase + (o1) + (kb)), (LAS unsigned*)(lds + (bufoff) + ldsw + 8192), 16, 0, 0); } while (0)
#define G_STAGE_B(bufoff, bp, kb) do { \
        __builtin_amdgcn_global_load_lds((const unsigned*)((bp) + voffB[0] + (kb)), (LAS unsigned*)(lds + (bufoff) + ldsw), 16, 0, 0); \
        __builtin_amdgcn_global_load_lds((const unsigned*)((bp) + voffB[1] + (kb)), (LAS unsigned*)(lds + (bufoff) + ldsw + 8192), 16, 0, 0); } while (0)
#define G_LDA(dst, b, h) do { _Pragma("unroll") for (int m = 0; m < 4; ++m) _Pragma("unroll") for (int k = 0; k < 2; ++k) dst[m][k] = *(const LAS bf16x8*)(lds + G_SA(b, h) + aoff + m * 2048 + k * 1024); } while (0)
#define G_LDB(dst, b, h) do { _Pragma("unroll") for (int n = 0; n < 2; ++n) _Pragma("unroll") for (int k = 0; k < 2; ++k) dst[n][k] = *(const LAS bf16x8*)(lds + G_SB(b, h) + boff + n * 2048 + k * 1024); } while (0)
#define G_MMA(ai, bj, At, Bt) do { __builtin_amdgcn_s_setprio(1); _Pragma("unroll") for (int m = 0; m < 4; ++m) _Pragma("unroll") for (int n = 0; n < 2; ++n) _Pragma("unroll") for (int k = 0; k < 2; ++k) \
        acc[ai][bj][m][n] = __builtin_amdgcn_mfma_f32_16x16x32_bf16(Bt[n][k], At[m][k], acc[ai][bj][m][n], 0, 0, 0); __builtin_amdgcn_s_setprio(0); } while (0)
#define G_WAIT_V(n) asm volatile("s_waitcnt vmcnt(" #n ")" ::: "memory")
#define G_WAIT_L(n) asm volatile("s_waitcnt lgkmcnt(" #n ")" ::: "memory")
#define G_BAR __builtin_amdgcn_s_barrier()
#define G_SCHED __builtin_amdgcn_sched_barrier(0)
#define G_ZERO() do { _Pragma("unroll") for (int a = 0; a < 2; ++a) _Pragma("unroll") for (int b = 0; b < 2; ++b) _Pragma("unroll") for (int m = 0; m < 4; ++m) _Pragma("unroll") for (int n = 0; n < 2; ++n) acc[a][b][m][n] = (f32x4){0.f, 0.f, 0.f, 0.f}; } while (0)
    Unit cur, nxt; int ui = 0;
    if (!S.next(0, cur)) return;
    f32x4 acc[2][2][4][2];
    G_ZERO();
    bf16x8 At[4][2], B0[2][2], B1[2][2];
    G_STAGE_B(G_SB(0, 0), cur.Bp, 0); G_STAGE_B(G_SB(0, 1), cur.Bp + hstepB, 0); G_STAGE_A(G_SA(0, 0), cur.a00, cur.a01, 0); G_STAGE_A(G_SA(0, 1), cur.a10, cur.a11, 0);
    if (wr == 1) G_BAR;
    G_WAIT_V(2); G_BAR;
    G_STAGE_B(G_SB(1, 0), cur.Bp, 128); G_STAGE_A(G_SA(1, 0), cur.a00, cur.a01, 128); G_STAGE_B(G_SB(1, 1), cur.Bp + hstepB, 128);
    G_WAIT_V(6); G_BAR;
    for (;;) {
        const bool has_next = S.next(ui + 1, nxt);
        if (!has_next) nxt = cur;
        for (int t = 0; t < nt; t += 2) {
            const bool last = (t == nt - 2);
            const size_t kb1 = (size_t)(t + 1) * 128, kb2 = last ? 0 : (size_t)(t + 2) * 128, kb3 = kb2 + 128;
            const char* b2 = last ? nxt.Bp : cur.Bp;
            const unsigned x00 = last ? nxt.a00 : cur.a00, x01 = last ? nxt.a01 : cur.a01, x10 = last ? nxt.a10 : cur.a10, x11 = last ? nxt.a11 : cur.a11;
            G_LDB(B0, 0, 0); G_LDB(B1, 0, 1); G_SCHED; G_LDA(At, 0, 0); G_STAGE_A(G_SA(1, 1), cur.a10, cur.a11, kb1);
            G_WAIT_V(8); G_WAIT_L(0); G_BAR; G_MMA(0, 0, At, B0); G_MMA(0, 1, At, B1); G_BAR; G_SCHED;
            G_LDA(At, 0, 1); G_STAGE_B(G_SB(0, 0), b2, kb2); G_STAGE_B(G_SB(0, 1), b2 + hstepB, kb2); G_STAGE_A(G_SA(0, 0), x00, x01, kb2);
            G_WAIT_V(8); G_WAIT_L(0); G_BAR; G_MMA(1, 0, At, B0); G_MMA(1, 1, At, B1); G_BAR; G_SCHED;
            G_LDB(B0, 1, 0); G_LDB(B1, 1, 1); G_SCHED; G_LDA(At, 1, 0); G_STAGE_A(G_SA(0, 1), x10, x11, kb2);
            G_WAIT_V(8); G_WAIT_L(0); G_BAR; G_MMA(0, 0, At, B0); G_MMA(0, 1, At, B1); G_BAR; G_SCHED;
            G_LDA(At, 1, 1); G_STAGE_B(G_SB(1, 0), b2, kb3); G_STAGE_B(G_SB(1, 1), b2 + hstepB, kb3); G_STAGE_A(G_SA(1, 0), x00, x01, kb3);
            G_WAIT_V(8); G_WAIT_L(0); G_BAR; G_MMA(1, 0, At, B0); G_MMA(1, 1, At, B1); G_BAR; G_SCHED;
        }
        if (wr == 0) G_BAR;
        E(acc, cur, wr, wc, fr, fq);
        if (!has_next) break;
        if (!E.keep(cur)) G_ZERO();
        cur = nxt; ++ui;
        if (wr == 1) G_BAR;
    }
    G_WAIT_V(0);
    G_BAR;
#undef G_SA
#undef G_SB
#undef G_STAGE_A
#undef G_STAGE_B
#undef G_LDA
#undef G_LDB
#undef G_MMA
#undef G_WAIT_V
#undef G_WAIT_L
#undef G_BAR
#undef G_SCHED
#undef G_ZERO
}

struct DenseSched {
    int nM, nN, nwg, G, c, lda, K, parts; const char* Bt; const char* Bt2; int R0, C0, R1, C1;
    __device__ void init(int M, int N, int K_, int lda_, const void* Bt_, const void* Bt2_, int parts_) {
        nM = M / BM; nN = N / BM; nwg = nM * nN; G = gridDim.x; c = blockIdx.x; lda = lda_; K = K_; Bt = (const char*)Bt_; Bt2 = (const char*)Bt2_; parts = parts_;
        stage_rc(threadIdx.x * 16, R0, C0); stage_rc(threadIdx.x * 16 + 8192, R1, C1);
    }
    __device__ bool next(int i, Unit& u) const {
        const int ti = parts == 2 ? (i >> 1) : i, part = parts == 2 ? (i & 1) : 0;
        const long L = (long)ti * G + c; if (L >= nwg) return false;
        int wgid = (int)L; { const int q = nwg / 8, r = nwg % 8, xcd = wgid % 8, off = wgid / 8; wgid = (xcd < r ? xcd * (q + 1) : r * (q + 1) + (xcd - r) * q) + off; }
        const int nig = 8 * nN, gid = wgid / nig, fm = gid * 8, gsz = (nM - fm) < 8 ? (nM - fm) : 8;
        u.pm = fm + ((wgid % nig) % gsz); u.pn = (wgid % nig) / gsz; u.aux = part;
        u.Bp = (part ? Bt2 : Bt) + (size_t)u.pn * BM * K * 2;
        const unsigned rb = (unsigned)u.pm * BM, po = part ? (unsigned)K * 2u : 0u;
        u.a00 = ((rb + R0) * lda + C0) * 2u + po; u.a01 = ((rb + R1) * lda + C1) * 2u + po;
        u.a10 = ((rb + HALF + R0) * lda + C0) * 2u + po; u.a11 = ((rb + HALF + R1) * lda + C1) * 2u + po;
        return true;
    }
};
template <bool GATHER>
struct MoeSched {
    int nN, G, c, K, lda, nent; const int* blk_row; const int* blk_exp; const int* tok_p; const char* W; size_t wstride; int R0, C0, R1, C1;
    __device__ void init(int nN_, int K_, int lda_, const int* nent_p, const int* blk_row_, const int* blk_exp_, const int* tok_p_, const void* W_, size_t wstride_) {
        nN = nN_; G = gridDim.x; c = blockIdx.x; K = K_; lda = lda_; nent = *nent_p; blk_row = blk_row_; blk_exp = blk_exp_; tok_p = tok_p_; W = (const char*)W_; wstride = wstride_;
        stage_rc(threadIdx.x * 16, R0, C0); stage_rc(threadIdx.x * 16 + 8192, R1, C1);
    }
    __device__ bool next(int i, Unit& u) const {
        const long L = (long)i * G + c; if (L >= (long)nent * nN) return false;
        const int ent = (int)(L / nN); u.pn = (int)(L % nN);
        const int rb = blk_row[ent], e = blk_exp[ent]; u.pm = rb; u.aux = e;
        u.Bp = W + (size_t)e * wstride + (size_t)u.pn * BM * K * 2;
        if (GATHER) {
            const unsigned t00 = tok_p[rb + R0], t01 = tok_p[rb + R1], t10 = tok_p[rb + HALF + R0], t11 = tok_p[rb + HALF + R1];
            u.a00 = (t00 * lda + C0) * 2u; u.a01 = (t01 * lda + C1) * 2u; u.a10 = (t10 * lda + C0) * 2u; u.a11 = (t11 * lda + C1) * 2u;
        } else {
            u.a00 = ((unsigned)(rb + R0) * lda + C0) * 2u; u.a01 = ((unsigned)(rb + R1) * lda + C1) * 2u;
            u.a10 = ((unsigned)(rb + HALF + R0) * lda + C0) * 2u; u.a11 = ((unsigned)(rb + HALF + R1) * lda + C1) * 2u;
        }
        return true;
    }
};

struct EpiProj {
    static constexpr bool PERM = true; bf16_t* O;
    __device__ __forceinline__ bool keep(const Unit&) const { return false; }
    __device__ __forceinline__ void operator()(f32x4 (&acc)[2][2][4][2], const Unit& u, int wr, int wc, int fr, int fq) const {
        const int row0 = u.pm * BM + wr * 64 + fr, col0 = u.pn * BM + wc * 32 + 8 * fq;
#pragma unroll
        for (int ai = 0; ai < 2; ++ai)
#pragma unroll
            for (int m = 0; m < 4; ++m) { bf16_t* rowp = O + (size_t)(row0 + ai * HALF + m * 16) * PW + col0;
#pragma unroll
                for (int bj = 0; bj < 2; ++bj) { const f32x4 v0 = acc[ai][bj][m][0], v1 = acc[ai][bj][m][1]; u32x4 w;
                    w.x = cvt_pk_bf16(v0[0], v0[1]); w.y = cvt_pk_bf16(v0[2], v0[3]); w.z = cvt_pk_bf16(v1[0], v1[1]); w.w = cvt_pk_bf16(v1[2], v1[3]);
                    *(u32x4*)(rowp + bj * HALF) = w; } }
    }
};
struct EpiMerge {
    static constexpr bool PERM = true; const bf16_t* proj; bf16_t* O;
    __device__ __forceinline__ bool keep(const Unit& u) const { return u.aux == 0; }
    __device__ __forceinline__ void operator()(f32x4 (&acc)[2][2][4][2], const Unit& u, int wr, int wc, int fr, int fq) const {
        const int row0 = u.pm * BM + wr * 64 + fr, col0 = u.pn * BM + wc * 32 + 8 * fq;
#pragma unroll
        for (int ai = 0; ai < 2; ++ai)
#pragma unroll
            for (int m = 0; m < 4; ++m) { const size_t r = (size_t)(row0 + ai * HALF + m * 16);
#pragma unroll
                for (int bj = 0; bj < 2; ++bj) {
                    const u32x4 gb = *(const u32x4*)(proj + r * PW + C_MGB + col0 + bj * HALF);
                    const f32x4 eb0 = {__expf(-bflo(gb.x)), __expf(-bfhi(gb.x)), __expf(-bflo(gb.y)), __expf(-bfhi(gb.y))};
                    const f32x4 eb1 = {__expf(-bflo(gb.z)), __expf(-bfhi(gb.z)), __expf(-bflo(gb.w)), __expf(-bfhi(gb.w))};
                    if (u.aux == 0) {
                        const u32x4 ga = *(const u32x4*)(proj + r * PW + C_MGA + col0 + bj * HALF);
                        const f32x4 ea0 = {__expf(-bflo(ga.x)), __expf(-bfhi(ga.x)), __expf(-bflo(ga.y)), __expf(-bfhi(ga.y))};
                        const f32x4 ea1 = {__expf(-bflo(ga.z)), __expf(-bfhi(ga.z)), __expf(-bflo(ga.w)), __expf(-bfhi(ga.w))};
                        acc[ai][bj][m][0] = acc[ai][bj][m][0] * (1.f + eb0) / (1.f + ea0); acc[ai][bj][m][1] = acc[ai][bj][m][1] * (1.f + eb1) / (1.f + ea1);
                    } else {
                        const f32x4 v0 = acc[ai][bj][m][0] / (1.f + eb0), v1 = acc[ai][bj][m][1] / (1.f + eb1);
                        u32x4 w; w.x = cvt_pk_bf16(v0[0], v0[1]); w.y = cvt_pk_bf16(v0[2], v0[3]); w.z = cvt_pk_bf16(v1[0], v1[1]); w.w = cvt_pk_bf16(v1[2], v1[3]);
                        *(u32x4*)(O + r * D + col0 + bj * HALF) = w;
                    } } }
    }
};
struct EpiResid {
    static constexpr bool PERM = false; const float* x; const float* gt; float* O;
    __device__ __forceinline__ bool keep(const Unit&) const { return false; }
    __device__ __forceinline__ void operator()(f32x4 (&acc)[2][2][4][2], const Unit& u, int wr, int wc, int fr, int fq) const {
        const int row0 = u.pm * BM + wr * 64 + fr, col0 = u.pn * BM + wc * 32 + 4 * fq;
        f32x4 g[2][2];
#pragma unroll
        for (int bj = 0; bj < 2; ++bj)
#pragma unroll
            for (int n = 0; n < 2; ++n) g[bj][n] = *(const f32x4*)(gt + col0 + bj * HALF + n * 16);
#pragma unroll
        for (int ai = 0; ai < 2; ++ai)
#pragma unroll
            for (int m = 0; m < 4; ++m) { const size_t ro = (size_t)(row0 + ai * HALF + m * 16) * D + col0;
#pragma unroll
                for (int bj = 0; bj < 2; ++bj)
#pragma unroll
                    for (int n = 0; n < 2; ++n) { const f32x4 xv = *(const f32x4*)(x + ro + bj * HALF + n * 16); *(f32x4*)(O + ro + bj * HALF + n * 16) = xv + g[bj][n] * acc[ai][bj][m][n]; } }
    }
};
struct EpiSwiglu {
    static constexpr bool PERM = true; bf16_t* hid;
    __device__ __forceinline__ bool keep(const Unit&) const { return false; }
    __device__ __forceinline__ void operator()(f32x4 (&acc)[2][2][4][2], const Unit& u, int wr, int wc, int fr, int fq) const {
        const int row0 = u.pm + wr * 64 + fr, j0 = u.pn * 128 + wc * 16 + 4 * fq;
#pragma unroll
        for (int ai = 0; ai < 2; ++ai)
#pragma unroll
            for (int m = 0; m < 4; ++m) { bf16_t* rowp = hid + (size_t)(row0 + ai * HALF + m * 16) * FF + j0;
#pragma unroll
                for (int bj = 0; bj < 2; ++bj) { const f32x4 g = acc[ai][bj][m][0], up = acc[ai][bj][m][1]; u32x2 w;
                    w.x = cvt_pk_bf16(siluf_(g[0]) * up[0], siluf_(g[1]) * up[1]); w.y = cvt_pk_bf16(siluf_(g[2]) * up[2], siluf_(g[3]) * up[3]);
                    *(u32x2*)(rowp + bj * 64) = w; } }
    }
};
struct EpiDown {
    static constexpr bool PERM = true; bf16_t* Y; const float* w_p;
    __device__ __forceinline__ bool keep(const Unit&) const { return false; }
    __device__ __forceinline__ void operator()(f32x4 (&acc)[2][2][4][2], const Unit& u, int wr, int wc, int fr, int fq) const {
        const int row0 = u.pm + wr * 64 + fr, col0 = u.pn * BM + wc * 32 + 8 * fq;
#pragma unroll
        for (int ai = 0; ai < 2; ++ai)
#pragma unroll
            for (int m = 0; m < 4; ++m) { const int r = row0 + ai * HALF + m * 16; const float wt = w_p[r]; bf16_t* rowp = Y + (size_t)r * D + col0;
#pragma unroll
                for (int bj = 0; bj < 2; ++bj) { const f32x4 v0 = acc[ai][bj][m][0] * wt, v1 = acc[ai][bj][m][1] * wt; u32x4 w;
                    w.x = cvt_pk_bf16(v0[0], v0[1]); w.y = cvt_pk_bf16(v0[2], v0[3]); w.z = cvt_pk_bf16(v1[0], v1[1]); w.w = cvt_pk_bf16(v1[2], v1[3]);
                    *(u32x4*)(rowp + bj * HALF) = w; } }
    }
};
}

struct Ctx {
    const float *x, *c, *w_ada, *b_ada, *norm1_g, *norm2_g, *w_in, *lb_table, *hgrn_onorm_g, *conv_w, *a_log, *dt_bias, *gdn_onorm_g, *w_bh, *w_bg, *w_out, *w_router, *router_bias,
        *w_eg, *w_eu, *w_ed, *w_sg, *w_su, *w_sd, *normf_g;
    float* out;
    float *modp, *mod, *lb, *gab;
    int *idx, *cnt, *tok_p, *pos, *blk_row, *blk_exp, *nent;
    float *wts, *w_p;
    bf16_t *win_t, *wa_t, *wb_t, *wout_t, *h1, *proj, *ocat, *merged;
    float *gq, *gk, *gv, *gbeta, *gdec, *oa, *ob;
    bf16_t *dn_t, *hid, *gu_t, *h2, *Y; float* h2f;
};

__device__ __forceinline__ void cvt_tile(LAS float* t, const float* srcA, const float* srcB, int ld, int mode, bf16_t* dst, int ldd) {
    const int tid = threadIdx.x, kr = tid >> 6, cl = tid & 63;
    const float* sp = (mode == 1 && cl >= 32) ? (srcB + cl - 32) : (srcA + cl);
    float v[8];
#pragma unroll
    for (int p = 0; p < 8; ++p) v[p] = sp[(size_t)(p * 8 + kr) * ld];
    __syncthreads();
#pragma unroll
    for (int p = 0; p < 8; ++p) t[(p * 8 + kr) * 65 + cl] = v[p];
    __syncthreads();
    const int r = tid >> 3, seg = (tid & 7) * 8;
    const int lc = mode == 1 ? (((r >> 2) & 1) * 32 + 4 * (r >> 3) + (r & 3)) : r;
    float w[8];
#pragma unroll
    for (int j = 0; j < 8; ++j) w[j] = t[(seg + j) * 65 + lc];
    u32x4 o; o.x = cvt_pk_bf16(w[0], w[1]); o.y = cvt_pk_bf16(w[2], w[3]); o.z = cvt_pk_bf16(w[4], w[5]); o.w = cvt_pk_bf16(w[6], w[7]);
    *(u32x4*)(dst + (size_t)r * ldd + seg) = o;
}
__device__ __forceinline__ void cvt_job(LAS float* t, int tile, const float* src, int ld, int K, bf16_t* dst) {
    const int nkt = K / 64, nt = tile / nkt, kt = tile % nkt;
    cvt_tile(t, src + (size_t)kt * 64 * ld + nt * 64, nullptr, ld, 0, dst + (size_t)nt * 64 * K + kt * 64, K);
}

__device__ void ph_pro1(const Ctx& c, LAS unsigned char* lds) {
    const int tid = threadIdx.x, wg = blockIdx.x, G = gridDim.x;
    LAS float* lf = (LAS float*)lds;
    for (int job = wg; job < 192; job += G) {
        const int cc = job % 48, kp = job / 48, q = tid & 63, rg = tid >> 6;
        f32x4 a = {0.f, 0.f, 0.f, 0.f};
        for (int r = rg; r < 512; r += 8) { const int k = kp * 512 + r; const float s = siluf_(c.c[k]); a += s * *(const f32x4*)(c.w_ada + (size_t)k * (6 * D) + cc * 256 + q * 4); }
        __syncthreads();
        *(LAS f32x4*)(lf + (rg * 64 + q) * 4) = a;
        __syncthreads();
        if (tid < 64) { f32x4 s = {0.f, 0.f, 0.f, 0.f};
#pragma unroll
            for (int g = 0; g < 8; ++g) s += *(LAS f32x4*)(lf + (g * 64 + tid) * 4);
            *(f32x4*)(c.modp + (size_t)kp * (6 * D) + cc * 256 + tid * 4) = s; }
    }
    if (wg == G - 1) for (int j = tid; j < 1024; j += 512) c.lb[j] = 1.f / (1.f + expf(c.lb_table[1024 + j] - c.lb_table[j]));
    for (int T = wg; T < 8192; T += G) {
        if (T < 6144) { const int nt = T / 32, kt = T % 32; const int sc = nt * 64 + (nt * 64 >= WIN_GAB ? 16 : 0);
            cvt_tile(lf, c.w_in + (size_t)kt * 64 * INW + sc, nullptr, INW, 0, c.win_t + (size_t)nt * 64 * D + kt * 64, D); }
        else if (T < 6656) cvt_job(lf, T - 6144, c.w_bh, D, 1024, c.wa_t);
        else if (T < 7168) cvt_job(lf, T - 6656, c.w_bg, D, 1024, c.wb_t);
        else cvt_job(lf, T - 7168, c.w_out, D, 2048, c.wout_t);
    }
}
__device__ void ph_norm1(const Ctx& c, LAS unsigned char* lds) {
    const int tid = threadIdx.x, wg = blockIdx.x, G = gridDim.x, lane = tid & 63, wv = tid >> 6;
    LAS float* la = (LAS float*)lds;
    LAS float* lb_ = la + D;
    LAS float* lw = lb_ + D;
    for (int j = tid; j < D; j += 512) {
        float sh = c.b_ada[j], sc = c.b_ada[D + j];
#pragma unroll
        for (int p = 0; p < 4; ++p) { sh += c.modp[(size_t)p * 6 * D + j]; sc += c.modp[(size_t)p * 6 * D + D + j]; }
        la[j] = c.norm1_g[j] * (1.f + sc); lb_[j] = sh;
    }
    for (int j = wg * 512 + tid; j < 6 * D; j += G * 512) { float m = c.b_ada[j];
#pragma unroll
        for (int p = 0; p < 4; ++p) m += c.modp[(size_t)p * 6 * D + j];
        c.mod[j] = m; }
    for (int i = tid; i < D * 4; i += 512) { const int e = i >> 2, q = i & 3; const f32x4 w = *(const f32x4*)(c.w_in + (size_t)e * INW + WIN_GAB + q * 4);
        lw[(q * 4 + 0) * D + e] = w[0]; lw[(q * 4 + 1) * D + e] = w[1]; lw[(q * 4 + 2) * D + e] = w[2]; lw[(q * 4 + 3) * D + e] = w[3]; }
    __syncthreads();
    for (int row = wg * 8 + wv; row < S; row += G * 8) {
        const float* xr = c.x + (size_t)row * D; f32x4 v[8]; float ss = 0.f;
#pragma unroll
        for (int i = 0; i < 8; ++i) { v[i] = *(const f32x4*)(xr + i * 256 + lane * 4); ss += v[i][0] * v[i][0] + v[i][1] * v[i][1] + v[i][2] * v[i][2] + v[i][3] * v[i][3]; }
        ss = wave_sum(ss); const float r = rsqrtf(ss * (1.f / D) + 1e-6f);
#pragma unroll
        for (int i = 0; i < 8; ++i) { const int e = i * 256 + lane * 4; const f32x4 a = *(LAS f32x4*)(la + e), b = *(LAS f32x4*)(lb_ + e); v[i] = v[i] * r * a + b;
            u32x2 w; w.x = cvt_pk_bf16(v[i][0], v[i][1]); w.y = cvt_pk_bf16(v[i][2], v[i][3]); *(u32x2*)(c.h1 + (size_t)row * D + e) = w; }
        float mine = 0.f;
        for (int cc = 0; cc < 16; ++cc) { float d = 0.f;
#pragma unroll
            for (int i = 0; i < 8; ++i) { const f32x4 w = *(LAS f32x4*)(lw + cc * D + i * 256 + lane * 4); d += v[i][0] * w[0] + v[i][1] * w[1] + v[i][2] * w[2] + v[i][3] * w[3]; }
            d = wave_sum(d); if (lane == cc) mine = d; }
        if (lane < 16) c.gab[(size_t)row * 16 + lane] = mine;
    }
}
__device__ void ph_gemm1(const Ctx& c, LAS unsigned char* lds) {
    gm::DenseSched Sd; Sd.init(S, PW, D, D, c.win_t, nullptr, 1); gm::EpiProj E{c.proj};
    gm::gphase(lds, (const char*)c.h1, D, Sd, E);
}
__device__ void ph_gemm2(const Ctx& c, LAS unsigned char* lds) {
    gm::DenseSched Sd; Sd.init(S, D, 1024, 2048, c.wa_t, c.wb_t, 2); gm::EpiMerge E{c.proj, c.merged};
    gm::gphase(lds, (const char*)c.ocat, 1024, Sd, E);
}
__device__ void ph_gemm3(const Ctx& c, LAS unsigned char* lds) {
    gm::DenseSched Sd; Sd.init(S, D, D, D, c.wout_t, nullptr, 1); gm::EpiResid E{c.x, c.mod + 2 * D, c.out};
    gm::gphase(lds, (const char*)c.merged, D, Sd, E);
}
__device__ void ph_moe_gu(const Ctx& c, LAS unsigned char* lds) {
    gm::MoeSched<true> Sm; Sm.init(4, D, D, c.nent, c.blk_row, c.blk_exp, c.tok_p, c.gu_t, (size_t)1024 * D * 2); gm::EpiSwiglu E{c.hid};
    gm::gphase(lds, (const char*)c.h2, D, Sm, E);
}
__device__ void ph_moe_dn(const Ctx& c, LAS unsigned char* lds) {
    gm::MoeSched<false> Sm; Sm.init(8, FF, FF, c.nent, c.blk_row, c.blk_exp, c.tok_p, c.dn_t, (size_t)D * FF * 2); gm::EpiDown E{c.Y, c.w_p};
    gm::gphase(lds, (const char*)c.hid, FF, Sm, E);
}
__device__ void ph_norm2(const Ctx& c, LAS unsigned char* lds) {
    const int tid = threadIdx.x, wg = blockIdx.x, G = gridDim.x, lane = tid & 63, wv = tid >> 6;
    LAS float* la = (LAS float*)lds; LAS float* lb_ = la + D;
    for (int j = tid; j < D; j += 512) { la[j] = c.norm2_g[j] * (1.f + c.mod[4 * D + j]); lb_[j] = c.mod[3 * D + j]; }
    __syncthreads();
    for (int row = wg * 8 + wv; row < S; row += G * 8) {
        const float* xr = c.out + (size_t)row * D; f32x4 v[8]; float ss = 0.f;
#pragma unroll
        for (int i = 0; i < 8; ++i) { v[i] = *(const f32x4*)(xr + i * 256 + lane * 4); ss += v[i][0] * v[i][0] + v[i][1] * v[i][1] + v[i][2] * v[i][2] + v[i][3] * v[i][3]; }
        ss = wave_sum(ss); const float r = rsqrtf(ss * (1.f / D) + 1e-6f);
#pragma unroll
        for (int i = 0; i < 8; ++i) { const int e = i * 256 + lane * 4; const f32x4 a = *(LAS f32x4*)(la + e), b = *(LAS f32x4*)(lb_ + e); v[i] = v[i] * r * a + b;
            u32x2 w; w.x = cvt_pk_bf16(v[i][0], v[i][1]); w.y = cvt_pk_bf16(v[i][2], v[i][3]); *(u32x2*)(c.h2 + (size_t)row * D + e) = w;
            *(f32x4*)(c.h2f + (size_t)row * D + e) = v[i]; }
    }
}
__device__ void ph_cvt_exp(const Ctx& c, LAS unsigned char* lds) {
    LAS float* lf = (LAS float*)lds; const int wg = blockIdx.x, G = gridDim.x;
    constexpr int GU_T = 16 * 32, DN_T = 32 * 8;
    for (int T = wg; T < NEX * (GU_T + DN_T); T += G) {
        if (T < NEX * GU_T) { const int e = T / GU_T, r = T % GU_T, nt = r / 32, kt = r % 32;
            const float* sg = e < NE ? c.w_eg + (size_t)e * D * FF : c.w_sg; const float* su = e < NE ? c.w_eu + (size_t)e * D * FF : c.w_su;
            cvt_tile(lf, sg + (size_t)kt * 64 * FF + nt * 32, su + (size_t)kt * 64 * FF + nt * 32, FF, 1, c.gu_t + ((size_t)e * 1024 + nt * 64) * D + kt * 64, D); }
        else { const int T2 = T - NEX * GU_T, e = T2 / DN_T, r = T2 % DN_T; const float* sd = e < NE ? c.w_ed + (size_t)e * FF * D : c.w_sd;
            cvt_job(lf, r, sd, D, FF, c.dn_t + (size_t)e * D * FF); }
    }
}
__device__ void ph_final(const Ctx& c, LAS unsigned char* lds) {
    const int tid = threadIdx.x, wg = blockIdx.x, G = gridDim.x, lane = tid & 63, wv = tid >> 6;
    const float* gt2 = c.mod + 5 * D;
    for (int row = wg * 8 + wv; row < S; row += G * 8) {
        int p[9];
#pragma unroll
        for (int k = 0; k < 8; ++k) p[k] = c.pos[row * TOPK + k];
        p[8] = PROUTED + row;
        f32x4 v[8]; float ss = 0.f;
#pragma unroll
        for (int i = 0; i < 8; ++i) {
            const int e = i * 256 + lane * 4; f32x4 a = {0.f, 0.f, 0.f, 0.f};
#pragma unroll
            for (int k = 0; k < 9; ++k) { const u32x2 y = *(const u32x2*)(c.Y + (size_t)p[k] * D + e); a[0] += bflo(y.x); a[1] += bfhi(y.x); a[2] += bflo(y.y); a[3] += bfhi(y.y); }
            const f32x4 xv = *(const f32x4*)(c.out + (size_t)row * D + e), g = *(const f32x4*)(gt2 + e);
            v[i] = xv + g * a; ss += v[i][0] * v[i][0] + v[i][1] * v[i][1] + v[i][2] * v[i][2] + v[i][3] * v[i][3];
        }
        ss = wave_sum(ss); const float r = rsqrtf(ss * (1.f / D) + 1e-6f);
#pragma unroll
        for (int i = 0; i < 8; ++i) { const int e = i * 256 + lane * 4; *(f32x4*)(c.out + (size_t)row * D + e) = v[i] * r * *(const f32x4*)(c.normf_g + e); }
    }
}

template <int PH> __global__ void __launch_bounds__(512, 2) k_phase(Ctx c) {
    extern __shared__ __attribute__((aligned(16))) unsigned char smem[];
    LAS unsigned char* lds = (LAS unsigned char*)smem;
    if constexpr (PH == 0) ph_pro1(c, lds);
    if constexpr (PH == 1) ph_norm1(c, lds);
    if constexpr (PH == 2) ph_gemm1(c, lds);
    if constexpr (PH == 3) ph_gemm2(c, lds);
    if constexpr (PH == 4) ph_gemm3(c, lds);
    if constexpr (PH == 5) ph_norm2(c, lds);
    if constexpr (PH == 6) ph_cvt_exp(c, lds);
    if constexpr (PH == 7) ph_moe_gu(c, lds);
    if constexpr (PH == 8) ph_moe_dn(c, lds);
    if constexpr (PH == 9) ph_final(c, lds);
}

__global__ void __launch_bounds__(128) k_hgrn(const bf16_t* __restrict__ proj, const float* __restrict__ lb, float* __restrict__ oraw) {
    constexpr int TB = 8;
    __shared__ float sq[TB][128], sf[TB][128], sk[TB][128], sv[TB][128];
    const int h = blockIdx.x, tid = threadIdx.x; const float lbv = lb[h * 128 + tid];
    float st[128];
#pragma unroll
    for (int d = 0; d < 128; ++d) st[d] = 0.f;
    for (int t0 = 0; t0 < S; t0 += TB) {
        for (int tt = 0; tt < TB; ++tt) {
            const bf16_t* base = proj + (size_t)(t0 + tt) * PW + h * 128 + tid;
            const float f = lbv + (1.f - lbv) * sigmoidf_(bf2f(base[C_HF]));
            sq[tt][tid] = siluf_(bf2f(base[C_HQ])) * 0.08838834764831845f; sf[tt][tid] = f; sk[tt][tid] = 1.f - f; sv[tt][tid] = bf2f(base[C_HI]);
        }
        __syncthreads();
#pragma unroll 1
        for (int tt = 0; tt < TB; ++tt) {
            float o = 0.f; const float vv = sv[tt][tid];
#pragma unroll
            for (int d = 0; d < 128; d += 4) {
                const float4 q4 = *(const float4*)&sq[tt][d], f4 = *(const float4*)&sf[tt][d], k4 = *(const float4*)&sk[tt][d];
                st[d] = f4.x * st[d] + k4.x * vv; o += q4.x * st[d];
                st[d + 1] = f4.y * st[d + 1] + k4.y * vv; o += q4.y * st[d + 1];
                st[d + 2] = f4.z * st[d + 2] + k4.z * vv; o += q4.z * st[d + 2];
                st[d + 3] = f4.w * st[d + 3] + k4.w * vv; o += q4.w * st[d + 3];
            }
            oraw[(size_t)(t0 + tt) * 1024 + h * 128 + tid] = o;
        }
        __syncthreads();
    }
}
__device__ __forceinline__ float half_sum128(float v, float* red) {
    v = wave_sum(v); const int w = threadIdx.x >> 6;
    __syncthreads(); if ((threadIdx.x & 63) == 0) red[w] = v; __syncthreads();
    return red[w & ~1] + red[w | 1];
}
__global__ void __launch_bounds__(256) k_gdn_pre(const bf16_t* __restrict__ proj, const float* __restrict__ gab, const float* __restrict__ cw, const float* __restrict__ a_log, const float* __restrict__ dt_bias,
                                                 float* gq, float* gk, float* gv, float* gbeta, float* gdec) {
    __shared__ float red[4];
    const int t = blockIdx.x, tid = threadIdx.x;
    for (int grp = 0; grp < 12; ++grp) {
        const int ch = grp * 256 + tid; float acc = 0.f;
#pragma unroll
        for (int j = 0; j < 4; ++j) { const int tt = t - 3 + j; if (tt >= 0) acc += cw[j * 3072 + ch] * bf2f(proj[(size_t)tt * PW + C_GQKV + ch]); }
        const float val = siluf_(acc);
        if (grp < 8) {
            const float ss = half_sum128(val * val, red); const float n = val * rsqrtf(ss + 1e-6f);
            if (grp < 4) gq[(size_t)t * 1024 + ch] = n * 0.08838834764831845f; else gk[(size_t)t * 1024 + ch - 1024] = n;
        } else gv[(size_t)t * 1024 + ch - 2048] = val;
    }
    if (tid < 8) {
        const float ga = gab[(size_t)t * 16 + tid], gb = gab[(size_t)t * 16 + 8 + tid];
        gbeta[t * 8 + tid] = sigmoidf_(gb); gdec[t * 8 + tid] = expf(-expf(a_log[tid]) * softplusf_(ga + dt_bias[tid]));
    }
}
__global__ void __launch_bounds__(128) k_gdn(const float* __restrict__ gq, const float* __restrict__ gk, const float* __restrict__ gv, const float* __restrict__ gbeta, const float* __restrict__ gdec, float* __restrict__ oraw) {
    constexpr int TB = 8;
    __shared__ float sq[TB][128], sk[TB][128], sv[TB][128], sb[TB], sa[TB];
    const int h = blockIdx.x, tid = threadIdx.x;
    float st[128];
#pragma unroll
    for (int d = 0; d < 128; ++d) st[d] = 0.f;
    for (int t0 = 0; t0 < S; t0 += TB) {
        for (int tt = 0; tt < TB; ++tt) {
            const size_t o = (size_t)(t0 + tt) * 1024 + h * 128 + tid;
            sq[tt][tid] = gq[o]; sk[tt][tid] = gk[o]; sv[tt][tid] = gv[o];
        }
        if (tid < TB) { sb[tid] = gbeta[(t0 + tid) * 8 + h]; sa[tid] = gdec[(t0 + tid) * 8 + h]; }
        __syncthreads();
#pragma unroll 1
        for (int tt = 0; tt < TB; ++tt) {
            const float a = sa[tt], be = sb[tt]; float kd = 0.f;
#pragma unroll
            for (int d = 0; d < 128; d += 4) { const float4 k4 = *(const float4*)&sk[tt][d]; kd += k4.x * st[d] + k4.y * st[d + 1] + k4.z * st[d + 2] + k4.w * st[d + 3]; }
            const float c1 = be * (sv[tt][tid] - a * kd); float o = 0.f;
#pragma unroll
            for (int d = 0; d < 128; d += 4) {
                const float4 k4 = *(const float4*)&sk[tt][d], q4 = *(const float4*)&sq[tt][d];
                st[d] = a * st[d] + c1 * k4.x; o += q4.x * st[d];
                st[d + 1] = a * st[d + 1] + c1 * k4.y; o += q4.y * st[d + 1];
                st[d + 2] = a * st[d + 2] + c1 * k4.z; o += q4.z * st[d + 2];
                st[d + 3] = a * st[d + 3] + c1 * k4.w; o += q4.w * st[d + 3];
            }
            oraw[(size_t)(t0 + tt) * 1024 + h * 128 + tid] = o;
        }
        __syncthreads();
    }
}
__global__ void __launch_bounds__(256) k_onorm(const float* oraw, const bf16_t* __restrict__ proj, int gate_col, const float* __restrict__ g, bf16_t* ocat, int colbase) {
    __shared__ float red[4];
    const int t = blockIdx.x, tid = threadIdx.x;
    for (int i = 0; i < 4; ++i) {
        const int ch = i * 256 + tid; const float v = oraw[(size_t)t * 1024 + ch];
        const float ss = half_sum128(v * v, red);
        const float o = v * rsqrtf(ss * (1.f / 128.f) + 1e-6f) * g[ch & 127] * siluf_(bf2f(proj[(size_t)t * PW + gate_col + ch]));
        const unsigned pk = cvt_pk_bf16(o, o); ocat[(size_t)t * D + colbase + ch] = (bf16_t)(pk & 0xffffu);
    }
}
__global__ void __launch_bounds__(256) k_router(const float* __restrict__ h2, const float* __restrict__ wr, const float* __restrict__ rbias, int* __restrict__ idx, float* __restrict__ wts) {
    const int lane = threadIdx.x & 63, t = blockIdx.x * 4 + (threadIdx.x >> 6);
    const float* hr = h2 + (size_t)t * D; float acc = 0.f;
    for (int i = 0; i < D; ++i) acc += hr[i] * wr[i * 64 + lane];
    const float s = sigmoidf_(acc), b = s + rbias[lane];
    int rk = 0;
#pragma unroll
    for (int x = 1; x < 8; ++x) { const float ob = __shfl_xor(b, x); const int ol = lane ^ x; rk += (ob > b || (ob == b && ol < lane)) ? 1 : 0; }
    float gs = rk < 2 ? b : 0.f; gs += __shfl_xor(gs, 1); gs += __shfl_xor(gs, 2); gs += __shfl_xor(gs, 4);
    int grk = 0;
#pragma unroll
    for (int x = 8; x < 64; x += 8) { const float og = __shfl_xor(gs, x); const int ol = lane ^ x; grk += (og > gs || (og == gs && ol < lane)) ? 1 : 0; }
    float mb = grk < 4 ? b : -INFINITY;
    float wsum = 0.f; int myk = -1;
    for (int k = 0; k < TOPK; ++k) {
        float m = mb;
#pragma unroll
        for (int o = 32; o >= 1; o >>= 1) m = fmaxf(m, __shfl_xor(m, o));
        const unsigned long long bal = __ballot(mb == m); const int win = __ffsll((long long)bal) - 1;
        const float sw = __shfl(s, win); wsum += sw;
        if (lane == win) { mb = -INFINITY; myk = k; }
    }
    if (myk >= 0) { idx[t * TOPK + myk] = lane; wts[t * TOPK + myk] = s / wsum * 2.5f; }
}
__global__ void __launch_bounds__(256) k_count(const int* __restrict__ idx, int* cnt) {
    __shared__ int red[4]; const int e = blockIdx.x; int c = 0;
    for (int p = threadIdx.x; p < TK; p += 256) c += (idx[p] == e) ? 1 : 0;
#pragma unroll
    for (int o = 32; o >= 1; o >>= 1) c += __shfl_xor(c, o);
    if ((threadIdx.x & 63) == 0) red[threadIdx.x >> 6] = c; __syncthreads();
    if (threadIdx.x == 0) cnt[e] = red[0] + red[1] + red[2] + red[3];
}
__global__ void __launch_bounds__(256) k_scatter(const int* __restrict__ idx, const float* __restrict__ wts, const int* __restrict__ cnt, int* tok_p, float* w_p, int* pos, int* blk_row, int* blk_exp, int* nent) {
    __shared__ int wsum[4]; __shared__ int base;
    const int e = blockIdx.x, tid = threadIdx.x, lane = tid & 63, w = tid >> 6;
    if (tid == 0) { int o = 0; for (int i = 0; i < e; ++i) o += (cnt[i] + 255) & ~255; base = o; }
    __syncthreads();
    const int ps = base, ce = cnt[e], pe = (ce + 255) & ~255;
    for (int r = ce + tid; r < pe; r += 256) { tok_p[ps + r] = 0; w_p[ps + r] = 0.f; }
    { const int t = e * 256 + tid; tok_p[PROUTED + t] = t; w_p[PROUTED + t] = 1.f; }
    if (e == 0 && tid == 0) {
        int nb = 0;
        for (int i = 0; i < NE; ++i) { const int nbi = (cnt[i] + 255) >> 8; for (int b = 0; b < nbi; ++b) { blk_row[nb] = nb * 256; blk_exp[nb] = i; ++nb; } }
        for (int b = 0; b < S / 256; ++b) { blk_row[nb + b] = PROUTED + b * 256; blk_exp[nb + b] = NE; }
        *nent = nb + S / 256;
    }
    int run = ps;
    for (int p0 = 0; p0 < TK; p0 += 256) {
        const int p = p0 + tid; const bool f = idx[p] == e;
        const unsigned long long bal = __ballot(f); const int pre = __popcll(bal & ((1ull << lane) - 1ull));
        if (lane == 0) wsum[w] = __popcll(bal);
        __syncthreads();
        int wo = 0; for (int i = 0; i < w; ++i) wo += wsum[i];
        const int tot = wsum[0] + wsum[1] + wsum[2] + wsum[3];
        if (f) { const int d = run + wo + pre; tok_p[d] = p / TOPK; w_p[d] = wts[p]; pos[p] = d; }
        run += tot;
        __syncthreads();
    }
}

constexpr int LDS_BYTES = 147456;
template <int PH> static void launch_phase(const Ctx& c, hipStream_t stream) {
    static bool attr = false;
    if (!attr) { hipFuncSetAttribute((const void*)k_phase<PH>, hipFuncAttributeMaxDynamicSharedMemorySize, LDS_BYTES); attr = true; }
    hipLaunchKernelGGL(k_phase<PH>, dim3(256), dim3(512), LDS_BYTES, stream, c);
}
extern "C" void kernel_launch(void* const* d_in, const int* in_sizes, int n_in, void* d_out, int out_size, void* d_ws, size_t ws_size, hipStream_t stream) {
    Ctx c{};
    const float** ip = (const float**)&c.x;
    for (int i = 0; i < 25; ++i) ip[i] = (const float*)d_in[i];
    c.out = (float*)d_out;
    char* ws = (char*)d_ws; constexpr size_t MB = 1024 * 1024;
    c.modp = (float*)(ws + 0); c.mod = (float*)(ws + 256 * 1024); c.lb = (float*)(ws + 320 * 1024);
    c.cnt = (int*)(ws + 328 * 1024); c.nent = (int*)(ws + 332 * 1024); c.blk_row = (int*)(ws + 336 * 1024); c.blk_exp = (int*)(ws + 340 * 1024);
    c.idx = (int*)(ws + 1 * MB); c.wts = (float*)(ws + 2 * MB); c.tok_p = (int*)(ws + 3 * MB); c.w_p = (float*)(ws + 4 * MB); c.pos = (int*)(ws + 5 * MB);
    c.gab = (float*)(ws + 6 * MB); c.gbeta = (float*)(ws + 7 * MB + 0); c.gdec = (float*)(ws + 7 * MB + 512 * 1024);
    char* big = ws + 16 * MB;
    size_t o = 0;
    auto take = [&](size_t bytes) { char* p = big + o; o += (bytes + 255) & ~(size_t)255; return p; };
    c.win_t = (bf16_t*)take((size_t)PW * D * 2); c.wa_t = (bf16_t*)take((size_t)D * 1024 * 2); c.wb_t = (bf16_t*)take((size_t)D * 1024 * 2); c.wout_t = (bf16_t*)take((size_t)D * D * 2);
    c.h1 = (bf16_t*)take((size_t)S * D * 2); c.proj = (bf16_t*)take((size_t)S * PW * 2);
    c.gq = (float*)take((size_t)S * 1024 * 4); c.gk = (float*)take((size_t)S * 1024 * 4); c.gv = (float*)take((size_t)S * 1024 * 4);
    c.oa = (float*)take((size_t)S * 1024 * 4); c.ob = (float*)take((size_t)S * 1024 * 4);
    c.ocat = (bf16_t*)take((size_t)S * D * 2); c.merged = (bf16_t*)take((size_t)S * D * 2);
    const size_t era1 = o;
    o = 0;
    c.dn_t = (bf16_t*)take((size_t)NEX * D * FF * 2); c.hid = (bf16_t*)take((size_t)PTOT * FF * 2);
    const size_t ybase = o;
    c.gu_t = (bf16_t*)take((size_t)NEX * 1024 * D * 2); c.h2 = (bf16_t*)take((size_t)S * D * 2);
    const size_t after_h2 = o;
    c.Y = (bf16_t*)(big + ybase);
    size_t yend = ybase + (size_t)PTOT * D * 2; if (yend < after_h2) yend = after_h2;
    o = (yend + 255) & ~(size_t)255;
    c.h2f = (float*)take((size_t)S * D * 4);
    const size_t era2 = o;
    const size_t need = 16 * MB + (era1 > era2 ? era1 : era2);
    if (ws_size < need) { fprintf(stderr, "kernel_launch: workspace too small: %zu < %zu\n", ws_size, need); return; }

    launch_phase<0>(c, stream);
    launch_phase<1>(c, stream);
    launch_phase<2>(c, stream);
    k_hgrn<<<8, 128, 0, stream>>>(c.proj, c.lb, c.oa);
    k_gdn_pre<<<S, 256, 0, stream>>>(c.proj, c.gab, c.conv_w, c.a_log, c.dt_bias, c.gq, c.gk, c.gv, c.gbeta, c.gdec);
    k_gdn<<<8, 128, 0, stream>>>(c.gq, c.gk, c.gv, c.gbeta, c.gdec, c.ob);
    k_onorm<<<S, 256, 0, stream>>>(c.oa, c.proj, C_HG, c.hgrn_onorm_g, c.ocat, 0);
    k_onorm<<<S, 256, 0, stream>>>(c.ob, c.proj, C_GG, c.gdn_onorm_g, c.ocat, 1024);
    launch_phase<3>(c, stream);
    launch_phase<4>(c, stream);
    launch_phase<5>(c, stream);
    k_router<<<S / 4, 256, 0, stream>>>(c.h2f, c.w_router, c.router_bias, c.idx, c.wts);
    k_count<<<NE, 256, 0, stream>>>(c.idx, c.cnt);
    k_scatter<<<NE, 256, 0, stream>>>(c.idx, c.wts, c.cnt, c.tok_p, c.w_p, c.pos, c.blk_row, c.blk_exp, c.nent);
    launch_phase<6>(c, stream);
    launch_phase<7>(c, stream);
    launch_phase<8>(c, stream);
    launch_phase<9>(c, stream);
}
```

```cpp
#include <hip/hip_runtime.h>
#include <stdint.h>
#include <stdio.h>

#define LAS __attribute__((address_space(3)))
typedef unsigned short bf16_t;
typedef short bf16x8 __attribute__((ext_vector_type(8)));
typedef float f32x4 __attribute__((ext_vector_type(4)));
typedef unsigned u32x4 __attribute__((ext_vector_type(4)));
typedef unsigned u32x2 __attribute__((ext_vector_type(2)));

constexpr int S = 16384, D = 2048, INW = 12304, PW = 12288, NE = 64, TOPK = 8, TK = S * TOPK, FF = 512;
constexpr int NEX = NE + 1;
constexpr int PROUTED = 147456, PTOT = PROUTED + S, NBLK_MAX = PROUTED / 256;
constexpr int C_HQ = 0, C_HF = 1024, C_HI = 2048, C_HG = 3072, C_GQKV = 4096, C_GG = 7168, C_MGA = 8192, C_MGB = 10240;
constexpr int WIN_GAB = 7168;

__device__ __forceinline__ float sigmoidf_(float x) { return 1.f / (1.f + __expf(-x)); }
__device__ __forceinline__ float siluf_(float x) { return x / (1.f + __expf(-x)); }
__device__ __forceinline__ float softplusf_(float x) { return x > 20.f ? x : log1pf(expf(x)); }
__device__ __forceinline__ float bf2f(bf16_t b) { return __uint_as_float(((unsigned)b) << 16); }
__device__ __forceinline__ float bflo(unsigned w) { return __uint_as_float(w << 16); }
__device__ __forceinline__ float bfhi(unsigned w) { return __uint_as_float(w & 0xffff0000u); }
__device__ __forceinline__ unsigned cvt_pk_bf16(float lo, float hi) { unsigned r; asm volatile("v_cvt_pk_bf16_f32 %0, %1, %2" : "=v"(r) : "v"(lo), "v"(hi)); return r; }
__device__ __forceinline__ int ltid() { int t = threadIdx.x; asm volatile("" : "+v"(t)); return t; }
__device__ __forceinline__ float wave_sum(float v) {
#pragma unroll
    for (int o = 32; o >= 1; o >>= 1) v += __shfl_xor(v, o);
    return v;
}


#define XB_TMO      128
#define XB_XCNT(j)  (256  + 64 * (j))
#define XB_XSUB(j)  (1280 + 64 * (j))
#define XB_XGEN(j)  (2304 + 64 * (j))
#define XB_TOP      3328
#define XB_TOPGEN   3392
#define XCD_BAR_WORDS 3456
#define XB_SPIN_CAP (1u << 18)
__device__ __forceinline__ unsigned xb_ld(unsigned* p)              { return __hip_atomic_load(p, __ATOMIC_RELAXED, __HIP_MEMORY_SCOPE_AGENT); }
__device__ __forceinline__ unsigned xb_add(unsigned* p, unsigned v) { return __hip_atomic_fetch_add(p, v, __ATOMIC_RELAXED, __HIP_MEMORY_SCOPE_AGENT); }
__device__ __forceinline__ unsigned xb_xcc_id() { return (unsigned)__builtin_amdgcn_s_getreg((3 << 11) | 20) & 0xFu; }
#define XB_SPIN(cond, bar) do { unsigned _sp = 0; while (cond) { __builtin_amdgcn_s_sleep(1); \
    if ((++_sp & 255u) == 0u) { if (xb_ld(&(bar)[XB_TMO])) break; if (_sp > XB_SPIN_CAP) { atomicAdd(&(bar)[XB_TMO], 1u); break; } } } } while (0)
struct XcdBarrier { unsigned* bar; unsigned x; volatile LAS unsigned* st; };
__device__ __forceinline__ XcdBarrier xcd_barrier_post(unsigned* bar, volatile LAS unsigned* st) {
    XcdBarrier b; b.bar = bar; b.x = xb_xcc_id(); b.st = st;
    if (threadIdx.x == 0) (void)xb_add(&bar[XB_XCNT(b.x)], 1u);
    return b;
}
__device__ __forceinline__ void xcd_barrier_complete(unsigned* bar, unsigned x, unsigned& nloc, unsigned& nx) {
    const unsigned G = gridDim.x * gridDim.y * gridDim.z;
    unsigned sum, cnt, mine, sp = 0u;
    for (;;) {
        sum = 0u; cnt = 0u; mine = 0u;
#pragma unroll
        for (unsigned j = 0; j < 16; ++j) { const unsigned c = xb_ld(&bar[XB_XCNT(j)]); sum += c; cnt += (c > 0u) ? 1u : 0u; mine = (j == x) ? c : mine; }
        if (sum == G) break;
        __builtin_amdgcn_s_sleep(1);
        if ((++sp & 255u) == 0u) { if (xb_ld(&bar[XB_TMO])) break; if (sp > XB_SPIN_CAP) { atomicAdd(&bar[XB_TMO], 1u); break; } }
    }
    nloc = mine > 0u ? mine : 1u; nx = cnt > 0u ? cnt : 1u;
}
__device__ __forceinline__ void xcd_barrier(const XcdBarrier& b) {
    asm volatile("s_waitcnt vmcnt(0)" ::: "memory");
    __syncthreads();
    if (threadIdx.x == 0) {
        unsigned* bar = b.bar;
        __builtin_amdgcn_s_waitcnt(0);
        unsigned nloc = b.st[0], nx = b.st[1];
        if (nloc == 0u) { xcd_barrier_complete(bar, b.x, nloc, nx); b.st[0] = nloc; b.st[1] = nx; }
        const unsigned old = xb_add(&bar[XB_XSUB(b.x)], 1u);
        const unsigned gen = old / nloc;
        if (old + 1u == (gen + 1u) * nloc) {
            __builtin_amdgcn_fence(__ATOMIC_RELEASE, "agent");
            asm volatile("s_waitcnt vmcnt(0)" ::: "memory");
            const unsigned og = xb_add(&bar[XB_TOP], 1u);
            const unsigned tg = og / nx;
            if (og + 1u == (tg + 1u) * nx) xb_add(&bar[XB_TOPGEN], 1u);
            else XB_SPIN(xb_ld(&bar[XB_TOPGEN]) == tg, bar);
            __builtin_amdgcn_fence(__ATOMIC_ACQUIRE, "agent");
            xb_add(&bar[XB_XGEN(b.x)], 1u);
            asm volatile("s_waitcnt vmcnt(0)" ::: "memory");
        } else {
            XB_SPIN(xb_ld(&bar[XB_XGEN(b.x)]) == gen, bar);
            __builtin_amdgcn_fence(__ATOMIC_ACQUIRE, "agent");
            asm volatile("s_waitcnt vmcnt(0)" ::: "memory");
        }
    }
    __syncthreads();
}

namespace gm {
constexpr int BM = 256, BK = 64, HALF = 128, HTB = HALF * BK * 2, STAGE_BYTES = 8 * HTB;
__host__ __device__ __forceinline__ int lds_byte(int r, int c) { const int st = (r >> 4) * 2 + (c >> 5), rr = r & 15, cc = c & 31, ob = rr * 64 + cc * 2; return st * 1024 + (ob ^ (((ob >> 9) & 1) << 5)); }
__host__ __device__ __forceinline__ void stage_rc(int b, int& R, int& C) { const int st = b / 1024, sb = b % 1024, swz = sb ^ (((sb >> 9) & 1) << 5); R = (st >> 1) * 16 + swz / 64; C = (st & 1) * 32 + (swz % 64) / 2; }
__host__ __device__ __forceinline__ int perm32(int rho) { const int n = rho >> 4, i = rho & 15; return 8 * (i >> 2) + 4 * n + (i & 3); }

struct Unit { int pm, pn, aux; const char* Bp; unsigned a00, a01, a10, a11; };

template <class Epi, class Sched>
__device__ __forceinline__ void gphase(LAS unsigned char* lds, const char* Abase, const int K, Sched& S, Epi& E) {
    const int tid = ltid(), wid = __builtin_amdgcn_readfirstlane(tid >> 6), lane = tid & 63, wr = wid >> 2, wc = wid & 3, fr = lane & 15, fq = lane >> 4;
    const int nt = K / BK;
    unsigned voffB[2];
#pragma unroll
    for (int i = 0; i < 2; ++i) { int R, C; stage_rc(tid * 16 + i * 8192, R, C); const int Rb = Epi::PERM ? ((R & ~31) + perm32(R & 31)) : R; voffB[i] = (unsigned)(Rb * K + C) * 2u; }
    const size_t hstepB = (size_t)HALF * K * 2;
    const unsigned ldsw = (unsigned)wid * 1024u;
    const int aoff = lds_byte(wr * 64 + fr, fq * 8), boff = lds_byte(wc * 32 + fr, fq * 8);
#define G_SA(b, h) (((b) * 2 + (h)) * HTB)
#define G_SB(b, h) ((4 + (b) * 2 + (h)) * HTB)
#define G_STAGE_A(bufoff, o0, o1, kb) do { \
        __builtin_amdgcn_global_load_lds((const unsigned*)(Abase + (o0) + (kb)), (LAS unsigned*)(lds + (bufoff) + ldsw), 16, 0, 0); \
        __builtin_amdgcn_global_load_lds((const unsigned*)(Abase + (o1) + (kb)), (LAS unsigned*)(lds + (bufoff) + ldsw + 8192), 16, 0, 0); } while (0)
#define G_STAGE_B(bufoff, bp, kb) do { \
        __builtin_amdgcn_global_load_lds((const unsigned*)((bp) + voffB[0] + (kb)), (LAS unsigned*)(lds + (bufoff) + ldsw), 16, 0, 0); \
        __builtin_amdgcn_global_load_lds((const unsigned*)((bp) + voffB[1] + (kb)), (LAS unsigned*)(lds + (bufoff) + ldsw + 8192), 16, 0, 0); } while (0)
#define G_LDA(dst, b, h) do { _Pragma("unroll") for (int m = 0; m < 4; ++m) _Pragma("unroll") for (int k = 0; k < 2; ++k) dst[m][k] = *(const LAS bf16x8*)(lds + G_SA(b, h) + aoff + m * 2048 + k * 1024); } while (0)
#define G_LDB(dst, b, h) do { _Pragma("unroll") for (int n = 0; n < 2; ++n) _Pragma("unroll") for (int k = 0; k < 2; ++k) dst[n][k] = *(const LAS bf16x8*)(lds + G_SB(b, h) + boff + n * 2048 + k * 1024); } while (0)
#define G_MMA(ai, bj, At, Bt) do { __builtin_amdgcn_s_setprio(1); _Pragma("unroll") for (int m = 0; m < 4; ++m) _Pragma("unroll") for (int n = 0; n < 2; ++n) _Pragma("unroll") for (int k = 0; k < 2; ++k) \
        acc[ai][bj][m][n] = __builtin_amdgcn_mfma_f32_16x16x32_bf16(Bt[n][k], At[m][k], acc[ai][bj][m][n], 0, 0, 0); __builtin_amdgcn_s_setprio(0); } while (0)
#define G_WAIT_V(n) asm volatile("s_waitcnt vmcnt(" #n ")" ::: "memory")
#define G_WAIT_L(n) asm volatile("s_waitcnt lgkmcnt(" #n ")" ::: "memory")
#define G_BAR __builtin_amdgcn_s_barrier()
#define G_SCHED __builtin_amdgcn_sched_barrier(0)
#define G_ZERO() do { _Pragma("unroll") for (int a = 0; a < 2; ++a) _Pragma("unroll") for (int b = 0; b < 2; ++b) _Pragma("unroll") for (int m = 0; m < 4; ++m) _Pragma("unroll") for (int n = 0; n < 2; ++n) acc[a][b][m][n] = (f32x4){0.f, 0.f, 0.f, 0.f}; } while (0)
    Unit cur, nxt; int ui = 0;
    if (!S.next(0, cur)) return;
    f32x4 acc[2][2][4][2];
    G_ZERO();
    bf16x8 At[4][2], B0[2][2], B1[2][2];
    G_STAGE_B(G_SB(0, 0), cur.Bp, 0); G_STAGE_B(G_SB(0, 1), cur.Bp + hstepB, 0); G_STAGE_A(G_SA(0, 0), cur.a00, cur.a01, 0); G_STAGE_A(G_SA(0, 1), cur.a10, cur.a11, 0);
    if (wr == 1) G_BAR;
    G_WAIT_V(2); G_BAR;
    G_STAGE_B(G_SB(1, 0), cur.Bp, 128); G_STAGE_A(G_SA(1, 0), cur.a00, cur.a01, 128); G_STAGE_B(G_SB(1, 1), cur.Bp + hstepB, 128);
    G_WAIT_V(6); G_BAR;
    for (;;) {
        const bool has_next = S.next(ui + 1, nxt);
        if (!has_next) nxt = cur;
        for (int t = 0; t < nt; t += 2) {
            const bool last = (t == nt - 2);
            const size_t kb1 = (size_t)(t + 1) * 128, kb2 = last ? 0 : (size_t)(t + 2) * 128, kb3 = kb2 + 128;
            const char* b2 = last ? nxt.Bp : cur.Bp;
            const unsigned x00 = last ? nxt.a00 : cur.a00, x01 = last ? nxt.a01 : cur.a01, x10 = last ? nxt.a10 : cur.a10, x11 = last ? nxt.a11 : cur.a11;
            G_LDB(B0, 0, 0); G_LDB(B1, 0, 1); G_SCHED; G_LDA(At, 0, 0); G_STAGE_A(G_SA(1, 1), cur.a10, cur.a11, kb1);
            G_WAIT_V(8); G_WAIT_L(0); G_BAR; G_MMA(0, 0, At, B0); G_MMA(0, 1, At, B1); G_BAR; G_SCHED;
            G_LDA(At, 0, 1); G_STAGE_B(G_SB(0, 0), b2, kb2); G_STAGE_B(G_SB(0, 1), b2 + hstepB, kb2); G_STAGE_A(G_SA(0, 0), x00, x01, kb2);
            G_WAIT_V(8); G_WAIT_L(0); G_BAR; G_MMA(1, 0, At, B0); G_MMA(1, 1, At, B1); G_BAR; G_SCHED;
            G_LDB(B0, 1, 0); G_LDB(B1, 1, 1); G_SCHED; G_LDA(At, 1, 0); G_STAGE_A(G_SA(0, 1), x10, x11, kb2);
            G_WAIT_V(8); G_WAIT_L(0); G_BAR; G_MMA(0, 0, At, B0); G_MMA(0, 1, At, B1); G_BAR; G_SCHED;
            G_LDA(At, 1, 1); G_STAGE_B(G_SB(1, 0), b2, kb3); G_STAGE_B(G_SB(1, 1), b2 + hstepB, kb3); G_STAGE_A(G_SA(1, 0), x00, x01, kb3);
            G_WAIT_V(8); G_WAIT_L(0); G_BAR; G_MMA(1, 0, At, B0); G_MMA(1, 1, At, B1); G_BAR; G_SCHED;
        }
        if (wr == 0) G_BAR;
        E(acc, cur, wr, wc, fr, fq);
        if (!has_next) break;
        if (!E.keep(cur)) G_ZERO();
        cur = nxt; ++ui;
        if (wr == 1) G_BAR;
    }
    G_WAIT_V(0);
    G_BAR;
#undef G_SA
#undef G_SB
#undef G_STAGE_A
#undef G_STAGE_B
#undef G_LDA
#undef G_LDB
#undef G_MMA
#undef G_WAIT_V
#undef G_WAIT_L
#undef G_BAR
#undef G_SCHED
#undef G_ZERO
}

struct DenseSched {
    int nM, nN, nwg, G, c, lda, K, parts; const char* Bt; const char* Bt2; int R0, C0, R1, C1;
    __device__ void init(int M, int N, int K_, int lda_, const void* Bt_, const void* Bt2_, int parts_) {
        nM = M / BM; nN = N / BM; nwg = nM * nN; G = gridDim.x; c = blockIdx.x; lda = lda_; K = K_; Bt = (const char*)Bt_; Bt2 = (const char*)Bt2_; parts = parts_;
        stage_rc(ltid() * 16, R0, C0); stage_rc(ltid() * 16 + 8192, R1, C1);
    }
    __device__ bool next(int i, Unit& u) const {
        const int ti = parts == 2 ? (i >> 1) : i, part = parts == 2 ? (i & 1) : 0;
        const long L = (long)ti * G + c; if (L >= nwg) return false;
        int wgid = (int)L; { const int q = nwg / 8, r = nwg % 8, xcd = wgid % 8, off = wgid / 8; wgid = (xcd < r ? xcd * (q + 1) : r * (q + 1) + (xcd - r) * q) + off; }
        const int nig = 8 * nN, gid = wgid / nig, fm = gid * 8, gsz = (nM - fm) < 8 ? (nM - fm) : 8;
        u.pm = fm + ((wgid % nig) % gsz); u.pn = (wgid % nig) / gsz; u.aux = part;
        u.Bp = (part ? Bt2 : Bt) + (size_t)u.pn * BM * K * 2;
        const unsigned rb = (unsigned)u.pm * BM, po = part ? (unsigned)K * 2u : 0u;
        u.a00 = ((rb + R0) * lda + C0) * 2u + po; u.a01 = ((rb + R1) * lda + C1) * 2u + po;
        u.a10 = ((rb + HALF + R0) * lda + C0) * 2u + po; u.a11 = ((rb + HALF + R1) * lda + C1) * 2u + po;
        return true;
    }
};
template <bool GATHER>
struct MoeSched {
    int nN, G, c, K, lda, nent; const int* blk_row; const int* blk_exp; const int* tok_p; const char* W; size_t wstride; int R0, C0, R1, C1;
    __device__ void init(int nN_, int K_, int lda_, const int* nent_p, const int* blk_row_, const int* blk_exp_, const int* tok_p_, const void* W_, size_t wstride_) {
        nN = nN_; G = gridDim.x; c = blockIdx.x; K = K_; lda = lda_; nent = *nent_p; blk_row = blk_row_; blk_exp = blk_exp_; tok_p = tok_p_; W = (const char*)W_; wstride = wstride_;
        stage_rc(ltid() * 16, R0, C0); stage_rc(ltid() * 16 + 8192, R1, C1);
    }
    __device__ bool next(int i, Unit& u) const {
        const long L = (long)i * G + c; if (L >= (long)nent * nN) return false;
        const int ent = (int)(L / nN); u.pn = (int)(L % nN);
        const int rb = blk_row[ent], e = blk_exp[ent]; u.pm = rb; u.aux = e;
        u.Bp = W + (size_t)e * wstride + (size_t)u.pn * BM * K * 2;
        if (GATHER) {
            const unsigned t00 = tok_p[rb + R0], t01 = tok_p[rb + R1], t10 = tok_p[rb + HALF + R0], t11 = tok_p[rb + HALF + R1];
            u.a00 = (t00 * lda + C0) * 2u; u.a01 = (t01 * lda + C1) * 2u; u.a10 = (t10 * lda + C0) * 2u; u.a11 = (t11 * lda + C1) * 2u;
        } else {
            u.a00 = ((unsigned)(rb + R0) * lda + C0) * 2u; u.a01 = ((unsigned)(rb + R1) * lda + C1) * 2u;
            u.a10 = ((unsigned)(rb + HALF + R0) * lda + C0) * 2u; u.a11 = ((unsigned)(rb + HALF + R1) * lda + C1) * 2u;
        }
        return true;
    }
};

struct EpiProj {
    static constexpr bool PERM = true; bf16_t* O;
    __device__ __forceinline__ bool keep(const Unit&) const { return false; }
    __device__ __forceinline__ void operator()(f32x4 (&acc)[2][2][4][2], const Unit& u, int wr, int wc, int fr, int fq) const {
        const int row0 = u.pm * BM + wr * 64 + fr, col0 = u.pn * BM + wc * 32 + 8 * fq;
#pragma unroll
        for (int ai = 0; ai < 2; ++ai)
#pragma unroll
            for (int m = 0; m < 4; ++m) { bf16_t* rowp = O + (size_t)(row0 + ai * HALF + m * 16) * PW + col0;
#pragma unroll
                for (int bj = 0; bj < 2; ++bj) { const f32x4 v0 = acc[ai][bj][m][0], v1 = acc[ai][bj][m][1]; u32x4 w;
                    w.x = cvt_pk_bf16(v0[0], v0[1]); w.y = cvt_pk_bf16(v0[2], v0[3]); w.z = cvt_pk_bf16(v1[0], v1[1]); w.w = cvt_pk_bf16(v1[2], v1[3]);
                    *(u32x4*)(rowp + bj * HALF) = w; } }
    }
};
struct EpiMerge {
    static constexpr bool PERM = true; const bf16_t* proj; bf16_t* O;
    __device__ __forceinline__ bool keep(const Unit& u) const { return u.aux == 0; }
    __device__ __forceinline__ void operator()(f32x4 (&acc)[2][2][4][2], const Unit& u, int wr, int wc, int fr, int fq) const {
        const int row0 = u.pm * BM + wr * 64 + fr, col0 = u.pn * BM + wc * 32 + 8 * fq;
#pragma unroll
        for (int ai = 0; ai < 2; ++ai)
#pragma unroll
            for (int m = 0; m < 4; ++m) { const size_t r = (size_t)(row0 + ai * HALF + m * 16);
#pragma unroll
                for (int bj = 0; bj < 2; ++bj) {
                    const u32x4 gb = *(const u32x4*)(proj + r * PW + C_MGB + col0 + bj * HALF);
                    const f32x4 eb0 = {__expf(-bflo(gb.x)), __expf(-bfhi(gb.x)), __expf(-bflo(gb.y)), __expf(-bfhi(gb.y))};
                    const f32x4 eb1 = {__expf(-bflo(gb.z)), __expf(-bfhi(gb.z)), __expf(-bflo(gb.w)), __expf(-bfhi(gb.w))};
                    if (u.aux == 0) {
                        const u32x4 ga = *(const u32x4*)(proj + r * PW + C_MGA + col0 + bj * HALF);
                        const f32x4 ea0 = {__expf(-bflo(ga.x)), __expf(-bfhi(ga.x)), __expf(-bflo(ga.y)), __expf(-bfhi(ga.y))};
                        const f32x4 ea1 = {__expf(-bflo(ga.z)), __expf(-bfhi(ga.z)), __expf(-bflo(ga.w)), __expf(-bfhi(ga.w))};
                        acc[ai][bj][m][0] = acc[ai][bj][m][0] * (1.f + eb0) / (1.f + ea0); acc[ai][bj][m][1] = acc[ai][bj][m][1] * (1.f + eb1) / (1.f + ea1);
                    } else {
                        const f32x4 v0 = acc[ai][bj][m][0] / (1.f + eb0), v1 = acc[ai][bj][m][1] / (1.f + eb1);
                        u32x4 w; w.x = cvt_pk_bf16(v0[0], v0[1]); w.y = cvt_pk_bf16(v0[2], v0[3]); w.z = cvt_pk_bf16(v1[0], v1[1]); w.w = cvt_pk_bf16(v1[2], v1[3]);
                        *(u32x4*)(O + r * D + col0 + bj * HALF) = w;
                    } } }
    }
};
struct EpiResid {
    static constexpr bool PERM = false; const float* x; const float* gt; float* O;
    __device__ __forceinline__ bool keep(const Unit&) const { return false; }
    __device__ __forceinline__ void operator()(f32x4 (&acc)[2][2][4][2], const Unit& u, int wr, int wc, int fr, int fq) const {
        const int row0 = u.pm * BM + wr * 64 + fr, col0 = u.pn * BM + wc * 32 + 4 * fq;
        f32x4 g[2][2];
#pragma unroll
        for (int bj = 0; bj < 2; ++bj)
#pragma unroll
            for (int n = 0; n < 2; ++n) g[bj][n] = *(const f32x4*)(gt + col0 + bj * HALF + n * 16);
#pragma unroll
        for (int ai = 0; ai < 2; ++ai)
#pragma unroll
            for (int m = 0; m < 4; ++m) { const size_t ro = (size_t)(row0 + ai * HALF + m * 16) * D + col0;
#pragma unroll
                for (int bj = 0; bj < 2; ++bj)
#pragma unroll
                    for (int n = 0; n < 2; ++n) { const f32x4 xv = *(const f32x4*)(x + ro + bj * HALF + n * 16); *(f32x4*)(O + ro + bj * HALF + n * 16) = xv + g[bj][n] * acc[ai][bj][m][n]; } }
    }
};
struct EpiSwiglu {
    static constexpr bool PERM = true; bf16_t* hid;
    __device__ __forceinline__ bool keep(const Unit&) const { return false; }
    __device__ __forceinline__ void operator()(f32x4 (&acc)[2][2][4][2], const Unit& u, int wr, int wc, int fr, int fq) const {
        const int row0 = u.pm + wr * 64 + fr, j0 = u.pn * 128 + wc * 16 + 4 * fq;
#pragma unroll
        for (int ai = 0; ai < 2; ++ai)
#pragma unroll
            for (int m = 0; m < 4; ++m) { bf16_t* rowp = hid + (size_t)(row0 + ai * HALF + m * 16) * FF + j0;
#pragma unroll
                for (int bj = 0; bj < 2; ++bj) { const f32x4 g = acc[ai][bj][m][0], up = acc[ai][bj][m][1]; u32x2 w;
                    w.x = cvt_pk_bf16(siluf_(g[0]) * up[0], siluf_(g[1]) * up[1]); w.y = cvt_pk_bf16(siluf_(g[2]) * up[2], siluf_(g[3]) * up[3]);
                    *(u32x2*)(rowp + bj * 64) = w; } }
    }
};
struct EpiDown {
    static constexpr bool PERM = true; bf16_t* Y; const float* w_p;
    __device__ __forceinline__ bool keep(const Unit&) const { return false; }
    __device__ __forceinline__ void operator()(f32x4 (&acc)[2][2][4][2], const Unit& u, int wr, int wc, int fr, int fq) const {
        const int row0 = u.pm + wr * 64 + fr, col0 = u.pn * BM + wc * 32 + 8 * fq;
#pragma unroll
        for (int ai = 0; ai < 2; ++ai)
#pragma unroll
            for (int m = 0; m < 4; ++m) { const int r = row0 + ai * HALF + m * 16; const float wt = w_p[r]; bf16_t* rowp = Y + (size_t)r * D + col0;
#pragma unroll
                for (int bj = 0; bj < 2; ++bj) { const f32x4 v0 = acc[ai][bj][m][0] * wt, v1 = acc[ai][bj][m][1] * wt; u32x4 w;
                    w.x = cvt_pk_bf16(v0[0], v0[1]); w.y = cvt_pk_bf16(v0[2], v0[3]); w.z = cvt_pk_bf16(v1[0], v1[1]); w.w = cvt_pk_bf16(v1[2], v1[3]);
                    *(u32x4*)(rowp + bj * HALF) = w; } }
    }
};
}

struct Ctx {
    const float *x, *c, *w_ada, *b_ada, *norm1_g, *norm2_g, *w_in, *lb_table, *hgrn_onorm_g, *conv_w, *a_log, *dt_bias, *gdn_onorm_g, *w_bh, *w_bg, *w_out, *w_router, *router_bias,
        *w_eg, *w_eu, *w_ed, *w_sg, *w_su, *w_sd, *normf_g;
    float* out;
    unsigned* bar;
    float *modp, *mod, *lb, *gab;
    int *idx, *cnt, *tok_p, *pos, *blk_row, *blk_exp, *nent;
    float *wts, *w_p;
    bf16_t *win_t, *wa_t, *wb_t, *wout_t, *h1, *proj, *ocat, *merged;
    float *gq, *gk, *gv, *gbeta, *gdec, *oa, *ob;
    bf16_t *dn_t, *hid, *gu_t, *h2, *Y; float* h2f;
};

typedef const __attribute__((address_space(4))) Ctx CtxK;

__device__ __forceinline__ void cvt_tile(LAS float* t, const float* srcA, const float* srcB, int ld, int mode, bf16_t* dst, int ldd) {
    const int tid = ltid(), kr = tid >> 6, cl = tid & 63;
    const float* sp = (mode == 1 && cl >= 32) ? (srcB + cl - 32) : (srcA + cl);
    float v[8];
#pragma unroll
    for (int p = 0; p < 8; ++p) v[p] = sp[(size_t)(p * 8 + kr) * ld];
    __syncthreads();
#pragma unroll
    for (int p = 0; p < 8; ++p) t[(p * 8 + kr) * 65 + cl] = v[p];
    __syncthreads();
    const int r = tid >> 3, seg = (tid & 7) * 8;
    const int lc = mode == 1 ? (((r >> 2) & 1) * 32 + 4 * (r >> 3) + (r & 3)) : r;
    float w[8];
#pragma unroll
    for (int j = 0; j < 8; ++j) w[j] = t[(seg + j) * 65 + lc];
    u32x4 o; o.x = cvt_pk_bf16(w[0], w[1]); o.y = cvt_pk_bf16(w[2], w[3]); o.z = cvt_pk_bf16(w[4], w[5]); o.w = cvt_pk_bf16(w[6], w[7]);
    *(u32x4*)(dst + (size_t)r * ldd + seg) = o;
}
__device__ __forceinline__ void cvt_job(LAS float* t, int tile, const float* src, int ld, int K, bf16_t* dst) {
    const int nkt = K / 64, nt = tile / nkt, kt = tile % nkt;
    cvt_tile(t, src + (size_t)kt * 64 * ld + nt * 64, nullptr, ld, 0, dst + (size_t)nt * 64 * K + kt * 64, K);
}

__device__ void ph_pro1(CtxK& c, LAS unsigned char* lds) {
    const int tid = ltid(), wg = blockIdx.x, G = gridDim.x;
    LAS float* lf = (LAS float*)lds;
    for (int job = wg; job < 192; job += G) {
        const int cc = job % 48, kp = job / 48, q = tid & 63, rg = tid >> 6;
        f32x4 a = {0.f, 0.f, 0.f, 0.f};
        for (int r = rg; r < 512; r += 8) { const int k = kp * 512 + r; const float s = siluf_(c.c[k]); a += s * *(const f32x4*)(c.w_ada + (size_t)k * (6 * D) + cc * 256 + q * 4); }
        __syncthreads();
        *(LAS f32x4*)(lf + (rg * 64 + q) * 4) = a;
        __syncthreads();
        if (tid < 64) { f32x4 s = {0.f, 0.f, 0.f, 0.f};
#pragma unroll
            for (int g = 0; g < 8; ++g) s += *(LAS f32x4*)(lf + (g * 64 + tid) * 4);
            *(f32x4*)(c.modp + (size_t)kp * (6 * D) + cc * 256 + tid * 4) = s; }
    }
    if (wg == G - 1) for (int j = tid; j < 1024; j += 512) c.lb[j] = 1.f / (1.f + expf(c.lb_table[1024 + j] - c.lb_table[j]));
    for (int T = wg; T < 8192; T += G) {
        if (T < 6144) { const int nt = T / 32, kt = T % 32; const int sc = nt * 64 + (nt * 64 >= WIN_GAB ? 16 : 0);
            cvt_tile(lf, c.w_in + (size_t)kt * 64 * INW + sc, nullptr, INW, 0, c.win_t + (size_t)nt * 64 * D + kt * 64, D); }
        else if (T < 6656) cvt_job(lf, T - 6144, c.w_bh, D, 1024, c.wa_t);
        else if (T < 7168) cvt_job(lf, T - 6656, c.w_bg, D, 1024, c.wb_t);
        else cvt_job(lf, T - 7168, c.w_out, D, 2048, c.wout_t);
    }
}
__device__ void ph_norm1(CtxK& c, LAS unsigned char* lds) {
    const int tid = ltid(), wg = blockIdx.x, G = gridDim.x, lane = tid & 63, wv = tid >> 6;
    LAS float* la = (LAS float*)lds;
    LAS float* lb_ = la + D;
    LAS float* lw = lb_ + D;
    for (int j = tid; j < D; j += 512) {
        float sh = c.b_ada[j], sc = c.b_ada[D + j];
#pragma unroll
        for (int p = 0; p < 4; ++p) { sh += c.modp[(size_t)p * 6 * D + j]; sc += c.modp[(size_t)p * 6 * D + D + j]; }
        la[j] = c.norm1_g[j] * (1.f + sc); lb_[j] = sh;
    }
    for (int j = wg * 512 + tid; j < 6 * D; j += G * 512) { float m = c.b_ada[j];
#pragma unroll
        for (int p = 0; p < 4; ++p) m += c.modp[(size_t)p * 6 * D + j];
        c.mod[j] = m; }
    for (int i = tid; i < D * 4; i += 512) { const int e = i >> 2, q = i & 3; const f32x4 w = *(const f32x4*)(c.w_in + (size_t)e * INW + WIN_GAB + q * 4);
        lw[(q * 4 + 0) * D + e] = w[0]; lw[(q * 4 + 1) * D + e] = w[1]; lw[(q * 4 + 2) * D + e] = w[2]; lw[(q * 4 + 3) * D + e] = w[3]; }
    __syncthreads();
    for (int row = wg * 8 + wv; row < S; row += G * 8) {
        const float* xr = c.x + (size_t)row * D; f32x4 v[8]; float ss = 0.f;
#pragma unroll
        for (int i = 0; i < 8; ++i) { v[i] = *(const f32x4*)(xr + i * 256 + lane * 4); ss += v[i][0] * v[i][0] + v[i][1] * v[i][1] + v[i][2] * v[i][2] + v[i][3] * v[i][3]; }
        ss = wave_sum(ss); const float r = rsqrtf(ss * (1.f / D) + 1e-6f);
#pragma unroll
        for (int i = 0; i < 8; ++i) { const int e = i * 256 + lane * 4; const f32x4 a = *(LAS f32x4*)(la + e), b = *(LAS f32x4*)(lb_ + e); v[i] = v[i] * r * a + b;
            u32x2 w; w.x = cvt_pk_bf16(v[i][0], v[i][1]); w.y = cvt_pk_bf16(v[i][2], v[i][3]); *(u32x2*)(c.h1 + (size_t)row * D + e) = w; }
        float mine = 0.f;
        for (int cc = 0; cc < 16; ++cc) { float d = 0.f;
#pragma unroll
            for (int i = 0; i < 8; ++i) { const f32x4 w = *(LAS f32x4*)(lw + cc * D + i * 256 + lane * 4); d += v[i][0] * w[0] + v[i][1] * w[1] + v[i][2] * w[2] + v[i][3] * w[3]; }
            d = wave_sum(d); if (lane == cc) mine = d; }
        if (lane < 16) c.gab[(size_t)row * 16 + lane] = mine;
    }
}
__device__ void ph_gemm1(CtxK& c, LAS unsigned char* lds) {
    gm::DenseSched Sd; Sd.init(S, PW, D, D, c.win_t, nullptr, 1); gm::EpiProj E{c.proj};
    gm::gphase(lds, (const char*)c.h1, D, Sd, E);
}
__device__ void ph_gemm2(CtxK& c, LAS unsigned char* lds) {
    gm::DenseSched Sd; Sd.init(S, D, 1024, 2048, c.wa_t, c.wb_t, 2); gm::EpiMerge E{c.proj, c.merged};
    gm::gphase(lds, (const char*)c.ocat, 1024, Sd, E);
}
__device__ void ph_gemm3(CtxK& c, LAS unsigned char* lds) {
    gm::DenseSched Sd; Sd.init(S, D, D, D, c.wout_t, nullptr, 1); gm::EpiResid E{c.x, c.mod + 2 * D, c.out};
    gm::gphase(lds, (const char*)c.merged, D, Sd, E);
}
__device__ void ph_moe_gu(CtxK& c, LAS unsigned char* lds) {
    gm::MoeSched<true> Sm; Sm.init(4, D, D, c.nent, c.blk_row, c.blk_exp, c.tok_p, c.gu_t, (size_t)1024 * D * 2); gm::EpiSwiglu E{c.hid};
    gm::gphase(lds, (const char*)c.h2, D, Sm, E);
}
__device__ void ph_moe_dn(CtxK& c, LAS unsigned char* lds) {
    gm::MoeSched<false> Sm; Sm.init(8, FF, FF, c.nent, c.blk_row, c.blk_exp, c.tok_p, c.dn_t, (size_t)D * FF * 2); gm::EpiDown E{c.Y, c.w_p};
    gm::gphase(lds, (const char*)c.hid, FF, Sm, E);
}
__device__ void ph_norm2(CtxK& c, LAS unsigned char* lds) {
    const int tid = ltid(), wg = blockIdx.x, G = gridDim.x, lane = tid & 63, wv = tid >> 6;
    LAS float* la = (LAS float*)lds; LAS float* lb_ = la + D;
    for (int j = tid; j < D; j += 512) { la[j] = c.norm2_g[j] * (1.f + c.mod[4 * D + j]); lb_[j] = c.mod[3 * D + j]; }
    __syncthreads();
    for (int row = wg * 8 + wv; row < S; row += G * 8) {
        const float* xr = c.out + (size_t)row * D; f32x4 v[8]; float ss = 0.f;
#pragma unroll
        for (int i = 0; i < 8; ++i) { v[i] = *(const f32x4*)(xr + i * 256 + lane * 4); ss += v[i][0] * v[i][0] + v[i][1] * v[i][1] + v[i][2] * v[i][2] + v[i][3] * v[i][3]; }
        ss = wave_sum(ss); const float r = rsqrtf(ss * (1.f / D) + 1e-6f);
#pragma unroll
        for (int i = 0; i < 8; ++i) { const int e = i * 256 + lane * 4; const f32x4 a = *(LAS f32x4*)(la + e), b = *(LAS f32x4*)(lb_ + e); v[i] = v[i] * r * a + b;
            u32x2 w; w.x = cvt_pk_bf16(v[i][0], v[i][1]); w.y = cvt_pk_bf16(v[i][2], v[i][3]); *(u32x2*)(c.h2 + (size_t)row * D + e) = w;
            *(f32x4*)(c.h2f + (size_t)row * D + e) = v[i]; }
    }
}
__device__ void ph_cvt_exp(CtxK& c, LAS unsigned char* lds) {
    LAS float* lf = (LAS float*)lds; const int wg = blockIdx.x, G = gridDim.x;
    constexpr int GU_T = 16 * 32, DN_T = 32 * 8;
    for (int T = wg; T < NEX * (GU_T + DN_T); T += G) {
        if (T < NEX * GU_T) { const int e = T / GU_T, r = T % GU_T, nt = r / 32, kt = r % 32;
            const float* sg = e < NE ? c.w_eg + (size_t)e * D * FF : c.w_sg; const float* su = e < NE ? c.w_eu + (size_t)e * D * FF : c.w_su;
            cvt_tile(lf, sg + (size_t)kt * 64 * FF + nt * 32, su + (size_t)kt * 64 * FF + nt * 32, FF, 1, c.gu_t + ((size_t)e * 1024 + nt * 64) * D + kt * 64, D); }
        else { const int T2 = T - NEX * GU_T, e = T2 / DN_T, r = T2 % DN_T; const float* sd = e < NE ? c.w_ed + (size_t)e * FF * D : c.w_sd;
            cvt_job(lf, r, sd, D, FF, c.dn_t + (size_t)e * D * FF); }
    }
}
__device__ void ph_final(CtxK& c, LAS unsigned char* lds) {
    const int tid = ltid(), wg = blockIdx.x, G = gridDim.x, lane = tid & 63, wv = tid >> 6;
    const float* gt2 = c.mod + 5 * D;
    for (int row = wg * 8 + wv; row < S; row += G * 8) {
        int p[9];
#pragma unroll
        for (int k = 0; k < 8; ++k) p[k] = c.pos[row * TOPK + k];
        p[8] = PROUTED + row;
        f32x4 v[8]; float ss = 0.f;
#pragma unroll
        for (int i = 0; i < 8; ++i) {
            const int e = i * 256 + lane * 4; f32x4 a = {0.f, 0.f, 0.f, 0.f};
#pragma unroll
            for (int k = 0; k < 9; ++k) { const u32x2 y = *(const u32x2*)(c.Y + (size_t)p[k] * D + e); a[0] += bflo(y.x); a[1] += bfhi(y.x); a[2] += bflo(y.y); a[3] += bfhi(y.y); }
            const f32x4 xv = *(const f32x4*)(c.out + (size_t)row * D + e), g = *(const f32x4*)(gt2 + e);
            v[i] = xv + g * a; ss += v[i][0] * v[i][0] + v[i][1] * v[i][1] + v[i][2] * v[i][2] + v[i][3] * v[i][3];
        }
        ss = wave_sum(ss); const float r = rsqrtf(ss * (1.f / D) + 1e-6f);
#pragma unroll
        for (int i = 0; i < 8; ++i) { const int e = i * 256 + lane * 4; *(f32x4*)(c.out + (size_t)row * D + e) = v[i] * r * *(const f32x4*)(c.normf_g + e); }
    }
}

__device__ __forceinline__ float pair_sum128(float v, LAS float* red) {
    v = wave_sum(v); const int w = ltid() >> 6;
    __syncthreads(); if ((ltid() & 63) == 0) red[w] = v; __syncthreads();
    return red[w & ~1] + red[w | 1];
}
__device__ void ph_gdn_pre(CtxK& c, LAS unsigned char* lds) {
    LAS float* red = (LAS float*)lds;
    const int tid = ltid() & 255, g = ltid() >> 8;
    for (int t = blockIdx.x * 2 + g; t < S; t += gridDim.x * 2) {
        for (int grp = 0; grp < 12; ++grp) {
            const int ch = grp * 256 + tid; float acc = 0.f;
#pragma unroll
            for (int j = 0; j < 4; ++j) { const int tt = t - 3 + j; if (tt >= 0) acc += c.conv_w[j * 3072 + ch] * bf2f(c.proj[(size_t)tt * PW + C_GQKV + ch]); }
            const float val = siluf_(acc);
            if (grp < 8) {
                const float ss = pair_sum128(val * val, red); const float n = val * rsqrtf(ss + 1e-6f);
                if (grp < 4) c.gq[(size_t)t * 1024 + ch] = n * 0.08838834764831845f; else c.gk[(size_t)t * 1024 + ch - 1024] = n;
            } else c.gv[(size_t)t * 1024 + ch - 2048] = val;
        }
        if (tid < 8) {
            const float ga = c.gab[(size_t)t * 16 + tid], gb = c.gab[(size_t)t * 16 + 8 + tid];
            c.gbeta[t * 8 + tid] = sigmoidf_(gb); c.gdec[t * 8 + tid] = expf(-expf(c.a_log[tid]) * softplusf_(ga + c.dt_bias[tid]));
        }
    }
}
__device__ void ph_mix_naive(CtxK& c, LAS unsigned char* lds) {
    constexpr int TB = 8;
    const int wg = blockIdx.x, t512 = ltid(), tid = t512 & 127; const bool ld = t512 < 128, act = t512 < 256;
    const int v = (t512 >> 1) & 127, d0 = (t512 & 1) * 64;
    if (wg >= 16) return;
    LAS float* sq = (LAS float*)lds; LAS float* sf = sq + TB * 128; LAS float* sk = sf + TB * 128; LAS float* sv = sk + TB * 128; LAS float* sb = sv + TB * 128; LAS float* sa = sb + TB;
    float st[64];
#pragma unroll
    for (int d = 0; d < 64; ++d) st[d] = 0.f;
    if (wg < 8) {
        const int h = wg; const float lbv = c.lb[h * 128 + tid];
        for (int t0 = 0; t0 < S; t0 += TB) {
            if (ld) for (int tt = 0; tt < TB; ++tt) {
                const bf16_t* base = c.proj + (size_t)(t0 + tt) * PW + h * 128 + tid;
                const float f = lbv + (1.f - lbv) * sigmoidf_(bf2f(base[C_HF]));
                sq[tt * 128 + tid] = siluf_(bf2f(base[C_HQ])) * 0.08838834764831845f; sf[tt * 128 + tid] = f; sk[tt * 128 + tid] = 1.f - f; sv[tt * 128 + tid] = bf2f(base[C_HI]);
            }
            __syncthreads();
            if (act) {
#pragma unroll 1
            for (int tt = 0; tt < TB; ++tt) {
                float o = 0.f; const float vv = sv[tt * 128 + v];
#pragma unroll
                for (int d = 0; d < 64; d += 4) {
                    const f32x4 q4 = *(LAS f32x4*)(sq + tt * 128 + d0 + d), f4 = *(LAS f32x4*)(sf + tt * 128 + d0 + d), k4 = *(LAS f32x4*)(sk + tt * 128 + d0 + d);
                    st[d] = f4[0] * st[d] + k4[0] * vv; o += q4[0] * st[d];
                    st[d + 1] = f4[1] * st[d + 1] + k4[1] * vv; o += q4[1] * st[d + 1];
                    st[d + 2] = f4[2] * st[d + 2] + k4[2] * vv; o += q4[2] * st[d + 2];
                    st[d + 3] = f4[3] * st[d + 3] + k4[3] * vv; o += q4[3] * st[d + 3];
                }
                o += __shfl_xor(o, 1);
                if (d0 == 0) c.oa[(size_t)(t0 + tt) * 1024 + h * 128 + v] = o;
            } }
            __syncthreads();
        }
    } else {
        const int h = wg - 8;
        for (int t0 = 0; t0 < S; t0 += TB) {
            if (ld) { for (int tt = 0; tt < TB; ++tt) {
                const size_t o = (size_t)(t0 + tt) * 1024 + h * 128 + tid;
                sq[tt * 128 + tid] = c.gq[o]; sk[tt * 128 + tid] = c.gk[o]; sv[tt * 128 + tid] = c.gv[o];
            }
            if (tid < TB) { sb[tid] = c.gbeta[(t0 + tid) * 8 + h]; sa[tid] = c.gdec[(t0 + tid) * 8 + h]; } }
            __syncthreads();
            if (act) {
#pragma unroll 1
            for (int tt = 0; tt < TB; ++tt) {
                const float a = sa[tt], be = sb[tt]; float kd = 0.f;
#pragma unroll
                for (int d = 0; d < 64; d += 4) { const f32x4 k4 = *(LAS f32x4*)(sk + tt * 128 + d0 + d); kd += k4[0] * st[d] + k4[1] * st[d + 1] + k4[2] * st[d + 2] + k4[3] * st[d + 3]; }
                kd += __shfl_xor(kd, 1);
                const float c1 = be * (sv[tt * 128 + v] - a * kd); float o = 0.f;
#pragma unroll
                for (int d = 0; d < 64; d += 4) {
                    const f32x4 k4 = *(LAS f32x4*)(sk + tt * 128 + d0 + d), q4 = *(LAS f32x4*)(sq + tt * 128 + d0 + d);
                    st[d] = a * st[d] + c1 * k4[0]; o += q4[0] * st[d];
                    st[d + 1] = a * st[d + 1] + c1 * k4[1]; o += q4[1] * st[d + 1];
                    st[d + 2] = a * st[d + 2] + c1 * k4[2]; o += q4[2] * st[d + 2];
                    st[d + 3] = a * st[d + 3] + c1 * k4[3]; o += q4[3] * st[d + 3];
                }
                o += __shfl_xor(o, 1);
                if (d0 == 0) c.ob[(size_t)(t0 + tt) * 1024 + h * 128 + v] = o;
            } }
            __syncthreads();
        }
    }
}
__device__ void ph_onorm(CtxK& c, LAS unsigned char* lds) {
    LAS float* red = (LAS float*)lds;
    const int tid = ltid() & 255, g = ltid() >> 8;
    for (int t = blockIdx.x * 2 + g; t < S; t += gridDim.x * 2) {
        for (int i = 0; i < 8; ++i) {
            const int br = i >> 2, ch = (i & 3) * 256 + tid; const float v = (br ? c.ob : c.oa)[(size_t)t * 1024 + ch];
            const float ss = pair_sum128(v * v, red);
            const float o = v * rsqrtf(ss * (1.f / 128.f) + 1e-6f) * (br ? c.gdn_onorm_g : c.hgrn_onorm_g)[ch & 127] * siluf_(bf2f(c.proj[(size_t)t * PW + (br ? C_GG : C_HG) + ch]));
            const unsigned pk = cvt_pk_bf16(o, o); c.ocat[(size_t)t * D + br * 1024 + ch] = (bf16_t)(pk & 0xffffu);
        }
    }
}
__device__ void ph_router(CtxK& c, LAS unsigned char* lds) {
    const int lane = ltid() & 63, wv = ltid() >> 6;
    const float rb = c.router_bias[lane];
    for (int t = blockIdx.x * 8 + wv; t < S; t += gridDim.x * 8) {
        const float* hr = c.h2f + (size_t)t * D; float acc = 0.f;
        for (int i = 0; i < D; ++i) acc += hr[i] * c.w_router[i * 64 + lane];
        const float s = sigmoidf_(acc), b = s + rb;
        int rk = 0;
#pragma unroll
        for (int x = 1; x < 8; ++x) { const float ob = __shfl_xor(b, x); const int ol = lane ^ x; rk += (ob > b || (ob == b && ol < lane)) ? 1 : 0; }
        float gs = rk < 2 ? b : 0.f; gs += __shfl_xor(gs, 1); gs += __shfl_xor(gs, 2); gs += __shfl_xor(gs, 4);
        int grk = 0;
#pragma unroll
        for (int x = 8; x < 64; x += 8) { const float og = __shfl_xor(gs, x); const int ol = lane ^ x; grk += (og > gs || (og == gs && ol < lane)) ? 1 : 0; }
        float mb = grk < 4 ? b : -INFINITY;
        float wsum = 0.f; int myk = -1;
        for (int k = 0; k < TOPK; ++k) {
            float m = mb;
#pragma unroll
            for (int o = 32; o >= 1; o >>= 1) m = fmaxf(m, __shfl_xor(m, o));
            const unsigned long long bal = __ballot(mb == m); const int win = __ffsll((long long)bal) - 1;
            const float sw = __shfl(s, win); wsum += sw;
            if (lane == win) { mb = -INFINITY; myk = k; }
        }
        if (myk >= 0) { c.idx[t * TOPK + myk] = lane; c.wts[t * TOPK + myk] = s / wsum * 2.5f; }
    }
}
__device__ void ph_count(CtxK& c, LAS unsigned char* lds) {
    LAS int* red = (LAS int*)lds; const int e = blockIdx.x; if (e >= NE) return;
    int n = 0;
    for (int p = ltid(); p < TK; p += 512) n += (c.idx[p] == e) ? 1 : 0;
#pragma unroll
    for (int o = 32; o >= 1; o >>= 1) n += __shfl_xor(n, o);
    if ((ltid() & 63) == 0) red[ltid() >> 6] = n; __syncthreads();
    if (ltid() == 0) { int s_ = 0; for (int i = 0; i < 8; ++i) s_ += red[i]; c.cnt[e] = s_; }
}
__device__ void ph_scatter(CtxK& c, LAS unsigned char* lds) {
    LAS int* wsum = (LAS int*)lds; LAS int* base = wsum + 8;
    const int e = blockIdx.x, tid = ltid(), lane = tid & 63, w = tid >> 6; if (e >= NE) return;
    if (tid == 0) { int o = 0; for (int i = 0; i < e; ++i) o += (c.cnt[i] + 255) & ~255; *base = o; }
    __syncthreads();
    const int ps = *base, ce = c.cnt[e], pe = (ce + 255) & ~255;
    for (int r = ce + tid; r < pe; r += 512) { c.tok_p[ps + r] = 0; c.w_p[ps + r] = 0.f; }
    if (tid < 256) { const int t = e * 256 + tid; c.tok_p[PROUTED + t] = t; c.w_p[PROUTED + t] = 1.f; }
    if (e == 0 && tid == 0) {
        int nb = 0;
        for (int i = 0; i < NE; ++i) { const int nbi = (c.cnt[i] + 255) >> 8; for (int b = 0; b < nbi; ++b) { c.blk_row[nb] = nb * 256; c.blk_exp[nb] = i; ++nb; } }
        for (int b = 0; b < S / 256; ++b) { c.blk_row[nb + b] = PROUTED + b * 256; c.blk_exp[nb + b] = NE; }
        *c.nent = nb + S / 256;
    }
    int run = ps;
    for (int p0 = 0; p0 < TK; p0 += 512) {
        const int p = p0 + tid; const bool f = c.idx[p] == e;
        const unsigned long long bal = __ballot(f); const int pre = __popcll(bal & ((1ull << lane) - 1ull));
        __syncthreads();
        if (lane == 0) wsum[w] = __popcll(bal);
        __syncthreads();
        int wo = 0, tot = 0;
#pragma unroll
        for (int i = 0; i < 8; ++i) { const int x = wsum[i]; wo += i < w ? x : 0; tot += x; }
        if (f) { const int d = run + wo + pre; c.tok_p[d] = p / TOPK; c.w_p[d] = c.wts[p]; c.pos[p] = d; }
        run += tot;
    }
}

constexpr int LDS_MAIN = 147456, LDS_BYTES = LDS_MAIN + 16;
__global__ void __launch_bounds__(512, 2) k_mega(Ctx c) {
    extern __shared__ __attribute__((aligned(16))) unsigned char smem[];
    LAS unsigned char* lds = (LAS unsigned char*)smem;
    if (ltid() == 0) *(LAS u32x4*)(lds + LDS_MAIN) = (u32x4){0u, 0u, 0u, 0u};
    __syncthreads();
    CtxK* kp = (CtxK*)__builtin_amdgcn_kernarg_segment_ptr();
    (void)xcd_barrier_post(c.bar, (volatile LAS unsigned*)(lds + LDS_MAIN));
#define PHASE(fn) do { const CtxK* kp_ = kp; asm volatile("" : "+s"(kp_)); fn(*kp_, lds); } while (0)
#define GRID_BARRIER() do { const CtxK* kp_ = kp; asm volatile("" : "+s"(kp_)); XcdBarrier bb_; bb_.bar = kp_->bar; bb_.x = xb_xcc_id(); bb_.st = (volatile LAS unsigned*)(lds + LDS_MAIN); xcd_barrier(bb_); } while (0)
    PHASE(ph_pro1);      GRID_BARRIER();
    PHASE(ph_norm1);     GRID_BARRIER();
    PHASE(ph_gemm1);     GRID_BARRIER();
    PHASE(ph_gdn_pre);   GRID_BARRIER();
    PHASE(ph_mix_naive); GRID_BARRIER();
    PHASE(ph_onorm);     GRID_BARRIER();
    PHASE(ph_gemm2);     GRID_BARRIER();
    PHASE(ph_gemm3);     GRID_BARRIER();
    PHASE(ph_norm2);     GRID_BARRIER();
    PHASE(ph_router);    GRID_BARRIER();
    PHASE(ph_count);     GRID_BARRIER();
    PHASE(ph_scatter);   PHASE(ph_cvt_exp); GRID_BARRIER();
    PHASE(ph_moe_gu);    GRID_BARRIER();
    PHASE(ph_moe_dn);    GRID_BARRIER();
    PHASE(ph_final);
#undef PHASE
#undef GRID_BARRIER
}

extern "C" void kernel_launch(void* const* d_in, const int* in_sizes, int n_in, void* d_out, int out_size, void* d_ws, size_t ws_size, hipStream_t stream) {
    Ctx c{};
    const float** ip = (const float**)&c.x;
    for (int i = 0; i < 25; ++i) ip[i] = (const float*)d_in[i];
    c.out = (float*)d_out;
    char* ws = (char*)d_ws; constexpr size_t MB = 1024 * 1024;
    c.bar = (unsigned*)ws;
    c.modp = (float*)(ws + 64 * 1024); c.mod = (float*)(ws + 320 * 1024); c.lb = (float*)(ws + 384 * 1024);
    c.cnt = (int*)(ws + 392 * 1024); c.nent = (int*)(ws + 396 * 1024); c.blk_row = (int*)(ws + 400 * 1024); c.blk_exp = (int*)(ws + 404 * 1024);
    c.idx = (int*)(ws + 1 * MB); c.wts = (float*)(ws + 2 * MB); c.tok_p = (int*)(ws + 3 * MB); c.w_p = (float*)(ws + 4 * MB); c.pos = (int*)(ws + 5 * MB);
    c.gab = (float*)(ws + 6 * MB); c.gbeta = (float*)(ws + 7 * MB + 0); c.gdec = (float*)(ws + 7 * MB + 512 * 1024);
    char* big = ws + 16 * MB;
    size_t o = 0;
    auto take = [&](size_t bytes) { char* p = big + o; o += (bytes + 255) & ~(size_t)255; return p; };
    c.win_t = (bf16_t*)take((size_t)PW * D * 2); c.wa_t = (bf16_t*)take((size_t)D * 1024 * 2); c.wb_t = (bf16_t*)take((size_t)D * 1024 * 2); c.wout_t = (bf16_t*)take((size_t)D * D * 2);
    c.h1 = (bf16_t*)take((size_t)S * D * 2); c.proj = (bf16_t*)take((size_t)S * PW * 2);
    c.gq = (float*)take((size_t)S * 1024 * 4); c.gk = (float*)take((size_t)S * 1024 * 4); c.gv = (float*)take((size_t)S * 1024 * 4);
    c.oa = (float*)take((size_t)S * 1024 * 4); c.ob = (float*)take((size_t)S * 1024 * 4);
    c.ocat = (bf16_t*)take((size_t)S * D * 2); c.merged = (bf16_t*)take((size_t)S * D * 2);
    const size_t era1 = o;
    o = 0;
    c.dn_t = (bf16_t*)take((size_t)NEX * D * FF * 2); c.hid = (bf16_t*)take((size_t)PTOT * FF * 2);
    const size_t ybase = o;
    c.gu_t = (bf16_t*)take((size_t)NEX * 1024 * D * 2); c.h2 = (bf16_t*)take((size_t)S * D * 2);
    const size_t after_h2 = o;
    c.Y = (bf16_t*)(big + ybase);
    size_t yend = ybase + (size_t)PTOT * D * 2; if (yend < after_h2) yend = after_h2;
    o = (yend + 255) & ~(size_t)255;
    c.h2f = (float*)take((size_t)S * D * 4);
    const size_t era2 = o;
    const size_t need = 16 * MB + (era1 > era2 ? era1 : era2);
    if (ws_size < need) { fprintf(stderr, "kernel_launch: workspace too small: %zu < %zu\n", ws_size, need); return; }

    static int grid = 0;
    if (!grid) {
        int dev = 0, cus = 0, per_cu = 0;
        hipGetDevice(&dev); hipDeviceGetAttribute(&cus, hipDeviceAttributeMultiprocessorCount, dev);
        hipFuncSetAttribute((const void*)k_mega, hipFuncAttributeMaxDynamicSharedMemorySize, LDS_BYTES);
        hipOccupancyMaxActiveBlocksPerMultiprocessor(&per_cu, (const void*)k_mega, 512, LDS_BYTES);
        if (per_cu < 1) fprintf(stderr, "kernel_launch: occupancy query reports %d blocks per CU\n", per_cu);
        grid = cus;
    }
    hipMemsetAsync(c.bar, 0, XCD_BAR_WORDS * sizeof(unsigned), stream);
    hipLaunchKernelGGL(k_mega, dim3(grid), dim3(512), LDS_BYTES, stream, c);
}
```

```cpp
#include <hip/hip_runtime.h>
#include <stdint.h>
#include <stdio.h>

#define LAS __attribute__((address_space(3)))
typedef unsigned short bf16_t;
typedef short bf16x8 __attribute__((ext_vector_type(8)));
typedef float f32x4 __attribute__((ext_vector_type(4)));
typedef unsigned u32x4 __attribute__((ext_vector_type(4)));
typedef unsigned u32x2 __attribute__((ext_vector_type(2)));

constexpr int S = 16384, D = 2048, INW = 12304, PW = 12288, NE = 64, TOPK = 8, TK = S * TOPK, FF = 512;
constexpr int NEX = NE + 1;
constexpr int PROUTED = 147456, PTOT = PROUTED + S, NBLK_MAX = PROUTED / 256;
constexpr int C_HQ = 0, C_HF = 1024, C_HI = 2048, C_HG = 3072, C_GQKV = 4096, C_GG = 7168, C_MGA = 8192, C_MGB = 10240;
constexpr int WIN_GAB = 7168;

__device__ __forceinline__ float sigmoidf_(float x) { return 1.f / (1.f + __expf(-x)); }
__device__ __forceinline__ float siluf_(float x) { return x / (1.f + __expf(-x)); }
__device__ __forceinline__ float softplusf_(float x) { return x > 20.f ? x : log1pf(expf(x)); }
__device__ __forceinline__ float bf2f(bf16_t b) { return __uint_as_float(((unsigned)b) << 16); }
__device__ __forceinline__ float bflo(unsigned w) { return __uint_as_float(w << 16); }
__device__ __forceinline__ float bfhi(unsigned w) { return __uint_as_float(w & 0xffff0000u); }
__device__ __forceinline__ unsigned cvt_pk_bf16(float lo, float hi) { unsigned r; asm volatile("v_cvt_pk_bf16_f32 %0, %1, %2" : "=v"(r) : "v"(lo), "v"(hi)); return r; }
__device__ __forceinline__ int ltid() { int t = threadIdx.x; asm volatile("" : "+v"(t)); return t; }
__device__ __forceinline__ float wave_sum(float v) {
#pragma unroll
    for (int o = 32; o >= 1; o >>= 1) v += __shfl_xor(v, o);
    return v;
}


#define XB_TMO      128
#define XB_XCNT(j)  (256  + 64 * (j))
#define XB_XSUB(j)  (1280 + 64 * (j))
#define XB_XGEN(j)  (2304 + 64 * (j))
#define XB_TOP      3328
#define XB_TOPGEN   3392
#define XCD_BAR_WORDS 3456
#define XB_SPIN_CAP (1u << 18)
__device__ __forceinline__ unsigned xb_ld(unsigned* p)              { return __hip_atomic_load(p, __ATOMIC_RELAXED, __HIP_MEMORY_SCOPE_AGENT); }
__device__ __forceinline__ unsigned xb_add(unsigned* p, unsigned v) { return __hip_atomic_fetch_add(p, v, __ATOMIC_RELAXED, __HIP_MEMORY_SCOPE_AGENT); }
__device__ __forceinline__ unsigned xb_xcc_id() { return (unsigned)__builtin_amdgcn_s_getreg((3 << 11) | 20) & 0xFu; }
#define XB_SPIN(cond, bar) do { unsigned _sp = 0; while (cond) { __builtin_amdgcn_s_sleep(1); \
    if ((++_sp & 255u) == 0u) { if (xb_ld(&(bar)[XB_TMO])) break; if (_sp > XB_SPIN_CAP) { atomicAdd(&(bar)[XB_TMO], 1u); break; } } } } while (0)
struct XcdBarrier { unsigned* bar; unsigned x; volatile LAS unsigned* st; };
__device__ __forceinline__ XcdBarrier xcd_barrier_post(unsigned* bar, volatile LAS unsigned* st) {
    XcdBarrier b; b.bar = bar; b.x = xb_xcc_id(); b.st = st;
    if (threadIdx.x == 0) (void)xb_add(&bar[XB_XCNT(b.x)], 1u);
    return b;
}
__device__ __forceinline__ void xcd_barrier_complete(unsigned* bar, unsigned x, unsigned& nloc, unsigned& nx) {
    const unsigned G = gridDim.x * gridDim.y * gridDim.z;
    unsigned sum, cnt, mine, sp = 0u;
    for (;;) {
        sum = 0u; cnt = 0u; mine = 0u;
#pragma unroll
        for (unsigned j = 0; j < 16; ++j) { const unsigned c = xb_ld(&bar[XB_XCNT(j)]); sum += c; cnt += (c > 0u) ? 1u : 0u; mine = (j == x) ? c : mine; }
        if (sum == G) break;
        __builtin_amdgcn_s_sleep(1);
        if ((++sp & 255u) == 0u) { if (xb_ld(&bar[XB_TMO])) break; if (sp > XB_SPIN_CAP) { atomicAdd(&bar[XB_TMO], 1u); break; } }
    }
    nloc = mine > 0u ? mine : 1u; nx = cnt > 0u ? cnt : 1u;
}
__device__ __forceinline__ void xcd_barrier(const XcdBarrier& b) {
    asm volatile("s_waitcnt vmcnt(0)" ::: "memory");
    __syncthreads();
    if (threadIdx.x == 0) {
        unsigned* bar = b.bar;
        __builtin_amdgcn_s_waitcnt(0);
        unsigned nloc = b.st[0], nx = b.st[1];
        if (nloc == 0u) { xcd_barrier_complete(bar, b.x, nloc, nx); b.st[0] = nloc; b.st[1] = nx; }
        const unsigned old = xb_add(&bar[XB_XSUB(b.x)], 1u);
        const unsigned gen = old / nloc;
        if (old + 1u == (gen + 1u) * nloc) {
            __builtin_amdgcn_fence(__ATOMIC_RELEASE, "agent");
            asm volatile("s_waitcnt vmcnt(0)" ::: "memory");
            const unsigned og = xb_add(&bar[XB_TOP], 1u);
            const unsigned tg = og / nx;
            if (og + 1u == (tg + 1u) * nx) xb_add(&bar[XB_TOPGEN], 1u);
            else XB_SPIN(xb_ld(&bar[XB_TOPGEN]) == tg, bar);
            __builtin_amdgcn_fence(__ATOMIC_ACQUIRE, "agent");
            xb_add(&bar[XB_XGEN(b.x)], 1u);
            asm volatile("s_waitcnt vmcnt(0)" ::: "memory");
        } else {
            XB_SPIN(xb_ld(&bar[XB_XGEN(b.x)]) == gen, bar);
            __builtin_amdgcn_fence(__ATOMIC_ACQUIRE, "agent");
            asm volatile("s_waitcnt vmcnt(0)" ::: "memory");
        }
    }
    __syncthreads();
}

namespace gm {
constexpr int BM = 256, BK = 64, HALF = 128, HTB = HALF * BK * 2, STAGE_BYTES = 8 * HTB;
__host__ __device__ __forceinline__ int lds_byte(int r, int c) { const int st = (r >> 4) * 2 + (c >> 5), rr = r & 15, cc = c & 31, ob = rr * 64 + cc * 2; return st * 1024 + (ob ^ (((ob >> 9) & 1) << 5)); }
__host__ __device__ __forceinline__ void stage_rc(int b, int& R, int& C) { const int st = b / 1024, sb = b % 1024, swz = sb ^ (((sb >> 9) & 1) << 5); R = (st >> 1) * 16 + swz / 64; C = (st & 1) * 32 + (swz % 64) / 2; }
__host__ __device__ __forceinline__ int perm32(int rho) { const int n = rho >> 4, i = rho & 15; return 8 * (i >> 2) + 4 * n + (i & 3); }

struct Unit { int pm, pn, aux; const char* Bp; unsigned a00, a01, a10, a11; };

template <class Epi, class Sched>
__device__ __forceinline__ void gphase(LAS unsigned char* lds, const char* Abase, const int K, Sched& S, Epi& E) {
    const int tid = ltid(), wid = __builtin_amdgcn_readfirstlane(tid >> 6), lane = tid & 63, wr = wid >> 2, wc = wid & 3, fr = lane & 15, fq = lane >> 4;
    const int nt = K / BK;
    unsigned voffB[2];
#pragma unroll
    for (int i = 0; i < 2; ++i) { int R, C; stage_rc(tid * 16 + i * 8192, R, C); const int Rb = Epi::PERM ? ((R & ~31) + perm32(R & 31)) : R; voffB[i] = (unsigned)(Rb * K + C) * 2u; }
    const size_t hstepB = (size_t)HALF * K * 2;
    const unsigned ldsw = (unsigned)wid * 1024u;
    const int aoff = lds_byte(wr * 64 + fr, fq * 8), boff = lds_byte(wc * 32 + fr, fq * 8);
#define G_SA(b, h) (((b) * 2 + (h)) * HTB)
#define G_SB(b, h) ((4 + (b) * 2 + (h)) * HTB)
#define G_STAGE_A(bufoff, o0, o1, kb) do { \
        __builtin_amdgcn_global_load_lds((const unsigned*)(Abase + (o0) + (kb)), (LAS unsigned*)(lds + (bufoff) + ldsw), 16, 0, 0); \
        __builtin_amdgcn_global_load_lds((const unsigned*)(Abase + (o1) + (kb)), (LAS unsigned*)(lds + (bufoff) + ldsw + 8192), 16, 0, 0); } while (0)
#define G_STAGE_B(bufoff, bp, kb) do { \
        __builtin_amdgcn_global_load_lds((const unsigned*)((bp) + voffB[0] + (kb)), (LAS unsigned*)(lds + (bufoff) + ldsw), 16, 0, 0); \
        __builtin_amdgcn_global_load_lds((const unsigned*)((bp) + voffB[1] + (kb)), (LAS unsigned*)(lds + (bufoff) + ldsw + 8192), 16, 0, 0); } while (0)
#define G_LDA(dst, b, h) do { _Pragma("unroll") for (int m = 0; m < 4; ++m) _Pragma("unroll") for (int k = 0; k < 2; ++k) dst[m][k] = *(const LAS bf16x8*)(lds + G_SA(b, h) + aoff + m * 2048 + k * 1024); } while (0)
#define G_LDB(dst, b, h) do { _Pragma("unroll") for (int n = 0; n < 2; ++n) _Pragma("unroll") for (int k = 0; k < 2; ++k) dst[n][k] = *(const LAS bf16x8*)(lds + G_SB(b, h) + boff + n * 2048 + k * 1024); } while (0)
#define G_MMA(ai, bj, At, Bt) do { __builtin_amdgcn_s_setprio(1); _Pragma("unroll") for (int m = 0; m < 4; ++m) _Pragma("unroll") for (int n = 0; n < 2; ++n) _Pragma("unroll") for (int k = 0; k < 2; ++k) \
        acc[ai][bj][m][n] = __builtin_amdgcn_mfma_f32_16x16x32_bf16(Bt[n][k], At[m][k], acc[ai][bj][m][n], 0, 0, 0); __builtin_amdgcn_s_setprio(0); } while (0)
#define G_WAIT_V(n) asm volatile("s_waitcnt vmcnt(" #n ")" ::: "memory")
#define G_WAIT_L(n) asm volatile("s_waitcnt lgkmcnt(" #n ")" ::: "memory")
#define G_BAR __builtin_amdgcn_s_barrier()
#define G_SCHED __builtin_amdgcn_sched_barrier(0)
#define G_ZERO() do { _Pragma("unroll") for (int a = 0; a < 2; ++a) _Pragma("unroll") for (int b = 0; b < 2; ++b) _Pragma("unroll") for (int m = 0; m < 4; ++m) _Pragma("unroll") for (int n = 0; n < 2; ++n) acc[a][b][m][n] = (f32x4){0.f, 0.f, 0.f, 0.f}; } while (0)
    Unit cur, nxt; int ui = 0;
    if (!S.next(0, cur)) return;
    f32x4 acc[2][2][4][2];
    G_ZERO();
    bf16x8 At[4][2], B0[2][2], B1[2][2];
    G_STAGE_B(G_SB(0, 0), cur.Bp, 0); G_STAGE_B(G_SB(0, 1), cur.Bp + hstepB, 0); G_STAGE_A(G_SA(0, 0), cur.a00, cur.a01, 0); G_STAGE_A(G_SA(0, 1), cur.a10, cur.a11, 0);
    if (wr == 1) G_BAR;
    G_WAIT_V(2); G_BAR;
    G_STAGE_B(G_SB(1, 0), cur.Bp, 128); G_STAGE_A(G_SA(1, 0), cur.a00, cur.a01, 128); G_STAGE_B(G_SB(1, 1), cur.Bp + hstepB, 128);
    G_WAIT_V(6); G_BAR;
    for (;;) {
        const bool has_next = S.next(ui + 1, nxt);
        if (!has_next) nxt = cur;
        for (int t = 0; t < nt; t += 2) {
            const bool last = (t == nt - 2);
            const size_t kb1 = (size_t)(t + 1) * 128, kb2 = last ? 0 : (size_t)(t + 2) * 128, kb3 = kb2 + 128;
            const char* b2 = last ? nxt.Bp : cur.Bp;
            const unsigned x00 = last ? nxt.a00 : cur.a00, x01 = last ? nxt.a01 : cur.a01, x10 = last ? nxt.a10 : cur.a10, x11 = last ? nxt.a11 : cur.a11;
            G_LDB(B0, 0, 0); G_LDB(B1, 0, 1); G_SCHED; G_LDA(At, 0, 0); G_STAGE_A(G_SA(1, 1), cur.a10, cur.a11, kb1);
            G_WAIT_V(8); G_WAIT_L(0); G_BAR; G_MMA(0, 0, At, B0); G_MMA(0, 1, At, B1); G_BAR; G_SCHED;
            G_LDA(At, 0, 1); G_STAGE_B(G_SB(0, 0), b2, kb2); G_STAGE_B(G_SB(0, 1), b2 + hstepB, kb2); G_STAGE_A(G_SA(0, 0), x00, x01, kb2);
            G_WAIT_V(8); G_WAIT_L(0); G_BAR; G_MMA(1, 0, At, B0); G_MMA(1, 1, At, B1); G_BAR; G_SCHED;
            G_LDB(B0, 1, 0); G_LDB(B1, 1, 1); G_SCHED; G_LDA(At, 1, 0); G_STAGE_A(G_SA(0, 1), x10, x11, kb2);
            G_WAIT_V(8); G_WAIT_L(0); G_BAR; G_MMA(0, 0, At, B0); G_MMA(0, 1, At, B1); G_BAR; G_SCHED;
            G_LDA(At, 1, 1); G_STAGE_B(G_SB(1, 0), b2, kb3); G_STAGE_B(G_SB(1, 1), b2 + hstepB, kb3); G_STAGE_A(G_SA(1, 0), x00, x01, kb3);
            G_WAIT_V(8); G_WAIT_L(0); G_BAR; G_MMA(1, 0, At, B0); G_MMA(1, 1, At, B1); G_BAR; G_SCHED;
        }
        if (wr == 0) G_BAR;
        E(acc, cur, wr, wc, fr, fq);
        if (!has_next) break;
        if (!E.keep(cur)) G_ZERO();
        cur = nxt; ++ui;
        if (wr == 1) G_BAR;
    }
    G_WAIT_V(0);
    G_BAR;
#undef G_SA
#undef G_SB
#undef G_STAGE_A
#undef G_STAGE_B
#undef G_LDA
#undef G_LDB
#undef G_MMA
#undef G_WAIT_V
#undef G_WAIT_L
#undef G_BAR
#undef G_SCHED
#undef G_ZERO
}

struct DenseSched {
    int nM, nN, nwg, G, c, lda, K, parts; const char* Bt; const char* Bt2; int R0, C0, R1, C1;
    __device__ void init(int M, int N, int K_, int lda_, const void* Bt_, const void* Bt2_, int parts_) {
        nM = M / BM; nN = N / BM; nwg = nM * nN; G = gridDim.x; c = blockIdx.x; lda = lda_; K = K_; Bt = (const char*)Bt_; Bt2 = (const char*)Bt2_; parts = parts_;
        stage_rc(ltid() * 16, R0, C0); stage_rc(ltid() * 16 + 8192, R1, C1);
    }
    __device__ bool next(int i, Unit& u) const {
        const int ti = parts == 2 ? (i >> 1) : i, part = parts == 2 ? (i & 1) : 0;
        const long L = (long)ti * G + c; if (L >= nwg) return false;
        int wgid = (int)L; { const int q = nwg / 8, r = nwg % 8, xcd = wgid % 8, off = wgid / 8; wgid = (xcd < r ? xcd * (q + 1) : r * (q + 1) + (xcd - r) * q) + off; }
        const int nig = 8 * nN, gid = wgid / nig, fm = gid * 8, gsz = (nM - fm) < 8 ? (nM - fm) : 8;
        u.pm = fm + ((wgid % nig) % gsz); u.pn = (wgid % nig) / gsz; u.aux = part;
        u.Bp = (part ? Bt2 : Bt) + (size_t)u.pn * BM * K * 2;
        const unsigned rb = (unsigned)u.pm * BM, po = part ? (unsigned)K * 2u : 0u;
        u.a00 = ((rb + R0) * lda + C0) * 2u + po; u.a01 = ((rb + R1) * lda + C1) * 2u + po;
        u.a10 = ((rb + HALF + R0) * lda + C0) * 2u + po; u.a11 = ((rb + HALF + R1) * lda + C1) * 2u + po;
        return true;
    }
};
template <bool GATHER>
struct MoeSched {
    int nN, G, c, K, lda, nent; const int* blk_row; const int* blk_exp; const int* tok_p; const char* W; size_t wstride; int R0, C0, R1, C1;
    __device__ void init(int nN_, int K_, int lda_, const int* nent_p, const int* blk_row_, const int* blk_exp_, const int* tok_p_, const void* W_, size_t wstride_) {
        nN = nN_; G = gridDim.x; c = blockIdx.x; K = K_; lda = lda_; nent = *nent_p; blk_row = blk_row_; blk_exp = blk_exp_; tok_p = tok_p_; W = (const char*)W_; wstride = wstride_;
        stage_rc(ltid() * 16, R0, C0); stage_rc(ltid() * 16 + 8192, R1, C1);
    }
    __device__ bool next(int i, Unit& u) const {
        const long L = (long)i * G + c; if (L >= (long)nent * nN) return false;
        const int ent = (int)(L / nN); u.pn = (int)(L % nN);
        const int rb = blk_row[ent], e = blk_exp[ent]; u.pm = rb; u.aux = e;
        u.Bp = W + (size_t)e * wstride + (size_t)u.pn * BM * K * 2;
        if (GATHER) {
            const unsigned t00 = tok_p[rb + R0], t01 = tok_p[rb + R1], t10 = tok_p[rb + HALF + R0], t11 = tok_p[rb + HALF + R1];
            u.a00 = (t00 * lda + C0) * 2u; u.a01 = (t01 * lda + C1) * 2u; u.a10 = (t10 * lda + C0) * 2u; u.a11 = (t11 * lda + C1) * 2u;
        } else {
            u.a00 = ((unsigned)(rb + R0) * lda + C0) * 2u; u.a01 = ((unsigned)(rb + R1) * lda + C1) * 2u;
            u.a10 = ((unsigned)(rb + HALF + R0) * lda + C0) * 2u; u.a11 = ((unsigned)(rb + HALF + R1) * lda + C1) * 2u;
        }
        return true;
    }
};

struct EpiProj {
    static constexpr bool PERM = true; bf16_t* O;
    __device__ __forceinline__ bool keep(const Unit&) const { return false; }
    __device__ __forceinline__ void operator()(f32x4 (&acc)[2][2][4][2], const Unit& u, int wr, int wc, int fr, int fq) const {
        const int row0 = u.pm * BM + wr * 64 + fr, col0 = u.pn * BM + wc * 32 + 8 * fq;
#pragma unroll
        for (int ai = 0; ai < 2; ++ai)
#pragma unroll
            for (int m = 0; m < 4; ++m) { bf16_t* rowp = O + (size_t)(row0 + ai * HALF + m * 16) * PW + col0;
#pragma unroll
                for (int bj = 0; bj < 2; ++bj) { const f32x4 v0 = acc[ai][bj][m][0], v1 = acc[ai][bj][m][1]; u32x4 w;
                    w.x = cvt_pk_bf16(v0[0], v0[1]); w.y = cvt_pk_bf16(v0[2], v0[3]); w.z = cvt_pk_bf16(v1[0], v1[1]); w.w = cvt_pk_bf16(v1[2], v1[3]);
                    *(u32x4*)(rowp + bj * HALF) = w; } }
    }
};
struct EpiMerge {
    static constexpr bool PERM = true; const bf16_t* proj; bf16_t* O;
    __device__ __forceinline__ bool keep(const Unit& u) const { return u.aux == 0; }
    __device__ __forceinline__ void operator()(f32x4 (&acc)[2][2][4][2], const Unit& u, int wr, int wc, int fr, int fq) const {
        const int row0 = u.pm * BM + wr * 64 + fr, col0 = u.pn * BM + wc * 32 + 8 * fq;
#pragma unroll
        for (int ai = 0; ai < 2; ++ai)
#pragma unroll
            for (int m = 0; m < 4; ++m) { const size_t r = (size_t)(row0 + ai * HALF + m * 16);
#pragma unroll
                for (int bj = 0; bj < 2; ++bj) {
                    const u32x4 gb = *(const u32x4*)(proj + r * PW + C_MGB + col0 + bj * HALF);
                    const f32x4 eb0 = {__expf(-bflo(gb.x)), __expf(-bfhi(gb.x)), __expf(-bflo(gb.y)), __expf(-bfhi(gb.y))};
                    const f32x4 eb1 = {__expf(-bflo(gb.z)), __expf(-bfhi(gb.z)), __expf(-bflo(gb.w)), __expf(-bfhi(gb.w))};
                    if (u.aux == 0) {
                        const u32x4 ga = *(const u32x4*)(proj + r * PW + C_MGA + col0 + bj * HALF);
                        const f32x4 ea0 = {__expf(-bflo(ga.x)), __expf(-bfhi(ga.x)), __expf(-bflo(ga.y)), __expf(-bfhi(ga.y))};
                        const f32x4 ea1 = {__expf(-bflo(ga.z)), __expf(-bfhi(ga.z)), __expf(-bflo(ga.w)), __expf(-bfhi(ga.w))};
                        acc[ai][bj][m][0] = acc[ai][bj][m][0] * (1.f + eb0) / (1.f + ea0); acc[ai][bj][m][1] = acc[ai][bj][m][1] * (1.f + eb1) / (1.f + ea1);
                    } else {
                        const f32x4 v0 = acc[ai][bj][m][0] / (1.f + eb0), v1 = acc[ai][bj][m][1] / (1.f + eb1);
                        u32x4 w; w.x = cvt_pk_bf16(v0[0], v0[1]); w.y = cvt_pk_bf16(v0[2], v0[3]); w.z = cvt_pk_bf16(v1[0], v1[1]); w.w = cvt_pk_bf16(v1[2], v1[3]);
                        *(u32x4*)(O + r * D + col0 + bj * HALF) = w;
                    } } }
    }
};
struct EpiResid {
    static constexpr bool PERM = false; const float* x; const float* gt; float* O;
    __device__ __forceinline__ bool keep(const Unit&) const { return false; }
    __device__ __forceinline__ void operator()(f32x4 (&acc)[2][2][4][2], const Unit& u, int wr, int wc, int fr, int fq) const {
        const int row0 = u.pm * BM + wr * 64 + fr, col0 = u.pn * BM + wc * 32 + 4 * fq;
        f32x4 g[2][2];
#pragma unroll
        for (int bj = 0; bj < 2; ++bj)
#pragma unroll
            for (int n = 0; n < 2; ++n) g[bj][n] = *(const f32x4*)(gt + col0 + bj * HALF + n * 16);
#pragma unroll
        for (int ai = 0; ai < 2; ++ai)
#pragma unroll
            for (int m = 0; m < 4; ++m) { const size_t ro = (size_t)(row0 + ai * HALF + m * 16) * D + col0;
#pragma unroll
                for (int bj = 0; bj < 2; ++bj)
#pragma unroll
                    for (int n = 0; n < 2; ++n) { const f32x4 xv = *(const f32x4*)(x + ro + bj * HALF + n * 16); *(f32x4*)(O + ro + bj * HALF + n * 16) = xv + g[bj][n] * acc[ai][bj][m][n]; } }
    }
};
struct EpiSwiglu {
    static constexpr bool PERM = true; bf16_t* hid;
    __device__ __forceinline__ bool keep(const Unit&) const { return false; }
    __device__ __forceinline__ void operator()(f32x4 (&acc)[2][2][4][2], const Unit& u, int wr, int wc, int fr, int fq) const {
        const int row0 = u.pm + wr * 64 + fr, j0 = u.pn * 128 + wc * 16 + 4 * fq;
#pragma unroll
        for (int ai = 0; ai < 2; ++ai)
#pragma unroll
            for (int m = 0; m < 4; ++m) { bf16_t* rowp = hid + (size_t)(row0 + ai * HALF + m * 16) * FF + j0;
#pragma unroll
                for (int bj = 0; bj < 2; ++bj) { const f32x4 g = acc[ai][bj][m][0], up = acc[ai][bj][m][1]; u32x2 w;
                    w.x = cvt_pk_bf16(siluf_(g[0]) * up[0], siluf_(g[1]) * up[1]); w.y = cvt_pk_bf16(siluf_(g[2]) * up[2], siluf_(g[3]) * up[3]);
                    *(u32x2*)(rowp + bj * 64) = w; } }
    }
};
struct EpiDown {
    static constexpr bool PERM = true; bf16_t* Y; const float* w_p;
    __device__ __forceinline__ bool keep(const Unit&) const { return false; }
    __device__ __forceinline__ void operator()(f32x4 (&acc)[2][2][4][2], const Unit& u, int wr, int wc, int fr, int fq) const {
        const int row0 = u.pm + wr * 64 + fr, col0 = u.pn * BM + wc * 32 + 8 * fq;
#pragma unroll
        for (int ai = 0; ai < 2; ++ai)
#pragma unroll
            for (int m = 0; m < 4; ++m) { const int r = row0 + ai * HALF + m * 16; const float wt = w_p[r]; bf16_t* rowp = Y + (size_t)r * D + col0;
#pragma unroll
                for (int bj = 0; bj < 2; ++bj) { const f32x4 v0 = acc[ai][bj][m][0] * wt, v1 = acc[ai][bj][m][1] * wt; u32x4 w;
                    w.x = cvt_pk_bf16(v0[0], v0[1]); w.y = cvt_pk_bf16(v0[2], v0[3]); w.z = cvt_pk_bf16(v1[0], v1[1]); w.w = cvt_pk_bf16(v1[2], v1[3]);
                    *(u32x4*)(rowp + bj * HALF) = w; } }
    }
};
}

struct Ctx {
    const float *x, *c, *w_ada, *b_ada, *norm1_g, *norm2_g, *w_in, *lb_table, *hgrn_onorm_g, *conv_w, *a_log, *dt_bias, *gdn_onorm_g, *w_bh, *w_bg, *w_out, *w_router, *router_bias,
        *w_eg, *w_eu, *w_ed, *w_sg, *w_su, *w_sd, *normf_g;
    float* out;
    unsigned* bar;
    float *modp, *mod, *lb, *gab;
    int *idx, *cnt, *tok_p, *pos, *blk_row, *blk_exp, *nent;
    float *wts, *w_p;
    bf16_t *win_t, *wa_t, *wb_t, *wout_t, *h1, *proj, *ocat, *merged;
    float *gq, *gk, *gv, *gbeta, *gdec, *oa, *ob;
    float *hL, *hS, *hD;
    float *gAT, *gB, *gS; unsigned char *gBlob, *gM;
    bf16_t *dn_t, *hid, *gu_t, *h2, *Y; float* h2f;
};

typedef const __attribute__((address_space(4))) Ctx CtxK;

__device__ __forceinline__ void cvt_tile(LAS float* t, const float* srcA, const float* srcB, int ld, int mode, bf16_t* dst, int ldd) {
    const int tid = ltid(), kr = tid >> 6, cl = tid & 63;
    const float* sp = (mode == 1 && cl >= 32) ? (srcB + cl - 32) : (srcA + cl);
    float v[8];
#pragma unroll
    for (int p = 0; p < 8; ++p) v[p] = sp[(size_t)(p * 8 + kr) * ld];
    __syncthreads();
#pragma unroll
    for (int p = 0; p < 8; ++p) t[(p * 8 + kr) * 65 + cl] = v[p];
    __syncthreads();
    const int r = tid >> 3, seg = (tid & 7) * 8;
    const int lc = mode == 1 ? (((r >> 2) & 1) * 32 + 4 * (r >> 3) + (r & 3)) : r;
    float w[8];
#pragma unroll
    for (int j = 0; j < 8; ++j) w[j] = t[(seg + j) * 65 + lc];
    u32x4 o; o.x = cvt_pk_bf16(w[0], w[1]); o.y = cvt_pk_bf16(w[2], w[3]); o.z = cvt_pk_bf16(w[4], w[5]); o.w = cvt_pk_bf16(w[6], w[7]);
    *(u32x4*)(dst + (size_t)r * ldd + seg) = o;
}
__device__ __forceinline__ void cvt_job(LAS float* t, int tile, const float* src, int ld, int K, bf16_t* dst) {
    const int nkt = K / 64, nt = tile / nkt, kt = tile % nkt;
    cvt_tile(t, src + (size_t)kt * 64 * ld + nt * 64, nullptr, ld, 0, dst + (size_t)nt * 64 * K + kt * 64, K);
}

__device__ void ph_pro1(CtxK& c, LAS unsigned char* lds) {
    const int tid = ltid(), wg = blockIdx.x, G = gridDim.x;
    LAS float* lf = (LAS float*)lds;
    for (int job = wg; job < 192; job += G) {
        const int cc = job % 48, kp = job / 48, q = tid & 63, rg = tid >> 6;
        f32x4 a = {0.f, 0.f, 0.f, 0.f};
        for (int r = rg; r < 512; r += 8) { const int k = kp * 512 + r; const float s = siluf_(c.c[k]); a += s * *(const f32x4*)(c.w_ada + (size_t)k * (6 * D) + cc * 256 + q * 4); }
        __syncthreads();
        *(LAS f32x4*)(lf + (rg * 64 + q) * 4) = a;
        __syncthreads();
        if (tid < 64) { f32x4 s = {0.f, 0.f, 0.f, 0.f};
#pragma unroll
            for (int g = 0; g < 8; ++g) s += *(LAS f32x4*)(lf + (g * 64 + tid) * 4);
            *(f32x4*)(c.modp + (size_t)kp * (6 * D) + cc * 256 + tid * 4) = s; }
    }
    if (wg == G - 1) for (int j = tid; j < 1024; j += 512) c.lb[j] = 1.f / (1.f + expf(c.lb_table[1024 + j] - c.lb_table[j]));
    for (int T = wg; T < 8192; T += G) {
        if (T < 6144) { const int nt = T / 32, kt = T % 32; const int sc = nt * 64 + (nt * 64 >= WIN_GAB ? 16 : 0);
            cvt_tile(lf, c.w_in + (size_t)kt * 64 * INW + sc, nullptr, INW, 0, c.win_t + (size_t)nt * 64 * D + kt * 64, D); }
        else if (T < 6656) cvt_job(lf, T - 6144, c.w_bh, D, 1024, c.wa_t);
        else if (T < 7168) cvt_job(lf, T - 6656, c.w_bg, D, 1024, c.wb_t);
        else cvt_job(lf, T - 7168, c.w_out, D, 2048, c.wout_t);
    }
}
__device__ void ph_norm1(CtxK& c, LAS unsigned char* lds) {
    const int tid = ltid(), wg = blockIdx.x, G = gridDim.x, lane = tid & 63, wv = tid >> 6;
    LAS float* la = (LAS float*)lds;
    LAS float* lb_ = la + D;
    LAS float* lw = lb_ + D;
    for (int j = tid; j < D; j += 512) {
        float sh = c.b_ada[j], sc = c.b_ada[D + j];
#pragma unroll
        for (int p = 0; p < 4; ++p) { sh += c.modp[(size_t)p * 6 * D + j]; sc += c.modp[(size_t)p * 6 * D + D + j]; }
        la[j] = c.norm1_g[j] * (1.f + sc); lb_[j] = sh;
    }
    for (int j = wg * 512 + tid; j < 6 * D; j += G * 512) { float m = c.b_ada[j];
#pragma unroll
        for (int p = 0; p < 4; ++p) m += c.modp[(size_t)p * 6 * D + j];
        c.mod[j] = m; }
    for (int i = tid; i < D * 4; i += 512) { const int e = i >> 2, q = i & 3; const f32x4 w = *(const f32x4*)(c.w_in + (size_t)e * INW + WIN_GAB + q * 4);
        lw[(q * 4 + 0) * D + e] = w[0]; lw[(q * 4 + 1) * D + e] = w[1]; lw[(q * 4 + 2) * D + e] = w[2]; lw[(q * 4 + 3) * D + e] = w[3]; }
    __syncthreads();
    for (int row = wg * 8 + wv; row < S; row += G * 8) {
        const float* xr = c.x + (size_t)row * D; f32x4 v[8]; float ss = 0.f;
#pragma unroll
        for (int i = 0; i < 8; ++i) { v[i] = *(const f32x4*)(xr + i * 256 + lane * 4); ss += v[i][0] * v[i][0] + v[i][1] * v[i][1] + v[i][2] * v[i][2] + v[i][3] * v[i][3]; }
        ss = wave_sum(ss); const float r = rsqrtf(ss * (1.f / D) + 1e-6f);
#pragma unroll
        for (int i = 0; i < 8; ++i) { const int e = i * 256 + lane * 4; const f32x4 a = *(LAS f32x4*)(la + e), b = *(LAS f32x4*)(lb_ + e); v[i] = v[i] * r * a + b;
            u32x2 w; w.x = cvt_pk_bf16(v[i][0], v[i][1]); w.y = cvt_pk_bf16(v[i][2], v[i][3]); *(u32x2*)(c.h1 + (size_t)row * D + e) = w; }
        float mine = 0.f;
        for (int cc = 0; cc < 16; ++cc) { float d = 0.f;
#pragma unroll
            for (int i = 0; i < 8; ++i) { const f32x4 w = *(LAS f32x4*)(lw + cc * D + i * 256 + lane * 4); d += v[i][0] * w[0] + v[i][1] * w[1] + v[i][2] * w[2] + v[i][3] * w[3]; }
            d = wave_sum(d); if (lane == cc) mine = d; }
        if (lane < 16) c.gab[(size_t)row * 16 + lane] = mine;
    }
}
__device__ void ph_gemm1(CtxK& c, LAS unsigned char* lds) {
    gm::DenseSched Sd; Sd.init(S, PW, D, D, c.win_t, nullptr, 1); gm::EpiProj E{c.proj};
    gm::gphase(lds, (const char*)c.h1, D, Sd, E);
}
__device__ void ph_gemm2(CtxK& c, LAS unsigned char* lds) {
    gm::DenseSched Sd; Sd.init(S, D, 1024, 2048, c.wa_t, c.wb_t, 2); gm::EpiMerge E{c.proj, c.merged};
    gm::gphase(lds, (const char*)c.ocat, 1024, Sd, E);
}
__device__ void ph_gemm3(CtxK& c, LAS unsigned char* lds) {
    gm::DenseSched Sd; Sd.init(S, D, D, D, c.wout_t, nullptr, 1); gm::EpiResid E{c.x, c.mod + 2 * D, c.out};
    gm::gphase(lds, (const char*)c.merged, D, Sd, E);
}
__device__ void ph_moe_gu(CtxK& c, LAS unsigned char* lds) {
    gm::MoeSched<true> Sm; Sm.init(4, D, D, c.nent, c.blk_row, c.blk_exp, c.tok_p, c.gu_t, (size_t)1024 * D * 2); gm::EpiSwiglu E{c.hid};
    gm::gphase(lds, (const char*)c.h2, D, Sm, E);
}
__device__ void ph_moe_dn(CtxK& c, LAS unsigned char* lds) {
    gm::MoeSched<false> Sm; Sm.init(8, FF, FF, c.nent, c.blk_row, c.blk_exp, c.tok_p, c.dn_t, (size_t)D * FF * 2); gm::EpiDown E{c.Y, c.w_p};
    gm::gphase(lds, (const char*)c.hid, FF, Sm, E);
}
__device__ void ph_norm2(CtxK& c, LAS unsigned char* lds) {
    const int tid = ltid(), wg = blockIdx.x, G = gridDim.x, lane = tid & 63, wv = tid >> 6;
    LAS float* la = (LAS float*)lds; LAS float* lb_ = la + D;
    for (int j = tid; j < D; j += 512) { la[j] = c.norm2_g[j] * (1.f + c.mod[4 * D + j]); lb_[j] = c.mod[3 * D + j]; }
    __syncthreads();
    for (int row = wg * 8 + wv; row < S; row += G * 8) {
        const float* xr = c.out + (size_t)row * D; f32x4 v[8]; float ss = 0.f;
#pragma unroll
        for (int i = 0; i < 8; ++i) { v[i] = *(const f32x4*)(xr + i * 256 + lane * 4); ss += v[i][0] * v[i][0] + v[i][1] * v[i][1] + v[i][2] * v[i][2] + v[i][3] * v[i][3]; }
        ss = wave_sum(ss); const float r = rsqrtf(ss * (1.f / D) + 1e-6f);
#pragma unroll
        for (int i = 0; i < 8; ++i) { const int e = i * 256 + lane * 4; const f32x4 a = *(LAS f32x4*)(la + e), b = *(LAS f32x4*)(lb_ + e); v[i] = v[i] * r * a + b;
            u32x2 w; w.x = cvt_pk_bf16(v[i][0], v[i][1]); w.y = cvt_pk_bf16(v[i][2], v[i][3]); *(u32x2*)(c.h2 + (size_t)row * D + e) = w;
            *(f32x4*)(c.h2f + (size_t)row * D + e) = v[i]; }
    }
}
__device__ void ph_cvt_exp(CtxK& c, LAS unsigned char* lds) {
    LAS float* lf = (LAS float*)lds; const int wg = blockIdx.x, G = gridDim.x;
    constexpr int GU_T = 16 * 32, DN_T = 32 * 8;
    for (int T = wg; T < NEX * (GU_T + DN_T); T += G) {
        if (T < NEX * GU_T) { const int e = T / GU_T, r = T % GU_T, nt = r / 32, kt = r % 32;
            const float* sg = e < NE ? c.w_eg + (size_t)e * D * FF : c.w_sg; const float* su = e < NE ? c.w_eu + (size_t)e * D * FF : c.w_su;
            cvt_tile(lf, sg + (size_t)kt * 64 * FF + nt * 32, su + (size_t)kt * 64 * FF + nt * 32, FF, 1, c.gu_t + ((size_t)e * 1024 + nt * 64) * D + kt * 64, D); }
        else { const int T2 = T - NEX * GU_T, e = T2 / DN_T, r = T2 % DN_T; const float* sd = e < NE ? c.w_ed + (size_t)e * FF * D : c.w_sd;
            cvt_job(lf, r, sd, D, FF, c.dn_t + (size_t)e * D * FF); }
    }
}
__device__ void ph_final(CtxK& c, LAS unsigned char* lds) {
    const int tid = ltid(), wg = blockIdx.x, G = gridDim.x, lane = tid & 63, wv = tid >> 6;
    const float* gt2 = c.mod + 5 * D;
    for (int row = wg * 8 + wv; row < S; row += G * 8) {
        int p[9];
#pragma unroll
        for (int k = 0; k < 8; ++k) p[k] = c.pos[row * TOPK + k];
        p[8] = PROUTED + row;
        f32x4 v[8]; float ss = 0.f;
#pragma unroll
        for (int i = 0; i < 8; ++i) {
            const int e = i * 256 + lane * 4; f32x4 a = {0.f, 0.f, 0.f, 0.f};
#pragma unroll
            for (int k = 0; k < 9; ++k) { const u32x2 y = *(const u32x2*)(c.Y + (size_t)p[k] * D + e); a[0] += bflo(y.x); a[1] += bfhi(y.x); a[2] += bflo(y.y); a[3] += bfhi(y.y); }
            const f32x4 xv = *(const f32x4*)(c.out + (size_t)row * D + e), g = *(const f32x4*)(gt2 + e);
            v[i] = xv + g * a; ss += v[i][0] * v[i][0] + v[i][1] * v[i][1] + v[i][2] * v[i][2] + v[i][3] * v[i][3];
        }
        ss = wave_sum(ss); const float r = rsqrtf(ss * (1.f / D) + 1e-6f);
#pragma unroll
        for (int i = 0; i < 8; ++i) { const int e = i * 256 + lane * 4; *(f32x4*)(c.out + (size_t)row * D + e) = v[i] * r * *(const f32x4*)(c.normf_g + e); }
    }
}


namespace mx {
constexpr int ST128 = 272, ST64 = 144;
constexpr int FRAG_F4 = 8 * 8 * 64;
__device__ __forceinline__ f32x4 mfma16(bf16x8 a, bf16x8 b, f32x4 c) { return __builtin_amdgcn_mfma_f32_16x16x32_bf16(a, b, c, 0, 0, 0); }
template <int MT, int KS>
__device__ __forceinline__ void mma_nt(f32x4 (&acc)[MT], LAS const unsigned char* xs, int sx, LAS const unsigned char* ys, int sy, int fr, int fq) {
#pragma unroll
    for (int kk = 0; kk < KS; ++kk) {
        const bf16x8 b = *(const LAS bf16x8*)(ys + fr * sy + (kk * 32 + fq * 8) * 2);
#pragma unroll
        for (int m = 0; m < MT; ++m) { const bf16x8 a = *(const LAS bf16x8*)(xs + (16 * m + fr) * sx + (kk * 32 + fq * 8) * 2); acc[m] = mfma16(a, b, acc[m]); }
    }
}
__device__ __forceinline__ void lds_fence() { asm volatile("s_waitcnt lgkmcnt(0)" ::: "memory"); }
__device__ __forceinline__ u32x4 pack8(const float (&v)[8]) { u32x4 o; o.x = cvt_pk_bf16(v[0], v[1]); o.y = cvt_pk_bf16(v[2], v[3]); o.z = cvt_pk_bf16(v[4], v[5]); o.w = cvt_pk_bf16(v[6], v[7]); return o; }
__device__ __forceinline__ void unpack8(const u32x4 w, float (&v)[8]) { v[0] = bflo(w.x); v[1] = bfhi(w.x); v[2] = bflo(w.y); v[3] = bfhi(w.y); v[4] = bflo(w.z); v[5] = bfhi(w.z); v[6] = bflo(w.w); v[7] = bfhi(w.w); }
__device__ __forceinline__ void mfma_pad8(f32x4 (&a)[8]) { asm volatile("s_nop 15\n\ts_nop 7" : "+v"(a[0]), "+v"(a[1]), "+v"(a[2]), "+v"(a[3]), "+v"(a[4]), "+v"(a[5]), "+v"(a[6]), "+v"(a[7])); }
__device__ __forceinline__ void mfma_pad4(f32x4 (&a)[4]) { asm volatile("s_nop 15\n\ts_nop 7" : "+v"(a[0]), "+v"(a[1]), "+v"(a[2]), "+v"(a[3])); }
__device__ __forceinline__ void write_st(LAS unsigned char* stw, f32x4 (&S)[8], int fr, int fq) {
    mfma_pad8(S);
#pragma unroll
    for (int m = 0; m < 8; ++m) { u32x2 w; w.x = cvt_pk_bf16(S[m][0], S[m][1]); w.y = cvt_pk_bf16(S[m][2], S[m][3]); *(LAS u32x2*)(stw + fr * ST128 + (16 * m + 4 * fq) * 2) = w; }
}

constexpr int H_QT = 0, H_KT = 17408, H_QI = 34816, H_KU = 52224, H_VT = 70656, H_P = 89088, H_DEC = 98304, H_OCT = 98816, H_F4 = 102912, H_PART = 103424, H_RINV = 105472, H_ST = 105728, H_END = H_ST + 8 * 16 * ST128;
static_assert(H_END <= 147456, "hgrn lds");
template <bool OUT>
__device__ void hgrn_pass(CtxK& c, LAS unsigned char* lds) {
    const int tid = ltid(), wv = __builtin_amdgcn_readfirstlane(tid >> 6), lane = tid & 63, fr = lane & 15, fq = lane >> 4;
    LAS float* dec = (LAS float*)(lds + H_DEC); LAS float* oct = (LAS float*)(lds + H_OCT); LAS float* f4 = (LAS float*)(lds + H_F4);
    LAS float* part = (LAS float*)(lds + H_PART); LAS float* rinv = (LAS float*)(lds + H_RINV);
    LAS unsigned char* stw = lds + H_ST + wv * 16 * ST128;
    {
        const int wu = blockIdx.x, h = wu & 7, g = wu >> 3;
        f32x4 Sacc[8];
#pragma unroll
        for (int m = 0; m < 8; ++m) Sacc[m] = (f32x4){0.f, 0.f, 0.f, 0.f};
        if (OUT) {
            if (g > 0) { const f32x4* sp = (const f32x4*)c.hS + (size_t)(h * 32 + g) * FRAG_F4 + (wv * 8) * 64 + lane;
#pragma unroll
                for (int m = 0; m < 8; ++m) Sacc[m] = sp[m * 64]; }
            write_st(stw, Sacc, fr, fq);
        }
        float dsum = 0.f;
        for (int i = 0; i < 8; ++i) {
            const int T0 = (g * 8 + i) * 64;
            const int tp = ltid(), to = (tp >> 4) & 7, co = tp & 15, c0 = to * 8, d0 = co * 8;
            float cs[8][8];
            if (tid < 128) {
                float lbv[8];
                { const f32x4 l0 = *(const f32x4*)(c.lb + h * 128 + d0), l1 = *(const f32x4*)(c.lb + h * 128 + d0 + 4);
                  lbv[0] = l0[0]; lbv[1] = l0[1]; lbv[2] = l0[2]; lbv[3] = l0[3]; lbv[4] = l1[0]; lbv[5] = l1[1]; lbv[6] = l1[2]; lbv[7] = l1[3]; }
#pragma unroll
                for (int tt = 0; tt < 8; ++tt) {
                    float fv[8]; unpack8(*(const u32x4*)(c.proj + (size_t)(T0 + c0 + tt) * PW + C_HF + h * 128 + d0), fv);
#pragma unroll
                    for (int j = 0; j < 8; ++j) { const float lf = __logf(lbv[j] + (1.f - lbv[j]) * sigmoidf_(fv[j])); cs[tt][j] = tt ? cs[tt - 1][j] + lf : lf; }
                }
#pragma unroll
                for (int j = 0; j < 8; ++j) { oct[to * 128 + d0 + j] = cs[7][j]; if (to == 4) f4[d0 + j] = cs[0][j]; }
            }
            __syncthreads();
            if (tid < 128) {
                float pre[8], tot[8], bmid[8];
#pragma unroll
                for (int j = 0; j < 8; ++j) { float p = 0.f, t_ = 0.f, bm = 0.f;
#pragma unroll
                    for (int o = 0; o < 8; ++o) { const float x = oct[o * 128 + d0 + j]; p += o < to ? x : 0.f; bm += o < 4 ? x : 0.f; t_ += x; }
                    pre[j] = p; tot[j] = t_; bmid[j] = bm + f4[d0 + j]; }
                if (to == 0) {
#pragma unroll
                    for (int j = 0; j < 8; ++j) dec[d0 + j] = __expf(tot[j]);
                }
                if (OUT) {
#pragma unroll
                    for (int tt = 0; tt < 8; ++tt) {
                        float qv[8], q1[8], k1[8], q2[8];
                        unpack8(*(const u32x4*)(c.proj + (size_t)(T0 + c0 + tt) * PW + C_HQ + h * 128 + d0), qv);
#pragma unroll
                        for (int j = 0; j < 8; ++j) {
                            const float lf = tt ? cs[tt][j] - cs[tt - 1][j] : cs[0][j], kk_ = 1.f - __expf(lf), b = pre[j] + cs[tt][j];
                            const float q = siluf_(qv[j]) * 0.08838834764831845f, e1 = __expf(b - bmid[j]); q1[j] = q * e1; k1[j] = kk_ / e1; q2[j] = q * __expf(b);
                        }
                        *(LAS u32x4*)(lds + H_QT + (c0 + tt) * ST128 + d0 * 2) = pack8(q1); *(LAS u32x4*)(lds + H_KT + (c0 + tt) * ST128 + d0 * 2) = pack8(k1); *(LAS u32x4*)(lds + H_QI + (c0 + tt) * ST128 + d0 * 2) = pack8(q2);
                    }
                }
#pragma unroll
                for (int j = 0; j < 8; ++j) { float col[8];
#pragma unroll
                    for (int tt = 0; tt < 8; ++tt) { const float lf = tt ? cs[tt][j] - cs[tt - 1][j] : cs[0][j]; col[tt] = (1.f - __expf(lf)) * __expf(tot[j] - pre[j] - cs[tt][j]); }
                    *(LAS u32x4*)(lds + H_KU + (d0 + j) * ST64 + c0 * 2) = pack8(col); }
                if (!OUT && to == 0) {   }
            } else if (tid < 256) {
                float vb[8][8];
#pragma unroll
                for (int tt = 0; tt < 8; ++tt) unpack8(*(const u32x4*)(c.proj + (size_t)(T0 + c0 + tt) * PW + C_HI + h * 128 + d0), vb[tt]);
#pragma unroll
                for (int j = 0; j < 8; ++j) { float col[8];
#pragma unroll
                    for (int tt = 0; tt < 8; ++tt) col[tt] = vb[tt][j];
                    *(LAS u32x4*)(lds + H_VT + (d0 + j) * ST64 + c0 * 2) = pack8(col); }
            }
            __syncthreads();
            if (!OUT && tid < 128) dsum += __logf(dec[tid]);
            f32x4 oacc[4];
            if (OUT) {
                { f32x4 sc[2] = {(f32x4){0.f, 0.f, 0.f, 0.f}, (f32x4){0.f, 0.f, 0.f, 0.f}};
                  const int nt = wv & 3, mb = (wv >> 2) * 2;
                  mma_nt<2, 4>(sc, lds + H_KT + mb * 16 * ST128, ST128, lds + H_QT + nt * 16 * ST128, ST128, fr, fq);
#pragma unroll
                  for (int m = 0; m < 2; ++m) { const int cc = nt * 16 + fr, s0 = (mb + m) * 16 + 4 * fq; u32x2 w;
                      w.x = cvt_pk_bf16(s0 + 0 <= cc ? sc[m][0] : 0.f, s0 + 1 <= cc ? sc[m][1] : 0.f); w.y = cvt_pk_bf16(s0 + 2 <= cc ? sc[m][2] : 0.f, s0 + 3 <= cc ? sc[m][3] : 0.f);
                      *(LAS u32x2*)(lds + H_P + cc * ST64 + s0 * 2) = w; } }
                __syncthreads();
#pragma unroll
                for (int m = 0; m < 4; ++m) oacc[m] = (f32x4){0.f, 0.f, 0.f, 0.f};
                mma_nt<4, 2>(oacc, lds + H_P, ST64, lds + H_VT + wv * 16 * ST64, ST64, fr, fq);
                mma_nt<4, 4>(oacc, lds + H_QI, ST128, stw, ST128, fr, fq);
#pragma unroll
                for (int m = 0; m < 4; ++m)
#pragma unroll
                    for (int r = 0; r < 4; ++r) { float q = oacc[m][r] * oacc[m][r]; q += __shfl_xor(q, 1); q += __shfl_xor(q, 2); q += __shfl_xor(q, 4); q += __shfl_xor(q, 8); if (fr == 0) part[wv * 64 + 16 * m + 4 * fq + r] = q; }
            }
#pragma unroll
            for (int m = 0; m < 8; ++m) { const f32x4 dv = *(LAS f32x4*)(dec + 16 * m + 4 * fq); Sacc[m] = Sacc[m] * dv; }
            mma_nt<8, 2>(Sacc, lds + H_KU, ST64, lds + H_VT + wv * 16 * ST64, ST64, fr, fq);
            if (OUT) {
                lds_fence();
                write_st(stw, Sacc, fr, fq);
                __syncthreads();
                if (tid < 64) { float s_ = 0.f;
#pragma unroll
                    for (int w = 0; w < 8; ++w) s_ += part[w * 64 + tid];
                    rinv[tid] = rsqrtf(s_ * (1.f / 128.f) + 1e-6f); }
                __syncthreads();
                const int v = wv * 16 + fr; const float gn = c.hgrn_onorm_g[v];
#pragma unroll
                for (int m = 0; m < 4; ++m)
#pragma unroll
                    for (int r = 0; r < 4; ++r) { const int cc = 16 * m + 4 * fq + r; const size_t t = (size_t)(T0 + cc);
                        const float o = oacc[m][r] * rinv[cc] * gn * siluf_(bf2f(c.proj[t * PW + C_HG + h * 128 + v]));
                        c.ocat[t * D + h * 128 + v] = (bf16_t)(cvt_pk_bf16(o, o) & 0xffffu); }
            }
            __syncthreads();
        }
        if (!OUT) {
            f32x4* sp = (f32x4*)c.hL + (size_t)(h * 32 + g) * FRAG_F4 + (wv * 8) * 64 + lane;
#pragma unroll
            for (int m = 0; m < 8; ++m) sp[m * 64] = Sacc[m];
            if (tid < 128) c.hD[(h * 32 + g) * 128 + tid] = __expf(dsum);
        }
    }
}
__device__ void hgrn_scan(CtxK& c) {
    const int e = blockIdx.x * 512 + ltid();
    if (e >= 8 * FRAG_F4) return;
    const int h = e / FRAG_F4, fi = e % FRAG_F4, m = (fi >> 6) & 7, lane = fi & 63, d0 = 16 * m + 4 * (lane >> 4);
    f32x4 s = {0.f, 0.f, 0.f, 0.f};
    for (int g = 0; g < 31; ++g) {
        const f32x4 dc = *(const f32x4*)(c.hD + (h * 32 + g) * 128 + d0);
        s = s * dc + ((const f32x4*)c.hL)[(size_t)(h * 32 + g) * FRAG_F4 + fi];
        ((f32x4*)c.hS)[(size_t)(h * 32 + g + 1) * FRAG_F4 + fi] = s;
    }
}

constexpr int B_T = 0, B_KBG = 9216, B_KU = 26624, B_VB = 45056, B_QD = 63488, B_AT = 80896, B_SC = 90112, BLOB = 90368;
constexpr int G_ST = BLOB, G_RV = G_ST + 8 * 16 * ST128, G_PART = G_RV + 8 * 16 * ST64, G_RINV = G_PART + 2048, G_END = G_RINV + 256;
static_assert(G_END <= 147456, "gdn lds");
constexpr int P_K = 0, P_Q = 17408, P_BETA = 34816, P_GC = P_BETA + 256, P_EG = P_GC + 256, P_EK = P_EG + 256;

__device__ void gdn_prep(CtxK& c, LAS unsigned char* lds, int h, int g) {
    const int tid = ltid(), wv = __builtin_amdgcn_readfirstlane(tid >> 6), lane = tid & 63, fr = lane & 15, fq = lane >> 4;
    LAS float* sbeta = (LAS float*)(lds + P_BETA); LAS float* sgc = (LAS float*)(lds + P_GC); LAS float* seg = (LAS float*)(lds + P_EG); LAS float* sek = (LAS float*)(lds + P_EK);
    for (int i = 0; i < 8; ++i) {
        const int n = g * 8 + i, T0 = n * 64;
        unsigned char* blob = (unsigned char*)c.gBlob + (size_t)(h * 256 + n) * BLOB;
        if (wv == 0) {
            const float ga = c.gab[(size_t)(T0 + lane) * 16 + h], gb = c.gab[(size_t)(T0 + lane) * 16 + 8 + h];
            const float gl_ = -__expf(c.a_log[h]) * softplusf_(ga + c.dt_bias[h]);
            float gc = gl_;
#pragma unroll
            for (int o = 1; o < 64; o <<= 1) { const float t_ = __shfl_up(gc, o); if (lane >= o) gc += t_; }
            const float glast = __shfl(gc, 63);
            sbeta[lane] = sigmoidf_(gb); sgc[lane] = gc; seg[lane] = __expf(gc); sek[lane] = __expf(glast - gc);
            if (lane == 0) *(float*)(blob + B_SC) = __expf(glast);
        }
        __syncthreads();
        const int tp = ltid(), part = tp >> 7, to = (tp >> 4) & 7, co = tp & 15, c0 = to * 8, d0 = co * 8;
        if (tp < 384) {
            const int chb = part * 1024 + h * 128 + d0;
            float val[8][8];
            {
                float wj[4][8];
#pragma unroll
                for (int j = 0; j < 4; ++j) { const f32x4 a = *(const f32x4*)(c.conv_w + j * 3072 + chb), b = *(const f32x4*)(c.conv_w + j * 3072 + chb + 4);
                    wj[j][0] = a[0]; wj[j][1] = a[1]; wj[j][2] = a[2]; wj[j][3] = a[3]; wj[j][4] = b[0]; wj[j][5] = b[1]; wj[j][6] = b[2]; wj[j][7] = b[3]; }
                u32x4 raw[11];
#pragma unroll
                for (int r = 0; r < 11; ++r) { const int tok = T0 + c0 - 3 + r; raw[r] = tok >= 0 ? *(const u32x4*)(c.proj + (size_t)tok * PW + C_GQKV + chb) : (u32x4){0u, 0u, 0u, 0u}; }
#pragma unroll
                for (int tt = 0; tt < 8; ++tt) {
                    float a[8] = {0.f, 0.f, 0.f, 0.f, 0.f, 0.f, 0.f, 0.f};
#pragma unroll
                    for (int j = 0; j < 4; ++j) { float xv[8]; unpack8(raw[tt + j], xv);
#pragma unroll
                        for (int jj = 0; jj < 8; ++jj) a[jj] += wj[j][jj] * xv[jj]; }
#pragma unroll
                    for (int jj = 0; jj < 8; ++jj) val[tt][jj] = siluf_(a[jj]);
                }
            }
            if (part < 2) {
#pragma unroll
                for (int tt = 0; tt < 8; ++tt) { float ss = 0.f;
#pragma unroll
                    for (int jj = 0; jj < 8; ++jj) ss += val[tt][jj] * val[tt][jj];
                    ss += __shfl_xor(ss, 1); ss += __shfl_xor(ss, 2); ss += __shfl_xor(ss, 4); ss += __shfl_xor(ss, 8);
                    const float rn = rsqrtf(ss + 1e-6f) * (part == 0 ? 0.08838834764831845f : 1.f);
#pragma unroll
                    for (int jj = 0; jj < 8; ++jj) val[tt][jj] *= rn; }
            }
            if (part == 0) {
#pragma unroll
                for (int tt = 0; tt < 8; ++tt) { const int cc = c0 + tt; *(LAS u32x4*)(lds + P_Q + cc * ST128 + d0 * 2) = pack8(val[tt]);
                    const float e = seg[cc]; float qd[8];
#pragma unroll
                    for (int jj = 0; jj < 8; ++jj) qd[jj] = val[tt][jj] * e;
                    *(u32x4*)(blob + B_QD + cc * ST128 + d0 * 2) = pack8(qd); }
            } else if (part == 1) {
#pragma unroll
                for (int tt = 0; tt < 8; ++tt) { const int cc = c0 + tt; *(LAS u32x4*)(lds + P_K + cc * ST128 + d0 * 2) = pack8(val[tt]);
                    const float e = seg[cc] * sbeta[cc]; float kb[8];
#pragma unroll
                    for (int jj = 0; jj < 8; ++jj) kb[jj] = val[tt][jj] * e;
                    *(u32x4*)(blob + B_KBG + cc * ST128 + d0 * 2) = pack8(kb); }
#pragma unroll
                for (int jj = 0; jj < 8; ++jj) { float col[8];
#pragma unroll
                    for (int tt = 0; tt < 8; ++tt) col[tt] = val[tt][jj] * sek[c0 + tt];
                    *(u32x4*)(blob + B_KU + (d0 + jj) * ST64 + c0 * 2) = pack8(col); }
            } else {
#pragma unroll
                for (int jj = 0; jj < 8; ++jj) { float col[8];
#pragma unroll
                    for (int tt = 0; tt < 8; ++tt) col[tt] = val[tt][jj] * sbeta[c0 + tt];
                    *(u32x4*)(blob + B_VB + (d0 + jj) * ST64 + c0 * 2) = pack8(col); }
            }
        }
        __syncthreads();
        {
            const int nt = wv & 3, mb = (wv >> 2) * 2, jj = nt * 16 + fr;
            f32x4 kk2[2] = {(f32x4){0.f, 0.f, 0.f, 0.f}, (f32x4){0.f, 0.f, 0.f, 0.f}}, at2[2] = {(f32x4){0.f, 0.f, 0.f, 0.f}, (f32x4){0.f, 0.f, 0.f, 0.f}};
            mma_nt<2, 4>(kk2, lds + P_K + mb * 16 * ST128, ST128, lds + P_K + nt * 16 * ST128, ST128, fr, fq);
            mma_nt<2, 4>(at2, lds + P_K + mb * 16 * ST128, ST128, lds + P_Q + nt * 16 * ST128, ST128, fr, fq);
            float* at = c.gAT + (size_t)(h * 256 + n) * 4096;
            const float gj = sgc[jj];
#pragma unroll
            for (int m = 0; m < 2; ++m) { const int i0 = (mb + m) * 16 + 4 * fq; f32x4 av; float pv[4];
#pragma unroll
                for (int r = 0; r < 4; ++r) { const int ii = i0 + r; const float gi = sgc[ii];
                    av[r] = jj < ii ? sbeta[ii] * kk2[m][r] * __expf(gi - gj) : 0.f;
                    pv[r] = ii <= jj ? at2[m][r] * __expf(gj - gi) : 0.f; }
                *(f32x4*)(at + jj * 64 + i0) = av;
                u32x2 w; w.x = cvt_pk_bf16(pv[0], pv[1]); w.y = cvt_pk_bf16(pv[2], pv[3]);
                *(u32x2*)(blob + B_AT + jj * ST64 + i0 * 2) = w; }
        }
        __syncthreads();
    }
}
__device__ void gdn_invert(CtxK& c, LAS unsigned char* lds, int h, int g) {
    const int tid = ltid(), wv = __builtin_amdgcn_readfirstlane(tid >> 6), lane = tid & 63;
    const int n = g * 8 + wv;
    LAS float* at = (LAS float*)(lds + wv * 16384);
    const float* src = c.gAT + (size_t)(h * 256 + n) * 4096;
#pragma unroll
    for (int k = 0; k < 16; ++k) *(LAS f32x4*)(at + (k * 64 + lane) * 4) = *(const f32x4*)(src + (k * 64 + lane) * 4);
    lds_fence();
    float r[64];
    unsigned ata = (unsigned)(size_t)at;
#pragma unroll
    for (int j = 63; j >= 0; --j) {
        float acc = lane == j ? 1.f : 0.f;
        LAS const float* arow = (LAS const float*)(size_t)ata + j * 64;
#pragma unroll
        for (int m4 = ((j + 1) & ~3); m4 < 64; m4 += 4) {
            const f32x4 a = *(LAS const f32x4*)(arow + m4);
#pragma unroll
            for (int q = 0; q < 4; ++q) if (m4 + q > j) acc = __builtin_fmaf(-r[m4 + q], a[q], acc);
        }
        r[j] = acc;
        asm volatile("" : "+v"(ata) : "v"(acc));
    }
    unsigned char* blob = (unsigned char*)c.gBlob + (size_t)(h * 256 + n) * BLOB;
#pragma unroll
    for (int k = 0; k < 8; ++k) { float v8[8];
#pragma unroll
        for (int q = 0; q < 8; ++q) v8[q] = r[k * 8 + q];
        *(u32x4*)(blob + B_T + lane * ST64 + k * 16) = pack8(v8); }
}
template <int MODE>
__device__ void gdn_pass(CtxK& c, LAS unsigned char* lds, int h, int g) {
    const int tid = ltid(), wv = __builtin_amdgcn_readfirstlane(tid >> 6), lane = tid & 63, fr = lane & 15, fq = lane >> 4;
    LAS unsigned char* stw = lds + G_ST + wv * 16 * ST128; LAS unsigned char* rvw = lds + G_RV + wv * 16 * ST64;
    LAS float* part = (LAS float*)(lds + G_PART); LAS float* rinv = (LAS float*)(lds + G_RINV);
    f32x4 Sacc[8];
#pragma unroll
    for (int m = 0; m < 8; ++m) {
        if (MODE == 1) { const int v = 16 * wv + fr, d0 = 16 * m + 4 * fq; Sacc[m] = (f32x4){d0 == v ? 1.f : 0.f, d0 + 1 == v ? 1.f : 0.f, d0 + 2 == v ? 1.f : 0.f, d0 + 3 == v ? 1.f : 0.f}; }
        else Sacc[m] = (f32x4){0.f, 0.f, 0.f, 0.f};
    }
    if (MODE == 2 && g > 0) { const f32x4* sp = (const f32x4*)c.gS + (size_t)(h * 32 + g) * FRAG_F4 + (wv * 8) * 64 + lane;
#pragma unroll
        for (int m = 0; m < 8; ++m) Sacc[m] = sp[m * 64]; }
    write_st(stw, Sacc, fr, fq);
    for (int i = 0; i < 8; ++i) {
        const int n = g * 8 + i, T0 = n * 64;
        { const unsigned char* blob = (const unsigned char*)c.gBlob + (size_t)(h * 256 + n) * BLOB; const int tl = ltid();
          for (int o = tl * 16; o < BLOB; o += 512 * 16) *(LAS u32x4*)(lds + o) = *(const u32x4*)(blob + o); }
        __syncthreads();
        const float dlast = *(LAS float*)(lds + B_SC);
        { f32x4 R[4];
#pragma unroll
          for (int m = 0; m < 4; ++m) R[m] = (f32x4){0.f, 0.f, 0.f, 0.f};
          mma_nt<4, 4>(R, lds + B_KBG, ST128, stw, ST128, fr, fq);
#pragma unroll
          for (int m = 0; m < 4; ++m) { float x0 = 0.f, x1 = 0.f, x2 = 0.f, x3 = 0.f;
              if (MODE != 1) { const u32x2 vb = *(LAS u32x2*)(lds + B_VB + (16 * wv + fr) * ST64 + (16 * m + 4 * fq) * 2); x0 = bflo(vb.x); x1 = bfhi(vb.x); x2 = bflo(vb.y); x3 = bfhi(vb.y); }
              u32x2 w; w.x = cvt_pk_bf16(x0 - R[m][0], x1 - R[m][1]); w.y = cvt_pk_bf16(x2 - R[m][2], x3 - R[m][3]);
              *(LAS u32x2*)(rvw + fr * ST64 + (16 * m + 4 * fq) * 2) = w; } }
        lds_fence();
        { f32x4 VN[4];
#pragma unroll
          for (int m = 0; m < 4; ++m) VN[m] = (f32x4){0.f, 0.f, 0.f, 0.f};
          mma_nt<4, 2>(VN, lds + B_T, ST64, rvw, ST64, fr, fq);
          mfma_pad4(VN); lds_fence();
#pragma unroll
          for (int m = 0; m < 4; ++m) { u32x2 w; w.x = cvt_pk_bf16(VN[m][0], VN[m][1]); w.y = cvt_pk_bf16(VN[m][2], VN[m][3]); *(LAS u32x2*)(rvw + fr * ST64 + (16 * m + 4 * fq) * 2) = w; } }
        lds_fence();
        f32x4 O[4];
        if (MODE == 2) {
#pragma unroll
            for (int m = 0; m < 4; ++m) O[m] = (f32x4){0.f, 0.f, 0.f, 0.f};
            mma_nt<4, 4>(O, lds + B_QD, ST128, stw, ST128, fr, fq);
            mma_nt<4, 2>(O, lds + B_AT, ST64, rvw, ST64, fr, fq);
#pragma unroll
            for (int m = 0; m < 4; ++m)
#pragma unroll
                for (int r = 0; r < 4; ++r) { float q = O[m][r] * O[m][r]; q += __shfl_xor(q, 1); q += __shfl_xor(q, 2); q += __shfl_xor(q, 4); q += __shfl_xor(q, 8); if (fr == 0) part[wv * 64 + 16 * m + 4 * fq + r] = q; }
        }
#pragma unroll
        for (int m = 0; m < 8; ++m) Sacc[m] = Sacc[m] * dlast;
        mma_nt<8, 2>(Sacc, lds + B_KU, ST64, rvw, ST64, fr, fq);
        lds_fence();
        write_st(stw, Sacc, fr, fq);
        if (MODE == 2) {
            __syncthreads();
            if (tid < 64) { float s_ = 0.f;
#pragma unroll
                for (int w = 0; w < 8; ++w) s_ += part[w * 64 + tid];
                rinv[tid] = rsqrtf(s_ * (1.f / 128.f) + 1e-6f); }
            __syncthreads();
            const int v = wv * 16 + fr; const float gn = c.gdn_onorm_g[v];
#pragma unroll
            for (int m = 0; m < 4; ++m)
#pragma unroll
                for (int r = 0; r < 4; ++r) { const int cc = 16 * m + 4 * fq + r; const size_t t = (size_t)(T0 + cc);
                    const float o = O[m][r] * rinv[cc] * gn * siluf_(bf2f(c.proj[t * PW + C_GG + h * 128 + v]));
                    c.ocat[t * D + 1024 + h * 128 + v] = (bf16_t)(cvt_pk_bf16(o, o) & 0xffffu); }
        }
        __syncthreads();
    }
    if (MODE == 0) {
        f32x4* sp = (f32x4*)c.gB + (size_t)(h * 32 + g) * FRAG_F4 + (wv * 8) * 64 + lane;
#pragma unroll
        for (int m = 0; m < 8; ++m) sp[m * 64] = Sacc[m];
    }
    if (MODE == 1) {
        mfma_pad8(Sacc);
        LAS bf16_t* img = (LAS bf16_t*)lds;
#pragma unroll
        for (int m = 0; m < 8; ++m)
#pragma unroll
            for (int r = 0; r < 4; ++r) img[(16 * m + 4 * fq + r) * (ST128 / 2) + 16 * wv + fr] = (bf16_t)(cvt_pk_bf16(Sacc[m][r], Sacc[m][r]) & 0xffffu);
        __syncthreads();
        unsigned char* dst = (unsigned char*)c.gM + (size_t)(h * 32 + g) * (128 * ST128);
        for (int o = tid * 16; o < 128 * ST128; o += 512 * 16) *(u32x4*)(dst + o) = *(LAS u32x4*)(lds + o);
        __syncthreads();
    }
}
__device__ void gdn_scan(CtxK& c, LAS unsigned char* lds, int h) {
    const int tid = ltid(), wv = __builtin_amdgcn_readfirstlane(tid >> 6), lane = tid & 63, fr = lane & 15, fq = lane >> 4;
    LAS unsigned char* stw = lds + G_ST + wv * 16 * ST128;
    f32x4 Sacc[8];
#pragma unroll
    for (int m = 0; m < 8; ++m) Sacc[m] = (f32x4){0.f, 0.f, 0.f, 0.f};
    for (int g = 0; g < 31; ++g) {
        const unsigned char* src = (const unsigned char*)c.gM + (size_t)(h * 32 + g) * (128 * ST128);
        for (int o = tid * 16; o < 128 * ST128; o += 512 * 16) *(LAS u32x4*)(lds + o) = *(const u32x4*)(src + o);
        write_st(stw, Sacc, fr, fq);
        const f32x4* bp = (const f32x4*)c.gB + (size_t)(h * 32 + g) * FRAG_F4 + (wv * 8) * 64 + lane;
#pragma unroll
        for (int m = 0; m < 8; ++m) Sacc[m] = bp[m * 64];
        __syncthreads();
        mma_nt<8, 4>(Sacc, lds, ST128, stw, ST128, fr, fq);
        f32x4* sp = (f32x4*)c.gS + (size_t)(h * 32 + g + 1) * FRAG_F4 + (wv * 8) * 64 + lane;
#pragma unroll
        for (int m = 0; m < 8; ++m) sp[m * 64] = Sacc[m];
        __syncthreads();
    }
}
}
__device__ void ph_hgrn1(CtxK& c, LAS unsigned char* lds) { mx::hgrn_pass<false>(c, lds); }
__device__ void ph_hgrn2(CtxK& c, LAS unsigned char* lds) { mx::hgrn_scan(c); }
__device__ void ph_hgrn3(CtxK& c, LAS unsigned char* lds) { mx::hgrn_pass<true>(c, lds); }
__device__ void ph_gdn1(CtxK& c, LAS unsigned char* lds) {
    const int wu = blockIdx.x, h = wu & 7, g = wu >> 3;
    mx::gdn_prep(c, lds, h, g); __syncthreads();
    asm volatile("s_waitcnt vmcnt(0)" ::: "memory"); __syncthreads();
    mx::gdn_invert(c, lds, h, g);
    asm volatile("s_waitcnt vmcnt(0)" ::: "memory"); __syncthreads();
    mx::gdn_pass<0>(c, lds, h, g); __syncthreads();
    mx::gdn_pass<1>(c, lds, h, g); __syncthreads();
}
__device__ void ph_gdn2(CtxK& c, LAS unsigned char* lds) { if (blockIdx.x < 8) mx::gdn_scan(c, lds, blockIdx.x); }
__device__ void ph_gdn3(CtxK& c, LAS unsigned char* lds) { const int wu = blockIdx.x; mx::gdn_pass<2>(c, lds, wu & 7, wu >> 3); }

__device__ __forceinline__ float pair_sum128(float v, LAS float* red) {
    v = wave_sum(v); const int w = ltid() >> 6;
    __syncthreads(); if ((ltid() & 63) == 0) red[w] = v; __syncthreads();
    return red[w & ~1] + red[w | 1];
}
__device__ void ph_gdn_pre(CtxK& c, LAS unsigned char* lds) {
    LAS float* red = (LAS float*)lds;
    const int tid = ltid() & 255, g = ltid() >> 8;
    for (int t = blockIdx.x * 2 + g; t < S; t += gridDim.x * 2) {
        for (int grp = 0; grp < 12; ++grp) {
            const int ch = grp * 256 + tid; float acc = 0.f;
#pragma unroll
            for (int j = 0; j < 4; ++j) { const int tt = t - 3 + j; if (tt >= 0) acc += c.conv_w[j * 3072 + ch] * bf2f(c.proj[(size_t)tt * PW + C_GQKV + ch]); }
            const float val = siluf_(acc);
            if (grp < 8) {
                const float ss = pair_sum128(val * val, red); const float n = val * rsqrtf(ss + 1e-6f);
                if (grp < 4) c.gq[(size_t)t * 1024 + ch] = n * 0.08838834764831845f; else c.gk[(size_t)t * 1024 + ch - 1024] = n;
            } else c.gv[(size_t)t * 1024 + ch - 2048] = val;
        }
        if (tid < 8) {
            const float ga = c.gab[(size_t)t * 16 + tid], gb = c.gab[(size_t)t * 16 + 8 + tid];
            c.gbeta[t * 8 + tid] = sigmoidf_(gb); c.gdec[t * 8 + tid] = expf(-expf(c.a_log[tid]) * softplusf_(ga + c.dt_bias[tid]));
        }
    }
}
__device__ void ph_mix_naive(CtxK& c, LAS unsigned char* lds) {
    constexpr int TB = 8;
    const int wg = blockIdx.x, t512 = ltid(), tid = t512 & 127; const bool ld = t512 < 128, act = t512 < 256;
    const int v = (t512 >> 1) & 127, d0 = (t512 & 1) * 64;
    if (wg < 8 || wg >= 16) return;
    LAS float* sq = (LAS float*)lds; LAS float* sf = sq + TB * 128; LAS float* sk = sf + TB * 128; LAS float* sv = sk + TB * 128; LAS float* sb = sv + TB * 128; LAS float* sa = sb + TB;
    float st[64];
#pragma unroll
    for (int d = 0; d < 64; ++d) st[d] = 0.f;
    if (wg < 8) {
        const int h = wg; const float lbv = c.lb[h * 128 + tid];
        for (int t0 = 0; t0 < S; t0 += TB) {
            if (ld) for (int tt = 0; tt < TB; ++tt) {
                const bf16_t* base = c.proj + (size_t)(t0 + tt) * PW + h * 128 + tid;
                const float f = lbv + (1.f - lbv) * sigmoidf_(bf2f(base[C_HF]));
                sq[tt * 128 + tid] = siluf_(bf2f(base[C_HQ])) * 0.08838834764831845f; sf[tt * 128 + tid] = f; sk[tt * 128 + tid] = 1.f - f; sv[tt * 128 + tid] = bf2f(base[C_HI]);
            }
            __syncthreads();
            if (act) {
#pragma unroll 1
            for (int tt = 0; tt < TB; ++tt) {
                float o = 0.f; const float vv = sv[tt * 128 + v];
#pragma unroll
                for (int d = 0; d < 64; d += 4) {
                    const f32x4 q4 = *(LAS f32x4*)(sq + tt * 128 + d0 + d), f4 = *(LAS f32x4*)(sf + tt * 128 + d0 + d), k4 = *(LAS f32x4*)(sk + tt * 128 + d0 + d);
                    st[d] = f4[0] * st[d] + k4[0] * vv; o += q4[0] * st[d];
                    st[d + 1] = f4[1] * st[d + 1] + k4[1] * vv; o += q4[1] * st[d + 1];
                    st[d + 2] = f4[2] * st[d + 2] + k4[2] * vv; o += q4[2] * st[d + 2];
                    st[d + 3] = f4[3] * st[d + 3] + k4[3] * vv; o += q4[3] * st[d + 3];
                }
                o += __shfl_xor(o, 1);
                if (d0 == 0) c.oa[(size_t)(t0 + tt) * 1024 + h * 128 + v] = o;
            } }
            __syncthreads();
        }
    } else {
        const int h = wg - 8;
        for (int t0 = 0; t0 < S; t0 += TB) {
            if (ld) { for (int tt = 0; tt < TB; ++tt) {
                const size_t o = (size_t)(t0 + tt) * 1024 + h * 128 + tid;
                sq[tt * 128 + tid] = c.gq[o]; sk[tt * 128 + tid] = c.gk[o]; sv[tt * 128 + tid] = c.gv[o];
            }
            if (tid < TB) { sb[tid] = c.gbeta[(t0 + tid) * 8 + h]; sa[tid] = c.gdec[(t0 + tid) * 8 + h]; } }
            __syncthreads();
            if (act) {
#pragma unroll 1
            for (int tt = 0; tt < TB; ++tt) {
                const float a = sa[tt], be = sb[tt]; float kd = 0.f;
#pragma unroll
                for (int d = 0; d < 64; d += 4) { const f32x4 k4 = *(LAS f32x4*)(sk + tt * 128 + d0 + d); kd += k4[0] * st[d] + k4[1] * st[d + 1] + k4[2] * st[d + 2] + k4[3] * st[d + 3]; }
                kd += __shfl_xor(kd, 1);
                const float c1 = be * (sv[tt * 128 + v] - a * kd); float o = 0.f;
#pragma unroll
                for (int d = 0; d < 64; d += 4) {
                    const f32x4 k4 = *(LAS f32x4*)(sk + tt * 128 + d0 + d), q4 = *(LAS f32x4*)(sq + tt * 128 + d0 + d);
                    st[d] = a * st[d] + c1 * k4[0]; o += q4[0] * st[d];
                    st[d + 1] = a * st[d + 1] + c1 * k4[1]; o += q4[1] * st[d + 1];
                    st[d + 2] = a * st[d + 2] + c1 * k4[2]; o += q4[2] * st[d + 2];
                    st[d + 3] = a * st[d + 3] + c1 * k4[3]; o += q4[3] * st[d + 3];
                }
                o += __shfl_xor(o, 1);
                if (d0 == 0) c.ob[(size_t)(t0 + tt) * 1024 + h * 128 + v] = o;
            } }
            __syncthreads();
        }
    }
}
__device__ void ph_onorm(CtxK& c, LAS unsigned char* lds) {
    LAS float* red = (LAS float*)lds;
    const int tid = ltid() & 255, g = ltid() >> 8;
    for (int t = blockIdx.x * 2 + g; t < S; t += gridDim.x * 2) {
        for (int i = 4; i < 8; ++i) {
            const int br = i >> 2, ch = (i & 3) * 256 + tid; const float v = (br ? c.ob : c.oa)[(size_t)t * 1024 + ch];
            const float ss = pair_sum128(v * v, red);
            const float o = v * rsqrtf(ss * (1.f / 128.f) + 1e-6f) * (br ? c.gdn_onorm_g : c.hgrn_onorm_g)[ch & 127] * siluf_(bf2f(c.proj[(size_t)t * PW + (br ? C_GG : C_HG) + ch]));
            const unsigned pk = cvt_pk_bf16(o, o); c.ocat[(size_t)t * D + br * 1024 + ch] = (bf16_t)(pk & 0xffffu);
        }
    }
}
__device__ void ph_router(CtxK& c, LAS unsigned char* lds) {
    const int lane = ltid() & 63, wv = ltid() >> 6;
    const float rb = c.router_bias[lane];
    for (int t = blockIdx.x * 8 + wv; t < S; t += gridDim.x * 8) {
        const float* hr = c.h2f + (size_t)t * D; float acc = 0.f;
        for (int i = 0; i < D; ++i) acc += hr[i] * c.w_router[i * 64 + lane];
        const float s = sigmoidf_(acc), b = s + rb;
        int rk = 0;
#pragma unroll
        for (int x = 1; x < 8; ++x) { const float ob = __shfl_xor(b, x); const int ol = lane ^ x; rk += (ob > b || (ob == b && ol < lane)) ? 1 : 0; }
        float gs = rk < 2 ? b : 0.f; gs += __shfl_xor(gs, 1); gs += __shfl_xor(gs, 2); gs += __shfl_xor(gs, 4);
        int grk = 0;
#pragma unroll
        for (int x = 8; x < 64; x += 8) { const float og = __shfl_xor(gs, x); const int ol = lane ^ x; grk += (og > gs || (og == gs && ol < lane)) ? 1 : 0; }
        float mb = grk < 4 ? b : -INFINITY;
        float wsum = 0.f; int myk = -1;
        for (int k = 0; k < TOPK; ++k) {
            float m = mb;
#pragma unroll
            for (int o = 32; o >= 1; o >>= 1) m = fmaxf(m, __shfl_xor(m, o));
            const unsigned long long bal = __ballot(mb == m); const int win = __ffsll((long long)bal) - 1;
            const float sw = __shfl(s, win); wsum += sw;
            if (lane == win) { mb = -INFINITY; myk = k; }
        }
        if (myk >= 0) { c.idx[t * TOPK + myk] = lane; c.wts[t * TOPK + myk] = s / wsum * 2.5f; }
    }
}
__device__ void ph_count(CtxK& c, LAS unsigned char* lds) {
    LAS int* red = (LAS int*)lds; const int e = blockIdx.x; if (e >= NE) return;
    int n = 0;
    for (int p = ltid(); p < TK; p += 512) n += (c.idx[p] == e) ? 1 : 0;
#pragma unroll
    for (int o = 32; o >= 1; o >>= 1) n += __shfl_xor(n, o);
    if ((ltid() & 63) == 0) red[ltid() >> 6] = n; __syncthreads();
    if (ltid() == 0) { int s_ = 0; for (int i = 0; i < 8; ++i) s_ += red[i]; c.cnt[e] = s_; }
}
__device__ void ph_scatter(CtxK& c, LAS unsigned char* lds) {
    LAS int* wsum = (LAS int*)lds; LAS int* base = wsum + 8;
    const int e = blockIdx.x, tid = ltid(), lane = tid & 63, w = tid >> 6; if (e >= NE) return;
    if (tid == 0) { int o = 0; for (int i = 0; i < e; ++i) o += (c.cnt[i] + 255) & ~255; *base = o; }
    __syncthreads();
    const int ps = *base, ce = c.cnt[e], pe = (ce + 255) & ~255;
    for (int r = ce + tid; r < pe; r += 512) { c.tok_p[ps + r] = 0; c.w_p[ps + r] = 0.f; }
    if (tid < 256) { const int t = e * 256 + tid; c.tok_p[PROUTED + t] = t; c.w_p[PROUTED + t] = 1.f; }
    if (e == 0 && tid == 0) {
        int nb = 0;
        for (int i = 0; i < NE; ++i) { const int nbi = (c.cnt[i] + 255) >> 8; for (int b = 0; b < nbi; ++b) { c.blk_row[nb] = nb * 256; c.blk_exp[nb] = i; ++nb; } }
        for (int b = 0; b < S / 256; ++b) { c.blk_row[nb + b] = PROUTED + b * 256; c.blk_exp[nb + b] = NE; }
        *c.nent = nb + S / 256;
    }
    int run = ps;
    for (int p0 = 0; p0 < TK; p0 += 512) {
        const int p = p0 + tid; const bool f = c.idx[p] == e;
        const unsigned long long bal = __ballot(f); const int pre = __popcll(bal & ((1ull << lane) - 1ull));
        __syncthreads();
        if (lane == 0) wsum[w] = __popcll(bal);
        __syncthreads();
        int wo = 0, tot = 0;
#pragma unroll
        for (int i = 0; i < 8; ++i) { const int x = wsum[i]; wo += i < w ? x : 0; tot += x; }
        if (f) { const int d = run + wo + pre; c.tok_p[d] = p / TOPK; c.w_p[d] = c.wts[p]; c.pos[p] = d; }
        run += tot;
    }
}

constexpr int LDS_MAIN = 147456, LDS_BYTES = LDS_MAIN + 16;
__global__ void __launch_bounds__(512, 2) k_mega(Ctx c) {
    extern __shared__ __attribute__((aligned(16))) unsigned char smem[];
    LAS unsigned char* lds = (LAS unsigned char*)smem;
    if (ltid() == 0) *(LAS u32x4*)(lds + LDS_MAIN) = (u32x4){0u, 0u, 0u, 0u};
    __syncthreads();
    CtxK* kp = (CtxK*)__builtin_amdgcn_kernarg_segment_ptr();
    (void)xcd_barrier_post(c.bar, (volatile LAS unsigned*)(lds + LDS_MAIN));
#define PHASE(fn) do { const CtxK* kp_ = kp; asm volatile("" : "+s"(kp_)); fn(*kp_, lds); __syncthreads(); } while (0)
#define GRID_BARRIER() do { const CtxK* kp_ = kp; asm volatile("" : "+s"(kp_)); XcdBarrier bb_; bb_.bar = kp_->bar; bb_.x = xb_xcc_id(); bb_.st = (volatile LAS unsigned*)(lds + LDS_MAIN); xcd_barrier(bb_); } while (0)
    PHASE(ph_pro1);      GRID_BARRIER();
    PHASE(ph_norm1);     GRID_BARRIER();
    PHASE(ph_gemm1);     GRID_BARRIER();
    PHASE(ph_hgrn1);     PHASE(ph_gdn1);  GRID_BARRIER();
    PHASE(ph_hgrn2);     PHASE(ph_gdn2);  GRID_BARRIER();
    PHASE(ph_hgrn3);     PHASE(ph_gdn3);  GRID_BARRIER();
    PHASE(ph_gemm2);     GRID_BARRIER();
    PHASE(ph_gemm3);     GRID_BARRIER();
    PHASE(ph_norm2);     GRID_BARRIER();
    PHASE(ph_router);    GRID_BARRIER();
    PHASE(ph_count);     GRID_BARRIER();
    PHASE(ph_scatter);   PHASE(ph_cvt_exp); GRID_BARRIER();
    PHASE(ph_moe_gu);    GRID_BARRIER();
    PHASE(ph_moe_dn);    GRID_BARRIER();
    PHASE(ph_final);
#undef PHASE
#undef GRID_BARRIER
}

extern "C" void kernel_launch(void* const* d_in, const int* in_sizes, int n_in, void* d_out, int out_size, void* d_ws, size_t ws_size, hipStream_t stream) {
    Ctx c{};
    const float** ip = (const float**)&c.x;
    for (int i = 0; i < 25; ++i) ip[i] = (const float*)d_in[i];
    c.out = (float*)d_out;
    char* ws = (char*)d_ws; constexpr size_t MB = 1024 * 1024;
    c.bar = (unsigned*)ws;
    c.modp = (float*)(ws + 64 * 1024); c.mod = (float*)(ws + 320 * 1024); c.lb = (float*)(ws + 384 * 1024);
    c.cnt = (int*)(ws + 392 * 1024); c.nent = (int*)(ws + 396 * 1024); c.blk_row = (int*)(ws + 400 * 1024); c.blk_exp = (int*)(ws + 404 * 1024);
    c.idx = (int*)(ws + 1 * MB); c.wts = (float*)(ws + 2 * MB); c.tok_p = (int*)(ws + 3 * MB); c.w_p = (float*)(ws + 4 * MB); c.pos = (int*)(ws + 5 * MB);
    c.gab = (float*)(ws + 6 * MB); c.gbeta = (float*)(ws + 7 * MB + 0); c.gdec = (float*)(ws + 7 * MB + 512 * 1024);
    char* big = ws + 16 * MB;
    size_t o = 0;
    auto take = [&](size_t bytes) { char* p = big + o; o += (bytes + 255) & ~(size_t)255; return p; };
    c.win_t = (bf16_t*)take((size_t)PW * D * 2); c.wa_t = (bf16_t*)take((size_t)D * 1024 * 2); c.wb_t = (bf16_t*)take((size_t)D * 1024 * 2); c.wout_t = (bf16_t*)take((size_t)D * D * 2);
    c.h1 = (bf16_t*)take((size_t)S * D * 2); c.proj = (bf16_t*)take((size_t)S * PW * 2);
    c.ocat = (bf16_t*)take((size_t)S * D * 2); c.merged = (bf16_t*)take((size_t)S * D * 2);
    c.hL = (float*)take((size_t)256 * mx::FRAG_F4 * 16); c.hS = (float*)take((size_t)256 * mx::FRAG_F4 * 16); c.hD = (float*)take((size_t)256 * 128 * 4);
    c.gAT = (float*)take((size_t)2048 * 4096 * 4); c.gB = (float*)take((size_t)256 * mx::FRAG_F4 * 16); c.gS = (float*)take((size_t)256 * mx::FRAG_F4 * 16);
    c.gBlob = (unsigned char*)take((size_t)2048 * mx::BLOB); c.gM = (unsigned char*)take((size_t)256 * 128 * mx::ST128);
    const size_t era1 = o;
    o = 0;
    c.dn_t = (bf16_t*)take((size_t)NEX * D * FF * 2); c.hid = (bf16_t*)take((size_t)PTOT * FF * 2);
    const size_t ybase = o;
    c.gu_t = (bf16_t*)take((size_t)NEX * 1024 * D * 2); c.h2 = (bf16_t*)take((size_t)S * D * 2);
    const size_t after_h2 = o;
    c.Y = (bf16_t*)(big + ybase);
    size_t yend = ybase + (size_t)PTOT * D * 2; if (yend < after_h2) yend = after_h2;
    o = (yend + 255) & ~(size_t)255;
    c.h2f = (float*)take((size_t)S * D * 4);
    const size_t era2 = o;
    const size_t need = 16 * MB + (era1 > era2 ? era1 : era2);
    if (ws_size < need) { fprintf(stderr, "kernel_launch: workspace too small: %zu < %zu\n", ws_size, need); return; }

    static int grid = 0;
    if (!grid) {
        int dev = 0, cus = 0, per_cu = 0;
        hipGetDevice(&dev); hipDeviceGetAttribute(&cus, hipDeviceAttributeMultiprocessorCount, dev);
        hipFuncSetAttribute((const void*)k_mega, hipFuncAttributeMaxDynamicSharedMemorySize, LDS_BYTES);
        hipOccupancyMaxActiveBlocksPerMultiprocessor(&per_cu, (const void*)k_mega, 512, LDS_BYTES);
        if (per_cu < 1) fprintf(stderr, "kernel_launch: occupancy query reports %d blocks per CU\n", per_cu);
        grid = cus;
        if (grid != 256) { fprintf(stderr, "kernel_launch: built for a 256-CU device (token-mixer units = workgroups); got %d CUs\n", cus); grid = -1; }
    }
    if (grid < 0) return;
    hipMemsetAsync(c.bar, 0, XCD_BAR_WORDS * sizeof(unsigned), stream);
    hipLaunchKernelGGL(k_mega, dim3(grid), dim3(512), LDS_BYTES, stream, c);
}
```

```cpp
#include <hip/hip_runtime.h>
#include <stdint.h>
#include <stdio.h>

#define LAS __attribute__((address_space(3)))
typedef unsigned short bf16_t;
typedef short bf16x8 __attribute__((ext_vector_type(8)));
typedef float f32x4 __attribute__((ext_vector_type(4)));
typedef unsigned u32x4 __attribute__((ext_vector_type(4)));
typedef unsigned u32x2 __attribute__((ext_vector_type(2)));

constexpr int S = 16384, D = 2048, INW = 12304, PW = 12288, NE = 64, TOPK = 8, TK = S * TOPK, FF = 512;
constexpr int NEX = NE + 1;
constexpr int PROUTED = 147456, PTOT = PROUTED + S, NBLK_MAX = PROUTED / 256;
constexpr int C_HQ = 0, C_HF = 1024, C_HI = 2048, C_HG = 3072, C_GQKV = 4096, C_GG = 7168, C_MGA = 8192, C_MGB = 10240;
constexpr int WIN_GAB = 7168;

__device__ __forceinline__ float sigmoidf_(float x) { return 1.f / (1.f + __expf(-x)); }
__device__ __forceinline__ float siluf_(float x) { return x / (1.f + __expf(-x)); }
__device__ __forceinline__ float softplusf_(float x) { return x > 20.f ? x : log1pf(expf(x)); }
__device__ __forceinline__ float bf2f(bf16_t b) { return __uint_as_float(((unsigned)b) << 16); }
__device__ __forceinline__ float bflo(unsigned w) { return __uint_as_float(w << 16); }
__device__ __forceinline__ float bfhi(unsigned w) { return __uint_as_float(w & 0xffff0000u); }
__device__ __forceinline__ unsigned cvt_pk_bf16(float lo, float hi) { unsigned r; asm volatile("v_cvt_pk_bf16_f32 %0, %1, %2" : "=v"(r) : "v"(lo), "v"(hi)); return r; }
__device__ __forceinline__ int ltid() { int t = threadIdx.x; asm volatile("" : "+v"(t)); return t; }
__device__ __forceinline__ float wave_sum(float v) {
#pragma unroll
    for (int o = 32; o >= 1; o >>= 1) v += __shfl_xor(v, o);
    return v;
}


#define XB_TMO      128
#define XB_XCNT(j)  (256  + 64 * (j))
#define XB_XSUB(j)  (1280 + 64 * (j))
#define XB_XGEN(j)  (2304 + 64 * (j))
#define XB_TOP      3328
#define XB_TOPGEN   3392
#define XCD_BAR_WORDS 3456
#define XB_SPIN_CAP (1u << 18)
__device__ __forceinline__ unsigned xb_ld(unsigned* p)              { return __hip_atomic_load(p, __ATOMIC_RELAXED, __HIP_MEMORY_SCOPE_AGENT); }
__device__ __forceinline__ unsigned xb_add(unsigned* p, unsigned v) { return __hip_atomic_fetch_add(p, v, __ATOMIC_RELAXED, __HIP_MEMORY_SCOPE_AGENT); }
__device__ __forceinline__ unsigned xb_xcc_id() { return (unsigned)__builtin_amdgcn_s_getreg((3 << 11) | 20) & 0xFu; }
#define XB_SPIN(cond, bar) do { unsigned _sp = 0; while (cond) { __builtin_amdgcn_s_sleep(1); \
    if ((++_sp & 255u) == 0u) { if (xb_ld(&(bar)[XB_TMO])) break; if (_sp > XB_SPIN_CAP) { atomicAdd(&(bar)[XB_TMO], 1u); break; } } } } while (0)
struct XcdBarrier { unsigned* bar; unsigned x; volatile LAS unsigned* st; };
__device__ __forceinline__ XcdBarrier xcd_barrier_post(unsigned* bar, volatile LAS unsigned* st) {
    XcdBarrier b; b.bar = bar; b.x = xb_xcc_id(); b.st = st;
    if (threadIdx.x == 0) (void)xb_add(&bar[XB_XCNT(b.x)], 1u);
    return b;
}
__device__ __forceinline__ void xcd_barrier_complete(unsigned* bar, unsigned x, unsigned& nloc, unsigned& nx) {
    const unsigned G = gridDim.x * gridDim.y * gridDim.z;
    unsigned sum, cnt, mine, sp = 0u;
    for (;;) {
        sum = 0u; cnt = 0u; mine = 0u;
#pragma unroll
        for (unsigned j = 0; j < 16; ++j) { const unsigned c = xb_ld(&bar[XB_XCNT(j)]); sum += c; cnt += (c > 0u) ? 1u : 0u; mine = (j == x) ? c : mine; }
        if (sum == G) break;
        __builtin_amdgcn_s_sleep(1);
        if ((++sp & 255u) == 0u) { if (xb_ld(&bar[XB_TMO])) break; if (sp > XB_SPIN_CAP) { atomicAdd(&bar[XB_TMO], 1u); break; } }
    }
    nloc = mine > 0u ? mine : 1u; nx = cnt > 0u ? cnt : 1u;
}
__device__ __forceinline__ void xcd_barrier(const XcdBarrier& b) {
    asm volatile("s_waitcnt vmcnt(0)" ::: "memory");
    __syncthreads();
    if (threadIdx.x == 0) {
        unsigned* bar = b.bar;
        __builtin_amdgcn_s_waitcnt(0);
        unsigned nloc = b.st[0], nx = b.st[1];
        if (nloc == 0u) { xcd_barrier_complete(bar, b.x, nloc, nx); b.st[0] = nloc; b.st[1] = nx; }
        const unsigned old = xb_add(&bar[XB_XSUB(b.x)], 1u);
        const unsigned gen = old / nloc;
        if (old + 1u == (gen + 1u) * nloc) {
            __builtin_amdgcn_fence(__ATOMIC_RELEASE, "agent");
            asm volatile("s_waitcnt vmcnt(0)" ::: "memory");
            const unsigned og = xb_add(&bar[XB_TOP], 1u);
            const unsigned tg = og / nx;
            if (og + 1u == (tg + 1u) * nx) xb_add(&bar[XB_TOPGEN], 1u);
            else XB_SPIN(xb_ld(&bar[XB_TOPGEN]) == tg, bar);
            __builtin_amdgcn_fence(__ATOMIC_ACQUIRE, "agent");
            xb_add(&bar[XB_XGEN(b.x)], 1u);
            asm volatile("s_waitcnt vmcnt(0)" ::: "memory");
        } else {
            XB_SPIN(xb_ld(&bar[XB_XGEN(b.x)]) == gen, bar);
            __builtin_amdgcn_fence(__ATOMIC_ACQUIRE, "agent");
            asm volatile("s_waitcnt vmcnt(0)" ::: "memory");
        }
    }
    __syncthreads();
}

namespace gm {
constexpr int BM = 256, BK = 64, HALF = 128, HTB = HALF * BK * 2, STAGE_BYTES = 8 * HTB;
__host__ __device__ __forceinline__ int lds_byte(int r, int c) { const int st = (r >> 4) * 2 + (c >> 5), rr = r & 15, cc = c & 31, ob = rr * 64 + cc * 2; return st * 1024 + (ob ^ (((ob >> 9) & 1) << 5)); }
__host__ __device__ __forceinline__ void stage_rc(int b, int& R, int& C) { const int st = b / 1024, sb = b % 1024, swz = sb ^ (((sb >> 9) & 1) << 5); R = (st >> 1) * 16 + swz / 64; C = (st & 1) * 32 + (swz % 64) / 2; }
__host__ __device__ __forceinline__ int perm32(int rho) { const int n = rho >> 4, i = rho & 15; return 8 * (i >> 2) + 4 * n + (i & 3); }

struct Unit { int pm, pn, aux; const char* Bp; unsigned a00, a01, a10, a11; };

template <class Epi, class Sched>
__device__ __forceinline__ void gphase(LAS unsigned char* lds, const char* Abase, const int K, Sched& S, Epi& E) {
    const int tid = ltid(), wid = __builtin_amdgcn_readfirstlane(tid >> 6), lane = tid & 63, wr = wid >> 2, wc = wid & 3, fr = lane & 15, fq = lane >> 4;
    const int nt = K / BK;
    unsigned voffB[2];
#pragma unroll
    for (int i = 0; i < 2; ++i) { int R, C; stage_rc(tid * 16 + i * 8192, R, C); const int Rb = Epi::PERM ? ((R & ~31) + perm32(R & 31)) : R; voffB[i] = (unsigned)(Rb * K + C) * 2u; }
    const size_t hstepB = (size_t)HALF * K * 2;
    const unsigned ldsw = (unsigned)wid * 1024u;
    const int aoff = lds_byte(wr * 64 + fr, fq * 8), boff = lds_byte(wc * 32 + fr, fq * 8);
#define G_SA(b, h) (((b) * 2 + (h)) * HTB)
#define G_SB(b, h) ((4 + (b) * 2 + (h)) * HTB)
#define G_STAGE_A(bufoff, o0, o1, kb) do { \
        __builtin_amdgcn_global_load_lds((const unsigned*)(Abase + (o0) + (kb)), (LAS unsigned*)(lds + (bufoff) + ldsw), 16, 0, 0); \
        __builtin_amdgcn_global_load_lds((const unsigned*)(Abase + (o1) + (kb)), (LAS unsigned*)(lds + (bufoff) + ldsw + 8192), 16, 0, 0); } while (0)
#define G_STAGE_B(bufoff, bp, kb) do { \
        __builtin_amdgcn_global_load_lds((const unsigned*)((bp) + voffB[0] + (kb)), (LAS unsigned*)(lds + (bufoff) + ldsw), 16, 0, 0); \
        __builtin_amdgcn_global_load_lds((const unsigned*)((bp) + voffB[1] + (kb)), (LAS unsigned*)(lds + (bufoff) + ldsw + 8192), 16, 0, 0); } while (0)
#define G_LDA(dst, b, h) do { _Pragma("unroll") for (int m = 0; m < 4; ++m) _Pragma("unroll") for (int k = 0; k < 2; ++k) dst[m][k] = *(const LAS bf16x8*)(lds + G_SA(b, h) + aoff + m * 2048 + k * 1024); } while (0)
#define G_LDB(dst, b, h) do { _Pragma("unroll") for (int n = 0; n < 2; ++n) _Pragma("unroll") for (int k = 0; k < 2; ++k) dst[n][k] = *(const LAS bf16x8*)(lds + G_SB(b, h) + boff + n * 2048 + k * 1024); } while (0)
#define G_MMA(ai, bj, At, Bt) do { __builtin_amdgcn_s_setprio(1); _Pragma("unroll") for (int m = 0; m < 4; ++m) _Pragma("unroll") for (int n = 0; n < 2; ++n) _Pragma("unroll") for (int k = 0; k < 2; ++k) \
        acc[ai][bj][m][n] = __builtin_amdgcn_mfma_f32_16x16x32_bf16(Bt[n][k], At[m][k], acc[ai][bj][m][n], 0, 0, 0); __builtin_amdgcn_s_setprio(0); } while (0)
#define G_WAIT_V(n) asm volatile("s_waitcnt vmcnt(" #n ")" ::: "memory")
#define G_WAIT_L(n) asm volatile("s_waitcnt lgkmcnt(" #n ")" ::: "memory")
#define G_BAR __builtin_amdgcn_s_barrier()
#define G_SCHED __builtin_amdgcn_sched_barrier(0)
#define G_ZERO() do { _Pragma("unroll") for (int a = 0; a < 2; ++a) _Pragma("unroll") for (int b = 0; b < 2; ++b) _Pragma("unroll") for (int m = 0; m < 4; ++m) _Pragma("unroll") for (int n = 0; n < 2; ++n) acc[a][b][m][n] = (f32x4){0.f, 0.f, 0.f, 0.f}; } while (0)
    Unit cur, nxt; int ui = 0;
    if (!S.next(0, cur)) return;
    f32x4 acc[2][2][4][2];
    G_ZERO();
    bf16x8 At[4][2], B0[2][2], B1[2][2];
    G_STAGE_B(G_SB(0, 0), cur.Bp, 0); G_STAGE_B(G_SB(0, 1), cur.Bp + hstepB, 0); G_STAGE_A(G_SA(0, 0), cur.a00, cur.a01, 0); G_STAGE_A(G_SA(0, 1), cur.a10, cur.a11, 0);
    if (wr == 1) G_BAR;
    G_WAIT_V(2); G_BAR;
    G_STAGE_B(G_SB(1, 0), cur.Bp, 128); G_STAGE_A(G_SA(1, 0), cur.a00, cur.a01, 128); G_STAGE_B(G_SB(1, 1), cur.Bp + hstepB, 128);
    G_WAIT_V(6); G_BAR;
    for (;;) {
        const bool has_next = S.next(ui + 1, nxt);
        if (!has_next) nxt = cur;
        for (int t = 0; t < nt; t += 2) {
            const bool last = (t == nt - 2);
            const size_t kb1 = (size_t)(t + 1) * 128, kb2 = last ? 0 : (size_t)(t + 2) * 128, kb3 = kb2 + 128;
            const char* b2 = last ? nxt.Bp : cur.Bp;
            const unsigned x00 = last ? nxt.a00 : cur.a00, x01 = last ? nxt.a01 : cur.a01, x10 = last ? nxt.a10 : cur.a10, x11 = last ? nxt.a11 : cur.a11;
            G_LDB(B0, 0, 0); G_LDB(B1, 0, 1); G_SCHED; G_LDA(At, 0, 0); G_STAGE_A(G_SA(1, 1), cur.a10, cur.a11, kb1);
            G_WAIT_V(8); G_WAIT_L(0); G_BAR; G_MMA(0, 0, At, B0); G_MMA(0, 1, At, B1); G_BAR; G_SCHED;
            G_LDA(At, 0, 1); G_STAGE_B(G_SB(0, 0), b2, kb2); G_STAGE_B(G_SB(0, 1), b2 + hstepB, kb2); G_STAGE_A(G_SA(0, 0), x00, x01, kb2);
            G_WAIT_V(8); G_WAIT_L(0); G_BAR; G_MMA(1, 0, At, B0); G_MMA(1, 1, At, B1); G_BAR; G_SCHED;
            G_LDB(B0, 1, 0); G_LDB(B1, 1, 1); G_SCHED; G_LDA(At, 1, 0); G_STAGE_A(G_SA(0, 1), x10, x11, kb2);
            G_WAIT_V(8); G_WAIT_L(0); G_BAR; G_MMA(0, 0, At, B0); G_MMA(0, 1, At, B1); G_BAR; G_SCHED;
            G_LDA(At, 1, 1); G_STAGE_B(G_SB(1, 0), b2, kb3); G_STAGE_B(G_SB(1, 1), b2 + hstepB, kb3); G_STAGE_A(G_SA(1, 0), x00, x01, kb3);
            G_WAIT_V(8); G_WAIT_L(0); G_BAR; G_MMA(1, 0, At, B0); G_MMA(1, 1, At, B1); G_BAR; G_SCHED;
        }
        if (wr == 0) G_BAR;
        E(acc, cur, wr, wc, fr, fq);
        if (!has_next) break;
        if (!E.keep(cur)) G_ZERO();
        cur = nxt; ++ui;
        if (wr == 1) G_BAR;
    }
    G_WAIT_V(0);
    G_BAR;
#undef G_SA
#undef G_SB
#undef G_STAGE_A
#undef G_STAGE_B
#undef G_LDA
#undef G_LDB
#undef G_MMA
#undef G_WAIT_V
#undef G_WAIT_L
#undef G_BAR
#undef G_SCHED
#undef G_ZERO
}

struct DenseSched {
    int nM, nN, nwg, G, c, lda, K, parts; const char* Bt; const char* Bt2; int R0, C0, R1, C1;
    __device__ void init(int M, int N, int K_, int lda_, const void* Bt_, const void* Bt2_, int parts_) {
        nM = M / BM; nN = N / BM; nwg = nM * nN; G = gridDim.x; c = blockIdx.x; lda = lda_; K = K_; Bt = (const char*)Bt_; Bt2 = (const char*)Bt2_; parts = parts_;
        stage_rc(ltid() * 16, R0, C0); stage_rc(ltid() * 16 + 8192, R1, C1);
    }
    __device__ bool next(int i, Unit& u) const {
        const int ti = parts == 2 ? (i >> 1) : i, part = parts == 2 ? (i & 1) : 0;
        const long L = (long)ti * G + c; if (L >= nwg) return false;
        int wgid = (int)L; { const int q = nwg / 8, r = nwg % 8, xcd = wgid % 8, off = wgid / 8; wgid = (xcd < r ? xcd * (q + 1) : r * (q + 1) + (xcd - r) * q) + off; }
        const int nig = 8 * nN, gid = wgid / nig, fm = gid * 8, gsz = (nM - fm) < 8 ? (nM - fm) : 8;
        u.pm = fm + ((wgid % nig) % gsz); u.pn = (wgid % nig) / gsz; u.aux = part;
        u.Bp = (part ? Bt2 : Bt) + (size_t)u.pn * BM * K * 2;
        const unsigned rb = (unsigned)u.pm * BM, po = part ? (unsigned)K * 2u : 0u;
        u.a00 = ((rb + R0) * lda + C0) * 2u + po; u.a01 = ((rb + R1) * lda + C1) * 2u + po;
        u.a10 = ((rb + HALF + R0) * lda + C0) * 2u + po; u.a11 = ((rb + HALF + R1) * lda + C1) * 2u + po;
        return true;
    }
};
template <bool GATHER>
struct MoeSched {
    int nN, G, c, K, lda, nent; const int* blk_row; const int* blk_exp; const int* tok_p; const char* W; size_t wstride; int R0, C0, R1, C1;
    __device__ void init(int nN_, int K_, int lda_, const int* nent_p, const int* blk_row_, const int* blk_exp_, const int* tok_p_, const void* W_, size_t wstride_) {
        nN = nN_; G = gridDim.x; c = blockIdx.x; K = K_; lda = lda_; nent = *nent_p; blk_row = blk_row_; blk_exp = blk_exp_; tok_p = tok_p_; W = (const char*)W_; wstride = wstride_;
        stage_rc(ltid() * 16, R0, C0); stage_rc(ltid() * 16 + 8192, R1, C1);
    }
    __device__ bool next(int i, Unit& u) const {
        const long L = (long)i * G + c; if (L >= (long)nent * nN) return false;
        const int ent = (int)(L / nN); u.pn = (int)(L % nN);
        const int rb = blk_row[ent], e = blk_exp[ent]; u.pm = rb; u.aux = e;
        u.Bp = W + (size_t)e * wstride + (size_t)u.pn * BM * K * 2;
        if (GATHER) {
            const unsigned t00 = tok_p[rb + R0], t01 = tok_p[rb + R1], t10 = tok_p[rb + HALF + R0], t11 = tok_p[rb + HALF + R1];
            u.a00 = (t00 * lda + C0) * 2u; u.a01 = (t01 * lda + C1) * 2u; u.a10 = (t10 * lda + C0) * 2u; u.a11 = (t11 * lda + C1) * 2u;
        } else {
            u.a00 = ((unsigned)(rb + R0) * lda + C0) * 2u; u.a01 = ((unsigned)(rb + R1) * lda + C1) * 2u;
            u.a10 = ((unsigned)(rb + HALF + R0) * lda + C0) * 2u; u.a11 = ((unsigned)(rb + HALF + R1) * lda + C1) * 2u;
        }
        return true;
    }
};

struct EpiProj {
    static constexpr bool PERM = true; bf16_t* O;
    __device__ __forceinline__ bool keep(const Unit&) const { return false; }
    __device__ __forceinline__ void operator()(f32x4 (&acc)[2][2][4][2], const Unit& u, int wr, int wc, int fr, int fq) const {
        const int row0 = u.pm * BM + wr * 64 + fr, col0 = u.pn * BM + wc * 32 + 8 * fq;
#pragma unroll
        for (int ai = 0; ai < 2; ++ai)
#pragma unroll
            for (int m = 0; m < 4; ++m) { bf16_t* rowp = O + (size_t)(row0 + ai * HALF + m * 16) * PW + col0;
#pragma unroll
                for (int bj = 0; bj < 2; ++bj) { const f32x4 v0 = acc[ai][bj][m][0], v1 = acc[ai][bj][m][1]; u32x4 w;
                    w.x = cvt_pk_bf16(v0[0], v0[1]); w.y = cvt_pk_bf16(v0[2], v0[3]); w.z = cvt_pk_bf16(v1[0], v1[1]); w.w = cvt_pk_bf16(v1[2], v1[3]);
                    *(u32x4*)(rowp + bj * HALF) = w; } }
    }
};
struct EpiMerge {
    static constexpr bool PERM = true; const bf16_t* proj; bf16_t* O;
    __device__ __forceinline__ bool keep(const Unit& u) const { return u.aux == 0; }
    __device__ __forceinline__ void operator()(f32x4 (&acc)[2][2][4][2], const Unit& u, int wr, int wc, int fr, int fq) const {
        const int row0 = u.pm * BM + wr * 64 + fr, col0 = u.pn * BM + wc * 32 + 8 * fq;
#pragma unroll
        for (int ai = 0; ai < 2; ++ai)
#pragma unroll
            for (int m = 0; m < 4; ++m) { const size_t r = (size_t)(row0 + ai * HALF + m * 16);
#pragma unroll
                for (int bj = 0; bj < 2; ++bj) {
                    const u32x4 gb = *(const u32x4*)(proj + r * PW + C_MGB + col0 + bj * HALF);
                    const f32x4 eb0 = {__expf(-bflo(gb.x)), __expf(-bfhi(gb.x)), __expf(-bflo(gb.y)), __expf(-bfhi(gb.y))};
                    const f32x4 eb1 = {__expf(-bflo(gb.z)), __expf(-bfhi(gb.z)), __expf(-bflo(gb.w)), __expf(-bfhi(gb.w))};
                    if (u.aux == 0) {
                        const u32x4 ga = *(const u32x4*)(proj + r * PW + C_MGA + col0 + bj * HALF);
                        const f32x4 ea0 = {__expf(-bflo(ga.x)), __expf(-bfhi(ga.x)), __expf(-bflo(ga.y)), __expf(-bfhi(ga.y))};
                        const f32x4 ea1 = {__expf(-bflo(ga.z)), __expf(-bfhi(ga.z)), __expf(-bflo(ga.w)), __expf(-bfhi(ga.w))};
                        acc[ai][bj][m][0] = acc[ai][bj][m][0] * (1.f + eb0) / (1.f + ea0); acc[ai][bj][m][1] = acc[ai][bj][m][1] * (1.f + eb1) / (1.f + ea1);
                    } else {
                        const f32x4 v0 = acc[ai][bj][m][0] / (1.f + eb0), v1 = acc[ai][bj][m][1] / (1.f + eb1);
                        u32x4 w; w.x = cvt_pk_bf16(v0[0], v0[1]); w.y = cvt_pk_bf16(v0[2], v0[3]); w.z = cvt_pk_bf16(v1[0], v1[1]); w.w = cvt_pk_bf16(v1[2], v1[3]);
                        *(u32x4*)(O + r * D + col0 + bj * HALF) = w;
                    } } }
    }
};
struct EpiResid {
    static constexpr bool PERM = false; const float* x; const float* gt; float* O;
    __device__ __forceinline__ bool keep(const Unit&) const { return false; }
    __device__ __forceinline__ void operator()(f32x4 (&acc)[2][2][4][2], const Unit& u, int wr, int wc, int fr, int fq) const {
        const int row0 = u.pm * BM + wr * 64 + fr, col0 = u.pn * BM + wc * 32 + 4 * fq;
        f32x4 g[2][2];
#pragma unroll
        for (int bj = 0; bj < 2; ++bj)
#pragma unroll
            for (int n = 0; n < 2; ++n) g[bj][n] = *(const f32x4*)(gt + col0 + bj * HALF + n * 16);
#pragma unroll
        for (int ai = 0; ai < 2; ++ai)
#pragma unroll
            for (int m = 0; m < 4; ++m) { const size_t ro = (size_t)(row0 + ai * HALF + m * 16) * D + col0;
#pragma unroll
                for (int bj = 0; bj < 2; ++bj)
#pragma unroll
                    for (int n = 0; n < 2; ++n) { const f32x4 xv = *(const f32x4*)(x + ro + bj * HALF + n * 16); *(f32x4*)(O + ro + bj * HALF + n * 16) = xv + g[bj][n] * acc[ai][bj][m][n]; } }
    }
};
struct EpiSwiglu {
    static constexpr bool PERM = true; bf16_t* hid;
    __device__ __forceinline__ bool keep(const Unit&) const { return false; }
    __device__ __forceinline__ void operator()(f32x4 (&acc)[2][2][4][2], const Unit& u, int wr, int wc, int fr, int fq) const {
        const int row0 = u.pm + wr * 64 + fr, j0 = u.pn * 128 + wc * 16 + 4 * fq;
#pragma unroll
        for (int ai = 0; ai < 2; ++ai)
#pragma unroll
            for (int m = 0; m < 4; ++m) { bf16_t* rowp = hid + (size_t)(row0 + ai * HALF + m * 16) * FF + j0;
#pragma unroll
                for (int bj = 0; bj < 2; ++bj) { const f32x4 g = acc[ai][bj][m][0], up = acc[ai][bj][m][1]; u32x2 w;
                    w.x = cvt_pk_bf16(siluf_(g[0]) * up[0], siluf_(g[1]) * up[1]); w.y = cvt_pk_bf16(siluf_(g[2]) * up[2], siluf_(g[3]) * up[3]);
                    *(u32x2*)(rowp + bj * 64) = w; } }
    }
};
struct EpiDown {
    static constexpr bool PERM = true; bf16_t* Y; const float* w_p;
    __device__ __forceinline__ bool keep(const Unit&) const { return false; }
    __device__ __forceinline__ void operator()(f32x4 (&acc)[2][2][4][2], const Unit& u, int wr, int wc, int fr, int fq) const {
        const int row0 = u.pm + wr * 64 + fr, col0 = u.pn * BM + wc * 32 + 8 * fq;
#pragma unroll
        for (int ai = 0; ai < 2; ++ai)
#pragma unroll
            for (int m = 0; m < 4; ++m) { const int r = row0 + ai * HALF + m * 16; const float wt = w_p[r]; bf16_t* rowp = Y + (size_t)r * D + col0;
#pragma unroll
                for (int bj = 0; bj < 2; ++bj) { const f32x4 v0 = acc[ai][bj][m][0] * wt, v1 = acc[ai][bj][m][1] * wt; u32x4 w;
                    w.x = cvt_pk_bf16(v0[0], v0[1]); w.y = cvt_pk_bf16(v0[2], v0[3]); w.z = cvt_pk_bf16(v1[0], v1[1]); w.w = cvt_pk_bf16(v1[2], v1[3]);
                    *(u32x4*)(rowp + bj * HALF) = w; } }
    }
};
}

struct Ctx {
    const float *x, *c, *w_ada, *b_ada, *norm1_g, *norm2_g, *w_in, *lb_table, *hgrn_onorm_g, *conv_w, *a_log, *dt_bias, *gdn_onorm_g, *w_bh, *w_bg, *w_out, *w_router, *router_bias,
        *w_eg, *w_eu, *w_ed, *w_sg, *w_su, *w_sd, *normf_g;
    float* out;
    unsigned* bar;
    float *modp, *mod, *lb, *gab;
    int *idx, *cnt, *tok_p, *pos, *blk_row, *blk_exp, *nent;
    float *wts, *w_p;
    bf16_t *win_t, *wa_t, *wb_t, *wout_t, *h1, *proj, *ocat, *merged;
    float *gq, *gk, *gv, *gbeta, *gdec, *oa, *ob;
    float *hL, *hS, *hD;
    float *gAT, *gB, *gS; unsigned char *gBlob, *gM;
    bf16_t *dn_t, *hid, *gu_t, *h2, *Y;
    bf16_t* rwimg; float* rbias2; int *tile_cnt, *rnk;
};

typedef const __attribute__((address_space(4))) Ctx CtxK;

__device__ __forceinline__ void cvt_tile(LAS float* t, const float* srcA, const float* srcB, int ld, int mode, bf16_t* dst, int ldd) {
    const int tid = ltid(), kr = tid >> 6, cl = tid & 63;
    const float* sp = (mode == 1 && cl >= 32) ? (srcB + cl - 32) : (srcA + cl);
    float v[8];
#pragma unroll
    for (int p = 0; p < 8; ++p) v[p] = sp[(size_t)(p * 8 + kr) * ld];
    __syncthreads();
#pragma unroll
    for (int p = 0; p < 8; ++p) t[(p * 8 + kr) * 65 + cl] = v[p];
    __syncthreads();
    const int r = tid >> 3, seg = (tid & 7) * 8;
    const int lc = mode == 1 ? (((r >> 2) & 1) * 32 + 4 * (r >> 3) + (r & 3)) : r;
    float w[8];
#pragma unroll
    for (int j = 0; j < 8; ++j) w[j] = t[(seg + j) * 65 + lc];
    u32x4 o; o.x = cvt_pk_bf16(w[0], w[1]); o.y = cvt_pk_bf16(w[2], w[3]); o.z = cvt_pk_bf16(w[4], w[5]); o.w = cvt_pk_bf16(w[6], w[7]);
    *(u32x4*)(dst + (size_t)r * ldd + seg) = o;
}
__device__ __forceinline__ void cvt_job(LAS float* t, int tile, const float* src, int ld, int K, bf16_t* dst) {
    const int nkt = K / 64, nt = tile / nkt, kt = tile % nkt;
    cvt_tile(t, src + (size_t)kt * 64 * ld + nt * 64, nullptr, ld, 0, dst + (size_t)nt * 64 * K + kt * 64, K);
}

__device__ void ph_pro1(CtxK& c, LAS unsigned char* lds) {
    const int tid = ltid(), wg = blockIdx.x, G = gridDim.x;
    LAS float* lf = (LAS float*)lds;
    for (int job = wg; job < 192; job += G) {
        const int cc = job % 48, kp = job / 48, q = tid & 63, rg = tid >> 6;
        f32x4 a = {0.f, 0.f, 0.f, 0.f};
        for (int r = rg; r < 512; r += 8) { const int k = kp * 512 + r; const float s = siluf_(c.c[k]); a += s * *(const f32x4*)(c.w_ada + (size_t)k * (6 * D) + cc * 256 + q * 4); }
        __syncthreads();
        *(LAS f32x4*)(lf + (rg * 64 + q) * 4) = a;
        __syncthreads();
        if (tid < 64) { f32x4 s = {0.f, 0.f, 0.f, 0.f};
#pragma unroll
            for (int g = 0; g < 8; ++g) s += *(LAS f32x4*)(lf + (g * 64 + tid) * 4);
            *(f32x4*)(c.modp + (size_t)kp * (6 * D) + cc * 256 + tid * 4) = s; }
    }
    if (wg == G - 1) for (int j = tid; j < 1024; j += 512) c.lb[j] = 1.f / (1.f + expf(c.lb_table[1024 + j] - c.lb_table[j]));
    for (int T = wg; T < 8192; T += G) {
        if (T < 6144) { const int nt = T / 32, kt = T % 32; const int sc = nt * 64 + (nt * 64 >= WIN_GAB ? 16 : 0);
            cvt_tile(lf, c.w_in + (size_t)kt * 64 * INW + sc, nullptr, INW, 0, c.win_t + (size_t)nt * 64 * D + kt * 64, D); }
        else if (T < 6656) cvt_job(lf, T - 6144, c.w_bh, D, 1024, c.wa_t);
        else if (T < 7168) cvt_job(lf, T - 6656, c.w_bg, D, 1024, c.wb_t);
        else cvt_job(lf, T - 7168, c.w_out, D, 2048, c.wout_t);
    }
}
__device__ void ph_norm1(CtxK& c, LAS unsigned char* lds) {
    const int tid = ltid(), wg = blockIdx.x, G = gridDim.x, lane = tid & 63, wv = tid >> 6;
    LAS float* la = (LAS float*)lds;
    LAS float* lb_ = la + D;
    LAS float* lw = lb_ + D;
    for (int j = tid; j < D; j += 512) {
        float sh = c.b_ada[j], sc = c.b_ada[D + j];
#pragma unroll
        for (int p = 0; p < 4; ++p) { sh += c.modp[(size_t)p * 6 * D + j]; sc += c.modp[(size_t)p * 6 * D + D + j]; }
        la[j] = c.norm1_g[j] * (1.f + sc); lb_[j] = sh;
    }
    for (int j = wg * 512 + tid; j < 6 * D; j += G * 512) { float m = c.b_ada[j];
#pragma unroll
        for (int p = 0; p < 4; ++p) m += c.modp[(size_t)p * 6 * D + j];
        c.mod[j] = m; }
    for (int i = tid; i < D * 4; i += 512) { const int e = i >> 2, q = i & 3; const f32x4 w = *(const f32x4*)(c.w_in + (size_t)e * INW + WIN_GAB + q * 4);
        lw[(q * 4 + 0) * D + e] = w[0]; lw[(q * 4 + 1) * D + e] = w[1]; lw[(q * 4 + 2) * D + e] = w[2]; lw[(q * 4 + 3) * D + e] = w[3]; }
    __syncthreads();
    for (int row = wg * 8 + wv; row < S; row += G * 8) {
        const float* xr = c.x + (size_t)row * D; f32x4 v[8]; float ss = 0.f;
#pragma unroll
        for (int i = 0; i < 8; ++i) { v[i] = *(const f32x4*)(xr + i * 256 + lane * 4); ss += v[i][0] * v[i][0] + v[i][1] * v[i][1] + v[i][2] * v[i][2] + v[i][3] * v[i][3]; }
        ss = wave_sum(ss); const float r = rsqrtf(ss * (1.f / D) + 1e-6f);
#pragma unroll
        for (int i = 0; i < 8; ++i) { const int e = i * 256 + lane * 4; const f32x4 a = *(LAS f32x4*)(la + e), b = *(LAS f32x4*)(lb_ + e); v[i] = v[i] * r * a + b;
            u32x2 w; w.x = cvt_pk_bf16(v[i][0], v[i][1]); w.y = cvt_pk_bf16(v[i][2], v[i][3]); *(u32x2*)(c.h1 + (size_t)row * D + e) = w; }
        float mine = 0.f;
        for (int cc = 0; cc < 16; ++cc) { float d = 0.f;
#pragma unroll
            for (int i = 0; i < 8; ++i) { const f32x4 w = *(LAS f32x4*)(lw + cc * D + i * 256 + lane * 4); d += v[i][0] * w[0] + v[i][1] * w[1] + v[i][2] * w[2] + v[i][3] * w[3]; }
            d = wave_sum(d); if (lane == cc) mine = d; }
        if (lane < 16) c.gab[(size_t)row * 16 + lane] = mine;
    }
    { const int id = wg * 512 + tid, i = id >> 6, e = id & 63;
      if (id < D * 64) {
          float sc = c.b_ada[4 * D + i];
#pragma unroll
          for (int p = 0; p < 4; ++p) sc += c.modp[(size_t)p * 6 * D + 4 * D + i];
          const float w = c.norm2_g[i] * (1.f + sc) * c.w_router[id];
          const unsigned hi = cvt_pk_bf16(w, w) & 0xffffu; const float lo = w - __uint_as_float(hi << 16);
          const int ch = i >> 7, kk = i & 127;
          c.rwimg[((ch * 2 + 0) * 64 + e) * 136 + kk] = (bf16_t)hi; c.rwimg[((ch * 2 + 1) * 64 + e) * 136 + kk] = (bf16_t)(cvt_pk_bf16(lo, lo) & 0xffffu);
      } }
    if (wg < 64) {
        __syncthreads();
        float a = 0.f;
        for (int i = tid; i < D; i += 512) { float sh = c.b_ada[3 * D + i];
#pragma unroll
            for (int p = 0; p < 4; ++p) sh += c.modp[(size_t)p * 6 * D + 3 * D + i];
            a += sh * c.w_router[i * 64 + wg]; }
        a = wave_sum(a); if (lane == 0) la[wv] = a; __syncthreads();
        if (tid == 0) c.rbias2[wg] = la[0] + la[1] + la[2] + la[3] + la[4] + la[5] + la[6] + la[7];
    }
}
__device__ void ph_gemm1(CtxK& c, LAS unsigned char* lds) {
    gm::DenseSched Sd; Sd.init(S, PW, D, D, c.win_t, nullptr, 1); gm::EpiProj E{c.proj};
    gm::gphase(lds, (const char*)c.h1, D, Sd, E);
}
__device__ void ph_gemm2(CtxK& c, LAS unsigned char* lds) {
    gm::DenseSched Sd; Sd.init(S, D, 1024, 2048, c.wa_t, c.wb_t, 2); gm::EpiMerge E{c.proj, c.merged};
    gm::gphase(lds, (const char*)c.ocat, 1024, Sd, E);
}
__device__ void ph_gemm3(CtxK& c, LAS unsigned char* lds) {
    gm::DenseSched Sd; Sd.init(S, D, D, D, c.wout_t, nullptr, 1); gm::EpiResid E{c.x, c.mod + 2 * D, c.out};
    gm::gphase(lds, (const char*)c.merged, D, Sd, E);
}
__device__ void ph_moe_gu(CtxK& c, LAS unsigned char* lds) {
    gm::MoeSched<true> Sm; Sm.init(4, D, D, c.nent, c.blk_row, c.blk_exp, c.tok_p, c.gu_t, (size_t)1024 * D * 2); gm::EpiSwiglu E{c.hid};
    gm::gphase(lds, (const char*)c.h2, D, Sm, E);
}
__device__ void ph_moe_dn(CtxK& c, LAS unsigned char* lds) {
    gm::MoeSched<false> Sm; Sm.init(8, FF, FF, c.nent, c.blk_row, c.blk_exp, c.tok_p, c.dn_t, (size_t)D * FF * 2); gm::EpiDown E{c.Y, c.w_p};
    gm::gphase(lds, (const char*)c.hid, FF, Sm, E);
}
__device__ void ph_cvt_exp(CtxK& c, LAS unsigned char* lds) {
    LAS float* lf = (LAS float*)lds; const int wg = blockIdx.x - 8, G = gridDim.x - 8;
    if (wg < 0) return;
    constexpr int GU_T = 16 * 32, DN_T = 32 * 8;
    for (int T = wg; T < NEX * (GU_T + DN_T); T += G) {
        if (T < NEX * GU_T) { const int e = T / GU_T, r = T % GU_T, nt = r / 32, kt = r % 32;
            const float* sg = e < NE ? c.w_eg + (size_t)e * D * FF : c.w_sg; const float* su = e < NE ? c.w_eu + (size_t)e * D * FF : c.w_su;
            cvt_tile(lf, sg + (size_t)kt * 64 * FF + nt * 32, su + (size_t)kt * 64 * FF + nt * 32, FF, 1, c.gu_t + ((size_t)e * 1024 + nt * 64) * D + kt * 64, D); }
        else { const int T2 = T - NEX * GU_T, e = T2 / DN_T, r = T2 % DN_T; const float* sd = e < NE ? c.w_ed + (size_t)e * FF * D : c.w_sd;
            cvt_job(lf, r, sd, D, FF, c.dn_t + (size_t)e * D * FF); }
    }
}
__device__ void ph_final(CtxK& c, LAS unsigned char* lds) {
    const int tid = ltid(), wg = blockIdx.x, G = gridDim.x, lane = tid & 63, wv = tid >> 6;
    const float* gt2 = c.mod + 5 * D;
    for (int row = wg * 8 + wv; row < S; row += G * 8) {
        int p[9];
#pragma unroll
        for (int k = 0; k < 8; ++k) p[k] = c.pos[row * TOPK + k];
        p[8] = PROUTED + row;
        f32x4 v[8]; float ss = 0.f;
#pragma unroll
        for (int i = 0; i < 8; ++i) {
            const int e = i * 256 + lane * 4; f32x4 a = {0.f, 0.f, 0.f, 0.f};
#pragma unroll
            for (int k = 0; k < 9; ++k) { const u32x2 y = *(const u32x2*)(c.Y + (size_t)p[k] * D + e); a[0] += bflo(y.x); a[1] += bfhi(y.x); a[2] += bflo(y.y); a[3] += bfhi(y.y); }
            const f32x4 xv = *(const f32x4*)(c.out + (size_t)row * D + e), g = *(const f32x4*)(gt2 + e);
            v[i] = xv + g * a; ss += v[i][0] * v[i][0] + v[i][1] * v[i][1] + v[i][2] * v[i][2] + v[i][3] * v[i][3];
        }
        ss = wave_sum(ss); const float r = rsqrtf(ss * (1.f / D) + 1e-6f);
#pragma unroll
        for (int i = 0; i < 8; ++i) { const int e = i * 256 + lane * 4; *(f32x4*)(c.out + (size_t)row * D + e) = v[i] * r * *(const f32x4*)(c.normf_g + e); }
    }
}


namespace mx {
constexpr int ST128 = 272, ST64 = 144;
constexpr int FRAG_F4 = 8 * 8 * 64;
__device__ __forceinline__ f32x4 mfma16(bf16x8 a, bf16x8 b, f32x4 c) { return __builtin_amdgcn_mfma_f32_16x16x32_bf16(a, b, c, 0, 0, 0); }
template <int MT, int KS>
__device__ __forceinline__ void mma_nt(f32x4 (&acc)[MT], LAS const unsigned char* xs, int sx, LAS const unsigned char* ys, int sy, int fr, int fq) {
#pragma unroll
    for (int kk = 0; kk < KS; ++kk) {
        const bf16x8 b = *(const LAS bf16x8*)(ys + fr * sy + (kk * 32 + fq * 8) * 2);
#pragma unroll
        for (int m = 0; m < MT; ++m) { const bf16x8 a = *(const LAS bf16x8*)(xs + (16 * m + fr) * sx + (kk * 32 + fq * 8) * 2); acc[m] = mfma16(a, b, acc[m]); }
    }
}
__device__ __forceinline__ void lds_fence() { asm volatile("s_waitcnt lgkmcnt(0)" ::: "memory"); }
__device__ __forceinline__ u32x4 pack8(const float (&v)[8]) { u32x4 o; o.x = cvt_pk_bf16(v[0], v[1]); o.y = cvt_pk_bf16(v[2], v[3]); o.z = cvt_pk_bf16(v[4], v[5]); o.w = cvt_pk_bf16(v[6], v[7]); return o; }
__device__ __forceinline__ void unpack8(const u32x4 w, float (&v)[8]) { v[0] = bflo(w.x); v[1] = bfhi(w.x); v[2] = bflo(w.y); v[3] = bfhi(w.y); v[4] = bflo(w.z); v[5] = bfhi(w.z); v[6] = bflo(w.w); v[7] = bfhi(w.w); }
__device__ __forceinline__ void mfma_pad8(f32x4 (&a)[8]) { asm volatile("s_nop 15\n\ts_nop 7" : "+v"(a[0]), "+v"(a[1]), "+v"(a[2]), "+v"(a[3]), "+v"(a[4]), "+v"(a[5]), "+v"(a[6]), "+v"(a[7])); }
__device__ __forceinline__ void mfma_pad4(f32x4 (&a)[4]) { asm volatile("s_nop 15\n\ts_nop 7" : "+v"(a[0]), "+v"(a[1]), "+v"(a[2]), "+v"(a[3])); }
__device__ __forceinline__ void write_st(LAS unsigned char* stw, f32x4 (&S)[8], int fr, int fq) {
    mfma_pad8(S);
#pragma unroll
    for (int m = 0; m < 8; ++m) { u32x2 w; w.x = cvt_pk_bf16(S[m][0], S[m][1]); w.y = cvt_pk_bf16(S[m][2], S[m][3]); *(LAS u32x2*)(stw + fr * ST128 + (16 * m + 4 * fq) * 2) = w; }
}

constexpr int H_QT = 0, H_KT = 17408, H_QI = 34816, H_KU = 52224, H_VT = 70656, H_P = 89088, H_DEC = 98304, H_OCT = 98816, H_F4 = 102912, H_PART = 103424, H_RINV = 105472, H_ST = 105728, H_END = H_ST + 8 * 16 * ST128;
static_assert(H_END <= 147456, "hgrn lds");
template <bool OUT>
__device__ void hgrn_pass(CtxK& c, LAS unsigned char* lds) {
    const int tid = ltid(), wv = __builtin_amdgcn_readfirstlane(tid >> 6), lane = tid & 63, fr = lane & 15, fq = lane >> 4;
    LAS float* dec = (LAS float*)(lds + H_DEC); LAS float* oct = (LAS float*)(lds + H_OCT); LAS float* f4 = (LAS float*)(lds + H_F4);
    LAS float* part = (LAS float*)(lds + H_PART); LAS float* rinv = (LAS float*)(lds + H_RINV);
    LAS unsigned char* stw = lds + H_ST + wv * 16 * ST128;
    {
        const int wu = blockIdx.x, h = wu & 7, g = wu >> 3;
        f32x4 Sacc[8];
#pragma unroll
        for (int m = 0; m < 8; ++m) Sacc[m] = (f32x4){0.f, 0.f, 0.f, 0.f};
        if (OUT) {
            if (g > 0) { const f32x4* sp = (const f32x4*)c.hS + (size_t)(h * 32 + g) * FRAG_F4 + (wv * 8) * 64 + lane;
#pragma unroll
                for (int m = 0; m < 8; ++m) Sacc[m] = sp[m * 64]; }
            write_st(stw, Sacc, fr, fq);
        }
        float dsum = 0.f;
        for (int i = 0; i < 8; ++i) {
            const int T0 = (g * 8 + i) * 64;
            const int tp = ltid(), to = (tp >> 4) & 7, co = tp & 15, c0 = to * 8, d0 = co * 8;
            float cs[8][8];
            if (tid < 128) {
                float lbv[8];
                { const f32x4 l0 = *(const f32x4*)(c.lb + h * 128 + d0), l1 = *(const f32x4*)(c.lb + h * 128 + d0 + 4);
                  lbv[0] = l0[0]; lbv[1] = l0[1]; lbv[2] = l0[2]; lbv[3] = l0[3]; lbv[4] = l1[0]; lbv[5] = l1[1]; lbv[6] = l1[2]; lbv[7] = l1[3]; }
#pragma unroll
                for (int tt = 0; tt < 8; ++tt) {
                    float fv[8]; unpack8(*(const u32x4*)(c.proj + (size_t)(T0 + c0 + tt) * PW + C_HF + h * 128 + d0), fv);
#pragma unroll
                    for (int j = 0; j < 8; ++j) { const float lf = __logf(lbv[j] + (1.f - lbv[j]) * sigmoidf_(fv[j])); cs[tt][j] = tt ? cs[tt - 1][j] + lf : lf; }
                }
#pragma unroll
                for (int j = 0; j < 8; ++j) { oct[to * 128 + d0 + j] = cs[7][j]; if (to == 4) f4[d0 + j] = cs[0][j]; }
            }
            __syncthreads();
            if (tid < 128) {
                float pre[8], tot[8], bmid[8];
#pragma unroll
                for (int j = 0; j < 8; ++j) { float p = 0.f, t_ = 0.f, bm = 0.f;
#pragma unroll
                    for (int o = 0; o < 8; ++o) { const float x = oct[o * 128 + d0 + j]; p += o < to ? x : 0.f; bm += o < 4 ? x : 0.f; t_ += x; }
                    pre[j] = p; tot[j] = t_; bmid[j] = bm + f4[d0 + j]; }
                if (to == 0) {
#pragma unroll
                    for (int j = 0; j < 8; ++j) dec[d0 + j] = __expf(tot[j]);
                }
                if (OUT) {
#pragma unroll
                    for (int tt = 0; tt < 8; ++tt) {
                        float qv[8], q1[8], k1[8], q2[8];
                        unpack8(*(const u32x4*)(c.proj + (size_t)(T0 + c0 + tt) * PW + C_HQ + h * 128 + d0), qv);
#pragma unroll
                        for (int j = 0; j < 8; ++j) {
                            const float lf = tt ? cs[tt][j] - cs[tt - 1][j] : cs[0][j], kk_ = 1.f - __expf(lf), b = pre[j] + cs[tt][j];
                            const float q = siluf_(qv[j]) * 0.08838834764831845f, e1 = __expf(b - bmid[j]); q1[j] = q * e1; k1[j] = kk_ / e1; q2[j] = q * __expf(b);
                        }
                        *(LAS u32x4*)(lds + H_QT + (c0 + tt) * ST128 + d0 * 2) = pack8(q1); *(LAS u32x4*)(lds + H_KT + (c0 + tt) * ST128 + d0 * 2) = pack8(k1); *(LAS u32x4*)(lds + H_QI + (c0 + tt) * ST128 + d0 * 2) = pack8(q2);
                    }
                }
#pragma unroll
                for (int j = 0; j < 8; ++j) { float col[8];
#pragma unroll
                    for (int tt = 0; tt < 8; ++tt) { const float lf = tt ? cs[tt][j] - cs[tt - 1][j] : cs[0][j]; col[tt] = (1.f - __expf(lf)) * __expf(tot[j] - pre[j] - cs[tt][j]); }
                    *(LAS u32x4*)(lds + H_KU + (d0 + j) * ST64 + c0 * 2) = pack8(col); }
                if (!OUT && to == 0) {   }
            } else if (tid < 256) {
                float vb[8][8];
#pragma unroll
                for (int tt = 0; tt < 8; ++tt) unpack8(*(const u32x4*)(c.proj + (size_t)(T0 + c0 + tt) * PW + C_HI + h * 128 + d0), vb[tt]);
#pragma unroll
                for (int j = 0; j < 8; ++j) { float col[8];
#pragma unroll
                    for (int tt = 0; tt < 8; ++tt) col[tt] = vb[tt][j];
                    *(LAS u32x4*)(lds + H_VT + (d0 + j) * ST64 + c0 * 2) = pack8(col); }
            }
            __syncthreads();
            if (!OUT && tid < 128) dsum += __logf(dec[tid]);
            f32x4 oacc[4];
            if (OUT) {
                { f32x4 sc[2] = {(f32x4){0.f, 0.f, 0.f, 0.f}, (f32x4){0.f, 0.f, 0.f, 0.f}};
                  const int nt = wv & 3, mb = (wv >> 2) * 2;
                  mma_nt<2, 4>(sc, lds + H_KT + mb * 16 * ST128, ST128, lds + H_QT + nt * 16 * ST128, ST128, fr, fq);
#pragma unroll
                  for (int m = 0; m < 2; ++m) { const int cc = nt * 16 + fr, s0 = (mb + m) * 16 + 4 * fq; u32x2 w;
                      w.x = cvt_pk_bf16(s0 + 0 <= cc ? sc[m][0] : 0.f, s0 + 1 <= cc ? sc[m][1] : 0.f); w.y = cvt_pk_bf16(s0 + 2 <= cc ? sc[m][2] : 0.f, s0 + 3 <= cc ? sc[m][3] : 0.f);
                      *(LAS u32x2*)(lds + H_P + cc * ST64 + s0 * 2) = w; } }
                __syncthreads();
#pragma unroll
                for (int m = 0; m < 4; ++m) oacc[m] = (f32x4){0.f, 0.f, 0.f, 0.f};
                mma_nt<4, 2>(oacc, lds + H_P, ST64, lds + H_VT + wv * 16 * ST64, ST64, fr, fq);
                mma_nt<4, 4>(oacc, lds + H_QI, ST128, stw, ST128, fr, fq);
#pragma unroll
                for (int m = 0; m < 4; ++m)
#pragma unroll
                    for (int r = 0; r < 4; ++r) { float q = oacc[m][r] * oacc[m][r]; q += __shfl_xor(q, 1); q += __shfl_xor(q, 2); q += __shfl_xor(q, 4); q += __shfl_xor(q, 8); if (fr == 0) part[wv * 64 + 16 * m + 4 * fq + r] = q; }
            }
#pragma unroll
            for (int m = 0; m < 8; ++m) { const f32x4 dv = *(LAS f32x4*)(dec + 16 * m + 4 * fq); Sacc[m] = Sacc[m] * dv; }
            mma_nt<8, 2>(Sacc, lds + H_KU, ST64, lds + H_VT + wv * 16 * ST64, ST64, fr, fq);
            if (OUT) {
                lds_fence();
                write_st(stw, Sacc, fr, fq);
                __syncthreads();
                if (tid < 64) { float s_ = 0.f;
#pragma unroll
                    for (int w = 0; w < 8; ++w) s_ += part[w * 64 + tid];
                    rinv[tid] = rsqrtf(s_ * (1.f / 128.f) + 1e-6f); }
                __syncthreads();
                const int v = wv * 16 + fr; const float gn = c.hgrn_onorm_g[v];
#pragma unroll
                for (int m = 0; m < 4; ++m)
#pragma unroll
                    for (int r = 0; r < 4; ++r) { const int cc = 16 * m + 4 * fq + r; const size_t t = (size_t)(T0 + cc);
                        const float o = oacc[m][r] * rinv[cc] * gn * siluf_(bf2f(c.proj[t * PW + C_HG + h * 128 + v]));
                        c.ocat[t * D + h * 128 + v] = (bf16_t)(cvt_pk_bf16(o, o) & 0xffffu); }
            }
            __syncthreads();
        }
        if (!OUT) {
            f32x4* sp = (f32x4*)c.hL + (size_t)(h * 32 + g) * FRAG_F4 + (wv * 8) * 64 + lane;
#pragma unroll
            for (int m = 0; m < 8; ++m) sp[m * 64] = Sacc[m];
            if (tid < 128) c.hD[(h * 32 + g) * 128 + tid] = __expf(dsum);
        }
    }
}
__device__ void hgrn_scan(CtxK& c) {
    const int e = blockIdx.x * 512 + ltid();
    if (e >= 8 * FRAG_F4) return;
    const int h = e / FRAG_F4, fi = e % FRAG_F4, m = (fi >> 6) & 7, lane = fi & 63, d0 = 16 * m + 4 * (lane >> 4);
    f32x4 s = {0.f, 0.f, 0.f, 0.f};
    for (int g = 0; g < 31; ++g) {
        const f32x4 dc = *(const f32x4*)(c.hD + (h * 32 + g) * 128 + d0);
        s = s * dc + ((const f32x4*)c.hL)[(size_t)(h * 32 + g) * FRAG_F4 + fi];
        ((f32x4*)c.hS)[(size_t)(h * 32 + g + 1) * FRAG_F4 + fi] = s;
    }
}

constexpr int B_T = 0, B_KBG = 9216, B_KU = 26624, B_VB = 45056, B_QD = 63488, B_AT = 80896, B_SC = 90112, BLOB = 90368;
constexpr int G_ST = BLOB, G_RV = G_ST + 8 * 16 * ST128, G_PART = G_RV + 8 * 16 * ST64, G_RINV = G_PART + 2048, G_END = G_RINV + 256;
static_assert(G_END <= 147456, "gdn lds");
constexpr int P_K = 0, P_Q = 17408, P_BETA = 34816, P_GC = P_BETA + 256, P_EG = P_GC + 256, P_EK = P_EG + 256;

__device__ void gdn_prep(CtxK& c, LAS unsigned char* lds, int h, int g) {
    const int tid = ltid(), wv = __builtin_amdgcn_readfirstlane(tid >> 6), lane = tid & 63, fr = lane & 15, fq = lane >> 4;
    LAS float* sbeta = (LAS float*)(lds + P_BETA); LAS float* sgc = (LAS float*)(lds + P_GC); LAS float* seg = (LAS float*)(lds + P_EG); LAS float* sek = (LAS float*)(lds + P_EK);
    for (int i = 0; i < 8; ++i) {
        const int n = g * 8 + i, T0 = n * 64;
        unsigned char* blob = (unsigned char*)c.gBlob + (size_t)(h * 256 + n) * BLOB;
        if (wv == 0) {
            const float ga = c.gab[(size_t)(T0 + lane) * 16 + h], gb = c.gab[(size_t)(T0 + lane) * 16 + 8 + h];
            const float gl_ = -__expf(c.a_log[h]) * softplusf_(ga + c.dt_bias[h]);
            float gc = gl_;
#pragma unroll
            for (int o = 1; o < 64; o <<= 1) { const float t_ = __shfl_up(gc, o); if (lane >= o) gc += t_; }
            const float glast = __shfl(gc, 63);
            sbeta[lane] = sigmoidf_(gb); sgc[lane] = gc; seg[lane] = __expf(gc); sek[lane] = __expf(glast - gc);
            if (lane == 0) *(float*)(blob + B_SC) = __expf(glast);
        }
        __syncthreads();
        const int tp = ltid(), part = tp >> 7, to = (tp >> 4) & 7, co = tp & 15, c0 = to * 8, d0 = co * 8;
        if (tp < 384) {
            const int chb = part * 1024 + h * 128 + d0;
            float val[8][8];
            {
                float wj[4][8];
#pragma unroll
                for (int j = 0; j < 4; ++j) { const f32x4 a = *(const f32x4*)(c.conv_w + j * 3072 + chb), b = *(const f32x4*)(c.conv_w + j * 3072 + chb + 4);
                    wj[j][0] = a[0]; wj[j][1] = a[1]; wj[j][2] = a[2]; wj[j][3] = a[3]; wj[j][4] = b[0]; wj[j][5] = b[1]; wj[j][6] = b[2]; wj[j][7] = b[3]; }
                u32x4 raw[11];
#pragma unroll
                for (int r = 0; r < 11; ++r) { const int tok = T0 + c0 - 3 + r; raw[r] = tok >= 0 ? *(const u32x4*)(c.proj + (size_t)tok * PW + C_GQKV + chb) : (u32x4){0u, 0u, 0u, 0u}; }
#pragma unroll
                for (int tt = 0; tt < 8; ++tt) {
                    float a[8] = {0.f, 0.f, 0.f, 0.f, 0.f, 0.f, 0.f, 0.f};
#pragma unroll
                    for (int j = 0; j < 4; ++j) { float xv[8]; unpack8(raw[tt + j], xv);
#pragma unroll
                        for (int jj = 0; jj < 8; ++jj) a[jj] += wj[j][jj] * xv[jj]; }
#pragma unroll
                    for (int jj = 0; jj < 8; ++jj) val[tt][jj] = siluf_(a[jj]);
                }
            }
            if (part < 2) {
#pragma unroll
                for (int tt = 0; tt < 8; ++tt) { float ss = 0.f;
#pragma unroll
                    for (int jj = 0; jj < 8; ++jj) ss += val[tt][jj] * val[tt][jj];
                    ss += __shfl_xor(ss, 1); ss += __shfl_xor(ss, 2); ss += __shfl_xor(ss, 4); ss += __shfl_xor(ss, 8);
                    const float rn = rsqrtf(ss + 1e-6f) * (part == 0 ? 0.08838834764831845f : 1.f);
#pragma unroll
                    for (int jj = 0; jj < 8; ++jj) val[tt][jj] *= rn; }
            }
            if (part == 0) {
#pragma unroll
                for (int tt = 0; tt < 8; ++tt) { const int cc = c0 + tt; *(LAS u32x4*)(lds + P_Q + cc * ST128 + d0 * 2) = pack8(val[tt]);
                    const float e = seg[cc]; float qd[8];
#pragma unroll
                    for (int jj = 0; jj < 8; ++jj) qd[jj] = val[tt][jj] * e;
                    *(u32x4*)(blob + B_QD + cc * ST128 + d0 * 2) = pack8(qd); }
            } else if (part == 1) {
#pragma unroll
                for (int tt = 0; tt < 8; ++tt) { const int cc = c0 + tt; *(LAS u32x4*)(lds + P_K + cc * ST128 + d0 * 2) = pack8(val[tt]);
                    const float e = seg[cc] * sbeta[cc]; float kb[8];
#pragma unroll
                    for (int jj = 0; jj < 8; ++jj) kb[jj] = val[tt][jj] * e;
                    *(u32x4*)(blob + B_KBG + cc * ST128 + d0 * 2) = pack8(kb); }
#pragma unroll
                for (int jj = 0; jj < 8; ++jj) { float col[8];
#pragma unroll
                    for (int tt = 0; tt < 8; ++tt) col[tt] = val[tt][jj] * sek[c0 + tt];
                    *(u32x4*)(blob + B_KU + (d0 + jj) * ST64 + c0 * 2) = pack8(col); }
            } else {
#pragma unroll
                for (int jj = 0; jj < 8; ++jj) { float col[8];
#pragma unroll
                    for (int tt = 0; tt < 8; ++tt) col[tt] = val[tt][jj] * sbeta[c0 + tt];
                    *(u32x4*)(blob + B_VB + (d0 + jj) * ST64 + c0 * 2) = pack8(col); }
            }
        }
        __syncthreads();
        {
            const int nt = wv & 3, mb = (wv >> 2) * 2, jj = nt * 16 + fr;
            f32x4 kk2[2] = {(f32x4){0.f, 0.f, 0.f, 0.f}, (f32x4){0.f, 0.f, 0.f, 0.f}}, at2[2] = {(f32x4){0.f, 0.f, 0.f, 0.f}, (f32x4){0.f, 0.f, 0.f, 0.f}};
            mma_nt<2, 4>(kk2, lds + P_K + mb * 16 * ST128, ST128, lds + P_K + nt * 16 * ST128, ST128, fr, fq);
            mma_nt<2, 4>(at2, lds + P_K + mb * 16 * ST128, ST128, lds + P_Q + nt * 16 * ST128, ST128, fr, fq);
            float* at = c.gAT + (size_t)(h * 256 + n) * 4096;
            const float gj = sgc[jj];
#pragma unroll
            for (int m = 0; m < 2; ++m) { const int i0 = (mb + m) * 16 + 4 * fq; f32x4 av; float pv[4];
#pragma unroll
                for (int r = 0; r < 4; ++r) { const int ii = i0 + r; const float gi = sgc[ii];
                    av[r] = jj < ii ? sbeta[ii] * kk2[m][r] * __expf(gi - gj) : 0.f;
                    pv[r] = ii <= jj ? at2[m][r] * __expf(gj - gi) : 0.f; }
                *(f32x4*)(at + jj * 64 + i0) = av;
                u32x2 w; w.x = cvt_pk_bf16(pv[0], pv[1]); w.y = cvt_pk_bf16(pv[2], pv[3]);
                *(u32x2*)(blob + B_AT + jj * ST64 + i0 * 2) = w; }
        }
        __syncthreads();
    }
}
__device__ void gdn_invert(CtxK& c, LAS unsigned char* lds, int h, int g) {
    const int tid = ltid(), wv = __builtin_amdgcn_readfirstlane(tid >> 6), lane = tid & 63;
    const int n = g * 8 + wv;
    LAS float* at = (LAS float*)(lds + wv * 16384);
    const float* src = c.gAT + (size_t)(h * 256 + n) * 4096;
#pragma unroll
    for (int k = 0; k < 16; ++k) *(LAS f32x4*)(at + (k * 64 + lane) * 4) = *(const f32x4*)(src + (k * 64 + lane) * 4);
    lds_fence();
    float r[64];
    unsigned ata = (unsigned)(size_t)at;
#pragma unroll
    for (int j = 63; j >= 0; --j) {
        float acc = lane == j ? 1.f : 0.f;
        LAS const float* arow = (LAS const float*)(size_t)ata + j * 64;
#pragma unroll
        for (int m4 = ((j + 1) & ~3); m4 < 64; m4 += 4) {
            const f32x4 a = *(LAS const f32x4*)(arow + m4);
#pragma unroll
            for (int q = 0; q < 4; ++q) if (m4 + q > j) acc = __builtin_fmaf(-r[m4 + q], a[q], acc);
        }
        r[j] = acc;
        asm volatile("" : "+v"(ata) : "v"(acc));
    }
    unsigned char* blob = (unsigned char*)c.gBlob + (size_t)(h * 256 + n) * BLOB;
#pragma unroll
    for (int k = 0; k < 8; ++k) { float v8[8];
#pragma unroll
        for (int q = 0; q < 8; ++q) v8[q] = r[k * 8 + q];
        *(u32x4*)(blob + B_T + lane * ST64 + k * 16) = pack8(v8); }
}
template <int MODE>
__device__ void gdn_pass(CtxK& c, LAS unsigned char* lds, int h, int g) {
    const int tid = ltid(), wv = __builtin_amdgcn_readfirstlane(tid >> 6), lane = tid & 63, fr = lane & 15, fq = lane >> 4;
    LAS unsigned char* stw = lds + G_ST + wv * 16 * ST128; LAS unsigned char* rvw = lds + G_RV + wv * 16 * ST64;
    LAS float* part = (LAS float*)(lds + G_PART); LAS float* rinv = (LAS float*)(lds + G_RINV);
    f32x4 Sacc[8];
#pragma unroll
    for (int m = 0; m < 8; ++m) {
        if (MODE == 1) { const int v = 16 * wv + fr, d0 = 16 * m + 4 * fq; Sacc[m] = (f32x4){d0 == v ? 1.f : 0.f, d0 + 1 == v ? 1.f : 0.f, d0 + 2 == v ? 1.f : 0.f, d0 + 3 == v ? 1.f : 0.f}; }
        else Sacc[m] = (f32x4){0.f, 0.f, 0.f, 0.f};
    }
    if (MODE == 2 && g > 0) { const f32x4* sp = (const f32x4*)c.gS + (size_t)(h * 32 + g) * FRAG_F4 + (wv * 8) * 64 + lane;
#pragma unroll
        for (int m = 0; m < 8; ++m) Sacc[m] = sp[m * 64]; }
    write_st(stw, Sacc, fr, fq);
    for (int i = 0; i < 8; ++i) {
        const int n = g * 8 + i, T0 = n * 64;
        { const unsigned char* blob = (const unsigned char*)c.gBlob + (size_t)(h * 256 + n) * BLOB; const int tl = ltid();
          for (int o = tl * 16; o < BLOB; o += 512 * 16) *(LAS u32x4*)(lds + o) = *(const u32x4*)(blob + o); }
        __syncthreads();
        const float dlast = *(LAS float*)(lds + B_SC);
        { f32x4 R[4];
#pragma unroll
          for (int m = 0; m < 4; ++m) R[m] = (f32x4){0.f, 0.f, 0.f, 0.f};
          mma_nt<4, 4>(R, lds + B_KBG, ST128, stw, ST128, fr, fq);
#pragma unroll
          for (int m = 0; m < 4; ++m) { float x0 = 0.f, x1 = 0.f, x2 = 0.f, x3 = 0.f;
              if (MODE != 1) { const u32x2 vb = *(LAS u32x2*)(lds + B_VB + (16 * wv + fr) * ST64 + (16 * m + 4 * fq) * 2); x0 = bflo(vb.x); x1 = bfhi(vb.x); x2 = bflo(vb.y); x3 = bfhi(vb.y); }
              u32x2 w; w.x = cvt_pk_bf16(x0 - R[m][0], x1 - R[m][1]); w.y = cvt_pk_bf16(x2 - R[m][2], x3 - R[m][3]);
              *(LAS u32x2*)(rvw + fr * ST64 + (16 * m + 4 * fq) * 2) = w; } }
        lds_fence();
        { f32x4 VN[4];
#pragma unroll
          for (int m = 0; m < 4; ++m) VN[m] = (f32x4){0.f, 0.f, 0.f, 0.f};
          mma_nt<4, 2>(VN, lds + B_T, ST64, rvw, ST64, fr, fq);
          mfma_pad4(VN); lds_fence();
#pragma unroll
          for (int m = 0; m < 4; ++m) { u32x2 w; w.x = cvt_pk_bf16(VN[m][0], VN[m][1]); w.y = cvt_pk_bf16(VN[m][2], VN[m][3]); *(LAS u32x2*)(rvw + fr * ST64 + (16 * m + 4 * fq) * 2) = w; } }
        lds_fence();
        f32x4 O[4];
        if (MODE == 2) {
#pragma unroll
            for (int m = 0; m < 4; ++m) O[m] = (f32x4){0.f, 0.f, 0.f, 0.f};
            mma_nt<4, 4>(O, lds + B_QD, ST128, stw, ST128, fr, fq);
            mma_nt<4, 2>(O, lds + B_AT, ST64, rvw, ST64, fr, fq);
#pragma unroll
            for (int m = 0; m < 4; ++m)
#pragma unroll
                for (int r = 0; r < 4; ++r) { float q = O[m][r] * O[m][r]; q += __shfl_xor(q, 1); q += __shfl_xor(q, 2); q += __shfl_xor(q, 4); q += __shfl_xor(q, 8); if (fr == 0) part[wv * 64 + 16 * m + 4 * fq + r] = q; }
        }
#pragma unroll
        for (int m = 0; m < 8; ++m) Sacc[m] = Sacc[m] * dlast;
        mma_nt<8, 2>(Sacc, lds + B_KU, ST64, rvw, ST64, fr, fq);
        lds_fence();
        write_st(stw, Sacc, fr, fq);
        if (MODE == 2) {
            __syncthreads();
            if (tid < 64) { float s_ = 0.f;
#pragma unroll
                for (int w = 0; w < 8; ++w) s_ += part[w * 64 + tid];
                rinv[tid] = rsqrtf(s_ * (1.f / 128.f) + 1e-6f); }
            __syncthreads();
            const int v = wv * 16 + fr; const float gn = c.gdn_onorm_g[v];
#pragma unroll
            for (int m = 0; m < 4; ++m)
#pragma unroll
                for (int r = 0; r < 4; ++r) { const int cc = 16 * m + 4 * fq + r; const size_t t = (size_t)(T0 + cc);
                    const float o = O[m][r] * rinv[cc] * gn * siluf_(bf2f(c.proj[t * PW + C_GG + h * 128 + v]));
                    c.ocat[t * D + 1024 + h * 128 + v] = (bf16_t)(cvt_pk_bf16(o, o) & 0xffffu); }
        }
        __syncthreads();
    }
    if (MODE == 0) {
        f32x4* sp = (f32x4*)c.gB + (size_t)(h * 32 + g) * FRAG_F4 + (wv * 8) * 64 + lane;
#pragma unroll
        for (int m = 0; m < 8; ++m) sp[m * 64] = Sacc[m];
    }
    if (MODE == 1) {
        mfma_pad8(Sacc);
        LAS bf16_t* img = (LAS bf16_t*)lds;
#pragma unroll
        for (int m = 0; m < 8; ++m)
#pragma unroll
            for (int r = 0; r < 4; ++r) img[(16 * m + 4 * fq + r) * (ST128 / 2) + 16 * wv + fr] = (bf16_t)(cvt_pk_bf16(Sacc[m][r], Sacc[m][r]) & 0xffffu);
        __syncthreads();
        unsigned char* dst = (unsigned char*)c.gM + (size_t)(h * 32 + g) * (128 * ST128);
        for (int o = tid * 16; o < 128 * ST128; o += 512 * 16) *(u32x4*)(dst + o) = *(LAS u32x4*)(lds + o);
        __syncthreads();
    }
}
__device__ void gdn_scan(CtxK& c, LAS unsigned char* lds, int h) {
    const int tid = ltid(), wv = __builtin_amdgcn_readfirstlane(tid >> 6), lane = tid & 63, fr = lane & 15, fq = lane >> 4;
    LAS unsigned char* stw = lds + G_ST + wv * 16 * ST128;
    f32x4 Sacc[8];
#pragma unroll
    for (int m = 0; m < 8; ++m) Sacc[m] = (f32x4){0.f, 0.f, 0.f, 0.f};
    for (int g = 0; g < 31; ++g) {
        const unsigned char* src = (const unsigned char*)c.gM + (size_t)(h * 32 + g) * (128 * ST128);
        for (int o = tid * 16; o < 128 * ST128; o += 512 * 16) *(LAS u32x4*)(lds + o) = *(const u32x4*)(src + o);
        write_st(stw, Sacc, fr, fq);
        const f32x4* bp = (const f32x4*)c.gB + (size_t)(h * 32 + g) * FRAG_F4 + (wv * 8) * 64 + lane;
#pragma unroll
        for (int m = 0; m < 8; ++m) Sacc[m] = bp[m * 64];
        __syncthreads();
        mma_nt<8, 4>(Sacc, lds, ST128, stw, ST128, fr, fq);
        f32x4* sp = (f32x4*)c.gS + (size_t)(h * 32 + g + 1) * FRAG_F4 + (wv * 8) * 64 + lane;
#pragma unroll
        for (int m = 0; m < 8; ++m) sp[m * 64] = Sacc[m];
        __syncthreads();
    }
}
}
__device__ void ph_hgrn1(CtxK& c, LAS unsigned char* lds) { mx::hgrn_pass<false>(c, lds); }
__device__ void ph_hgrn2(CtxK& c, LAS unsigned char* lds) { mx::hgrn_scan(c); }
__device__ void ph_hgrn3(CtxK& c, LAS unsigned char* lds) { mx::hgrn_pass<true>(c, lds); }
__device__ void ph_gdn1(CtxK& c, LAS unsigned char* lds) {
    const int wu = blockIdx.x, h = wu & 7, g = wu >> 3;
    mx::gdn_prep(c, lds, h, g); __syncthreads();
    asm volatile("s_waitcnt vmcnt(0)" ::: "memory"); __syncthreads();
    mx::gdn_invert(c, lds, h, g);
    asm volatile("s_waitcnt vmcnt(0)" ::: "memory"); __syncthreads();
    mx::gdn_pass<0>(c, lds, h, g); __syncthreads();
    mx::gdn_pass<1>(c, lds, h, g); __syncthreads();
}
__device__ void ph_gdn2(CtxK& c, LAS unsigned char* lds) { if (blockIdx.x < 8) mx::gdn_scan(c, lds, blockIdx.x); }
__device__ void ph_gdn3(CtxK& c, LAS unsigned char* lds) { const int wu = blockIdx.x; mx::gdn_pass<2>(c, lds, wu & 7, wu >> 3); }

__device__ __forceinline__ float pair_sum128(float v, LAS float* red) {
    v = wave_sum(v); const int w = ltid() >> 6;
    __syncthreads(); if ((ltid() & 63) == 0) red[w] = v; __syncthreads();
    return red[w & ~1] + red[w | 1];
}
__device__ void ph_gdn_pre(CtxK& c, LAS unsigned char* lds) {
    LAS float* red = (LAS float*)lds;
    const int tid = ltid() & 255, g = ltid() >> 8;
    for (int t = blockIdx.x * 2 + g; t < S; t += gridDim.x * 2) {
        for (int grp = 0; grp < 12; ++grp) {
            const int ch = grp * 256 + tid; float acc = 0.f;
#pragma unroll
            for (int j = 0; j < 4; ++j) { const int tt = t - 3 + j; if (tt >= 0) acc += c.conv_w[j * 3072 + ch] * bf2f(c.proj[(size_t)tt * PW + C_GQKV + ch]); }
            const float val = siluf_(acc);
            if (grp < 8) {
                const float ss = pair_sum128(val * val, red); const float n = val * rsqrtf(ss + 1e-6f);
                if (grp < 4) c.gq[(size_t)t * 1024 + ch] = n * 0.08838834764831845f; else c.gk[(size_t)t * 1024 + ch - 1024] = n;
            } else c.gv[(size_t)t * 1024 + ch - 2048] = val;
        }
        if (tid < 8) {
            const float ga = c.gab[(size_t)t * 16 + tid], gb = c.gab[(size_t)t * 16 + 8 + tid];
            c.gbeta[t * 8 + tid] = sigmoidf_(gb); c.gdec[t * 8 + tid] = expf(-expf(c.a_log[tid]) * softplusf_(ga + c.dt_bias[tid]));
        }
    }
}
__device__ void ph_mix_naive(CtxK& c, LAS unsigned char* lds) {
    constexpr int TB = 8;
    const int wg = blockIdx.x, t512 = ltid(), tid = t512 & 127; const bool ld = t512 < 128, act = t512 < 256;
    const int v = (t512 >> 1) & 127, d0 = (t512 & 1) * 64;
    if (wg < 8 || wg >= 16) return;
    LAS float* sq = (LAS float*)lds; LAS float* sf = sq + TB * 128; LAS float* sk = sf + TB * 128; LAS float* sv = sk + TB * 128; LAS float* sb = sv + TB * 128; LAS float* sa = sb + TB;
    float st[64];
#pragma unroll
    for (int d = 0; d < 64; ++d) st[d] = 0.f;
    if (wg < 8) {
        const int h = wg; const float lbv = c.lb[h * 128 + tid];
        for (int t0 = 0; t0 < S; t0 += TB) {
            if (ld) for (int tt = 0; tt < TB; ++tt) {
                const bf16_t* base = c.proj + (size_t)(t0 + tt) * PW + h * 128 + tid;
                const float f = lbv + (1.f - lbv) * sigmoidf_(bf2f(base[C_HF]));
                sq[tt * 128 + tid] = siluf_(bf2f(base[C_HQ])) * 0.08838834764831845f; sf[tt * 128 + tid] = f; sk[tt * 128 + tid] = 1.f - f; sv[tt * 128 + tid] = bf2f(base[C_HI]);
            }
            __syncthreads();
            if (act) {
#pragma unroll 1
            for (int tt = 0; tt < TB; ++tt) {
                float o = 0.f; const float vv = sv[tt * 128 + v];
#pragma unroll
                for (int d = 0; d < 64; d += 4) {
                    const f32x4 q4 = *(LAS f32x4*)(sq + tt * 128 + d0 + d), f4 = *(LAS f32x4*)(sf + tt * 128 + d0 + d), k4 = *(LAS f32x4*)(sk + tt * 128 + d0 + d);
                    st[d] = f4[0] * st[d] + k4[0] * vv; o += q4[0] * st[d];
                    st[d + 1] = f4[1] * st[d + 1] + k4[1] * vv; o += q4[1] * st[d + 1];
                    st[d + 2] = f4[2] * st[d + 2] + k4[2] * vv; o += q4[2] * st[d + 2];
                    st[d + 3] = f4[3] * st[d + 3] + k4[3] * vv; o += q4[3] * st[d + 3];
                }
                o += __shfl_xor(o, 1);
                if (d0 == 0) c.oa[(size_t)(t0 + tt) * 1024 + h * 128 + v] = o;
            } }
            __syncthreads();
        }
    } else {
        const int h = wg - 8;
        for (int t0 = 0; t0 < S; t0 += TB) {
            if (ld) { for (int tt = 0; tt < TB; ++tt) {
                const size_t o = (size_t)(t0 + tt) * 1024 + h * 128 + tid;
                sq[tt * 128 + tid] = c.gq[o]; sk[tt * 128 + tid] = c.gk[o]; sv[tt * 128 + tid] = c.gv[o];
            }
            if (tid < TB) { sb[tid] = c.gbeta[(t0 + tid) * 8 + h]; sa[tid] = c.gdec[(t0 + tid) * 8 + h]; } }
            __syncthreads();
            if (act) {
#pragma unroll 1
            for (int tt = 0; tt < TB; ++tt) {
                const float a = sa[tt], be = sb[tt]; float kd = 0.f;
#pragma unroll
                for (int d = 0; d < 64; d += 4) { const f32x4 k4 = *(LAS f32x4*)(sk + tt * 128 + d0 + d); kd += k4[0] * st[d] + k4[1] * st[d + 1] + k4[2] * st[d + 2] + k4[3] * st[d + 3]; }
                kd += __shfl_xor(kd, 1);
                const float c1 = be * (sv[tt * 128 + v] - a * kd); float o = 0.f;
#pragma unroll
                for (int d = 0; d < 64; d += 4) {
                    const f32x4 k4 = *(LAS f32x4*)(sk + tt * 128 + d0 + d), q4 = *(LAS f32x4*)(sq + tt * 128 + d0 + d);
                    st[d] = a * st[d] + c1 * k4[0]; o += q4[0] * st[d];
                    st[d + 1] = a * st[d + 1] + c1 * k4[1]; o += q4[1] * st[d + 1];
                    st[d + 2] = a * st[d + 2] + c1 * k4[2]; o += q4[2] * st[d + 2];
                    st[d + 3] = a * st[d + 3] + c1 * k4[3]; o += q4[3] * st[d + 3];
                }
                o += __shfl_xor(o, 1);
                if (d0 == 0) c.ob[(size_t)(t0 + tt) * 1024 + h * 128 + v] = o;
            } }
            __syncthreads();
        }
    }
}
__device__ void ph_onorm(CtxK& c, LAS unsigned char* lds) {
    LAS float* red = (LAS float*)lds;
    const int tid = ltid() & 255, g = ltid() >> 8;
    for (int t = blockIdx.x * 2 + g; t < S; t += gridDim.x * 2) {
        for (int i = 4; i < 8; ++i) {
            const int br = i >> 2, ch = (i & 3) * 256 + tid; const float v = (br ? c.ob : c.oa)[(size_t)t * 1024 + ch];
            const float ss = pair_sum128(v * v, red);
            const float o = v * rsqrtf(ss * (1.f / 128.f) + 1e-6f) * (br ? c.gdn_onorm_g : c.hgrn_onorm_g)[ch & 127] * siluf_(bf2f(c.proj[(size_t)t * PW + (br ? C_GG : C_HG) + ch]));
            const unsigned pk = cvt_pk_bf16(o, o); c.ocat[(size_t)t * D + br * 1024 + ch] = (bf16_t)(pk & 0xffffu);
        }
    }
}
constexpr int N2_LA = 0, N2_LB = 8192, N2_XH = 16384, N2_XL = N2_XH + 17408, N2_Y = N2_XL + 17408, N2_LOG = N2_Y + 34816, N2_RS = N2_LOG + 64 * 65 * 4, N2_IDX = N2_RS + 256, N2_BIAS = N2_IDX + 2048, N2_END = N2_BIAS + 256;
static_assert(N2_END <= 147456, "norm2 lds");
__device__ void ph_norm2(CtxK& c, LAS unsigned char* lds) {
    const int tid = ltid(), wg = blockIdx.x, lane = tid & 63, wv = __builtin_amdgcn_readfirstlane(tid >> 6), fr = lane & 15, fq = lane >> 4;
    LAS float* la = (LAS float*)(lds + N2_LA); LAS float* lb_ = (LAS float*)(lds + N2_LB); LAS float* lg = (LAS float*)(lds + N2_LOG); LAS float* rs = (LAS float*)(lds + N2_RS);
    LAS int* idxt = (LAS int*)(lds + N2_IDX); LAS float* bias2 = (LAS float*)(lds + N2_BIAS);
    for (int j = tid; j < D; j += 512) { la[j] = c.norm2_g[j] * (1.f + c.mod[4 * D + j]); lb_[j] = c.mod[3 * D + j]; }
    if (tid < 64) bias2[tid] = c.rbias2[tid];
    __syncthreads();
    const int tok0 = wg * 64;
    for (int rr = 0; rr < 8; ++rr) {
        const int row = tok0 + wv * 8 + rr;
        const float* xr = c.out + (size_t)row * D; f32x4 v[8]; float ss = 0.f;
#pragma unroll
        for (int i = 0; i < 8; ++i) { v[i] = *(const f32x4*)(xr + i * 256 + lane * 4); ss += v[i][0] * v[i][0] + v[i][1] * v[i][1] + v[i][2] * v[i][2] + v[i][3] * v[i][3]; }
        ss = wave_sum(ss); const float r = rsqrtf(ss * (1.f / D) + 1e-6f);
        if (lane == 0) rs[wv * 8 + rr] = r;
#pragma unroll
        for (int i = 0; i < 8; ++i) { const int e = i * 256 + lane * 4; const f32x4 a = *(LAS f32x4*)(la + e), b = *(LAS f32x4*)(lb_ + e); const f32x4 y = v[i] * r * a + b;
            u32x2 w; w.x = cvt_pk_bf16(y[0], y[1]); w.y = cvt_pk_bf16(y[2], y[3]); *(u32x2*)(c.h2 + (size_t)row * D + e) = w; }
    }
    const int xrow = tid >> 3, xseg = (tid & 7) * 16;
    f32x4 xr_[4]; u32x4 yr_[5];
    auto issue = [&](int ch) {
        const float* xp = c.out + (size_t)(tok0 + xrow) * D + ch * 128 + xseg;
#pragma unroll
        for (int q = 0; q < 4; ++q) xr_[q] = *(const f32x4*)(xp + q * 4);
        const unsigned char* yp = (const unsigned char*)c.rwimg + (size_t)ch * 34816 + tid * 16;
#pragma unroll
        for (int q = 0; q < 4; ++q) yr_[q] = *(const u32x4*)(yp + q * 8192);
        if (tid < 128) yr_[4] = *(const u32x4*)(yp + 32768);
    };
    issue(0);
    f32x4 acc[2] = {(f32x4){0.f, 0.f, 0.f, 0.f}, (f32x4){0.f, 0.f, 0.f, 0.f}};
    const int mt = wv >> 1, nb = (wv & 1) * 2;
    for (int ch = 0; ch < 16; ++ch) {
        __syncthreads();
        { float hi[16], lo[16];
#pragma unroll
          for (int q = 0; q < 4; ++q)
#pragma unroll
              for (int j = 0; j < 4; ++j) { const float x = xr_[q][j]; const float h = __uint_as_float(cvt_pk_bf16(x, x) << 16); hi[q * 4 + j] = h; lo[q * 4 + j] = x - h; }
          float t8[8];
#pragma unroll
          for (int hh = 0; hh < 2; ++hh) {
#pragma unroll
              for (int j = 0; j < 8; ++j) t8[j] = hi[hh * 8 + j];
              *(LAS u32x4*)(lds + N2_XH + xrow * 272 + (xseg + hh * 8) * 2) = mx::pack8(t8);
#pragma unroll
              for (int j = 0; j < 8; ++j) t8[j] = lo[hh * 8 + j];
              *(LAS u32x4*)(lds + N2_XL + xrow * 272 + (xseg + hh * 8) * 2) = mx::pack8(t8); }
#pragma unroll
          for (int q = 0; q < 4; ++q) *(LAS u32x4*)(lds + N2_Y + tid * 16 + q * 8192) = yr_[q];
          if (tid < 128) *(LAS u32x4*)(lds + N2_Y + tid * 16 + 32768) = yr_[4]; }
        __syncthreads();
        if (ch + 1 < 16) issue(ch + 1);
#pragma unroll
        for (int kk = 0; kk < 4; ++kk) {
            const int ko = (kk * 32 + fq * 8) * 2;
            const bf16x8 ah = *(const LAS bf16x8*)(lds + N2_XH + (16 * mt + fr) * 272 + ko), al = *(const LAS bf16x8*)(lds + N2_XL + (16 * mt + fr) * 272 + ko);
#pragma unroll
            for (int n = 0; n < 2; ++n) {
                const bf16x8 bh = *(const LAS bf16x8*)(lds + N2_Y + (16 * (nb + n) + fr) * 272 + ko), bl = *(const LAS bf16x8*)(lds + N2_Y + 17408 + (16 * (nb + n) + fr) * 272 + ko);
                acc[n] = mx::mfma16(ah, bh, acc[n]); acc[n] = mx::mfma16(ah, bl, acc[n]); acc[n] = mx::mfma16(al, bh, acc[n]);
            }
        }
    }
#pragma unroll
    for (int n = 0; n < 2; ++n)
#pragma unroll
        for (int r = 0; r < 4; ++r) lg[(16 * mt + 4 * fq + r) * 65 + 16 * (nb + n) + fr] = acc[n][r];
    __syncthreads();
    const float rb = c.router_bias[lane], b2 = bias2[lane];
    for (int rr = 0; rr < 8; ++rr) {
        const int lr = wv * 8 + rr, t = tok0 + lr;
        const float s = sigmoidf_(lg[lr * 65 + lane] * rs[lr] + b2), b = s + rb;
        int rk = 0;
#pragma unroll
        for (int x = 1; x < 8; ++x) { const float ob = __shfl_xor(b, x); const int ol = lane ^ x; rk += (ob > b || (ob == b && ol < lane)) ? 1 : 0; }
        float gs = rk < 2 ? b : 0.f; gs += __shfl_xor(gs, 1); gs += __shfl_xor(gs, 2); gs += __shfl_xor(gs, 4);
        int grk = 0;
#pragma unroll
        for (int x = 8; x < 64; x += 8) { const float og = __shfl_xor(gs, x); const int ol = lane ^ x; grk += (og > gs || (og == gs && ol < lane)) ? 1 : 0; }
        float mb = grk < 4 ? b : -INFINITY;
        float wsum = 0.f; int myk = -1;
        for (int k = 0; k < TOPK; ++k) {
            float m = mb;
#pragma unroll
            for (int o = 32; o >= 1; o >>= 1) m = fmaxf(m, __shfl_xor(m, o));
            const unsigned long long bal = __ballot(mb == m); const int win = __ffsll((long long)bal) - 1;
            const float sw = __shfl(s, win); wsum += sw;
            if (lane == win) { mb = -INFINITY; myk = k; }
        }
        if (myk >= 0) { c.idx[t * TOPK + myk] = lane; c.wts[t * TOPK + myk] = s / wsum * 2.5f; idxt[lr * TOPK + myk] = lane; }
    }
    __syncthreads();
    if (tid < 64) { int n = 0;
        for (int p = 0; p < 512; ++p) if (idxt[p] == tid) { c.rnk[wg * 512 + p] = n; ++n; }
        c.tile_cnt[wg * 64 + tid] = n; }
}
__device__ void ph_route(CtxK& c, LAS unsigned char* lds) {
    const int tid = ltid(), b = blockIdx.x, e = tid & 63, part = tid >> 6;
    LAS int* psum = (LAS int*)lds; LAS int* pbel = psum + 512; LAS int* tot = pbel + 512; LAS int* offb = tot + 64; LAS int* pst = offb + 64;
    { int sa = 0, sb = 0;
      for (int tl = part * 32; tl < part * 32 + 32; ++tl) { const int v = c.tile_cnt[tl * 64 + e]; sa += v; sb += tl < b ? v : 0; }
      psum[part * 64 + e] = sa; pbel[part * 64 + e] = sb; }
    __syncthreads();
    if (tid < 64) {
        int t_ = 0, o_ = 0;
#pragma unroll
        for (int q = 0; q < 8; ++q) { t_ += psum[q * 64 + e]; o_ += pbel[q * 64 + e]; }
        const int pad = (t_ + 255) & ~255; int inc = pad;
#pragma unroll
        for (int o = 1; o < 64; o <<= 1) { const int x = __shfl_up(inc, o); if (e >= o) inc += x; }
        const int ps = inc - pad;
        tot[e] = t_; offb[e] = o_; pst[e] = ps;
        if (b == 0) {
            const int b0 = ps >> 8, nbe = pad >> 8;
            for (int j = 0; j < nbe; ++j) { c.blk_row[b0 + j] = ps + j * 256; c.blk_exp[b0 + j] = e; }
            const int nbr = __shfl(inc, 63) >> 8;
            c.blk_row[nbr + e] = PROUTED + e * 256; c.blk_exp[nbr + e] = NE;
            if (e == 0) *c.nent = nbr + S / 256;
        }
        c.tok_p[PROUTED + b * 64 + e] = b * 64 + e; c.w_p[PROUTED + b * 64 + e] = 1.f;
    }
    __syncthreads();
    { const int p = b * 512 + tid, ex = c.idx[p], d = pst[ex] + offb[ex] + c.rnk[p];
      c.tok_p[d] = p >> 3; c.w_p[d] = c.wts[p]; c.pos[p] = d; }
    if (b < NE) { const int ps = pst[b], t_ = tot[b], pe = (t_ + 255) & ~255;
        for (int r = t_ + tid; r < pe; r += 512) { c.tok_p[ps + r] = 0; c.w_p[ps + r] = 0.f; } }
}

constexpr int LDS_MAIN = 147456, LDS_BYTES = LDS_MAIN + 16;
__global__ void __launch_bounds__(512, 2) k_mega(Ctx c) {
    extern __shared__ __attribute__((aligned(16))) unsigned char smem[];
    LAS unsigned char* lds = (LAS unsigned char*)smem;
    if (ltid() == 0) *(LAS u32x4*)(lds + LDS_MAIN) = (u32x4){0u, 0u, 0u, 0u};
    __syncthreads();
    CtxK* kp = (CtxK*)__builtin_amdgcn_kernarg_segment_ptr();
    (void)xcd_barrier_post(c.bar, (volatile LAS unsigned*)(lds + LDS_MAIN));
#define PHASE(fn) do { const CtxK* kp_ = kp; asm volatile("" : "+s"(kp_)); fn(*kp_, lds); __syncthreads(); } while (0)
#define GRID_BARRIER() do { const CtxK* kp_ = kp; asm volatile("" : "+s"(kp_)); XcdBarrier bb_; bb_.bar = kp_->bar; bb_.x = xb_xcc_id(); bb_.st = (volatile LAS unsigned*)(lds + LDS_MAIN); xcd_barrier(bb_); } while (0)
    PHASE(ph_pro1);      GRID_BARRIER();
    PHASE(ph_norm1);     GRID_BARRIER();
    PHASE(ph_gemm1);     GRID_BARRIER();
    PHASE(ph_hgrn1);     PHASE(ph_gdn1);  GRID_BARRIER();
    PHASE(ph_hgrn2);     PHASE(ph_gdn2);  PHASE(ph_cvt_exp); GRID_BARRIER();
    PHASE(ph_hgrn3);     PHASE(ph_gdn3);  GRID_BARRIER();
    PHASE(ph_gemm2);     GRID_BARRIER();
    PHASE(ph_gemm3);     GRID_BARRIER();
    PHASE(ph_norm2);     GRID_BARRIER();
    PHASE(ph_route);     GRID_BARRIER();
    PHASE(ph_moe_gu);    GRID_BARRIER();
    PHASE(ph_moe_dn);    GRID_BARRIER();
    PHASE(ph_final);
#undef PHASE
#undef GRID_BARRIER
}

extern "C" void kernel_launch(void* const* d_in, const int* in_sizes, int n_in, void* d_out, int out_size, void* d_ws, size_t ws_size, hipStream_t stream) {
    Ctx c{};
    const float** ip = (const float**)&c.x;
    for (int i = 0; i < 25; ++i) ip[i] = (const float*)d_in[i];
    c.out = (float*)d_out;
    char* ws = (char*)d_ws; constexpr size_t MB = 1024 * 1024;
    c.bar = (unsigned*)ws;
    c.modp = (float*)(ws + 64 * 1024); c.mod = (float*)(ws + 320 * 1024); c.lb = (float*)(ws + 384 * 1024);
    c.cnt = (int*)(ws + 392 * 1024); c.nent = (int*)(ws + 396 * 1024); c.blk_row = (int*)(ws + 400 * 1024); c.blk_exp = (int*)(ws + 404 * 1024);
    c.idx = (int*)(ws + 1 * MB); c.wts = (float*)(ws + 2 * MB); c.tok_p = (int*)(ws + 3 * MB); c.w_p = (float*)(ws + 4 * MB); c.pos = (int*)(ws + 5 * MB);
    c.gab = (float*)(ws + 6 * MB); c.gbeta = (float*)(ws + 7 * MB + 0); c.gdec = (float*)(ws + 7 * MB + 512 * 1024);
    c.rwimg = (bf16_t*)(ws + 8 * MB); c.rbias2 = (float*)(ws + 9 * MB); c.tile_cnt = (int*)(ws + 9 * MB + 4096); c.rnk = (int*)(ws + 10 * MB);
    char* big = ws + 16 * MB;
    auto at = [&](size_t mib) { return big + mib * MB; };
    c.dn_t = (bf16_t*)at(0); c.gu_t = (bf16_t*)at(130);
    c.win_t = (bf16_t*)at(0); c.h1 = (bf16_t*)at(48); c.gAT = (float*)at(112);
    c.proj = (bf16_t*)at(390); c.gBlob = (unsigned char*)at(774); c.merged = (bf16_t*)at(774);
    c.gM = (unsigned char*)at(951); c.gB = (float*)at(960); c.hL = (float*)at(976); c.gS = (float*)at(992); c.hS = (float*)at(1008); c.hD = (float*)at(1024);
    c.wa_t = (bf16_t*)at(1025); c.wb_t = (bf16_t*)at(1029); c.wout_t = (bf16_t*)at(1033); c.ocat = (bf16_t*)at(1041);
    c.Y = (bf16_t*)at(130); c.hid = (bf16_t*)at(770); c.h2 = (bf16_t*)at(930);
    static_assert((size_t)NEX * D * FF * 2 <= 130 * MB && (size_t)NEX * 1024 * D * 2 <= 260 * MB && (size_t)PW * D * 2 <= 48 * MB && (size_t)S * D * 2 <= 64 * MB, "map A");
    static_assert((size_t)S * PW * 2 <= 384 * MB && (size_t)2048 * mx::BLOB <= 177 * MB && (size_t)256 * 128 * mx::ST128 <= 9 * MB && (size_t)PTOT * D * 2 <= 640 * MB && (size_t)PTOT * FF * 2 <= 160 * MB, "map B");
    const size_t need = 16 * MB + 1105 * MB;
    if (ws_size < need) { fprintf(stderr, "kernel_launch: workspace too small: %zu < %zu\n", ws_size, need); return; }

    static int grid = 0;
    if (!grid) {
        int dev = 0, cus = 0, per_cu = 0;
        hipGetDevice(&dev); hipDeviceGetAttribute(&cus, hipDeviceAttributeMultiprocessorCount, dev);
        hipFuncSetAttribute((const void*)k_mega, hipFuncAttributeMaxDynamicSharedMemorySize, LDS_BYTES);
        hipOccupancyMaxActiveBlocksPerMultiprocessor(&per_cu, (const void*)k_mega, 512, LDS_BYTES);
        if (per_cu < 1) fprintf(stderr, "kernel_launch: occupancy query reports %d blocks per CU\n", per_cu);
        grid = cus;
        if (grid != 256) { fprintf(stderr, "kernel_launch: built for a 256-CU device (token-mixer units = workgroups); got %d CUs\n", cus); grid = -1; }
    }
    if (grid < 0) return;
    hipMemsetAsync(c.bar, 0, XCD_BAR_WORDS * sizeof(unsigned), stream);
    hipLaunchKernelGGL(k_mega, dim3(grid), dim3(512), LDS_BYTES, stream, c);
}
```

```cpp
#include <hip/hip_runtime.h>
#include <stdint.h>
#include <stdio.h>

#define LAS __attribute__((address_space(3)))
typedef unsigned short bf16_t;
typedef short bf16x8 __attribute__((ext_vector_type(8)));
typedef float f32x4 __attribute__((ext_vector_type(4)));
typedef unsigned u32x4 __attribute__((ext_vector_type(4)));
typedef unsigned u32x2 __attribute__((ext_vector_type(2)));

constexpr int S = 16384, D = 2048, INW = 12304, PW = 12288, NE = 64, TOPK = 8, TK = S * TOPK, FF = 512;
constexpr int NEX = NE + 1;
constexpr int PROUTED = 147456, PTOT = PROUTED + S, NBLK_MAX = PROUTED / 256;
constexpr int C_HQ = 0, C_HF = 1024, C_HI = 2048, C_HG = 3072, C_GQKV = 4096, C_GG = 7168, C_MGA = 8192, C_MGB = 10240;
constexpr int WIN_GAB = 7168;

__device__ __forceinline__ float rcpf_(float x) { return __builtin_amdgcn_rcpf(x); }
__device__ __forceinline__ float sigmoidf_(float x) { return rcpf_(1.f + __expf(-x)); }
__device__ __forceinline__ float siluf_(float x) { return x * rcpf_(1.f + __expf(-x)); }
__device__ __forceinline__ float softplusf_(float x) { return x > 20.f ? x : log1pf(expf(x)); }
__device__ __forceinline__ float bf2f(bf16_t b) { return __uint_as_float(((unsigned)b) << 16); }
__device__ __forceinline__ float bflo(unsigned w) { return __uint_as_float(w << 16); }
__device__ __forceinline__ float bfhi(unsigned w) { return __uint_as_float(w & 0xffff0000u); }
__device__ __forceinline__ unsigned cvt_pk_bf16(float lo, float hi) { unsigned r; asm volatile("v_cvt_pk_bf16_f32 %0, %1, %2" : "=v"(r) : "v"(lo), "v"(hi)); return r; }
__device__ __forceinline__ int ltid() { int t = threadIdx.x; asm volatile("" : "+v"(t)); return t; }
__device__ __forceinline__ float wave_sum(float v) {
#pragma unroll
    for (int o = 32; o >= 1; o >>= 1) v += __shfl_xor(v, o);
    return v;
}


#define XB_TMO      128
#define XB_XCNT(j)  (256  + 64 * (j))
#define XB_XSUB(j)  (1280 + 64 * (j))
#define XB_XGEN(j)  (2304 + 64 * (j))
#define XB_TOP      3328
#define XB_TOPGEN   3392
#define XCD_BAR_WORDS 3456
#define XB_SPIN_CAP (1u << 18)
__device__ __forceinline__ unsigned xb_ld(unsigned* p)              { return __hip_atomic_load(p, __ATOMIC_RELAXED, __HIP_MEMORY_SCOPE_AGENT); }
__device__ __forceinline__ unsigned xb_add(unsigned* p, unsigned v) { return __hip_atomic_fetch_add(p, v, __ATOMIC_RELAXED, __HIP_MEMORY_SCOPE_AGENT); }
__device__ __forceinline__ unsigned xb_xcc_id() { return (unsigned)__builtin_amdgcn_s_getreg((3 << 11) | 20) & 0xFu; }
#define XB_SPIN(cond, bar) do { unsigned _sp = 0; while (cond) { __builtin_amdgcn_s_sleep(1); \
    if ((++_sp & 255u) == 0u) { if (xb_ld(&(bar)[XB_TMO])) break; if (_sp > XB_SPIN_CAP) { atomicAdd(&(bar)[XB_TMO], 1u); break; } } } } while (0)
struct XcdBarrier { unsigned* bar; unsigned x; volatile LAS unsigned* st; };
__device__ __forceinline__ XcdBarrier xcd_barrier_post(unsigned* bar, volatile LAS unsigned* st) {
    XcdBarrier b; b.bar = bar; b.x = xb_xcc_id(); b.st = st;
    if (threadIdx.x == 0) (void)xb_add(&bar[XB_XCNT(b.x)], 1u);
    return b;
}
__device__ __forceinline__ void xcd_barrier_complete(unsigned* bar, unsigned x, unsigned& nloc, unsigned& nx) {
    const unsigned G = gridDim.x * gridDim.y * gridDim.z;
    unsigned sum, cnt, mine, sp = 0u;
    for (;;) {
        sum = 0u; cnt = 0u; mine = 0u;
#pragma unroll
        for (unsigned j = 0; j < 16; ++j) { const unsigned c = xb_ld(&bar[XB_XCNT(j)]); sum += c; cnt += (c > 0u) ? 1u : 0u; mine = (j == x) ? c : mine; }
        if (sum == G) break;
        __builtin_amdgcn_s_sleep(1);
        if ((++sp & 255u) == 0u) { if (xb_ld(&bar[XB_TMO])) break; if (sp > XB_SPIN_CAP) { atomicAdd(&bar[XB_TMO], 1u); break; } }
    }
    nloc = mine > 0u ? mine : 1u; nx = cnt > 0u ? cnt : 1u;
}
__device__ __forceinline__ void xcd_barrier(const XcdBarrier& b) {
    asm volatile("s_waitcnt vmcnt(0)" ::: "memory");
    __syncthreads();
    if (threadIdx.x == 0) {
        unsigned* bar = b.bar;
        __builtin_amdgcn_s_waitcnt(0);
        unsigned nloc = b.st[0], nx = b.st[1];
        if (nloc == 0u) { xcd_barrier_complete(bar, b.x, nloc, nx); b.st[0] = nloc; b.st[1] = nx; }
        const unsigned old = xb_add(&bar[XB_XSUB(b.x)], 1u);
        const unsigned gen = old / nloc;
        if (old + 1u == (gen + 1u) * nloc) {
            __builtin_amdgcn_fence(__ATOMIC_RELEASE, "agent");
            asm volatile("s_waitcnt vmcnt(0)" ::: "memory");
            const unsigned og = xb_add(&bar[XB_TOP], 1u);
            const unsigned tg = og / nx;
            if (og + 1u == (tg + 1u) * nx) xb_add(&bar[XB_TOPGEN], 1u);
            else XB_SPIN(xb_ld(&bar[XB_TOPGEN]) == tg, bar);
            __builtin_amdgcn_fence(__ATOMIC_ACQUIRE, "agent");
            xb_add(&bar[XB_XGEN(b.x)], 1u);
            asm volatile("s_waitcnt vmcnt(0)" ::: "memory");
        } else {
            XB_SPIN(xb_ld(&bar[XB_XGEN(b.x)]) == gen, bar);
            __builtin_amdgcn_fence(__ATOMIC_ACQUIRE, "agent");
            asm volatile("s_waitcnt vmcnt(0)" ::: "memory");
        }
    }
    __syncthreads();
}

namespace gm {
constexpr int BM = 256, BK = 64, HALF = 128, HTB = HALF * BK * 2, STAGE_BYTES = 8 * HTB;
__host__ __device__ __forceinline__ int lds_byte(int r, int c) { const int st = (r >> 4) * 2 + (c >> 5), rr = r & 15, cc = c & 31, ob = rr * 64 + cc * 2; return st * 1024 + (ob ^ (((ob >> 9) & 1) << 5)); }
__host__ __device__ __forceinline__ void stage_rc(int b, int& R, int& C) { const int st = b / 1024, sb = b % 1024, swz = sb ^ (((sb >> 9) & 1) << 5); R = (st >> 1) * 16 + swz / 64; C = (st & 1) * 32 + (swz % 64) / 2; }
__host__ __device__ __forceinline__ int perm32(int rho) { const int n = rho >> 4, i = rho & 15; return 8 * (i >> 2) + 4 * n + (i & 3); }

struct Unit { int pm, pn, aux; const char* Bp; unsigned a00, a01, a10, a11; };

template <class Epi, class Sched>
__device__ __forceinline__ void gphase(LAS unsigned char* lds, const char* Abase, const int K, Sched& S, Epi& E) {
    const int tid = ltid(), wid = __builtin_amdgcn_readfirstlane(tid >> 6), lane = tid & 63, wr = wid >> 2, wc = wid & 3, fr = lane & 15, fq = lane >> 4;
    const int nt = K / BK;
    unsigned voffB[2];
#pragma unroll
    for (int i = 0; i < 2; ++i) { int R, C; stage_rc(tid * 16 + i * 8192, R, C); const int Rb = Epi::PERM ? ((R & ~31) + perm32(R & 31)) : R; voffB[i] = (unsigned)(Rb * K + C) * 2u; }
    const size_t hstepB = (size_t)HALF * K * 2;
    const unsigned ldsw = (unsigned)wid * 1024u;
    const int aoff = lds_byte(wr * 64 + fr, fq * 8), boff = lds_byte(wc * 32 + fr, fq * 8);
#define G_SA(b, h) (((b) * 2 + (h)) * HTB)
#define G_SB(b, h) ((4 + (b) * 2 + (h)) * HTB)
#define G_STAGE_A(bufoff, o0, o1, kb) do { \
        __builtin_amdgcn_global_load_lds((const unsigned*)(Abase + (o0) + (kb)), (LAS unsigned*)(lds + (bufoff) + ldsw), 16, 0, 0); \
        __builtin_amdgcn_global_load_lds((const unsigned*)(Abase + (o1) + (kb)), (LAS unsigned*)(lds + (bufoff) + ldsw + 8192), 16, 0, 0); } while (0)
#define G_STAGE_B(bufoff, bp, kb) do { \
        __builtin_amdgcn_global_load_lds((const unsigned*)((bp) + voffB[0] + (kb)), (LAS unsigned*)(lds + (bufoff) + ldsw), 16, 0, 0); \
        __builtin_amdgcn_global_load_lds((const unsigned*)((bp) + voffB[1] + (kb)), (LAS unsigned*)(lds + (bufoff) + ldsw + 8192), 16, 0, 0); } while (0)
#define G_LDA(dst, b, h) do { _Pragma("unroll") for (int m = 0; m < 4; ++m) _Pragma("unroll") for (int k = 0; k < 2; ++k) dst[m][k] = *(const LAS bf16x8*)(lds + G_SA(b, h) + aoff + m * 2048 + k * 1024); } while (0)
#define G_LDB(dst, b, h) do { _Pragma("unroll") for (int n = 0; n < 2; ++n) _Pragma("unroll") for (int k = 0; k < 2; ++k) dst[n][k] = *(const LAS bf16x8*)(lds + G_SB(b, h) + boff + n * 2048 + k * 1024); } while (0)
#define G_MMA(ai, bj, At, Bt) do { __builtin_amdgcn_s_setprio(1); _Pragma("unroll") for (int m = 0; m < 4; ++m) _Pragma("unroll") for (int n = 0; n < 2; ++n) _Pragma("unroll") for (int k = 0; k < 2; ++k) \
        acc[ai][bj][m][n] = __builtin_amdgcn_mfma_f32_16x16x32_bf16(Bt[n][k], At[m][k], acc[ai][bj][m][n], 0, 0, 0); __builtin_amdgcn_s_setprio(0); } while (0)
#define G_WAIT_V(n) asm volatile("s_waitcnt vmcnt(" #n ")" ::: "memory")
#define G_WAIT_L(n) asm volatile("s_waitcnt lgkmcnt(" #n ")" ::: "memory")
#define G_BAR __builtin_amdgcn_s_barrier()
#define G_SCHED __builtin_amdgcn_sched_barrier(0)
#define G_ZERO() do { _Pragma("unroll") for (int a = 0; a < 2; ++a) _Pragma("unroll") for (int b = 0; b < 2; ++b) _Pragma("unroll") for (int m = 0; m < 4; ++m) _Pragma("unroll") for (int n = 0; n < 2; ++n) acc[a][b][m][n] = (f32x4){0.f, 0.f, 0.f, 0.f}; } while (0)
    Unit cur, nxt; int ui = 0;
    if (!S.next(0, cur)) return;
    f32x4 acc[2][2][4][2];
    G_ZERO();
    bf16x8 At[4][2], B0[2][2], B1[2][2];
    G_STAGE_B(G_SB(0, 0), cur.Bp, 0); G_STAGE_B(G_SB(0, 1), cur.Bp + hstepB, 0); G_STAGE_A(G_SA(0, 0), cur.a00, cur.a01, 0); G_STAGE_A(G_SA(0, 1), cur.a10, cur.a11, 0);
    if (wr == 1) G_BAR;
    G_WAIT_V(2); G_BAR;
    G_STAGE_B(G_SB(1, 0), cur.Bp, 128); G_STAGE_A(G_SA(1, 0), cur.a00, cur.a01, 128); G_STAGE_B(G_SB(1, 1), cur.Bp + hstepB, 128);
    G_WAIT_V(6); G_BAR;
    for (;;) {
        const bool has_next = S.next(ui + 1, nxt);
        if (!has_next) nxt = cur;
        for (int t = 0; t < nt; t += 2) {
            const bool last = (t == nt - 2);
            const size_t kb1 = (size_t)(t + 1) * 128, kb2 = last ? 0 : (size_t)(t + 2) * 128, kb3 = kb2 + 128;
            const char* b2 = last ? nxt.Bp : cur.Bp;
            const unsigned x00 = last ? nxt.a00 : cur.a00, x01 = last ? nxt.a01 : cur.a01, x10 = last ? nxt.a10 : cur.a10, x11 = last ? nxt.a11 : cur.a11;
            G_LDB(B0, 0, 0); G_LDB(B1, 0, 1); G_SCHED; G_LDA(At, 0, 0); G_STAGE_A(G_SA(1, 1), cur.a10, cur.a11, kb1);
            G_WAIT_V(8); G_WAIT_L(0); G_BAR; G_MMA(0, 0, At, B0); G_MMA(0, 1, At, B1); G_BAR; G_SCHED;
            G_LDA(At, 0, 1); G_STAGE_B(G_SB(0, 0), b2, kb2); G_STAGE_B(G_SB(0, 1), b2 + hstepB, kb2); G_STAGE_A(G_SA(0, 0), x00, x01, kb2);
            G_WAIT_V(8); G_WAIT_L(0); G_BAR; G_MMA(1, 0, At, B0); G_MMA(1, 1, At, B1); G_BAR; G_SCHED;
            G_LDB(B0, 1, 0); G_LDB(B1, 1, 1); G_SCHED; G_LDA(At, 1, 0); G_STAGE_A(G_SA(0, 1), x10, x11, kb2);
            G_WAIT_V(8); G_WAIT_L(0); G_BAR; G_MMA(0, 0, At, B0); G_MMA(0, 1, At, B1); G_BAR; G_SCHED;
            G_LDA(At, 1, 1); G_STAGE_B(G_SB(1, 0), b2, kb3); G_STAGE_B(G_SB(1, 1), b2 + hstepB, kb3); G_STAGE_A(G_SA(1, 0), x00, x01, kb3);
            G_WAIT_V(8); G_WAIT_L(0); G_BAR; G_MMA(1, 0, At, B0); G_MMA(1, 1, At, B1); G_BAR; G_SCHED;
        }
        if (wr == 0) G_BAR;
        E(acc, cur, wr, wc, fr, fq);
        if (!has_next) break;
        if (!E.keep(cur)) G_ZERO();
        cur = nxt; ++ui;
        if (wr == 1) G_BAR;
    }
    G_WAIT_V(0);
    G_BAR;
#undef G_SA
#undef G_SB
#undef G_STAGE_A
#undef G_STAGE_B
#undef G_LDA
#undef G_LDB
#undef G_MMA
#undef G_WAIT_V
#undef G_WAIT_L
#undef G_BAR
#undef G_SCHED
#undef G_ZERO
}

struct DenseSched {
    int nM, nN, nwg, G, c, lda, K, parts; const char* Bt; const char* Bt2; int R0, C0, R1, C1;
    __device__ void init(int M, int N, int K_, int lda_, const void* Bt_, const void* Bt2_, int parts_) {
        nM = M / BM; nN = N / BM; nwg = nM * nN; G = gridDim.x; c = blockIdx.x; lda = lda_; K = K_; Bt = (const char*)Bt_; Bt2 = (const char*)Bt2_; parts = parts_;
        stage_rc(ltid() * 16, R0, C0); stage_rc(ltid() * 16 + 8192, R1, C1);
    }
    __device__ bool next(int i, Unit& u) const {
        const int ti = parts == 2 ? (i >> 1) : i, part = parts == 2 ? (i & 1) : 0;
        const long L = (long)ti * G + c; if (L >= nwg) return false;
        int wgid = (int)L; { const int q = nwg / 8, r = nwg % 8, xcd = wgid % 8, off = wgid / 8; wgid = (xcd < r ? xcd * (q + 1) : r * (q + 1) + (xcd - r) * q) + off; }
        const int nig = 8 * nN, gid = wgid / nig, fm = gid * 8, gsz = (nM - fm) < 8 ? (nM - fm) : 8;
        u.pm = fm + ((wgid % nig) % gsz); u.pn = (wgid % nig) / gsz; u.aux = part;
        u.Bp = (part ? Bt2 : Bt) + (size_t)u.pn * BM * K * 2;
        const unsigned rb = (unsigned)u.pm * BM, po = part ? (unsigned)K * 2u : 0u;
        u.a00 = ((rb + R0) * lda + C0) * 2u + po; u.a01 = ((rb + R1) * lda + C1) * 2u + po;
        u.a10 = ((rb + HALF + R0) * lda + C0) * 2u + po; u.a11 = ((rb + HALF + R1) * lda + C1) * 2u + po;
        return true;
    }
};
template <bool GATHER>
struct MoeSched {
    int nN, G, c, K, lda, nent; const int* blk_row; const int* blk_exp; const int* tok_p; const char* W; size_t wstride; int R0, C0, R1, C1;
    __device__ void init(int nN_, int K_, int lda_, const int* nent_p, const int* blk_row_, const int* blk_exp_, const int* tok_p_, const void* W_, size_t wstride_) {
        nN = nN_; G = gridDim.x; c = blockIdx.x; K = K_; lda = lda_; nent = *nent_p; blk_row = blk_row_; blk_exp = blk_exp_; tok_p = tok_p_; W = (const char*)W_; wstride = wstride_;
        stage_rc(ltid() * 16, R0, C0); stage_rc(ltid() * 16 + 8192, R1, C1);
    }
    __device__ bool next(int i, Unit& u) const {
        const long L = (long)i * G + c; if (L >= (long)nent * nN) return false;
        const int ent = (int)(L / nN); u.pn = (int)(L % nN);
        const int rb = blk_row[ent], e = blk_exp[ent]; u.pm = rb; u.aux = e;
        u.Bp = W + (size_t)e * wstride + (size_t)u.pn * BM * K * 2;
        if (GATHER) {
            const unsigned t00 = tok_p[rb + R0], t01 = tok_p[rb + R1], t10 = tok_p[rb + HALF + R0], t11 = tok_p[rb + HALF + R1];
            u.a00 = (t00 * lda + C0) * 2u; u.a01 = (t01 * lda + C1) * 2u; u.a10 = (t10 * lda + C0) * 2u; u.a11 = (t11 * lda + C1) * 2u;
        } else {
            u.a00 = ((unsigned)(rb + R0) * lda + C0) * 2u; u.a01 = ((unsigned)(rb + R1) * lda + C1) * 2u;
            u.a10 = ((unsigned)(rb + HALF + R0) * lda + C0) * 2u; u.a11 = ((unsigned)(rb + HALF + R1) * lda + C1) * 2u;
        }
        return true;
    }
};

struct EpiProj {
    static constexpr bool PERM = true; bf16_t* O;
    __device__ __forceinline__ bool keep(const Unit&) const { return false; }
    __device__ __forceinline__ void operator()(f32x4 (&acc)[2][2][4][2], const Unit& u, int wr, int wc, int fr, int fq) const {
        const int row0 = u.pm * BM + wr * 64 + fr, col0 = u.pn * BM + wc * 32 + 8 * fq;
#pragma unroll
        for (int ai = 0; ai < 2; ++ai)
#pragma unroll
            for (int m = 0; m < 4; ++m) { bf16_t* rowp = O + (size_t)(row0 + ai * HALF + m * 16) * PW + col0;
#pragma unroll
                for (int bj = 0; bj < 2; ++bj) { const f32x4 v0 = acc[ai][bj][m][0], v1 = acc[ai][bj][m][1]; u32x4 w;
                    w.x = cvt_pk_bf16(v0[0], v0[1]); w.y = cvt_pk_bf16(v0[2], v0[3]); w.z = cvt_pk_bf16(v1[0], v1[1]); w.w = cvt_pk_bf16(v1[2], v1[3]);
                    *(u32x4*)(rowp + bj * HALF) = w; } }
    }
};
struct EpiMerge {
    static constexpr bool PERM = true; const bf16_t* proj; bf16_t* O;
    __device__ __forceinline__ bool keep(const Unit& u) const { return u.aux == 0; }
    __device__ __forceinline__ void operator()(f32x4 (&acc)[2][2][4][2], const Unit& u, int wr, int wc, int fr, int fq) const {
        const int row0 = u.pm * BM + wr * 64 + fr, col0 = u.pn * BM + wc * 32 + 8 * fq;
#pragma unroll
        for (int ai = 0; ai < 2; ++ai)
#pragma unroll
            for (int m = 0; m < 4; ++m) { const size_t r = (size_t)(row0 + ai * HALF + m * 16);
#pragma unroll
                for (int bj = 0; bj < 2; ++bj) {
                    const u32x4 gb = *(const u32x4*)(proj + r * PW + C_MGB + col0 + bj * HALF);
                    const f32x4 eb0 = {__expf(-bflo(gb.x)), __expf(-bfhi(gb.x)), __expf(-bflo(gb.y)), __expf(-bfhi(gb.y))};
                    const f32x4 eb1 = {__expf(-bflo(gb.z)), __expf(-bfhi(gb.z)), __expf(-bflo(gb.w)), __expf(-bfhi(gb.w))};
                    if (u.aux == 0) {
                        const u32x4 ga = *(const u32x4*)(proj + r * PW + C_MGA + col0 + bj * HALF);
                        const f32x4 ea0 = {__expf(-bflo(ga.x)), __expf(-bfhi(ga.x)), __expf(-bflo(ga.y)), __expf(-bfhi(ga.y))};
                        const f32x4 ea1 = {__expf(-bflo(ga.z)), __expf(-bfhi(ga.z)), __expf(-bflo(ga.w)), __expf(-bfhi(ga.w))};
#pragma unroll
                        for (int j = 0; j < 4; ++j) { acc[ai][bj][m][0][j] *= (1.f + eb0[j]) * rcpf_(1.f + ea0[j]); acc[ai][bj][m][1][j] *= (1.f + eb1[j]) * rcpf_(1.f + ea1[j]); }
                    } else {
                        f32x4 v0 = acc[ai][bj][m][0], v1 = acc[ai][bj][m][1];
#pragma unroll
                        for (int j = 0; j < 4; ++j) { v0[j] *= rcpf_(1.f + eb0[j]); v1[j] *= rcpf_(1.f + eb1[j]); }
                        u32x4 w; w.x = cvt_pk_bf16(v0[0], v0[1]); w.y = cvt_pk_bf16(v0[2], v0[3]); w.z = cvt_pk_bf16(v1[0], v1[1]); w.w = cvt_pk_bf16(v1[2], v1[3]);
                        *(u32x4*)(O + r * D + col0 + bj * HALF) = w;
                    } } }
    }
};
struct EpiResid {
    static constexpr bool PERM = false; const float* x; const float* gt; float* O;
    __device__ __forceinline__ bool keep(const Unit&) const { return false; }
    __device__ __forceinline__ void operator()(f32x4 (&acc)[2][2][4][2], const Unit& u, int wr, int wc, int fr, int fq) const {
        const int row0 = u.pm * BM + wr * 64 + fr, col0 = u.pn * BM + wc * 32 + 4 * fq;
        f32x4 g[2][2];
#pragma unroll
        for (int bj = 0; bj < 2; ++bj)
#pragma unroll
            for (int n = 0; n < 2; ++n) g[bj][n] = *(const f32x4*)(gt + col0 + bj * HALF + n * 16);
#pragma unroll
        for (int ai = 0; ai < 2; ++ai)
#pragma unroll
            for (int m = 0; m < 4; ++m) { const size_t ro = (size_t)(row0 + ai * HALF + m * 16) * D + col0;
#pragma unroll
                for (int bj = 0; bj < 2; ++bj)
#pragma unroll
                    for (int n = 0; n < 2; ++n) { const f32x4 xv = *(const f32x4*)(x + ro + bj * HALF + n * 16); *(f32x4*)(O + ro + bj * HALF + n * 16) = xv + g[bj][n] * acc[ai][bj][m][n]; } }
    }
};
struct EpiSwiglu {
    static constexpr bool PERM = true; bf16_t* hid;
    __device__ __forceinline__ bool keep(const Unit&) const { return false; }
    __device__ __forceinline__ void operator()(f32x4 (&acc)[2][2][4][2], const Unit& u, int wr, int wc, int fr, int fq) const {
        const int row0 = u.pm + wr * 64 + fr, j0 = u.pn * 128 + wc * 16 + 4 * fq;
#pragma unroll
        for (int ai = 0; ai < 2; ++ai)
#pragma unroll
            for (int m = 0; m < 4; ++m) { bf16_t* rowp = hid + (size_t)(row0 + ai * HALF + m * 16) * FF + j0;
#pragma unroll
                for (int bj = 0; bj < 2; ++bj) { const f32x4 g = acc[ai][bj][m][0], up = acc[ai][bj][m][1]; u32x2 w;
                    w.x = cvt_pk_bf16(siluf_(g[0]) * up[0], siluf_(g[1]) * up[1]); w.y = cvt_pk_bf16(siluf_(g[2]) * up[2], siluf_(g[3]) * up[3]);
                    *(u32x2*)(rowp + bj * 64) = w; } }
    }
};
struct EpiDown {
    static constexpr bool PERM = true; bf16_t* Y; const float* w_p;
    __device__ __forceinline__ bool keep(const Unit&) const { return false; }
    __device__ __forceinline__ void operator()(f32x4 (&acc)[2][2][4][2], const Unit& u, int wr, int wc, int fr, int fq) const {
        const int row0 = u.pm + wr * 64 + fr, col0 = u.pn * BM + wc * 32 + 8 * fq;
#pragma unroll
        for (int ai = 0; ai < 2; ++ai)
#pragma unroll
            for (int m = 0; m < 4; ++m) { const int r = row0 + ai * HALF + m * 16; const float wt = w_p[r]; bf16_t* rowp = Y + (size_t)r * D + col0;
#pragma unroll
                for (int bj = 0; bj < 2; ++bj) { const f32x4 v0 = acc[ai][bj][m][0] * wt, v1 = acc[ai][bj][m][1] * wt; u32x4 w;
                    w.x = cvt_pk_bf16(v0[0], v0[1]); w.y = cvt_pk_bf16(v0[2], v0[3]); w.z = cvt_pk_bf16(v1[0], v1[1]); w.w = cvt_pk_bf16(v1[2], v1[3]);
                    *(u32x4*)(rowp + bj * HALF) = w; } }
    }
};
}

struct Ctx {
    const float *x, *c, *w_ada, *b_ada, *norm1_g, *norm2_g, *w_in, *lb_table, *hgrn_onorm_g, *conv_w, *a_log, *dt_bias, *gdn_onorm_g, *w_bh, *w_bg, *w_out, *w_router, *router_bias,
        *w_eg, *w_eu, *w_ed, *w_sg, *w_su, *w_sd, *normf_g;
    float* out;
    unsigned* bar;
    float *modp, *mod, *lb, *gab;
    int *idx, *cnt, *tok_p, *pos, *blk_row, *blk_exp, *nent;
    float *wts, *w_p;
    bf16_t *win_t, *wa_t, *wb_t, *wout_t, *h1, *proj, *ocat, *merged;
    float *gq, *gk, *gv, *gbeta, *gdec, *oa, *ob;
    float *hL, *hS, *hD;
    float *gAT, *gB, *gS; unsigned char *gBlob, *gM;
    bf16_t *dn_t, *hid, *gu_t, *h2, *Y;
    bf16_t* rwimg; float* rbias2; int *tile_cnt, *rnk;
};

typedef const __attribute__((address_space(4))) Ctx CtxK;

__device__ __forceinline__ void cvt_tile(LAS float* t, const float* srcA, const float* srcB, int ld, int mode, bf16_t* dst, int ldd) {
    const int tid = ltid(), kr = tid >> 6, cl = tid & 63;
    const float* sp = (mode == 1 && cl >= 32) ? (srcB + cl - 32) : (srcA + cl);
    float v[8];
#pragma unroll
    for (int p = 0; p < 8; ++p) v[p] = sp[(size_t)(p * 8 + kr) * ld];
    __syncthreads();
#pragma unroll
    for (int p = 0; p < 8; ++p) t[(p * 8 + kr) * 65 + cl] = v[p];
    __syncthreads();
    const int r = tid >> 3, seg = (tid & 7) * 8;
    const int lc = mode == 1 ? (((r >> 2) & 1) * 32 + 4 * (r >> 3) + (r & 3)) : r;
    float w[8];
#pragma unroll
    for (int j = 0; j < 8; ++j) w[j] = t[(seg + j) * 65 + lc];
    u32x4 o; o.x = cvt_pk_bf16(w[0], w[1]); o.y = cvt_pk_bf16(w[2], w[3]); o.z = cvt_pk_bf16(w[4], w[5]); o.w = cvt_pk_bf16(w[6], w[7]);
    *(u32x4*)(dst + (size_t)r * ldd + seg) = o;
}
__device__ __forceinline__ void cvt_job(LAS float* t, int tile, const float* src, int ld, int K, bf16_t* dst) {
    const int nkt = K / 64, nt = tile / nkt, kt = tile % nkt;
    cvt_tile(t, src + (size_t)kt * 64 * ld + nt * 64, nullptr, ld, 0, dst + (size_t)nt * 64 * K + kt * 64, K);
}

__device__ void ph_pro1(CtxK& c, LAS unsigned char* lds) {
    const int tid = ltid(), wg = blockIdx.x, G = gridDim.x;
    LAS float* lf = (LAS float*)lds;
    for (int job = wg; job < 192; job += G) {
        const int cc = job % 48, kp = job / 48, q = tid & 63, rg = tid >> 6;
        f32x4 a = {0.f, 0.f, 0.f, 0.f};
        for (int r = rg; r < 512; r += 8) { const int k = kp * 512 + r; const float s = siluf_(c.c[k]); a += s * *(const f32x4*)(c.w_ada + (size_t)k * (6 * D) + cc * 256 + q * 4); }
        __syncthreads();
        *(LAS f32x4*)(lf + (rg * 64 + q) * 4) = a;
        __syncthreads();
        if (tid < 64) { f32x4 s = {0.f, 0.f, 0.f, 0.f};
#pragma unroll
            for (int g = 0; g < 8; ++g) s += *(LAS f32x4*)(lf + (g * 64 + tid) * 4);
            *(f32x4*)(c.modp + (size_t)kp * (6 * D) + cc * 256 + tid * 4) = s; }
    }
    if (wg == G - 1) for (int j = tid; j < 1024; j += 512) c.lb[j] = 1.f / (1.f + expf(c.lb_table[1024 + j] - c.lb_table[j]));
    for (int T = wg; T < 8192; T += G) {
        if (T < 6144) { const int nt = T / 32, kt = T % 32; const int sc = nt * 64 + (nt * 64 >= WIN_GAB ? 16 : 0);
            cvt_tile(lf, c.w_in + (size_t)kt * 64 * INW + sc, nullptr, INW, 0, c.win_t + (size_t)nt * 64 * D + kt * 64, D); }
        else if (T < 6656) cvt_job(lf, T - 6144, c.w_bh, D, 1024, c.wa_t);
        else if (T < 7168) cvt_job(lf, T - 6656, c.w_bg, D, 1024, c.wb_t);
        else cvt_job(lf, T - 7168, c.w_out, D, 2048, c.wout_t);
    }
}
__device__ void ph_norm1(CtxK& c, LAS unsigned char* lds) {
    const int tid = ltid(), wg = blockIdx.x, G = gridDim.x, lane = tid & 63, wv = tid >> 6;
    LAS float* la = (LAS float*)lds;
    LAS float* lb_ = la + D;
    LAS float* lw = lb_ + D;
    for (int j = tid; j < D; j += 512) {
        float sh = c.b_ada[j], sc = c.b_ada[D + j];
#pragma unroll
        for (int p = 0; p < 4; ++p) { sh += c.modp[(size_t)p * 6 * D + j]; sc += c.modp[(size_t)p * 6 * D + D + j]; }
        la[j] = c.norm1_g[j] * (1.f + sc); lb_[j] = sh;
    }
    for (int j = wg * 512 + tid; j < 6 * D; j += G * 512) { float m = c.b_ada[j];
#pragma unroll
        for (int p = 0; p < 4; ++p) m += c.modp[(size_t)p * 6 * D + j];
        c.mod[j] = m; }
    for (int i = tid; i < D * 4; i += 512) { const int e = i >> 2, q = i & 3; const f32x4 w = *(const f32x4*)(c.w_in + (size_t)e * INW + WIN_GAB + q * 4);
        lw[(q * 4 + 0) * D + e] = w[0]; lw[(q * 4 + 1) * D + e] = w[1]; lw[(q * 4 + 2) * D + e] = w[2]; lw[(q * 4 + 3) * D + e] = w[3]; }
    __syncthreads();
    for (int row = wg * 8 + wv; row < S; row += G * 8) {
        const float* xr = c.x + (size_t)row * D; f32x4 v[8]; float ss = 0.f;
#pragma unroll
        for (int i = 0; i < 8; ++i) { v[i] = *(const f32x4*)(xr + i * 256 + lane * 4); ss += v[i][0] * v[i][0] + v[i][1] * v[i][1] + v[i][2] * v[i][2] + v[i][3] * v[i][3]; }
        ss = wave_sum(ss); const float r = rsqrtf(ss * (1.f / D) + 1e-6f);
#pragma unroll
        for (int i = 0; i < 8; ++i) { const int e = i * 256 + lane * 4; const f32x4 a = *(LAS f32x4*)(la + e), b = *(LAS f32x4*)(lb_ + e); v[i] = v[i] * r * a + b;
            u32x2 w; w.x = cvt_pk_bf16(v[i][0], v[i][1]); w.y = cvt_pk_bf16(v[i][2], v[i][3]); *(u32x2*)(c.h1 + (size_t)row * D + e) = w; }
        float mine = 0.f;
        for (int cc = 0; cc < 16; ++cc) { float d = 0.f;
#pragma unroll
            for (int i = 0; i < 8; ++i) { const f32x4 w = *(LAS f32x4*)(lw + cc * D + i * 256 + lane * 4); d += v[i][0] * w[0] + v[i][1] * w[1] + v[i][2] * w[2] + v[i][3] * w[3]; }
            d = wave_sum(d); if (lane == cc) mine = d; }
        if (lane < 16) c.gab[(size_t)row * 16 + lane] = mine;
    }
    { const int id = wg * 512 + tid, i = id >> 6, e = id & 63;
      if (id < D * 64) {
          float sc = c.b_ada[4 * D + i];
#pragma unroll
          for (int p = 0; p < 4; ++p) sc += c.modp[(size_t)p * 6 * D + 4 * D + i];
          const float w = c.norm2_g[i] * (1.f + sc) * c.w_router[id];
          const unsigned hi = cvt_pk_bf16(w, w) & 0xffffu; const float lo = w - __uint_as_float(hi << 16);
          const int ch = i >> 7, kk = i & 127;
          c.rwimg[((ch * 2 + 0) * 64 + e) * 136 + kk] = (bf16_t)hi; c.rwimg[((ch * 2 + 1) * 64 + e) * 136 + kk] = (bf16_t)(cvt_pk_bf16(lo, lo) & 0xffffu);
      } }
    if (wg < 64) {
        __syncthreads();
        float a = 0.f;
        for (int i = tid; i < D; i += 512) { float sh = c.b_ada[3 * D + i];
#pragma unroll
            for (int p = 0; p < 4; ++p) sh += c.modp[(size_t)p * 6 * D + 3 * D + i];
            a += sh * c.w_router[i * 64 + wg]; }
        a = wave_sum(a); if (lane == 0) la[wv] = a; __syncthreads();
        if (tid == 0) c.rbias2[wg] = la[0] + la[1] + la[2] + la[3] + la[4] + la[5] + la[6] + la[7];
    }
}
__device__ void ph_gemm1(CtxK& c, LAS unsigned char* lds) {
    gm::DenseSched Sd; Sd.init(S, PW, D, D, c.win_t, nullptr, 1); gm::EpiProj E{c.proj};
    gm::gphase(lds, (const char*)c.h1, D, Sd, E);
}
__device__ void ph_gemm2(CtxK& c, LAS unsigned char* lds) {
    gm::DenseSched Sd; Sd.init(S, D, 1024, 2048, c.wa_t, c.wb_t, 2); gm::EpiMerge E{c.proj, c.merged};
    gm::gphase(lds, (const char*)c.ocat, 1024, Sd, E);
}
__device__ void ph_gemm3(CtxK& c, LAS unsigned char* lds) {
    gm::DenseSched Sd; Sd.init(S, D, D, D, c.wout_t, nullptr, 1); gm::EpiResid E{c.x, c.mod + 2 * D, c.out};
    gm::gphase(lds, (const char*)c.merged, D, Sd, E);
}
__device__ void ph_moe_gu(CtxK& c, LAS unsigned char* lds) {
    gm::MoeSched<true> Sm; Sm.init(4, D, D, c.nent, c.blk_row, c.blk_exp, c.tok_p, c.gu_t, (size_t)1024 * D * 2); gm::EpiSwiglu E{c.hid};
    gm::gphase(lds, (const char*)c.h2, D, Sm, E);
}
__device__ void ph_moe_dn(CtxK& c, LAS unsigned char* lds) {
    gm::MoeSched<false> Sm; Sm.init(8, FF, FF, c.nent, c.blk_row, c.blk_exp, c.tok_p, c.dn_t, (size_t)D * FF * 2); gm::EpiDown E{c.Y, c.w_p};
    gm::gphase(lds, (const char*)c.hid, FF, Sm, E);
}
__device__ void ph_cvt_exp(CtxK& c, LAS unsigned char* lds) {
    LAS float* lf = (LAS float*)lds; const int wg = blockIdx.x - 8, G = gridDim.x - 8;
    if (wg < 0) return;
    constexpr int GU_T = 16 * 32, DN_T = 32 * 8;
    for (int T = wg; T < NEX * (GU_T + DN_T); T += G) {
        if (T < NEX * GU_T) { const int e = T / GU_T, r = T % GU_T, nt = r / 32, kt = r % 32;
            const float* sg = e < NE ? c.w_eg + (size_t)e * D * FF : c.w_sg; const float* su = e < NE ? c.w_eu + (size_t)e * D * FF : c.w_su;
            cvt_tile(lf, sg + (size_t)kt * 64 * FF + nt * 32, su + (size_t)kt * 64 * FF + nt * 32, FF, 1, c.gu_t + ((size_t)e * 1024 + nt * 64) * D + kt * 64, D); }
        else { const int T2 = T - NEX * GU_T, e = T2 / DN_T, r = T2 % DN_T; const float* sd = e < NE ? c.w_ed + (size_t)e * FF * D : c.w_sd;
            cvt_job(lf, r, sd, D, FF, c.dn_t + (size_t)e * D * FF); }
    }
}
__device__ void ph_final(CtxK& c, LAS unsigned char* lds) {
    const int tid = ltid(), wg = blockIdx.x, G = gridDim.x, lane = tid & 63, wv = tid >> 6;
    const float* gt2 = c.mod + 5 * D;
    for (int row = wg * 8 + wv; row < S; row += G * 8) {
        int p[9];
#pragma unroll
        for (int k = 0; k < 8; ++k) p[k] = c.pos[row * TOPK + k];
        p[8] = PROUTED + row;
        f32x4 v[8]; float ss = 0.f;
#pragma unroll
        for (int i = 0; i < 8; ++i) {
            const int e = i * 256 + lane * 4; f32x4 a = {0.f, 0.f, 0.f, 0.f};
#pragma unroll
            for (int k = 0; k < 9; ++k) { const u32x2 y = *(const u32x2*)(c.Y + (size_t)p[k] * D + e); a[0] += bflo(y.x); a[1] += bfhi(y.x); a[2] += bflo(y.y); a[3] += bfhi(y.y); }
            const f32x4 xv = *(const f32x4*)(c.out + (size_t)row * D + e), g = *(const f32x4*)(gt2 + e);
            v[i] = xv + g * a; ss += v[i][0] * v[i][0] + v[i][1] * v[i][1] + v[i][2] * v[i][2] + v[i][3] * v[i][3];
        }
        ss = wave_sum(ss); const float r = rsqrtf(ss * (1.f / D) + 1e-6f);
#pragma unroll
        for (int i = 0; i < 8; ++i) { const int e = i * 256 + lane * 4; *(f32x4*)(c.out + (size_t)row * D + e) = v[i] * r * *(const f32x4*)(c.normf_g + e); }
    }
}


namespace mx {
constexpr int ST128 = 272, ST64 = 144;
constexpr int FRAG_F4 = 8 * 8 * 64;
__device__ __forceinline__ f32x4 mfma16(bf16x8 a, bf16x8 b, f32x4 c) { return __builtin_amdgcn_mfma_f32_16x16x32_bf16(a, b, c, 0, 0, 0); }
template <int MT, int KS>
__device__ __forceinline__ void mma_nt(f32x4 (&acc)[MT], LAS const unsigned char* xs, int sx, LAS const unsigned char* ys, int sy, int fr, int fq) {
#pragma unroll
    for (int kk = 0; kk < KS; ++kk) {
        const bf16x8 b = *(const LAS bf16x8*)(ys + fr * sy + (kk * 32 + fq * 8) * 2);
#pragma unroll
        for (int m = 0; m < MT; ++m) { const bf16x8 a = *(const LAS bf16x8*)(xs + (16 * m + fr) * sx + (kk * 32 + fq * 8) * 2); acc[m] = mfma16(a, b, acc[m]); }
    }
}
__device__ __forceinline__ void lds_fence() { asm volatile("s_waitcnt lgkmcnt(0)" ::: "memory"); }
__device__ __forceinline__ u32x4 pack8(const float (&v)[8]) { u32x4 o; o.x = cvt_pk_bf16(v[0], v[1]); o.y = cvt_pk_bf16(v[2], v[3]); o.z = cvt_pk_bf16(v[4], v[5]); o.w = cvt_pk_bf16(v[6], v[7]); return o; }
__device__ __forceinline__ void unpack8(const u32x4 w, float (&v)[8]) { v[0] = bflo(w.x); v[1] = bfhi(w.x); v[2] = bflo(w.y); v[3] = bfhi(w.y); v[4] = bflo(w.z); v[5] = bfhi(w.z); v[6] = bflo(w.w); v[7] = bfhi(w.w); }
__device__ __forceinline__ void mfma_pad8(f32x4 (&a)[8]) { asm volatile("s_nop 15\n\ts_nop 7" : "+v"(a[0]), "+v"(a[1]), "+v"(a[2]), "+v"(a[3]), "+v"(a[4]), "+v"(a[5]), "+v"(a[6]), "+v"(a[7])); }
__device__ __forceinline__ void mfma_pad4(f32x4 (&a)[4]) { asm volatile("s_nop 15\n\ts_nop 7" : "+v"(a[0]), "+v"(a[1]), "+v"(a[2]), "+v"(a[3])); }
__device__ __forceinline__ void write_st(LAS unsigned char* stw, f32x4 (&S)[8], int fr, int fq) {
    mfma_pad8(S);
#pragma unroll
    for (int m = 0; m < 8; ++m) { u32x2 w; w.x = cvt_pk_bf16(S[m][0], S[m][1]); w.y = cvt_pk_bf16(S[m][2], S[m][3]); *(LAS u32x2*)(stw + fr * ST128 + (16 * m + 4 * fq) * 2) = w; }
}

__device__ __forceinline__ void gate_issue(u32x4 (&gp)[2], const bf16_t* gate0) {
    const int t_ = ltid(); const bf16_t* p = gate0 + (size_t)(t_ >> 3) * PW + (t_ & 7) * 16;
    gp[0] = *(const u32x4*)p; gp[1] = *(const u32x4*)(p + 8);
}
__device__ __forceinline__ void out_stage(LAS unsigned char* ot, LAS float* part, const f32x4 (&o)[4], const u32x4 (&gp)[2], const float* gnorm, bf16_t* out0, int wv, int lane, int fr, int fq) {
    float s_ = 0.f;
#pragma unroll
    for (int w = 0; w < 8; ++w) s_ += part[w * 64 + lane];
    const float rv = rsqrtf(s_ * (1.f / 128.f) + 1e-6f);
    const float gn = gnorm[wv * 16 + fr];
#pragma unroll
    for (int m = 0; m < 4; ++m)
#pragma unroll
        for (int r = 0; r < 4; ++r) { const int cc = 16 * m + 4 * fq + r; const float x = o[m][r] * __shfl(rv, cc) * gn;
            *(LAS bf16_t*)(ot + cc * ST128 + (wv * 16 + fr) * 2) = (bf16_t)(cvt_pk_bf16(x, x) & 0xffffu); }
    __syncthreads();
    const int t_ = ltid(), cc = t_ >> 3, sg = (t_ & 7) * 16;
#pragma unroll
    for (int hh = 0; hh < 2; ++hh) { float ov[8], gv[8];
        unpack8(*(LAS u32x4*)(ot + cc * ST128 + (sg + hh * 8) * 2), ov); unpack8(gp[hh], gv);
#pragma unroll
        for (int j = 0; j < 8; ++j) ov[j] *= siluf_(gv[j]);
        *(u32x4*)(out0 + (size_t)cc * D + sg + hh * 8) = pack8(ov); }
}

constexpr int H_QT = 0, H_KT = 17408, H_QI = 34816, H_KU = 52224, H_VT = 70656, H_P = 89088, H_DEC = 98304, H_OCT = 98816, H_F4 = 102912, H_PART = 103424, H_RINV = 105472, H_ST = 105728, H_END = H_ST + 8 * 16 * ST128;
static_assert(H_END <= 147456, "hgrn lds");
template <bool OUT>
__device__ void hgrn_pass(CtxK& c, LAS unsigned char* lds) {
    const int tid = ltid(), wv = __builtin_amdgcn_readfirstlane(tid >> 6), lane = tid & 63, fr = lane & 15, fq = lane >> 4;
    LAS float* dec = (LAS float*)(lds + H_DEC); LAS float* oct = (LAS float*)(lds + H_OCT); LAS float* f4 = (LAS float*)(lds + H_F4);
    LAS float* part = (LAS float*)(lds + H_PART); LAS float* rinv = (LAS float*)(lds + H_RINV);
    LAS unsigned char* stw = lds + H_ST + wv * 16 * ST128;
    {
        const int wu = blockIdx.x, h = wu & 7, g = wu >> 3;
        f32x4 Sacc[8];
#pragma unroll
        for (int m = 0; m < 8; ++m) Sacc[m] = (f32x4){0.f, 0.f, 0.f, 0.f};
        if (OUT) {
            if (g > 0) { const f32x4* sp = (const f32x4*)c.hS + (size_t)(h * 32 + g) * FRAG_F4 + (wv * 8) * 64 + lane;
#pragma unroll
                for (int m = 0; m < 8; ++m) Sacc[m] = sp[m * 64]; }
            write_st(stw, Sacc, fr, fq);
        }
        float dsum = 0.f;
        for (int i = 0; i < 8; ++i) {
            const int T0 = (g * 8 + i) * 64;
            u32x4 gpre[2];
            if (OUT) gate_issue(gpre, c.proj + (size_t)T0 * PW + C_HG + h * 128);
            const int tp = ltid(), to = (tp >> 4) & 7, co = tp & 15, c0 = to * 8, d0 = co * 8;
            float cs[8][8];
            if (tid < 128) {
                float lbv[8];
                { const f32x4 l0 = *(const f32x4*)(c.lb + h * 128 + d0), l1 = *(const f32x4*)(c.lb + h * 128 + d0 + 4);
                  lbv[0] = l0[0]; lbv[1] = l0[1]; lbv[2] = l0[2]; lbv[3] = l0[3]; lbv[4] = l1[0]; lbv[5] = l1[1]; lbv[6] = l1[2]; lbv[7] = l1[3]; }
#pragma unroll
                for (int tt = 0; tt < 8; ++tt) {
                    float fv[8]; unpack8(*(const u32x4*)(c.proj + (size_t)(T0 + c0 + tt) * PW + C_HF + h * 128 + d0), fv);
#pragma unroll
                    for (int j = 0; j < 8; ++j) { const float lf = __logf(lbv[j] + (1.f - lbv[j]) * sigmoidf_(fv[j])); cs[tt][j] = tt ? cs[tt - 1][j] + lf : lf; }
                }
#pragma unroll
                for (int j = 0; j < 8; ++j) { oct[to * 128 + d0 + j] = cs[7][j]; if (to == 4) f4[d0 + j] = cs[0][j]; }
            }
            __syncthreads();
            if (tid < 128) {
                float pre[8], tot[8], bmid[8], ebm[8];
#pragma unroll
                for (int j = 0; j < 8; ++j) { float p = 0.f, t_ = 0.f, bm = 0.f;
#pragma unroll
                    for (int o = 0; o < 8; ++o) { const float x = oct[o * 128 + d0 + j]; p += o < to ? x : 0.f; bm += o < 4 ? x : 0.f; t_ += x; }
                    pre[j] = p; tot[j] = t_; bmid[j] = bm + f4[d0 + j]; ebm[j] = OUT ? __expf(bmid[j]) : 0.f; }
                if (to == 0) {
#pragma unroll
                    for (int j = 0; j < 8; ++j) dec[d0 + j] = __expf(tot[j]);
                }
                if (OUT) {
#pragma unroll
                    for (int tt = 0; tt < 8; ++tt) {
                        float qv[8], q1[8], k1[8], q2[8];
                        unpack8(*(const u32x4*)(c.proj + (size_t)(T0 + c0 + tt) * PW + C_HQ + h * 128 + d0), qv);
#pragma unroll
                        for (int j = 0; j < 8; ++j) {
                            const float lf = tt ? cs[tt][j] - cs[tt - 1][j] : cs[0][j], kk_ = 1.f - __expf(lf), b = pre[j] + cs[tt][j];
                            const float q = siluf_(qv[j]) * 0.08838834764831845f, e1 = __expf(b - bmid[j]); q1[j] = q * e1; k1[j] = kk_ * rcpf_(e1); q2[j] = q1[j] * ebm[j];
                        }
                        *(LAS u32x4*)(lds + H_QT + (c0 + tt) * ST128 + d0 * 2) = pack8(q1); *(LAS u32x4*)(lds + H_KT + (c0 + tt) * ST128 + d0 * 2) = pack8(k1); *(LAS u32x4*)(lds + H_QI + (c0 + tt) * ST128 + d0 * 2) = pack8(q2);
                    }
                }
#pragma unroll
                for (int j = 0; j < 8; ++j) { float col[8];
#pragma unroll
                    for (int tt = 0; tt < 8; ++tt) { const float lf = tt ? cs[tt][j] - cs[tt - 1][j] : cs[0][j]; col[tt] = (1.f - __expf(lf)) * __expf(tot[j] - pre[j] - cs[tt][j]); }
                    *(LAS u32x4*)(lds + H_KU + (d0 + j) * ST64 + c0 * 2) = pack8(col); }
                if (!OUT && to == 0) {   }
            } else if (tid < 256) {
                float vb[8][8];
#pragma unroll
                for (int tt = 0; tt < 8; ++tt) unpack8(*(const u32x4*)(c.proj + (size_t)(T0 + c0 + tt) * PW + C_HI + h * 128 + d0), vb[tt]);
#pragma unroll
                for (int j = 0; j < 8; ++j) { float col[8];
#pragma unroll
                    for (int tt = 0; tt < 8; ++tt) col[tt] = vb[tt][j];
                    *(LAS u32x4*)(lds + H_VT + (d0 + j) * ST64 + c0 * 2) = pack8(col); }
            }
            __syncthreads();
            if (!OUT && tid < 128) dsum += __logf(dec[tid]);
            f32x4 oacc[4];
            if (OUT) {
                { f32x4 sc[2] = {(f32x4){0.f, 0.f, 0.f, 0.f}, (f32x4){0.f, 0.f, 0.f, 0.f}};
                  const int nt = wv & 3, mb = (wv >> 2) * 2;
                  mma_nt<2, 4>(sc, lds + H_KT + mb * 16 * ST128, ST128, lds + H_QT + nt * 16 * ST128, ST128, fr, fq);
#pragma unroll
                  for (int m = 0; m < 2; ++m) { const int cc = nt * 16 + fr, s0 = (mb + m) * 16 + 4 * fq; u32x2 w;
                      w.x = cvt_pk_bf16(s0 + 0 <= cc ? sc[m][0] : 0.f, s0 + 1 <= cc ? sc[m][1] : 0.f); w.y = cvt_pk_bf16(s0 + 2 <= cc ? sc[m][2] : 0.f, s0 + 3 <= cc ? sc[m][3] : 0.f);
                      *(LAS u32x2*)(lds + H_P + cc * ST64 + s0 * 2) = w; } }
                __syncthreads();
#pragma unroll
                for (int m = 0; m < 4; ++m) oacc[m] = (f32x4){0.f, 0.f, 0.f, 0.f};
                mma_nt<4, 2>(oacc, lds + H_P, ST64, lds + H_VT + wv * 16 * ST64, ST64, fr, fq);
                mma_nt<4, 4>(oacc, lds + H_QI, ST128, stw, ST128, fr, fq);
#pragma unroll
                for (int m = 0; m < 4; ++m)
#pragma unroll
                    for (int r = 0; r < 4; ++r) { float q = oacc[m][r] * oacc[m][r]; q += __shfl_xor(q, 1); q += __shfl_xor(q, 2); q += __shfl_xor(q, 4); q += __shfl_xor(q, 8); if (fr == 0) part[wv * 64 + 16 * m + 4 * fq + r] = q; }
            }
#pragma unroll
            for (int m = 0; m < 8; ++m) { const f32x4 dv = *(LAS f32x4*)(dec + 16 * m + 4 * fq); Sacc[m] = Sacc[m] * dv; }
            mma_nt<8, 2>(Sacc, lds + H_KU, ST64, lds + H_VT + wv * 16 * ST64, ST64, fr, fq);
            if (OUT) {
                lds_fence();
                write_st(stw, Sacc, fr, fq);
                __syncthreads();
                out_stage(lds + H_QT, part, oacc, gpre, c.hgrn_onorm_g, c.ocat + (size_t)T0 * D + h * 128, wv, lane, fr, fq);
            }
            __syncthreads();
        }
        if (!OUT) {
            f32x4* sp = (f32x4*)c.hL + (size_t)(h * 32 + g) * FRAG_F4 + (wv * 8) * 64 + lane;
#pragma unroll
            for (int m = 0; m < 8; ++m) sp[m * 64] = Sacc[m];
            if (tid < 128) c.hD[(h * 32 + g) * 128 + tid] = __expf(dsum);
        }
    }
}
__device__ void hgrn_scan(CtxK& c) {
    const int e = blockIdx.x * 512 + ltid();
    if (e >= 8 * FRAG_F4) return;
    const int h = e / FRAG_F4, fi = e % FRAG_F4, m = (fi >> 6) & 7, lane = fi & 63, d0 = 16 * m + 4 * (lane >> 4);
    f32x4 s = {0.f, 0.f, 0.f, 0.f};
    for (int g = 0; g < 31; ++g) {
        const f32x4 dc = *(const f32x4*)(c.hD + (h * 32 + g) * 128 + d0);
        s = s * dc + ((const f32x4*)c.hL)[(size_t)(h * 32 + g) * FRAG_F4 + fi];
        ((f32x4*)c.hS)[(size_t)(h * 32 + g + 1) * FRAG_F4 + fi] = s;
    }
}

constexpr int B_T = 0, B_KBG = 9216, B_KU = 26624, B_VB = 45056, B_QD = 63488, B_AT = 80896, B_SC = 90112, BLOB = 90368;
constexpr int G_ST = BLOB, G_RV = G_ST + 8 * 16 * ST128, G_PART = G_RV + 8 * 16 * ST64, G_RINV = G_PART + 2048, G_END = G_RINV + 256;
static_assert(G_END <= 147456, "gdn lds");
constexpr int P_K = 0, P_Q = 17408, P_BETA = 34816, P_GC = P_BETA + 256, P_EG = P_GC + 256, P_EK = P_EG + 256;

__device__ void gdn_prep(CtxK& c, LAS unsigned char* lds, int h, int g) {
    const int tid = ltid(), wv = __builtin_amdgcn_readfirstlane(tid >> 6), lane = tid & 63, fr = lane & 15, fq = lane >> 4;
    LAS float* sbeta = (LAS float*)(lds + P_BETA); LAS float* sgc = (LAS float*)(lds + P_GC); LAS float* seg = (LAS float*)(lds + P_EG); LAS float* sek = (LAS float*)(lds + P_EK);
    for (int i = 0; i < 8; ++i) {
        const int n = g * 8 + i, T0 = n * 64;
        unsigned char* blob = (unsigned char*)c.gBlob + (size_t)(h * 256 + n) * BLOB;
        if (wv == 0) {
            const float ga = c.gab[(size_t)(T0 + lane) * 16 + h], gb = c.gab[(size_t)(T0 + lane) * 16 + 8 + h];
            const float gl_ = -__expf(c.a_log[h]) * softplusf_(ga + c.dt_bias[h]);
            float gc = gl_;
#pragma unroll
            for (int o = 1; o < 64; o <<= 1) { const float t_ = __shfl_up(gc, o); if (lane >= o) gc += t_; }
            const float glast = __shfl(gc, 63);
            sbeta[lane] = sigmoidf_(gb); sgc[lane] = gc; seg[lane] = __expf(gc); sek[lane] = __expf(glast - gc);
            if (lane == 0) *(float*)(blob + B_SC) = __expf(glast);
        }
        __syncthreads();
        const int tp = ltid(), part = tp >> 7, to = (tp >> 4) & 7, co = tp & 15, c0 = to * 8, d0 = co * 8;
        if (tp < 384) {
            const int chb = part * 1024 + h * 128 + d0;
            float val[8][8];
            {
                float wj[4][8];
#pragma unroll
                for (int j = 0; j < 4; ++j) { const f32x4 a = *(const f32x4*)(c.conv_w + j * 3072 + chb), b = *(const f32x4*)(c.conv_w + j * 3072 + chb + 4);
                    wj[j][0] = a[0]; wj[j][1] = a[1]; wj[j][2] = a[2]; wj[j][3] = a[3]; wj[j][4] = b[0]; wj[j][5] = b[1]; wj[j][6] = b[2]; wj[j][7] = b[3]; }
                u32x4 raw[11];
#pragma unroll
                for (int r = 0; r < 11; ++r) { const int tok = T0 + c0 - 3 + r; raw[r] = tok >= 0 ? *(const u32x4*)(c.proj + (size_t)tok * PW + C_GQKV + chb) : (u32x4){0u, 0u, 0u, 0u}; }
#pragma unroll
                for (int tt = 0; tt < 8; ++tt) {
                    float a[8] = {0.f, 0.f, 0.f, 0.f, 0.f, 0.f, 0.f, 0.f};
#pragma unroll
                    for (int j = 0; j < 4; ++j) { float xv[8]; unpack8(raw[tt + j], xv);
#pragma unroll
                        for (int jj = 0; jj < 8; ++jj) a[jj] += wj[j][jj] * xv[jj]; }
#pragma unroll
                    for (int jj = 0; jj < 8; ++jj) val[tt][jj] = siluf_(a[jj]);
                }
            }
            if (part < 2) {
#pragma unroll
                for (int tt = 0; tt < 8; ++tt) { float ss = 0.f;
#pragma unroll
                    for (int jj = 0; jj < 8; ++jj) ss += val[tt][jj] * val[tt][jj];
                    ss += __shfl_xor(ss, 1); ss += __shfl_xor(ss, 2); ss += __shfl_xor(ss, 4); ss += __shfl_xor(ss, 8);
                    const float rn = rsqrtf(ss + 1e-6f) * (part == 0 ? 0.08838834764831845f : 1.f);
#pragma unroll
                    for (int jj = 0; jj < 8; ++jj) val[tt][jj] *= rn; }
            }
            if (part == 0) {
#pragma unroll
                for (int tt = 0; tt < 8; ++tt) { const int cc = c0 + tt; *(LAS u32x4*)(lds + P_Q + cc * ST128 + d0 * 2) = pack8(val[tt]);
                    const float e = seg[cc]; float qd[8];
#pragma unroll
                    for (int jj = 0; jj < 8; ++jj) qd[jj] = val[tt][jj] * e;
                    *(u32x4*)(blob + B_QD + cc * ST128 + d0 * 2) = pack8(qd); }
            } else if (part == 1) {
#pragma unroll
                for (int tt = 0; tt < 8; ++tt) { const int cc = c0 + tt; *(LAS u32x4*)(lds + P_K + cc * ST128 + d0 * 2) = pack8(val[tt]);
                    const float e = seg[cc] * sbeta[cc]; float kb[8];
#pragma unroll
                    for (int jj = 0; jj < 8; ++jj) kb[jj] = val[tt][jj] * e;
                    *(u32x4*)(blob + B_KBG + cc * ST128 + d0 * 2) = pack8(kb); }
#pragma unroll
                for (int jj = 0; jj < 8; ++jj) { float col[8];
#pragma unroll
                    for (int tt = 0; tt < 8; ++tt) col[tt] = val[tt][jj] * sek[c0 + tt];
                    *(u32x4*)(blob + B_KU + (d0 + jj) * ST64 + c0 * 2) = pack8(col); }
            } else {
#pragma unroll
                for (int jj = 0; jj < 8; ++jj) { float col[8];
#pragma unroll
                    for (int tt = 0; tt < 8; ++tt) col[tt] = val[tt][jj] * sbeta[c0 + tt];
                    *(u32x4*)(blob + B_VB + (d0 + jj) * ST64 + c0 * 2) = pack8(col); }
            }
        }
        __syncthreads();
        {
            const int nt = wv & 3, mb = (wv >> 2) * 2, jj = nt * 16 + fr;
            f32x4 kk2[2] = {(f32x4){0.f, 0.f, 0.f, 0.f}, (f32x4){0.f, 0.f, 0.f, 0.f}}, at2[2] = {(f32x4){0.f, 0.f, 0.f, 0.f}, (f32x4){0.f, 0.f, 0.f, 0.f}};
            mma_nt<2, 4>(kk2, lds + P_K + mb * 16 * ST128, ST128, lds + P_K + nt * 16 * ST128, ST128, fr, fq);
            mma_nt<2, 4>(at2, lds + P_K + mb * 16 * ST128, ST128, lds + P_Q + nt * 16 * ST128, ST128, fr, fq);
            float* at = c.gAT + (size_t)(h * 256 + n) * 4096;
            const float gj = sgc[jj];
#pragma unroll
            for (int m = 0; m < 2; ++m) { const int i0 = (mb + m) * 16 + 4 * fq; f32x4 av; float pv[4];
#pragma unroll
                for (int r = 0; r < 4; ++r) { const int ii = i0 + r; const float gi = sgc[ii];
                    av[r] = jj < ii ? sbeta[ii] * kk2[m][r] * __expf(gi - gj) : 0.f;
                    pv[r] = ii <= jj ? at2[m][r] * __expf(gj - gi) : 0.f; }
                *(f32x4*)(at + jj * 64 + i0) = av;
                u32x2 w; w.x = cvt_pk_bf16(pv[0], pv[1]); w.y = cvt_pk_bf16(pv[2], pv[3]);
                *(u32x2*)(blob + B_AT + jj * ST64 + i0 * 2) = w; }
        }
        __syncthreads();
    }
}
__device__ void gdn_invert(CtxK& c, LAS unsigned char* lds, int h, int g) {
    const int tid = ltid(), wv = __builtin_amdgcn_readfirstlane(tid >> 6), lane = tid & 63;
    const int n = g * 8 + wv;
    LAS float* at = (LAS float*)(lds + wv * 16384);
    const float* src = c.gAT + (size_t)(h * 256 + n) * 4096;
#pragma unroll
    for (int k = 0; k < 16; ++k) *(LAS f32x4*)(at + (k * 64 + lane) * 4) = *(const f32x4*)(src + (k * 64 + lane) * 4);
    lds_fence();
    float r[64];
    unsigned ata = (unsigned)(size_t)at;
#pragma unroll
    for (int j = 63; j >= 0; --j) {
        float acc = lane == j ? 1.f : 0.f;
        LAS const float* arow = (LAS const float*)(size_t)ata + j * 64;
#pragma unroll
        for (int m4 = ((j + 1) & ~3); m4 < 64; m4 += 4) {
            const f32x4 a = *(LAS const f32x4*)(arow + m4);
#pragma unroll
            for (int q = 0; q < 4; ++q) if (m4 + q > j) acc = __builtin_fmaf(-r[m4 + q], a[q], acc);
        }
        r[j] = acc;
        asm volatile("" : "+v"(ata) : "v"(acc));
    }
    unsigned char* blob = (unsigned char*)c.gBlob + (size_t)(h * 256 + n) * BLOB;
#pragma unroll
    for (int k = 0; k < 8; ++k) { float v8[8];
#pragma unroll
        for (int q = 0; q < 8; ++q) v8[q] = r[k * 8 + q];
        *(u32x4*)(blob + B_T + lane * ST64 + k * 16) = pack8(v8); }
}
template <int MODE>
__device__ void gdn_pass(CtxK& c, LAS unsigned char* lds, int h, int g) {
    const int tid = ltid(), wv = __builtin_amdgcn_readfirstlane(tid >> 6), lane = tid & 63, fr = lane & 15, fq = lane >> 4;
    LAS unsigned char* stw = lds + G_ST + wv * 16 * ST128; LAS unsigned char* rvw = lds + G_RV + wv * 16 * ST64;
    LAS float* part = (LAS float*)(lds + G_PART); LAS float* rinv = (LAS float*)(lds + G_RINV);
    f32x4 Sacc[8];
#pragma unroll
    for (int m = 0; m < 8; ++m) {
        if (MODE == 1) { const int v = 16 * wv + fr, d0 = 16 * m + 4 * fq; Sacc[m] = (f32x4){d0 == v ? 1.f : 0.f, d0 + 1 == v ? 1.f : 0.f, d0 + 2 == v ? 1.f : 0.f, d0 + 3 == v ? 1.f : 0.f}; }
        else Sacc[m] = (f32x4){0.f, 0.f, 0.f, 0.f};
    }
    if (MODE == 2 && g > 0) { const f32x4* sp = (const f32x4*)c.gS + (size_t)(h * 32 + g) * FRAG_F4 + (wv * 8) * 64 + lane;
#pragma unroll
        for (int m = 0; m < 8; ++m) Sacc[m] = sp[m * 64]; }
    write_st(stw, Sacc, fr, fq);
    constexpr int LIM = MODE == 2 ? B_SC : B_QD, NQ = (LIM + 8191) / 8192;
    u32x4 pre[NQ];
    const unsigned char* blob0 = (const unsigned char*)c.gBlob + (size_t)(h * 256 + g * 8) * BLOB;
#define GP_ISSUE(i_) do { const unsigned char* bp_ = blob0 + (size_t)(i_) * BLOB + ltid() * 16; _Pragma("unroll") for (int q = 0; q < NQ; ++q) if (q * 8192 + 8176 < LIM || ltid() * 16 + q * 8192 < LIM) pre[q] = *(const u32x4*)(bp_ + q * 8192); } while (0)
    GP_ISSUE(0);
    for (int i = 0; i < 8; ++i) {
        const int n = g * 8 + i, T0 = n * 64;
        { const int tl = ltid() * 16;
#pragma unroll
          for (int q = 0; q < NQ; ++q) if (q * 8192 + 8176 < LIM || tl + q * 8192 < LIM) *(LAS u32x4*)(lds + tl + q * 8192) = pre[q]; }
        const float dlast = *(const float*)(blob0 + (size_t)i * BLOB + B_SC);
        u32x4 gpre[2];
        if (MODE == 2) gate_issue(gpre, c.proj + (size_t)T0 * PW + C_GG + h * 128);
        __syncthreads();
        if (i + 1 < 8) GP_ISSUE(i + 1);
        { f32x4 R[4];
#pragma unroll
          for (int m = 0; m < 4; ++m) R[m] = (f32x4){0.f, 0.f, 0.f, 0.f};
          mma_nt<4, 4>(R, lds + B_KBG, ST128, stw, ST128, fr, fq);
#pragma unroll
          for (int m = 0; m < 4; ++m) { float x0 = 0.f, x1 = 0.f, x2 = 0.f, x3 = 0.f;
              if (MODE != 1) { const u32x2 vb = *(LAS u32x2*)(lds + B_VB + (16 * wv + fr) * ST64 + (16 * m + 4 * fq) * 2); x0 = bflo(vb.x); x1 = bfhi(vb.x); x2 = bflo(vb.y); x3 = bfhi(vb.y); }
              u32x2 w; w.x = cvt_pk_bf16(x0 - R[m][0], x1 - R[m][1]); w.y = cvt_pk_bf16(x2 - R[m][2], x3 - R[m][3]);
              *(LAS u32x2*)(rvw + fr * ST64 + (16 * m + 4 * fq) * 2) = w; } }
        lds_fence();
        { f32x4 VN[4];
#pragma unroll
          for (int m = 0; m < 4; ++m) VN[m] = (f32x4){0.f, 0.f, 0.f, 0.f};
          mma_nt<4, 2>(VN, lds + B_T, ST64, rvw, ST64, fr, fq);
          mfma_pad4(VN); lds_fence();
#pragma unroll
          for (int m = 0; m < 4; ++m) { u32x2 w; w.x = cvt_pk_bf16(VN[m][0], VN[m][1]); w.y = cvt_pk_bf16(VN[m][2], VN[m][3]); *(LAS u32x2*)(rvw + fr * ST64 + (16 * m + 4 * fq) * 2) = w; } }
        lds_fence();
        f32x4 O[4];
        if (MODE == 2) {
#pragma unroll
            for (int m = 0; m < 4; ++m) O[m] = (f32x4){0.f, 0.f, 0.f, 0.f};
            mma_nt<4, 4>(O, lds + B_QD, ST128, stw, ST128, fr, fq);
            mma_nt<4, 2>(O, lds + B_AT, ST64, rvw, ST64, fr, fq);
#pragma unroll
            for (int m = 0; m < 4; ++m)
#pragma unroll
                for (int r = 0; r < 4; ++r) { float q = O[m][r] * O[m][r]; q += __shfl_xor(q, 1); q += __shfl_xor(q, 2); q += __shfl_xor(q, 4); q += __shfl_xor(q, 8); if (fr == 0) part[wv * 64 + 16 * m + 4 * fq + r] = q; }
        }
#pragma unroll
        for (int m = 0; m < 8; ++m) Sacc[m] = Sacc[m] * dlast;
        mma_nt<8, 2>(Sacc, lds + B_KU, ST64, rvw, ST64, fr, fq);
        lds_fence();
        write_st(stw, Sacc, fr, fq);
        if (MODE == 2) {
            __syncthreads();
            out_stage(lds + B_KBG, part, O, gpre, c.gdn_onorm_g, c.ocat + (size_t)T0 * D + 1024 + h * 128, wv, lane, fr, fq);
        }
        __syncthreads();
    }
#undef GP_ISSUE
    if (MODE == 0) {
        f32x4* sp = (f32x4*)c.gB + (size_t)(h * 32 + g) * FRAG_F4 + (wv * 8) * 64 + lane;
#pragma unroll
        for (int m = 0; m < 8; ++m) sp[m * 64] = Sacc[m];
    }
    if (MODE == 1) {
        mfma_pad8(Sacc);
        LAS bf16_t* img = (LAS bf16_t*)lds;
#pragma unroll
        for (int m = 0; m < 8; ++m)
#pragma unroll
            for (int r = 0; r < 4; ++r) img[(16 * m + 4 * fq + r) * (ST128 / 2) + 16 * wv + fr] = (bf16_t)(cvt_pk_bf16(Sacc[m][r], Sacc[m][r]) & 0xffffu);
        __syncthreads();
        unsigned char* dst = (unsigned char*)c.gM + (size_t)(h * 32 + g) * (128 * ST128);
#pragma unroll
        for (int q = 0; q < 5; ++q) { const int o = tid * 16 + q * 8192; if (q < 4 || o < 128 * ST128) *(u32x4*)(dst + o) = *(LAS u32x4*)(lds + o); }
        __syncthreads();
    }
}
__device__ void gdn_scan(CtxK& c, LAS unsigned char* lds, int h) {
    const int tid = ltid(), wv = __builtin_amdgcn_readfirstlane(tid >> 6), lane = tid & 63, fr = lane & 15, fq = lane >> 4;
    LAS unsigned char* stw = lds + G_ST + wv * 16 * ST128;
    f32x4 Sacc[8], Bn[8]; u32x4 mp[5];
#pragma unroll
    for (int m = 0; m < 8; ++m) Sacc[m] = (f32x4){0.f, 0.f, 0.f, 0.f};
#define GS_ISSUE(g_) do { const unsigned char* src_ = (const unsigned char*)c.gM + (size_t)(h * 32 + (g_)) * (128 * ST128) + tid * 16; \
        _Pragma("unroll") for (int q = 0; q < 5; ++q) if (q < 4 || tid * 16 + q * 8192 < 128 * ST128) mp[q] = *(const u32x4*)(src_ + q * 8192); \
        const f32x4* bp_ = (const f32x4*)c.gB + (size_t)(h * 32 + (g_)) * FRAG_F4 + (wv * 8) * 64 + lane; \
        _Pragma("unroll") for (int m = 0; m < 8; ++m) Bn[m] = bp_[m * 64]; } while (0)
    GS_ISSUE(0);
    for (int g = 0; g < 31; ++g) {
#pragma unroll
        for (int q = 0; q < 5; ++q) if (q < 4 || tid * 16 + q * 8192 < 128 * ST128) *(LAS u32x4*)(lds + tid * 16 + q * 8192) = mp[q];
        write_st(stw, Sacc, fr, fq);
#pragma unroll
        for (int m = 0; m < 8; ++m) Sacc[m] = Bn[m];
        __syncthreads();
        if (g + 1 < 31) GS_ISSUE(g + 1);
        mma_nt<8, 4>(Sacc, lds, ST128, stw, ST128, fr, fq);
        f32x4* sp = (f32x4*)c.gS + (size_t)(h * 32 + g + 1) * FRAG_F4 + (wv * 8) * 64 + lane;
#pragma unroll
        for (int m = 0; m < 8; ++m) sp[m * 64] = Sacc[m];
        __syncthreads();
    }
#undef GS_ISSUE
}
}
__device__ void ph_hgrn1(CtxK& c, LAS unsigned char* lds) { mx::hgrn_pass<false>(c, lds); }
__device__ void ph_hgrn2(CtxK& c, LAS unsigned char* lds) { mx::hgrn_scan(c); }
__device__ void ph_hgrn3(CtxK& c, LAS unsigned char* lds) { mx::hgrn_pass<true>(c, lds); }
__device__ void ph_gdn1(CtxK& c, LAS unsigned char* lds) {
    const int wu = blockIdx.x, h = wu & 7, g = wu >> 3;
    mx::gdn_prep(c, lds, h, g); __syncthreads();
    asm volatile("s_waitcnt vmcnt(0)" ::: "memory"); __syncthreads();
    mx::gdn_invert(c, lds, h, g);
    asm volatile("s_waitcnt vmcnt(0)" ::: "memory"); __syncthreads();
    mx::gdn_pass<0>(c, lds, h, g); __syncthreads();
    mx::gdn_pass<1>(c, lds, h, g); __syncthreads();
}
__device__ void ph_gdn2(CtxK& c, LAS unsigned char* lds) { if (blockIdx.x < 8) mx::gdn_scan(c, lds, blockIdx.x); }
__device__ void ph_gdn3(CtxK& c, LAS unsigned char* lds) { const int wu = blockIdx.x; mx::gdn_pass<2>(c, lds, wu & 7, wu >> 3); }

__device__ __forceinline__ float pair_sum128(float v, LAS float* red) {
    v = wave_sum(v); const int w = ltid() >> 6;
    __syncthreads(); if ((ltid() & 63) == 0) red[w] = v; __syncthreads();
    return red[w & ~1] + red[w | 1];
}
__device__ void ph_gdn_pre(CtxK& c, LAS unsigned char* lds) {
    LAS float* red = (LAS float*)lds;
    const int tid = ltid() & 255, g = ltid() >> 8;
    for (int t = blockIdx.x * 2 + g; t < S; t += gridDim.x * 2) {
        for (int grp = 0; grp < 12; ++grp) {
            const int ch = grp * 256 + tid; float acc = 0.f;
#pragma unroll
            for (int j = 0; j < 4; ++j) { const int tt = t - 3 + j; if (tt >= 0) acc += c.conv_w[j * 3072 + ch] * bf2f(c.proj[(size_t)tt * PW + C_GQKV + ch]); }
            const float val = siluf_(acc);
            if (grp < 8) {
                const float ss = pair_sum128(val * val, red); const float n = val * rsqrtf(ss + 1e-6f);
                if (grp < 4) c.gq[(size_t)t * 1024 + ch] = n * 0.08838834764831845f; else c.gk[(size_t)t * 1024 + ch - 1024] = n;
            } else c.gv[(size_t)t * 1024 + ch - 2048] = val;
        }
        if (tid < 8) {
            const float ga = c.gab[(size_t)t * 16 + tid], gb = c.gab[(size_t)t * 16 + 8 + tid];
            c.gbeta[t * 8 + tid] = sigmoidf_(gb); c.gdec[t * 8 + tid] = expf(-expf(c.a_log[tid]) * softplusf_(ga + c.dt_bias[tid]));
        }
    }
}
__device__ void ph_mix_naive(CtxK& c, LAS unsigned char* lds) {
    constexpr int TB = 8;
    const int wg = blockIdx.x, t512 = ltid(), tid = t512 & 127; const bool ld = t512 < 128, act = t512 < 256;
    const int v = (t512 >> 1) & 127, d0 = (t512 & 1) * 64;
    if (wg < 8 || wg >= 16) return;
    LAS float* sq = (LAS float*)lds; LAS float* sf = sq + TB * 128; LAS float* sk = sf + TB * 128; LAS float* sv = sk + TB * 128; LAS float* sb = sv + TB * 128; LAS float* sa = sb + TB;
    float st[64];
#pragma unroll
    for (int d = 0; d < 64; ++d) st[d] = 0.f;
    if (wg < 8) {
        const int h = wg; const float lbv = c.lb[h * 128 + tid];
        for (int t0 = 0; t0 < S; t0 += TB) {
            if (ld) for (int tt = 0; tt < TB; ++tt) {
                const bf16_t* base = c.proj + (size_t)(t0 + tt) * PW + h * 128 + tid;
                const float f = lbv + (1.f - lbv) * sigmoidf_(bf2f(base[C_HF]));
                sq[tt * 128 + tid] = siluf_(bf2f(base[C_HQ])) * 0.08838834764831845f; sf[tt * 128 + tid] = f; sk[tt * 128 + tid] = 1.f - f; sv[tt * 128 + tid] = bf2f(base[C_HI]);
            }
            __syncthreads();
            if (act) {
#pragma unroll 1
            for (int tt = 0; tt < TB; ++tt) {
                float o = 0.f; const float vv = sv[tt * 128 + v];
#pragma unroll
                for (int d = 0; d < 64; d += 4) {
                    const f32x4 q4 = *(LAS f32x4*)(sq + tt * 128 + d0 + d), f4 = *(LAS f32x4*)(sf + tt * 128 + d0 + d), k4 = *(LAS f32x4*)(sk + tt * 128 + d0 + d);
                    st[d] = f4[0] * st[d] + k4[0] * vv; o += q4[0] * st[d];
                    st[d + 1] = f4[1] * st[d + 1] + k4[1] * vv; o += q4[1] * st[d + 1];
                    st[d + 2] = f4[2] * st[d + 2] + k4[2] * vv; o += q4[2] * st[d + 2];
                    st[d + 3] = f4[3] * st[d + 3] + k4[3] * vv; o += q4[3] * st[d + 3];
                }
                o += __shfl_xor(o, 1);
                if (d0 == 0) c.oa[(size_t)(t0 + tt) * 1024 + h * 128 + v] = o;
            } }
            __syncthreads();
        }
    } else {
        const int h = wg - 8;
        for (int t0 = 0; t0 < S; t0 += TB) {
            if (ld) { for (int tt = 0; tt < TB; ++tt) {
                const size_t o = (size_t)(t0 + tt) * 1024 + h * 128 + tid;
                sq[tt * 128 + tid] = c.gq[o]; sk[tt * 128 + tid] = c.gk[o]; sv[tt * 128 + tid] = c.gv[o];
            }
            if (tid < TB) { sb[tid] = c.gbeta[(t0 + tid) * 8 + h]; sa[tid] = c.gdec[(t0 + tid) * 8 + h]; } }
            __syncthreads();
            if (act) {
#pragma unroll 1
            for (int tt = 0; tt < TB; ++tt) {
                const float a = sa[tt], be = sb[tt]; float kd = 0.f;
#pragma unroll
                for (int d = 0; d < 64; d += 4) { const f32x4 k4 = *(LAS f32x4*)(sk + tt * 128 + d0 + d); kd += k4[0] * st[d] + k4[1] * st[d + 1] + k4[2] * st[d + 2] + k4[3] * st[d + 3]; }
                kd += __shfl_xor(kd, 1);
                const float c1 = be * (sv[tt * 128 + v] - a * kd); float o = 0.f;
#pragma unroll
                for (int d = 0; d < 64; d += 4) {
                    const f32x4 k4 = *(LAS f32x4*)(sk + tt * 128 + d0 + d), q4 = *(LAS f32x4*)(sq + tt * 128 + d0 + d);
                    st[d] = a * st[d] + c1 * k4[0]; o += q4[0] * st[d];
                    st[d + 1] = a * st[d + 1] + c1 * k4[1]; o += q4[1] * st[d + 1];
                    st[d + 2] = a * st[d + 2] + c1 * k4[2]; o += q4[2] * st[d + 2];
                    st[d + 3] = a * st[d + 3] + c1 * k4[3]; o += q4[3] * st[d + 3];
                }
                o += __shfl_xor(o, 1);
                if (d0 == 0) c.ob[(size_t)(t0 + tt) * 1024 + h * 128 + v] = o;
            } }
            __syncthreads();
        }
    }
}
__device__ void ph_onorm(CtxK& c, LAS unsigned char* lds) {
    LAS float* red = (LAS float*)lds;
    const int tid = ltid() & 255, g = ltid() >> 8;
    for (int t = blockIdx.x * 2 + g; t < S; t += gridDim.x * 2) {
        for (int i = 4; i < 8; ++i) {
            const int br = i >> 2, ch = (i & 3) * 256 + tid; const float v = (br ? c.ob : c.oa)[(size_t)t * 1024 + ch];
            const float ss = pair_sum128(v * v, red);
            const float o = v * rsqrtf(ss * (1.f / 128.f) + 1e-6f) * (br ? c.gdn_onorm_g : c.hgrn_onorm_g)[ch & 127] * siluf_(bf2f(c.proj[(size_t)t * PW + (br ? C_GG : C_HG) + ch]));
            const unsigned pk = cvt_pk_bf16(o, o); c.ocat[(size_t)t * D + br * 1024 + ch] = (bf16_t)(pk & 0xffffu);
        }
    }
}
constexpr int N2_LA = 0, N2_LB = 8192, N2_XH = 16384, N2_XL = N2_XH + 17408, N2_Y = N2_XL + 17408, N2_LOG = N2_Y + 34816, N2_RS = N2_LOG + 64 * 65 * 4, N2_IDX = N2_RS + 256, N2_BIAS = N2_IDX + 2048, N2_END = N2_BIAS + 256;
static_assert(N2_END <= 147456, "norm2 lds");
__device__ void ph_norm2(CtxK& c, LAS unsigned char* lds) {
    const int tid = ltid(), wg = blockIdx.x, lane = tid & 63, wv = __builtin_amdgcn_readfirstlane(tid >> 6), fr = lane & 15, fq = lane >> 4;
    LAS float* la = (LAS float*)(lds + N2_LA); LAS float* lb_ = (LAS float*)(lds + N2_LB); LAS float* lg = (LAS float*)(lds + N2_LOG); LAS float* rs = (LAS float*)(lds + N2_RS);
    LAS int* idxt = (LAS int*)(lds + N2_IDX); LAS float* bias2 = (LAS float*)(lds + N2_BIAS);
    for (int j = tid; j < D; j += 512) { la[j] = c.norm2_g[j] * (1.f + c.mod[4 * D + j]); lb_[j] = c.mod[3 * D + j]; }
    if (tid < 64) bias2[tid] = c.rbias2[tid];
    __syncthreads();
    const int tok0 = wg * 64;
    for (int rr = 0; rr < 8; ++rr) {
        const int row = tok0 + wv * 8 + rr;
        const float* xr = c.out + (size_t)row * D; f32x4 v[8]; float ss = 0.f;
#pragma unroll
        for (int i = 0; i < 8; ++i) { v[i] = *(const f32x4*)(xr + i * 256 + lane * 4); ss += v[i][0] * v[i][0] + v[i][1] * v[i][1] + v[i][2] * v[i][2] + v[i][3] * v[i][3]; }
        ss = wave_sum(ss); const float r = rsqrtf(ss * (1.f / D) + 1e-6f);
        if (lane == 0) rs[wv * 8 + rr] = r;
#pragma unroll
        for (int i = 0; i < 8; ++i) { const int e = i * 256 + lane * 4; const f32x4 a = *(LAS f32x4*)(la + e), b = *(LAS f32x4*)(lb_ + e); const f32x4 y = v[i] * r * a + b;
            u32x2 w; w.x = cvt_pk_bf16(y[0], y[1]); w.y = cvt_pk_bf16(y[2], y[3]); *(u32x2*)(c.h2 + (size_t)row * D + e) = w; }
    }
    const int xrow = tid >> 3, xseg = (tid & 7) * 16;
    f32x4 xr_[4]; u32x4 yr_[5];
    auto issue = [&](int ch) {
        const float* xp = c.out + (size_t)(tok0 + xrow) * D + ch * 128 + xseg;
#pragma unroll
        for (int q = 0; q < 4; ++q) xr_[q] = *(const f32x4*)(xp + q * 4);
        const unsigned char* yp = (const unsigned char*)c.rwimg + (size_t)ch * 34816 + tid * 16;
#pragma unroll
        for (int q = 0; q < 4; ++q) yr_[q] = *(const u32x4*)(yp + q * 8192);
        if (tid < 128) yr_[4] = *(const u32x4*)(yp + 32768);
    };
    issue(0);
    f32x4 acc[2] = {(f32x4){0.f, 0.f, 0.f, 0.f}, (f32x4){0.f, 0.f, 0.f, 0.f}};
    const int mt = wv >> 1, nb = (wv & 1) * 2;
    for (int ch = 0; ch < 16; ++ch) {
        __syncthreads();
        { float hi[16], lo[16];
#pragma unroll
          for (int q = 0; q < 4; ++q)
#pragma unroll
              for (int j = 0; j < 4; ++j) { const float x = xr_[q][j]; const float h = __uint_as_float(cvt_pk_bf16(x, x) << 16); hi[q * 4 + j] = h; lo[q * 4 + j] = x - h; }
          float t8[8];
#pragma unroll
          for (int hh = 0; hh < 2; ++hh) {
#pragma unroll
              for (int j = 0; j < 8; ++j) t8[j] = hi[hh * 8 + j];
              *(LAS u32x4*)(lds + N2_XH + xrow * 272 + (xseg + hh * 8) * 2) = mx::pack8(t8);
#pragma unroll
              for (int j = 0; j < 8; ++j) t8[j] = lo[hh * 8 + j];
              *(LAS u32x4*)(lds + N2_XL + xrow * 272 + (xseg + hh * 8) * 2) = mx::pack8(t8); }
#pragma unroll
          for (int q = 0; q < 4; ++q) *(LAS u32x4*)(lds + N2_Y + tid * 16 + q * 8192) = yr_[q];
          if (tid < 128) *(LAS u32x4*)(lds + N2_Y + tid * 16 + 32768) = yr_[4]; }
        __syncthreads();
        if (ch + 1 < 16) issue(ch + 1);
#pragma unroll
        for (int kk = 0; kk < 4; ++kk) {
            const int ko = (kk * 32 + fq * 8) * 2;
            const bf16x8 ah = *(const LAS bf16x8*)(lds + N2_XH + (16 * mt + fr) * 272 + ko), al = *(const LAS bf16x8*)(lds + N2_XL + (16 * mt + fr) * 272 + ko);
#pragma unroll
            for (int n = 0; n < 2; ++n) {
                const bf16x8 bh = *(const LAS bf16x8*)(lds + N2_Y + (16 * (nb + n) + fr) * 272 + ko), bl = *(const LAS bf16x8*)(lds + N2_Y + 17408 + (16 * (nb + n) + fr) * 272 + ko);
                acc[n] = mx::mfma16(ah, bh, acc[n]); acc[n] = mx::mfma16(ah, bl, acc[n]); acc[n] = mx::mfma16(al, bh, acc[n]);
            }
        }
    }
#pragma unroll
    for (int n = 0; n < 2; ++n)
#pragma unroll
        for (int r = 0; r < 4; ++r) lg[(16 * mt + 4 * fq + r) * 65 + 16 * (nb + n) + fr] = acc[n][r];
    __syncthreads();
    const float rb = c.router_bias[lane], b2 = bias2[lane];
    for (int rr = 0; rr < 8; ++rr) {
        const int lr = wv * 8 + rr, t = tok0 + lr;
        const float s = sigmoidf_(lg[lr * 65 + lane] * rs[lr] + b2), b = s + rb;
        int rk = 0;
#pragma unroll
        for (int x = 1; x < 8; ++x) { const float ob = __shfl_xor(b, x); const int ol = lane ^ x; rk += (ob > b || (ob == b && ol < lane)) ? 1 : 0; }
        float gs = rk < 2 ? b : 0.f; gs += __shfl_xor(gs, 1); gs += __shfl_xor(gs, 2); gs += __shfl_xor(gs, 4);
        int grk = 0;
#pragma unroll
        for (int x = 8; x < 64; x += 8) { const float og = __shfl_xor(gs, x); const int ol = lane ^ x; grk += (og > gs || (og == gs && ol < lane)) ? 1 : 0; }
        float mb = grk < 4 ? b : -INFINITY;
        float wsum = 0.f; int myk = -1;
        for (int k = 0; k < TOPK; ++k) {
            float m = mb;
#pragma unroll
            for (int o = 32; o >= 1; o >>= 1) m = fmaxf(m, __shfl_xor(m, o));
            const unsigned long long bal = __ballot(mb == m); const int win = __ffsll((long long)bal) - 1;
            const float sw = __shfl(s, win); wsum += sw;
            if (lane == win) { mb = -INFINITY; myk = k; }
        }
        if (myk >= 0) { c.idx[t * TOPK + myk] = lane; c.wts[t * TOPK + myk] = s / wsum * 2.5f; idxt[lr * TOPK + myk] = lane; }
    }
    __syncthreads();
    if (tid < 64) { int n = 0;
        for (int p = 0; p < 512; ++p) if (idxt[p] == tid) { c.rnk[wg * 512 + p] = n; ++n; }
        c.tile_cnt[wg * 64 + tid] = n; }
}
__device__ void ph_route(CtxK& c, LAS unsigned char* lds) {
    const int tid = ltid(), b = blockIdx.x, e = tid & 63, part = tid >> 6;
    LAS int* psum = (LAS int*)lds; LAS int* pbel = psum + 512; LAS int* tot = pbel + 512; LAS int* offb = tot + 64; LAS int* pst = offb + 64;
    { int sa = 0, sb = 0;
      for (int tl = part * 32; tl < part * 32 + 32; ++tl) { const int v = c.tile_cnt[tl * 64 + e]; sa += v; sb += tl < b ? v : 0; }
      psum[part * 64 + e] = sa; pbel[part * 64 + e] = sb; }
    __syncthreads();
    if (tid < 64) {
        int t_ = 0, o_ = 0;
#pragma unroll
        for (int q = 0; q < 8; ++q) { t_ += psum[q * 64 + e]; o_ += pbel[q * 64 + e]; }
        const int pad = (t_ + 255) & ~255; int inc = pad;
#pragma unroll
        for (int o = 1; o < 64; o <<= 1) { const int x = __shfl_up(inc, o); if (e >= o) inc += x; }
        const int ps = inc - pad;
        tot[e] = t_; offb[e] = o_; pst[e] = ps;
        if (b == 0) {
            const int b0 = ps >> 8, nbe = pad >> 8;
            for (int j = 0; j < nbe; ++j) { c.blk_row[b0 + j] = ps + j * 256; c.blk_exp[b0 + j] = e; }
            const int nbr = __shfl(inc, 63) >> 8;
            c.blk_row[nbr + e] = PROUTED + e * 256; c.blk_exp[nbr + e] = NE;
            if (e == 0) *c.nent = nbr + S / 256;
        }
        c.tok_p[PROUTED + b * 64 + e] = b * 64 + e; c.w_p[PROUTED + b * 64 + e] = 1.f;
    }
    __syncthreads();
    { const int p = b * 512 + tid, ex = c.idx[p], d = pst[ex] + offb[ex] + c.rnk[p];
      c.tok_p[d] = p >> 3; c.w_p[d] = c.wts[p]; c.pos[p] = d; }
    if (b < NE) { const int ps = pst[b], t_ = tot[b], pe = (t_ + 255) & ~255;
        for (int r = t_ + tid; r < pe; r += 512) { c.tok_p[ps + r] = 0; c.w_p[ps + r] = 0.f; } }
}

constexpr int LDS_MAIN = 147456, LDS_BYTES = LDS_MAIN + 16;
__global__ void __launch_bounds__(512, 2) k_mega(Ctx c) {
    extern __shared__ __attribute__((aligned(16))) unsigned char smem[];
    LAS unsigned char* lds = (LAS unsigned char*)smem;
    if (ltid() == 0) *(LAS u32x4*)(lds + LDS_MAIN) = (u32x4){0u, 0u, 0u, 0u};
    __syncthreads();
    CtxK* kp = (CtxK*)__builtin_amdgcn_kernarg_segment_ptr();
    (void)xcd_barrier_post(c.bar, (volatile LAS unsigned*)(lds + LDS_MAIN));
#define PHASE(fn) do { const CtxK* kp_ = kp; asm volatile("" : "+s"(kp_)); fn(*kp_, lds); __syncthreads(); } while (0)
#define GRID_BARRIER() do { const CtxK* kp_ = kp; asm volatile("" : "+s"(kp_)); XcdBarrier bb_; bb_.bar = kp_->bar; bb_.x = xb_xcc_id(); bb_.st = (volatile LAS unsigned*)(lds + LDS_MAIN); xcd_barrier(bb_); } while (0)
    PHASE(ph_pro1);      GRID_BARRIER();
    PHASE(ph_norm1);     GRID_BARRIER();
    PHASE(ph_gemm1);     GRID_BARRIER();
    PHASE(ph_hgrn1);     PHASE(ph_gdn1);  GRID_BARRIER();
    PHASE(ph_hgrn2);     PHASE(ph_gdn2);  PHASE(ph_cvt_exp); GRID_BARRIER();
    PHASE(ph_hgrn3);     PHASE(ph_gdn3);  GRID_BARRIER();
    PHASE(ph_gemm2);     GRID_BARRIER();
    PHASE(ph_gemm3);     GRID_BARRIER();
    PHASE(ph_norm2);     GRID_BARRIER();
    PHASE(ph_route);     GRID_BARRIER();
    PHASE(ph_moe_gu);    GRID_BARRIER();
    PHASE(ph_moe_dn);    GRID_BARRIER();
    PHASE(ph_final);
#undef PHASE
#undef GRID_BARRIER
}

extern "C" void kernel_launch(void* const* d_in, const int* in_sizes, int n_in, void* d_out, int out_size, void* d_ws, size_t ws_size, hipStream_t stream) {
    Ctx c{};
    const float** ip = (const float**)&c.x;
    for (int i = 0; i < 25; ++i) ip[i] = (const float*)d_in[i];
    c.out = (float*)d_out;
    char* ws = (char*)d_ws; constexpr size_t MB = 1024 * 1024;
    c.bar = (unsigned*)ws;
    c.modp = (float*)(ws + 64 * 1024); c.mod = (float*)(ws + 320 * 1024); c.lb = (float*)(ws + 384 * 1024);
    c.cnt = (int*)(ws + 392 * 1024); c.nent = (int*)(ws + 396 * 1024); c.blk_row = (int*)(ws + 400 * 1024); c.blk_exp = (int*)(ws + 404 * 1024);
    c.idx = (int*)(ws + 1 * MB); c.wts = (float*)(ws + 2 * MB); c.tok_p = (int*)(ws + 3 * MB); c.w_p = (float*)(ws + 4 * MB); c.pos = (int*)(ws + 5 * MB);
    c.gab = (float*)(ws + 6 * MB); c.gbeta = (float*)(ws + 7 * MB + 0); c.gdec = (float*)(ws + 7 * MB + 512 * 1024);
    c.rwimg = (bf16_t*)(ws + 8 * MB); c.rbias2 = (float*)(ws + 9 * MB); c.tile_cnt = (int*)(ws + 9 * MB + 4096); c.rnk = (int*)(ws + 10 * MB);
    char* big = ws + 16 * MB;
    auto at = [&](size_t mib) { return big + mib * MB; };
    c.dn_t = (bf16_t*)at(0); c.gu_t = (bf16_t*)at(130);
    c.win_t = (bf16_t*)at(0); c.h1 = (bf16_t*)at(48); c.gAT = (float*)at(112);
    c.proj = (bf16_t*)at(390); c.gBlob = (unsigned char*)at(774); c.merged = (bf16_t*)at(774);
    c.gM = (unsigned char*)at(951); c.gB = (float*)at(960); c.hL = (float*)at(976); c.gS = (float*)at(992); c.hS = (float*)at(1008); c.hD = (float*)at(1024);
    c.wa_t = (bf16_t*)at(1025); c.wb_t = (bf16_t*)at(1029); c.wout_t = (bf16_t*)at(1033); c.ocat = (bf16_t*)at(1041);
    c.Y = (bf16_t*)at(130); c.hid = (bf16_t*)at(770); c.h2 = (bf16_t*)at(930);
    static_assert((size_t)NEX * D * FF * 2 <= 130 * MB && (size_t)NEX * 1024 * D * 2 <= 260 * MB && (size_t)PW * D * 2 <= 48 * MB && (size_t)S * D * 2 <= 64 * MB, "map A");
    static_assert((size_t)S * PW * 2 <= 384 * MB && (size_t)2048 * mx::BLOB <= 177 * MB && (size_t)256 * 128 * mx::ST128 <= 9 * MB && (size_t)PTOT * D * 2 <= 640 * MB && (size_t)PTOT * FF * 2 <= 160 * MB, "map B");
    const size_t need = 16 * MB + 1105 * MB;
    if (ws_size < need) { fprintf(stderr, "kernel_launch: workspace too small: %zu < %zu\n", ws_size, need); return; }

    static int grid = 0;
    if (!grid) {
        int dev = 0, cus = 0, per_cu = 0;
        hipGetDevice(&dev); hipDeviceGetAttribute(&cus, hipDeviceAttributeMultiprocessorCount, dev);
        hipFuncSetAttribute((const void*)k_mega, hipFuncAttributeMaxDynamicSharedMemorySize, LDS_BYTES);
        hipOccupancyMaxActiveBlocksPerMultiprocessor(&per_cu, (const void*)k_mega, 512, LDS_BYTES);
        if (per_cu < 1) fprintf(stderr, "kernel_launch: occupancy query reports %d blocks per CU\n", per_cu);
        grid = cus;
        if (grid != 256) { fprintf(stderr, "kernel_launch: built for a 256-CU device (token-mixer units = workgroups); got %d CUs\n", cus); grid = -1; }
    }
    if (grid < 0) return;
    hipMemsetAsync(c.bar, 0, XCD_BAR_WORDS * sizeof(unsigned), stream);
    hipLaunchKernelGGL(k_mega, dim3(grid), dim3(512), LDS_BYTES, stream, c);
}
```

```cpp
#include <hip/hip_runtime.h>
#include <stdint.h>
#include <stdio.h>

#define LAS __attribute__((address_space(3)))
typedef unsigned short bf16_t;
typedef short bf16x8 __attribute__((ext_vector_type(8)));
typedef float f32x4 __attribute__((ext_vector_type(4)));
typedef unsigned u32x4 __attribute__((ext_vector_type(4)));
typedef unsigned u32x2 __attribute__((ext_vector_type(2)));

constexpr int S = 16384, D = 2048, INW = 12304, PW = 12288, NE = 64, TOPK = 8, TK = S * TOPK, FF = 512;
constexpr int NEX = NE + 1;
constexpr int PROUTED = 147456, PTOT = PROUTED + S, NBLK_MAX = PROUTED / 256;
constexpr int C_HQ = 0, C_HF = 1024, C_HI = 2048, C_HG = 3072, C_GQKV = 4096, C_GG = 7168, C_MGA = 8192, C_MGB = 10240;
constexpr int WIN_GAB = 7168;

__device__ __forceinline__ float rcpf_(float x) { return __builtin_amdgcn_rcpf(x); }
__device__ __forceinline__ float sigmoidf_(float x) { return rcpf_(1.f + __expf(-x)); }
__device__ __forceinline__ float siluf_(float x) { return x * rcpf_(1.f + __expf(-x)); }
__device__ __forceinline__ float softplusf_(float x) { return x > 20.f ? x : log1pf(expf(x)); }
__device__ __forceinline__ float bf2f(bf16_t b) { return __uint_as_float(((unsigned)b) << 16); }
__device__ __forceinline__ float bflo(unsigned w) { return __uint_as_float(w << 16); }
__device__ __forceinline__ float bfhi(unsigned w) { return __uint_as_float(w & 0xffff0000u); }
__device__ __forceinline__ unsigned cvt_pk_bf16(float lo, float hi) { unsigned r; asm volatile("v_cvt_pk_bf16_f32 %0, %1, %2" : "=v"(r) : "v"(lo), "v"(hi)); return r; }
__device__ __forceinline__ int ltid() { int t = threadIdx.x; asm volatile("" : "+v"(t)); return t; }
__device__ __forceinline__ float wave_sum(float v) {
#pragma unroll
    for (int o = 32; o >= 1; o >>= 1) v += __shfl_xor(v, o);
    return v;
}


#define XB_TMO      128
#define XB_XCNT(j)  (256  + 64 * (j))
#define XB_XSUB(j)  (1280 + 64 * (j))
#define XB_XGEN(j)  (2304 + 64 * (j))
#define XB_TOP      3328
#define XB_TOPGEN   3392
#define XCD_BAR_WORDS 3456
#define XB_SPIN_CAP (1u << 18)
__device__ __forceinline__ unsigned xb_ld(unsigned* p)              { return __hip_atomic_load(p, __ATOMIC_RELAXED, __HIP_MEMORY_SCOPE_AGENT); }
__device__ __forceinline__ unsigned xb_add(unsigned* p, unsigned v) { return __hip_atomic_fetch_add(p, v, __ATOMIC_RELAXED, __HIP_MEMORY_SCOPE_AGENT); }
__device__ __forceinline__ unsigned xb_xcc_id() { return (unsigned)__builtin_amdgcn_s_getreg((3 << 11) | 20) & 0xFu; }
#define XB_SPIN(cond, bar) do { unsigned _sp = 0; while (cond) { __builtin_amdgcn_s_sleep(1); \
    if ((++_sp & 255u) == 0u) { if (xb_ld(&(bar)[XB_TMO])) break; if (_sp > XB_SPIN_CAP) { atomicAdd(&(bar)[XB_TMO], 1u); break; } } } } while (0)
struct XcdBarrier { unsigned* bar; unsigned x; volatile LAS unsigned* st; };
__device__ __forceinline__ XcdBarrier xcd_barrier_post(unsigned* bar, volatile LAS unsigned* st) {
    XcdBarrier b; b.bar = bar; b.x = xb_xcc_id(); b.st = st;
    if (threadIdx.x == 0) (void)xb_add(&bar[XB_XCNT(b.x)], 1u);
    return b;
}
__device__ __forceinline__ void xcd_barrier_complete(unsigned* bar, unsigned x, unsigned& nloc, unsigned& nx) {
    const unsigned G = gridDim.x * gridDim.y * gridDim.z;
    unsigned sum, cnt, mine, sp = 0u;
    for (;;) {
        sum = 0u; cnt = 0u; mine = 0u;
#pragma unroll
        for (unsigned j = 0; j < 16; ++j) { const unsigned c = xb_ld(&bar[XB_XCNT(j)]); sum += c; cnt += (c > 0u) ? 1u : 0u; mine = (j == x) ? c : mine; }
        if (sum == G) break;
        __builtin_amdgcn_s_sleep(1);
        if ((++sp & 255u) == 0u) { if (xb_ld(&bar[XB_TMO])) break; if (sp > XB_SPIN_CAP) { atomicAdd(&bar[XB_TMO], 1u); break; } }
    }
    nloc = mine > 0u ? mine : 1u; nx = cnt > 0u ? cnt : 1u;
}
__device__ __forceinline__ void xcd_barrier(const XcdBarrier& b) {
    asm volatile("s_waitcnt vmcnt(0)" ::: "memory");
    __syncthreads();
    if (threadIdx.x == 0) {
        unsigned* bar = b.bar;
        __builtin_amdgcn_s_waitcnt(0);
        unsigned nloc = b.st[0], nx = b.st[1];
        if (nloc == 0u) { xcd_barrier_complete(bar, b.x, nloc, nx); b.st[0] = nloc; b.st[1] = nx; }
        const unsigned old = xb_add(&bar[XB_XSUB(b.x)], 1u);
        const unsigned gen = old / nloc;
        if (old + 1u == (gen + 1u) * nloc) {
            __builtin_amdgcn_fence(__ATOMIC_RELEASE, "agent");
            asm volatile("s_waitcnt vmcnt(0)" ::: "memory");
            const unsigned og = xb_add(&bar[XB_TOP], 1u);
            const unsigned tg = og / nx;
            if (og + 1u == (tg + 1u) * nx) xb_add(&bar[XB_TOPGEN], 1u);
            else XB_SPIN(xb_ld(&bar[XB_TOPGEN]) == tg, bar);
            __builtin_amdgcn_fence(__ATOMIC_ACQUIRE, "agent");
            xb_add(&bar[XB_XGEN(b.x)], 1u);
            asm volatile("s_waitcnt vmcnt(0)" ::: "memory");
        } else {
            XB_SPIN(xb_ld(&bar[XB_XGEN(b.x)]) == gen, bar);
            __builtin_amdgcn_fence(__ATOMIC_ACQUIRE, "agent");
            asm volatile("s_waitcnt vmcnt(0)" ::: "memory");
        }
    }
    __syncthreads();
}

namespace gm {
constexpr int BM = 256, BK = 64, HALF = 128, HTB = HALF * BK * 2, STAGE_BYTES = 8 * HTB;
__host__ __device__ __forceinline__ int lds_byte(int r, int c) { const int st = (r >> 4) * 2 + (c >> 5), rr = r & 15, cc = c & 31, ob = rr * 64 + cc * 2; return st * 1024 + (ob ^ (((ob >> 9) & 1) << 5)); }
__host__ __device__ __forceinline__ void stage_rc(int b, int& R, int& C) { const int st = b / 1024, sb = b % 1024, swz = sb ^ (((sb >> 9) & 1) << 5); R = (st >> 1) * 16 + swz / 64; C = (st & 1) * 32 + (swz % 64) / 2; }
__host__ __device__ __forceinline__ int perm32(int rho) { const int n = rho >> 4, i = rho & 15; return 8 * (i >> 2) + 4 * n + (i & 3); }

struct Unit { int pm, pn, aux; const char* Bp; unsigned a00, a01, a10, a11; };

template <class Epi, class Sched>
__device__ __forceinline__ void gphase(LAS unsigned char* lds, const char* Abase, const int K, Sched& S, Epi& E) {
    const int tid = ltid(), wid = __builtin_amdgcn_readfirstlane(tid >> 6), lane = tid & 63, wr = wid >> 2, wc = wid & 3, fr = lane & 15, fq = lane >> 4;
    const int nt = K / BK;
    unsigned voffB[2];
#pragma unroll
    for (int i = 0; i < 2; ++i) { int R, C; stage_rc(tid * 16 + i * 8192, R, C); const int Rb = Epi::PERM ? ((R & ~31) + perm32(R & 31)) : R; voffB[i] = (unsigned)(Rb * K + C) * 2u; }
    const size_t hstepB = (size_t)HALF * K * 2;
    const unsigned ldsw = (unsigned)wid * 1024u;
    const int aoff = lds_byte(wr * 64 + fr, fq * 8), boff = lds_byte(wc * 32 + fr, fq * 8);
#define G_SA(b, h) (((b) * 2 + (h)) * HTB)
#define G_SB(b, h) ((4 + (b) * 2 + (h)) * HTB)
#define G_STAGE_A(bufoff, o0, o1, kb) do { \
        __builtin_amdgcn_global_load_lds((const unsigned*)(Abase + (o0) + (kb)), (LAS unsigned*)(lds + (bufoff) + ldsw), 16, 0, 0); \
        __builtin_amdgcn_global_load_lds((const unsigned*)(Abase + (o1) + (kb)), (LAS unsigned*)(lds + (bufoff) + ldsw + 8192), 16, 0, 0); } while (0)
#define G_STAGE_B(bufoff, bp, kb) do { \
        __builtin_amdgcn_global_load_lds((const unsigned*)((bp) + voffB[0] + (kb)), (LAS unsigned*)(lds + (bufoff) + ldsw), 16, 0, 0); \
        __builtin_amdgcn_global_load_lds((const unsigned*)((bp) + voffB[1] + (kb)), (LAS unsigned*)(lds + (bufoff) + ldsw + 8192), 16, 0, 0); } while (0)
#define G_LDA(dst, b, h) do { _Pragma("unroll") for (int m = 0; m < 4; ++m) _Pragma("unroll") for (int k = 0; k < 2; ++k) dst[m][k] = *(const LAS bf16x8*)(lds + G_SA(b, h) + aoff + m * 2048 + k * 1024); } while (0)
#define G_LDB(dst, b, h) do { _Pragma("unroll") for (int n = 0; n < 2; ++n) _Pragma("unroll") for (int k = 0; k < 2; ++k) dst[n][k] = *(const LAS bf16x8*)(lds + G_SB(b, h) + boff + n * 2048 + k * 1024); } while (0)
#define G_MMA(ai, bj, At, Bt) do { __builtin_amdgcn_s_setprio(1); _Pragma("unroll") for (int m = 0; m < 4; ++m) _Pragma("unroll") for (int n = 0; n < 2; ++n) _Pragma("unroll") for (int k = 0; k < 2; ++k) \
        acc[ai][bj][m][n] = __builtin_amdgcn_mfma_f32_16x16x32_bf16(Bt[n][k], At[m][k], acc[ai][bj][m][n], 0, 0, 0); __builtin_amdgcn_s_setprio(0); } while (0)
#define G_WAIT_V(n) asm volatile("s_waitcnt vmcnt(" #n ")" ::: "memory")
#define G_WAIT_L(n) asm volatile("s_waitcnt lgkmcnt(" #n ")" ::: "memory")
#define G_BAR __builtin_amdgcn_s_barrier()
#define G_SCHED __builtin_amdgcn_sched_barrier(0)
#define G_ZERO() do { _Pragma("unroll") for (int a = 0; a < 2; ++a) _Pragma("unroll") for (int b = 0; b < 2; ++b) _Pragma("unroll") for (int m = 0; m < 4; ++m) _Pragma("unroll") for (int n = 0; n < 2; ++n) acc[a][b][m][n] = (f32x4){0.f, 0.f, 0.f, 0.f}; } while (0)
    Unit cur, nxt; int ui = 0;
    if (!S.next(0, cur)) return;
    f32x4 acc[2][2][4][2];
    G_ZERO();
    bf16x8 At[4][2], B0[2][2], B1[2][2];
    G_STAGE_B(G_SB(0, 0), cur.Bp, 0); G_STAGE_B(G_SB(0, 1), cur.Bp + hstepB, 0); G_STAGE_A(G_SA(0, 0), cur.a00, cur.a01, 0); G_STAGE_A(G_SA(0, 1), cur.a10, cur.a11, 0);
    if (wr == 1) G_BAR;
    G_WAIT_V(2); G_BAR;
    G_STAGE_B(G_SB(1, 0), cur.Bp, 128); G_STAGE_A(G_SA(1, 0), cur.a00, cur.a01, 128); G_STAGE_B(G_SB(1, 1), cur.Bp + hstepB, 128);
    G_WAIT_V(6); G_BAR;
    for (;;) {
        const bool has_next = S.next(ui + 1, nxt);
        if (!has_next) nxt = cur;
        for (int t = 0; t < nt; t += 2) {
            const bool last = (t == nt - 2);
            const size_t kb1 = (size_t)(t + 1) * 128, kb2 = last ? 0 : (size_t)(t + 2) * 128, kb3 = kb2 + 128;
            const char* b2 = last ? nxt.Bp : cur.Bp;
            const unsigned x00 = last ? nxt.a00 : cur.a00, x01 = last ? nxt.a01 : cur.a01, x10 = last ? nxt.a10 : cur.a10, x11 = last ? nxt.a11 : cur.a11;
            G_LDB(B0, 0, 0); G_LDB(B1, 0, 1); G_SCHED; G_LDA(At, 0, 0); G_STAGE_A(G_SA(1, 1), cur.a10, cur.a11, kb1);
            G_WAIT_V(8); G_WAIT_L(0); G_BAR; G_MMA(0, 0, At, B0); G_MMA(0, 1, At, B1); G_BAR; G_SCHED;
            G_LDA(At, 0, 1); G_STAGE_B(G_SB(0, 0), b2, kb2); G_STAGE_B(G_SB(0, 1), b2 + hstepB, kb2); G_STAGE_A(G_SA(0, 0), x00, x01, kb2);
            G_WAIT_V(8); G_WAIT_L(0); G_BAR; G_MMA(1, 0, At, B0); G_MMA(1, 1, At, B1); G_BAR; G_SCHED;
            G_LDB(B0, 1, 0); G_LDB(B1, 1, 1); G_SCHED; G_LDA(At, 1, 0); G_STAGE_A(G_SA(0, 1), x10, x11, kb2);
            G_WAIT_V(8); G_WAIT_L(0); G_BAR; G_MMA(0, 0, At, B0); G_MMA(0, 1, At, B1); G_BAR; G_SCHED;
            G_LDA(At, 1, 1); G_STAGE_B(G_SB(1, 0), b2, kb3); G_STAGE_B(G_SB(1, 1), b2 + hstepB, kb3); G_STAGE_A(G_SA(1, 0), x00, x01, kb3);
            G_WAIT_V(8); G_WAIT_L(0); G_BAR; G_MMA(1, 0, At, B0); G_MMA(1, 1, At, B1); G_BAR; G_SCHED;
        }
        if (wr == 0) G_BAR;
        E(acc, cur, wr, wc, fr, fq);
        if (!has_next) break;
        if (!E.keep(cur)) G_ZERO();
        cur = nxt; ++ui;
        if (wr == 1) G_BAR;
    }
    G_WAIT_V(0);
    G_BAR;
#undef G_SA
#undef G_SB
#undef G_STAGE_A
#undef G_STAGE_B
#undef G_LDA
#undef G_LDB
#undef G_MMA
#undef G_WAIT_V
#undef G_WAIT_L
#undef G_BAR
#undef G_SCHED
#undef G_ZERO
}

struct DenseSched {
    int nM, nN, nwg, G, c, lda, K, parts; const char* Bt; const char* Bt2; int R0, C0, R1, C1;
    __device__ void init(int M, int N, int K_, int lda_, const void* Bt_, const void* Bt2_, int parts_) {
        nM = M / BM; nN = N / BM; nwg = nM * nN; G = gridDim.x; c = blockIdx.x; lda = lda_; K = K_; Bt = (const char*)Bt_; Bt2 = (const char*)Bt2_; parts = parts_;
        stage_rc(ltid() * 16, R0, C0); stage_rc(ltid() * 16 + 8192, R1, C1);
    }
    __device__ bool next(int i, Unit& u) const {
        const int ti = parts == 2 ? (i >> 1) : i, part = parts == 2 ? (i & 1) : 0;
        const long L = (long)ti * G + c; if (L >= nwg) return false;
        int wgid = (int)L; { const int q = nwg / 8, r = nwg % 8, xcd = wgid % 8, off = wgid / 8; wgid = (xcd < r ? xcd * (q + 1) : r * (q + 1) + (xcd - r) * q) + off; }
        const int nig = 8 * nN, gid = wgid / nig, fm = gid * 8, gsz = (nM - fm) < 8 ? (nM - fm) : 8;
        u.pm = fm + ((wgid % nig) % gsz); u.pn = (wgid % nig) / gsz; u.aux = part;
        u.Bp = (part ? Bt2 : Bt) + (size_t)u.pn * BM * K * 2;
        const unsigned rb = (unsigned)u.pm * BM, po = part ? (unsigned)K * 2u : 0u;
        u.a00 = ((rb + R0) * lda + C0) * 2u + po; u.a01 = ((rb + R1) * lda + C1) * 2u + po;
        u.a10 = ((rb + HALF + R0) * lda + C0) * 2u + po; u.a11 = ((rb + HALF + R1) * lda + C1) * 2u + po;
        return true;
    }
};
template <bool GATHER>
struct MoeSched {
    static constexpr int MAXU = 24;
    int nN, K, lda, nu; const char* W; size_t wstride; int R0, C0, R1, C1; LAS const int* tbl; LAS const int* tokt;
    __device__ void init(LAS unsigned char* spare  , int nN_, int K_, int lda_, const int* nent_p, const int* blk_row, const int* blk_exp, const int* tok_p, const void* W_, size_t wstride_) {
        nN = nN_; K = K_; lda = lda_; W = (const char*)W_; wstride = wstride_;
        const int tid = ltid(), G = gridDim.x, c = blockIdx.x, nent = *nent_p;
        stage_rc(tid * 16, R0, C0); stage_rc(tid * 16 + 8192, R1, C1);
        const int x = c & 7, slot = c >> 3, nslot = G >> 3, e0 = (int)((long)x * nent / 8), e1 = (int)((long)(x + 1) * nent / 8), tot = (e1 - e0) * nN;
        nu = tot > slot ? (tot - slot + nslot - 1) / nslot : 0; if (nu > MAXU) nu = MAXU;
        LAS int* t_ = (LAS int*)spare; LAS int* k_ = (LAS int*)(spare + 256);
        if (tid < nu) { const int uidx = tid * nslot + slot, ent = e0 + uidx / nN; t_[tid * 2] = blk_row[ent]; t_[tid * 2 + 1] = blk_exp[ent] * 16 + uidx % nN; }
        __syncthreads();
        if (GATHER) { for (int j = tid; j < nu * 256; j += 512) k_[j] = tok_p[t_[(j >> 8) * 2] + (j & 255)]; __syncthreads(); }
        tbl = t_; tokt = k_;
    }
    __device__ bool next(int i, Unit& u) const {
        if (i >= nu) return false;
        const int rb = tbl[i * 2], ep = tbl[i * 2 + 1], e = ep >> 4; u.pn = ep & 15; u.pm = rb; u.aux = e;
        u.Bp = W + (size_t)e * wstride + (size_t)u.pn * BM * K * 2;
        if (GATHER) {
            const unsigned t00 = tokt[i * 256 + R0], t01 = tokt[i * 256 + R1], t10 = tokt[i * 256 + HALF + R0], t11 = tokt[i * 256 + HALF + R1];
            u.a00 = (t00 * lda + C0) * 2u; u.a01 = (t01 * lda + C1) * 2u; u.a10 = (t10 * lda + C0) * 2u; u.a11 = (t11 * lda + C1) * 2u;
        } else {
            u.a00 = ((unsigned)(rb + R0) * lda + C0) * 2u; u.a01 = ((unsigned)(rb + R1) * lda + C1) * 2u;
            u.a10 = ((unsigned)(rb + HALF + R0) * lda + C0) * 2u; u.a11 = ((unsigned)(rb + HALF + R1) * lda + C1) * 2u;
        }
        return true;
    }
};

struct EpiProj {
    static constexpr bool PERM = true; bf16_t* O;
    __device__ __forceinline__ bool keep(const Unit&) const { return false; }
    __device__ __forceinline__ void operator()(f32x4 (&acc)[2][2][4][2], const Unit& u, int wr, int wc, int fr, int fq) const {
        const int row0 = u.pm * BM + wr * 64 + fr, col0 = u.pn * BM + wc * 32 + 8 * fq;
#pragma unroll
        for (int ai = 0; ai < 2; ++ai)
#pragma unroll
            for (int m = 0; m < 4; ++m) { bf16_t* rowp = O + (size_t)(row0 + ai * HALF + m * 16) * PW + col0;
#pragma unroll
                for (int bj = 0; bj < 2; ++bj) { const f32x4 v0 = acc[ai][bj][m][0], v1 = acc[ai][bj][m][1]; u32x4 w;
                    w.x = cvt_pk_bf16(v0[0], v0[1]); w.y = cvt_pk_bf16(v0[2], v0[3]); w.z = cvt_pk_bf16(v1[0], v1[1]); w.w = cvt_pk_bf16(v1[2], v1[3]);
                    *(u32x4*)(rowp + bj * HALF) = w; } }
    }
};
struct EpiMerge {
    static constexpr bool PERM = true; const bf16_t* proj; bf16_t* O;
    __device__ __forceinline__ bool keep(const Unit& u) const { return u.aux == 0; }
    __device__ __forceinline__ void operator()(f32x4 (&acc)[2][2][4][2], const Unit& u, int wr, int wc, int fr, int fq) const {
        const int row0 = u.pm * BM + wr * 64 + fr, col0 = u.pn * BM + wc * 32 + 8 * fq;
#pragma unroll
        for (int ai = 0; ai < 2; ++ai)
#pragma unroll
            for (int m = 0; m < 4; ++m) { const size_t r = (size_t)(row0 + ai * HALF + m * 16);
#pragma unroll
                for (int bj = 0; bj < 2; ++bj) {
                    const u32x4 gb = *(const u32x4*)(proj + r * PW + C_MGB + col0 + bj * HALF);
                    const f32x4 eb0 = {__expf(-bflo(gb.x)), __expf(-bfhi(gb.x)), __expf(-bflo(gb.y)), __expf(-bfhi(gb.y))};
                    const f32x4 eb1 = {__expf(-bflo(gb.z)), __expf(-bfhi(gb.z)), __expf(-bflo(gb.w)), __expf(-bfhi(gb.w))};
                    if (u.aux == 0) {
                        const u32x4 ga = *(const u32x4*)(proj + r * PW + C_MGA + col0 + bj * HALF);
                        const f32x4 ea0 = {__expf(-bflo(ga.x)), __expf(-bfhi(ga.x)), __expf(-bflo(ga.y)), __expf(-bfhi(ga.y))};
                        const f32x4 ea1 = {__expf(-bflo(ga.z)), __expf(-bfhi(ga.z)), __expf(-bflo(ga.w)), __expf(-bfhi(ga.w))};
#pragma unroll
                        for (int j = 0; j < 4; ++j) { acc[ai][bj][m][0][j] *= (1.f + eb0[j]) * rcpf_(1.f + ea0[j]); acc[ai][bj][m][1][j] *= (1.f + eb1[j]) * rcpf_(1.f + ea1[j]); }
                    } else {
                        f32x4 v0 = acc[ai][bj][m][0], v1 = acc[ai][bj][m][1];
#pragma unroll
                        for (int j = 0; j < 4; ++j) { v0[j] *= rcpf_(1.f + eb0[j]); v1[j] *= rcpf_(1.f + eb1[j]); }
                        u32x4 w; w.x = cvt_pk_bf16(v0[0], v0[1]); w.y = cvt_pk_bf16(v0[2], v0[3]); w.z = cvt_pk_bf16(v1[0], v1[1]); w.w = cvt_pk_bf16(v1[2], v1[3]);
                        *(u32x4*)(O + r * D + col0 + bj * HALF) = w;
                    } } }
    }
};
struct EpiResid {
    static constexpr bool PERM = false; const float* x; const float* gt; float* O;
    __device__ __forceinline__ bool keep(const Unit&) const { return false; }
    __device__ __forceinline__ void operator()(f32x4 (&acc)[2][2][4][2], const Unit& u, int wr, int wc, int fr, int fq) const {
        const int row0 = u.pm * BM + wr * 64 + fr, col0 = u.pn * BM + wc * 32 + 4 * fq;
        f32x4 g[2][2];
#pragma unroll
        for (int bj = 0; bj < 2; ++bj)
#pragma unroll
            for (int n = 0; n < 2; ++n) g[bj][n] = *(const f32x4*)(gt + col0 + bj * HALF + n * 16);
#pragma unroll
        for (int ai = 0; ai < 2; ++ai)
#pragma unroll
            for (int m = 0; m < 4; ++m) { const size_t ro = (size_t)(row0 + ai * HALF + m * 16) * D + col0;
#pragma unroll
                for (int bj = 0; bj < 2; ++bj)
#pragma unroll
                    for (int n = 0; n < 2; ++n) { const f32x4 xv = *(const f32x4*)(x + ro + bj * HALF + n * 16); *(f32x4*)(O + ro + bj * HALF + n * 16) = xv + g[bj][n] * acc[ai][bj][m][n]; } }
    }
};
struct EpiSwiglu {
    static constexpr bool PERM = true; bf16_t* hid;
    __device__ __forceinline__ bool keep(const Unit&) const { return false; }
    __device__ __forceinline__ void operator()(f32x4 (&acc)[2][2][4][2], const Unit& u, int wr, int wc, int fr, int fq) const {
        const int row0 = u.pm + wr * 64 + fr, j0 = u.pn * 128 + wc * 16 + 4 * fq;
#pragma unroll
        for (int ai = 0; ai < 2; ++ai)
#pragma unroll
            for (int m = 0; m < 4; ++m) { bf16_t* rowp = hid + (size_t)(row0 + ai * HALF + m * 16) * FF + j0;
#pragma unroll
                for (int bj = 0; bj < 2; ++bj) { const f32x4 g = acc[ai][bj][m][0], up = acc[ai][bj][m][1]; u32x2 w;
                    w.x = cvt_pk_bf16(siluf_(g[0]) * up[0], siluf_(g[1]) * up[1]); w.y = cvt_pk_bf16(siluf_(g[2]) * up[2], siluf_(g[3]) * up[3]);
                    *(u32x2*)(rowp + bj * 64) = w; } }
    }
};
struct EpiDown {
    static constexpr bool PERM = true; unsigned char* Y; const float* w_p;
    __device__ __forceinline__ bool keep(const Unit&) const { return false; }
    __device__ __forceinline__ void operator()(f32x4 (&acc)[2][2][4][2], const Unit& u, int wr, int wc, int fr, int fq) const {
        const int row0 = u.pm + wr * 64 + fr, col0 = u.pn * BM + wc * 32 + 8 * fq;
#pragma unroll
        for (int ai = 0; ai < 2; ++ai)
#pragma unroll
            for (int m = 0; m < 4; ++m) { const int r = row0 + ai * HALF + m * 16; const float wt = w_p[r] * 16.f; unsigned char* rowp = Y + (size_t)r * D + col0;
#pragma unroll
                for (int bj = 0; bj < 2; ++bj) { f32x4 v0 = acc[ai][bj][m][0] * wt, v1 = acc[ai][bj][m][1] * wt;
#pragma unroll
                    for (int j = 0; j < 4; ++j) { v0[j] = fminf(fmaxf(v0[j], -448.f), 448.f); v1[j] = fminf(fmaxf(v1[j], -448.f), 448.f); }
                    int w0 = __builtin_amdgcn_cvt_pk_fp8_f32(v0[0], v0[1], 0, false); w0 = __builtin_amdgcn_cvt_pk_fp8_f32(v0[2], v0[3], w0, true);
                    int w1 = __builtin_amdgcn_cvt_pk_fp8_f32(v1[0], v1[1], 0, false); w1 = __builtin_amdgcn_cvt_pk_fp8_f32(v1[2], v1[3], w1, true);
                    *(u32x2*)(rowp + bj * HALF) = (u32x2){(unsigned)w0, (unsigned)w1}; } }
    }
};
}

struct Ctx {
    const float *x, *c, *w_ada, *b_ada, *norm1_g, *norm2_g, *w_in, *lb_table, *hgrn_onorm_g, *conv_w, *a_log, *dt_bias, *gdn_onorm_g, *w_bh, *w_bg, *w_out, *w_router, *router_bias,
        *w_eg, *w_eu, *w_ed, *w_sg, *w_su, *w_sd, *normf_g;
    float* out;
    unsigned* bar;
    float *modp, *mod, *lb, *gab;
    int *idx, *cnt, *tok_p, *pos, *blk_row, *blk_exp, *nent;
    float *wts, *w_p;
    bf16_t *win_t, *wa_t, *wb_t, *wout_t, *h1, *proj, *ocat, *merged;
    float *gq, *gk, *gv, *gbeta, *gdec, *oa, *ob;
    float *hL, *hS, *hD;
    float *gAT, *gB, *gS; unsigned char *gBlob, *gM;
    bf16_t *dn_t, *hid, *gu_t, *h2; unsigned char* Y;
    bf16_t* rwimg; float* rbias2; int *tile_cnt, *rnk;
};

typedef const __attribute__((address_space(4))) Ctx CtxK;

__device__ __forceinline__ void cvt_tile(LAS float* t, const float* srcA, const float* srcB, int ld, int mode, bf16_t* dst, int ldd) {
    const int tid = ltid(), kr = tid >> 6, cl = tid & 63;
    const float* sp = (mode == 1 && cl >= 32) ? (srcB + cl - 32) : (srcA + cl);
    float v[8];
#pragma unroll
    for (int p = 0; p < 8; ++p) v[p] = sp[(size_t)(p * 8 + kr) * ld];
    __syncthreads();
#pragma unroll
    for (int p = 0; p < 8; ++p) t[(p * 8 + kr) * 65 + cl] = v[p];
    __syncthreads();
    const int r = tid >> 3, seg = (tid & 7) * 8;
    const int lc = mode == 1 ? (((r >> 2) & 1) * 32 + 4 * (r >> 3) + (r & 3)) : r;
    float w[8];
#pragma unroll
    for (int j = 0; j < 8; ++j) w[j] = t[(seg + j) * 65 + lc];
    u32x4 o; o.x = cvt_pk_bf16(w[0], w[1]); o.y = cvt_pk_bf16(w[2], w[3]); o.z = cvt_pk_bf16(w[4], w[5]); o.w = cvt_pk_bf16(w[6], w[7]);
    *(u32x4*)(dst + (size_t)r * ldd + seg) = o;
}
__device__ __forceinline__ void cvt_job(LAS float* t, int tile, const float* src, int ld, int K, bf16_t* dst) {
    const int nkt = K / 64, nt = tile / nkt, kt = tile % nkt;
    cvt_tile(t, src + (size_t)kt * 64 * ld + nt * 64, nullptr, ld, 0, dst + (size_t)nt * 64 * K + kt * 64, K);
}

__device__ void ph_pro1(CtxK& c, LAS unsigned char* lds) {
    const int tid = ltid(), wg = blockIdx.x, G = gridDim.x;
    LAS float* lf = (LAS float*)lds;
    for (int job = wg; job < 192; job += G) {
        const int cc = job % 48, kp = job / 48, q = tid & 63, rg = tid >> 6;
        f32x4 a = {0.f, 0.f, 0.f, 0.f};
        for (int r = rg; r < 512; r += 8) { const int k = kp * 512 + r; const float s = siluf_(c.c[k]); a += s * *(const f32x4*)(c.w_ada + (size_t)k * (6 * D) + cc * 256 + q * 4); }
        __syncthreads();
        *(LAS f32x4*)(lf + (rg * 64 + q) * 4) = a;
        __syncthreads();
        if (tid < 64) { f32x4 s = {0.f, 0.f, 0.f, 0.f};
#pragma unroll
            for (int g = 0; g < 8; ++g) s += *(LAS f32x4*)(lf + (g * 64 + tid) * 4);
            *(f32x4*)(c.modp + (size_t)kp * (6 * D) + cc * 256 + tid * 4) = s; }
    }
    if (wg == G - 1) for (int j = tid; j < 1024; j += 512) c.lb[j] = 1.f / (1.f + expf(c.lb_table[1024 + j] - c.lb_table[j]));
    for (int T = wg; T < 8192; T += G) {
        if (T < 6144) { const int nt = T / 32, kt = T % 32; const int sc = nt * 64 + (nt * 64 >= WIN_GAB ? 16 : 0);
            cvt_tile(lf, c.w_in + (size_t)kt * 64 * INW + sc, nullptr, INW, 0, c.win_t + (size_t)nt * 64 * D + kt * 64, D); }
        else if (T < 6656) cvt_job(lf, T - 6144, c.w_bh, D, 1024, c.wa_t);
        else if (T < 7168) cvt_job(lf, T - 6656, c.w_bg, D, 1024, c.wb_t);
        else cvt_job(lf, T - 7168, c.w_out, D, 2048, c.wout_t);
    }
}
__device__ void ph_norm1(CtxK& c, LAS unsigned char* lds) {
    const int tid = ltid(), wg = blockIdx.x, G = gridDim.x, lane = tid & 63, wv = tid >> 6;
    LAS float* la = (LAS float*)lds;
    LAS float* lb_ = la + D;
    LAS float* lw = lb_ + D;
    for (int j = tid; j < D; j += 512) {
        float sh = c.b_ada[j], sc = c.b_ada[D + j];
#pragma unroll
        for (int p = 0; p < 4; ++p) { sh += c.modp[(size_t)p * 6 * D + j]; sc += c.modp[(size_t)p * 6 * D + D + j]; }
        la[j] = c.norm1_g[j] * (1.f + sc); lb_[j] = sh;
    }
    for (int j = wg * 512 + tid; j < 6 * D; j += G * 512) { float m = c.b_ada[j];
#pragma unroll
        for (int p = 0; p < 4; ++p) m += c.modp[(size_t)p * 6 * D + j];
        c.mod[j] = m; }
    for (int i = tid; i < D * 4; i += 512) { const int e = i >> 2, q = i & 3; const f32x4 w = *(const f32x4*)(c.w_in + (size_t)e * INW + WIN_GAB + q * 4);
        lw[(q * 4 + 0) * D + e] = w[0]; lw[(q * 4 + 1) * D + e] = w[1]; lw[(q * 4 + 2) * D + e] = w[2]; lw[(q * 4 + 3) * D + e] = w[3]; }
    __syncthreads();
    f32x4 vn[8];
    { const float* xr = c.x + (size_t)(wg * 8 + wv) * D;
#pragma unroll
      for (int i = 0; i < 8; ++i) vn[i] = *(const f32x4*)(xr + i * 256 + lane * 4); }
    for (int row = wg * 8 + wv; row < S; row += G * 8) {
        f32x4 v[8]; float ss = 0.f;
#pragma unroll
        for (int i = 0; i < 8; ++i) { v[i] = vn[i]; ss += v[i][0] * v[i][0] + v[i][1] * v[i][1] + v[i][2] * v[i][2] + v[i][3] * v[i][3]; }
        if (row + G * 8 < S) { const float* xr = c.x + (size_t)(row + G * 8) * D;
#pragma unroll
            for (int i = 0; i < 8; ++i) vn[i] = *(const f32x4*)(xr + i * 256 + lane * 4); }
        ss = wave_sum(ss); const float r = rsqrtf(ss * (1.f / D) + 1e-6f);
#pragma unroll
        for (int i = 0; i < 8; ++i) { const int e = i * 256 + lane * 4; const f32x4 a = *(LAS f32x4*)(la + e), b = *(LAS f32x4*)(lb_ + e); v[i] = v[i] * r * a + b;
            u32x2 w; w.x = cvt_pk_bf16(v[i][0], v[i][1]); w.y = cvt_pk_bf16(v[i][2], v[i][3]); *(u32x2*)(c.h1 + (size_t)row * D + e) = w; }
        float mine = 0.f;
        for (int cc = 0; cc < 16; ++cc) { float d = 0.f;
#pragma unroll
            for (int i = 0; i < 8; ++i) { const f32x4 w = *(LAS f32x4*)(lw + cc * D + i * 256 + lane * 4); d += v[i][0] * w[0] + v[i][1] * w[1] + v[i][2] * w[2] + v[i][3] * w[3]; }
            d = wave_sum(d); if (lane == cc) mine = d; }
        if (lane < 16) c.gab[(size_t)row * 16 + lane] = mine;
    }
    { const int id = wg * 512 + tid, i = id >> 6, e = id & 63;
      if (id < D * 64) {
          float sc = c.b_ada[4 * D + i];
#pragma unroll
          for (int p = 0; p < 4; ++p) sc += c.modp[(size_t)p * 6 * D + 4 * D + i];
          const float w = c.norm2_g[i] * (1.f + sc) * c.w_router[id];
          const unsigned hi = cvt_pk_bf16(w, w) & 0xffffu; const float lo = w - __uint_as_float(hi << 16);
          const int ch = i >> 7, kk = i & 127;
          c.rwimg[((ch * 2 + 0) * 64 + e) * 136 + kk] = (bf16_t)hi; c.rwimg[((ch * 2 + 1) * 64 + e) * 136 + kk] = (bf16_t)(cvt_pk_bf16(lo, lo) & 0xffffu);
      } }
    if (wg < 64) {
        __syncthreads();
        float a = 0.f;
        for (int i = tid; i < D; i += 512) { float sh = c.b_ada[3 * D + i];
#pragma unroll
            for (int p = 0; p < 4; ++p) sh += c.modp[(size_t)p * 6 * D + 3 * D + i];
            a += sh * c.w_router[i * 64 + wg]; }
        a = wave_sum(a); if (lane == 0) la[wv] = a; __syncthreads();
        if (tid == 0) c.rbias2[wg] = la[0] + la[1] + la[2] + la[3] + la[4] + la[5] + la[6] + la[7];
    }
}
__device__ void ph_gemm1(CtxK& c, LAS unsigned char* lds) {
    gm::DenseSched Sd; Sd.init(S, PW, D, D, c.win_t, nullptr, 1); gm::EpiProj E{c.proj};
    gm::gphase(lds, (const char*)c.h1, D, Sd, E);
}
__device__ void ph_gemm2(CtxK& c, LAS unsigned char* lds) {
    gm::DenseSched Sd; Sd.init(S, D, 1024, 2048, c.wa_t, c.wb_t, 2); gm::EpiMerge E{c.proj, c.merged};
    gm::gphase(lds, (const char*)c.ocat, 1024, Sd, E);
}
__device__ void ph_gemm3(CtxK& c, LAS unsigned char* lds) {
    gm::DenseSched Sd; Sd.init(S, D, D, D, c.wout_t, nullptr, 1); gm::EpiResid E{c.x, c.mod + 2 * D, c.out};
    gm::gphase(lds, (const char*)c.merged, D, Sd, E);
}
__device__ void ph_moe_gu(CtxK& c, LAS unsigned char* lds) {
    gm::MoeSched<true> Sm; Sm.init(lds + gm::STAGE_BYTES, 4, D, D, c.nent, c.blk_row, c.blk_exp, c.tok_p, c.gu_t, (size_t)1024 * D * 2); gm::EpiSwiglu E{c.hid};
    gm::gphase(lds, (const char*)c.h2, D, Sm, E);
}
__device__ void ph_moe_dn(CtxK& c, LAS unsigned char* lds) {
    gm::MoeSched<false> Sm; Sm.init(lds + gm::STAGE_BYTES, 8, FF, FF, c.nent, c.blk_row, c.blk_exp, c.tok_p, c.dn_t, (size_t)D * FF * 2); gm::EpiDown E{c.Y, c.w_p};
    gm::gphase(lds, (const char*)c.hid, FF, Sm, E);
}
__device__ void ph_cvt_exp(CtxK& c, LAS unsigned char* lds) {
    LAS float* lf = (LAS float*)lds; const int wg = blockIdx.x - 8, G = gridDim.x - 8;
    if (wg < 0) return;
    constexpr int GU_T = 16 * 32, DN_T = 32 * 8;
    for (int T = wg; T < NEX * (GU_T + DN_T); T += G) {
        if (T < NEX * GU_T) { const int e = T / GU_T, r = T % GU_T, nt = r / 32, kt = r % 32;
            const float* sg = e < NE ? c.w_eg + (size_t)e * D * FF : c.w_sg; const float* su = e < NE ? c.w_eu + (size_t)e * D * FF : c.w_su;
            cvt_tile(lf, sg + (size_t)kt * 64 * FF + nt * 32, su + (size_t)kt * 64 * FF + nt * 32, FF, 1, c.gu_t + ((size_t)e * 1024 + nt * 64) * D + kt * 64, D); }
        else { const int T2 = T - NEX * GU_T, e = T2 / DN_T, r = T2 % DN_T; const float* sd = e < NE ? c.w_ed + (size_t)e * FF * D : c.w_sd;
            cvt_job(lf, r, sd, D, FF, c.dn_t + (size_t)e * D * FF); }
    }
}
__device__ void ph_final(CtxK& c, LAS unsigned char* lds) {
    const int tid = ltid(), wg = blockIdx.x, G = gridDim.x, lane = tid & 63, wv = tid >> 6;
    const float* gt2 = c.mod + 5 * D;
    for (int row0 = (wg * 8 + wv) * 2; row0 < S; row0 += G * 16) {
        int p[2][9];
#pragma unroll
        for (int rr = 0; rr < 2; ++rr) {
#pragma unroll
            for (int k = 0; k < 8; ++k) p[rr][k] = c.pos[(row0 + rr) * TOPK + k];
            p[rr][8] = PROUTED + row0 + rr; }
        f32x4 v[2][4][2]; float ss[2] = {0.f, 0.f};
#pragma unroll
        for (int rr = 0; rr < 2; ++rr) {
#pragma unroll
            for (int i = 0; i < 4; ++i) {
                const int e = i * 512 + lane * 8; f32x4 a0 = {0.f, 0.f, 0.f, 0.f}, a1 = {0.f, 0.f, 0.f, 0.f};
#pragma unroll
                for (int k = 0; k < 9; ++k) { const u32x2 y = *(const u32x2*)(c.Y + (size_t)p[rr][k] * D + e);
                    const auto q0 = __builtin_amdgcn_cvt_pk_f32_fp8((int)y.x, false), q1 = __builtin_amdgcn_cvt_pk_f32_fp8((int)y.x, true), q2 = __builtin_amdgcn_cvt_pk_f32_fp8((int)y.y, false), q3 = __builtin_amdgcn_cvt_pk_f32_fp8((int)y.y, true);
                    a0[0] += q0[0]; a0[1] += q0[1]; a0[2] += q1[0]; a0[3] += q1[1]; a1[0] += q2[0]; a1[1] += q2[1]; a1[2] += q3[0]; a1[3] += q3[1]; }
                const float* xp = c.out + (size_t)(row0 + rr) * D + e;
                const f32x4 x0 = *(const f32x4*)xp, x1 = *(const f32x4*)(xp + 4), g0 = *(const f32x4*)(gt2 + e) * 0.0625f, g1 = *(const f32x4*)(gt2 + e + 4) * 0.0625f;
                v[rr][i][0] = x0 + g0 * a0; v[rr][i][1] = x1 + g1 * a1;
#pragma unroll
                for (int j = 0; j < 4; ++j) ss[rr] += v[rr][i][0][j] * v[rr][i][0][j] + v[rr][i][1][j] * v[rr][i][1][j];
            } }
#pragma unroll
        for (int rr = 0; rr < 2; ++rr) {
            const float r = rsqrtf(wave_sum(ss[rr]) * (1.f / D) + 1e-6f);
#pragma unroll
            for (int i = 0; i < 4; ++i) { const int e = i * 512 + lane * 8; float* op = c.out + (size_t)(row0 + rr) * D + e;
                *(f32x4*)op = v[rr][i][0] * r * *(const f32x4*)(c.normf_g + e); *(f32x4*)(op + 4) = v[rr][i][1] * r * *(const f32x4*)(c.normf_g + e + 4); } }
    }
}

namespace mx {
constexpr int ST128 = 272, ST64 = 144;
constexpr int FRAG_F4 = 8 * 8 * 64;
__device__ __forceinline__ f32x4 mfma16(bf16x8 a, bf16x8 b, f32x4 c) { return __builtin_amdgcn_mfma_f32_16x16x32_bf16(a, b, c, 0, 0, 0); }
template <int MT, int KS>
__device__ __forceinline__ void mma_nt(f32x4 (&acc)[MT], LAS const unsigned char* xs, int sx, LAS const unsigned char* ys, int sy, int fr, int fq) {
#pragma unroll
    for (int kk = 0; kk < KS; ++kk) {
        const bf16x8 b = *(const LAS bf16x8*)(ys + fr * sy + (kk * 32 + fq * 8) * 2);
#pragma unroll
        for (int m = 0; m < MT; ++m) { const bf16x8 a = *(const LAS bf16x8*)(xs + (16 * m + fr) * sx + (kk * 32 + fq * 8) * 2); acc[m] = mfma16(a, b, acc[m]); }
    }
}
__device__ __forceinline__ void lds_fence() { asm volatile("s_waitcnt lgkmcnt(0)" ::: "memory"); }
__device__ __forceinline__ u32x4 pack8(const float (&v)[8]) { u32x4 o; o.x = cvt_pk_bf16(v[0], v[1]); o.y = cvt_pk_bf16(v[2], v[3]); o.z = cvt_pk_bf16(v[4], v[5]); o.w = cvt_pk_bf16(v[6], v[7]); return o; }
__device__ __forceinline__ void unpack8(const u32x4 w, float (&v)[8]) { v[0] = bflo(w.x); v[1] = bfhi(w.x); v[2] = bflo(w.y); v[3] = bfhi(w.y); v[4] = bflo(w.z); v[5] = bfhi(w.z); v[6] = bflo(w.w); v[7] = bfhi(w.w); }
__device__ __forceinline__ void mfma_pad8(f32x4 (&a)[8]) { asm volatile("s_nop 15\n\ts_nop 7" : "+v"(a[0]), "+v"(a[1]), "+v"(a[2]), "+v"(a[3]), "+v"(a[4]), "+v"(a[5]), "+v"(a[6]), "+v"(a[7])); }
__device__ __forceinline__ void mfma_pad4(f32x4 (&a)[4]) { asm volatile("s_nop 15\n\ts_nop 7" : "+v"(a[0]), "+v"(a[1]), "+v"(a[2]), "+v"(a[3])); }
__device__ __forceinline__ void write_st(LAS unsigned char* stw, f32x4 (&S)[8], int fr, int fq) {
    mfma_pad8(S);
#pragma unroll
    for (int m = 0; m < 8; ++m) { u32x2 w; w.x = cvt_pk_bf16(S[m][0], S[m][1]); w.y = cvt_pk_bf16(S[m][2], S[m][3]); *(LAS u32x2*)(stw + fr * ST128 + (16 * m + 4 * fq) * 2) = w; }
}

__device__ __forceinline__ void gate_issue(u32x4 (&gp)[2], const bf16_t* gate0) {
    const int t_ = ltid(); const bf16_t* p = gate0 + (size_t)(t_ >> 3) * PW + (t_ & 7) * 16;
    gp[0] = *(const u32x4*)p; gp[1] = *(const u32x4*)(p + 8);
}
__device__ __forceinline__ void out_stage(LAS unsigned char* ot, LAS float* part, const f32x4 (&o)[4], const u32x4 (&gp)[2], const float* gnorm, bf16_t* out0, int wv, int lane, int fr, int fq) {
    float s_ = 0.f;
#pragma unroll
    for (int w = 0; w < 8; ++w) s_ += part[w * 64 + lane];
    const float rv = rsqrtf(s_ * (1.f / 128.f) + 1e-6f);
    const float gn = gnorm[wv * 16 + fr];
#pragma unroll
    for (int m = 0; m < 4; ++m)
#pragma unroll
        for (int r = 0; r < 4; ++r) { const int cc = 16 * m + 4 * fq + r; const float x = o[m][r] * __shfl(rv, cc) * gn;
            *(LAS bf16_t*)(ot + cc * ST128 + (wv * 16 + fr) * 2) = (bf16_t)(cvt_pk_bf16(x, x) & 0xffffu); }
    __syncthreads();
    const int t_ = ltid(), cc = t_ >> 3, sg = (t_ & 7) * 16;
#pragma unroll
    for (int hh = 0; hh < 2; ++hh) { float ov[8], gv[8];
        unpack8(*(LAS u32x4*)(ot + cc * ST128 + (sg + hh * 8) * 2), ov); unpack8(gp[hh], gv);
#pragma unroll
        for (int j = 0; j < 8; ++j) ov[j] *= siluf_(gv[j]);
        *(u32x4*)(out0 + (size_t)cc * D + sg + hh * 8) = pack8(ov); }
}

constexpr int H_QT = 0, H_KT = 17408, H_QI = 34816, H_KU = 52224, H_VT = 70656, H_P = 89088, H_DEC = 98304, H_OCT = 98816, H_F4 = 102912, H_PART = 103424, H_RINV = 105472, H_ST = 105728, H_END = H_ST + 8 * 16 * ST128;
static_assert(H_END <= 147456, "hgrn lds");
template <bool OUT>
__device__ void hgrn_pass(CtxK& c, LAS unsigned char* lds) {
    const int tid = ltid(), wv = __builtin_amdgcn_readfirstlane(tid >> 6), lane = tid & 63, fr = lane & 15, fq = lane >> 4;
    LAS float* dec = (LAS float*)(lds + H_DEC); LAS float* oct = (LAS float*)(lds + H_OCT); LAS float* f4 = (LAS float*)(lds + H_F4);
    LAS float* part = (LAS float*)(lds + H_PART); LAS float* rinv = (LAS float*)(lds + H_RINV);
    LAS unsigned char* stw = lds + H_ST + wv * 16 * ST128;
    {
        const int wu = blockIdx.x, h = wu & 7, g = wu >> 3;
        f32x4 Sacc[8];
#pragma unroll
        for (int m = 0; m < 8; ++m) Sacc[m] = (f32x4){0.f, 0.f, 0.f, 0.f};
        if (OUT) {
            if (g > 0) { const f32x4* sp = (const f32x4*)c.hS + (size_t)(h * 32 + g) * FRAG_F4 + (wv * 8) * 64 + lane;
#pragma unroll
                for (int m = 0; m < 8; ++m) Sacc[m] = sp[m * 64]; }
            write_st(stw, Sacc, fr, fq);
        }
        float dsum = 0.f;
        for (int i = 0; i < 8; ++i) {
            const int T0 = (g * 8 + i) * 64;
            u32x4 gpre[2];
            if (OUT) gate_issue(gpre, c.proj + (size_t)T0 * PW + C_HG + h * 128);
            const int tp = ltid(), grp = tp >> 7, to = (tp >> 4) & 7, co = tp & 15, c0 = to * 8, d0 = co * 8;
            const bool cum = grp == 2 || (OUT && grp == 0);
            float cs[8][8];
            if (cum) {
                float lbv[8];
                { const f32x4 l0 = *(const f32x4*)(c.lb + h * 128 + d0), l1 = *(const f32x4*)(c.lb + h * 128 + d0 + 4);
                  lbv[0] = l0[0]; lbv[1] = l0[1]; lbv[2] = l0[2]; lbv[3] = l0[3]; lbv[4] = l1[0]; lbv[5] = l1[1]; lbv[6] = l1[2]; lbv[7] = l1[3]; }
#pragma unroll
                for (int tt = 0; tt < 8; ++tt) {
                    float fv[8]; unpack8(*(const u32x4*)(c.proj + (size_t)(T0 + c0 + tt) * PW + C_HF + h * 128 + d0), fv);
#pragma unroll
                    for (int j = 0; j < 8; ++j) { const float lf = __logf(lbv[j] + (1.f - lbv[j]) * sigmoidf_(fv[j])); cs[tt][j] = tt ? cs[tt - 1][j] + lf : lf; }
                }
                if (grp == 2) {
#pragma unroll
                    for (int j = 0; j < 8; ++j) { oct[to * 128 + d0 + j] = cs[7][j]; if (to == 4) f4[d0 + j] = cs[0][j]; }
                }
            }
            __syncthreads();
            if (cum) {
                float pre[8], tot[8], bmid[8];
#pragma unroll
                for (int j = 0; j < 8; ++j) { float p = 0.f, t_ = 0.f, bm = 0.f;
#pragma unroll
                    for (int o = 0; o < 8; ++o) { const float x = oct[o * 128 + d0 + j]; p += o < to ? x : 0.f; bm += o < 4 ? x : 0.f; t_ += x; }
                    pre[j] = p; tot[j] = t_; bmid[j] = bm + f4[d0 + j]; }
                if (grp == 0) {
                    float ebm[8];
#pragma unroll
                    for (int j = 0; j < 8; ++j) ebm[j] = __expf(bmid[j]);
#pragma unroll
                    for (int tt = 0; tt < 8; ++tt) {
                        float qv[8], q1[8], q2[8];
                        unpack8(*(const u32x4*)(c.proj + (size_t)(T0 + c0 + tt) * PW + C_HQ + h * 128 + d0), qv);
#pragma unroll
                        for (int j = 0; j < 8; ++j) { const float q = siluf_(qv[j]) * 0.08838834764831845f; q1[j] = q * __expf(pre[j] + cs[tt][j] - bmid[j]); q2[j] = q1[j] * ebm[j]; }
                        *(LAS u32x4*)(lds + H_QT + (c0 + tt) * ST128 + d0 * 2) = pack8(q1); *(LAS u32x4*)(lds + H_QI + (c0 + tt) * ST128 + d0 * 2) = pack8(q2);
                    }
                } else {
                    if (to == 0) {
#pragma unroll
                        for (int j = 0; j < 8; ++j) dec[d0 + j] = __expf(tot[j]);
                    }
                    float ku[8][8];
#pragma unroll
                    for (int tt = 0; tt < 8; ++tt) {
                        float k1[8];
#pragma unroll
                        for (int j = 0; j < 8; ++j) {
                            const float lf = tt ? cs[tt][j] - cs[tt - 1][j] : cs[0][j], kk_ = 1.f - __expf(lf), b = pre[j] + cs[tt][j];
                            ku[tt][j] = kk_ * __expf(tot[j] - b);
                            if (OUT) k1[j] = kk_ * __expf(bmid[j] - b);
                        }
                        if (OUT) *(LAS u32x4*)(lds + H_KT + (c0 + tt) * ST128 + d0 * 2) = pack8(k1);
                    }
#pragma unroll
                    for (int j = 0; j < 8; ++j) { float col[8];
#pragma unroll
                        for (int tt = 0; tt < 8; ++tt) col[tt] = ku[tt][j];
                        *(LAS u32x4*)(lds + H_KU + (d0 + j) * ST64 + c0 * 2) = pack8(col); }
                }
            } else if (grp == 1) {
                float vb[8][8];
#pragma unroll
                for (int tt = 0; tt < 8; ++tt) unpack8(*(const u32x4*)(c.proj + (size_t)(T0 + c0 + tt) * PW + C_HI + h * 128 + d0), vb[tt]);
#pragma unroll
                for (int j = 0; j < 8; ++j) { float col[8];
#pragma unroll
                    for (int tt = 0; tt < 8; ++tt) col[tt] = vb[tt][j];
                    *(LAS u32x4*)(lds + H_VT + (d0 + j) * ST64 + c0 * 2) = pack8(col); }
            }
            __syncthreads();
            if (!OUT && tid < 128) dsum += __logf(dec[tid]);
            f32x4 oacc[4];
            if (OUT) {
                { f32x4 sc[2] = {(f32x4){0.f, 0.f, 0.f, 0.f}, (f32x4){0.f, 0.f, 0.f, 0.f}};
                  const int nt = wv & 3, mb = (wv >> 2) * 2;
                  mma_nt<2, 4>(sc, lds + H_KT + mb * 16 * ST128, ST128, lds + H_QT + nt * 16 * ST128, ST128, fr, fq);
#pragma unroll
                  for (int m = 0; m < 2; ++m) { const int cc = nt * 16 + fr, s0 = (mb + m) * 16 + 4 * fq; u32x2 w;
                      w.x = cvt_pk_bf16(s0 + 0 <= cc ? sc[m][0] : 0.f, s0 + 1 <= cc ? sc[m][1] : 0.f); w.y = cvt_pk_bf16(s0 + 2 <= cc ? sc[m][2] : 0.f, s0 + 3 <= cc ? sc[m][3] : 0.f);
                      *(LAS u32x2*)(lds + H_P + cc * ST64 + s0 * 2) = w; } }
                __syncthreads();
#pragma unroll
                for (int m = 0; m < 4; ++m) oacc[m] = (f32x4){0.f, 0.f, 0.f, 0.f};
                mma_nt<4, 2>(oacc, lds + H_P, ST64, lds + H_VT + wv * 16 * ST64, ST64, fr, fq);
                mma_nt<4, 4>(oacc, lds + H_QI, ST128, stw, ST128, fr, fq);
#pragma unroll
                for (int m = 0; m < 4; ++m)
#pragma unroll
                    for (int r = 0; r < 4; ++r) { float q = oacc[m][r] * oacc[m][r]; q += __shfl_xor(q, 1); q += __shfl_xor(q, 2); q += __shfl_xor(q, 4); q += __shfl_xor(q, 8); if (fr == 0) part[wv * 64 + 16 * m + 4 * fq + r] = q; }
            }
#pragma unroll
            for (int m = 0; m < 8; ++m) { const f32x4 dv = *(LAS f32x4*)(dec + 16 * m + 4 * fq); Sacc[m] = Sacc[m] * dv; }
            mma_nt<8, 2>(Sacc, lds + H_KU, ST64, lds + H_VT + wv * 16 * ST64, ST64, fr, fq);
            if (OUT) {
                lds_fence();
                write_st(stw, Sacc, fr, fq);
                __syncthreads();
                out_stage(lds + H_QT, part, oacc, gpre, c.hgrn_onorm_g, c.ocat + (size_t)T0 * D + h * 128, wv, lane, fr, fq);
            }
            __syncthreads();
        }
        if (!OUT) {
            f32x4* sp = (f32x4*)c.hL + (size_t)(h * 32 + g) * FRAG_F4 + (wv * 8) * 64 + lane;
#pragma unroll
            for (int m = 0; m < 8; ++m) sp[m * 64] = Sacc[m];
            if (tid < 128) c.hD[(h * 32 + g) * 128 + tid] = __expf(dsum);
        }
    }
}
__device__ void hgrn_scan(CtxK& c) {
    const int e = blockIdx.x * 512 + ltid();
    if (e >= 8 * FRAG_F4) return;
    const int h = e / FRAG_F4, fi = e % FRAG_F4, m = (fi >> 6) & 7, lane = fi & 63, d0 = 16 * m + 4 * (lane >> 4);
    f32x4 s = {0.f, 0.f, 0.f, 0.f};
    for (int g = 0; g < 31; ++g) {
        const f32x4 dc = *(const f32x4*)(c.hD + (h * 32 + g) * 128 + d0);
        s = s * dc + ((const f32x4*)c.hL)[(size_t)(h * 32 + g) * FRAG_F4 + fi];
        ((f32x4*)c.hS)[(size_t)(h * 32 + g + 1) * FRAG_F4 + fi] = s;
    }
}

constexpr int B_T = 0, B_KBG = 9216, B_KU = 26624, B_VB = 45056, B_QD = 63488, B_AT = 80896, B_SC = 90112, BLOB = 90368;
constexpr int G_ST = BLOB, G_RV = G_ST + 8 * 16 * ST128, G_PART = G_RV + 8 * 16 * ST64, G_RINV = G_PART + 2048, G_END = G_RINV + 256;
static_assert(G_END <= 147456, "gdn lds");
constexpr int P_K = 0, P_Q = 17408, P_BETA = 34816, P_GC = P_BETA + 256, P_EG = P_GC + 256, P_EK = P_EG + 256;

__device__ void gdn_prep(CtxK& c, LAS unsigned char* lds, int h, int g) {
    const int tid = ltid(), wv = __builtin_amdgcn_readfirstlane(tid >> 6), lane = tid & 63, fr = lane & 15, fq = lane >> 4;
    LAS float* sbeta = (LAS float*)(lds + P_BETA); LAS float* sgc = (LAS float*)(lds + P_GC); LAS float* seg = (LAS float*)(lds + P_EG); LAS float* sek = (LAS float*)(lds + P_EK);
    for (int i = 0; i < 8; ++i) {
        const int n = g * 8 + i, T0 = n * 64;
        unsigned char* blob = (unsigned char*)c.gBlob + (size_t)(h * 256 + n) * BLOB;
        if (wv == 0) {
            const float ga = c.gab[(size_t)(T0 + lane) * 16 + h], gb = c.gab[(size_t)(T0 + lane) * 16 + 8 + h];
            const float gl_ = -__expf(c.a_log[h]) * softplusf_(ga + c.dt_bias[h]);
            float gc = gl_;
#pragma unroll
            for (int o = 1; o < 64; o <<= 1) { const float t_ = __shfl_up(gc, o); if (lane >= o) gc += t_; }
            const float glast = __shfl(gc, 63);
            sbeta[lane] = sigmoidf_(gb); sgc[lane] = gc; seg[lane] = __expf(gc); sek[lane] = __expf(glast - gc);
            if (lane == 0) *(float*)(blob + B_SC) = __expf(glast);
        }
        __syncthreads();
        const int tp = ltid(), part = tp >> 7, to = (tp >> 4) & 7, co = tp & 15, c0 = to * 8, d0 = co * 8;
        if (tp < 384) {
            const int chb = part * 1024 + h * 128 + d0;
            float val[8][8];
            {
                float wj[4][8];
#pragma unroll
                for (int j = 0; j < 4; ++j) { const f32x4 a = *(const f32x4*)(c.conv_w + j * 3072 + chb), b = *(const f32x4*)(c.conv_w + j * 3072 + chb + 4);
                    wj[j][0] = a[0]; wj[j][1] = a[1]; wj[j][2] = a[2]; wj[j][3] = a[3]; wj[j][4] = b[0]; wj[j][5] = b[1]; wj[j][6] = b[2]; wj[j][7] = b[3]; }
                u32x4 raw[11];
#pragma unroll
                for (int r = 0; r < 11; ++r) { const int tok = T0 + c0 - 3 + r; raw[r] = tok >= 0 ? *(const u32x4*)(c.proj + (size_t)tok * PW + C_GQKV + chb) : (u32x4){0u, 0u, 0u, 0u}; }
#pragma unroll
                for (int tt = 0; tt < 8; ++tt) {
                    float a[8] = {0.f, 0.f, 0.f, 0.f, 0.f, 0.f, 0.f, 0.f};
#pragma unroll
                    for (int j = 0; j < 4; ++j) { float xv[8]; unpack8(raw[tt + j], xv);
#pragma unroll
                        for (int jj = 0; jj < 8; ++jj) a[jj] += wj[j][jj] * xv[jj]; }
#pragma unroll
                    for (int jj = 0; jj < 8; ++jj) val[tt][jj] = siluf_(a[jj]);
                }
            }
            if (part < 2) {
#pragma unroll
                for (int tt = 0; tt < 8; ++tt) { float ss = 0.f;
#pragma unroll
                    for (int jj = 0; jj < 8; ++jj) ss += val[tt][jj] * val[tt][jj];
                    ss += __shfl_xor(ss, 1); ss += __shfl_xor(ss, 2); ss += __shfl_xor(ss, 4); ss += __shfl_xor(ss, 8);
                    const float rn = rsqrtf(ss + 1e-6f) * (part == 0 ? 0.08838834764831845f : 1.f);
#pragma unroll
                    for (int jj = 0; jj < 8; ++jj) val[tt][jj] *= rn; }
            }
            if (part == 0) {
#pragma unroll
                for (int tt = 0; tt < 8; ++tt) { const int cc = c0 + tt; *(LAS u32x4*)(lds + P_Q + cc * ST128 + d0 * 2) = pack8(val[tt]);
                    const float e = seg[cc]; float qd[8];
#pragma unroll
                    for (int jj = 0; jj < 8; ++jj) qd[jj] = val[tt][jj] * e;
                    *(u32x4*)(blob + B_QD + cc * ST128 + d0 * 2) = pack8(qd); }
            } else if (part == 1) {
#pragma unroll
                for (int tt = 0; tt < 8; ++tt) { const int cc = c0 + tt; *(LAS u32x4*)(lds + P_K + cc * ST128 + d0 * 2) = pack8(val[tt]);
                    const float e = seg[cc] * sbeta[cc]; float kb[8];
#pragma unroll
                    for (int jj = 0; jj < 8; ++jj) kb[jj] = val[tt][jj] * e;
                    *(u32x4*)(blob + B_KBG + cc * ST128 + d0 * 2) = pack8(kb); }
#pragma unroll
                for (int jj = 0; jj < 8; ++jj) { float col[8];
#pragma unroll
                    for (int tt = 0; tt < 8; ++tt) col[tt] = val[tt][jj] * sek[c0 + tt];
                    *(u32x4*)(blob + B_KU + (d0 + jj) * ST64 + c0 * 2) = pack8(col); }
            } else {
#pragma unroll
                for (int jj = 0; jj < 8; ++jj) { float col[8];
#pragma unroll
                    for (int tt = 0; tt < 8; ++tt) col[tt] = val[tt][jj] * sbeta[c0 + tt];
                    *(u32x4*)(blob + B_VB + (d0 + jj) * ST64 + c0 * 2) = pack8(col); }
            }
        }
        __syncthreads();
        {
            const int nt = wv & 3, mb = (wv >> 2) * 2, jj = nt * 16 + fr;
            f32x4 kk2[2] = {(f32x4){0.f, 0.f, 0.f, 0.f}, (f32x4){0.f, 0.f, 0.f, 0.f}}, at2[2] = {(f32x4){0.f, 0.f, 0.f, 0.f}, (f32x4){0.f, 0.f, 0.f, 0.f}};
            mma_nt<2, 4>(kk2, lds + P_K + mb * 16 * ST128, ST128, lds + P_K + nt * 16 * ST128, ST128, fr, fq);
            mma_nt<2, 4>(at2, lds + P_K + mb * 16 * ST128, ST128, lds + P_Q + nt * 16 * ST128, ST128, fr, fq);
            float* at = c.gAT + (size_t)(h * 256 + n) * 4096;
            const float gj = sgc[jj];
#pragma unroll
            for (int m = 0; m < 2; ++m) { const int i0 = (mb + m) * 16 + 4 * fq; f32x4 av; float pv[4];
#pragma unroll
                for (int r = 0; r < 4; ++r) { const int ii = i0 + r; const float gi = sgc[ii];
                    av[r] = jj < ii ? sbeta[ii] * kk2[m][r] * __expf(gi - gj) : 0.f;
                    pv[r] = ii <= jj ? at2[m][r] * __expf(gj - gi) : 0.f; }
                *(f32x4*)(at + jj * 64 + i0) = av;
                u32x2 w; w.x = cvt_pk_bf16(pv[0], pv[1]); w.y = cvt_pk_bf16(pv[2], pv[3]);
                *(u32x2*)(blob + B_AT + jj * ST64 + i0 * 2) = w; }
        }
        __syncthreads();
    }
}
__device__ void gdn_invert(CtxK& c, LAS unsigned char* lds, int h, int g) {
    const int tid = ltid(), wv = __builtin_amdgcn_readfirstlane(tid >> 6), lane = tid & 63;
    const int n = g * 8 + wv;
    LAS float* at = (LAS float*)(lds + wv * 16384);
    const float* src = c.gAT + (size_t)(h * 256 + n) * 4096;
#pragma unroll
    for (int k = 0; k < 16; ++k) *(LAS f32x4*)(at + (k * 64 + lane) * 4) = *(const f32x4*)(src + (k * 64 + lane) * 4);
    lds_fence();
    float r[64];
    unsigned ata = (unsigned)(size_t)at;
#pragma unroll
    for (int j = 63; j >= 0; --j) {
        float acc = lane == j ? 1.f : 0.f;
        LAS const float* arow = (LAS const float*)(size_t)ata + j * 64;
#pragma unroll
        for (int m4 = ((j + 1) & ~3); m4 < 64; m4 += 4) {
            const f32x4 a = *(LAS const f32x4*)(arow + m4);
#pragma unroll
            for (int q = 0; q < 4; ++q) if (m4 + q > j) acc = __builtin_fmaf(-r[m4 + q], a[q], acc);
        }
        r[j] = acc;
        asm volatile("" : "+v"(ata) : "v"(acc));
    }
    unsigned char* blob = (unsigned char*)c.gBlob + (size_t)(h * 256 + n) * BLOB;
#pragma unroll
    for (int k = 0; k < 8; ++k) { float v8[8];
#pragma unroll
        for (int q = 0; q < 8; ++q) v8[q] = r[k * 8 + q];
        *(u32x4*)(blob + B_T + lane * ST64 + k * 16) = pack8(v8); }
}
template <int MODE>
__device__ void gdn_pass(CtxK& c, LAS unsigned char* lds, int h, int g) {
    const int tid = ltid(), wv = __builtin_amdgcn_readfirstlane(tid >> 6), lane = tid & 63, fr = lane & 15, fq = lane >> 4;
    LAS unsigned char* stw = lds + G_ST + wv * 16 * ST128; LAS unsigned char* rvw = lds + G_RV + wv * 16 * ST64;
    LAS float* part = (LAS float*)(lds + G_PART); LAS float* rinv = (LAS float*)(lds + G_RINV);
    f32x4 Sacc[8];
#pragma unroll
    for (int m = 0; m < 8; ++m) {
        if (MODE == 1) { const int v = 16 * wv + fr, d0 = 16 * m + 4 * fq; Sacc[m] = (f32x4){d0 == v ? 1.f : 0.f, d0 + 1 == v ? 1.f : 0.f, d0 + 2 == v ? 1.f : 0.f, d0 + 3 == v ? 1.f : 0.f}; }
        else Sacc[m] = (f32x4){0.f, 0.f, 0.f, 0.f};
    }
    if (MODE == 2 && g > 0) { const f32x4* sp = (const f32x4*)c.gS + (size_t)(h * 32 + g) * FRAG_F4 + (wv * 8) * 64 + lane;
#pragma unroll
        for (int m = 0; m < 8; ++m) Sacc[m] = sp[m * 64]; }
    write_st(stw, Sacc, fr, fq);
    constexpr int LIM = MODE == 2 ? B_SC : B_QD, NQ = (LIM + 8191) / 8192;
    u32x4 pre[NQ];
    const unsigned char* blob0 = (const unsigned char*)c.gBlob + (size_t)(h * 256 + g * 8) * BLOB;
#define GP_ISSUE(i_) do { const unsigned char* bp_ = blob0 + (size_t)(i_) * BLOB + ltid() * 16; _Pragma("unroll") for (int q = 0; q < NQ; ++q) if (q * 8192 + 8176 < LIM || ltid() * 16 + q * 8192 < LIM) pre[q] = *(const u32x4*)(bp_ + q * 8192); } while (0)
    GP_ISSUE(0);
    for (int i = 0; i < 8; ++i) {
        const int n = g * 8 + i, T0 = n * 64;
        { const int tl = ltid() * 16;
#pragma unroll
          for (int q = 0; q < NQ; ++q) if (q * 8192 + 8176 < LIM || tl + q * 8192 < LIM) *(LAS u32x4*)(lds + tl + q * 8192) = pre[q]; }
        const float dlast = *(const float*)(blob0 + (size_t)i * BLOB + B_SC);
        u32x4 gpre[2];
        if (MODE == 2) gate_issue(gpre, c.proj + (size_t)T0 * PW + C_GG + h * 128);
        __syncthreads();
        if (i + 1 < 8) GP_ISSUE(i + 1);
        { f32x4 R[4];
#pragma unroll
          for (int m = 0; m < 4; ++m) R[m] = (f32x4){0.f, 0.f, 0.f, 0.f};
          mma_nt<4, 4>(R, lds + B_KBG, ST128, stw, ST128, fr, fq);
#pragma unroll
          for (int m = 0; m < 4; ++m) { float x0 = 0.f, x1 = 0.f, x2 = 0.f, x3 = 0.f;
              if (MODE != 1) { const u32x2 vb = *(LAS u32x2*)(lds + B_VB + (16 * wv + fr) * ST64 + (16 * m + 4 * fq) * 2); x0 = bflo(vb.x); x1 = bfhi(vb.x); x2 = bflo(vb.y); x3 = bfhi(vb.y); }
              u32x2 w; w.x = cvt_pk_bf16(x0 - R[m][0], x1 - R[m][1]); w.y = cvt_pk_bf16(x2 - R[m][2], x3 - R[m][3]);
              *(LAS u32x2*)(rvw + fr * ST64 + (16 * m + 4 * fq) * 2) = w; } }
        lds_fence();
        { f32x4 VN[4];
#pragma unroll
          for (int m = 0; m < 4; ++m) VN[m] = (f32x4){0.f, 0.f, 0.f, 0.f};
          mma_nt<4, 2>(VN, lds + B_T, ST64, rvw, ST64, fr, fq);
          mfma_pad4(VN); lds_fence();
#pragma unroll
          for (int m = 0; m < 4; ++m) { u32x2 w; w.x = cvt_pk_bf16(VN[m][0], VN[m][1]); w.y = cvt_pk_bf16(VN[m][2], VN[m][3]); *(LAS u32x2*)(rvw + fr * ST64 + (16 * m + 4 * fq) * 2) = w; } }
        lds_fence();
        f32x4 O[4];
        if (MODE == 2) {
#pragma unroll
            for (int m = 0; m < 4; ++m) O[m] = (f32x4){0.f, 0.f, 0.f, 0.f};
            mma_nt<4, 4>(O, lds + B_QD, ST128, stw, ST128, fr, fq);
            mma_nt<4, 2>(O, lds + B_AT, ST64, rvw, ST64, fr, fq);
#pragma unroll
            for (int m = 0; m < 4; ++m)
#pragma unroll
                for (int r = 0; r < 4; ++r) { float q = O[m][r] * O[m][r]; q += __shfl_xor(q, 1); q += __shfl_xor(q, 2); q += __shfl_xor(q, 4); q += __shfl_xor(q, 8); if (fr == 0) part[wv * 64 + 16 * m + 4 * fq + r] = q; }
        }
#pragma unroll
        for (int m = 0; m < 8; ++m) Sacc[m] = Sacc[m] * dlast;
        mma_nt<8, 2>(Sacc, lds + B_KU, ST64, rvw, ST64, fr, fq);
        lds_fence();
        write_st(stw, Sacc, fr, fq);
        if (MODE == 2) {
            __syncthreads();
            out_stage(lds + B_KBG, part, O, gpre, c.gdn_onorm_g, c.ocat + (size_t)T0 * D + 1024 + h * 128, wv, lane, fr, fq);
        }
        __syncthreads();
    }
#undef GP_ISSUE
    if (MODE == 0) {
        f32x4* sp = (f32x4*)c.gB + (size_t)(h * 32 + g) * FRAG_F4 + (wv * 8) * 64 + lane;
#pragma unroll
        for (int m = 0; m < 8; ++m) sp[m * 64] = Sacc[m];
    }
    if (MODE == 1) {
        mfma_pad8(Sacc);
        LAS bf16_t* img = (LAS bf16_t*)lds;
#pragma unroll
        for (int m = 0; m < 8; ++m)
#pragma unroll
            for (int r = 0; r < 4; ++r) img[(16 * m + 4 * fq + r) * (ST128 / 2) + 16 * wv + fr] = (bf16_t)(cvt_pk_bf16(Sacc[m][r], Sacc[m][r]) & 0xffffu);
        __syncthreads();
        unsigned char* dst = (unsigned char*)c.gM + (size_t)(h * 32 + g) * (128 * ST128);
#pragma unroll
        for (int q = 0; q < 5; ++q) { const int o = tid * 16 + q * 8192; if (q < 4 || o < 128 * ST128) *(u32x4*)(dst + o) = *(LAS u32x4*)(lds + o); }
        __syncthreads();
    }
}
__device__ void gdn_scan(CtxK& c, LAS unsigned char* lds, int h) {
    const int tid = ltid(), wv = __builtin_amdgcn_readfirstlane(tid >> 6), lane = tid & 63, fr = lane & 15, fq = lane >> 4;
    LAS unsigned char* stw = lds + G_ST + wv * 16 * ST128;
    f32x4 Sacc[8], Bn[8]; u32x4 mp[5];
#pragma unroll
    for (int m = 0; m < 8; ++m) Sacc[m] = (f32x4){0.f, 0.f, 0.f, 0.f};
#define GS_ISSUE(g_) do { const unsigned char* src_ = (const unsigned char*)c.gM + (size_t)(h * 32 + (g_)) * (128 * ST128) + tid * 16; \
        _Pragma("unroll") for (int q = 0; q < 5; ++q) if (q < 4 || tid * 16 + q * 8192 < 128 * ST128) mp[q] = *(const u32x4*)(src_ + q * 8192); \
        const f32x4* bp_ = (const f32x4*)c.gB + (size_t)(h * 32 + (g_)) * FRAG_F4 + (wv * 8) * 64 + lane; \
        _Pragma("unroll") for (int m = 0; m < 8; ++m) Bn[m] = bp_[m * 64]; } while (0)
    GS_ISSUE(0);
    for (int g = 0; g < 31; ++g) {
#pragma unroll
        for (int q = 0; q < 5; ++q) if (q < 4 || tid * 16 + q * 8192 < 128 * ST128) *(LAS u32x4*)(lds + tid * 16 + q * 8192) = mp[q];
        write_st(stw, Sacc, fr, fq);
#pragma unroll
        for (int m = 0; m < 8; ++m) Sacc[m] = Bn[m];
        __syncthreads();
        if (g + 1 < 31) GS_ISSUE(g + 1);
        mma_nt<8, 4>(Sacc, lds, ST128, stw, ST128, fr, fq);
        f32x4* sp = (f32x4*)c.gS + (size_t)(h * 32 + g + 1) * FRAG_F4 + (wv * 8) * 64 + lane;
#pragma unroll
        for (int m = 0; m < 8; ++m) sp[m * 64] = Sacc[m];
        __syncthreads();
    }
#undef GS_ISSUE
}
}
__device__ void ph_hgrn1(CtxK& c, LAS unsigned char* lds) { mx::hgrn_pass<false>(c, lds); }
__device__ void ph_hgrn2(CtxK& c, LAS unsigned char* lds) { mx::hgrn_scan(c); }
__device__ void ph_hgrn3(CtxK& c, LAS unsigned char* lds) { mx::hgrn_pass<true>(c, lds); }
__device__ void ph_gdn1(CtxK& c, LAS unsigned char* lds) {
    const int wu = blockIdx.x, h = wu & 7, g = wu >> 3;
    mx::gdn_prep(c, lds, h, g); __syncthreads();
    asm volatile("s_waitcnt vmcnt(0)" ::: "memory"); __syncthreads();
    mx::gdn_invert(c, lds, h, g);
    asm volatile("s_waitcnt vmcnt(0)" ::: "memory"); __syncthreads();
    mx::gdn_pass<0>(c, lds, h, g); __syncthreads();
    mx::gdn_pass<1>(c, lds, h, g); __syncthreads();
}
__device__ void ph_gdn2(CtxK& c, LAS unsigned char* lds) { if (blockIdx.x < 8) mx::gdn_scan(c, lds, blockIdx.x); }
__device__ void ph_gdn3(CtxK& c, LAS unsigned char* lds) { const int wu = blockIdx.x; mx::gdn_pass<2>(c, lds, wu & 7, wu >> 3); }

__device__ __forceinline__ float pair_sum128(float v, LAS float* red) {
    v = wave_sum(v); const int w = ltid() >> 6;
    __syncthreads(); if ((ltid() & 63) == 0) red[w] = v; __syncthreads();
    return red[w & ~1] + red[w | 1];
}
__device__ void ph_gdn_pre(CtxK& c, LAS unsigned char* lds) {
    LAS float* red = (LAS float*)lds;
    const int tid = ltid() & 255, g = ltid() >> 8;
    for (int t = blockIdx.x * 2 + g; t < S; t += gridDim.x * 2) {
        for (int grp = 0; grp < 12; ++grp) {
            const int ch = grp * 256 + tid; float acc = 0.f;
#pragma unroll
            for (int j = 0; j < 4; ++j) { const int tt = t - 3 + j; if (tt >= 0) acc += c.conv_w[j * 3072 + ch] * bf2f(c.proj[(size_t)tt * PW + C_GQKV + ch]); }
            const float val = siluf_(acc);
            if (grp < 8) {
                const float ss = pair_sum128(val * val, red); const float n = val * rsqrtf(ss + 1e-6f);
                if (grp < 4) c.gq[(size_t)t * 1024 + ch] = n * 0.08838834764831845f; else c.gk[(size_t)t * 1024 + ch - 1024] = n;
            } else c.gv[(size_t)t * 1024 + ch - 2048] = val;
        }
        if (tid < 8) {
            const float ga = c.gab[(size_t)t * 16 + tid], gb = c.gab[(size_t)t * 16 + 8 + tid];
            c.gbeta[t * 8 + tid] = sigmoidf_(gb); c.gdec[t * 8 + tid] = expf(-expf(c.a_log[tid]) * softplusf_(ga + c.dt_bias[tid]));
        }
    }
}
__device__ void ph_mix_naive(CtxK& c, LAS unsigned char* lds) {
    constexpr int TB = 8;
    const int wg = blockIdx.x, t512 = ltid(), tid = t512 & 127; const bool ld = t512 < 128, act = t512 < 256;
    const int v = (t512 >> 1) & 127, d0 = (t512 & 1) * 64;
    if (wg < 8 || wg >= 16) return;
    LAS float* sq = (LAS float*)lds; LAS float* sf = sq + TB * 128; LAS float* sk = sf + TB * 128; LAS float* sv = sk + TB * 128; LAS float* sb = sv + TB * 128; LAS float* sa = sb + TB;
    float st[64];
#pragma unroll
    for (int d = 0; d < 64; ++d) st[d] = 0.f;
    if (wg < 8) {
        const int h = wg; const float lbv = c.lb[h * 128 + tid];
        for (int t0 = 0; t0 < S; t0 += TB) {
            if (ld) for (int tt = 0; tt < TB; ++tt) {
                const bf16_t* base = c.proj + (size_t)(t0 + tt) * PW + h * 128 + tid;
                const float f = lbv + (1.f - lbv) * sigmoidf_(bf2f(base[C_HF]));
                sq[tt * 128 + tid] = siluf_(bf2f(base[C_HQ])) * 0.08838834764831845f; sf[tt * 128 + tid] = f; sk[tt * 128 + tid] = 1.f - f; sv[tt * 128 + tid] = bf2f(base[C_HI]);
            }
            __syncthreads();
            if (act) {
#pragma unroll 1
            for (int tt = 0; tt < TB; ++tt) {
                float o = 0.f; const float vv = sv[tt * 128 + v];
#pragma unroll
                for (int d = 0; d < 64; d += 4) {
                    const f32x4 q4 = *(LAS f32x4*)(sq + tt * 128 + d0 + d), f4 = *(LAS f32x4*)(sf + tt * 128 + d0 + d), k4 = *(LAS f32x4*)(sk + tt * 128 + d0 + d);
                    st[d] = f4[0] * st[d] + k4[0] * vv; o += q4[0] * st[d];
                    st[d + 1] = f4[1] * st[d + 1] + k4[1] * vv; o += q4[1] * st[d + 1];
                    st[d + 2] = f4[2] * st[d + 2] + k4[2] * vv; o += q4[2] * st[d + 2];
                    st[d + 3] = f4[3] * st[d + 3] + k4[3] * vv; o += q4[3] * st[d + 3];
                }
                o += __shfl_xor(o, 1);
                if (d0 == 0) c.oa[(size_t)(t0 + tt) * 1024 + h * 128 + v] = o;
            } }
            __syncthreads();
        }
    } else {
        const int h = wg - 8;
        for (int t0 = 0; t0 < S; t0 += TB) {
            if (ld) { for (int tt = 0; tt < TB; ++tt) {
                const size_t o = (size_t)(t0 + tt) * 1024 + h * 128 + tid;
                sq[tt * 128 + tid] = c.gq[o]; sk[tt * 128 + tid] = c.gk[o]; sv[tt * 128 + tid] = c.gv[o];
            }
            if (tid < TB) { sb[tid] = c.gbeta[(t0 + tid) * 8 + h]; sa[tid] = c.gdec[(t0 + tid) * 8 + h]; } }
            __syncthreads();
            if (act) {
#pragma unroll 1
            for (int tt = 0; tt < TB; ++tt) {
                const float a = sa[tt], be = sb[tt]; float kd = 0.f;
#pragma unroll
                for (int d = 0; d < 64; d += 4) { const f32x4 k4 = *(LAS f32x4*)(sk + tt * 128 + d0 + d); kd += k4[0] * st[d] + k4[1] * st[d + 1] + k4[2] * st[d + 2] + k4[3] * st[d + 3]; }
                kd += __shfl_xor(kd, 1);
                const float c1 = be * (sv[tt * 128 + v] - a * kd); float o = 0.f;
#pragma unroll
                for (int d = 0; d < 64; d += 4) {
                    const f32x4 k4 = *(LAS f32x4*)(sk + tt * 128 + d0 + d), q4 = *(LAS f32x4*)(sq + tt * 128 + d0 + d);
                    st[d] = a * st[d] + c1 * k4[0]; o += q4[0] * st[d];
                    st[d + 1] = a * st[d + 1] + c1 * k4[1]; o += q4[1] * st[d + 1];
                    st[d + 2] = a * st[d + 2] + c1 * k4[2]; o += q4[2] * st[d + 2];
                    st[d + 3] = a * st[d + 3] + c1 * k4[3]; o += q4[3] * st[d + 3];
                }
                o += __shfl_xor(o, 1);
                if (d0 == 0) c.ob[(size_t)(t0 + tt) * 1024 + h * 128 + v] = o;
            } }
            __syncthreads();
        }
    }
}
__device__ void ph_onorm(CtxK& c, LAS unsigned char* lds) {
    LAS float* red = (LAS float*)lds;
    const int tid = ltid() & 255, g = ltid() >> 8;
    for (int t = blockIdx.x * 2 + g; t < S; t += gridDim.x * 2) {
        for (int i = 4; i < 8; ++i) {
            const int br = i >> 2, ch = (i & 3) * 256 + tid; const float v = (br ? c.ob : c.oa)[(size_t)t * 1024 + ch];
            const float ss = pair_sum128(v * v, red);
            const float o = v * rsqrtf(ss * (1.f / 128.f) + 1e-6f) * (br ? c.gdn_onorm_g : c.hgrn_onorm_g)[ch & 127] * siluf_(bf2f(c.proj[(size_t)t * PW + (br ? C_GG : C_HG) + ch]));
            const unsigned pk = cvt_pk_bf16(o, o); c.ocat[(size_t)t * D + br * 1024 + ch] = (bf16_t)(pk & 0xffffu);
        }
    }
}
constexpr int N2_LA = 0, N2_LB = 8192, N2_XH = 16384, N2_XL = N2_XH + 17408, N2_Y = N2_XL + 17408, N2_LOG = N2_Y + 34816, N2_RS = N2_LOG + 64 * 65 * 4, N2_IDX = N2_RS + 256, N2_BIAS = N2_IDX + 2048, N2_END = N2_BIAS + 256;
static_assert(N2_END <= 147456, "norm2 lds");
__device__ void ph_norm2(CtxK& c, LAS unsigned char* lds) {
    const int tid = ltid(), wg = blockIdx.x, lane = tid & 63, wv = __builtin_amdgcn_readfirstlane(tid >> 6), fr = lane & 15, fq = lane >> 4;
    LAS float* la = (LAS float*)(lds + N2_LA); LAS float* lb_ = (LAS float*)(lds + N2_LB); LAS float* lg = (LAS float*)(lds + N2_LOG); LAS float* rs = (LAS float*)(lds + N2_RS);
    LAS int* idxt = (LAS int*)(lds + N2_IDX); LAS float* bias2 = (LAS float*)(lds + N2_BIAS);
    for (int j = tid; j < D; j += 512) { la[j] = c.norm2_g[j] * (1.f + c.mod[4 * D + j]); lb_[j] = c.mod[3 * D + j]; }
    if (tid < 64) bias2[tid] = c.rbias2[tid];
    __syncthreads();
    const int tok0 = wg * 64;
    f32x4 vn[8];
    { const float* xr = c.out + (size_t)(tok0 + wv * 8) * D;
#pragma unroll
      for (int i = 0; i < 8; ++i) vn[i] = *(const f32x4*)(xr + i * 256 + lane * 4); }
    for (int rr = 0; rr < 8; ++rr) {
        const int row = tok0 + wv * 8 + rr;
        f32x4 v[8]; float ss = 0.f;
#pragma unroll
        for (int i = 0; i < 8; ++i) { v[i] = vn[i]; ss += v[i][0] * v[i][0] + v[i][1] * v[i][1] + v[i][2] * v[i][2] + v[i][3] * v[i][3]; }
        if (rr + 1 < 8) { const float* xr = c.out + (size_t)(row + 1) * D;
#pragma unroll
            for (int i = 0; i < 8; ++i) vn[i] = *(const f32x4*)(xr + i * 256 + lane * 4); }
        ss = wave_sum(ss); const float r = rsqrtf(ss * (1.f / D) + 1e-6f);
        if (lane == 0) rs[wv * 8 + rr] = r;
#pragma unroll
        for (int i = 0; i < 8; ++i) { const int e = i * 256 + lane * 4; const f32x4 a = *(LAS f32x4*)(la + e), b = *(LAS f32x4*)(lb_ + e); const f32x4 y = v[i] * r * a + b;
            u32x2 w; w.x = cvt_pk_bf16(y[0], y[1]); w.y = cvt_pk_bf16(y[2], y[3]); *(u32x2*)(c.h2 + (size_t)row * D + e) = w; }
    }
    const int xrow = tid >> 3, xseg = (tid & 7) * 16;
    f32x4 xr_[4]; u32x4 yr_[5];
    auto issue = [&](int ch) {
        const float* xp = c.out + (size_t)(tok0 + xrow) * D + ch * 128 + xseg;
#pragma unroll
        for (int q = 0; q < 4; ++q) xr_[q] = *(const f32x4*)(xp + q * 4);
        const unsigned char* yp = (const unsigned char*)c.rwimg + (size_t)ch * 34816 + tid * 16;
#pragma unroll
        for (int q = 0; q < 4; ++q) yr_[q] = *(const u32x4*)(yp + q * 8192);
        if (tid < 128) yr_[4] = *(const u32x4*)(yp + 32768);
    };
    issue(0);
    f32x4 acc[2] = {(f32x4){0.f, 0.f, 0.f, 0.f}, (f32x4){0.f, 0.f, 0.f, 0.f}};
    const int mt = wv >> 1, nb = (wv & 1) * 2;
    for (int ch = 0; ch < 16; ++ch) {
        __syncthreads();
        { float hi[16], lo[16];
#pragma unroll
          for (int q = 0; q < 4; ++q)
#pragma unroll
              for (int j = 0; j < 4; ++j) { const float x = xr_[q][j]; const float h = __uint_as_float(cvt_pk_bf16(x, x) << 16); hi[q * 4 + j] = h; lo[q * 4 + j] = x - h; }
          float t8[8];
#pragma unroll
          for (int hh = 0; hh < 2; ++hh) {
#pragma unroll
              for (int j = 0; j < 8; ++j) t8[j] = hi[hh * 8 + j];
              *(LAS u32x4*)(lds + N2_XH + xrow * 272 + (xseg + hh * 8) * 2) = mx::pack8(t8);
#pragma unroll
              for (int j = 0; j < 8; ++j) t8[j] = lo[hh * 8 + j];
              *(LAS u32x4*)(lds + N2_XL + xrow * 272 + (xseg + hh * 8) * 2) = mx::pack8(t8); }
#pragma unroll
          for (int q = 0; q < 4; ++q) *(LAS u32x4*)(lds + N2_Y + tid * 16 + q * 8192) = yr_[q];
          if (tid < 128) *(LAS u32x4*)(lds + N2_Y + tid * 16 + 32768) = yr_[4]; }
        __syncthreads();
        if (ch + 1 < 16) issue(ch + 1);
#pragma unroll
        for (int kk = 0; kk < 4; ++kk) {
            const int ko = (kk * 32 + fq * 8) * 2;
            const bf16x8 ah = *(const LAS bf16x8*)(lds + N2_XH + (16 * mt + fr) * 272 + ko), al = *(const LAS bf16x8*)(lds + N2_XL + (16 * mt + fr) * 272 + ko);
#pragma unroll
            for (int n = 0; n < 2; ++n) {
                const bf16x8 bh = *(const LAS bf16x8*)(lds + N2_Y + (16 * (nb + n) + fr) * 272 + ko), bl = *(const LAS bf16x8*)(lds + N2_Y + 17408 + (16 * (nb + n) + fr) * 272 + ko);
                acc[n] = mx::mfma16(ah, bh, acc[n]); acc[n] = mx::mfma16(ah, bl, acc[n]); acc[n] = mx::mfma16(al, bh, acc[n]);
            }
        }
    }
#pragma unroll
    for (int n = 0; n < 2; ++n)
#pragma unroll
        for (int r = 0; r < 4; ++r) lg[(16 * mt + 4 * fq + r) * 65 + 16 * (nb + n) + fr] = acc[n][r];
    __syncthreads();
    const float rb = c.router_bias[lane], b2 = bias2[lane];
    for (int rr = 0; rr < 8; ++rr) {
        const int lr = wv * 8 + rr, t = tok0 + lr;
        const float s = sigmoidf_(lg[lr * 65 + lane] * rs[lr] + b2), b = s + rb;
        int rk = 0;
#pragma unroll
        for (int x = 1; x < 8; ++x) { const float ob = __shfl_xor(b, x); const int ol = lane ^ x; rk += (ob > b || (ob == b && ol < lane)) ? 1 : 0; }
        float gs = rk < 2 ? b : 0.f; gs += __shfl_xor(gs, 1); gs += __shfl_xor(gs, 2); gs += __shfl_xor(gs, 4);
        int grk = 0;
#pragma unroll
        for (int x = 8; x < 64; x += 8) { const float og = __shfl_xor(gs, x); const int ol = lane ^ x; grk += (og > gs || (og == gs && ol < lane)) ? 1 : 0; }
        float mb = grk < 4 ? b : -INFINITY;
        float wsum = 0.f; int myk = -1;
        for (int k = 0; k < TOPK; ++k) {
            float m = mb;
#pragma unroll
            for (int o = 32; o >= 1; o >>= 1) m = fmaxf(m, __shfl_xor(m, o));
            const unsigned long long bal = __ballot(mb == m); const int win = __ffsll((long long)bal) - 1;
            const float sw = __shfl(s, win); wsum += sw;
            if (lane == win) { mb = -INFINITY; myk = k; }
        }
        if (myk >= 0) { c.idx[t * TOPK + myk] = lane; c.wts[t * TOPK + myk] = s / wsum * 2.5f; idxt[lr * TOPK + myk] = lane; }
    }
    __syncthreads();
    if (tid < 64) { int n = 0;
        for (int p = 0; p < 512; ++p) if (idxt[p] == tid) { c.rnk[wg * 512 + p] = n; ++n; }
        c.tile_cnt[wg * 64 + tid] = n; }
}
__device__ void ph_route(CtxK& c, LAS unsigned char* lds) {
    const int tid = ltid(), b = blockIdx.x, e = tid & 63, part = tid >> 6;
    LAS int* psum = (LAS int*)lds; LAS int* pbel = psum + 512; LAS int* tot = pbel + 512; LAS int* offb = tot + 64; LAS int* pst = offb + 64;
    { int sa = 0, sb = 0;
      for (int tl = part * 32; tl < part * 32 + 32; ++tl) { const int v = c.tile_cnt[tl * 64 + e]; sa += v; sb += tl < b ? v : 0; }
      psum[part * 64 + e] = sa; pbel[part * 64 + e] = sb; }
    __syncthreads();
    if (tid < 64) {
        int t_ = 0, o_ = 0;
#pragma unroll
        for (int q = 0; q < 8; ++q) { t_ += psum[q * 64 + e]; o_ += pbel[q * 64 + e]; }
        const int pad = (t_ + 255) & ~255; int inc = pad;
#pragma unroll
        for (int o = 1; o < 64; o <<= 1) { const int x = __shfl_up(inc, o); if (e >= o) inc += x; }
        const int ps = inc - pad;
        tot[e] = t_; offb[e] = o_; pst[e] = ps;
        if (b == 0) {
            const int b0 = ps >> 8, nbe = pad >> 8;
            for (int j = 0; j < nbe; ++j) { c.blk_row[b0 + j] = ps + j * 256; c.blk_exp[b0 + j] = e; }
            const int nbr = __shfl(inc, 63) >> 8;
            c.blk_row[nbr + e] = PROUTED + e * 256; c.blk_exp[nbr + e] = NE;
            if (e == 0) *c.nent = nbr + S / 256;
        }
        c.tok_p[PROUTED + b * 64 + e] = b * 64 + e; c.w_p[PROUTED + b * 64 + e] = 1.f;
    }
    __syncthreads();
    { const int p = b * 512 + tid, ex = c.idx[p], d = pst[ex] + offb[ex] + c.rnk[p];
      c.tok_p[d] = p >> 3; c.w_p[d] = c.wts[p]; c.pos[p] = d; }
    if (b < NE) { const int ps = pst[b], t_ = tot[b], pe = (t_ + 255) & ~255;
        for (int r = t_ + tid; r < pe; r += 512) { c.tok_p[ps + r] = 0; c.w_p[ps + r] = 0.f; } }
}

constexpr int LDS_MAIN = 147456, LDS_BYTES = LDS_MAIN + 16;
__global__ void __launch_bounds__(512, 2) k_mega(Ctx c) {
    extern __shared__ __attribute__((aligned(16))) unsigned char smem[];
    LAS unsigned char* lds = (LAS unsigned char*)smem;
    if (ltid() == 0) *(LAS u32x4*)(lds + LDS_MAIN) = (u32x4){0u, 0u, 0u, 0u};
    __syncthreads();
    CtxK* kp = (CtxK*)__builtin_amdgcn_kernarg_segment_ptr();
    (void)xcd_barrier_post(c.bar, (volatile LAS unsigned*)(lds + LDS_MAIN));
#define PHASE(fn) do { const CtxK* kp_ = kp; asm volatile("" : "+s"(kp_)); fn(*kp_, lds); __syncthreads(); } while (0)
#define GRID_BARRIER() do { const CtxK* kp_ = kp; asm volatile("" : "+s"(kp_)); XcdBarrier bb_; bb_.bar = kp_->bar; bb_.x = xb_xcc_id(); bb_.st = (volatile LAS unsigned*)(lds + LDS_MAIN); xcd_barrier(bb_); } while (0)
    PHASE(ph_pro1);      GRID_BARRIER();
    PHASE(ph_norm1);     GRID_BARRIER();
    PHASE(ph_gemm1);     GRID_BARRIER();
    PHASE(ph_hgrn1);     PHASE(ph_gdn1);  GRID_BARRIER();
    PHASE(ph_hgrn2);     PHASE(ph_gdn2);  PHASE(ph_cvt_exp); GRID_BARRIER();
    PHASE(ph_hgrn3);     PHASE(ph_gdn3);  GRID_BARRIER();
    PHASE(ph_gemm2);     GRID_BARRIER();
    PHASE(ph_gemm3);     GRID_BARRIER();
    PHASE(ph_norm2);     GRID_BARRIER();
    PHASE(ph_route);     GRID_BARRIER();
    PHASE(ph_moe_gu);    GRID_BARRIER();
    PHASE(ph_moe_dn);    GRID_BARRIER();
    PHASE(ph_final);
#undef PHASE
#undef GRID_BARRIER
}

extern "C" void kernel_launch(void* const* d_in, const int* in_sizes, int n_in, void* d_out, int out_size, void* d_ws, size_t ws_size, hipStream_t stream) {
    Ctx c{};
    const float** ip = (const float**)&c.x;
    for (int i = 0; i < 25; ++i) ip[i] = (const float*)d_in[i];
    c.out = (float*)d_out;
    char* ws = (char*)d_ws; constexpr size_t MB = 1024 * 1024;
    c.bar = (unsigned*)ws;
    c.modp = (float*)(ws + 64 * 1024); c.mod = (float*)(ws + 320 * 1024); c.lb = (float*)(ws + 384 * 1024);
    c.cnt = (int*)(ws + 392 * 1024); c.nent = (int*)(ws + 396 * 1024); c.blk_row = (int*)(ws + 400 * 1024); c.blk_exp = (int*)(ws + 404 * 1024);
    c.idx = (int*)(ws + 1 * MB); c.wts = (float*)(ws + 2 * MB); c.tok_p = (int*)(ws + 3 * MB); c.w_p = (float*)(ws + 4 * MB); c.pos = (int*)(ws + 5 * MB);
    c.gab = (float*)(ws + 6 * MB); c.gbeta = (float*)(ws + 7 * MB + 0); c.gdec = (float*)(ws + 7 * MB + 512 * 1024);
    c.rwimg = (bf16_t*)(ws + 8 * MB); c.rbias2 = (float*)(ws + 9 * MB); c.tile_cnt = (int*)(ws + 9 * MB + 4096); c.rnk = (int*)(ws + 10 * MB);
    char* big = ws + 16 * MB;
    auto at = [&](size_t mib) { return big + mib * MB; };
    c.dn_t = (bf16_t*)at(0); c.gu_t = (bf16_t*)at(130);
    c.win_t = (bf16_t*)at(0); c.h1 = (bf16_t*)at(48); c.gAT = (float*)at(112);
    c.proj = (bf16_t*)at(390); c.gBlob = (unsigned char*)at(774); c.merged = (bf16_t*)at(774);
    c.gM = (unsigned char*)at(951); c.gB = (float*)at(960); c.hL = (float*)at(976); c.gS = (float*)at(992); c.hS = (float*)at(1008); c.hD = (float*)at(1024);
    c.wa_t = (bf16_t*)at(1025); c.wb_t = (bf16_t*)at(1029); c.wout_t = (bf16_t*)at(1033); c.ocat = (bf16_t*)at(1041);
    c.Y = (unsigned char*)at(130); c.hid = (bf16_t*)at(770); c.h2 = (bf16_t*)at(930);
    static_assert((size_t)NEX * D * FF * 2 <= 130 * MB && (size_t)NEX * 1024 * D * 2 <= 260 * MB && (size_t)PW * D * 2 <= 48 * MB && (size_t)S * D * 2 <= 64 * MB, "map A");
    static_assert((size_t)S * PW * 2 <= 384 * MB && (size_t)2048 * mx::BLOB <= 177 * MB && (size_t)256 * 128 * mx::ST128 <= 9 * MB && (size_t)PTOT * D * 2 <= 640 * MB && (size_t)PTOT * FF * 2 <= 160 * MB, "map B");
    const size_t need = 16 * MB + 1105 * MB;
    if (ws_size < need) { fprintf(stderr, "kernel_launch: workspace too small: %zu < %zu\n", ws_size, need); return; }

    static int grid = 0;
    if (!grid) {
        int dev = 0, cus = 0, per_cu = 0;
        hipGetDevice(&dev); hipDeviceGetAttribute(&cus, hipDeviceAttributeMultiprocessorCount, dev);
        hipFuncSetAttribute((const void*)k_mega, hipFuncAttributeMaxDynamicSharedMemorySize, LDS_BYTES);
        hipOccupancyMaxActiveBlocksPerMultiprocessor(&per_cu, (const void*)k_mega, 512, LDS_BYTES);
        if (per_cu < 1) fprintf(stderr, "kernel_launch: occupancy query reports %d blocks per CU\n", per_cu);
        grid = cus;
        if (grid != 256) { fprintf(stderr, "kernel_launch: built for a 256-CU device (token-mixer units = workgroups); got %d CUs\n", cus); grid = -1; }
    }
    if (grid < 0) return;
    hipMemsetAsync(c.bar, 0, XCD_BAR_WORDS * sizeof(unsigned), stream);
    hipLaunchKernelGGL(k_mega, dim3(grid), dim3(512), LDS_BYTES, stream, c);
}
```

```cpp
#include <hip/hip_runtime.h>
#include <stdint.h>
#include <stdio.h>

#define LAS __attribute__((address_space(3)))
typedef unsigned short bf16_t;
typedef short bf16x8 __attribute__((ext_vector_type(8)));
typedef float f32x4 __attribute__((ext_vector_type(4)));
typedef unsigned u32x4 __attribute__((ext_vector_type(4)));
typedef unsigned u32x2 __attribute__((ext_vector_type(2)));

constexpr int S = 16384, D = 2048, INW = 12304, PW = 12288, NE = 64, TOPK = 8, TK = S * TOPK, FF = 512;
constexpr int NEX = NE + 1;
constexpr int PROUTED = 147456, PTOT = PROUTED + S, NBLK_MAX = PROUTED / 256;
constexpr int C_HQ = 0, C_HF = 1024, C_HI = 2048, C_HG = 3072, C_GQKV = 4096, C_GG = 7168, C_MGA = 8192, C_MGB = 10240;
constexpr int WIN_GAB = 7168;

__device__ __forceinline__ float rcpf_(float x) { return __builtin_amdgcn_rcpf(x); }
__device__ __forceinline__ float sigmoidf_(float x) { return rcpf_(1.f + __expf(-x)); }
__device__ __forceinline__ float siluf_(float x) { return x * rcpf_(1.f + __expf(-x)); }
__device__ __forceinline__ float softplusf_(float x) { return x > 20.f ? x : log1pf(expf(x)); }
__device__ __forceinline__ float bf2f(bf16_t b) { return __uint_as_float(((unsigned)b) << 16); }
__device__ __forceinline__ float bflo(unsigned w) { return __uint_as_float(w << 16); }
__device__ __forceinline__ float bfhi(unsigned w) { return __uint_as_float(w & 0xffff0000u); }
__device__ __forceinline__ unsigned cvt_pk_bf16(float lo, float hi) { unsigned r; asm volatile("v_cvt_pk_bf16_f32 %0, %1, %2" : "=v"(r) : "v"(lo), "v"(hi)); return r; }
__device__ __forceinline__ int ltid() { int t = threadIdx.x; asm volatile("" : "+v"(t)); return t; }
__device__ __forceinline__ float wave_sum(float v) {
#pragma unroll
    for (int o = 32; o >= 1; o >>= 1) v += __shfl_xor(v, o);
    return v;
}


#define XB_TMO      128
#define XB_XCNT(j)  (256  + 64 * (j))
#define XB_XSUB(j)  (1280 + 64 * (j))
#define XB_XGEN(j)  (2304 + 64 * (j))
#define XB_TOP      3328
#define XB_TOPGEN   3392
#define XCD_BAR_WORDS 3456
#define XB_SPIN_CAP (1u << 18)
__device__ __forceinline__ unsigned xb_ld(unsigned* p)              { return __hip_atomic_load(p, __ATOMIC_RELAXED, __HIP_MEMORY_SCOPE_AGENT); }
__device__ __forceinline__ unsigned xb_add(unsigned* p, unsigned v) { return __hip_atomic_fetch_add(p, v, __ATOMIC_RELAXED, __HIP_MEMORY_SCOPE_AGENT); }
__device__ __forceinline__ unsigned xb_xcc_id() { return (unsigned)__builtin_amdgcn_s_getreg((3 << 11) | 20) & 0xFu; }
#define XB_SPIN(cond, bar) do { unsigned _sp = 0; while (cond) { __builtin_amdgcn_s_sleep(1); \
    if ((++_sp & 255u) == 0u) { if (xb_ld(&(bar)[XB_TMO])) break; if (_sp > XB_SPIN_CAP) { atomicAdd(&(bar)[XB_TMO], 1u); break; } } } } while (0)
struct XcdBarrier { unsigned* bar; unsigned x; volatile LAS unsigned* st; };
__device__ __forceinline__ XcdBarrier xcd_barrier_post(unsigned* bar, volatile LAS unsigned* st) {
    XcdBarrier b; b.bar = bar; b.x = xb_xcc_id(); b.st = st;
    if (threadIdx.x == 0) (void)xb_add(&bar[XB_XCNT(b.x)], 1u);
    return b;
}
__device__ __forceinline__ void xcd_barrier_complete(unsigned* bar, unsigned x, unsigned& nloc, unsigned& nx) {
    const unsigned G = gridDim.x * gridDim.y * gridDim.z;
    unsigned sum, cnt, mine, sp = 0u;
    for (;;) {
        sum = 0u; cnt = 0u; mine = 0u;
#pragma unroll
        for (unsigned j = 0; j < 16; ++j) { const unsigned c = xb_ld(&bar[XB_XCNT(j)]); sum += c; cnt += (c > 0u) ? 1u : 0u; mine = (j == x) ? c : mine; }
        if (sum == G) break;
        __builtin_amdgcn_s_sleep(1);
        if ((++sp & 255u) == 0u) { if (xb_ld(&bar[XB_TMO])) break; if (sp > XB_SPIN_CAP) { atomicAdd(&bar[XB_TMO], 1u); break; } }
    }
    nloc = mine > 0u ? mine : 1u; nx = cnt > 0u ? cnt : 1u;
}
__device__ __forceinline__ void xcd_barrier(const XcdBarrier& b) {
    asm volatile("s_waitcnt vmcnt(0)" ::: "memory");
    __syncthreads();
    if (threadIdx.x == 0) {
        unsigned* bar = b.bar;
        __builtin_amdgcn_s_waitcnt(0);
        unsigned nloc = b.st[0], nx = b.st[1];
        if (nloc == 0u) { xcd_barrier_complete(bar, b.x, nloc, nx); b.st[0] = nloc; b.st[1] = nx; }
        const unsigned old = xb_add(&bar[XB_XSUB(b.x)], 1u);
        const unsigned gen = old / nloc;
        if (old + 1u == (gen + 1u) * nloc) {
            __builtin_amdgcn_fence(__ATOMIC_RELEASE, "agent");
            asm volatile("s_waitcnt vmcnt(0)" ::: "memory");
            const unsigned og = xb_add(&bar[XB_TOP], 1u);
            const unsigned tg = og / nx;
            if (og + 1u == (tg + 1u) * nx) xb_add(&bar[XB_TOPGEN], 1u);
            else XB_SPIN(xb_ld(&bar[XB_TOPGEN]) == tg, bar);
            __builtin_amdgcn_fence(__ATOMIC_ACQUIRE, "agent");
            xb_add(&bar[XB_XGEN(b.x)], 1u);
            asm volatile("s_waitcnt vmcnt(0)" ::: "memory");
        } else {
            XB_SPIN(xb_ld(&bar[XB_XGEN(b.x)]) == gen, bar);
            __builtin_amdgcn_fence(__ATOMIC_ACQUIRE, "agent");
            asm volatile("s_waitcnt vmcnt(0)" ::: "memory");
        }
    }
    __syncthreads();
}

namespace gm {
constexpr int BM = 256, BK = 64, HALF = 128, HTB = HALF * BK * 2, STAGE_BYTES = 8 * HTB;
__host__ __device__ __forceinline__ int lds_byte(int r, int c) { const int st = (r >> 4) * 2 + (c >> 5), rr = r & 15, cc = c & 31, ob = rr * 64 + cc * 2; return st * 1024 + (ob ^ (((ob >> 9) & 1) << 5)); }
__host__ __device__ __forceinline__ void stage_rc(int b, int& R, int& C) { const int st = b / 1024, sb = b % 1024, swz = sb ^ (((sb >> 9) & 1) << 5); R = (st >> 1) * 16 + swz / 64; C = (st & 1) * 32 + (swz % 64) / 2; }
__host__ __device__ __forceinline__ int perm32(int rho) { const int n = rho >> 4, i = rho & 15; return 8 * (i >> 2) + 4 * n + (i & 3); }

struct Unit { int pm, pn, aux; const char* Bp; unsigned a00, a01, a10, a11; };

template <class Epi, class Sched>
__device__ __forceinline__ void gphase(LAS unsigned char* lds, const char* Abase, const int K, Sched& S, Epi& E) {
    const int tid = ltid(), wid = __builtin_amdgcn_readfirstlane(tid >> 6), lane = tid & 63, wr = wid >> 2, wc = wid & 3, fr = lane & 15, fq = lane >> 4;
    const int nt = K / BK;
    unsigned voffB[2];
#pragma unroll
    for (int i = 0; i < 2; ++i) { int R, C; stage_rc(tid * 16 + i * 8192, R, C); const int Rb = Epi::PERM ? ((R & ~31) + perm32(R & 31)) : R; voffB[i] = (unsigned)(Rb * K + C) * 2u; }
    const size_t hstepB = (size_t)HALF * K * 2;
    const unsigned ldsw = (unsigned)wid * 1024u;
    const int aoff = lds_byte(wr * 64 + fr, fq * 8), boff = lds_byte(wc * 32 + fr, fq * 8);
#define G_SA(b, h) (((b) * 2 + (h)) * HTB)
#define G_SB(b, h) ((4 + (b) * 2 + (h)) * HTB)
#define G_STAGE_A(bufoff, o0, o1, kb) do { \
        __builtin_amdgcn_global_load_lds((const unsigned*)(Abase + (o0) + (kb)), (LAS unsigned*)(lds + (bufoff) + ldsw), 16, 0, 0); \
        __builtin_amdgcn_global_load_lds((const unsigned*)(Abase + (o1) + (kb)), (LAS unsigned*)(lds + (bufoff) + ldsw + 8192), 16, 0, 0); } while (0)
#define G_STAGE_B(bufoff, bp, kb) do { \
        __builtin_amdgcn_global_load_lds((const unsigned*)((bp) + voffB[0] + (kb)), (LAS unsigned*)(lds + (bufoff) + ldsw), 16, 0, 0); \
        __builtin_amdgcn_global_load_lds((const unsigned*)((bp) + voffB[1] + (kb)), (LAS unsigned*)(lds + (bufoff) + ldsw + 8192), 16, 0, 0); } while (0)
#define G_LDA(dst, b, h) do { _Pragma("unroll") for (int m = 0; m < 4; ++m) _Pragma("unroll") for (int k = 0; k < 2; ++k) dst[m][k] = *(const LAS bf16x8*)(lds + G_SA(b, h) + aoff + m * 2048 + k * 1024); } while (0)
#define G_LDB(dst, b, h) do { _Pragma("unroll") for (int n = 0; n < 2; ++n) _Pragma("unroll") for (int k = 0; k < 2; ++k) dst[n][k] = *(const LAS bf16x8*)(lds + G_SB(b, h) + boff + n * 2048 + k * 1024); } while (0)
#define G_MMA(ai, bj, At, Bt) do { __builtin_amdgcn_s_setprio(1); _Pragma("unroll") for (int m = 0; m < 4; ++m) _Pragma("unroll") for (int n = 0; n < 2; ++n) _Pragma("unroll") for (int k = 0; k < 2; ++k) \
        acc[ai][bj][m][n] = __builtin_amdgcn_mfma_f32_16x16x32_bf16(Bt[n][k], At[m][k], acc[ai][bj][m][n], 0, 0, 0); __builtin_amdgcn_s_setprio(0); } while (0)
#define G_WAIT_V(n) asm volatile("s_waitcnt vmcnt(" #n ")" ::: "memory")
#define G_WAIT_L(n) asm volatile("s_waitcnt lgkmcnt(" #n ")" ::: "memory")
#define G_BAR __builtin_amdgcn_s_barrier()
#define G_SCHED __builtin_amdgcn_sched_barrier(0)
#define G_ZERO() do { _Pragma("unroll") for (int a = 0; a < 2; ++a) _Pragma("unroll") for (int b = 0; b < 2; ++b) _Pragma("unroll") for (int m = 0; m < 4; ++m) _Pragma("unroll") for (int n = 0; n < 2; ++n) acc[a][b][m][n] = (f32x4){0.f, 0.f, 0.f, 0.f}; } while (0)
    Unit cur, nxt; int ui = 0;
    if (!S.next(0, cur)) return;
    f32x4 acc[2][2][4][2];
    G_ZERO();
    bf16x8 At[4][2], B0[2][2], B1[2][2];
    G_STAGE_B(G_SB(0, 0), cur.Bp, 0); G_STAGE_B(G_SB(0, 1), cur.Bp + hstepB, 0); G_STAGE_A(G_SA(0, 0), cur.a00, cur.a01, 0); G_STAGE_A(G_SA(0, 1), cur.a10, cur.a11, 0);
    if (wr == 1) G_BAR;
    G_WAIT_V(2); G_BAR;
    G_STAGE_B(G_SB(1, 0), cur.Bp, 128); G_STAGE_A(G_SA(1, 0), cur.a00, cur.a01, 128); G_STAGE_B(G_SB(1, 1), cur.Bp + hstepB, 128);
    G_WAIT_V(6); G_BAR;
    for (;;) {
        const bool has_next = S.next(ui + 1, nxt);
        if (!has_next) nxt = cur;
        for (int t = 0; t < nt; t += 2) {
            const bool last = (t == nt - 2);
            const size_t kb1 = (size_t)(t + 1) * 128, kb2 = last ? 0 : (size_t)(t + 2) * 128, kb3 = kb2 + 128;
            const char* b2 = last ? nxt.Bp : cur.Bp;
            const unsigned x00 = last ? nxt.a00 : cur.a00, x01 = last ? nxt.a01 : cur.a01, x10 = last ? nxt.a10 : cur.a10, x11 = last ? nxt.a11 : cur.a11;
            G_LDB(B0, 0, 0); G_LDB(B1, 0, 1); G_SCHED; G_LDA(At, 0, 0); G_STAGE_A(G_SA(1, 1), cur.a10, cur.a11, kb1);
            G_WAIT_V(8); G_WAIT_L(0); G_BAR; G_MMA(0, 0, At, B0); G_MMA(0, 1, At, B1); G_BAR; G_SCHED;
            G_LDA(At, 0, 1); G_STAGE_B(G_SB(0, 0), b2, kb2); G_STAGE_B(G_SB(0, 1), b2 + hstepB, kb2); G_STAGE_A(G_SA(0, 0), x00, x01, kb2);
            G_WAIT_V(8); G_WAIT_L(0); G_BAR; G_MMA(1, 0, At, B0); G_MMA(1, 1, At, B1); G_BAR; G_SCHED;
            G_LDB(B0, 1, 0); G_LDB(B1, 1, 1); G_SCHED; G_LDA(At, 1, 0); G_STAGE_A(G_SA(0, 1), x10, x11, kb2);
            G_WAIT_V(8); G_WAIT_L(0); G_BAR; G_MMA(0, 0, At, B0); G_MMA(0, 1, At, B1); G_BAR; G_SCHED;
            G_LDA(At, 1, 1); G_STAGE_B(G_SB(1, 0), b2, kb3); G_STAGE_B(G_SB(1, 1), b2 + hstepB, kb3); G_STAGE_A(G_SA(1, 0), x00, x01, kb3);
            G_WAIT_V(8); G_WAIT_L(0); G_BAR; G_MMA(1, 0, At, B0); G_MMA(1, 1, At, B1); G_BAR; G_SCHED;
        }
        if (wr == 0) G_BAR;
        E(acc, cur, wr, wc, fr, fq);
        if (!has_next) break;
        if (!E.keep(cur)) G_ZERO();
        cur = nxt; ++ui;
        if (wr == 1) G_BAR;
    }
    G_WAIT_V(0);
    G_BAR;
#undef G_SA
#undef G_SB
#undef G_STAGE_A
#undef G_STAGE_B
#undef G_LDA
#undef G_LDB
#undef G_MMA
#undef G_WAIT_V
#undef G_WAIT_L
#undef G_BAR
#undef G_SCHED
#undef G_ZERO
}

struct DenseSched {
    int nM, nN, nwg, G, c, lda, K, parts; const char* Bt; const char* Bt2; int R0, C0, R1, C1;
    __device__ void init(int M, int N, int K_, int lda_, const void* Bt_, const void* Bt2_, int parts_) {
        nM = M / BM; nN = N / BM; nwg = nM * nN; G = gridDim.x; c = blockIdx.x; lda = lda_; K = K_; Bt = (const char*)Bt_; Bt2 = (const char*)Bt2_; parts = parts_;
        stage_rc(ltid() * 16, R0, C0); stage_rc(ltid() * 16 + 8192, R1, C1);
    }
    __device__ bool next(int i, Unit& u) const {
        const int ti = parts == 2 ? (i >> 1) : i, part = parts == 2 ? (i & 1) : 0;
        const long L = (long)ti * G + c; if (L >= nwg) return false;
        int wgid = (int)L; { const int q = nwg / 8, r = nwg % 8, xcd = wgid % 8, off = wgid / 8; wgid = (xcd < r ? xcd * (q + 1) : r * (q + 1) + (xcd - r) * q) + off; }
        const int nig = 8 * nN, gid = wgid / nig, fm = gid * 8, gsz = (nM - fm) < 8 ? (nM - fm) : 8;
        u.pm = fm + ((wgid % nig) % gsz); u.pn = (wgid % nig) / gsz; u.aux = part;
        u.Bp = (part ? Bt2 : Bt) + (size_t)u.pn * BM * K * 2;
        const unsigned rb = (unsigned)u.pm * BM, po = part ? (unsigned)K * 2u : 0u;
        u.a00 = ((rb + R0) * lda + C0) * 2u + po; u.a01 = ((rb + R1) * lda + C1) * 2u + po;
        u.a10 = ((rb + HALF + R0) * lda + C0) * 2u + po; u.a11 = ((rb + HALF + R1) * lda + C1) * 2u + po;
        return true;
    }
};
template <bool GATHER>
struct MoeSched {
    static constexpr int MAXU = 24;
    int nN, K, lda, nu; const char* W; size_t wstride; int R0, C0, R1, C1; LAS const int* tbl; LAS const int* tokt;
    __device__ void init(LAS unsigned char* spare  , int nN_, int K_, int lda_, const int* nent_p, const int* blk_row, const int* blk_exp, const int* tok_p, const void* W_, size_t wstride_) {
        nN = nN_; K = K_; lda = lda_; W = (const char*)W_; wstride = wstride_;
        const int tid = ltid(), G = gridDim.x, c = blockIdx.x, nent = *nent_p;
        stage_rc(tid * 16, R0, C0); stage_rc(tid * 16 + 8192, R1, C1);
        const int x = c & 7, slot = c >> 3, nslot = G >> 3, e0 = (int)((long)x * nent / 8), e1 = (int)((long)(x + 1) * nent / 8), tot = (e1 - e0) * nN;
        nu = tot > slot ? (tot - slot + nslot - 1) / nslot : 0; if (nu > MAXU) nu = MAXU;
        LAS int* t_ = (LAS int*)spare; LAS int* k_ = (LAS int*)(spare + 256);
        if (tid < nu) { const int uidx = tid * nslot + slot, ent = e0 + uidx / nN; t_[tid * 2] = blk_row[ent]; t_[tid * 2 + 1] = blk_exp[ent] * 16 + uidx % nN; }
        __syncthreads();
        if (GATHER) { for (int j = tid; j < nu * 256; j += 512) k_[j] = tok_p[t_[(j >> 8) * 2] + (j & 255)]; __syncthreads(); }
        tbl = t_; tokt = k_;
    }
    __device__ bool next(int i, Unit& u) const {
        if (i >= nu) return false;
        const int rb = tbl[i * 2], ep = tbl[i * 2 + 1], e = ep >> 4; u.pn = ep & 15; u.pm = rb; u.aux = e;
        u.Bp = W + (size_t)e * wstride + (size_t)u.pn * BM * K * 2;
        if (GATHER) {
            const unsigned t00 = tokt[i * 256 + R0], t01 = tokt[i * 256 + R1], t10 = tokt[i * 256 + HALF + R0], t11 = tokt[i * 256 + HALF + R1];
            u.a00 = (t00 * lda + C0) * 2u; u.a01 = (t01 * lda + C1) * 2u; u.a10 = (t10 * lda + C0) * 2u; u.a11 = (t11 * lda + C1) * 2u;
        } else {
            u.a00 = ((unsigned)(rb + R0) * lda + C0) * 2u; u.a01 = ((unsigned)(rb + R1) * lda + C1) * 2u;
            u.a10 = ((unsigned)(rb + HALF + R0) * lda + C0) * 2u; u.a11 = ((unsigned)(rb + HALF + R1) * lda + C1) * 2u;
        }
        return true;
    }
};

struct EpiProj {
    static constexpr bool PERM = true; bf16_t* O;
    __device__ __forceinline__ bool keep(const Unit&) const { return false; }
    __device__ __forceinline__ void operator()(f32x4 (&acc)[2][2][4][2], const Unit& u, int wr, int wc, int fr, int fq) const {
        const int row0 = u.pm * BM + wr * 64 + fr, col0 = u.pn * BM + wc * 32 + 8 * fq;
#pragma unroll
        for (int ai = 0; ai < 2; ++ai)
#pragma unroll
            for (int m = 0; m < 4; ++m) { bf16_t* rowp = O + (size_t)(row0 + ai * HALF + m * 16) * PW + col0;
#pragma unroll
                for (int bj = 0; bj < 2; ++bj) { const f32x4 v0 = acc[ai][bj][m][0], v1 = acc[ai][bj][m][1]; u32x4 w;
                    w.x = cvt_pk_bf16(v0[0], v0[1]); w.y = cvt_pk_bf16(v0[2], v0[3]); w.z = cvt_pk_bf16(v1[0], v1[1]); w.w = cvt_pk_bf16(v1[2], v1[3]);
                    *(u32x4*)(rowp + bj * HALF) = w; } }
    }
};
struct EpiMerge {
    static constexpr bool PERM = true; const bf16_t* proj; bf16_t* O;
    __device__ __forceinline__ bool keep(const Unit& u) const { return u.aux == 0; }
    __device__ __forceinline__ void operator()(f32x4 (&acc)[2][2][4][2], const Unit& u, int wr, int wc, int fr, int fq) const {
        const int row0 = u.pm * BM + wr * 64 + fr, col0 = u.pn * BM + wc * 32 + 8 * fq;
#pragma unroll
        for (int ai = 0; ai < 2; ++ai)
#pragma unroll
            for (int m = 0; m < 4; ++m) { const size_t r = (size_t)(row0 + ai * HALF + m * 16);
#pragma unroll
                for (int bj = 0; bj < 2; ++bj) {
                    const u32x4 gb = *(const u32x4*)(proj + r * PW + C_MGB + col0 + bj * HALF);
                    const f32x4 eb0 = {__expf(-bflo(gb.x)), __expf(-bfhi(gb.x)), __expf(-bflo(gb.y)), __expf(-bfhi(gb.y))};
                    const f32x4 eb1 = {__expf(-bflo(gb.z)), __expf(-bfhi(gb.z)), __expf(-bflo(gb.w)), __expf(-bfhi(gb.w))};
                    if (u.aux == 0) {
                        const u32x4 ga = *(const u32x4*)(proj + r * PW + C_MGA + col0 + bj * HALF);
                        const f32x4 ea0 = {__expf(-bflo(ga.x)), __expf(-bfhi(ga.x)), __expf(-bflo(ga.y)), __expf(-bfhi(ga.y))};
                        const f32x4 ea1 = {__expf(-bflo(ga.z)), __expf(-bfhi(ga.z)), __expf(-bflo(ga.w)), __expf(-bfhi(ga.w))};
#pragma unroll
                        for (int j = 0; j < 4; ++j) { acc[ai][bj][m][0][j] *= (1.f + eb0[j]) * rcpf_(1.f + ea0[j]); acc[ai][bj][m][1][j] *= (1.f + eb1[j]) * rcpf_(1.f + ea1[j]); }
                    } else {
                        f32x4 v0 = acc[ai][bj][m][0], v1 = acc[ai][bj][m][1];
#pragma unroll
                        for (int j = 0; j < 4; ++j) { v0[j] *= rcpf_(1.f + eb0[j]); v1[j] *= rcpf_(1.f + eb1[j]); }
                        u32x4 w; w.x = cvt_pk_bf16(v0[0], v0[1]); w.y = cvt_pk_bf16(v0[2], v0[3]); w.z = cvt_pk_bf16(v1[0], v1[1]); w.w = cvt_pk_bf16(v1[2], v1[3]);
                        *(u32x4*)(O + r * D + col0 + bj * HALF) = w;
                    } } }
    }
};
struct EpiResid {
    static constexpr bool PERM = false; const float* x; const float* gt; float* O;
    __device__ __forceinline__ bool keep(const Unit&) const { return false; }
    __device__ __forceinline__ void operator()(f32x4 (&acc)[2][2][4][2], const Unit& u, int wr, int wc, int fr, int fq) const {
        const int row0 = u.pm * BM + wr * 64 + fr, col0 = u.pn * BM + wc * 32 + 4 * fq;
        f32x4 g[2][2];
#pragma unroll
        for (int bj = 0; bj < 2; ++bj)
#pragma unroll
            for (int n = 0; n < 2; ++n) g[bj][n] = *(const f32x4*)(gt + col0 + bj * HALF + n * 16);
#pragma unroll
        for (int ai = 0; ai < 2; ++ai)
#pragma unroll
            for (int m = 0; m < 4; ++m) { const size_t ro = (size_t)(row0 + ai * HALF + m * 16) * D + col0;
#pragma unroll
                for (int bj = 0; bj < 2; ++bj)
#pragma unroll
                    for (int n = 0; n < 2; ++n) { const f32x4 xv = *(const f32x4*)(x + ro + bj * HALF + n * 16); *(f32x4*)(O + ro + bj * HALF + n * 16) = xv + g[bj][n] * acc[ai][bj][m][n]; } }
    }
};
struct EpiSwiglu {
    static constexpr bool PERM = true; bf16_t* hid;
    __device__ __forceinline__ bool keep(const Unit&) const { return false; }
    __device__ __forceinline__ void operator()(f32x4 (&acc)[2][2][4][2], const Unit& u, int wr, int wc, int fr, int fq) const {
        const int row0 = u.pm + wr * 64 + fr, j0 = u.pn * 128 + wc * 16 + 4 * fq;
#pragma unroll
        for (int ai = 0; ai < 2; ++ai)
#pragma unroll
            for (int m = 0; m < 4; ++m) { bf16_t* rowp = hid + (size_t)(row0 + ai * HALF + m * 16) * FF + j0;
#pragma unroll
                for (int bj = 0; bj < 2; ++bj) { const f32x4 g = acc[ai][bj][m][0], up = acc[ai][bj][m][1]; u32x2 w;
                    w.x = cvt_pk_bf16(siluf_(g[0]) * up[0], siluf_(g[1]) * up[1]); w.y = cvt_pk_bf16(siluf_(g[2]) * up[2], siluf_(g[3]) * up[3]);
                    *(u32x2*)(rowp + bj * 64) = w; } }
    }
};
struct EpiDown {
    static constexpr bool PERM = true; unsigned char* Y; const float* w_p;
    __device__ __forceinline__ bool keep(const Unit&) const { return false; }
    __device__ __forceinline__ void operator()(f32x4 (&acc)[2][2][4][2], const Unit& u, int wr, int wc, int fr, int fq) const {
        const int row0 = u.pm + wr * 64 + fr, col0 = u.pn * BM + wc * 32 + 8 * fq;
#pragma unroll
        for (int ai = 0; ai < 2; ++ai)
#pragma unroll
            for (int m = 0; m < 4; ++m) { const int r = row0 + ai * HALF + m * 16; const float wt = w_p[r] * 16.f; unsigned char* rowp = Y + (size_t)r * D + col0;
#pragma unroll
                for (int bj = 0; bj < 2; ++bj) { f32x4 v0 = acc[ai][bj][m][0] * wt, v1 = acc[ai][bj][m][1] * wt;
#pragma unroll
                    for (int j = 0; j < 4; ++j) { v0[j] = fminf(fmaxf(v0[j], -448.f), 448.f); v1[j] = fminf(fmaxf(v1[j], -448.f), 448.f); }
                    int w0 = __builtin_amdgcn_cvt_pk_fp8_f32(v0[0], v0[1], 0, false); w0 = __builtin_amdgcn_cvt_pk_fp8_f32(v0[2], v0[3], w0, true);
                    int w1 = __builtin_amdgcn_cvt_pk_fp8_f32(v1[0], v1[1], 0, false); w1 = __builtin_amdgcn_cvt_pk_fp8_f32(v1[2], v1[3], w1, true);
                    *(u32x2*)(rowp + bj * HALF) = (u32x2){(unsigned)w0, (unsigned)w1}; } }
    }
};
}

struct Ctx {
    const float *x, *c, *w_ada, *b_ada, *norm1_g, *norm2_g, *w_in, *lb_table, *hgrn_onorm_g, *conv_w, *a_log, *dt_bias, *gdn_onorm_g, *w_bh, *w_bg, *w_out, *w_router, *router_bias,
        *w_eg, *w_eu, *w_ed, *w_sg, *w_su, *w_sd, *normf_g;
    float* out;
    unsigned* bar;
    float *modp, *mod, *lb, *gab;
    int *idx, *cnt, *tok_p, *pos, *blk_row, *blk_exp, *nent;
    float *wts, *w_p;
    bf16_t *win_t, *wa_t, *wb_t, *wout_t, *h1, *proj, *ocat, *merged;
    float *gq, *gk, *gv, *gbeta, *gdec, *oa, *ob;
    float *hL, *hS, *hD;
    float *gAT, *gB, *gS; unsigned char *gBlob, *gM;
    bf16_t *dn_t, *hid, *gu_t, *h2; unsigned char* Y;
    bf16_t* rwimg; float* rbias2; int *tile_cnt, *rnk;
};

typedef const __attribute__((address_space(4))) Ctx CtxK;

__device__ __forceinline__ void cvt_tile(LAS float* t, const float* srcA, const float* srcB, int ld, int mode, bf16_t* dst, int ldd) {
    const int tid = ltid(), kr = tid >> 6, cl = tid & 63;
    const float* sp = (mode == 1 && cl >= 32) ? (srcB + cl - 32) : (srcA + cl);
    float v[8];
#pragma unroll
    for (int p = 0; p < 8; ++p) v[p] = sp[(size_t)(p * 8 + kr) * ld];
    __syncthreads();
#pragma unroll
    for (int p = 0; p < 8; ++p) t[(p * 8 + kr) * 65 + cl] = v[p];
    __syncthreads();
    const int r = tid >> 3, seg = (tid & 7) * 8;
    const int lc = mode == 1 ? (((r >> 2) & 1) * 32 + 4 * (r >> 3) + (r & 3)) : r;
    float w[8];
#pragma unroll
    for (int j = 0; j < 8; ++j) w[j] = t[(seg + j) * 65 + lc];
    u32x4 o; o.x = cvt_pk_bf16(w[0], w[1]); o.y = cvt_pk_bf16(w[2], w[3]); o.z = cvt_pk_bf16(w[4], w[5]); o.w = cvt_pk_bf16(w[6], w[7]);
    *(u32x4*)(dst + (size_t)r * ldd + seg) = o;
}
__device__ __forceinline__ void cvt_job(LAS float* t, int tile, const float* src, int ld, int K, bf16_t* dst) {
    const int nkt = K / 64, nt = tile / nkt, kt = tile % nkt;
    cvt_tile(t, src + (size_t)kt * 64 * ld + nt * 64, nullptr, ld, 0, dst + (size_t)nt * 64 * K + kt * 64, K);
}

__device__ void ph_pro1(CtxK& c, LAS unsigned char* lds) {
    const int tid = ltid(), wg = blockIdx.x, G = gridDim.x;
    LAS float* lf = (LAS float*)lds;
    for (int job = wg; job < 192; job += G) {
        const int cc = job % 48, kp = job / 48, q = tid & 63, rg = tid >> 6;
        f32x4 a = {0.f, 0.f, 0.f, 0.f};
        for (int r = rg; r < 512; r += 8) { const int k = kp * 512 + r; const float s = siluf_(c.c[k]); a += s * *(const f32x4*)(c.w_ada + (size_t)k * (6 * D) + cc * 256 + q * 4); }
        __syncthreads();
        *(LAS f32x4*)(lf + (rg * 64 + q) * 4) = a;
        __syncthreads();
        if (tid < 64) { f32x4 s = {0.f, 0.f, 0.f, 0.f};
#pragma unroll
            for (int g = 0; g < 8; ++g) s += *(LAS f32x4*)(lf + (g * 64 + tid) * 4);
            *(f32x4*)(c.modp + (size_t)kp * (6 * D) + cc * 256 + tid * 4) = s; }
    }
    if (wg == G - 1) for (int j = tid; j < 1024; j += 512) c.lb[j] = 1.f / (1.f + expf(c.lb_table[1024 + j] - c.lb_table[j]));
    for (int T = wg; T < 8192; T += G) {
        if (T < 6144) { const int nt = T / 32, kt = T % 32; const int sc = nt * 64 + (nt * 64 >= WIN_GAB ? 16 : 0);
            cvt_tile(lf, c.w_in + (size_t)kt * 64 * INW + sc, nullptr, INW, 0, c.win_t + (size_t)nt * 64 * D + kt * 64, D); }
        else if (T < 6656) cvt_job(lf, T - 6144, c.w_bh, D, 1024, c.wa_t);
        else if (T < 7168) cvt_job(lf, T - 6656, c.w_bg, D, 1024, c.wb_t);
        else cvt_job(lf, T - 7168, c.w_out, D, 2048, c.wout_t);
    }
}
__device__ void ph_norm1(CtxK& c, LAS unsigned char* lds) {
    const int tid = ltid(), wg = blockIdx.x, G = gridDim.x, lane = tid & 63, wv = tid >> 6;
    LAS float* la = (LAS float*)lds;
    LAS float* lb_ = la + D;
    LAS float* lw = lb_ + D;
    for (int j = tid; j < D; j += 512) {
        float sh = c.b_ada[j], sc = c.b_ada[D + j];
#pragma unroll
        for (int p = 0; p < 4; ++p) { sh += c.modp[(size_t)p * 6 * D + j]; sc += c.modp[(size_t)p * 6 * D + D + j]; }
        la[j] = c.norm1_g[j] * (1.f + sc); lb_[j] = sh;
    }
    for (int j = wg * 512 + tid; j < 6 * D; j += G * 512) { float m = c.b_ada[j];
#pragma unroll
        for (int p = 0; p < 4; ++p) m += c.modp[(size_t)p * 6 * D + j];
        c.mod[j] = m; }
    for (int i = tid; i < D * 4; i += 512) { const int e = i >> 2, q = i & 3; const f32x4 w = *(const f32x4*)(c.w_in + (size_t)e * INW + WIN_GAB + q * 4);
        lw[(q * 4 + 0) * D + e] = w[0]; lw[(q * 4 + 1) * D + e] = w[1]; lw[(q * 4 + 2) * D + e] = w[2]; lw[(q * 4 + 3) * D + e] = w[3]; }
    __syncthreads();
    f32x4 vn[8];
    { const float* xr = c.x + (size_t)(wg * 8 + wv) * D;
#pragma unroll
      for (int i = 0; i < 8; ++i) vn[i] = *(const f32x4*)(xr + i * 256 + lane * 4); }
    for (int row = wg * 8 + wv; row < S; row += G * 8) {
        f32x4 v[8]; float ss = 0.f;
#pragma unroll
        for (int i = 0; i < 8; ++i) { v[i] = vn[i]; ss += v[i][0] * v[i][0] + v[i][1] * v[i][1] + v[i][2] * v[i][2] + v[i][3] * v[i][3]; }
        if (row + G * 8 < S) { const float* xr = c.x + (size_t)(row + G * 8) * D;
#pragma unroll
            for (int i = 0; i < 8; ++i) vn[i] = *(const f32x4*)(xr + i * 256 + lane * 4); }
        ss = wave_sum(ss); const float r = rsqrtf(ss * (1.f / D) + 1e-6f);
#pragma unroll
        for (int i = 0; i < 8; ++i) { const int e = i * 256 + lane * 4; const f32x4 a = *(LAS f32x4*)(la + e), b = *(LAS f32x4*)(lb_ + e); v[i] = v[i] * r * a + b;
            u32x2 w; w.x = cvt_pk_bf16(v[i][0], v[i][1]); w.y = cvt_pk_bf16(v[i][2], v[i][3]); *(u32x2*)(c.h1 + (size_t)row * D + e) = w; }
        float mine = 0.f;
        for (int cc = 0; cc < 16; ++cc) { float d = 0.f;
#pragma unroll
            for (int i = 0; i < 8; ++i) { const f32x4 w = *(LAS f32x4*)(lw + cc * D + i * 256 + lane * 4); d += v[i][0] * w[0] + v[i][1] * w[1] + v[i][2] * w[2] + v[i][3] * w[3]; }
            d = wave_sum(d); if (lane == cc) mine = d; }
        if (lane < 16) c.gab[(size_t)row * 16 + lane] = mine;
    }
    { const int id = wg * 512 + tid, i = id >> 6, e = id & 63;
      if (id < D * 64) {
          float sc = c.b_ada[4 * D + i];
#pragma unroll
          for (int p = 0; p < 4; ++p) sc += c.modp[(size_t)p * 6 * D + 4 * D + i];
          const float w = c.norm2_g[i] * (1.f + sc) * c.w_router[id];
          const unsigned hi = cvt_pk_bf16(w, w) & 0xffffu; const float lo = w - __uint_as_float(hi << 16);
          const int ch = i >> 7, kk = i & 127;
          c.rwimg[((ch * 2 + 0) * 64 + e) * 136 + kk] = (bf16_t)hi; c.rwimg[((ch * 2 + 1) * 64 + e) * 136 + kk] = (bf16_t)(cvt_pk_bf16(lo, lo) & 0xffffu);
      } }
    if (wg < 64) {
        __syncthreads();
        float a = 0.f;
        for (int i = tid; i < D; i += 512) { float sh = c.b_ada[3 * D + i];
#pragma unroll
            for (int p = 0; p < 4; ++p) sh += c.modp[(size_t)p * 6 * D + 3 * D + i];
            a += sh * c.w_router[i * 64 + wg]; }
        a = wave_sum(a); if (lane == 0) la[wv] = a; __syncthreads();
        if (tid == 0) c.rbias2[wg] = la[0] + la[1] + la[2] + la[3] + la[4] + la[5] + la[6] + la[7];
    }
}
__device__ void ph_gemm1(CtxK& c, LAS unsigned char* lds) {
    gm::DenseSched Sd; Sd.init(S, PW, D, D, c.win_t, nullptr, 1); gm::EpiProj E{c.proj};
    gm::gphase(lds, (const char*)c.h1, D, Sd, E);
}
__device__ void ph_gemm2(CtxK& c, LAS unsigned char* lds) {
    gm::DenseSched Sd; Sd.init(S, D, 1024, 2048, c.wa_t, c.wb_t, 2); gm::EpiMerge E{c.proj, c.merged};
    gm::gphase(lds, (const char*)c.ocat, 1024, Sd, E);
}
__device__ void ph_gemm3(CtxK& c, LAS unsigned char* lds) {
    gm::DenseSched Sd; Sd.init(S, D, D, D, c.wout_t, nullptr, 1); gm::EpiResid E{c.x, c.mod + 2 * D, c.out};
    gm::gphase(lds, (const char*)c.merged, D, Sd, E);
}
__device__ void ph_moe_gu(CtxK& c, LAS unsigned char* lds) {
    gm::MoeSched<true> Sm; Sm.init(lds + gm::STAGE_BYTES, 4, D, D, c.nent, c.blk_row, c.blk_exp, c.tok_p, c.gu_t, (size_t)1024 * D * 2); gm::EpiSwiglu E{c.hid};
    gm::gphase(lds, (const char*)c.h2, D, Sm, E);
}
__device__ void ph_moe_dn(CtxK& c, LAS unsigned char* lds) {
    gm::MoeSched<false> Sm; Sm.init(lds + gm::STAGE_BYTES, 8, FF, FF, c.nent, c.blk_row, c.blk_exp, c.tok_p, c.dn_t, (size_t)D * FF * 2); gm::EpiDown E{c.Y, c.w_p};
    gm::gphase(lds, (const char*)c.hid, FF, Sm, E);
}
__device__ void ph_cvt_exp(CtxK& c, LAS unsigned char* lds) {
    LAS float* lf = (LAS float*)lds; const int wg = blockIdx.x - 8, G = gridDim.x - 8;
    if (wg < 0) return;
    constexpr int GU_T = 16 * 32, DN_T = 32 * 8;
    for (int T = wg; T < NEX * (GU_T + DN_T); T += G) {
        if (T < NEX * GU_T) { const int e = T / GU_T, r = T % GU_T, nt = r / 32, kt = r % 32;
            const float* sg = e < NE ? c.w_eg + (size_t)e * D * FF : c.w_sg; const float* su = e < NE ? c.w_eu + (size_t)e * D * FF : c.w_su;
            cvt_tile(lf, sg + (size_t)kt * 64 * FF + nt * 32, su + (size_t)kt * 64 * FF + nt * 32, FF, 1, c.gu_t + ((size_t)e * 1024 + nt * 64) * D + kt * 64, D); }
        else { const int T2 = T - NEX * GU_T, e = T2 / DN_T, r = T2 % DN_T; const float* sd = e < NE ? c.w_ed + (size_t)e * FF * D : c.w_sd;
            cvt_job(lf, r, sd, D, FF, c.dn_t + (size_t)e * D * FF); }
    }
}
__device__ void ph_final(CtxK& c, LAS unsigned char* lds) {
    const int tid = ltid(), wg = blockIdx.x, G = gridDim.x, lane = tid & 63, wv = tid >> 6;
    const float* gt2 = c.mod + 5 * D;
    for (int row0 = (wg * 8 + wv) * 2; row0 < S; row0 += G * 16) {
        int p[2][9];
#pragma unroll
        for (int rr = 0; rr < 2; ++rr) {
#pragma unroll
            for (int k = 0; k < 8; ++k) p[rr][k] = c.pos[(row0 + rr) * TOPK + k];
            p[rr][8] = PROUTED + row0 + rr; }
        f32x4 v[2][4][2]; float ss[2] = {0.f, 0.f};
#pragma unroll
        for (int rr = 0; rr < 2; ++rr) {
#pragma unroll
            for (int i = 0; i < 4; ++i) {
                const int e = i * 512 + lane * 8; f32x4 a0 = {0.f, 0.f, 0.f, 0.f}, a1 = {0.f, 0.f, 0.f, 0.f};
#pragma unroll
                for (int k = 0; k < 9; ++k) { const u32x2 y = *(const u32x2*)(c.Y + (size_t)p[rr][k] * D + e);
                    const auto q0 = __builtin_amdgcn_cvt_pk_f32_fp8((int)y.x, false), q1 = __builtin_amdgcn_cvt_pk_f32_fp8((int)y.x, true), q2 = __builtin_amdgcn_cvt_pk_f32_fp8((int)y.y, false), q3 = __builtin_amdgcn_cvt_pk_f32_fp8((int)y.y, true);
                    a0[0] += q0[0]; a0[1] += q0[1]; a0[2] += q1[0]; a0[3] += q1[1]; a1[0] += q2[0]; a1[1] += q2[1]; a1[2] += q3[0]; a1[3] += q3[1]; }
                const float* xp = c.out + (size_t)(row0 + rr) * D + e;
                const f32x4 x0 = *(const f32x4*)xp, x1 = *(const f32x4*)(xp + 4), g0 = *(const f32x4*)(gt2 + e) * 0.0625f, g1 = *(const f32x4*)(gt2 + e + 4) * 0.0625f;
                v[rr][i][0] = x0 + g0 * a0; v[rr][i][1] = x1 + g1 * a1;
#pragma unroll
                for (int j = 0; j < 4; ++j) ss[rr] += v[rr][i][0][j] * v[rr][i][0][j] + v[rr][i][1][j] * v[rr][i][1][j];
            } }
#pragma unroll
        for (int rr = 0; rr < 2; ++rr) {
            const float r = rsqrtf(wave_sum(ss[rr]) * (1.f / D) + 1e-6f);
#pragma unroll
            for (int i = 0; i < 4; ++i) { const int e = i * 512 + lane * 8; float* op = c.out + (size_t)(row0 + rr) * D + e;
                *(f32x4*)op = v[rr][i][0] * r * *(const f32x4*)(c.normf_g + e); *(f32x4*)(op + 4) = v[rr][i][1] * r * *(const f32x4*)(c.normf_g + e + 4); } }
    }
}

namespace mx {
constexpr int ST128 = 272, ST64 = 144;
constexpr int FRAG_F4 = 8 * 8 * 64;
__device__ __forceinline__ f32x4 mfma16(bf16x8 a, bf16x8 b, f32x4 c) { return __builtin_amdgcn_mfma_f32_16x16x32_bf16(a, b, c, 0, 0, 0); }
template <int MT, int KS>
__device__ __forceinline__ void mma_nt(f32x4 (&acc)[MT], LAS const unsigned char* xs, int sx, LAS const unsigned char* ys, int sy, int fr, int fq) {
#pragma unroll
    for (int kk = 0; kk < KS; ++kk) {
        const bf16x8 b = *(const LAS bf16x8*)(ys + fr * sy + (kk * 32 + fq * 8) * 2);
#pragma unroll
        for (int m = 0; m < MT; ++m) { const bf16x8 a = *(const LAS bf16x8*)(xs + (16 * m + fr) * sx + (kk * 32 + fq * 8) * 2); acc[m] = mfma16(a, b, acc[m]); }
    }
}
__device__ __forceinline__ void lds_fence() { asm volatile("s_waitcnt lgkmcnt(0)" ::: "memory"); }
__device__ __forceinline__ u32x4 pack8(const float (&v)[8]) { u32x4 o; o.x = cvt_pk_bf16(v[0], v[1]); o.y = cvt_pk_bf16(v[2], v[3]); o.z = cvt_pk_bf16(v[4], v[5]); o.w = cvt_pk_bf16(v[6], v[7]); return o; }
__device__ __forceinline__ void unpack8(const u32x4 w, float (&v)[8]) { v[0] = bflo(w.x); v[1] = bfhi(w.x); v[2] = bflo(w.y); v[3] = bfhi(w.y); v[4] = bflo(w.z); v[5] = bfhi(w.z); v[6] = bflo(w.w); v[7] = bfhi(w.w); }
__device__ __forceinline__ void mfma_pad8(f32x4 (&a)[8]) { asm volatile("s_nop 15\n\ts_nop 7" : "+v"(a[0]), "+v"(a[1]), "+v"(a[2]), "+v"(a[3]), "+v"(a[4]), "+v"(a[5]), "+v"(a[6]), "+v"(a[7])); }
__device__ __forceinline__ void mfma_pad4(f32x4 (&a)[4]) { asm volatile("s_nop 15\n\ts_nop 7" : "+v"(a[0]), "+v"(a[1]), "+v"(a[2]), "+v"(a[3])); }
__device__ __forceinline__ void write_st(LAS unsigned char* stw, f32x4 (&S)[8], int fr, int fq) {
    mfma_pad8(S);
#pragma unroll
    for (int m = 0; m < 8; ++m) { u32x2 w; w.x = cvt_pk_bf16(S[m][0], S[m][1]); w.y = cvt_pk_bf16(S[m][2], S[m][3]); *(LAS u32x2*)(stw + fr * ST128 + (16 * m + 4 * fq) * 2) = w; }
}

__device__ __forceinline__ void gate_issue(u32x4 (&gp)[2], const bf16_t* gate0) {
    const int t_ = ltid(); const bf16_t* p = gate0 + (size_t)(t_ >> 3) * PW + (t_ & 7) * 16;
    gp[0] = *(const u32x4*)p; gp[1] = *(const u32x4*)(p + 8);
}
__device__ __forceinline__ void out_stage(LAS unsigned char* ot, LAS float* part, const f32x4 (&o)[4], const u32x4 (&gp)[2], const float* gnorm, bf16_t* out0, int wv, int lane, int fr, int fq) {
    float s_ = 0.f;
#pragma unroll
    for (int w = 0; w < 8; ++w) s_ += part[w * 64 + lane];
    const float rv = rsqrtf(s_ * (1.f / 128.f) + 1e-6f);
    const float gn = gnorm[wv * 16 + fr];
#pragma unroll
    for (int m = 0; m < 4; ++m)
#pragma unroll
        for (int r = 0; r < 4; ++r) { const int cc = 16 * m + 4 * fq + r; const float x = o[m][r] * __shfl(rv, cc) * gn;
            *(LAS bf16_t*)(ot + cc * ST128 + (wv * 16 + fr) * 2) = (bf16_t)(cvt_pk_bf16(x, x) & 0xffffu); }
    __syncthreads();
    const int t_ = ltid(), cc = t_ >> 3, sg = (t_ & 7) * 16;
#pragma unroll
    for (int hh = 0; hh < 2; ++hh) { float ov[8], gv[8];
        unpack8(*(LAS u32x4*)(ot + cc * ST128 + (sg + hh * 8) * 2), ov); unpack8(gp[hh], gv);
#pragma unroll
        for (int j = 0; j < 8; ++j) ov[j] *= siluf_(gv[j]);
        *(u32x4*)(out0 + (size_t)cc * D + sg + hh * 8) = pack8(ov); }
}

constexpr int H_QT = 0, H_KT = 17408, H_QI = 34816, H_KU = 52224, H_VT = 70656, H_P = 89088, H_DEC = 98304, H_OCT = 98816, H_F4 = 102912, H_PART = 103424, H_RINV = 105472, H_ST = 105728, H_LB = H_ST + 8 * 16 * ST128, H_END = H_LB + 512;
static_assert(H_END <= 147456, "hgrn lds");
template <bool OUT>
__device__ void hgrn_pass(CtxK& c, LAS unsigned char* lds) {
    const int tid = ltid(), wv = __builtin_amdgcn_readfirstlane(tid >> 6), lane = tid & 63, fr = lane & 15, fq = lane >> 4;
    LAS float* dec = (LAS float*)(lds + H_DEC); LAS float* oct = (LAS float*)(lds + H_OCT); LAS float* f4 = (LAS float*)(lds + H_F4);
    LAS float* part = (LAS float*)(lds + H_PART); LAS float* rinv = (LAS float*)(lds + H_RINV);
    LAS unsigned char* stw = lds + H_ST + wv * 16 * ST128;
    {
        const int wu = blockIdx.x, h = wu & 7, g = wu >> 3;
        f32x4 Sacc[8];
#pragma unroll
        for (int m = 0; m < 8; ++m) Sacc[m] = (f32x4){0.f, 0.f, 0.f, 0.f};
        if (OUT) {
            if (g > 0) { const f32x4* sp = (const f32x4*)c.hS + (size_t)(h * 32 + g) * FRAG_F4 + (wv * 8) * 64 + lane;
#pragma unroll
                for (int m = 0; m < 8; ++m) Sacc[m] = sp[m * 64]; }
            write_st(stw, Sacc, fr, fq);
        }
        LAS float* lbs = (LAS float*)(lds + H_LB);
        if (tid < 128) lbs[tid] = c.lb[h * 128 + tid];
        __syncthreads();
        float dsum = 0.f;
        u32x4 pf[8];
#define HP_ISSUE(i_) do { const int tq_ = ltid(), gq_ = tq_ >> 7; if (gq_ < 3 && (OUT || gq_ > 0)) { const bf16_t* b_ = c.proj + (size_t)((g * 8 + (i_)) * 64 + ((tq_ >> 4) & 7) * 8) * PW + h * 128 + (tq_ & 15) * 8 + (gq_ == 1 ? C_HI : C_HF); \
        _Pragma("unroll") for (int tt = 0; tt < 8; ++tt) pf[tt] = *(const u32x4*)(b_ + (size_t)tt * PW); } } while (0)
        HP_ISSUE(0);
        for (int i = 0; i < 8; ++i) {
            const int T0 = (g * 8 + i) * 64;
            const int tp = ltid(), grp = tp >> 7, to = (tp >> 4) & 7, co = tp & 15, c0 = to * 8, d0 = co * 8;
            const bool cum = grp == 2 || (OUT && grp == 0);
            float cs[8][8];
            if (cum) {
                float lbv[8];
                { const f32x4 l0 = *(LAS f32x4*)(lbs + d0), l1 = *(LAS f32x4*)(lbs + d0 + 4);
                  lbv[0] = l0[0]; lbv[1] = l0[1]; lbv[2] = l0[2]; lbv[3] = l0[3]; lbv[4] = l1[0]; lbv[5] = l1[1]; lbv[6] = l1[2]; lbv[7] = l1[3]; }
#pragma unroll
                for (int tt = 0; tt < 8; ++tt) {
                    float fv[8]; unpack8(pf[tt], fv);
#pragma unroll
                    for (int j = 0; j < 8; ++j) { const float lf = __logf(lbv[j] + (1.f - lbv[j]) * sigmoidf_(fv[j])); cs[tt][j] = tt ? cs[tt - 1][j] + lf : lf; }
                }
                if (grp == 2) {
#pragma unroll
                    for (int j = 0; j < 8; ++j) { oct[to * 128 + d0 + j] = cs[7][j]; if (to == 4) f4[d0 + j] = cs[0][j]; }
                }
            }
            __syncthreads();
            if (cum) {
                float pre[8], tot[8], bmid[8];
#pragma unroll
                for (int j = 0; j < 8; ++j) { float p = 0.f, t_ = 0.f, bm = 0.f;
#pragma unroll
                    for (int o = 0; o < 8; ++o) { const float x = oct[o * 128 + d0 + j]; p += o < to ? x : 0.f; bm += o < 4 ? x : 0.f; t_ += x; }
                    pre[j] = p; tot[j] = t_; bmid[j] = bm + f4[d0 + j]; }
                if (grp == 0) {
                    float ebm[8];
#pragma unroll
                    for (int j = 0; j < 8; ++j) ebm[j] = __expf(bmid[j]);
#pragma unroll
                    for (int tt = 0; tt < 8; ++tt) {
                        float qv[8], q1[8], q2[8];
                        unpack8(*(const u32x4*)(c.proj + (size_t)(T0 + c0 + tt) * PW + C_HQ + h * 128 + d0), qv);
#pragma unroll
                        for (int j = 0; j < 8; ++j) { const float q = siluf_(qv[j]) * 0.08838834764831845f; q1[j] = q * __expf(pre[j] + cs[tt][j] - bmid[j]); q2[j] = q1[j] * ebm[j]; }
                        *(LAS u32x4*)(lds + H_QT + (c0 + tt) * ST128 + d0 * 2) = pack8(q1); *(LAS u32x4*)(lds + H_QI + (c0 + tt) * ST128 + d0 * 2) = pack8(q2);
                    }
                } else {
                    if (to == 0) {
#pragma unroll
                        for (int j = 0; j < 8; ++j) dec[d0 + j] = __expf(tot[j]);
                    }
                    if (OUT) {
#pragma unroll
                        for (int tt = 0; tt < 8; ++tt) {
                            float k1[8];
#pragma unroll
                            for (int j = 0; j < 8; ++j) { const float lf = tt ? cs[tt][j] - cs[tt - 1][j] : cs[0][j]; k1[j] = (1.f - __expf(lf)) * __expf(bmid[j] - pre[j] - cs[tt][j]); }
                            *(LAS u32x4*)(lds + H_KT + (c0 + tt) * ST128 + d0 * 2) = pack8(k1);
                        }
                    }
#pragma unroll
                    for (int j = 0; j < 8; ++j) { float col[8];
#pragma unroll
                        for (int tt = 0; tt < 8; ++tt) { const float lf = tt ? cs[tt][j] - cs[tt - 1][j] : cs[0][j]; col[tt] = (1.f - __expf(lf)) * __expf(tot[j] - pre[j] - cs[tt][j]); }
                        *(LAS u32x4*)(lds + H_KU + (d0 + j) * ST64 + c0 * 2) = pack8(col); }
                }
            } else if (grp == 1) {
                float vb[8][8];
#pragma unroll
                for (int tt = 0; tt < 8; ++tt) unpack8(pf[tt], vb[tt]);
#pragma unroll
                for (int j = 0; j < 8; ++j) { float col[8];
#pragma unroll
                    for (int tt = 0; tt < 8; ++tt) col[tt] = vb[tt][j];
                    *(LAS u32x4*)(lds + H_VT + (d0 + j) * ST64 + c0 * 2) = pack8(col); }
            }
            __syncthreads();
            if (i + 1 < 8) HP_ISSUE(i + 1);
            u32x4 gpre[2];
            if (OUT) gate_issue(gpre, c.proj + (size_t)T0 * PW + C_HG + h * 128);
            if (!OUT && tid < 128) dsum += __logf(dec[tid]);
            f32x4 oacc[4];
            if (OUT) {
                { f32x4 sc[2] = {(f32x4){0.f, 0.f, 0.f, 0.f}, (f32x4){0.f, 0.f, 0.f, 0.f}};
                  const int nt = wv & 3, mb = (wv >> 2) * 2;
                  mma_nt<2, 4>(sc, lds + H_KT + mb * 16 * ST128, ST128, lds + H_QT + nt * 16 * ST128, ST128, fr, fq);
#pragma unroll
                  for (int m = 0; m < 2; ++m) { const int cc = nt * 16 + fr, s0 = (mb + m) * 16 + 4 * fq; u32x2 w;
                      w.x = cvt_pk_bf16(s0 + 0 <= cc ? sc[m][0] : 0.f, s0 + 1 <= cc ? sc[m][1] : 0.f); w.y = cvt_pk_bf16(s0 + 2 <= cc ? sc[m][2] : 0.f, s0 + 3 <= cc ? sc[m][3] : 0.f);
                      *(LAS u32x2*)(lds + H_P + cc * ST64 + s0 * 2) = w; } }
                __syncthreads();
#pragma unroll
                for (int m = 0; m < 4; ++m) oacc[m] = (f32x4){0.f, 0.f, 0.f, 0.f};
                mma_nt<4, 2>(oacc, lds + H_P, ST64, lds + H_VT + wv * 16 * ST64, ST64, fr, fq);
                mma_nt<4, 4>(oacc, lds + H_QI, ST128, stw, ST128, fr, fq);
#pragma unroll
                for (int m = 0; m < 4; ++m)
#pragma unroll
                    for (int r = 0; r < 4; ++r) { float q = oacc[m][r] * oacc[m][r]; q += __shfl_xor(q, 1); q += __shfl_xor(q, 2); q += __shfl_xor(q, 4); q += __shfl_xor(q, 8); if (fr == 0) part[wv * 64 + 16 * m + 4 * fq + r] = q; }
            }
#pragma unroll
            for (int m = 0; m < 8; ++m) { const f32x4 dv = *(LAS f32x4*)(dec + 16 * m + 4 * fq); Sacc[m] = Sacc[m] * dv; }
            mma_nt<8, 2>(Sacc, lds + H_KU, ST64, lds + H_VT + wv * 16 * ST64, ST64, fr, fq);
            if (OUT) {
                lds_fence();
                write_st(stw, Sacc, fr, fq);
                __syncthreads();
                out_stage(lds + H_QT, part, oacc, gpre, c.hgrn_onorm_g, c.ocat + (size_t)T0 * D + h * 128, wv, lane, fr, fq);
            }
            __syncthreads();
        }
#undef HP_ISSUE
        if (!OUT) {
            f32x4* sp = (f32x4*)c.hL + (size_t)(h * 32 + g) * FRAG_F4 + (wv * 8) * 64 + lane;
#pragma unroll
            for (int m = 0; m < 8; ++m) sp[m * 64] = Sacc[m];
            if (tid < 128) c.hD[(h * 32 + g) * 128 + tid] = __expf(dsum);
        }
    }
}
__device__ void hgrn_scan(CtxK& c) {
    const int e = blockIdx.x * 512 + ltid();
    if (e >= 8 * FRAG_F4) return;
    const int h = e / FRAG_F4, fi = e % FRAG_F4, m = (fi >> 6) & 7, lane = fi & 63, d0 = 16 * m + 4 * (lane >> 4);
    f32x4 s = {0.f, 0.f, 0.f, 0.f};
    for (int g = 0; g < 31; ++g) {
        const f32x4 dc = *(const f32x4*)(c.hD + (h * 32 + g) * 128 + d0);
        s = s * dc + ((const f32x4*)c.hL)[(size_t)(h * 32 + g) * FRAG_F4 + fi];
        ((f32x4*)c.hS)[(size_t)(h * 32 + g + 1) * FRAG_F4 + fi] = s;
    }
}

constexpr int B_T = 0, B_KBG = 9216, B_KU = 26624, B_VB = 45056, B_QD = 63488, B_AT = 80896, B_SC = 90112, BLOB = 90368;
constexpr int G_ST = BLOB, G_RV = G_ST + 8 * 16 * ST128, G_PART = G_RV + 8 * 16 * ST64, G_RINV = G_PART + 2048, G_END = G_RINV + 256;
static_assert(G_END <= 147456, "gdn lds");
constexpr int P_K = 0, P_Q = 17408, P_BETA = 34816, P_GC = P_BETA + 256, P_EG = P_GC + 256, P_EK = P_EG + 256;

__device__ void gdn_prep(CtxK& c, LAS unsigned char* lds, int h, int g) {
    const int tid = ltid(), wv = __builtin_amdgcn_readfirstlane(tid >> 6), lane = tid & 63, fr = lane & 15, fq = lane >> 4;
    LAS float* sbeta = (LAS float*)(lds + P_BETA); LAS float* sgc = (LAS float*)(lds + P_GC); LAS float* seg = (LAS float*)(lds + P_EG); LAS float* sek = (LAS float*)(lds + P_EK);
    for (int i = 0; i < 8; ++i) {
        const int n = g * 8 + i, T0 = n * 64;
        unsigned char* blob = (unsigned char*)c.gBlob + (size_t)(h * 256 + n) * BLOB;
        if (wv == 0) {
            const float ga = c.gab[(size_t)(T0 + lane) * 16 + h], gb = c.gab[(size_t)(T0 + lane) * 16 + 8 + h];
            const float gl_ = -__expf(c.a_log[h]) * softplusf_(ga + c.dt_bias[h]);
            float gc = gl_;
#pragma unroll
            for (int o = 1; o < 64; o <<= 1) { const float t_ = __shfl_up(gc, o); if (lane >= o) gc += t_; }
            const float glast = __shfl(gc, 63);
            sbeta[lane] = sigmoidf_(gb); sgc[lane] = gc; seg[lane] = __expf(gc); sek[lane] = __expf(glast - gc);
            if (lane == 0) *(float*)(blob + B_SC) = __expf(glast);
        }
        __syncthreads();
        const int tp = ltid(), part = tp >> 7, to = (tp >> 4) & 7, co = tp & 15, c0 = to * 8, d0 = co * 8;
        if (tp < 384) {
            const int chb = part * 1024 + h * 128 + d0;
            float val[8][8];
            {
                float wj[4][8];
#pragma unroll
                for (int j = 0; j < 4; ++j) { const f32x4 a = *(const f32x4*)(c.conv_w + j * 3072 + chb), b = *(const f32x4*)(c.conv_w + j * 3072 + chb + 4);
                    wj[j][0] = a[0]; wj[j][1] = a[1]; wj[j][2] = a[2]; wj[j][3] = a[3]; wj[j][4] = b[0]; wj[j][5] = b[1]; wj[j][6] = b[2]; wj[j][7] = b[3]; }
                u32x4 raw[11];
#pragma unroll
                for (int r = 0; r < 11; ++r) { const int tok = T0 + c0 - 3 + r; raw[r] = tok >= 0 ? *(const u32x4*)(c.proj + (size_t)tok * PW + C_GQKV + chb) : (u32x4){0u, 0u, 0u, 0u}; }
#pragma unroll
                for (int tt = 0; tt < 8; ++tt) {
                    float a[8] = {0.f, 0.f, 0.f, 0.f, 0.f, 0.f, 0.f, 0.f};
#pragma unroll
                    for (int j = 0; j < 4; ++j) { float xv[8]; unpack8(raw[tt + j], xv);
#pragma unroll
                        for (int jj = 0; jj < 8; ++jj) a[jj] += wj[j][jj] * xv[jj]; }
#pragma unroll
                    for (int jj = 0; jj < 8; ++jj) val[tt][jj] = siluf_(a[jj]);
                }
            }
            if (part < 2) {
#pragma unroll
                for (int tt = 0; tt < 8; ++tt) { float ss = 0.f;
#pragma unroll
                    for (int jj = 0; jj < 8; ++jj) ss += val[tt][jj] * val[tt][jj];
                    ss += __shfl_xor(ss, 1); ss += __shfl_xor(ss, 2); ss += __shfl_xor(ss, 4); ss += __shfl_xor(ss, 8);
                    const float rn = rsqrtf(ss + 1e-6f) * (part == 0 ? 0.08838834764831845f : 1.f);
#pragma unroll
                    for (int jj = 0; jj < 8; ++jj) val[tt][jj] *= rn; }
            }
            if (part == 0) {
#pragma unroll
                for (int tt = 0; tt < 8; ++tt) { const int cc = c0 + tt; *(LAS u32x4*)(lds + P_Q + cc * ST128 + d0 * 2) = pack8(val[tt]);
                    const float e = seg[cc]; float qd[8];
#pragma unroll
                    for (int jj = 0; jj < 8; ++jj) qd[jj] = val[tt][jj] * e;
                    *(u32x4*)(blob + B_QD + cc * ST128 + d0 * 2) = pack8(qd); }
            } else if (part == 1) {
#pragma unroll
                for (int tt = 0; tt < 8; ++tt) { const int cc = c0 + tt; *(LAS u32x4*)(lds + P_K + cc * ST128 + d0 * 2) = pack8(val[tt]);
                    const float e = seg[cc] * sbeta[cc]; float kb[8];
#pragma unroll
                    for (int jj = 0; jj < 8; ++jj) kb[jj] = val[tt][jj] * e;
                    *(u32x4*)(blob + B_KBG + cc * ST128 + d0 * 2) = pack8(kb); }
#pragma unroll
                for (int jj = 0; jj < 8; ++jj) { float col[8];
#pragma unroll
                    for (int tt = 0; tt < 8; ++tt) col[tt] = val[tt][jj] * sek[c0 + tt];
                    *(u32x4*)(blob + B_KU + (d0 + jj) * ST64 + c0 * 2) = pack8(col); }
            } else {
#pragma unroll
                for (int jj = 0; jj < 8; ++jj) { float col[8];
#pragma unroll
                    for (int tt = 0; tt < 8; ++tt) col[tt] = val[tt][jj] * sbeta[c0 + tt];
                    *(u32x4*)(blob + B_VB + (d0 + jj) * ST64 + c0 * 2) = pack8(col); }
            }
        }
        __syncthreads();
        {
            const int nt = wv & 3, mb = (wv >> 2) * 2, jj = nt * 16 + fr;
            f32x4 kk2[2] = {(f32x4){0.f, 0.f, 0.f, 0.f}, (f32x4){0.f, 0.f, 0.f, 0.f}}, at2[2] = {(f32x4){0.f, 0.f, 0.f, 0.f}, (f32x4){0.f, 0.f, 0.f, 0.f}};
            mma_nt<2, 4>(kk2, lds + P_K + mb * 16 * ST128, ST128, lds + P_K + nt * 16 * ST128, ST128, fr, fq);
            mma_nt<2, 4>(at2, lds + P_K + mb * 16 * ST128, ST128, lds + P_Q + nt * 16 * ST128, ST128, fr, fq);
            float* at = c.gAT + (size_t)(h * 256 + n) * 4096;
            const float gj = sgc[jj];
#pragma unroll
            for (int m = 0; m < 2; ++m) { const int i0 = (mb + m) * 16 + 4 * fq; f32x4 av; float pv[4];
#pragma unroll
                for (int r = 0; r < 4; ++r) { const int ii = i0 + r; const float gi = sgc[ii];
                    av[r] = jj < ii ? sbeta[ii] * kk2[m][r] * __expf(gi - gj) : 0.f;
                    pv[r] = ii <= jj ? at2[m][r] * __expf(gj - gi) : 0.f; }
                *(f32x4*)(at + jj * 64 + i0) = av;
                u32x2 w; w.x = cvt_pk_bf16(pv[0], pv[1]); w.y = cvt_pk_bf16(pv[2], pv[3]);
                *(u32x2*)(blob + B_AT + jj * ST64 + i0 * 2) = w; }
        }
        __syncthreads();
    }
}
__device__ void gdn_invert(CtxK& c, LAS unsigned char* lds, int h, int g) {
    const int tid = ltid(), wv = __builtin_amdgcn_readfirstlane(tid >> 6), lane = tid & 63;
    const int n = g * 8 + wv;
    LAS float* at = (LAS float*)(lds + wv * 16384);
    const float* src = c.gAT + (size_t)(h * 256 + n) * 4096;
#pragma unroll
    for (int k = 0; k < 16; ++k) *(LAS f32x4*)(at + (k * 64 + lane) * 4) = *(const f32x4*)(src + (k * 64 + lane) * 4);
    lds_fence();
    float r[64];
    unsigned ata = (unsigned)(size_t)at;
#pragma unroll
    for (int j = 63; j >= 0; --j) {
        float acc = lane == j ? 1.f : 0.f;
        LAS const float* arow = (LAS const float*)(size_t)ata + j * 64;
#pragma unroll
        for (int m4 = ((j + 1) & ~3); m4 < 64; m4 += 4) {
            const f32x4 a = *(LAS const f32x4*)(arow + m4);
#pragma unroll
            for (int q = 0; q < 4; ++q) if (m4 + q > j) acc = __builtin_fmaf(-r[m4 + q], a[q], acc);
        }
        r[j] = acc;
        asm volatile("" : "+v"(ata) : "v"(acc));
    }
    unsigned char* blob = (unsigned char*)c.gBlob + (size_t)(h * 256 + n) * BLOB;
#pragma unroll
    for (int k = 0; k < 8; ++k) { float v8[8];
#pragma unroll
        for (int q = 0; q < 8; ++q) v8[q] = r[k * 8 + q];
        *(u32x4*)(blob + B_T + lane * ST64 + k * 16) = pack8(v8); }
}
template <int MODE>
__device__ void gdn_pass(CtxK& c, LAS unsigned char* lds, int h, int g) {
    const int tid = ltid(), wv = __builtin_amdgcn_readfirstlane(tid >> 6), lane = tid & 63, fr = lane & 15, fq = lane >> 4;
    LAS unsigned char* stw = lds + G_ST + wv * 16 * ST128; LAS unsigned char* rvw = lds + G_RV + wv * 16 * ST64;
    LAS float* part = (LAS float*)(lds + G_PART); LAS float* rinv = (LAS float*)(lds + G_RINV);
    f32x4 Sacc[8];
#pragma unroll
    for (int m = 0; m < 8; ++m) {
        if (MODE == 1) { const int v = 16 * wv + fr, d0 = 16 * m + 4 * fq; Sacc[m] = (f32x4){d0 == v ? 1.f : 0.f, d0 + 1 == v ? 1.f : 0.f, d0 + 2 == v ? 1.f : 0.f, d0 + 3 == v ? 1.f : 0.f}; }
        else Sacc[m] = (f32x4){0.f, 0.f, 0.f, 0.f};
    }
    if (MODE == 2 && g > 0) { const f32x4* sp = (const f32x4*)c.gS + (size_t)(h * 32 + g) * FRAG_F4 + (wv * 8) * 64 + lane;
#pragma unroll
        for (int m = 0; m < 8; ++m) Sacc[m] = sp[m * 64]; }
    write_st(stw, Sacc, fr, fq);
    constexpr int LIM = MODE == 2 ? B_SC : B_QD, NQ = (LIM + 8191) / 8192;
    u32x4 pre[NQ];
    const unsigned char* blob0 = (const unsigned char*)c.gBlob + (size_t)(h * 256 + g * 8) * BLOB;
#define GP_ISSUE(i_) do { const unsigned char* bp_ = blob0 + (size_t)(i_) * BLOB + ltid() * 16; _Pragma("unroll") for (int q = 0; q < NQ; ++q) if (q * 8192 + 8176 < LIM || ltid() * 16 + q * 8192 < LIM) pre[q] = *(const u32x4*)(bp_ + q * 8192); } while (0)
    GP_ISSUE(0);
    for (int i = 0; i < 8; ++i) {
        const int n = g * 8 + i, T0 = n * 64;
        { const int tl = ltid() * 16;
#pragma unroll
          for (int q = 0; q < NQ; ++q) if (q * 8192 + 8176 < LIM || tl + q * 8192 < LIM) *(LAS u32x4*)(lds + tl + q * 8192) = pre[q]; }
        const float dlast = *(const float*)(blob0 + (size_t)i * BLOB + B_SC);
        u32x4 gpre[2];
        if (MODE == 2) gate_issue(gpre, c.proj + (size_t)T0 * PW + C_GG + h * 128);
        __syncthreads();
        if (i + 1 < 8) GP_ISSUE(i + 1);
        { f32x4 R[4];
#pragma unroll
          for (int m = 0; m < 4; ++m) R[m] = (f32x4){0.f, 0.f, 0.f, 0.f};
          mma_nt<4, 4>(R, lds + B_KBG, ST128, stw, ST128, fr, fq);
#pragma unroll
          for (int m = 0; m < 4; ++m) { float x0 = 0.f, x1 = 0.f, x2 = 0.f, x3 = 0.f;
              if (MODE != 1) { const u32x2 vb = *(LAS u32x2*)(lds + B_VB + (16 * wv + fr) * ST64 + (16 * m + 4 * fq) * 2); x0 = bflo(vb.x); x1 = bfhi(vb.x); x2 = bflo(vb.y); x3 = bfhi(vb.y); }
              u32x2 w; w.x = cvt_pk_bf16(x0 - R[m][0], x1 - R[m][1]); w.y = cvt_pk_bf16(x2 - R[m][2], x3 - R[m][3]);
              *(LAS u32x2*)(rvw + fr * ST64 + (16 * m + 4 * fq) * 2) = w; } }
        lds_fence();
        { f32x4 VN[4];
#pragma unroll
          for (int m = 0; m < 4; ++m) VN[m] = (f32x4){0.f, 0.f, 0.f, 0.f};
          mma_nt<4, 2>(VN, lds + B_T, ST64, rvw, ST64, fr, fq);
          mfma_pad4(VN); lds_fence();
#pragma unroll
          for (int m = 0; m < 4; ++m) { u32x2 w; w.x = cvt_pk_bf16(VN[m][0], VN[m][1]); w.y = cvt_pk_bf16(VN[m][2], VN[m][3]); *(LAS u32x2*)(rvw + fr * ST64 + (16 * m + 4 * fq) * 2) = w; } }
        lds_fence();
        f32x4 O[4];
        if (MODE == 2) {
#pragma unroll
            for (int m = 0; m < 4; ++m) O[m] = (f32x4){0.f, 0.f, 0.f, 0.f};
            mma_nt<4, 4>(O, lds + B_QD, ST128, stw, ST128, fr, fq);
            mma_nt<4, 2>(O, lds + B_AT, ST64, rvw, ST64, fr, fq);
#pragma unroll
            for (int m = 0; m < 4; ++m)
#pragma unroll
                for (int r = 0; r < 4; ++r) { float q = O[m][r] * O[m][r]; q += __shfl_xor(q, 1); q += __shfl_xor(q, 2); q += __shfl_xor(q, 4); q += __shfl_xor(q, 8); if (fr == 0) part[wv * 64 + 16 * m + 4 * fq + r] = q; }
        }
#pragma unroll
        for (int m = 0; m < 8; ++m) Sacc[m] = Sacc[m] * dlast;
        mma_nt<8, 2>(Sacc, lds + B_KU, ST64, rvw, ST64, fr, fq);
        lds_fence();
        write_st(stw, Sacc, fr, fq);
        if (MODE == 2) {
            __syncthreads();
            out_stage(lds + B_KBG, part, O, gpre, c.gdn_onorm_g, c.ocat + (size_t)T0 * D + 1024 + h * 128, wv, lane, fr, fq);
        }
        __syncthreads();
    }
#undef GP_ISSUE
    if (MODE == 0) {
        f32x4* sp = (f32x4*)c.gB + (size_t)(h * 32 + g) * FRAG_F4 + (wv * 8) * 64 + lane;
#pragma unroll
        for (int m = 0; m < 8; ++m) sp[m * 64] = Sacc[m];
    }
    if (MODE == 1) {
        mfma_pad8(Sacc);
        LAS bf16_t* img = (LAS bf16_t*)lds;
#pragma unroll
        for (int m = 0; m < 8; ++m)
#pragma unroll
            for (int r = 0; r < 4; ++r) img[(16 * m + 4 * fq + r) * (ST128 / 2) + 16 * wv + fr] = (bf16_t)(cvt_pk_bf16(Sacc[m][r], Sacc[m][r]) & 0xffffu);
        __syncthreads();
        unsigned char* dst = (unsigned char*)c.gM + (size_t)(h * 32 + g) * (128 * ST128);
#pragma unroll
        for (int q = 0; q < 5; ++q) { const int o = tid * 16 + q * 8192; if (q < 4 || o < 128 * ST128) *(u32x4*)(dst + o) = *(LAS u32x4*)(lds + o); }
        __syncthreads();
    }
}
__device__ void gdn_scan(CtxK& c, LAS unsigned char* lds, int h) {
    const int tid = ltid(), wv = __builtin_amdgcn_readfirstlane(tid >> 6), lane = tid & 63, fr = lane & 15, fq = lane >> 4;
    LAS unsigned char* stw = lds + G_ST + wv * 16 * ST128;
    f32x4 Sacc[8], Bn[8]; u32x4 mp[5];
#pragma unroll
    for (int m = 0; m < 8; ++m) Sacc[m] = (f32x4){0.f, 0.f, 0.f, 0.f};
#define GS_ISSUE(g_) do { const unsigned char* src_ = (const unsigned char*)c.gM + (size_t)(h * 32 + (g_)) * (128 * ST128) + tid * 16; \
        _Pragma("unroll") for (int q = 0; q < 5; ++q) if (q < 4 || tid * 16 + q * 8192 < 128 * ST128) mp[q] = *(const u32x4*)(src_ + q * 8192); \
        const f32x4* bp_ = (const f32x4*)c.gB + (size_t)(h * 32 + (g_)) * FRAG_F4 + (wv * 8) * 64 + lane; \
        _Pragma("unroll") for (int m = 0; m < 8; ++m) Bn[m] = bp_[m * 64]; } while (0)
    GS_ISSUE(0);
    for (int g = 0; g < 31; ++g) {
#pragma unroll
        for (int q = 0; q < 5; ++q) if (q < 4 || tid * 16 + q * 8192 < 128 * ST128) *(LAS u32x4*)(lds + tid * 16 + q * 8192) = mp[q];
        write_st(stw, Sacc, fr, fq);
#pragma unroll
        for (int m = 0; m < 8; ++m) Sacc[m] = Bn[m];
        __syncthreads();
        if (g + 1 < 31) GS_ISSUE(g + 1);
        mma_nt<8, 4>(Sacc, lds, ST128, stw, ST128, fr, fq);
        f32x4* sp = (f32x4*)c.gS + (size_t)(h * 32 + g + 1) * FRAG_F4 + (wv * 8) * 64 + lane;
#pragma unroll
        for (int m = 0; m < 8; ++m) sp[m * 64] = Sacc[m];
        __syncthreads();
    }
#undef GS_ISSUE
}
}
__device__ void ph_hgrn1(CtxK& c, LAS unsigned char* lds) { mx::hgrn_pass<false>(c, lds); }
__device__ void ph_hgrn2(CtxK& c, LAS unsigned char* lds) { mx::hgrn_scan(c); }
__device__ void ph_hgrn3(CtxK& c, LAS unsigned char* lds) { mx::hgrn_pass<true>(c, lds); }
__device__ void ph_gdn1(CtxK& c, LAS unsigned char* lds) {
    const int wu = blockIdx.x, h = wu & 7, g = wu >> 3;
    mx::gdn_prep(c, lds, h, g); __syncthreads();
    asm volatile("s_waitcnt vmcnt(0)" ::: "memory"); __syncthreads();
    mx::gdn_invert(c, lds, h, g);
    asm volatile("s_waitcnt vmcnt(0)" ::: "memory"); __syncthreads();
    mx::gdn_pass<0>(c, lds, h, g); __syncthreads();
    mx::gdn_pass<1>(c, lds, h, g); __syncthreads();
}
__device__ void ph_gdn2(CtxK& c, LAS unsigned char* lds) { if (blockIdx.x < 8) mx::gdn_scan(c, lds, blockIdx.x); }
__device__ void ph_gdn3(CtxK& c, LAS unsigned char* lds) { const int wu = blockIdx.x; mx::gdn_pass<2>(c, lds, wu & 7, wu >> 3); }

__device__ __forceinline__ float pair_sum128(float v, LAS float* red) {
    v = wave_sum(v); const int w = ltid() >> 6;
    __syncthreads(); if ((ltid() & 63) == 0) red[w] = v; __syncthreads();
    return red[w & ~1] + red[w | 1];
}
__device__ void ph_gdn_pre(CtxK& c, LAS unsigned char* lds) {
    LAS float* red = (LAS float*)lds;
    const int tid = ltid() & 255, g = ltid() >> 8;
    for (int t = blockIdx.x * 2 + g; t < S; t += gridDim.x * 2) {
        for (int grp = 0; grp < 12; ++grp) {
            const int ch = grp * 256 + tid; float acc = 0.f;
#pragma unroll
            for (int j = 0; j < 4; ++j) { const int tt = t - 3 + j; if (tt >= 0) acc += c.conv_w[j * 3072 + ch] * bf2f(c.proj[(size_t)tt * PW + C_GQKV + ch]); }
            const float val = siluf_(acc);
            if (grp < 8) {
                const float ss = pair_sum128(val * val, red); const float n = val * rsqrtf(ss + 1e-6f);
                if (grp < 4) c.gq[(size_t)t * 1024 + ch] = n * 0.08838834764831845f; else c.gk[(size_t)t * 1024 + ch - 1024] = n;
            } else c.gv[(size_t)t * 1024 + ch - 2048] = val;
        }
        if (tid < 8) {
            const float ga = c.gab[(size_t)t * 16 + tid], gb = c.gab[(size_t)t * 16 + 8 + tid];
            c.gbeta[t * 8 + tid] = sigmoidf_(gb); c.gdec[t * 8 + tid] = expf(-expf(c.a_log[tid]) * softplusf_(ga + c.dt_bias[tid]));
        }
    }
}
__device__ void ph_mix_naive(CtxK& c, LAS unsigned char* lds) {
    constexpr int TB = 8;
    const int wg = blockIdx.x, t512 = ltid(), tid = t512 & 127; const bool ld = t512 < 128, act = t512 < 256;
    const int v = (t512 >> 1) & 127, d0 = (t512 & 1) * 64;
    if (wg < 8 || wg >= 16) return;
    LAS float* sq = (LAS float*)lds; LAS float* sf = sq + TB * 128; LAS float* sk = sf + TB * 128; LAS float* sv = sk + TB * 128; LAS float* sb = sv + TB * 128; LAS float* sa = sb + TB;
    float st[64];
#pragma unroll
    for (int d = 0; d < 64; ++d) st[d] = 0.f;
    if (wg < 8) {
        const int h = wg; const float lbv = c.lb[h * 128 + tid];
        for (int t0 = 0; t0 < S; t0 += TB) {
            if (ld) for (int tt = 0; tt < TB; ++tt) {
                const bf16_t* base = c.proj + (size_t)(t0 + tt) * PW + h * 128 + tid;
                const float f = lbv + (1.f - lbv) * sigmoidf_(bf2f(base[C_HF]));
                sq[tt * 128 + tid] = siluf_(bf2f(base[C_HQ])) * 0.08838834764831845f; sf[tt * 128 + tid] = f; sk[tt * 128 + tid] = 1.f - f; sv[tt * 128 + tid] = bf2f(base[C_HI]);
            }
            __syncthreads();
            if (act) {
#pragma unroll 1
            for (int tt = 0; tt < TB; ++tt) {
                float o = 0.f; const float vv = sv[tt * 128 + v];
#pragma unroll
                for (int d = 0; d < 64; d += 4) {
                    const f32x4 q4 = *(LAS f32x4*)(sq + tt * 128 + d0 + d), f4 = *(LAS f32x4*)(sf + tt * 128 + d0 + d), k4 = *(LAS f32x4*)(sk + tt * 128 + d0 + d);
                    st[d] = f4[0] * st[d] + k4[0] * vv; o += q4[0] * st[d];
                    st[d + 1] = f4[1] * st[d + 1] + k4[1] * vv; o += q4[1] * st[d + 1];
                    st[d + 2] = f4[2] * st[d + 2] + k4[2] * vv; o += q4[2] * st[d + 2];
                    st[d + 3] = f4[3] * st[d + 3] + k4[3] * vv; o += q4[3] * st[d + 3];
                }
                o += __shfl_xor(o, 1);
                if (d0 == 0) c.oa[(size_t)(t0 + tt) * 1024 + h * 128 + v] = o;
            } }
            __syncthreads();
        }
    } else {
        const int h = wg - 8;
        for (int t0 = 0; t0 < S; t0 += TB) {
            if (ld) { for (int tt = 0; tt < TB; ++tt) {
                const size_t o = (size_t)(t0 + tt) * 1024 + h * 128 + tid;
                sq[tt * 128 + tid] = c.gq[o]; sk[tt * 128 + tid] = c.gk[o]; sv[tt * 128 + tid] = c.gv[o];
            }
            if (tid < TB) { sb[tid] = c.gbeta[(t0 + tid) * 8 + h]; sa[tid] = c.gdec[(t0 + tid) * 8 + h]; } }
            __syncthreads();
            if (act) {
#pragma unroll 1
            for (int tt = 0; tt < TB; ++tt) {
                const float a = sa[tt], be = sb[tt]; float kd = 0.f;
#pragma unroll
                for (int d = 0; d < 64; d += 4) { const f32x4 k4 = *(LAS f32x4*)(sk + tt * 128 + d0 + d); kd += k4[0] * st[d] + k4[1] * st[d + 1] + k4[2] * st[d + 2] + k4[3] * st[d + 3]; }
                kd += __shfl_xor(kd, 1);
                const float c1 = be * (sv[tt * 128 + v] - a * kd); float o = 0.f;
#pragma unroll
                for (int d = 0; d < 64; d += 4) {
                    const f32x4 k4 = *(LAS f32x4*)(sk + tt * 128 + d0 + d), q4 = *(LAS f32x4*)(sq + tt * 128 + d0 + d);
                    st[d] = a * st[d] + c1 * k4[0]; o += q4[0] * st[d];
                    st[d + 1] = a * st[d + 1] + c1 * k4[1]; o += q4[1] * st[d + 1];
                    st[d + 2] = a * st[d + 2] + c1 * k4[2]; o += q4[2] * st[d + 2];
                    st[d + 3] = a * st[d + 3] + c1 * k4[3]; o += q4[3] * st[d + 3];
                }
                o += __shfl_xor(o, 1);
                if (d0 == 0) c.ob[(size_t)(t0 + tt) * 1024 + h * 128 + v] = o;
            } }
            __syncthreads();
        }
    }
}
__device__ void ph_onorm(CtxK& c, LAS unsigned char* lds) {
    LAS float* red = (LAS float*)lds;
    const int tid = ltid() & 255, g = ltid() >> 8;
    for (int t = blockIdx.x * 2 + g; t < S; t += gridDim.x * 2) {
        for (int i = 4; i < 8; ++i) {
            const int br = i >> 2, ch = (i & 3) * 256 + tid; const float v = (br ? c.ob : c.oa)[(size_t)t * 1024 + ch];
            const float ss = pair_sum128(v * v, red);
            const float o = v * rsqrtf(ss * (1.f / 128.f) + 1e-6f) * (br ? c.gdn_onorm_g : c.hgrn_onorm_g)[ch & 127] * siluf_(bf2f(c.proj[(size_t)t * PW + (br ? C_GG : C_HG) + ch]));
            const unsigned pk = cvt_pk_bf16(o, o); c.ocat[(size_t)t * D + br * 1024 + ch] = (bf16_t)(pk & 0xffffu);
        }
    }
}
constexpr int N2_LA = 0, N2_LB = 8192, N2_XH = 16384, N2_XL = N2_XH + 17408, N2_Y = N2_XL + 17408, N2_LOG = N2_Y + 34816, N2_RS = N2_LOG + 64 * 65 * 4, N2_IDX = N2_RS + 256, N2_BIAS = N2_IDX + 2048, N2_END = N2_BIAS + 256;
static_assert(N2_END <= 147456, "norm2 lds");
__device__ void ph_norm2(CtxK& c, LAS unsigned char* lds) {
    const int tid = ltid(), wg = blockIdx.x, lane = tid & 63, wv = __builtin_amdgcn_readfirstlane(tid >> 6), fr = lane & 15, fq = lane >> 4;
    LAS float* la = (LAS float*)(lds + N2_LA); LAS float* lb_ = (LAS float*)(lds + N2_LB); LAS float* lg = (LAS float*)(lds + N2_LOG); LAS float* rs = (LAS float*)(lds + N2_RS);
    LAS int* idxt = (LAS int*)(lds + N2_IDX); LAS float* bias2 = (LAS float*)(lds + N2_BIAS);
    for (int j = tid; j < D; j += 512) { la[j] = c.norm2_g[j] * (1.f + c.mod[4 * D + j]); lb_[j] = c.mod[3 * D + j]; }
    if (tid < 64) bias2[tid] = c.rbias2[tid];
    __syncthreads();
    const int tok0 = wg * 64;
    f32x4 vn[8];
    { const float* xr = c.out + (size_t)(tok0 + wv * 8) * D;
#pragma unroll
      for (int i = 0; i < 8; ++i) vn[i] = *(const f32x4*)(xr + i * 256 + lane * 4); }
    for (int rr = 0; rr < 8; ++rr) {
        const int row = tok0 + wv * 8 + rr;
        f32x4 v[8]; float ss = 0.f;
#pragma unroll
        for (int i = 0; i < 8; ++i) { v[i] = vn[i]; ss += v[i][0] * v[i][0] + v[i][1] * v[i][1] + v[i][2] * v[i][2] + v[i][3] * v[i][3]; }
        if (rr + 1 < 8) { const float* xr = c.out + (size_t)(row + 1) * D;
#pragma unroll
            for (int i = 0; i < 8; ++i) vn[i] = *(const f32x4*)(xr + i * 256 + lane * 4); }
        ss = wave_sum(ss); const float r = rsqrtf(ss * (1.f / D) + 1e-6f);
        if (lane == 0) rs[wv * 8 + rr] = r;
#pragma unroll
        for (int i = 0; i < 8; ++i) { const int e = i * 256 + lane * 4; const f32x4 a = *(LAS f32x4*)(la + e), b = *(LAS f32x4*)(lb_ + e); const f32x4 y = v[i] * r * a + b;
            u32x2 w; w.x = cvt_pk_bf16(y[0], y[1]); w.y = cvt_pk_bf16(y[2], y[3]); *(u32x2*)(c.h2 + (size_t)row * D + e) = w; }
    }
    const int xrow = tid >> 3, xseg = (tid & 7) * 16;
    f32x4 xr_[4]; u32x4 yr_[5];
    auto issue = [&](int ch) {
        const float* xp = c.out + (size_t)(tok0 + xrow) * D + ch * 128 + xseg;
#pragma unroll
        for (int q = 0; q < 4; ++q) xr_[q] = *(const f32x4*)(xp + q * 4);
        const unsigned char* yp = (const unsigned char*)c.rwimg + (size_t)ch * 34816 + tid * 16;
#pragma unroll
        for (int q = 0; q < 4; ++q) yr_[q] = *(const u32x4*)(yp + q * 8192);
        if (tid < 128) yr_[4] = *(const u32x4*)(yp + 32768);
    };
    issue(0);
    f32x4 acc[2] = {(f32x4){0.f, 0.f, 0.f, 0.f}, (f32x4){0.f, 0.f, 0.f, 0.f}};
    const int mt = wv >> 1, nb = (wv & 1) * 2;
    for (int ch = 0; ch < 16; ++ch) {
        __syncthreads();
        { float hi[16], lo[16];
#pragma unroll
          for (int q = 0; q < 4; ++q)
#pragma unroll
              for (int j = 0; j < 4; ++j) { const float x = xr_[q][j]; const float h = __uint_as_float(cvt_pk_bf16(x, x) << 16); hi[q * 4 + j] = h; lo[q * 4 + j] = x - h; }
          float t8[8];
#pragma unroll
          for (int hh = 0; hh < 2; ++hh) {
#pragma unroll
              for (int j = 0; j < 8; ++j) t8[j] = hi[hh * 8 + j];
              *(LAS u32x4*)(lds + N2_XH + xrow * 272 + (xseg + hh * 8) * 2) = mx::pack8(t8);
#pragma unroll
              for (int j = 0; j < 8; ++j) t8[j] = lo[hh * 8 + j];
              *(LAS u32x4*)(lds + N2_XL + xrow * 272 + (xseg + hh * 8) * 2) = mx::pack8(t8); }
#pragma unroll
          for (int q = 0; q < 4; ++q) *(LAS u32x4*)(lds + N2_Y + tid * 16 + q * 8192) = yr_[q];
          if (tid < 128) *(LAS u32x4*)(lds + N2_Y + tid * 16 + 32768) = yr_[4]; }
        __syncthreads();
        if (ch + 1 < 16) issue(ch + 1);
#pragma unroll
        for (int kk = 0; kk < 4; ++kk) {
            const int ko = (kk * 32 + fq * 8) * 2;
            const bf16x8 ah = *(const LAS bf16x8*)(lds + N2_XH + (16 * mt + fr) * 272 + ko), al = *(const LAS bf16x8*)(lds + N2_XL + (16 * mt + fr) * 272 + ko);
#pragma unroll
            for (int n = 0; n < 2; ++n) {
                const bf16x8 bh = *(const LAS bf16x8*)(lds + N2_Y + (16 * (nb + n) + fr) * 272 + ko), bl = *(const LAS bf16x8*)(lds + N2_Y + 17408 + (16 * (nb + n) + fr) * 272 + ko);
                acc[n] = mx::mfma16(ah, bh, acc[n]); acc[n] = mx::mfma16(ah, bl, acc[n]); acc[n] = mx::mfma16(al, bh, acc[n]);
            }
        }
    }
#pragma unroll
    for (int n = 0; n < 2; ++n)
#pragma unroll
        for (int r = 0; r < 4; ++r) lg[(16 * mt + 4 * fq + r) * 65 + 16 * (nb + n) + fr] = acc[n][r];
    __syncthreads();
    const float rb = c.router_bias[lane], b2 = bias2[lane];
    for (int rr = 0; rr < 8; ++rr) {
        const int lr = wv * 8 + rr, t = tok0 + lr;
        const float s = sigmoidf_(lg[lr * 65 + lane] * rs[lr] + b2), b = s + rb;
        int rk = 0;
#pragma unroll
        for (int x = 1; x < 8; ++x) { const float ob = __shfl_xor(b, x); const int ol = lane ^ x; rk += (ob > b || (ob == b && ol < lane)) ? 1 : 0; }
        float gs = rk < 2 ? b : 0.f; gs += __shfl_xor(gs, 1); gs += __shfl_xor(gs, 2); gs += __shfl_xor(gs, 4);
        int grk = 0;
#pragma unroll
        for (int x = 8; x < 64; x += 8) { const float og = __shfl_xor(gs, x); const int ol = lane ^ x; grk += (og > gs || (og == gs && ol < lane)) ? 1 : 0; }
        float mb = grk < 4 ? b : -INFINITY;
        float wsum = 0.f; int myk = -1;
        for (int k = 0; k < TOPK; ++k) {
            float m = mb;
#pragma unroll
            for (int o = 32; o >= 1; o >>= 1) m = fmaxf(m, __shfl_xor(m, o));
            const unsigned long long bal = __ballot(mb == m); const int win = __ffsll((long long)bal) - 1;
            const float sw = __shfl(s, win); wsum += sw;
            if (lane == win) { mb = -INFINITY; myk = k; }
        }
        if (myk >= 0) { c.idx[t * TOPK + myk] = lane; c.wts[t * TOPK + myk] = s / wsum * 2.5f; idxt[lr * TOPK + myk] = lane; }
    }
    __syncthreads();
    if (tid < 64) { int n = 0;
        for (int p = 0; p < 512; ++p) if (idxt[p] == tid) { c.rnk[wg * 512 + p] = n; ++n; }
        c.tile_cnt[wg * 64 + tid] = n; }
}
__device__ void ph_route(CtxK& c, LAS unsigned char* lds) {
    const int tid = ltid(), b = blockIdx.x, e = tid & 63, part = tid >> 6;
    LAS int* psum = (LAS int*)lds; LAS int* pbel = psum + 512; LAS int* tot = pbel + 512; LAS int* offb = tot + 64; LAS int* pst = offb + 64;
    { int sa = 0, sb = 0;
      for (int tl = part * 32; tl < part * 32 + 32; ++tl) { const int v = c.tile_cnt[tl * 64 + e]; sa += v; sb += tl < b ? v : 0; }
      psum[part * 64 + e] = sa; pbel[part * 64 + e] = sb; }
    __syncthreads();
    if (tid < 64) {
        int t_ = 0, o_ = 0;
#pragma unroll
        for (int q = 0; q < 8; ++q) { t_ += psum[q * 64 + e]; o_ += pbel[q * 64 + e]; }
        const int pad = (t_ + 255) & ~255; int inc = pad;
#pragma unroll
        for (int o = 1; o < 64; o <<= 1) { const int x = __shfl_up(inc, o); if (e >= o) inc += x; }
        const int ps = inc - pad;
        tot[e] = t_; offb[e] = o_; pst[e] = ps;
        if (b == 0) {
            const int b0 = ps >> 8, nbe = pad >> 8;
            for (int j = 0; j < nbe; ++j) { c.blk_row[b0 + j] = ps + j * 256; c.blk_exp[b0 + j] = e; }
            const int nbr = __shfl(inc, 63) >> 8;
            c.blk_row[nbr + e] = PROUTED + e * 256; c.blk_exp[nbr + e] = NE;
            if (e == 0) *c.nent = nbr + S / 256;
        }
        c.tok_p[PROUTED + b * 64 + e] = b * 64 + e; c.w_p[PROUTED + b * 64 + e] = 1.f;
    }
    __syncthreads();
    { const int p = b * 512 + tid, ex = c.idx[p], d = pst[ex] + offb[ex] + c.rnk[p];
      c.tok_p[d] = p >> 3; c.w_p[d] = c.wts[p]; c.pos[p] = d; }
    if (b < NE) { const int ps = pst[b], t_ = tot[b], pe = (t_ + 255) & ~255;
        for (int r = t_ + tid; r < pe; r += 512) { c.tok_p[ps + r] = 0; c.w_p[ps + r] = 0.f; } }
}

constexpr int LDS_MAIN = 147456, LDS_BYTES = LDS_MAIN + 16;
__global__ void __launch_bounds__(512, 2) k_mega(Ctx c) {
    extern __shared__ __attribute__((aligned(16))) unsigned char smem[];
    LAS unsigned char* lds = (LAS unsigned char*)smem;
    if (ltid() == 0) *(LAS u32x4*)(lds + LDS_MAIN) = (u32x4){0u, 0u, 0u, 0u};
    __syncthreads();
    CtxK* kp = (CtxK*)__builtin_amdgcn_kernarg_segment_ptr();
    (void)xcd_barrier_post(c.bar, (volatile LAS unsigned*)(lds + LDS_MAIN));
#define PHASE(fn) do { const CtxK* kp_ = kp; asm volatile("" : "+s"(kp_)); fn(*kp_, lds); __syncthreads(); } while (0)
#define GRID_BARRIER() do { const CtxK* kp_ = kp; asm volatile("" : "+s"(kp_)); XcdBarrier bb_; bb_.bar = kp_->bar; bb_.x = xb_xcc_id(); bb_.st = (volatile LAS unsigned*)(lds + LDS_MAIN); xcd_barrier(bb_); } while (0)
    PHASE(ph_pro1);      GRID_BARRIER();
    PHASE(ph_norm1);     GRID_BARRIER();
    PHASE(ph_gemm1);     GRID_BARRIER();
    PHASE(ph_hgrn1);     PHASE(ph_gdn1);  GRID_BARRIER();
    PHASE(ph_hgrn2);     PHASE(ph_gdn2);  PHASE(ph_cvt_exp); GRID_BARRIER();
    PHASE(ph_hgrn3);     PHASE(ph_gdn3);  GRID_BARRIER();
    PHASE(ph_gemm2);     GRID_BARRIER();
    PHASE(ph_gemm3);     GRID_BARRIER();
    PHASE(ph_norm2);     GRID_BARRIER();
    PHASE(ph_route);     GRID_BARRIER();
    PHASE(ph_moe_gu);    GRID_BARRIER();
    PHASE(ph_moe_dn);    GRID_BARRIER();
    PHASE(ph_final);
#undef PHASE
#undef GRID_BARRIER
}

extern "C" void kernel_launch(void* const* d_in, const int* in_sizes, int n_in, void* d_out, int out_size, void* d_ws, size_t ws_size, hipStream_t stream) {
    Ctx c{};
    const float** ip = (const float**)&c.x;
    for (int i = 0; i < 25; ++i) ip[i] = (const float*)d_in[i];
    c.out = (float*)d_out;
    char* ws = (char*)d_ws; constexpr size_t MB = 1024 * 1024;
    c.bar = (unsigned*)ws;
    c.modp = (float*)(ws + 64 * 1024); c.mod = (float*)(ws + 320 * 1024); c.lb = (float*)(ws + 384 * 1024);
    c.cnt = (int*)(ws + 392 * 1024); c.nent = (int*)(ws + 396 * 1024); c.blk_row = (int*)(ws + 400 * 1024); c.blk_exp = (int*)(ws + 404 * 1024);
    c.idx = (int*)(ws + 1 * MB); c.wts = (float*)(ws + 2 * MB); c.tok_p = (int*)(ws + 3 * MB); c.w_p = (float*)(ws + 4 * MB); c.pos = (int*)(ws + 5 * MB);
    c.gab = (float*)(ws + 6 * MB); c.gbeta = (float*)(ws + 7 * MB + 0); c.gdec = (float*)(ws + 7 * MB + 512 * 1024);
    c.rwimg = (bf16_t*)(ws + 8 * MB); c.rbias2 = (float*)(ws + 9 * MB); c.tile_cnt = (int*)(ws + 9 * MB + 4096); c.rnk = (int*)(ws + 10 * MB);
    char* big = ws + 16 * MB;
    auto at = [&](size_t mib) { return big + mib * MB; };
    c.dn_t = (bf16_t*)at(0); c.gu_t = (bf16_t*)at(130);
    c.win_t = (bf16_t*)at(0); c.h1 = (bf16_t*)at(48); c.gAT = (float*)at(112);
    c.proj = (bf16_t*)at(390); c.gBlob = (unsigned char*)at(774); c.merged = (bf16_t*)at(774);
    c.gM = (unsigned char*)at(951); c.gB = (float*)at(960); c.hL = (float*)at(976); c.gS = (float*)at(992); c.hS = (float*)at(1008); c.hD = (float*)at(1024);
    c.wa_t = (bf16_t*)at(1025); c.wb_t = (bf16_t*)at(1029); c.wout_t = (bf16_t*)at(1033); c.ocat = (bf16_t*)at(1041);
    c.Y = (unsigned char*)at(130); c.hid = (bf16_t*)at(770); c.h2 = (bf16_t*)at(930);
    static_assert((size_t)NEX * D * FF * 2 <= 130 * MB && (size_t)NEX * 1024 * D * 2 <= 260 * MB && (size_t)PW * D * 2 <= 48 * MB && (size_t)S * D * 2 <= 64 * MB, "map A");
    static_assert((size_t)S * PW * 2 <= 384 * MB && (size_t)2048 * mx::BLOB <= 177 * MB && (size_t)256 * 128 * mx::ST128 <= 9 * MB && (size_t)PTOT * D * 2 <= 640 * MB && (size_t)PTOT * FF * 2 <= 160 * MB, "map B");
    const size_t need = 16 * MB + 1105 * MB;
    if (ws_size < need) { fprintf(stderr, "kernel_launch: workspace too small: %zu < %zu\n", ws_size, need); return; }

    static int grid = 0;
    if (!grid) {
        int dev = 0, cus = 0, per_cu = 0;
        hipGetDevice(&dev); hipDeviceGetAttribute(&cus, hipDeviceAttributeMultiprocessorCount, dev);
        hipFuncSetAttribute((const void*)k_mega, hipFuncAttributeMaxDynamicSharedMemorySize, LDS_BYTES);
        hipOccupancyMaxActiveBlocksPerMultiprocessor(&per_cu, (const void*)k_mega, 512, LDS_BYTES);
        if (per_cu < 1) fprintf(stderr, "kernel_launch: occupancy query reports %d blocks per CU\n", per_cu);
        grid = cus;
        if (grid != 256) { fprintf(stderr, "kernel_launch: built for a 256-CU device (token-mixer units = workgroups); got %d CUs\n", cus); grid = -1; }
    }
    if (grid < 0) return;
    hipMemsetAsync(c.bar, 0, XCD_BAR_WORDS * sizeof(unsigned), stream);
    hipLaunchKernelGGL(k_mega, dim3(grid), dim3(512), LDS_BYTES, stream, c);
}
```

```cpp
#include <hip/hip_runtime.h>
#include <stdint.h>
#include <stdio.h>

#define LAS __attribute__((address_space(3)))
typedef unsigned short bf16_t;
typedef short bf16x8 __attribute__((ext_vector_type(8)));
typedef float f32x4 __attribute__((ext_vector_type(4)));
typedef unsigned u32x4 __attribute__((ext_vector_type(4)));
typedef unsigned u32x2 __attribute__((ext_vector_type(2)));
typedef int v4i __attribute__((ext_vector_type(4)));
typedef int v8i __attribute__((ext_vector_type(8)));

constexpr int S = 16384, D = 2048, INW = 12304, PW = 12288, NE = 64, TOPK = 8, TK = S * TOPK, FF = 512;
constexpr int NEX = NE + 1;
constexpr int PROUTED = 147456, PTOT = PROUTED + S, NBLK_MAX = PROUTED / 256;
constexpr int C_HQ = 0, C_HF = 1024, C_HI = 2048, C_HG = 3072, C_GQKV = 4096, C_GG = 7168, C_MGA = 8192, C_MGB = 10240;
constexpr int WIN_GAB = 7168;

__device__ __forceinline__ float rcpf_(float x) { return __builtin_amdgcn_rcpf(x); }
__device__ __forceinline__ float sigmoidf_(float x) { return rcpf_(1.f + __expf(-x)); }
__device__ __forceinline__ float siluf_(float x) { return x * rcpf_(1.f + __expf(-x)); }
__device__ __forceinline__ float softplusf_(float x) { return x > 20.f ? x : log1pf(expf(x)); }
__device__ __forceinline__ float bf2f(bf16_t b) { return __uint_as_float(((unsigned)b) << 16); }
__device__ __forceinline__ float bflo(unsigned w) { return __uint_as_float(w << 16); }
__device__ __forceinline__ float bfhi(unsigned w) { return __uint_as_float(w & 0xffff0000u); }
__device__ __forceinline__ unsigned cvt_pk_bf16(float lo, float hi) { unsigned r; asm volatile("v_cvt_pk_bf16_f32 %0, %1, %2" : "=v"(r) : "v"(lo), "v"(hi)); return r; }
__device__ __forceinline__ unsigned cvt4_fp8(float a, float b, float c_, float d) {
    a = fminf(fmaxf(a, -448.f), 448.f); b = fminf(fmaxf(b, -448.f), 448.f); c_ = fminf(fmaxf(c_, -448.f), 448.f); d = fminf(fmaxf(d, -448.f), 448.f);
    int w = __builtin_amdgcn_cvt_pk_fp8_f32(a, b, 0, false); w = __builtin_amdgcn_cvt_pk_fp8_f32(c_, d, w, true); return (unsigned)w; }
__device__ __forceinline__ int ltid() { int t = threadIdx.x; asm volatile("" : "+v"(t)); return t; }
__device__ __forceinline__ float wave_sum_dpp(float v) {
    v += __builtin_bit_cast(float, __builtin_amdgcn_update_dpp(0, __builtin_bit_cast(int, v), 0x128, 0xf, 0xf, false));
    v += __builtin_bit_cast(float, __builtin_amdgcn_update_dpp(0, __builtin_bit_cast(int, v), 0x124, 0xf, 0xf, false));
    v += __builtin_bit_cast(float, __builtin_amdgcn_update_dpp(0, __builtin_bit_cast(int, v), 0x122, 0xf, 0xf, false));
    v += __builtin_bit_cast(float, __builtin_amdgcn_update_dpp(0, __builtin_bit_cast(int, v), 0x121, 0xf, 0xf, false));
    const int b = __builtin_bit_cast(int, v);
    return __builtin_bit_cast(float, __builtin_amdgcn_readlane(b, 0)) + __builtin_bit_cast(float, __builtin_amdgcn_readlane(b, 16)) + __builtin_bit_cast(float, __builtin_amdgcn_readlane(b, 32)) + __builtin_bit_cast(float, __builtin_amdgcn_readlane(b, 48));
}
__device__ __forceinline__ float wave_sum(float v) {
#pragma unroll
    for (int o = 32; o >= 1; o >>= 1) v += __shfl_xor(v, o);
    return v;
}


#define XB_TMO      128
#define XB_XCNT(j)  (256  + 64 * (j))
#define XB_XSUB(j)  (1280 + 64 * (j))
#define XB_XGEN(j)  (2304 + 64 * (j))
#define XB_TOP      3328
#define XB_TOPGEN   3392
#define XCD_BAR_WORDS 3456
#define XB_SPIN_CAP (1u << 18)
__device__ __forceinline__ unsigned xb_ld(unsigned* p)              { return __hip_atomic_load(p, __ATOMIC_RELAXED, __HIP_MEMORY_SCOPE_AGENT); }
__device__ __forceinline__ unsigned xb_add(unsigned* p, unsigned v) { return __hip_atomic_fetch_add(p, v, __ATOMIC_RELAXED, __HIP_MEMORY_SCOPE_AGENT); }
__device__ __forceinline__ unsigned xb_xcc_id() { return (unsigned)__builtin_amdgcn_s_getreg((3 << 11) | 20) & 0xFu; }
#define XB_SPIN(cond, bar) do { unsigned _sp = 0; while (cond) { __builtin_amdgcn_s_sleep(1); \
    if ((++_sp & 255u) == 0u) { if (xb_ld(&(bar)[XB_TMO])) break; if (_sp > XB_SPIN_CAP) { atomicAdd(&(bar)[XB_TMO], 1u); break; } } } } while (0)
struct XcdBarrier { unsigned* bar; unsigned x; volatile LAS unsigned* st; };
__device__ __forceinline__ XcdBarrier xcd_barrier_post(unsigned* bar, volatile LAS unsigned* st) {
    XcdBarrier b; b.bar = bar; b.x = xb_xcc_id(); b.st = st;
    if (threadIdx.x == 0) (void)xb_add(&bar[XB_XCNT(b.x)], 1u);
    return b;
}
__device__ __forceinline__ void xcd_barrier_complete(unsigned* bar, unsigned x, unsigned& nloc, unsigned& nx) {
    const unsigned G = gridDim.x * gridDim.y * gridDim.z;
    unsigned sum, cnt, mine, sp = 0u;
    for (;;) {
        sum = 0u; cnt = 0u; mine = 0u;
#pragma unroll
        for (unsigned j = 0; j < 16; ++j) { const unsigned c = xb_ld(&bar[XB_XCNT(j)]); sum += c; cnt += (c > 0u) ? 1u : 0u; mine = (j == x) ? c : mine; }
        if (sum == G) break;
        __builtin_amdgcn_s_sleep(1);
        if ((++sp & 255u) == 0u) { if (xb_ld(&bar[XB_TMO])) break; if (sp > XB_SPIN_CAP) { atomicAdd(&bar[XB_TMO], 1u); break; } }
    }
    nloc = mine > 0u ? mine : 1u; nx = cnt > 0u ? cnt : 1u;
}
__device__ __forceinline__ void xcd_barrier(const XcdBarrier& b) {
    asm volatile("s_waitcnt vmcnt(0)" ::: "memory");
    __syncthreads();
    if (threadIdx.x == 0) {
        unsigned* bar = b.bar;
        __builtin_amdgcn_s_waitcnt(0);
        unsigned nloc = b.st[0], nx = b.st[1];
        if (nloc == 0u) { xcd_barrier_complete(bar, b.x, nloc, nx); b.st[0] = nloc; b.st[1] = nx; }
        const unsigned old = xb_add(&bar[XB_XSUB(b.x)], 1u);
        const unsigned gen = old / nloc;
        if (old + 1u == (gen + 1u) * nloc) {
            __builtin_amdgcn_fence(__ATOMIC_RELEASE, "agent");
            asm volatile("s_waitcnt vmcnt(0)" ::: "memory");
            const unsigned og = xb_add(&bar[XB_TOP], 1u);
            const unsigned tg = og / nx;
            if (og + 1u == (tg + 1u) * nx) xb_add(&bar[XB_TOPGEN], 1u);
            else XB_SPIN(xb_ld(&bar[XB_TOPGEN]) == tg, bar);
            __builtin_amdgcn_fence(__ATOMIC_ACQUIRE, "agent");
            xb_add(&bar[XB_XGEN(b.x)], 1u);
            asm volatile("s_waitcnt vmcnt(0)" ::: "memory");
        } else {
            XB_SPIN(xb_ld(&bar[XB_XGEN(b.x)]) == gen, bar);
            __builtin_amdgcn_fence(__ATOMIC_ACQUIRE, "agent");
            asm volatile("s_waitcnt vmcnt(0)" ::: "memory");
        }
    }
    __syncthreads();
}

namespace gm {
constexpr int BM = 256, BK = 64, HALF = 128, HTB = HALF * BK * 2, STAGE_BYTES = 8 * HTB;
__host__ __device__ __forceinline__ int lds_byte(int r, int c) { const int st = (r >> 4) * 2 + (c >> 5), rr = r & 15, cc = c & 31, ob = rr * 64 + cc * 2; return st * 1024 + (ob ^ (((ob >> 9) & 1) << 5)); }
__host__ __device__ __forceinline__ void stage_rc(int b, int& R, int& C) { const int st = b / 1024, sb = b % 1024, swz = sb ^ (((sb >> 9) & 1) << 5); R = (st >> 1) * 16 + swz / 64; C = (st & 1) * 32 + (swz % 64) / 2; }
__host__ __device__ __forceinline__ int perm32(int rho) { const int n = rho >> 4, i = rho & 15; return 8 * (i >> 2) + 4 * n + (i & 3); }

struct Unit { int pm, pn, aux; const char* Bp; };
constexpr int UOFF = STAGE_BYTES + 256 + 10240, VBOFF = UOFF + 2 * 512 * 16;
__device__ __forceinline__ void put_offs(LAS unsigned char* lds, int ui, unsigned a00, unsigned a01, unsigned a10, unsigned a11) { *(LAS u32x4*)(lds + UOFF + ((ui & 1) * 512 + ltid()) * 16) = (u32x4){a00, a01, a10, a11}; }

template <class Epi, class Sched>
__device__ __forceinline__ void gphase(LAS unsigned char* lds, const char* Abase, const int K, Sched& S, Epi& E) {
    const int tid = ltid(), wid = __builtin_amdgcn_readfirstlane(tid >> 6), lane = tid & 63, wr = wid >> 2, wc = wid & 3, fr = lane & 15, fq = lane >> 4;
    const int nt = K / BK;
    { unsigned vb_[2];
#pragma unroll
      for (int i = 0; i < 2; ++i) { int R, C; stage_rc(tid * 16 + i * 8192, R, C); const int Rb = Epi::PERM ? ((R & ~31) + perm32(R & 31)) : R; vb_[i] = (unsigned)(Rb * K + C) * 2u; }
      *(LAS u32x2*)(lds + VBOFF + tid * 8) = (u32x2){vb_[0], vb_[1]}; }
    const unsigned hstepB = (unsigned)HALF * K * 2;
    const unsigned ldsw = (unsigned)wid * 1024u;
    constexpr bool F8 = Epi::F8; constexpr int KST = F8 ? 16 : 1024;
    const int aoff = lds_byte(wr * 64 + fr, fq * (F8 ? 16 : 8)), boff = lds_byte(wc * 32 + fr, fq * (F8 ? 16 : 8));
#define G_SA(b, h) (((b) * 2 + (h)) * HTB)
#define G_SB(b, h) ((4 + (b) * 2 + (h)) * HTB)
#define G_STAGE_A(bufoff, slot_, half_, kb) do { const char* ab_ = Abase + (kb); const u32x2 p_ = *(const LAS u32x2*)(lds + UOFF + (((slot_) & 1) * 512 + tid) * 16 + (half_) * 8); unsigned p0_ = p_.x, p1_ = p_.y; asm volatile("" : "+v"(p0_), "+v"(p1_)); \
        __builtin_amdgcn_global_load_lds((const unsigned*)(ab_ + p0_), (LAS unsigned*)(lds + (bufoff) + ldsw), 16, 0, 0); \
        __builtin_amdgcn_global_load_lds((const unsigned*)(ab_ + p1_), (LAS unsigned*)(lds + (bufoff) + ldsw + 8192), 16, 0, 0); } while (0)
#define G_STAGE_B(bufoff, bp, kb) do { const char* bb_ = (bp) + (kb); const u32x2 q_ = *(const LAS u32x2*)(lds + VBOFF + tid * 8); unsigned p0_ = q_.x, p1_ = q_.y; asm volatile("" : "+v"(p0_), "+v"(p1_)); \
        __builtin_amdgcn_global_load_lds((const unsigned*)(bb_ + p0_), (LAS unsigned*)(lds + (bufoff) + ldsw), 16, 0, 0); \
        __builtin_amdgcn_global_load_lds((const unsigned*)(bb_ + p1_), (LAS unsigned*)(lds + (bufoff) + ldsw + 8192), 16, 0, 0); } while (0)
#define G_LDA(dst, b, h) do { _Pragma("unroll") for (int m = 0; m < 4; ++m) _Pragma("unroll") for (int k = 0; k < 2; ++k) dst[m][k] = *(const LAS v4i*)(lds + G_SA(b, h) + aoff + m * 2048 + k * KST); } while (0)
#define G_LDB(dst, b, h) do { _Pragma("unroll") for (int n = 0; n < 2; ++n) _Pragma("unroll") for (int k = 0; k < 2; ++k) dst[n][k] = *(const LAS v4i*)(lds + G_SB(b, h) + boff + n * 2048 + k * KST); } while (0)
#define G_CAT(x_) __builtin_shufflevector(x_[0], x_[1], 0, 1, 2, 3, 4, 5, 6, 7)
#define G_MMA(ai, bj, At, Bt) do { __builtin_amdgcn_s_setprio(1); _Pragma("unroll") for (int m = 0; m < 4; ++m) _Pragma("unroll") for (int n = 0; n < 2; ++n) { \
        if constexpr (F8) acc[ai][bj][m][n] = __builtin_amdgcn_mfma_scale_f32_16x16x128_f8f6f4(G_CAT(Bt[n]), G_CAT(At[m]), acc[ai][bj][m][n], 0, 0, 0, Epi::SB, 0, Epi::SA); \
        else { _Pragma("unroll") for (int k = 0; k < 2; ++k) acc[ai][bj][m][n] = __builtin_amdgcn_mfma_f32_16x16x32_bf16(__builtin_bit_cast(bf16x8, Bt[n][k]), __builtin_bit_cast(bf16x8, At[m][k]), acc[ai][bj][m][n], 0, 0, 0); } } \
        __builtin_amdgcn_s_setprio(0); } while (0)
#define G_WAIT_V(n) asm volatile("s_waitcnt vmcnt(" #n ")" ::: "memory")
#define G_WAIT_L(n) asm volatile("s_waitcnt lgkmcnt(" #n ")" ::: "memory")
#define G_BAR __builtin_amdgcn_s_barrier()
#define G_SCHED __builtin_amdgcn_sched_barrier(0)
#define G_ZERO() do { _Pragma("unroll") for (int a = 0; a < 2; ++a) _Pragma("unroll") for (int b = 0; b < 2; ++b) _Pragma("unroll") for (int m = 0; m < 4; ++m) _Pragma("unroll") for (int n = 0; n < 2; ++n) acc[a][b][m][n] = (f32x4){0.f, 0.f, 0.f, 0.f}; } while (0)
    Unit cur, nxt; int ui = 0;
    if (!S.next(lds, 0, cur)) return;
    f32x4 acc[2][2][4][2];
    G_ZERO();
    v4i At[4][2], B0[2][2], B1[2][2];
    G_STAGE_B(G_SB(0, 0), cur.Bp, 0); G_STAGE_B(G_SB(0, 1), cur.Bp + hstepB, 0); G_STAGE_A(G_SA(0, 0), 0, 0, 0); G_STAGE_A(G_SA(0, 1), 0, 1, 0);
    if (wr == 1) G_BAR;
    G_WAIT_V(2); G_BAR;
    G_STAGE_B(G_SB(1, 0), cur.Bp, 128); G_STAGE_A(G_SA(1, 0), 0, 0, 128); G_STAGE_B(G_SB(1, 1), cur.Bp + hstepB, 128);
    G_WAIT_V(6); G_BAR;
    for (;;) {
        bool has_next = false;
#pragma unroll 1
        for (int t = 0; t < nt; t += 2) {
            const bool last = (t == nt - 2);
            const unsigned kb1 = (unsigned)(t + 1) * 128u, kb2 = last ? 0u : (unsigned)(t + 2) * 128u, kb3 = kb2 + 128u;
            const char* b2 = cur.Bp; int s2 = ui;
            if (last) {
                has_next = S.next(lds, ui + 1, nxt); if (!has_next) nxt = cur; else s2 = ui + 1;
                b2 = nxt.Bp; }
            G_LDB(B0, 0, 0); G_LDB(B1, 0, 1); G_SCHED; G_LDA(At, 0, 0); G_STAGE_A(G_SA(1, 1), ui, 1, kb1);
            G_WAIT_V(8); G_WAIT_L(0); G_BAR; G_MMA(0, 0, At, B0); G_MMA(0, 1, At, B1); G_BAR; G_SCHED;
            G_LDA(At, 0, 1); G_STAGE_B(G_SB(0, 0), b2, kb2); G_STAGE_B(G_SB(0, 1), b2 + hstepB, kb2); G_STAGE_A(G_SA(0, 0), s2, 0, kb2);
            G_WAIT_V(8); G_WAIT_L(0); G_BAR; G_MMA(1, 0, At, B0); G_MMA(1, 1, At, B1); G_BAR; G_SCHED;
            G_LDB(B0, 1, 0); G_LDB(B1, 1, 1); G_SCHED; G_LDA(At, 1, 0); G_STAGE_A(G_SA(0, 1), s2, 1, kb2);
            G_WAIT_V(8); G_WAIT_L(0); G_BAR; G_MMA(0, 0, At, B0); G_MMA(0, 1, At, B1); G_BAR; G_SCHED;
            G_LDA(At, 1, 1); G_STAGE_B(G_SB(1, 0), b2, kb3); G_STAGE_B(G_SB(1, 1), b2 + hstepB, kb3); G_STAGE_A(G_SA(1, 0), s2, 0, kb3);
            G_WAIT_V(8); G_WAIT_L(0); G_BAR; G_MMA(1, 0, At, B0); G_MMA(1, 1, At, B1); G_BAR; G_SCHED;
        }
        if (wr == 0) G_BAR;
        { const int tz = ltid(), wz = tz >> 6, lz = tz & 63; E(acc, cur, wz >> 2, wz & 3, lz & 15, lz >> 4); }
        if (!has_next) break;
        if (!E.keep(cur)) G_ZERO();
        cur = nxt; ++ui;
        if (wr == 1) G_BAR;
    }
    G_WAIT_V(0);
    G_BAR;
#undef G_SA
#undef G_SB
#undef G_STAGE_A
#undef G_STAGE_B
#undef G_LDA
#undef G_CAT
#undef G_LDB
#undef G_MMA
#undef G_WAIT_V
#undef G_WAIT_L
#undef G_BAR
#undef G_SCHED
#undef G_ZERO
}

struct DenseSched {
    int nM, nN, nwg, G, c, lda, K, parts; const char* Bt; const char* Bt2;
    __device__ void init(int M, int N, int K_, int lda_, const void* Bt_, const void* Bt2_, int parts_) {
        nM = M / BM; nN = N / BM; nwg = nM * nN; G = gridDim.x; c = blockIdx.x; lda = lda_; K = K_; Bt = (const char*)Bt_; Bt2 = (const char*)Bt2_; parts = parts_;
    }
    __device__ bool next(LAS unsigned char* lds, int i, Unit& u) const {
        const int ti = parts == 2 ? (i >> 1) : i, part = parts == 2 ? (i & 1) : 0;
        const long L = (long)ti * G + c; if (L >= nwg) return false;
        int wgid = (int)L; { const int q = nwg / 8, r = nwg % 8, xcd = wgid % 8, off = wgid / 8; wgid = (xcd < r ? xcd * (q + 1) : r * (q + 1) + (xcd - r) * q) + off; }
        const int nig = 8 * nN, gid = wgid / nig, fm = gid * 8, gsz = (nM - fm) < 8 ? (nM - fm) : 8;
        u.pm = fm + ((wgid % nig) % gsz); u.pn = (wgid % nig) / gsz; u.aux = part;
        u.Bp = (part ? Bt2 : Bt) + (size_t)u.pn * BM * K * 2;
        int R0, C0, R1, C1; { const int tz = ltid(); stage_rc(tz * 16, R0, C0); stage_rc(tz * 16 + 8192, R1, C1); }
        const unsigned rb = (unsigned)u.pm * BM, po = part ? (unsigned)K * 2u : 0u;
        put_offs(lds, i, ((rb + R0) * lda + C0) * 2u + po, ((rb + R1) * lda + C1) * 2u + po, ((rb + HALF + R0) * lda + C0) * 2u + po, ((rb + HALF + R1) * lda + C1) * 2u + po);
        return true;
    }
};
template <bool GATHER, int NN, int KK, int LDA, size_t WSTRIDE>
struct MoeSched {
    static constexpr int MAXU = 24, TBL = STAGE_BYTES, TOK = STAGE_BYTES + 256;
    int nu; const char* W;
    __device__ void init(LAS unsigned char* lds, const int* nent_p, const int* blk_row, const int* blk_exp, const int* tok_p, const void* W_) {
        W = (const char*)W_;
        const int tid = ltid(), G = gridDim.x, c = blockIdx.x, nent = *nent_p;
        const int x = c & 7, slot = c >> 3, nslot = G >> 3, e0 = (int)((long)x * nent / 8), e1 = (int)((long)(x + 1) * nent / 8), tot = (e1 - e0) * NN;
        nu = tot > slot ? (tot - slot + nslot - 1) / nslot : 0; if (nu > MAXU) nu = MAXU;
        LAS int* t_ = (LAS int*)(lds + TBL); LAS int* k_ = (LAS int*)(lds + TOK);
        if (tid < nu) { const int uidx = tid * nslot + slot, ent = e0 + uidx / NN; t_[tid * 2] = blk_row[ent]; t_[tid * 2 + 1] = blk_exp[ent] * 16 + uidx % NN; }
        __syncthreads();
        if (GATHER) { for (int j = tid; j < nu * 256; j += 512) k_[j] = tok_p[t_[(j >> 8) * 2] + (j & 255)]; __syncthreads(); }
    }
    __device__ bool next(LAS unsigned char* lds, int i, Unit& u) const {
        if (i >= nu) return false;
        LAS const int* tbl = (LAS const int*)(lds + TBL); LAS const int* tokt = (LAS const int*)(lds + TOK);
        int R0, C0, R1, C1; { const int tz = ltid(); stage_rc(tz * 16, R0, C0); stage_rc(tz * 16 + 8192, R1, C1); }
        const int rb = __builtin_amdgcn_readfirstlane(tbl[i * 2]), ep = __builtin_amdgcn_readfirstlane(tbl[i * 2 + 1]), e = ep >> 4; u.pn = ep & 15; u.pm = rb; u.aux = e;
        u.Bp = W + (size_t)e * WSTRIDE + (size_t)u.pn * BM * KK * 2;
        if (GATHER) {
            const unsigned t00 = tokt[i * 256 + R0], t01 = tokt[i * 256 + R1], t10 = tokt[i * 256 + HALF + R0], t11 = tokt[i * 256 + HALF + R1];
            put_offs(lds, i, (t00 * LDA + C0) * 2u, (t01 * LDA + C1) * 2u, (t10 * LDA + C0) * 2u, (t11 * LDA + C1) * 2u);
        } else {
            put_offs(lds, i, ((unsigned)(rb + R0) * LDA + C0) * 2u, ((unsigned)(rb + R1) * LDA + C1) * 2u, ((unsigned)(rb + HALF + R0) * LDA + C0) * 2u, ((unsigned)(rb + HALF + R1) * LDA + C1) * 2u);
        }
        return true;
    }
};

struct EpiProj {
    static constexpr bool PERM = true, F8 = false; static constexpr int SA = 0, SB = 0; bf16_t* O;
    __device__ __forceinline__ bool keep(const Unit&) const { return false; }
    __device__ __forceinline__ void operator()(f32x4 (&acc)[2][2][4][2], const Unit& u, int wr, int wc, int fr, int fq) const {
        const int row0 = u.pm * BM + wr * 64 + fr, col0 = u.pn * BM + wc * 32 + 8 * fq;
#pragma unroll
        for (int ai = 0; ai < 2; ++ai)
#pragma unroll
            for (int m = 0; m < 4; ++m) { bf16_t* rowp = O + (size_t)(row0 + ai * HALF + m * 16) * PW + col0;
#pragma unroll
                for (int bj = 0; bj < 2; ++bj) { const f32x4 v0 = acc[ai][bj][m][0], v1 = acc[ai][bj][m][1]; u32x4 w;
                    w.x = cvt_pk_bf16(v0[0], v0[1]); w.y = cvt_pk_bf16(v0[2], v0[3]); w.z = cvt_pk_bf16(v1[0], v1[1]); w.w = cvt_pk_bf16(v1[2], v1[3]);
                    *(u32x4*)(rowp + bj * HALF) = w; } }
    }
};
struct EpiMerge {
    static constexpr bool PERM = true, F8 = false; static constexpr int SA = 0, SB = 0; const bf16_t* proj; bf16_t* O;
    __device__ __forceinline__ bool keep(const Unit& u) const { return u.aux == 0; }
    __device__ __forceinline__ void operator()(f32x4 (&acc)[2][2][4][2], const Unit& u, int wr, int wc, int fr, int fq) const {
        const int row0 = u.pm * BM + wr * 64 + fr, col0 = u.pn * BM + wc * 32 + 8 * fq;
#pragma unroll
        for (int ai = 0; ai < 2; ++ai)
#pragma unroll
            for (int m = 0; m < 4; ++m) { const size_t r = (size_t)(row0 + ai * HALF + m * 16);
#pragma unroll
                for (int bj = 0; bj < 2; ++bj) {
                    const u32x4 gb = *(const u32x4*)(proj + r * PW + C_MGB + col0 + bj * HALF);
                    const f32x4 eb0 = {__expf(-bflo(gb.x)), __expf(-bfhi(gb.x)), __expf(-bflo(gb.y)), __expf(-bfhi(gb.y))};
                    const f32x4 eb1 = {__expf(-bflo(gb.z)), __expf(-bfhi(gb.z)), __expf(-bflo(gb.w)), __expf(-bfhi(gb.w))};
                    if (u.aux == 0) {
                        const u32x4 ga = *(const u32x4*)(proj + r * PW + C_MGA + col0 + bj * HALF);
                        const f32x4 ea0 = {__expf(-bflo(ga.x)), __expf(-bfhi(ga.x)), __expf(-bflo(ga.y)), __expf(-bfhi(ga.y))};
                        const f32x4 ea1 = {__expf(-bflo(ga.z)), __expf(-bfhi(ga.z)), __expf(-bflo(ga.w)), __expf(-bfhi(ga.w))};
#pragma unroll
                        for (int j = 0; j < 4; ++j) { acc[ai][bj][m][0][j] *= (1.f + eb0[j]) * rcpf_(1.f + ea0[j]); acc[ai][bj][m][1][j] *= (1.f + eb1[j]) * rcpf_(1.f + ea1[j]); }
                    } else {
                        f32x4 v0 = acc[ai][bj][m][0], v1 = acc[ai][bj][m][1];
#pragma unroll
                        for (int j = 0; j < 4; ++j) { v0[j] *= rcpf_(1.f + eb0[j]); v1[j] *= rcpf_(1.f + eb1[j]); }
                        u32x4 w; w.x = cvt_pk_bf16(v0[0], v0[1]); w.y = cvt_pk_bf16(v0[2], v0[3]); w.z = cvt_pk_bf16(v1[0], v1[1]); w.w = cvt_pk_bf16(v1[2], v1[3]);
                        *(u32x4*)(O + r * D + col0 + bj * HALF) = w;
                    } } }
    }
};
struct EpiResid {
    static constexpr bool PERM = false, F8 = false; static constexpr int SA = 0, SB = 0; const float* x; const float* gt; float* O;
    __device__ __forceinline__ bool keep(const Unit&) const { return false; }
    __device__ __forceinline__ void operator()(f32x4 (&acc)[2][2][4][2], const Unit& u, int wr, int wc, int fr, int fq) const {
        const int row0 = u.pm * BM + wr * 64 + fr, col0 = u.pn * BM + wc * 32 + 4 * fq;
        f32x4 g[2][2];
#pragma unroll
        for (int bj = 0; bj < 2; ++bj)
#pragma unroll
            for (int n = 0; n < 2; ++n) g[bj][n] = *(const f32x4*)(gt + col0 + bj * HALF + n * 16);
#pragma unroll
        for (int ai = 0; ai < 2; ++ai)
#pragma unroll
            for (int m = 0; m < 4; ++m) { const size_t ro = (size_t)(row0 + ai * HALF + m * 16) * D + col0;
#pragma unroll
                for (int bj = 0; bj < 2; ++bj)
#pragma unroll
                    for (int n = 0; n < 2; ++n) { const f32x4 xv = *(const f32x4*)(x + ro + bj * HALF + n * 16); *(f32x4*)(O + ro + bj * HALF + n * 16) = xv + g[bj][n] * acc[ai][bj][m][n]; } }
    }
};
struct EpiSwiglu {
    static constexpr bool PERM = true, F8 = true; static constexpr int SA = 0x7d7d7d7d, SB = 0x79797979; unsigned char* hid;
    __device__ __forceinline__ bool keep(const Unit&) const { return false; }
    __device__ __forceinline__ void operator()(f32x4 (&acc)[2][2][4][2], const Unit& u, int wr, int wc, int fr, int fq) const {
        const int row0 = u.pm + wr * 64 + fr, j0 = u.pn * 128 + wc * 16 + 4 * fq;
#pragma unroll
        for (int ai = 0; ai < 2; ++ai)
#pragma unroll
            for (int m = 0; m < 4; ++m) { unsigned char* rowp = hid + (unsigned)((row0 + ai * HALF + m * 16) * FF + j0);
#pragma unroll
                for (int bj = 0; bj < 2; ++bj) { const f32x4 g = acc[ai][bj][m][0], up = acc[ai][bj][m][1];
                    *(unsigned*)(rowp + bj * 64) = cvt4_fp8(8.f * siluf_(g[0]) * up[0], 8.f * siluf_(g[1]) * up[1], 8.f * siluf_(g[2]) * up[2], 8.f * siluf_(g[3]) * up[3]); }
                asm volatile("" ::: "memory"); __builtin_amdgcn_sched_barrier(0); }
    }
};
struct EpiDown {
    static constexpr bool PERM = true, F8 = true; static constexpr int SA = 0x7c7c7c7c, SB = 0x7a7a7a7a; unsigned char* Y; const float* w_p;
    __device__ __forceinline__ bool keep(const Unit&) const { return false; }
    __device__ __forceinline__ void operator()(f32x4 (&acc)[2][2][4][2], const Unit& u, int wr, int wc, int fr, int fq) const {
        const int row0 = u.pm + wr * 64 + fr, col0 = u.pn * BM + wc * 32 + 8 * fq;
#pragma unroll
        for (int ai = 0; ai < 2; ++ai)
#pragma unroll
            for (int m = 0; m < 4; ++m) { const int r = row0 + ai * HALF + m * 16; const float wt = w_p[(unsigned)r] * 16.f; unsigned char* rowp = Y + ((unsigned)r * D + col0);
#pragma unroll
                for (int bj = 0; bj < 2; ++bj) { const f32x4 v0 = acc[ai][bj][m][0] * wt, v1 = acc[ai][bj][m][1] * wt;
                    *(u32x2*)(rowp + bj * HALF) = (u32x2){cvt4_fp8(v0[0], v0[1], v0[2], v0[3]), cvt4_fp8(v1[0], v1[1], v1[2], v1[3])}; }
                asm volatile("" ::: "memory"); __builtin_amdgcn_sched_barrier(0); }
    }
};
}

struct Ctx {
    const float *x, *c, *w_ada, *b_ada, *norm1_g, *norm2_g, *w_in, *lb_table, *hgrn_onorm_g, *conv_w, *a_log, *dt_bias, *gdn_onorm_g, *w_bh, *w_bg, *w_out, *w_router, *router_bias,
        *w_eg, *w_eu, *w_ed, *w_sg, *w_su, *w_sd, *normf_g;
    float* out;
    unsigned* bar;
    float *modp, *mod, *lb, *gab;
    int *idx, *cnt, *tok_p, *pos, *blk_row, *blk_exp, *nent;
    float *wts, *w_p;
    bf16_t *win_t, *wa_t, *wb_t, *wout_t, *h1, *proj, *ocat, *merged;
    float *gq, *gk, *gv, *gbeta, *gdec, *oa, *ob;
    float *hL, *hS, *hD;
    float *gAT, *gB, *gS; unsigned char *gBlob, *gM;
    unsigned char *dn_t, *hid, *gu_t, *h2, *Y;
    bf16_t* rwimg; float* rbias2; int *tile_cnt, *rnk;
};

typedef const __attribute__((address_space(4))) Ctx CtxK;

__device__ __forceinline__ void cvt_tile(LAS float* t, const float* srcA, const float* srcB, int ld, int mode, bf16_t* dst, int ldd) {
    const int tid = ltid(), kr = tid >> 6, cl = tid & 63;
    const float* sp = (mode == 1 && cl >= 32) ? (srcB + cl - 32) : (srcA + cl);
    float v[8];
#pragma unroll
    for (int p = 0; p < 8; ++p) v[p] = sp[(size_t)(p * 8 + kr) * ld];
    __syncthreads();
#pragma unroll
    for (int p = 0; p < 8; ++p) t[(p * 8 + kr) * 65 + cl] = v[p];
    __syncthreads();
    const int r = tid >> 3, seg = (tid & 7) * 8;
    const int lc = mode == 1 ? (((r >> 2) & 1) * 32 + 4 * (r >> 3) + (r & 3)) : r;
    float w[8];
#pragma unroll
    for (int j = 0; j < 8; ++j) w[j] = t[(seg + j) * 65 + lc];
    u32x4 o; o.x = cvt_pk_bf16(w[0], w[1]); o.y = cvt_pk_bf16(w[2], w[3]); o.z = cvt_pk_bf16(w[4], w[5]); o.w = cvt_pk_bf16(w[6], w[7]);
    *(u32x4*)(dst + (size_t)r * ldd + seg) = o;
}
__device__ __forceinline__ void cvt_tile8(LAS float* t, const float* srcA, const float* srcB, int ld, int mode, unsigned char* dst, int ldd, float scale) {
    const int tid = ltid(), kr = tid >> 6, cl = tid & 63;
    const float* sp = (mode == 1 && cl >= 32) ? (srcB + cl - 32) : (srcA + cl);
    float v[8];
#pragma unroll
    for (int p = 0; p < 8; ++p) v[p] = sp[(size_t)(p * 8 + kr) * ld];
    __syncthreads();
#pragma unroll
    for (int p = 0; p < 8; ++p) t[(p * 8 + kr) * 65 + cl] = v[p] * scale;
    __syncthreads();
    const int r = tid >> 3, seg = (tid & 7) * 8;
    const int lc = mode == 1 ? (((r >> 2) & 1) * 32 + 4 * (r >> 3) + (r & 3)) : r;
    float w[8];
#pragma unroll
    for (int j = 0; j < 8; ++j) w[j] = t[(seg + j) * 65 + lc];
    *(u32x2*)(dst + (size_t)r * ldd + seg) = (u32x2){cvt4_fp8(w[0], w[1], w[2], w[3]), cvt4_fp8(w[4], w[5], w[6], w[7])};
}
__device__ __forceinline__ void cvt_job(LAS float* t, int tile, const float* src, int ld, int K, bf16_t* dst) {
    const int nkt = K / 64, nt = tile / nkt, kt = tile % nkt;
    cvt_tile(t, src + (size_t)kt * 64 * ld + nt * 64, nullptr, ld, 0, dst + (size_t)nt * 64 * K + kt * 64, K);
}

__device__ void ph_pro1(CtxK& c, LAS unsigned char* lds) {
    const int tid = ltid(), wg = blockIdx.x, G = gridDim.x;
    LAS float* lf = (LAS float*)lds;
    for (int job = wg; job < 192; job += G) {
        const int cc = job % 48, kp = job / 48, q = tid & 63, rg = tid >> 6;
        f32x4 a = {0.f, 0.f, 0.f, 0.f};
        for (int r = rg; r < 512; r += 8) { const int k = kp * 512 + r; const float s = siluf_(c.c[k]); a += s * *(const f32x4*)(c.w_ada + (size_t)k * (6 * D) + cc * 256 + q * 4); }
        __syncthreads();
        *(LAS f32x4*)(lf + (rg * 64 + q) * 4) = a;
        __syncthreads();
        if (tid < 64) { f32x4 s = {0.f, 0.f, 0.f, 0.f};
#pragma unroll
            for (int g = 0; g < 8; ++g) s += *(LAS f32x4*)(lf + (g * 64 + tid) * 4);
            *(f32x4*)(c.modp + (size_t)kp * (6 * D) + cc * 256 + tid * 4) = s; }
    }
    if (wg == G - 1) for (int j = tid; j < 1024; j += 512) c.lb[j] = 1.f / (1.f + expf(c.lb_table[1024 + j] - c.lb_table[j]));
    for (int T = wg; T < 8192; T += G) {
        if (T < 6144) { const int nt = T / 32, kt = T % 32; const int sc = nt * 64 + (nt * 64 >= WIN_GAB ? 16 : 0);
            cvt_tile(lf, c.w_in + (size_t)kt * 64 * INW + sc, nullptr, INW, 0, c.win_t + (size_t)nt * 64 * D + kt * 64, D); }
        else if (T < 6656) cvt_job(lf, T - 6144, c.w_bh, D, 1024, c.wa_t);
        else if (T < 7168) cvt_job(lf, T - 6656, c.w_bg, D, 1024, c.wb_t);
        else cvt_job(lf, T - 7168, c.w_out, D, 2048, c.wout_t);
    }
}
__device__ void ph_norm1(CtxK& c, LAS unsigned char* lds) {
    const int tid = ltid(), wg = blockIdx.x, G = gridDim.x, lane = tid & 63, wv = tid >> 6;
    LAS float* la = (LAS float*)lds;
    LAS float* lb_ = la + D;
    LAS float* lw = lb_ + D;
    for (int j = tid; j < D; j += 512) {
        float sh = c.b_ada[j], sc = c.b_ada[D + j];
#pragma unroll
        for (int p = 0; p < 4; ++p) { sh += c.modp[(size_t)p * 6 * D + j]; sc += c.modp[(size_t)p * 6 * D + D + j]; }
        la[j] = c.norm1_g[j] * (1.f + sc); lb_[j] = sh;
    }
    for (int j = wg * 512 + tid; j < 6 * D; j += G * 512) { float m = c.b_ada[j];
#pragma unroll
        for (int p = 0; p < 4; ++p) m += c.modp[(size_t)p * 6 * D + j];
        c.mod[j] = m; }
    for (int i = tid; i < D * 4; i += 512) { const int e = i >> 2, q = i & 3; const f32x4 w = *(const f32x4*)(c.w_in + (size_t)e * INW + WIN_GAB + q * 4);
        lw[(q * 4 + 0) * D + e] = w[0]; lw[(q * 4 + 1) * D + e] = w[1]; lw[(q * 4 + 2) * D + e] = w[2]; lw[(q * 4 + 3) * D + e] = w[3]; }
    __syncthreads();
    f32x4 vn[8];
    { const float* xr = c.x + (size_t)(wg * 8 + wv) * D;
#pragma unroll
      for (int i = 0; i < 8; ++i) vn[i] = *(const f32x4*)(xr + i * 256 + lane * 4); }
    for (int row = wg * 8 + wv; row < S; row += G * 8) {
        f32x4 v[8]; float ss = 0.f;
#pragma unroll
        for (int i = 0; i < 8; ++i) { v[i] = vn[i]; ss += v[i][0] * v[i][0] + v[i][1] * v[i][1] + v[i][2] * v[i][2] + v[i][3] * v[i][3]; }
        if (row + G * 8 < S) { const float* xr = c.x + (size_t)(row + G * 8) * D;
#pragma unroll
            for (int i = 0; i < 8; ++i) vn[i] = *(const f32x4*)(xr + i * 256 + lane * 4); }
        ss = wave_sum(ss); const float r = rsqrtf(ss * (1.f / D) + 1e-6f);
#pragma unroll
        for (int i = 0; i < 8; ++i) { const int e = i * 256 + lane * 4; const f32x4 a = *(LAS f32x4*)(la + e), b = *(LAS f32x4*)(lb_ + e); v[i] = v[i] * r * a + b;
            u32x2 w; w.x = cvt_pk_bf16(v[i][0], v[i][1]); w.y = cvt_pk_bf16(v[i][2], v[i][3]); *(u32x2*)(c.h1 + (size_t)row * D + e) = w; }
        float mine = 0.f;
        for (int cc = 0; cc < 16; ++cc) { float d = 0.f;
#pragma unroll
            for (int i = 0; i < 8; ++i) { const f32x4 w = *(LAS f32x4*)(lw + cc * D + i * 256 + lane * 4); d += v[i][0] * w[0] + v[i][1] * w[1] + v[i][2] * w[2] + v[i][3] * w[3]; }
            d = wave_sum(d); if (lane == cc) mine = d; }
        if (lane < 16) c.gab[(size_t)row * 16 + lane] = mine;
    }
    { const int id = wg * 512 + tid, i = id >> 6, e = id & 63;
      if (id < D * 64) {
          float sc = c.b_ada[4 * D + i];
#pragma unroll
          for (int p = 0; p < 4; ++p) sc += c.modp[(size_t)p * 6 * D + 4 * D + i];
          const float w = c.norm2_g[i] * (1.f + sc) * c.w_router[id];
          const unsigned hi = cvt_pk_bf16(w, w) & 0xffffu; const float lo = w - __uint_as_float(hi << 16);
          const int ch = i >> 7, kk = i & 127;
          c.rwimg[((ch * 2 + 0) * 64 + e) * 136 + kk] = (bf16_t)hi; c.rwimg[((ch * 2 + 1) * 64 + e) * 136 + kk] = (bf16_t)(cvt_pk_bf16(lo, lo) & 0xffffu);
      } }
    if (wg < 64) {
        __syncthreads();
        float a = 0.f;
        for (int i = tid; i < D; i += 512) { float sh = c.b_ada[3 * D + i];
#pragma unroll
            for (int p = 0; p < 4; ++p) sh += c.modp[(size_t)p * 6 * D + 3 * D + i];
            a += sh * c.w_router[i * 64 + wg]; }
        a = wave_sum(a); if (lane == 0) la[wv] = a; __syncthreads();
        if (tid == 0) c.rbias2[wg] = la[0] + la[1] + la[2] + la[3] + la[4] + la[5] + la[6] + la[7];
    }
}
__device__ void ph_gemm1(CtxK& c, LAS unsigned char* lds) {
    gm::DenseSched Sd; Sd.init(S, PW, D, D, c.win_t, nullptr, 1); gm::EpiProj E{c.proj};
    gm::gphase(lds, (const char*)c.h1, D, Sd, E);
}
__device__ void ph_gemm2(CtxK& c, LAS unsigned char* lds) {
    gm::DenseSched Sd; Sd.init(S, D, 1024, 2048, c.wa_t, c.wb_t, 2); gm::EpiMerge E{c.proj, c.merged};
    gm::gphase(lds, (const char*)c.ocat, 1024, Sd, E);
}
__device__ void ph_gemm3(CtxK& c, LAS unsigned char* lds) {
    gm::DenseSched Sd; Sd.init(S, D, D, D, c.wout_t, nullptr, 1); gm::EpiResid E{c.x, c.mod + 2 * D, c.out};
    gm::gphase(lds, (const char*)c.merged, D, Sd, E);
}
__device__ void ph_moe_gu(CtxK& c, LAS unsigned char* lds) {
    gm::MoeSched<true, 4, D / 2, D / 2, (size_t)1024 * D> Sm; Sm.init(lds, c.nent, c.blk_row, c.blk_exp, c.tok_p, c.gu_t); gm::EpiSwiglu E{c.hid};
    gm::gphase(lds, (const char*)c.h2, D / 2, Sm, E);
}
__device__ void ph_moe_dn(CtxK& c, LAS unsigned char* lds) {
    gm::MoeSched<false, 8, FF / 2, FF / 2, (size_t)D * FF> Sm; Sm.init(lds, c.nent, c.blk_row, c.blk_exp, c.tok_p, c.dn_t); gm::EpiDown E{c.Y, c.w_p};
    gm::gphase(lds, (const char*)c.hid, FF / 2, Sm, E);
}
__device__ void ph_cvt_exp(CtxK& c, LAS unsigned char* lds) {
    LAS float* lf = (LAS float*)lds; const int wg = blockIdx.x - 8, G = gridDim.x - 8;
    if (wg < 0) return;
    constexpr int GU_T = 16 * 32, DN_T = 32 * 8;
    for (int T = wg; T < NEX * (GU_T + DN_T); T += G) {
        if (T < NEX * GU_T) { const int e = T / GU_T, r = T % GU_T, nt = r / 32, kt = r % 32;
            const float* sg = e < NE ? c.w_eg + (size_t)e * D * FF : c.w_sg; const float* su = e < NE ? c.w_eu + (size_t)e * D * FF : c.w_su;
            cvt_tile8(lf, sg + (size_t)kt * 64 * FF + nt * 32, su + (size_t)kt * 64 * FF + nt * 32, FF, 1, c.gu_t + ((size_t)e * 1024 + nt * 64) * D + kt * 64, D, 64.f); }
        else { const int T2 = T - NEX * GU_T, e = T2 / DN_T, r = T2 % DN_T; const float* sd = e < NE ? c.w_ed + (size_t)e * FF * D : c.w_sd;
            { const int nkt = FF / 64, nt = r / nkt, kt = r % nkt; cvt_tile8(lf, sd + (size_t)kt * 64 * D + nt * 64, nullptr, D, 0, c.dn_t + (size_t)e * D * FF + (size_t)nt * 64 * FF + kt * 64, FF, 32.f); } }
    }
}
__device__ void ph_final(CtxK& c, LAS unsigned char* lds) {
    const int tid = ltid(), wg = blockIdx.x, G = gridDim.x, lane = tid & 63, wv = tid >> 6;
    const float* gt2 = c.mod + 5 * D;
    for (int row0 = (wg * 8 + wv) * 2; row0 < S; row0 += G * 16) {
        int p[2][9];
#pragma unroll
        for (int rr = 0; rr < 2; ++rr) {
#pragma unroll
            for (int k = 0; k < 8; ++k) p[rr][k] = c.pos[(row0 + rr) * TOPK + k];
            p[rr][8] = PROUTED + row0 + rr; }
        f32x4 v[2][4][2]; float ss[2] = {0.f, 0.f};
#pragma unroll
        for (int rr = 0; rr < 2; ++rr) {
#pragma unroll
            for (int i = 0; i < 4; ++i) {
                const int e = i * 512 + lane * 8; f32x4 a0 = {0.f, 0.f, 0.f, 0.f}, a1 = {0.f, 0.f, 0.f, 0.f};
#pragma unroll
                for (int k = 0; k < 9; ++k) { const u32x2 y = *(const u32x2*)(c.Y + (size_t)p[rr][k] * D + e);
                    const auto q0 = __builtin_amdgcn_cvt_pk_f32_fp8((int)y.x, false), q1 = __builtin_amdgcn_cvt_pk_f32_fp8((int)y.x, true), q2 = __builtin_amdgcn_cvt_pk_f32_fp8((int)y.y, false), q3 = __builtin_amdgcn_cvt_pk_f32_fp8((int)y.y, true);
                    a0[0] += q0[0]; a0[1] += q0[1]; a0[2] += q1[0]; a0[3] += q1[1]; a1[0] += q2[0]; a1[1] += q2[1]; a1[2] += q3[0]; a1[3] += q3[1]; }
                const float* xp = c.out + (size_t)(row0 + rr) * D + e;
                const f32x4 x0 = *(const f32x4*)xp, x1 = *(const f32x4*)(xp + 4), g0 = *(const f32x4*)(gt2 + e) * 0.0625f, g1 = *(const f32x4*)(gt2 + e + 4) * 0.0625f;
                v[rr][i][0] = x0 + g0 * a0; v[rr][i][1] = x1 + g1 * a1;
#pragma unroll
                for (int j = 0; j < 4; ++j) ss[rr] += v[rr][i][0][j] * v[rr][i][0][j] + v[rr][i][1][j] * v[rr][i][1][j];
            } }
#pragma unroll
        for (int rr = 0; rr < 2; ++rr) {
            const float r = rsqrtf(wave_sum_dpp(ss[rr]) * (1.f / D) + 1e-6f);
#pragma unroll
            for (int i = 0; i < 4; ++i) { const int e = i * 512 + lane * 8; float* op = c.out + (size_t)(row0 + rr) * D + e;
                *(f32x4*)op = v[rr][i][0] * r * *(const f32x4*)(c.normf_g + e); *(f32x4*)(op + 4) = v[rr][i][1] * r * *(const f32x4*)(c.normf_g + e + 4); } }
    }
}

namespace mx {
constexpr int ST128 = 272, ST64 = 144;
constexpr int FRAG_F4 = 8 * 8 * 64;
__device__ __forceinline__ f32x4 mfma16(bf16x8 a, bf16x8 b, f32x4 c) { return __builtin_amdgcn_mfma_f32_16x16x32_bf16(a, b, c, 0, 0, 0); }
template <int MT, int KS>
__device__ __forceinline__ void mma_nt(f32x4 (&acc)[MT], LAS const unsigned char* xs, int sx, LAS const unsigned char* ys, int sy, int fr, int fq) {
#pragma unroll
    for (int kk = 0; kk < KS; ++kk) {
        const bf16x8 b = *(const LAS bf16x8*)(ys + fr * sy + (kk * 32 + fq * 8) * 2);
#pragma unroll
        for (int m = 0; m < MT; ++m) { const bf16x8 a = *(const LAS bf16x8*)(xs + (16 * m + fr) * sx + (kk * 32 + fq * 8) * 2); acc[m] = mfma16(a, b, acc[m]); }
    }
}
__device__ __forceinline__ void lds_fence() { asm volatile("s_waitcnt lgkmcnt(0)" ::: "memory"); }
__device__ __forceinline__ u32x4 pack8(const float (&v)[8]) { u32x4 o; o.x = cvt_pk_bf16(v[0], v[1]); o.y = cvt_pk_bf16(v[2], v[3]); o.z = cvt_pk_bf16(v[4], v[5]); o.w = cvt_pk_bf16(v[6], v[7]); return o; }
__device__ __forceinline__ void unpack8(const u32x4 w, float (&v)[8]) { v[0] = bflo(w.x); v[1] = bfhi(w.x); v[2] = bflo(w.y); v[3] = bfhi(w.y); v[4] = bflo(w.z); v[5] = bfhi(w.z); v[6] = bflo(w.w); v[7] = bfhi(w.w); }
__device__ __forceinline__ void mfma_pad8(f32x4 (&a)[8]) { asm volatile("s_nop 15\n\ts_nop 7" : "+v"(a[0]), "+v"(a[1]), "+v"(a[2]), "+v"(a[3]), "+v"(a[4]), "+v"(a[5]), "+v"(a[6]), "+v"(a[7])); }
__device__ __forceinline__ void mfma_pad4(f32x4 (&a)[4]) { asm volatile("s_nop 15\n\ts_nop 7" : "+v"(a[0]), "+v"(a[1]), "+v"(a[2]), "+v"(a[3])); }
__device__ __forceinline__ void write_st(LAS unsigned char* stw, f32x4 (&S)[8], int fr, int fq) {
    mfma_pad8(S);
#pragma unroll
    for (int m = 0; m < 8; ++m) { u32x2 w; w.x = cvt_pk_bf16(S[m][0], S[m][1]); w.y = cvt_pk_bf16(S[m][2], S[m][3]); *(LAS u32x2*)(stw + fr * ST128 + (16 * m + 4 * fq) * 2) = w; }
}

__device__ __forceinline__ void gate_issue(u32x4 (&gp)[2], const bf16_t* gate0) {
    const int t_ = ltid(); const bf16_t* p = gate0 + (size_t)(t_ >> 3) * PW + (t_ & 7) * 16;
    gp[0] = *(const u32x4*)p; gp[1] = *(const u32x4*)(p + 8);
}
__device__ __forceinline__ void out_stage(LAS unsigned char* ot, LAS float* part, const f32x4 (&o)[4], const u32x4 (&gp)[2], const float* gnorm, bf16_t* out0, int wv, int lane, int fr, int fq) {
    float s_ = 0.f;
#pragma unroll
    for (int w = 0; w < 8; ++w) s_ += part[w * 64 + lane];
    const float rv = rsqrtf(s_ * (1.f / 128.f) + 1e-6f);
    const float gn = gnorm[wv * 16 + fr];
#pragma unroll
    for (int m = 0; m < 4; ++m)
#pragma unroll
        for (int r = 0; r < 4; ++r) { const int cc = 16 * m + 4 * fq + r; const float x = o[m][r] * __shfl(rv, cc) * gn;
            *(LAS bf16_t*)(ot + cc * ST128 + (wv * 16 + fr) * 2) = (bf16_t)(cvt_pk_bf16(x, x) & 0xffffu); }
    __syncthreads();
    const int t_ = ltid(), cc = t_ >> 3, sg = (t_ & 7) * 16;
#pragma unroll
    for (int hh = 0; hh < 2; ++hh) { float ov[8], gv[8];
        unpack8(*(LAS u32x4*)(ot + cc * ST128 + (sg + hh * 8) * 2), ov); unpack8(gp[hh], gv);
#pragma unroll
        for (int j = 0; j < 8; ++j) ov[j] *= siluf_(gv[j]);
        *(u32x4*)(out0 + (size_t)cc * D + sg + hh * 8) = pack8(ov); }
}

constexpr int H_QT = 0, H_KT = 17408, H_QI = 34816, H_KU = 52224, H_VT = 70656, H_P = 89088, H_DEC = 98304, H_OCT = 98816, H_F4 = 102912, H_PART = 103424, H_RINV = 105472, H_ST = 105728, H_LB = H_ST + 8 * 16 * ST128, H_END = H_LB + 512;
static_assert(H_END <= 147456, "hgrn lds");
template <bool OUT>
__device__ void hgrn_pass(CtxK& c, LAS unsigned char* lds) {
    const int tid = ltid(), wv = __builtin_amdgcn_readfirstlane(tid >> 6), lane = tid & 63, fr = lane & 15, fq = lane >> 4;
    LAS float* dec = (LAS float*)(lds + H_DEC); LAS float* oct = (LAS float*)(lds + H_OCT); LAS float* f4 = (LAS float*)(lds + H_F4);
    LAS float* part = (LAS float*)(lds + H_PART); LAS float* rinv = (LAS float*)(lds + H_RINV);
    LAS unsigned char* stw = lds + H_ST + wv * 16 * ST128;
    {
        const int wu = blockIdx.x, h = wu & 7, g = wu >> 3;
        f32x4 Sacc[8];
#pragma unroll
        for (int m = 0; m < 8; ++m) Sacc[m] = (f32x4){0.f, 0.f, 0.f, 0.f};
        if (OUT) {
            if (g > 0) { const f32x4* sp = (const f32x4*)c.hS + (size_t)(h * 32 + g) * FRAG_F4 + (wv * 8) * 64 + lane;
#pragma unroll
                for (int m = 0; m < 8; ++m) Sacc[m] = sp[m * 64]; }
            write_st(stw, Sacc, fr, fq);
        }
        LAS float* lbs = (LAS float*)(lds + H_LB);
        if (tid < 128) lbs[tid] = c.lb[h * 128 + tid];
        __syncthreads();
        float dsum = 0.f;
        u32x4 pf[8];
#define HP_ISSUE(i_) do { const int tq_ = ltid(), gq_ = tq_ >> 7; if (gq_ < 3 && (OUT || gq_ > 0)) { const bf16_t* b_ = c.proj + (size_t)((g * 8 + (i_)) * 64 + ((tq_ >> 4) & 7) * 8) * PW + h * 128 + (tq_ & 15) * 8 + (gq_ == 1 ? C_HI : C_HF); \
        _Pragma("unroll") for (int tt = 0; tt < 8; ++tt) pf[tt] = *(const u32x4*)(b_ + (size_t)tt * PW); } } while (0)
        HP_ISSUE(0);
        for (int i = 0; i < 8; ++i) {
            const int T0 = (g * 8 + i) * 64;
            const int tp = ltid(), grp = tp >> 7, to = (tp >> 4) & 7, co = tp & 15, c0 = to * 8, d0 = co * 8;
            const bool cum = grp == 2 || (OUT && grp == 0);
            float cs[8][8];
            if (cum) {
                float lbv[8];
                { const f32x4 l0 = *(LAS f32x4*)(lbs + d0), l1 = *(LAS f32x4*)(lbs + d0 + 4);
                  lbv[0] = l0[0]; lbv[1] = l0[1]; lbv[2] = l0[2]; lbv[3] = l0[3]; lbv[4] = l1[0]; lbv[5] = l1[1]; lbv[6] = l1[2]; lbv[7] = l1[3]; }
#pragma unroll
                for (int tt = 0; tt < 8; ++tt) {
                    float fv[8]; unpack8(pf[tt], fv);
#pragma unroll
                    for (int j = 0; j < 8; ++j) { const float lf = __logf(lbv[j] + (1.f - lbv[j]) * sigmoidf_(fv[j])); cs[tt][j] = tt ? cs[tt - 1][j] + lf : lf; }
                }
                if (grp == 2) {
#pragma unroll
                    for (int j = 0; j < 8; ++j) { oct[to * 128 + d0 + j] = cs[7][j]; if (to == 4) f4[d0 + j] = cs[0][j]; }
                }
            }
            __syncthreads();
            if (cum) {
                float pre[8], tot[8], bmid[8];
#pragma unroll
                for (int j = 0; j < 8; ++j) { float p = 0.f, t_ = 0.f, bm = 0.f;
#pragma unroll
                    for (int o = 0; o < 8; ++o) { const float x = oct[o * 128 + d0 + j]; p += o < to ? x : 0.f; bm += o < 4 ? x : 0.f; t_ += x; }
                    pre[j] = p; tot[j] = t_; bmid[j] = bm + f4[d0 + j]; }
                if (grp == 0) {
                    float ebm[8];
#pragma unroll
                    for (int j = 0; j < 8; ++j) ebm[j] = __expf(bmid[j]);
#pragma unroll
                    for (int tt = 0; tt < 8; ++tt) {
                        float qv[8], q1[8], q2[8];
                        unpack8(*(const u32x4*)(c.proj + (size_t)(T0 + c0 + tt) * PW + C_HQ + h * 128 + d0), qv);
#pragma unroll
                        for (int j = 0; j < 8; ++j) { const float q = siluf_(qv[j]) * 0.08838834764831845f; q1[j] = q * __expf(pre[j] + cs[tt][j] - bmid[j]); q2[j] = q1[j] * ebm[j]; }
                        *(LAS u32x4*)(lds + H_QT + (c0 + tt) * ST128 + d0 * 2) = pack8(q1); *(LAS u32x4*)(lds + H_QI + (c0 + tt) * ST128 + d0 * 2) = pack8(q2);
                    }
                } else {
                    if (to == 0) {
#pragma unroll
                        for (int j = 0; j < 8; ++j) dec[d0 + j] = __expf(tot[j]);
                    }
                    if (OUT) {
#pragma unroll
                        for (int tt = 0; tt < 8; ++tt) {
                            float k1[8];
#pragma unroll
                            for (int j = 0; j < 8; ++j) { const float lf = tt ? cs[tt][j] - cs[tt - 1][j] : cs[0][j]; k1[j] = (1.f - __expf(lf)) * __expf(bmid[j] - pre[j] - cs[tt][j]); }
                            *(LAS u32x4*)(lds + H_KT + (c0 + tt) * ST128 + d0 * 2) = pack8(k1);
                        }
                    }
#pragma unroll
                    for (int j = 0; j < 8; ++j) { float col[8];
#pragma unroll
                        for (int tt = 0; tt < 8; ++tt) { const float lf = tt ? cs[tt][j] - cs[tt - 1][j] : cs[0][j]; col[tt] = (1.f - __expf(lf)) * __expf(tot[j] - pre[j] - cs[tt][j]); }
                        *(LAS u32x4*)(lds + H_KU + (d0 + j) * ST64 + c0 * 2) = pack8(col); }
                }
            } else if (grp == 1) {
                float vb[8][8];
#pragma unroll
                for (int tt = 0; tt < 8; ++tt) unpack8(pf[tt], vb[tt]);
#pragma unroll
                for (int j = 0; j < 8; ++j) { float col[8];
#pragma unroll
                    for (int tt = 0; tt < 8; ++tt) col[tt] = vb[tt][j];
                    *(LAS u32x4*)(lds + H_VT + (d0 + j) * ST64 + c0 * 2) = pack8(col); }
            }
            __syncthreads();
            if (i + 1 < 8) HP_ISSUE(i + 1);
            u32x4 gpre[2];
            if (OUT) gate_issue(gpre, c.proj + (size_t)T0 * PW + C_HG + h * 128);
            if (!OUT && tid < 128) dsum += __logf(dec[tid]);
            f32x4 oacc[4];
            if (OUT) {
                { f32x4 sc[2] = {(f32x4){0.f, 0.f, 0.f, 0.f}, (f32x4){0.f, 0.f, 0.f, 0.f}};
                  const int nt = wv & 3, mb = (wv >> 2) * 2;
                  mma_nt<2, 4>(sc, lds + H_KT + mb * 16 * ST128, ST128, lds + H_QT + nt * 16 * ST128, ST128, fr, fq);
#pragma unroll
                  for (int m = 0; m < 2; ++m) { const int cc = nt * 16 + fr, s0 = (mb + m) * 16 + 4 * fq; u32x2 w;
                      w.x = cvt_pk_bf16(s0 + 0 <= cc ? sc[m][0] : 0.f, s0 + 1 <= cc ? sc[m][1] : 0.f); w.y = cvt_pk_bf16(s0 + 2 <= cc ? sc[m][2] : 0.f, s0 + 3 <= cc ? sc[m][3] : 0.f);
                      *(LAS u32x2*)(lds + H_P + cc * ST64 + s0 * 2) = w; } }
                __syncthreads();
#pragma unroll
                for (int m = 0; m < 4; ++m) oacc[m] = (f32x4){0.f, 0.f, 0.f, 0.f};
                mma_nt<4, 2>(oacc, lds + H_P, ST64, lds + H_VT + wv * 16 * ST64, ST64, fr, fq);
                mma_nt<4, 4>(oacc, lds + H_QI, ST128, stw, ST128, fr, fq);
#pragma unroll
                for (int m = 0; m < 4; ++m)
#pragma unroll
                    for (int r = 0; r < 4; ++r) { float q = oacc[m][r] * oacc[m][r]; q += __shfl_xor(q, 1); q += __shfl_xor(q, 2); q += __shfl_xor(q, 4); q += __shfl_xor(q, 8); if (fr == 0) part[wv * 64 + 16 * m + 4 * fq + r] = q; }
            }
#pragma unroll
            for (int m = 0; m < 8; ++m) { const f32x4 dv = *(LAS f32x4*)(dec + 16 * m + 4 * fq); Sacc[m] = Sacc[m] * dv; }
            mma_nt<8, 2>(Sacc, lds + H_KU, ST64, lds + H_VT + wv * 16 * ST64, ST64, fr, fq);
            if (OUT) {
                lds_fence();
                write_st(stw, Sacc, fr, fq);
                __syncthreads();
                out_stage(lds + H_QT, part, oacc, gpre, c.hgrn_onorm_g, c.ocat + (size_t)T0 * D + h * 128, wv, lane, fr, fq);
            }
            __syncthreads();
        }
#undef HP_ISSUE
        if (!OUT) {
            f32x4* sp = (f32x4*)c.hL + (size_t)(h * 32 + g) * FRAG_F4 + (wv * 8) * 64 + lane;
#pragma unroll
            for (int m = 0; m < 8; ++m) sp[m * 64] = Sacc[m];
            if (tid < 128) c.hD[(h * 32 + g) * 128 + tid] = __expf(dsum);
        }
    }
}
__device__ void hgrn_scan(CtxK& c) {
    const int e = blockIdx.x * 512 + ltid();
    if (e >= 8 * FRAG_F4) return;
    const int h = e / FRAG_F4, fi = e % FRAG_F4, m = (fi >> 6) & 7, lane = fi & 63, d0 = 16 * m + 4 * (lane >> 4);
    f32x4 s = {0.f, 0.f, 0.f, 0.f};
    for (int g = 0; g < 31; ++g) {
        const f32x4 dc = *(const f32x4*)(c.hD + (h * 32 + g) * 128 + d0);
        s = s * dc + ((const f32x4*)c.hL)[(size_t)(h * 32 + g) * FRAG_F4 + fi];
        ((f32x4*)c.hS)[(size_t)(h * 32 + g + 1) * FRAG_F4 + fi] = s;
    }
}

constexpr int B_T = 0, B_KBG = 9216, B_KU = 26624, B_VB = 45056, B_QD = 63488, B_AT = 80896, B_SC = 90112, BLOB = 90368;
constexpr int G_ST = BLOB, G_RV = G_ST + 8 * 16 * ST128, G_PART = G_RV + 8 * 16 * ST64, G_RINV = G_PART + 2048, G_END = G_RINV + 256;
static_assert(G_END <= 147456, "gdn lds");
constexpr int P_K = 0, P_Q = 17408, P_BETA = 34816, P_GC = P_BETA + 256, P_EG = P_GC + 256, P_EK = P_EG + 256;

__device__ void gdn_prep(CtxK& c, LAS unsigned char* lds, int h, int g) {
    const int tid = ltid(), wv = __builtin_amdgcn_readfirstlane(tid >> 6), lane = tid & 63, fr = lane & 15, fq = lane >> 4;
    LAS float* sbeta = (LAS float*)(lds + P_BETA); LAS float* sgc = (LAS float*)(lds + P_GC); LAS float* seg = (LAS float*)(lds + P_EG); LAS float* sek = (LAS float*)(lds + P_EK);
    for (int i = 0; i < 8; ++i) {
        const int n = g * 8 + i, T0 = n * 64;
        unsigned char* blob = (unsigned char*)c.gBlob + (size_t)(h * 256 + n) * BLOB;
        if (wv == 0) {
            const float ga = c.gab[(size_t)(T0 + lane) * 16 + h], gb = c.gab[(size_t)(T0 + lane) * 16 + 8 + h];
            const float gl_ = -__expf(c.a_log[h]) * softplusf_(ga + c.dt_bias[h]);
            float gc = gl_;
#pragma unroll
            for (int o = 1; o < 64; o <<= 1) { const float t_ = __shfl_up(gc, o); if (lane >= o) gc += t_; }
            const float glast = __shfl(gc, 63);
            sbeta[lane] = sigmoidf_(gb); sgc[lane] = gc; seg[lane] = __expf(gc); sek[lane] = __expf(glast - gc);
            if (lane == 0) *(float*)(blob + B_SC) = __expf(glast);
        }
        __syncthreads();
        const int tp = ltid(), part = tp >> 7, to = (tp >> 4) & 7, co = tp & 15, c0 = to * 8, d0 = co * 8;
        if (tp < 384) {
            const int chb = part * 1024 + h * 128 + d0;
            float val[8][8];
            {
                float wj[4][8];
#pragma unroll
                for (int j = 0; j < 4; ++j) { const f32x4 a = *(const f32x4*)(c.conv_w + j * 3072 + chb), b = *(const f32x4*)(c.conv_w + j * 3072 + chb + 4);
                    wj[j][0] = a[0]; wj[j][1] = a[1]; wj[j][2] = a[2]; wj[j][3] = a[3]; wj[j][4] = b[0]; wj[j][5] = b[1]; wj[j][6] = b[2]; wj[j][7] = b[3]; }
                u32x4 raw[11];
#pragma unroll
                for (int r = 0; r < 11; ++r) { const int tok = T0 + c0 - 3 + r; raw[r] = tok >= 0 ? *(const u32x4*)(c.proj + (size_t)tok * PW + C_GQKV + chb) : (u32x4){0u, 0u, 0u, 0u}; }
#pragma unroll
                for (int tt = 0; tt < 8; ++tt) {
                    float a[8] = {0.f, 0.f, 0.f, 0.f, 0.f, 0.f, 0.f, 0.f};
#pragma unroll
                    for (int j = 0; j < 4; ++j) { float xv[8]; unpack8(raw[tt + j], xv);
#pragma unroll
                        for (int jj = 0; jj < 8; ++jj) a[jj] += wj[j][jj] * xv[jj]; }
#pragma unroll
                    for (int jj = 0; jj < 8; ++jj) val[tt][jj] = siluf_(a[jj]);
                }
            }
            if (part < 2) {
#pragma unroll
                for (int tt = 0; tt < 8; ++tt) { float ss = 0.f;
#pragma unroll
                    for (int jj = 0; jj < 8; ++jj) ss += val[tt][jj] * val[tt][jj];
                    ss += __shfl_xor(ss, 1); ss += __shfl_xor(ss, 2); ss += __shfl_xor(ss, 4); ss += __shfl_xor(ss, 8);
                    const float rn = rsqrtf(ss + 1e-6f) * (part == 0 ? 0.08838834764831845f : 1.f);
#pragma unroll
                    for (int jj = 0; jj < 8; ++jj) val[tt][jj] *= rn; }
            }
            if (part == 0) {
#pragma unroll
                for (int tt = 0; tt < 8; ++tt) { const int cc = c0 + tt; *(LAS u32x4*)(lds + P_Q + cc * ST128 + d0 * 2) = pack8(val[tt]);
                    const float e = seg[cc]; float qd[8];
#pragma unroll
                    for (int jj = 0; jj < 8; ++jj) qd[jj] = val[tt][jj] * e;
                    *(u32x4*)(blob + B_QD + cc * ST128 + d0 * 2) = pack8(qd); }
            } else if (part == 1) {
#pragma unroll
                for (int tt = 0; tt < 8; ++tt) { const int cc = c0 + tt; *(LAS u32x4*)(lds + P_K + cc * ST128 + d0 * 2) = pack8(val[tt]);
                    const float e = seg[cc] * sbeta[cc]; float kb[8];
#pragma unroll
                    for (int jj = 0; jj < 8; ++jj) kb[jj] = val[tt][jj] * e;
                    *(u32x4*)(blob + B_KBG + cc * ST128 + d0 * 2) = pack8(kb); }
#pragma unroll
                for (int jj = 0; jj < 8; ++jj) { float col[8];
#pragma unroll
                    for (int tt = 0; tt < 8; ++tt) col[tt] = val[tt][jj] * sek[c0 + tt];
                    *(u32x4*)(blob + B_KU + (d0 + jj) * ST64 + c0 * 2) = pack8(col); }
            } else {
#pragma unroll
                for (int jj = 0; jj < 8; ++jj) { float col[8];
#pragma unroll
                    for (int tt = 0; tt < 8; ++tt) col[tt] = val[tt][jj] * sbeta[c0 + tt];
                    *(u32x4*)(blob + B_VB + (d0 + jj) * ST64 + c0 * 2) = pack8(col); }
            }
        }
        __syncthreads();
        {
            const int nt = wv & 3, mb = (wv >> 2) * 2, jj = nt * 16 + fr;
            f32x4 kk2[2] = {(f32x4){0.f, 0.f, 0.f, 0.f}, (f32x4){0.f, 0.f, 0.f, 0.f}}, at2[2] = {(f32x4){0.f, 0.f, 0.f, 0.f}, (f32x4){0.f, 0.f, 0.f, 0.f}};
            mma_nt<2, 4>(kk2, lds + P_K + mb * 16 * ST128, ST128, lds + P_K + nt * 16 * ST128, ST128, fr, fq);
            mma_nt<2, 4>(at2, lds + P_K + mb * 16 * ST128, ST128, lds + P_Q + nt * 16 * ST128, ST128, fr, fq);
            float* at = c.gAT + (size_t)(h * 256 + n) * 4096;
            const float gj = sgc[jj];
#pragma unroll
            for (int m = 0; m < 2; ++m) { const int i0 = (mb + m) * 16 + 4 * fq; f32x4 av; float pv[4];
#pragma unroll
                for (int r = 0; r < 4; ++r) { const int ii = i0 + r; const float gi = sgc[ii];
                    av[r] = jj < ii ? sbeta[ii] * kk2[m][r] * __expf(gi - gj) : 0.f;
                    pv[r] = ii <= jj ? at2[m][r] * __expf(gj - gi) : 0.f; }
                *(f32x4*)(at + jj * 64 + i0) = av;
                u32x2 w; w.x = cvt_pk_bf16(pv[0], pv[1]); w.y = cvt_pk_bf16(pv[2], pv[3]);
                *(u32x2*)(blob + B_AT + jj * ST64 + i0 * 2) = w; }
        }
        __syncthreads();
    }
}
__device__ void gdn_invert(CtxK& c, LAS unsigned char* lds, int h, int g) {
    const int tid = ltid(), wv = __builtin_amdgcn_readfirstlane(tid >> 6), lane = tid & 63;
    const int n = g * 8 + wv;
    LAS float* at = (LAS float*)(lds + wv * 16384);
    const float* src = c.gAT + (size_t)(h * 256 + n) * 4096;
#pragma unroll
    for (int k = 0; k < 16; ++k) *(LAS f32x4*)(at + (k * 64 + lane) * 4) = *(const f32x4*)(src + (k * 64 + lane) * 4);
    lds_fence();
    float r[64];
    unsigned ata = (unsigned)(size_t)at;
#pragma unroll
    for (int j = 63; j >= 0; --j) {
        float acc = lane == j ? 1.f : 0.f;
        LAS const float* arow = (LAS const float*)(size_t)ata + j * 64;
#pragma unroll
        for (int m4 = ((j + 1) & ~3); m4 < 64; m4 += 4) {
            const f32x4 a = *(LAS const f32x4*)(arow + m4);
#pragma unroll
            for (int q = 0; q < 4; ++q) if (m4 + q > j) acc = __builtin_fmaf(-r[m4 + q], a[q], acc);
        }
        r[j] = acc;
        asm volatile("" : "+v"(ata) : "v"(acc));
    }
    unsigned char* blob = (unsigned char*)c.gBlob + (size_t)(h * 256 + n) * BLOB;
#pragma unroll
    for (int k = 0; k < 8; ++k) { float v8[8];
#pragma unroll
        for (int q = 0; q < 8; ++q) v8[q] = r[k * 8 + q];
        *(u32x4*)(blob + B_T + lane * ST64 + k * 16) = pack8(v8); }
}
template <int MODE>
__device__ void gdn_pass(CtxK& c, LAS unsigned char* lds, int h, int g) {
    const int tid = ltid(), wv = __builtin_amdgcn_readfirstlane(tid >> 6), lane = tid & 63, fr = lane & 15, fq = lane >> 4;
    LAS unsigned char* stw = lds + G_ST + wv * 16 * ST128; LAS unsigned char* rvw = lds + G_RV + wv * 16 * ST64;
    LAS float* part = (LAS float*)(lds + G_PART); LAS float* rinv = (LAS float*)(lds + G_RINV);
    f32x4 Sacc[8];
#pragma unroll
    for (int m = 0; m < 8; ++m) {
        if (MODE == 1) { const int v = 16 * wv + fr, d0 = 16 * m + 4 * fq; Sacc[m] = (f32x4){d0 == v ? 1.f : 0.f, d0 + 1 == v ? 1.f : 0.f, d0 + 2 == v ? 1.f : 0.f, d0 + 3 == v ? 1.f : 0.f}; }
        else Sacc[m] = (f32x4){0.f, 0.f, 0.f, 0.f};
    }
    if (MODE == 2 && g > 0) { const f32x4* sp = (const f32x4*)c.gS + (size_t)(h * 32 + g) * FRAG_F4 + (wv * 8) * 64 + lane;
#pragma unroll
        for (int m = 0; m < 8; ++m) Sacc[m] = sp[m * 64]; }
    write_st(stw, Sacc, fr, fq);
    constexpr int LIM = MODE == 2 ? B_SC : B_QD, NQ = (LIM + 8191) / 8192;
    u32x4 pre[NQ];
    const unsigned char* blob0 = (const unsigned char*)c.gBlob + (size_t)(h * 256 + g * 8) * BLOB;
#define GP_ISSUE(i_) do { const unsigned char* bp_ = blob0 + (size_t)(i_) * BLOB + ltid() * 16; _Pragma("unroll") for (int q = 0; q < NQ; ++q) if (q * 8192 + 8176 < LIM || ltid() * 16 + q * 8192 < LIM) pre[q] = *(const u32x4*)(bp_ + q * 8192); } while (0)
    GP_ISSUE(0);
    for (int i = 0; i < 8; ++i) {
        const int n = g * 8 + i, T0 = n * 64;
        { const int tl = ltid() * 16;
#pragma unroll
          for (int q = 0; q < NQ; ++q) if (q * 8192 + 8176 < LIM || tl + q * 8192 < LIM) *(LAS u32x4*)(lds + tl + q * 8192) = pre[q]; }
        const float dlast = *(const float*)(blob0 + (size_t)i * BLOB + B_SC);
        u32x4 gpre[2];
        if (MODE == 2) gate_issue(gpre, c.proj + (size_t)T0 * PW + C_GG + h * 128);
        __syncthreads();
        if (i + 1 < 8) GP_ISSUE(i + 1);
        { f32x4 R[4];
#pragma unroll
          for (int m = 0; m < 4; ++m) R[m] = (f32x4){0.f, 0.f, 0.f, 0.f};
          mma_nt<4, 4>(R, lds + B_KBG, ST128, stw, ST128, fr, fq);
#pragma unroll
          for (int m = 0; m < 4; ++m) { float x0 = 0.f, x1 = 0.f, x2 = 0.f, x3 = 0.f;
              if (MODE != 1) { const u32x2 vb = *(LAS u32x2*)(lds + B_VB + (16 * wv + fr) * ST64 + (16 * m + 4 * fq) * 2); x0 = bflo(vb.x); x1 = bfhi(vb.x); x2 = bflo(vb.y); x3 = bfhi(vb.y); }
              u32x2 w; w.x = cvt_pk_bf16(x0 - R[m][0], x1 - R[m][1]); w.y = cvt_pk_bf16(x2 - R[m][2], x3 - R[m][3]);
              *(LAS u32x2*)(rvw + fr * ST64 + (16 * m + 4 * fq) * 2) = w; } }
        lds_fence();
        { f32x4 VN[4];
#pragma unroll
          for (int m = 0; m < 4; ++m) VN[m] = (f32x4){0.f, 0.f, 0.f, 0.f};
          mma_nt<4, 2>(VN, lds + B_T, ST64, rvw, ST64, fr, fq);
          mfma_pad4(VN); lds_fence();
#pragma unroll
          for (int m = 0; m < 4; ++m) { u32x2 w; w.x = cvt_pk_bf16(VN[m][0], VN[m][1]); w.y = cvt_pk_bf16(VN[m][2], VN[m][3]); *(LAS u32x2*)(rvw + fr * ST64 + (16 * m + 4 * fq) * 2) = w; } }
        lds_fence();
        f32x4 O[4];
        if (MODE == 2) {
#pragma unroll
            for (int m = 0; m < 4; ++m) O[m] = (f32x4){0.f, 0.f, 0.f, 0.f};
            mma_nt<4, 4>(O, lds + B_QD, ST128, stw, ST128, fr, fq);
            mma_nt<4, 2>(O, lds + B_AT, ST64, rvw, ST64, fr, fq);
#pragma unroll
            for (int m = 0; m < 4; ++m)
#pragma unroll
                for (int r = 0; r < 4; ++r) { float q = O[m][r] * O[m][r]; q += __shfl_xor(q, 1); q += __shfl_xor(q, 2); q += __shfl_xor(q, 4); q += __shfl_xor(q, 8); if (fr == 0) part[wv * 64 + 16 * m + 4 * fq + r] = q; }
        }
#pragma unroll
        for (int m = 0; m < 8; ++m) Sacc[m] = Sacc[m] * dlast;
        mma_nt<8, 2>(Sacc, lds + B_KU, ST64, rvw, ST64, fr, fq);
        lds_fence();
        write_st(stw, Sacc, fr, fq);
        if (MODE == 2) {
            __syncthreads();
            out_stage(lds + B_KBG, part, O, gpre, c.gdn_onorm_g, c.ocat + (size_t)T0 * D + 1024 + h * 128, wv, lane, fr, fq);
        }
        __syncthreads();
    }
#undef GP_ISSUE
    if (MODE == 0) {
        f32x4* sp = (f32x4*)c.gB + (size_t)(h * 32 + g) * FRAG_F4 + (wv * 8) * 64 + lane;
#pragma unroll
        for (int m = 0; m < 8; ++m) sp[m * 64] = Sacc[m];
    }
    if (MODE == 1) {
        mfma_pad8(Sacc);
        LAS bf16_t* img = (LAS bf16_t*)lds;
#pragma unroll
        for (int m = 0; m < 8; ++m)
#pragma unroll
            for (int r = 0; r < 4; ++r) img[(16 * m + 4 * fq + r) * (ST128 / 2) + 16 * wv + fr] = (bf16_t)(cvt_pk_bf16(Sacc[m][r], Sacc[m][r]) & 0xffffu);
        __syncthreads();
        unsigned char* dst = (unsigned char*)c.gM + (size_t)(h * 32 + g) * (128 * ST128);
#pragma unroll
        for (int q = 0; q < 5; ++q) { const int o = tid * 16 + q * 8192; if (q < 4 || o < 128 * ST128) *(u32x4*)(dst + o) = *(LAS u32x4*)(lds + o); }
        __syncthreads();
    }
}
__device__ void gdn_scan(CtxK& c, LAS unsigned char* lds, int h) {
    const int tid = ltid(), wv = __builtin_amdgcn_readfirstlane(tid >> 6), lane = tid & 63, fr = lane & 15, fq = lane >> 4;
    LAS unsigned char* stw = lds + G_ST + wv * 16 * ST128;
    f32x4 Sacc[8], Bn[8]; u32x4 mp[5];
#pragma unroll
    for (int m = 0; m < 8; ++m) Sacc[m] = (f32x4){0.f, 0.f, 0.f, 0.f};
#define GS_ISSUE(g_) do { const unsigned char* src_ = (const unsigned char*)c.gM + (size_t)(h * 32 + (g_)) * (128 * ST128) + tid * 16; \
        _Pragma("unroll") for (int q = 0; q < 5; ++q) if (q < 4 || tid * 16 + q * 8192 < 128 * ST128) mp[q] = *(const u32x4*)(src_ + q * 8192); \
        const f32x4* bp_ = (const f32x4*)c.gB + (size_t)(h * 32 + (g_)) * FRAG_F4 + (wv * 8) * 64 + lane; \
        _Pragma("unroll") for (int m = 0; m < 8; ++m) Bn[m] = bp_[m * 64]; } while (0)
    GS_ISSUE(0);
    for (int g = 0; g < 31; ++g) {
#pragma unroll
        for (int q = 0; q < 5; ++q) if (q < 4 || tid * 16 + q * 8192 < 128 * ST128) *(LAS u32x4*)(lds + tid * 16 + q * 8192) = mp[q];
        write_st(stw, Sacc, fr, fq);
#pragma unroll
        for (int m = 0; m < 8; ++m) Sacc[m] = Bn[m];
        __syncthreads();
        if (g + 1 < 31) GS_ISSUE(g + 1);
        mma_nt<8, 4>(Sacc, lds, ST128, stw, ST128, fr, fq);
        f32x4* sp = (f32x4*)c.gS + (size_t)(h * 32 + g + 1) * FRAG_F4 + (wv * 8) * 64 + lane;
#pragma unroll
        for (int m = 0; m < 8; ++m) sp[m * 64] = Sacc[m];
        __syncthreads();
    }
#undef GS_ISSUE
}
}
__device__ void ph_hgrn1(CtxK& c, LAS unsigned char* lds) { mx::hgrn_pass<false>(c, lds); }
__device__ void ph_hgrn2(CtxK& c, LAS unsigned char* lds) { mx::hgrn_scan(c); }
__device__ void ph_hgrn3(CtxK& c, LAS unsigned char* lds) { mx::hgrn_pass<true>(c, lds); }
__device__ void ph_gdn1(CtxK& c, LAS unsigned char* lds) {
    const int wu = blockIdx.x, h = wu & 7, g = wu >> 3;
    mx::gdn_prep(c, lds, h, g); __syncthreads();
    asm volatile("s_waitcnt vmcnt(0)" ::: "memory"); __syncthreads();
    mx::gdn_invert(c, lds, h, g);
    asm volatile("s_waitcnt vmcnt(0)" ::: "memory"); __syncthreads();
    mx::gdn_pass<0>(c, lds, h, g); __syncthreads();
    mx::gdn_pass<1>(c, lds, h, g); __syncthreads();
}
__device__ void ph_gdn2(CtxK& c, LAS unsigned char* lds) { if (blockIdx.x < 8) mx::gdn_scan(c, lds, blockIdx.x); }
__device__ void ph_gdn3(CtxK& c, LAS unsigned char* lds) { const int wu = blockIdx.x; mx::gdn_pass<2>(c, lds, wu & 7, wu >> 3); }

__device__ __forceinline__ float pair_sum128(float v, LAS float* red) {
    v = wave_sum(v); const int w = ltid() >> 6;
    __syncthreads(); if ((ltid() & 63) == 0) red[w] = v; __syncthreads();
    return red[w & ~1] + red[w | 1];
}
__device__ void ph_gdn_pre(CtxK& c, LAS unsigned char* lds) {
    LAS float* red = (LAS float*)lds;
    const int tid = ltid() & 255, g = ltid() >> 8;
    for (int t = blockIdx.x * 2 + g; t < S; t += gridDim.x * 2) {
        for (int grp = 0; grp < 12; ++grp) {
            const int ch = grp * 256 + tid; float acc = 0.f;
#pragma unroll
            for (int j = 0; j < 4; ++j) { const int tt = t - 3 + j; if (tt >= 0) acc += c.conv_w[j * 3072 + ch] * bf2f(c.proj[(size_t)tt * PW + C_GQKV + ch]); }
            const float val = siluf_(acc);
            if (grp < 8) {
                const float ss = pair_sum128(val * val, red); const float n = val * rsqrtf(ss + 1e-6f);
                if (grp < 4) c.gq[(size_t)t * 1024 + ch] = n * 0.08838834764831845f; else c.gk[(size_t)t * 1024 + ch - 1024] = n;
            } else c.gv[(size_t)t * 1024 + ch - 2048] = val;
        }
        if (tid < 8) {
            const float ga = c.gab[(size_t)t * 16 + tid], gb = c.gab[(size_t)t * 16 + 8 + tid];
            c.gbeta[t * 8 + tid] = sigmoidf_(gb); c.gdec[t * 8 + tid] = expf(-expf(c.a_log[tid]) * softplusf_(ga + c.dt_bias[tid]));
        }
    }
}
__device__ void ph_mix_naive(CtxK& c, LAS unsigned char* lds) {
    constexpr int TB = 8;
    const int wg = blockIdx.x, t512 = ltid(), tid = t512 & 127; const bool ld = t512 < 128, act = t512 < 256;
    const int v = (t512 >> 1) & 127, d0 = (t512 & 1) * 64;
    if (wg < 8 || wg >= 16) return;
    LAS float* sq = (LAS float*)lds; LAS float* sf = sq + TB * 128; LAS float* sk = sf + TB * 128; LAS float* sv = sk + TB * 128; LAS float* sb = sv + TB * 128; LAS float* sa = sb + TB;
    float st[64];
#pragma unroll
    for (int d = 0; d < 64; ++d) st[d] = 0.f;
    if (wg < 8) {
        const int h = wg; const float lbv = c.lb[h * 128 + tid];
        for (int t0 = 0; t0 < S; t0 += TB) {
            if (ld) for (int tt = 0; tt < TB; ++tt) {
                const bf16_t* base = c.proj + (size_t)(t0 + tt) * PW + h * 128 + tid;
                const float f = lbv + (1.f - lbv) * sigmoidf_(bf2f(base[C_HF]));
                sq[tt * 128 + tid] = siluf_(bf2f(base[C_HQ])) * 0.08838834764831845f; sf[tt * 128 + tid] = f; sk[tt * 128 + tid] = 1.f - f; sv[tt * 128 + tid] = bf2f(base[C_HI]);
            }
            __syncthreads();
            if (act) {
#pragma unroll 1
            for (int tt = 0; tt < TB; ++tt) {
                float o = 0.f; const float vv = sv[tt * 128 + v];
#pragma unroll
                for (int d = 0; d < 64; d += 4) {
                    const f32x4 q4 = *(LAS f32x4*)(sq + tt * 128 + d0 + d), f4 = *(LAS f32x4*)(sf + tt * 128 + d0 + d), k4 = *(LAS f32x4*)(sk + tt * 128 + d0 + d);
                    st[d] = f4[0] * st[d] + k4[0] * vv; o += q4[0] * st[d];
                    st[d + 1] = f4[1] * st[d + 1] + k4[1] * vv; o += q4[1] * st[d + 1];
                    st[d + 2] = f4[2] * st[d + 2] + k4[2] * vv; o += q4[2] * st[d + 2];
                    st[d + 3] = f4[3] * st[d + 3] + k4[3] * vv; o += q4[3] * st[d + 3];
                }
                o += __shfl_xor(o, 1);
                if (d0 == 0) c.oa[(size_t)(t0 + tt) * 1024 + h * 128 + v] = o;
            } }
            __syncthreads();
        }
    } else {
        const int h = wg - 8;
        for (int t0 = 0; t0 < S; t0 += TB) {
            if (ld) { for (int tt = 0; tt < TB; ++tt) {
                const size_t o = (size_t)(t0 + tt) * 1024 + h * 128 + tid;
                sq[tt * 128 + tid] = c.gq[o]; sk[tt * 128 + tid] = c.gk[o]; sv[tt * 128 + tid] = c.gv[o];
            }
            if (tid < TB) { sb[tid] = c.gbeta[(t0 + tid) * 8 + h]; sa[tid] = c.gdec[(t0 + tid) * 8 + h]; } }
            __syncthreads();
            if (act) {
#pragma unroll 1
            for (int tt = 0; tt < TB; ++tt) {
                const float a = sa[tt], be = sb[tt]; float kd = 0.f;
#pragma unroll
                for (int d = 0; d < 64; d += 4) { const f32x4 k4 = *(LAS f32x4*)(sk + tt * 128 + d0 + d); kd += k4[0] * st[d] + k4[1] * st[d + 1] + k4[2] * st[d + 2] + k4[3] * st[d + 3]; }
                kd += __shfl_xor(kd, 1);
                const float c1 = be * (sv[tt * 128 + v] - a * kd); float o = 0.f;
#pragma unroll
                for (int d = 0; d < 64; d += 4) {
                    const f32x4 k4 = *(LAS f32x4*)(sk + tt * 128 + d0 + d), q4 = *(LAS f32x4*)(sq + tt * 128 + d0 + d);
                    st[d] = a * st[d] + c1 * k4[0]; o += q4[0] * st[d];
                    st[d + 1] = a * st[d + 1] + c1 * k4[1]; o += q4[1] * st[d + 1];
                    st[d + 2] = a * st[d + 2] + c1 * k4[2]; o += q4[2] * st[d + 2];
                    st[d + 3] = a * st[d + 3] + c1 * k4[3]; o += q4[3] * st[d + 3];
                }
                o += __shfl_xor(o, 1);
                if (d0 == 0) c.ob[(size_t)(t0 + tt) * 1024 + h * 128 + v] = o;
            } }
            __syncthreads();
        }
    }
}
__device__ void ph_onorm(CtxK& c, LAS unsigned char* lds) {
    LAS float* red = (LAS float*)lds;
    const int tid = ltid() & 255, g = ltid() >> 8;
    for (int t = blockIdx.x * 2 + g; t < S; t += gridDim.x * 2) {
        for (int i = 4; i < 8; ++i) {
            const int br = i >> 2, ch = (i & 3) * 256 + tid; const float v = (br ? c.ob : c.oa)[(size_t)t * 1024 + ch];
            const float ss = pair_sum128(v * v, red);
            const float o = v * rsqrtf(ss * (1.f / 128.f) + 1e-6f) * (br ? c.gdn_onorm_g : c.hgrn_onorm_g)[ch & 127] * siluf_(bf2f(c.proj[(size_t)t * PW + (br ? C_GG : C_HG) + ch]));
            const unsigned pk = cvt_pk_bf16(o, o); c.ocat[(size_t)t * D + br * 1024 + ch] = (bf16_t)(pk & 0xffffu);
        }
    }
}
constexpr int N2_LA = 0, N2_LB = 8192, N2_XH = 16384, N2_XL = N2_XH + 17408, N2_Y = N2_XL + 17408, N2_LOG = N2_Y + 34816, N2_RS = N2_LOG + 64 * 65 * 4, N2_IDX = N2_RS + 256, N2_BIAS = N2_IDX + 2048, N2_END = N2_BIAS + 256;
static_assert(N2_END <= 147456, "norm2 lds");
__device__ void ph_norm2(CtxK& c, LAS unsigned char* lds) {
    const int tid = ltid(), wg = blockIdx.x, lane = tid & 63, wv = __builtin_amdgcn_readfirstlane(tid >> 6), fr = lane & 15, fq = lane >> 4;
    LAS float* la = (LAS float*)(lds + N2_LA); LAS float* lb_ = (LAS float*)(lds + N2_LB); LAS float* lg = (LAS float*)(lds + N2_LOG); LAS float* rs = (LAS float*)(lds + N2_RS);
    LAS int* idxt = (LAS int*)(lds + N2_IDX); LAS float* bias2 = (LAS float*)(lds + N2_BIAS);
    for (int j = tid; j < D; j += 512) { la[j] = c.norm2_g[j] * (1.f + c.mod[4 * D + j]); lb_[j] = c.mod[3 * D + j]; }
    if (tid < 64) bias2[tid] = c.rbias2[tid];
    __syncthreads();
    const int tok0 = wg * 64;
    f32x4 vn[8];
    { const float* xr = c.out + (size_t)(tok0 + wv * 8) * D;
#pragma unroll
      for (int i = 0; i < 8; ++i) vn[i] = *(const f32x4*)(xr + i * 256 + lane * 4); }
    for (int rr = 0; rr < 8; ++rr) {
        const int row = tok0 + wv * 8 + rr;
        f32x4 v[8]; float ss = 0.f;
#pragma unroll
        for (int i = 0; i < 8; ++i) { v[i] = vn[i]; ss += v[i][0] * v[i][0] + v[i][1] * v[i][1] + v[i][2] * v[i][2] + v[i][3] * v[i][3]; }
        if (rr + 1 < 8) { const float* xr = c.out + (size_t)(row + 1) * D;
#pragma unroll
            for (int i = 0; i < 8; ++i) vn[i] = *(const f32x4*)(xr + i * 256 + lane * 4); }
        ss = wave_sum(ss); const float r = rsqrtf(ss * (1.f / D) + 1e-6f);
        if (lane == 0) rs[wv * 8 + rr] = r;
#pragma unroll
        for (int i = 0; i < 8; ++i) { const int e = i * 256 + lane * 4; const f32x4 a = *(LAS f32x4*)(la + e), b = *(LAS f32x4*)(lb_ + e); const f32x4 y = v[i] * r * a + b;
            *(unsigned*)(c.h2 + (size_t)row * D + e) = cvt4_fp8(4.f * y[0], 4.f * y[1], 4.f * y[2], 4.f * y[3]); }
    }
    const int xrow = tid >> 3, xseg = (tid & 7) * 16;
    f32x4 xr_[4]; u32x4 yr_[5];
    auto issue = [&](int ch) {
        const float* xp = c.out + (size_t)(tok0 + xrow) * D + ch * 128 + xseg;
#pragma unroll
        for (int q = 0; q < 4; ++q) xr_[q] = *(const f32x4*)(xp + q * 4);
        const unsigned char* yp = (const unsigned char*)c.rwimg + (size_t)ch * 34816 + tid * 16;
#pragma unroll
        for (int q = 0; q < 4; ++q) yr_[q] = *(const u32x4*)(yp + q * 8192);
        if (tid < 128) yr_[4] = *(const u32x4*)(yp + 32768);
    };
    issue(0);
    f32x4 acc[2] = {(f32x4){0.f, 0.f, 0.f, 0.f}, (f32x4){0.f, 0.f, 0.f, 0.f}};
    const int mt = wv >> 1, nb = (wv & 1) * 2;
    for (int ch = 0; ch < 16; ++ch) {
        __syncthreads();
        { float hi[16], lo[16];
#pragma unroll
          for (int q = 0; q < 4; ++q)
#pragma unroll
              for (int j = 0; j < 4; ++j) { const float x = xr_[q][j]; const float h = __uint_as_float(cvt_pk_bf16(x, x) << 16); hi[q * 4 + j] = h; lo[q * 4 + j] = x - h; }
          float t8[8];
#pragma unroll
          for (int hh = 0; hh < 2; ++hh) {
#pragma unroll
              for (int j = 0; j < 8; ++j) t8[j] = hi[hh * 8 + j];
              *(LAS u32x4*)(lds + N2_XH + xrow * 272 + (xseg + hh * 8) * 2) = mx::pack8(t8);
#pragma unroll
              for (int j = 0; j < 8; ++j) t8[j] = lo[hh * 8 + j];
              *(LAS u32x4*)(lds + N2_XL + xrow * 272 + (xseg + hh * 8) * 2) = mx::pack8(t8); }
#pragma unroll
          for (int q = 0; q < 4; ++q) *(LAS u32x4*)(lds + N2_Y + tid * 16 + q * 8192) = yr_[q];
          if (tid < 128) *(LAS u32x4*)(lds + N2_Y + tid * 16 + 32768) = yr_[4]; }
        __syncthreads();
        if (ch + 1 < 16) issue(ch + 1);
#pragma unroll
        for (int kk = 0; kk < 4; ++kk) {
            const int ko = (kk * 32 + fq * 8) * 2;
            const bf16x8 ah = *(const LAS bf16x8*)(lds + N2_XH + (16 * mt + fr) * 272 + ko), al = *(const LAS bf16x8*)(lds + N2_XL + (16 * mt + fr) * 272 + ko);
#pragma unroll
            for (int n = 0; n < 2; ++n) {
                const bf16x8 bh = *(const LAS bf16x8*)(lds + N2_Y + (16 * (nb + n) + fr) * 272 + ko), bl = *(const LAS bf16x8*)(lds + N2_Y + 17408 + (16 * (nb + n) + fr) * 272 + ko);
                acc[n] = mx::mfma16(ah, bh, acc[n]); acc[n] = mx::mfma16(ah, bl, acc[n]); acc[n] = mx::mfma16(al, bh, acc[n]);
            }
        }
    }
#pragma unroll
    for (int n = 0; n < 2; ++n)
#pragma unroll
        for (int r = 0; r < 4; ++r) lg[(16 * mt + 4 * fq + r) * 65 + 16 * (nb + n) + fr] = acc[n][r];
    __syncthreads();
    const float rb = c.router_bias[lane], b2 = bias2[lane];
    for (int rr = 0; rr < 8; ++rr) {
        const int lr = wv * 8 + rr, t = tok0 + lr;
        const float s = sigmoidf_(lg[lr * 65 + lane] * rs[lr] + b2), b = s + rb;
        int rk = 0;
#pragma unroll
        for (int x = 1; x < 8; ++x) { const float ob = __shfl_xor(b, x); const int ol = lane ^ x; rk += (ob > b || (ob == b && ol < lane)) ? 1 : 0; }
        float gs = rk < 2 ? b : 0.f; gs += __shfl_xor(gs, 1); gs += __shfl_xor(gs, 2); gs += __shfl_xor(gs, 4);
        int grk = 0;
#pragma unroll
        for (int x = 8; x < 64; x += 8) { const float og = __shfl_xor(gs, x); const int ol = lane ^ x; grk += (og > gs || (og == gs && ol < lane)) ? 1 : 0; }
        float mb = grk < 4 ? b : -INFINITY;
        float wsum = 0.f; int myk = -1;
        for (int k = 0; k < TOPK; ++k) {
            float m = mb;
#pragma unroll
            for (int o = 32; o >= 1; o >>= 1) m = fmaxf(m, __shfl_xor(m, o));
            const unsigned long long bal = __ballot(mb == m); const int win = __ffsll((long long)bal) - 1;
            const float sw = __shfl(s, win); wsum += sw;
            if (lane == win) { mb = -INFINITY; myk = k; }
        }
        if (myk >= 0) { c.idx[t * TOPK + myk] = lane; c.wts[t * TOPK + myk] = s / wsum * 2.5f; idxt[lr * TOPK + myk] = lane; }
    }
    __syncthreads();
    if (tid < 64) { int n = 0;
        for (int p = 0; p < 512; ++p) if (idxt[p] == tid) { c.rnk[wg * 512 + p] = n; ++n; }
        c.tile_cnt[wg * 64 + tid] = n; }
}
__device__ void ph_route(CtxK& c, LAS unsigned char* lds) {
    const int tid = ltid(), b = blockIdx.x, e = tid & 63, part = tid >> 6;
    LAS int* psum = (LAS int*)lds; LAS int* pbel = psum + 512; LAS int* tot = pbel + 512; LAS int* offb = tot + 64; LAS int* pst = offb + 64;
    { int sa = 0, sb = 0;
      for (int tl = part * 32; tl < part * 32 + 32; ++tl) { const int v = c.tile_cnt[tl * 64 + e]; sa += v; sb += tl < b ? v : 0; }
      psum[part * 64 + e] = sa; pbel[part * 64 + e] = sb; }
    __syncthreads();
    if (tid < 64) {
        int t_ = 0, o_ = 0;
#pragma unroll
        for (int q = 0; q < 8; ++q) { t_ += psum[q * 64 + e]; o_ += pbel[q * 64 + e]; }
        const int pad = (t_ + 255) & ~255; int inc = pad;
#pragma unroll
        for (int o = 1; o < 64; o <<= 1) { const int x = __shfl_up(inc, o); if (e >= o) inc += x; }
        const int ps = inc - pad;
        tot[e] = t_; offb[e] = o_; pst[e] = ps;
        if (b == 0) {
            const int b0 = ps >> 8, nbe = pad >> 8;
            for (int j = 0; j < nbe; ++j) { c.blk_row[b0 + j] = ps + j * 256; c.blk_exp[b0 + j] = e; }
            const int nbr = __shfl(inc, 63) >> 8;
            c.blk_row[nbr + e] = PROUTED + e * 256; c.blk_exp[nbr + e] = NE;
            if (e == 0) *c.nent = nbr + S / 256;
        }
        c.tok_p[PROUTED + b * 64 + e] = b * 64 + e; c.w_p[PROUTED + b * 64 + e] = 1.f;
    }
    __syncthreads();
    { const int p = b * 512 + tid, ex = c.idx[p], d = pst[ex] + offb[ex] + c.rnk[p];
      c.tok_p[d] = p >> 3; c.w_p[d] = c.wts[p]; c.pos[p] = d; }
    if (b < NE) { const int ps = pst[b], t_ = tot[b], pe = (t_ + 255) & ~255;
        for (int r = t_ + tid; r < pe; r += 512) { c.tok_p[ps + r] = 0; c.w_p[ps + r] = 0.f; } }
}

constexpr int LDS_BYTES = 163840, LDS_MAIN = LDS_BYTES - 16;
static_assert(gm::VBOFF + 512 * 8 <= LDS_MAIN, "lds map");
__global__ void __launch_bounds__(512, 2) k_mega(Ctx c) {
    extern __shared__ __attribute__((aligned(16))) unsigned char smem[];
    LAS unsigned char* lds = (LAS unsigned char*)smem;
    if (ltid() == 0) *(LAS u32x4*)(lds + LDS_MAIN) = (u32x4){0u, 0u, 0u, 0u};
    __syncthreads();
    CtxK* kp = (CtxK*)__builtin_amdgcn_kernarg_segment_ptr();
    (void)xcd_barrier_post(c.bar, (volatile LAS unsigned*)(lds + LDS_MAIN));
#define PHASE(fn) do { const CtxK* kp_ = kp; asm volatile("" : "+s"(kp_)); fn(*kp_, lds); __syncthreads(); } while (0)
#define GRID_BARRIER() do { const CtxK* kp_ = kp; asm volatile("" : "+s"(kp_)); XcdBarrier bb_; bb_.bar = kp_->bar; bb_.x = xb_xcc_id(); bb_.st = (volatile LAS unsigned*)(lds + LDS_MAIN); xcd_barrier(bb_); } while (0)
    PHASE(ph_pro1);      GRID_BARRIER();
    PHASE(ph_norm1);     GRID_BARRIER();
    PHASE(ph_gemm1);     GRID_BARRIER();
    PHASE(ph_hgrn1);     PHASE(ph_gdn1);  GRID_BARRIER();
    PHASE(ph_hgrn2);     PHASE(ph_gdn2);  PHASE(ph_cvt_exp); GRID_BARRIER();
    PHASE(ph_hgrn3);     PHASE(ph_gdn3);  GRID_BARRIER();
    PHASE(ph_gemm2);     GRID_BARRIER();
    PHASE(ph_gemm3);     GRID_BARRIER();
    PHASE(ph_norm2);     GRID_BARRIER();
    PHASE(ph_route);     GRID_BARRIER();
    PHASE(ph_moe_gu);    GRID_BARRIER();
    PHASE(ph_moe_dn);    GRID_BARRIER();
    PHASE(ph_final);
#undef PHASE
#undef GRID_BARRIER
}

extern "C" void kernel_launch(void* const* d_in, const int* in_sizes, int n_in, void* d_out, int out_size, void* d_ws, size_t ws_size, hipStream_t stream) {
    Ctx c{};
    const float** ip = (const float**)&c.x;
    for (int i = 0; i < 25; ++i) ip[i] = (const float*)d_in[i];
    c.out = (float*)d_out;
    char* ws = (char*)d_ws; constexpr size_t MB = 1024 * 1024;
    c.bar = (unsigned*)ws;
    c.modp = (float*)(ws + 64 * 1024); c.mod = (float*)(ws + 320 * 1024); c.lb = (float*)(ws + 384 * 1024);
    c.cnt = (int*)(ws + 392 * 1024); c.nent = (int*)(ws + 396 * 1024); c.blk_row = (int*)(ws + 400 * 1024); c.blk_exp = (int*)(ws + 404 * 1024);
    c.idx = (int*)(ws + 1 * MB); c.wts = (float*)(ws + 2 * MB); c.tok_p = (int*)(ws + 3 * MB); c.w_p = (float*)(ws + 4 * MB); c.pos = (int*)(ws + 5 * MB);
    c.gab = (float*)(ws + 6 * MB); c.gbeta = (float*)(ws + 7 * MB + 0); c.gdec = (float*)(ws + 7 * MB + 512 * 1024);
    c.rwimg = (bf16_t*)(ws + 8 * MB); c.rbias2 = (float*)(ws + 9 * MB); c.tile_cnt = (int*)(ws + 9 * MB + 4096); c.rnk = (int*)(ws + 10 * MB);
    char* big = ws + 16 * MB;
    auto at = [&](size_t mib) { return big + mib * MB; };
    c.dn_t = (unsigned char*)at(0); c.gu_t = (unsigned char*)at(130);
    c.win_t = (bf16_t*)at(0); c.h1 = (bf16_t*)at(48); c.gAT = (float*)at(112);
    c.proj = (bf16_t*)at(390); c.gBlob = (unsigned char*)at(774); c.merged = (bf16_t*)at(774);
    c.gM = (unsigned char*)at(951); c.gB = (float*)at(960); c.hL = (float*)at(976); c.gS = (float*)at(992); c.hS = (float*)at(1008); c.hD = (float*)at(1024);
    c.wa_t = (bf16_t*)at(1025); c.wb_t = (bf16_t*)at(1029); c.wout_t = (bf16_t*)at(1033); c.ocat = (bf16_t*)at(1041);
    c.Y = (unsigned char*)at(130); c.hid = (unsigned char*)at(770); c.h2 = (unsigned char*)at(930);
    static_assert((size_t)NEX * D * FF * 2 <= 130 * MB && (size_t)NEX * 1024 * D * 2 <= 260 * MB && (size_t)PW * D * 2 <= 48 * MB && (size_t)S * D * 2 <= 64 * MB, "map A");
    static_assert((size_t)S * PW * 2 <= 384 * MB && (size_t)2048 * mx::BLOB <= 177 * MB && (size_t)256 * 128 * mx::ST128 <= 9 * MB && (size_t)PTOT * D * 2 <= 640 * MB && (size_t)PTOT * FF * 2 <= 160 * MB, "map B");
    const size_t need = 16 * MB + 1105 * MB;
    if (ws_size < need) { fprintf(stderr, "kernel_launch: workspace too small: %zu < %zu\n", ws_size, need); return; }

    static int grid = 0;
    if (!grid) {
        int dev = 0, cus = 0, per_cu = 0;
        hipGetDevice(&dev); hipDeviceGetAttribute(&cus, hipDeviceAttributeMultiprocessorCount, dev);
        hipFuncSetAttribute((const void*)k_mega, hipFuncAttributeMaxDynamicSharedMemorySize, LDS_BYTES);
        hipOccupancyMaxActiveBlocksPerMultiprocessor(&per_cu, (const void*)k_mega, 512, LDS_BYTES);
        if (per_cu < 1) fprintf(stderr, "kernel_launch: occupancy query reports %d blocks per CU\n", per_cu);
        grid = cus;
        if (grid != 256) { fprintf(stderr, "kernel_launch: built for a 256-CU device (token-mixer units = workgroups); got %d CUs\n", cus); grid = -1; }
    }
    if (grid < 0) return;
    hipMemsetAsync(c.bar, 0, XCD_BAR_WORDS * sizeof(unsigned), stream);
    hipLaunchKernelGGL(k_mega, dim3(grid), dim3(512), LDS_BYTES, stream, c);
}
```

```cpp
#include <hip/hip_runtime.h>
#include <stdint.h>
#include <stdio.h>

#define LAS __attribute__((address_space(3)))
typedef unsigned short bf16_t;
typedef short bf16x8 __attribute__((ext_vector_type(8)));
typedef float f32x4 __attribute__((ext_vector_type(4)));
typedef unsigned u32x4 __attribute__((ext_vector_type(4)));
typedef unsigned u32x2 __attribute__((ext_vector_type(2)));
typedef int v4i __attribute__((ext_vector_type(4)));
typedef int v8i __attribute__((ext_vector_type(8)));

constexpr int S = 16384, D = 2048, INW = 12304, PW = 12288, NE = 64, TOPK = 8, TK = S * TOPK, FF = 512;
constexpr int NEX = NE + 1;
constexpr int PROUTED = 147456, PTOT = PROUTED + S, NBLK_MAX = PROUTED / 256;
constexpr int C_HQ = 0, C_HF = 1024, C_HI = 2048, C_HG = 3072, C_GQKV = 4096, C_GG = 7168, C_MGA = 8192, C_MGB = 10240;
constexpr int WIN_GAB = 7168;

__device__ __forceinline__ float rcpf_(float x) { return __builtin_amdgcn_rcpf(x); }
__device__ __forceinline__ float sigmoidf_(float x) { return rcpf_(1.f + __expf(-x)); }
__device__ __forceinline__ float siluf_(float x) { return x * rcpf_(1.f + __expf(-x)); }
__device__ __forceinline__ float softplusf_(float x) { return x > 20.f ? x : log1pf(expf(x)); }
__device__ __forceinline__ float bf2f(bf16_t b) { return __uint_as_float(((unsigned)b) << 16); }
__device__ __forceinline__ float bflo(unsigned w) { return __uint_as_float(w << 16); }
__device__ __forceinline__ float bfhi(unsigned w) { return __uint_as_float(w & 0xffff0000u); }
__device__ __forceinline__ unsigned cvt_pk_bf16(float lo, float hi) { unsigned r; asm volatile("v_cvt_pk_bf16_f32 %0, %1, %2" : "=v"(r) : "v"(lo), "v"(hi)); return r; }
__device__ __forceinline__ unsigned cvt4_fp8(float a, float b, float c_, float d) {
    a = fminf(fmaxf(a, -448.f), 448.f); b = fminf(fmaxf(b, -448.f), 448.f); c_ = fminf(fmaxf(c_, -448.f), 448.f); d = fminf(fmaxf(d, -448.f), 448.f);
    int w = __builtin_amdgcn_cvt_pk_fp8_f32(a, b, 0, false); w = __builtin_amdgcn_cvt_pk_fp8_f32(c_, d, w, true); return (unsigned)w; }
__device__ __forceinline__ int ltid() { int t = threadIdx.x; asm volatile("" : "+v"(t)); return t; }
__device__ __forceinline__ float wave_sum_dpp(float v) {
    v += __builtin_bit_cast(float, __builtin_amdgcn_update_dpp(0, __builtin_bit_cast(int, v), 0x128, 0xf, 0xf, false));
    v += __builtin_bit_cast(float, __builtin_amdgcn_update_dpp(0, __builtin_bit_cast(int, v), 0x124, 0xf, 0xf, false));
    v += __builtin_bit_cast(float, __builtin_amdgcn_update_dpp(0, __builtin_bit_cast(int, v), 0x122, 0xf, 0xf, false));
    v += __builtin_bit_cast(float, __builtin_amdgcn_update_dpp(0, __builtin_bit_cast(int, v), 0x121, 0xf, 0xf, false));
    const int b = __builtin_bit_cast(int, v);
    return __builtin_bit_cast(float, __builtin_amdgcn_readlane(b, 0)) + __builtin_bit_cast(float, __builtin_amdgcn_readlane(b, 16)) + __builtin_bit_cast(float, __builtin_amdgcn_readlane(b, 32)) + __builtin_bit_cast(float, __builtin_amdgcn_readlane(b, 48));
}
__device__ __forceinline__ float wave_sum(float v) {
#pragma unroll
    for (int o = 32; o >= 1; o >>= 1) v += __shfl_xor(v, o);
    return v;
}


#define XB_TMO      128
#define XB_XCNT(j)  (256  + 64 * (j))
#define XB_XSUB(j)  (1280 + 64 * (j))
#define XB_XGEN(j)  (2304 + 64 * (j))
#define XB_TOP      3328
#define XB_TOPGEN   3392
#define XCD_BAR_WORDS 3456
#define XB_SPIN_CAP (1u << 18)
__device__ __forceinline__ unsigned xb_ld(unsigned* p)              { return __hip_atomic_load(p, __ATOMIC_RELAXED, __HIP_MEMORY_SCOPE_AGENT); }
__device__ __forceinline__ unsigned xb_add(unsigned* p, unsigned v) { return __hip_atomic_fetch_add(p, v, __ATOMIC_RELAXED, __HIP_MEMORY_SCOPE_AGENT); }
__device__ __forceinline__ unsigned xb_xcc_id() { return (unsigned)__builtin_amdgcn_s_getreg((3 << 11) | 20) & 0xFu; }
#define XB_SPIN(cond, bar) do { unsigned _sp = 0; while (cond) { __builtin_amdgcn_s_sleep(1); \
    if ((++_sp & 255u) == 0u) { if (xb_ld(&(bar)[XB_TMO])) break; if (_sp > XB_SPIN_CAP) { atomicAdd(&(bar)[XB_TMO], 1u); break; } } } } while (0)
struct XcdBarrier { unsigned* bar; unsigned x; volatile LAS unsigned* st; };
__device__ __forceinline__ XcdBarrier xcd_barrier_post(unsigned* bar, volatile LAS unsigned* st) {
    XcdBarrier b; b.bar = bar; b.x = xb_xcc_id(); b.st = st;
    if (threadIdx.x == 0) (void)xb_add(&bar[XB_XCNT(b.x)], 1u);
    return b;
}
__device__ __forceinline__ void xcd_barrier_complete(unsigned* bar, unsigned x, unsigned& nloc, unsigned& nx) {
    const unsigned G = gridDim.x * gridDim.y * gridDim.z;
    unsigned sum, cnt, mine, sp = 0u;
    for (;;) {
        sum = 0u; cnt = 0u; mine = 0u;
#pragma unroll
        for (unsigned j = 0; j < 16; ++j) { const unsigned c = xb_ld(&bar[XB_XCNT(j)]); sum += c; cnt += (c > 0u) ? 1u : 0u; mine = (j == x) ? c : mine; }
        if (sum == G) break;
        __builtin_amdgcn_s_sleep(1);
        if ((++sp & 255u) == 0u) { if (xb_ld(&bar[XB_TMO])) break; if (sp > XB_SPIN_CAP) { atomicAdd(&bar[XB_TMO], 1u); break; } }
    }
    nloc = mine > 0u ? mine : 1u; nx = cnt > 0u ? cnt : 1u;
}
__device__ __forceinline__ void xcd_barrier(const XcdBarrier& b) {
    asm volatile("s_waitcnt vmcnt(0)" ::: "memory");
    __syncthreads();
    if (threadIdx.x == 0) {
        unsigned* bar = b.bar;
        __builtin_amdgcn_s_waitcnt(0);
        unsigned nloc = b.st[0], nx = b.st[1];
        if (nloc == 0u) { xcd_barrier_complete(bar, b.x, nloc, nx); b.st[0] = nloc; b.st[1] = nx; }
        const unsigned old = xb_add(&bar[XB_XSUB(b.x)], 1u);
        const unsigned gen = old / nloc;
        if (old + 1u == (gen + 1u) * nloc) {
            __builtin_amdgcn_fence(__ATOMIC_RELEASE, "agent");
            asm volatile("s_waitcnt vmcnt(0)" ::: "memory");
            const unsigned og = xb_add(&bar[XB_TOP], 1u);
            const unsigned tg = og / nx;
            if (og + 1u == (tg + 1u) * nx) xb_add(&bar[XB_TOPGEN], 1u);
            else XB_SPIN(xb_ld(&bar[XB_TOPGEN]) == tg, bar);
            __builtin_amdgcn_fence(__ATOMIC_ACQUIRE, "agent");
            xb_add(&bar[XB_XGEN(b.x)], 1u);
            asm volatile("s_waitcnt vmcnt(0)" ::: "memory");
        } else {
            XB_SPIN(xb_ld(&bar[XB_XGEN(b.x)]) == gen, bar);
            __builtin_amdgcn_fence(__ATOMIC_ACQUIRE, "agent");
            asm volatile("s_waitcnt vmcnt(0)" ::: "memory");
        }
    }
    __syncthreads();
}

namespace gm {
constexpr int BM = 256, BK = 64, HALF = 128, HTB = HALF * BK * 2, STAGE_BYTES = 8 * HTB;
__host__ __device__ __forceinline__ int lds_byte(int r, int c) { const int st = (r >> 4) * 2 + (c >> 5), rr = r & 15, cc = c & 31, ob = rr * 64 + cc * 2; return st * 1024 + (ob ^ (((ob >> 9) & 1) << 5)); }
__host__ __device__ __forceinline__ void stage_rc(int b, int& R, int& C) { const int st = b / 1024, sb = b % 1024, swz = sb ^ (((sb >> 9) & 1) << 5); R = (st >> 1) * 16 + swz / 64; C = (st & 1) * 32 + (swz % 64) / 2; }
__host__ __device__ __forceinline__ int perm32(int rho) { const int n = rho >> 4, i = rho & 15; return 8 * (i >> 2) + 4 * n + (i & 3); }

struct Unit { int pm, pn, aux; const char* Bp; };
constexpr int UOFF = STAGE_BYTES + 256 + 10240, VBOFF = UOFF + 2 * 512 * 16;
__device__ __forceinline__ void put_offs(LAS unsigned char* lds, int ui, unsigned a00, unsigned a01, unsigned a10, unsigned a11) { *(LAS u32x4*)(lds + UOFF + ((ui & 1) * 512 + ltid()) * 16) = (u32x4){a00, a01, a10, a11}; }

template <class Epi, class Sched>
__device__ __forceinline__ void gphase(LAS unsigned char* lds, const char* Abase, const int K, Sched& S, Epi& E) {
    const int tid = ltid(), wid = __builtin_amdgcn_readfirstlane(tid >> 6), lane = tid & 63, wr = wid >> 2, wc = wid & 3, fr = lane & 15, fq = lane >> 4;
    const int nt = K / BK;
    { unsigned vb_[2];
#pragma unroll
      for (int i = 0; i < 2; ++i) { int R, C; stage_rc(tid * 16 + i * 8192, R, C); const int Rb = Epi::PERM ? ((R & ~31) + perm32(R & 31)) : R; vb_[i] = (unsigned)(Rb * K + C) * 2u; }
      *(LAS u32x2*)(lds + VBOFF + tid * 8) = (u32x2){vb_[0], vb_[1]}; }
    const unsigned hstepB = (unsigned)HALF * K * 2;
    const unsigned ldsw = (unsigned)wid * 1024u;
    constexpr bool F8 = Epi::F8; constexpr int KST = F8 ? 16 : 1024;
    const int aoff = lds_byte(wr * 64 + fr, fq * (F8 ? 16 : 8)), boff = lds_byte(wc * 32 + fr, fq * (F8 ? 16 : 8));
#define G_SA(b, h) (((b) * 2 + (h)) * HTB)
#define G_SB(b, h) ((4 + (b) * 2 + (h)) * HTB)
#define G_STAGE_A(bufoff, slot_, half_, kb) do { const char* ab_ = Abase + (kb); const u32x2 p_ = *(const LAS u32x2*)(lds + UOFF + (((slot_) & 1) * 512 + tid) * 16 + (half_) * 8); unsigned p0_ = p_.x, p1_ = p_.y; asm volatile("" : "+v"(p0_), "+v"(p1_)); \
        __builtin_amdgcn_global_load_lds((const unsigned*)(ab_ + p0_), (LAS unsigned*)(lds + (bufoff) + ldsw), 16, 0, 0); \
        __builtin_amdgcn_global_load_lds((const unsigned*)(ab_ + p1_), (LAS unsigned*)(lds + (bufoff) + ldsw + 8192), 16, 0, 0); } while (0)
#define G_STAGE_B(bufoff, bp, kb) do { const char* bb_ = (bp) + (kb); const u32x2 q_ = *(const LAS u32x2*)(lds + VBOFF + tid * 8); unsigned p0_ = q_.x, p1_ = q_.y; asm volatile("" : "+v"(p0_), "+v"(p1_)); \
        __builtin_amdgcn_global_load_lds((const unsigned*)(bb_ + p0_), (LAS unsigned*)(lds + (bufoff) + ldsw), 16, 0, 0); \
        __builtin_amdgcn_global_load_lds((const unsigned*)(bb_ + p1_), (LAS unsigned*)(lds + (bufoff) + ldsw + 8192), 16, 0, 0); } while (0)
#define G_LDA(dst, b, h) do { _Pragma("unroll") for (int m = 0; m < 4; ++m) _Pragma("unroll") for (int k = 0; k < 2; ++k) dst[m][k] = *(const LAS v4i*)(lds + G_SA(b, h) + aoff + m * 2048 + k * KST); } while (0)
#define G_LDB(dst, b, h) do { _Pragma("unroll") for (int n = 0; n < 2; ++n) _Pragma("unroll") for (int k = 0; k < 2; ++k) dst[n][k] = *(const LAS v4i*)(lds + G_SB(b, h) + boff + n * 2048 + k * KST); } while (0)
#define G_CAT(x_) __builtin_shufflevector(x_[0], x_[1], 0, 1, 2, 3, 4, 5, 6, 7)
#define G_MMA(ai, bj, At, Bt) do { __builtin_amdgcn_s_setprio(1); _Pragma("unroll") for (int m = 0; m < 4; ++m) _Pragma("unroll") for (int n = 0; n < 2; ++n) { \
        if constexpr (F8) acc[ai][bj][m][n] = __builtin_amdgcn_mfma_scale_f32_16x16x128_f8f6f4(G_CAT(Bt[n]), G_CAT(At[m]), acc[ai][bj][m][n], 0, 0, 0, Epi::SB, 0, Epi::SA); \
        else { _Pragma("unroll") for (int k = 0; k < 2; ++k) acc[ai][bj][m][n] = __builtin_amdgcn_mfma_f32_16x16x32_bf16(__builtin_bit_cast(bf16x8, Bt[n][k]), __builtin_bit_cast(bf16x8, At[m][k]), acc[ai][bj][m][n], 0, 0, 0); } } \
        __builtin_amdgcn_s_setprio(0); } while (0)
#define G_WAIT_V(n) asm volatile("s_waitcnt vmcnt(" #n ")" ::: "memory")
#define G_WAIT_L(n) asm volatile("s_waitcnt lgkmcnt(" #n ")" ::: "memory")
#define G_BAR __builtin_amdgcn_s_barrier()
#define G_SCHED __builtin_amdgcn_sched_barrier(0)
#define G_ZERO() do { _Pragma("unroll") for (int a = 0; a < 2; ++a) _Pragma("unroll") for (int b = 0; b < 2; ++b) _Pragma("unroll") for (int m = 0; m < 4; ++m) _Pragma("unroll") for (int n = 0; n < 2; ++n) acc[a][b][m][n] = (f32x4){0.f, 0.f, 0.f, 0.f}; } while (0)
    Unit cur, nxt; int ui = 0;
    if (!S.next(lds, 0, cur)) return;
    f32x4 acc[2][2][4][2];
    G_ZERO();
    v4i At[4][2], B0[2][2], B1[2][2];
    G_STAGE_B(G_SB(0, 0), cur.Bp, 0); G_STAGE_B(G_SB(0, 1), cur.Bp + hstepB, 0); G_STAGE_A(G_SA(0, 0), 0, 0, 0); G_STAGE_A(G_SA(0, 1), 0, 1, 0);
    if (wr == 1) G_BAR;
    G_WAIT_V(2); G_BAR;
    G_STAGE_B(G_SB(1, 0), cur.Bp, 128); G_STAGE_A(G_SA(1, 0), 0, 0, 128); G_STAGE_B(G_SB(1, 1), cur.Bp + hstepB, 128);
    G_WAIT_V(6); G_BAR;
    for (;;) {
        bool has_next = false;
#pragma unroll 1
        for (int t = 0; t < nt; t += 2) {
            const bool last = (t == nt - 2);
            const unsigned kb1 = (unsigned)(t + 1) * 128u, kb2 = last ? 0u : (unsigned)(t + 2) * 128u, kb3 = kb2 + 128u;
            const char* b2 = cur.Bp; int s2 = ui;
            if (last) {
                has_next = S.next(lds, ui + 1, nxt); if (!has_next) nxt = cur; else s2 = ui + 1;
                b2 = nxt.Bp; }
            G_LDB(B0, 0, 0); G_LDB(B1, 0, 1); G_SCHED; G_LDA(At, 0, 0); G_STAGE_A(G_SA(1, 1), ui, 1, kb1);
            G_WAIT_V(8); G_WAIT_L(0); G_BAR; G_MMA(0, 0, At, B0); G_MMA(0, 1, At, B1); G_BAR; G_SCHED;
            G_LDA(At, 0, 1); G_STAGE_B(G_SB(0, 0), b2, kb2); G_STAGE_B(G_SB(0, 1), b2 + hstepB, kb2); G_STAGE_A(G_SA(0, 0), s2, 0, kb2);
            G_WAIT_V(8); G_WAIT_L(0); G_BAR; G_MMA(1, 0, At, B0); G_MMA(1, 1, At, B1); G_BAR; G_SCHED;
            G_LDB(B0, 1, 0); G_LDB(B1, 1, 1); G_SCHED; G_LDA(At, 1, 0); G_STAGE_A(G_SA(0, 1), s2, 1, kb2);
            G_WAIT_V(8); G_WAIT_L(0); G_BAR; G_MMA(0, 0, At, B0); G_MMA(0, 1, At, B1); G_BAR; G_SCHED;
            G_LDA(At, 1, 1); G_STAGE_B(G_SB(1, 0), b2, kb3); G_STAGE_B(G_SB(1, 1), b2 + hstepB, kb3); G_STAGE_A(G_SA(1, 0), s2, 0, kb3);
            G_WAIT_V(8); G_WAIT_L(0); G_BAR; G_MMA(1, 0, At, B0); G_MMA(1, 1, At, B1); G_BAR; G_SCHED;
        }
        if (wr == 0) G_BAR;
        { const int tz = ltid(), wz = tz >> 6, lz = tz & 63; E(acc, cur, wz >> 2, wz & 3, lz & 15, lz >> 4); }
        if (!has_next) break;
        if (!E.keep(cur)) G_ZERO();
        cur = nxt; ++ui;
        if (wr == 1) G_BAR;
    }
    G_WAIT_V(0);
    G_BAR;
#undef G_SA
#undef G_SB
#undef G_STAGE_A
#undef G_STAGE_B
#undef G_LDA
#undef G_CAT
#undef G_LDB
#undef G_MMA
#undef G_WAIT_V
#undef G_WAIT_L
#undef G_BAR
#undef G_SCHED
#undef G_ZERO
}

struct DenseSched {
    int nM, nN, nwg, G, c, lda, K, parts; const char* Bt; const char* Bt2;
    __device__ void init(int M, int N, int K_, int lda_, const void* Bt_, const void* Bt2_, int parts_) {
        nM = M / BM; nN = N / BM; nwg = nM * nN; G = gridDim.x; c = blockIdx.x; lda = lda_; K = K_; Bt = (const char*)Bt_; Bt2 = (const char*)Bt2_; parts = parts_;
    }
    __device__ bool next(LAS unsigned char* lds, int i, Unit& u) const {
        const int ti = parts == 2 ? (i >> 1) : i, part = parts == 2 ? (i & 1) : 0;
        const long L = (long)ti * G + c; if (L >= nwg) return false;
        int wgid = (int)L; { const int q = nwg / 8, r = nwg % 8, xcd = wgid % 8, off = wgid / 8; wgid = (xcd < r ? xcd * (q + 1) : r * (q + 1) + (xcd - r) * q) + off; }
        const int nig = 8 * nN, gid = wgid / nig, fm = gid * 8, gsz = (nM - fm) < 8 ? (nM - fm) : 8;
        u.pm = fm + ((wgid % nig) % gsz); u.pn = (wgid % nig) / gsz; u.aux = part;
        u.Bp = (part ? Bt2 : Bt) + (size_t)u.pn * BM * K * 2;
        int R0, C0, R1, C1; { const int tz = ltid(); stage_rc(tz * 16, R0, C0); stage_rc(tz * 16 + 8192, R1, C1); }
        const unsigned rb = (unsigned)u.pm * BM, po = part ? (unsigned)K * 2u : 0u;
        put_offs(lds, i, ((rb + R0) * lda + C0) * 2u + po, ((rb + R1) * lda + C1) * 2u + po, ((rb + HALF + R0) * lda + C0) * 2u + po, ((rb + HALF + R1) * lda + C1) * 2u + po);
        return true;
    }
};
template <bool GATHER, int NN, int KK, int LDA, size_t WSTRIDE>
struct MoeSched {
    static constexpr int MAXU = 24, TBL = STAGE_BYTES, TOK = STAGE_BYTES + 256;
    int nu; const char* W;
    __device__ void init(LAS unsigned char* lds, const int* nent_p, const int* blk_row, const int* blk_exp, const int* tok_p, const void* W_) {
        W = (const char*)W_;
        const int tid = ltid(), G = gridDim.x, c = blockIdx.x, nent = *nent_p;
        const int x = c & 7, slot = c >> 3, nslot = G >> 3, e0 = (int)((long)x * nent / 8), e1 = (int)((long)(x + 1) * nent / 8), tot = (e1 - e0) * NN;
        nu = tot > slot ? (tot - slot + nslot - 1) / nslot : 0; if (nu > MAXU) nu = MAXU;
        LAS int* t_ = (LAS int*)(lds + TBL); LAS int* k_ = (LAS int*)(lds + TOK);
        if (tid < nu) { const int uidx = tid * nslot + slot, ent = e0 + uidx / NN; t_[tid * 2] = blk_row[ent]; t_[tid * 2 + 1] = blk_exp[ent] * 16 + uidx % NN; }
        __syncthreads();
        if (GATHER) { for (int j = tid; j < nu * 256; j += 512) k_[j] = tok_p[t_[(j >> 8) * 2] + (j & 255)]; __syncthreads(); }
    }
    __device__ bool next(LAS unsigned char* lds, int i, Unit& u) const {
        if (i >= nu) return false;
        LAS const int* tbl = (LAS const int*)(lds + TBL); LAS const int* tokt = (LAS const int*)(lds + TOK);
        int R0, C0, R1, C1; { const int tz = ltid(); stage_rc(tz * 16, R0, C0); stage_rc(tz * 16 + 8192, R1, C1); }
        const int rb = __builtin_amdgcn_readfirstlane(tbl[i * 2]), ep = __builtin_amdgcn_readfirstlane(tbl[i * 2 + 1]), e = ep >> 4; u.pn = ep & 15; u.pm = rb; u.aux = e;
        u.Bp = W + (size_t)e * WSTRIDE + (size_t)u.pn * BM * KK * 2;
        if (GATHER) {
            const unsigned t00 = tokt[i * 256 + R0], t01 = tokt[i * 256 + R1], t10 = tokt[i * 256 + HALF + R0], t11 = tokt[i * 256 + HALF + R1];
            put_offs(lds, i, (t00 * LDA + C0) * 2u, (t01 * LDA + C1) * 2u, (t10 * LDA + C0) * 2u, (t11 * LDA + C1) * 2u);
        } else {
            put_offs(lds, i, ((unsigned)(rb + R0) * LDA + C0) * 2u, ((unsigned)(rb + R1) * LDA + C1) * 2u, ((unsigned)(rb + HALF + R0) * LDA + C0) * 2u, ((unsigned)(rb + HALF + R1) * LDA + C1) * 2u);
        }
        return true;
    }
};

struct EpiProj {
    static constexpr bool PERM = true, F8 = false; static constexpr int SA = 0, SB = 0; bf16_t* O;
    __device__ __forceinline__ bool keep(const Unit&) const { return false; }
    __device__ __forceinline__ void operator()(f32x4 (&acc)[2][2][4][2], const Unit& u, int wr, int wc, int fr, int fq) const {
        const int row0 = u.pm * BM + wr * 64 + fr, col0 = u.pn * BM + wc * 32 + 8 * fq;
#pragma unroll
        for (int ai = 0; ai < 2; ++ai)
#pragma unroll
            for (int m = 0; m < 4; ++m) { bf16_t* rowp = O + (size_t)(row0 + ai * HALF + m * 16) * PW + col0;
#pragma unroll
                for (int bj = 0; bj < 2; ++bj) { const f32x4 v0 = acc[ai][bj][m][0], v1 = acc[ai][bj][m][1]; u32x4 w;
                    w.x = cvt_pk_bf16(v0[0], v0[1]); w.y = cvt_pk_bf16(v0[2], v0[3]); w.z = cvt_pk_bf16(v1[0], v1[1]); w.w = cvt_pk_bf16(v1[2], v1[3]);
                    *(u32x4*)(rowp + bj * HALF) = w; } }
    }
};
struct EpiMerge {
    static constexpr bool PERM = true, F8 = false; static constexpr int SA = 0, SB = 0; const bf16_t* proj; bf16_t* O;
    __device__ __forceinline__ bool keep(const Unit& u) const { return u.aux == 0; }
    __device__ __forceinline__ void operator()(f32x4 (&acc)[2][2][4][2], const Unit& u, int wr, int wc, int fr, int fq) const {
        const int row0 = u.pm * BM + wr * 64 + fr, col0 = u.pn * BM + wc * 32 + 8 * fq;
#pragma unroll
        for (int ai = 0; ai < 2; ++ai)
#pragma unroll
            for (int m = 0; m < 4; ++m) { const size_t r = (size_t)(row0 + ai * HALF + m * 16);
#pragma unroll
                for (int bj = 0; bj < 2; ++bj) {
                    const u32x4 gb = *(const u32x4*)(proj + r * PW + C_MGB + col0 + bj * HALF);
                    const f32x4 eb0 = {__expf(-bflo(gb.x)), __expf(-bfhi(gb.x)), __expf(-bflo(gb.y)), __expf(-bfhi(gb.y))};
                    const f32x4 eb1 = {__expf(-bflo(gb.z)), __expf(-bfhi(gb.z)), __expf(-bflo(gb.w)), __expf(-bfhi(gb.w))};
                    if (u.aux == 0) {
                        const u32x4 ga = *(const u32x4*)(proj + r * PW + C_MGA + col0 + bj * HALF);
                        const f32x4 ea0 = {__expf(-bflo(ga.x)), __expf(-bfhi(ga.x)), __expf(-bflo(ga.y)), __expf(-bfhi(ga.y))};
                        const f32x4 ea1 = {__expf(-bflo(ga.z)), __expf(-bfhi(ga.z)), __expf(-bflo(ga.w)), __expf(-bfhi(ga.w))};
#pragma unroll
                        for (int j = 0; j < 4; ++j) { acc[ai][bj][m][0][j] *= (1.f + eb0[j]) * rcpf_(1.f + ea0[j]); acc[ai][bj][m][1][j] *= (1.f + eb1[j]) * rcpf_(1.f + ea1[j]); }
                    } else {
                        f32x4 v0 = acc[ai][bj][m][0], v1 = acc[ai][bj][m][1];
#pragma unroll
                        for (int j = 0; j < 4; ++j) { v0[j] *= rcpf_(1.f + eb0[j]); v1[j] *= rcpf_(1.f + eb1[j]); }
                        u32x4 w; w.x = cvt_pk_bf16(v0[0], v0[1]); w.y = cvt_pk_bf16(v0[2], v0[3]); w.z = cvt_pk_bf16(v1[0], v1[1]); w.w = cvt_pk_bf16(v1[2], v1[3]);
                        *(u32x4*)(O + r * D + col0 + bj * HALF) = w;
                    } } }
    }
};
struct EpiResid {
    static constexpr bool PERM = false, F8 = false; static constexpr int SA = 0, SB = 0; const float* x; const float* gt; float* O;
    __device__ __forceinline__ bool keep(const Unit&) const { return false; }
    __device__ __forceinline__ void operator()(f32x4 (&acc)[2][2][4][2], const Unit& u, int wr, int wc, int fr, int fq) const {
        const int row0 = u.pm * BM + wr * 64 + fr, col0 = u.pn * BM + wc * 32 + 4 * fq;
        f32x4 g[2][2];
#pragma unroll
        for (int bj = 0; bj < 2; ++bj)
#pragma unroll
            for (int n = 0; n < 2; ++n) g[bj][n] = *(const f32x4*)(gt + col0 + bj * HALF + n * 16);
#pragma unroll
        for (int ai = 0; ai < 2; ++ai)
#pragma unroll
            for (int m = 0; m < 4; ++m) { const size_t ro = (size_t)(row0 + ai * HALF + m * 16) * D + col0;
#pragma unroll
                for (int bj = 0; bj < 2; ++bj)
#pragma unroll
                    for (int n = 0; n < 2; ++n) { const f32x4 xv = *(const f32x4*)(x + ro + bj * HALF + n * 16); *(f32x4*)(O + ro + bj * HALF + n * 16) = xv + g[bj][n] * acc[ai][bj][m][n]; } }
    }
};
struct EpiSwiglu {
    static constexpr bool PERM = true, F8 = true; static constexpr int SA = 0x7d7d7d7d, SB = 0x79797979; unsigned char* hid;
    __device__ __forceinline__ bool keep(const Unit&) const { return false; }
    __device__ __forceinline__ void operator()(f32x4 (&acc)[2][2][4][2], const Unit& u, int wr, int wc, int fr, int fq) const {
        const int row0 = u.pm + wr * 64 + fr, j0 = u.pn * 128 + wc * 16 + 4 * fq;
#pragma unroll
        for (int ai = 0; ai < 2; ++ai)
#pragma unroll
            for (int m = 0; m < 4; ++m) { unsigned char* rowp = hid + (unsigned)((row0 + ai * HALF + m * 16) * FF + j0);
#pragma unroll
                for (int bj = 0; bj < 2; ++bj) { const f32x4 g = acc[ai][bj][m][0], up = acc[ai][bj][m][1];
                    *(unsigned*)(rowp + bj * 64) = cvt4_fp8(8.f * siluf_(g[0]) * up[0], 8.f * siluf_(g[1]) * up[1], 8.f * siluf_(g[2]) * up[2], 8.f * siluf_(g[3]) * up[3]); }
                asm volatile("" ::: "memory"); __builtin_amdgcn_sched_barrier(0); }
    }
};
struct EpiDown {
    static constexpr bool PERM = true, F8 = true; static constexpr int SA = 0x7c7c7c7c, SB = 0x7a7a7a7a; unsigned char* Y; const float* w_p;
    __device__ __forceinline__ bool keep(const Unit&) const { return false; }
    __device__ __forceinline__ void operator()(f32x4 (&acc)[2][2][4][2], const Unit& u, int wr, int wc, int fr, int fq) const {
        const int row0 = u.pm + wr * 64 + fr, col0 = u.pn * BM + wc * 32 + 8 * fq;
#pragma unroll
        for (int ai = 0; ai < 2; ++ai)
#pragma unroll
            for (int m = 0; m < 4; ++m) { const int r = row0 + ai * HALF + m * 16; const float wt = w_p[(unsigned)r] * 16.f; unsigned char* rowp = Y + ((unsigned)r * D + col0);
#pragma unroll
                for (int bj = 0; bj < 2; ++bj) { const f32x4 v0 = acc[ai][bj][m][0] * wt, v1 = acc[ai][bj][m][1] * wt;
                    *(u32x2*)(rowp + bj * HALF) = (u32x2){cvt4_fp8(v0[0], v0[1], v0[2], v0[3]), cvt4_fp8(v1[0], v1[1], v1[2], v1[3])}; }
                asm volatile("" ::: "memory"); __builtin_amdgcn_sched_barrier(0); }
    }
};
}

struct Ctx {
    const float *x, *c, *w_ada, *b_ada, *norm1_g, *norm2_g, *w_in, *lb_table, *hgrn_onorm_g, *conv_w, *a_log, *dt_bias, *gdn_onorm_g, *w_bh, *w_bg, *w_out, *w_router, *router_bias,
        *w_eg, *w_eu, *w_ed, *w_sg, *w_su, *w_sd, *normf_g;
    float* out;
    unsigned* bar;
    float *modp, *mod, *lb, *gab;
    int *idx, *cnt, *tok_p, *pos, *blk_row, *blk_exp, *nent;
    float *wts, *w_p;
    bf16_t *win_t, *wa_t, *wb_t, *wout_t, *h1, *proj, *ocat, *merged;
    float *gq, *gk, *gv, *gbeta, *gdec, *oa, *ob;
    float *hL, *hS, *hD;
    float *gAT, *gB, *gS; unsigned char *gBlob, *gM;
    unsigned char *dn_t, *hid, *gu_t, *h2, *Y;
    bf16_t* rwimg; float* rbias2; int *tile_cnt, *rnk;
};

typedef const __attribute__((address_space(4))) Ctx CtxK;

__device__ __forceinline__ void cvt_tile(LAS float* t, const float* srcA, const float* srcB, int ld, int mode, bf16_t* dst, int ldd) {
    const int tid = ltid(), kr = tid >> 6, cl = tid & 63;
    const float* sp = (mode == 1 && cl >= 32) ? (srcB + cl - 32) : (srcA + cl);
    float v[8];
#pragma unroll
    for (int p = 0; p < 8; ++p) v[p] = sp[(size_t)(p * 8 + kr) * ld];
    __syncthreads();
#pragma unroll
    for (int p = 0; p < 8; ++p) t[(p * 8 + kr) * 65 + cl] = v[p];
    __syncthreads();
    const int r = tid >> 3, seg = (tid & 7) * 8;
    const int lc = mode == 1 ? (((r >> 2) & 1) * 32 + 4 * (r >> 3) + (r & 3)) : r;
    float w[8];
#pragma unroll
    for (int j = 0; j < 8; ++j) w[j] = t[(seg + j) * 65 + lc];
    u32x4 o; o.x = cvt_pk_bf16(w[0], w[1]); o.y = cvt_pk_bf16(w[2], w[3]); o.z = cvt_pk_bf16(w[4], w[5]); o.w = cvt_pk_bf16(w[6], w[7]);
    *(u32x4*)(dst + (size_t)r * ldd + seg) = o;
}
__device__ __forceinline__ void cvt_tile8(LAS float* t, const float* srcA, const float* srcB, int ld, int mode, unsigned char* dst, int ldd, float scale) {
    const int tid = ltid(), kr = tid >> 6, cl = tid & 63;
    const float* sp = (mode == 1 && cl >= 32) ? (srcB + cl - 32) : (srcA + cl);
    float v[8];
#pragma unroll
    for (int p = 0; p < 8; ++p) v[p] = sp[(size_t)(p * 8 + kr) * ld];
    __syncthreads();
#pragma unroll
    for (int p = 0; p < 8; ++p) t[(p * 8 + kr) * 65 + cl] = v[p] * scale;
    __syncthreads();
    const int r = tid >> 3, seg = (tid & 7) * 8;
    const int lc = mode == 1 ? (((r >> 2) & 1) * 32 + 4 * (r >> 3) + (r & 3)) : r;
    float w[8];
#pragma unroll
    for (int j = 0; j < 8; ++j) w[j] = t[(seg + j) * 65 + lc];
    *(u32x2*)(dst + (size_t)r * ldd + seg) = (u32x2){cvt4_fp8(w[0], w[1], w[2], w[3]), cvt4_fp8(w[4], w[5], w[6], w[7])};
}
__device__ __forceinline__ void cvt_job(LAS float* t, int tile, const float* src, int ld, int K, bf16_t* dst) {
    const int nkt = K / 64, nt = tile / nkt, kt = tile % nkt;
    cvt_tile(t, src + (size_t)kt * 64 * ld + nt * 64, nullptr, ld, 0, dst + (size_t)nt * 64 * K + kt * 64, K);
}

__device__ void ph_pro1(CtxK& c, LAS unsigned char* lds) {
    const int tid = ltid(), wg = blockIdx.x, G = gridDim.x;
    LAS float* lf = (LAS float*)lds;
    for (int job = wg; job < 192; job += G) {
        const int cc = job % 48, kp = job / 48, q = tid & 63, rg = tid >> 6;
        f32x4 a = {0.f, 0.f, 0.f, 0.f};
        for (int r = rg; r < 512; r += 8) { const int k = kp * 512 + r; const float s = siluf_(c.c[k]); a += s * *(const f32x4*)(c.w_ada + (size_t)k * (6 * D) + cc * 256 + q * 4); }
        __syncthreads();
        *(LAS f32x4*)(lf + (rg * 64 + q) * 4) = a;
        __syncthreads();
        if (tid < 64) { f32x4 s = {0.f, 0.f, 0.f, 0.f};
#pragma unroll
            for (int g = 0; g < 8; ++g) s += *(LAS f32x4*)(lf + (g * 64 + tid) * 4);
            *(f32x4*)(c.modp + (size_t)kp * (6 * D) + cc * 256 + tid * 4) = s; }
    }
    if (wg == G - 1) for (int j = tid; j < 1024; j += 512) c.lb[j] = 1.f / (1.f + expf(c.lb_table[1024 + j] - c.lb_table[j]));
    for (int T = wg; T < 8192; T += G) {
        if (T < 6144) { const int nt = T / 32, kt = T % 32; const int sc = nt * 64 + (nt * 64 >= WIN_GAB ? 16 : 0);
            cvt_tile(lf, c.w_in + (size_t)kt * 64 * INW + sc, nullptr, INW, 0, c.win_t + (size_t)nt * 64 * D + kt * 64, D); }
        else if (T < 6656) cvt_job(lf, T - 6144, c.w_bh, D, 1024, c.wa_t);
        else if (T < 7168) cvt_job(lf, T - 6656, c.w_bg, D, 1024, c.wb_t);
        else cvt_job(lf, T - 7168, c.w_out, D, 2048, c.wout_t);
    }
}
__device__ void ph_norm1(CtxK& c, LAS unsigned char* lds) {
    const int tid = ltid(), wg = blockIdx.x, G = gridDim.x, lane = tid & 63, wv = tid >> 6;
    LAS float* la = (LAS float*)lds;
    LAS float* lb_ = la + D;
    LAS float* lw = lb_ + D;
    for (int j = tid; j < D; j += 512) {
        float sh = c.b_ada[j], sc = c.b_ada[D + j];
#pragma unroll
        for (int p = 0; p < 4; ++p) { sh += c.modp[(size_t)p * 6 * D + j]; sc += c.modp[(size_t)p * 6 * D + D + j]; }
        la[j] = c.norm1_g[j] * (1.f + sc); lb_[j] = sh;
    }
    for (int j = wg * 512 + tid; j < 6 * D; j += G * 512) { float m = c.b_ada[j];
#pragma unroll
        for (int p = 0; p < 4; ++p) m += c.modp[(size_t)p * 6 * D + j];
        c.mod[j] = m; }
    for (int i = tid; i < D * 4; i += 512) { const int e = i >> 2, q = i & 3; const f32x4 w = *(const f32x4*)(c.w_in + (size_t)e * INW + WIN_GAB + q * 4);
        lw[(q * 4 + 0) * D + e] = w[0]; lw[(q * 4 + 1) * D + e] = w[1]; lw[(q * 4 + 2) * D + e] = w[2]; lw[(q * 4 + 3) * D + e] = w[3]; }
    __syncthreads();
    f32x4 vn[8];
    { const float* xr = c.x + (size_t)(wg * 8 + wv) * D;
#pragma unroll
      for (int i = 0; i < 8; ++i) vn[i] = *(const f32x4*)(xr + i * 256 + lane * 4); }
    for (int row = wg * 8 + wv; row < S; row += G * 8) {
        f32x4 v[8]; float ss = 0.f;
#pragma unroll
        for (int i = 0; i < 8; ++i) { v[i] = vn[i]; ss += v[i][0] * v[i][0] + v[i][1] * v[i][1] + v[i][2] * v[i][2] + v[i][3] * v[i][3]; }
        if (row + G * 8 < S) { const float* xr = c.x + (size_t)(row + G * 8) * D;
#pragma unroll
            for (int i = 0; i < 8; ++i) vn[i] = *(const f32x4*)(xr + i * 256 + lane * 4); }
        ss = wave_sum(ss); const float r = rsqrtf(ss * (1.f / D) + 1e-6f);
#pragma unroll
        for (int i = 0; i < 8; ++i) { const int e = i * 256 + lane * 4; const f32x4 a = *(LAS f32x4*)(la + e), b = *(LAS f32x4*)(lb_ + e); v[i] = v[i] * r * a + b;
            u32x2 w; w.x = cvt_pk_bf16(v[i][0], v[i][1]); w.y = cvt_pk_bf16(v[i][2], v[i][3]); *(u32x2*)(c.h1 + (size_t)row * D + e) = w; }
        float mine = 0.f;
        for (int cc = 0; cc < 16; ++cc) { float d = 0.f;
#pragma unroll
            for (int i = 0; i < 8; ++i) { const f32x4 w = *(LAS f32x4*)(lw + cc * D + i * 256 + lane * 4); d += v[i][0] * w[0] + v[i][1] * w[1] + v[i][2] * w[2] + v[i][3] * w[3]; }
            d = wave_sum(d); if (lane == cc) mine = d; }
        if (lane < 16) c.gab[(size_t)row * 16 + lane] = mine;
    }
    { const int id = wg * 512 + tid, i = id >> 6, e = id & 63;
      if (id < D * 64) {
          float sc = c.b_ada[4 * D + i];
#pragma unroll
          for (int p = 0; p < 4; ++p) sc += c.modp[(size_t)p * 6 * D + 4 * D + i];
          const float w = c.norm2_g[i] * (1.f + sc) * c.w_router[id];
          const unsigned hi = cvt_pk_bf16(w, w) & 0xffffu; const float lo = w - __uint_as_float(hi << 16);
          const int ch = i >> 7, kk = i & 127;
          c.rwimg[((ch * 2 + 0) * 64 + e) * 136 + kk] = (bf16_t)hi; c.rwimg[((ch * 2 + 1) * 64 + e) * 136 + kk] = (bf16_t)(cvt_pk_bf16(lo, lo) & 0xffffu);
      } }
    if (wg < 64) {
        __syncthreads();
        float a = 0.f;
        for (int i = tid; i < D; i += 512) { float sh = c.b_ada[3 * D + i];
#pragma unroll
            for (int p = 0; p < 4; ++p) sh += c.modp[(size_t)p * 6 * D + 3 * D + i];
            a += sh * c.w_router[i * 64 + wg]; }
        a = wave_sum(a); if (lane == 0) la[wv] = a; __syncthreads();
        if (tid == 0) c.rbias2[wg] = la[0] + la[1] + la[2] + la[3] + la[4] + la[5] + la[6] + la[7];
    }
}
__device__ void ph_gemm1(CtxK& c, LAS unsigned char* lds) {
    gm::DenseSched Sd; Sd.init(S, PW, D, D, c.win_t, nullptr, 1); gm::EpiProj E{c.proj};
    gm::gphase(lds, (const char*)c.h1, D, Sd, E);
}
__device__ void ph_gemm2(CtxK& c, LAS unsigned char* lds) {
    gm::DenseSched Sd; Sd.init(S, D, 1024, 2048, c.wa_t, c.wb_t, 2); gm::EpiMerge E{c.proj, c.merged};
    gm::gphase(lds, (const char*)c.ocat, 1024, Sd, E);
}
__device__ void ph_gemm3(CtxK& c, LAS unsigned char* lds) {
    gm::DenseSched Sd; Sd.init(S, D, D, D, c.wout_t, nullptr, 1); gm::EpiResid E{c.x, c.mod + 2 * D, c.out};
    gm::gphase(lds, (const char*)c.merged, D, Sd, E);
}
__device__ void ph_moe_gu(CtxK& c, LAS unsigned char* lds) {
    gm::MoeSched<true, 4, D / 2, D / 2, (size_t)1024 * D> Sm; Sm.init(lds, c.nent, c.blk_row, c.blk_exp, c.tok_p, c.gu_t); gm::EpiSwiglu E{c.hid};
    gm::gphase(lds, (const char*)c.h2, D / 2, Sm, E);
}
__device__ void ph_moe_dn(CtxK& c, LAS unsigned char* lds) {
    gm::MoeSched<false, 8, FF / 2, FF / 2, (size_t)D * FF> Sm; Sm.init(lds, c.nent, c.blk_row, c.blk_exp, c.tok_p, c.dn_t); gm::EpiDown E{c.Y, c.w_p};
    gm::gphase(lds, (const char*)c.hid, FF / 2, Sm, E);
}
__device__ void ph_cvt_exp(CtxK& c, LAS unsigned char* lds) {
    LAS float* lf = (LAS float*)lds; const int wg = blockIdx.x - 8, G = gridDim.x - 8;
    if (wg < 0) return;
    constexpr int GU_T = 16 * 32, DN_T = 32 * 8;
    for (int T = wg; T < NEX * (GU_T + DN_T); T += G) {
        if (T < NEX * GU_T) { const int e = T / GU_T, r = T % GU_T, nt = r / 32, kt = r % 32;
            const float* sg = e < NE ? c.w_eg + (size_t)e * D * FF : c.w_sg; const float* su = e < NE ? c.w_eu + (size_t)e * D * FF : c.w_su;
            cvt_tile8(lf, sg + (size_t)kt * 64 * FF + nt * 32, su + (size_t)kt * 64 * FF + nt * 32, FF, 1, c.gu_t + ((size_t)e * 1024 + nt * 64) * D + kt * 64, D, 64.f); }
        else { const int T2 = T - NEX * GU_T, e = T2 / DN_T, r = T2 % DN_T; const float* sd = e < NE ? c.w_ed + (size_t)e * FF * D : c.w_sd;
            { const int nkt = FF / 64, nt = r / nkt, kt = r % nkt; cvt_tile8(lf, sd + (size_t)kt * 64 * D + nt * 64, nullptr, D, 0, c.dn_t + (size_t)e * D * FF + (size_t)nt * 64 * FF + kt * 64, FF, 32.f); } }
    }
}
__device__ void ph_final(CtxK& c, LAS unsigned char* lds) {
    const int tid = ltid(), wg = blockIdx.x, G = gridDim.x, lane = tid & 63, wv = tid >> 6;
    const float* gt2 = c.mod + 5 * D;
    for (int row0 = (wg * 8 + wv) * 2; row0 < S; row0 += G * 16) {
        int p[2][9];
#pragma unroll
        for (int rr = 0; rr < 2; ++rr) {
#pragma unroll
            for (int k = 0; k < 8; ++k) p[rr][k] = c.pos[(row0 + rr) * TOPK + k];
            p[rr][8] = PROUTED + row0 + rr; }
        f32x4 v[2][4][2]; float ss[2] = {0.f, 0.f};
#pragma unroll
        for (int rr = 0; rr < 2; ++rr) {
#pragma unroll
            for (int i = 0; i < 4; ++i) {
                const int e = i * 512 + lane * 8; f32x4 a0 = {0.f, 0.f, 0.f, 0.f}, a1 = {0.f, 0.f, 0.f, 0.f};
#pragma unroll
                for (int k = 0; k < 9; ++k) { const u32x2 y = *(const u32x2*)(c.Y + (size_t)p[rr][k] * D + e);
                    const auto q0 = __builtin_amdgcn_cvt_pk_f32_fp8((int)y.x, false), q1 = __builtin_amdgcn_cvt_pk_f32_fp8((int)y.x, true), q2 = __builtin_amdgcn_cvt_pk_f32_fp8((int)y.y, false), q3 = __builtin_amdgcn_cvt_pk_f32_fp8((int)y.y, true);
                    a0[0] += q0[0]; a0[1] += q0[1]; a0[2] += q1[0]; a0[3] += q1[1]; a1[0] += q2[0]; a1[1] += q2[1]; a1[2] += q3[0]; a1[3] += q3[1]; }
                const float* xp = c.out + (size_t)(row0 + rr) * D + e;
                const f32x4 x0 = *(const f32x4*)xp, x1 = *(const f32x4*)(xp + 4), g0 = *(const f32x4*)(gt2 + e) * 0.0625f, g1 = *(const f32x4*)(gt2 + e + 4) * 0.0625f;
                v[rr][i][0] = x0 + g0 * a0; v[rr][i][1] = x1 + g1 * a1;
#pragma unroll
                for (int j = 0; j < 4; ++j) ss[rr] += v[rr][i][0][j] * v[rr][i][0][j] + v[rr][i][1][j] * v[rr][i][1][j];
            } }
#pragma unroll
        for (int rr = 0; rr < 2; ++rr) {
            const float r = rsqrtf(wave_sum_dpp(ss[rr]) * (1.f / D) + 1e-6f);
#pragma unroll
            for (int i = 0; i < 4; ++i) { const int e = i * 512 + lane * 8; float* op = c.out + (size_t)(row0 + rr) * D + e;
                *(f32x4*)op = v[rr][i][0] * r * *(const f32x4*)(c.normf_g + e); *(f32x4*)(op + 4) = v[rr][i][1] * r * *(const f32x4*)(c.normf_g + e + 4); } }
    }
}

namespace mx {
constexpr int ST128 = 272, ST64 = 144;
constexpr int FRAG_F4 = 8 * 8 * 64;
__device__ __forceinline__ f32x4 mfma16(bf16x8 a, bf16x8 b, f32x4 c) { return __builtin_amdgcn_mfma_f32_16x16x32_bf16(a, b, c, 0, 0, 0); }
template <int MT, int KS>
__device__ __forceinline__ void mma_nt(f32x4 (&acc)[MT], LAS const unsigned char* xs, int sx, LAS const unsigned char* ys, int sy, int fr, int fq) {
#pragma unroll
    for (int kk = 0; kk < KS; ++kk) {
        const bf16x8 b = *(const LAS bf16x8*)(ys + fr * sy + (kk * 32 + fq * 8) * 2);
#pragma unroll
        for (int m = 0; m < MT; ++m) { const bf16x8 a = *(const LAS bf16x8*)(xs + (16 * m + fr) * sx + (kk * 32 + fq * 8) * 2); acc[m] = mfma16(a, b, acc[m]); }
    }
}
__device__ __forceinline__ void lds_fence() { asm volatile("s_waitcnt lgkmcnt(0)" ::: "memory"); }
__device__ __forceinline__ u32x4 pack8(const float (&v)[8]) { u32x4 o; o.x = cvt_pk_bf16(v[0], v[1]); o.y = cvt_pk_bf16(v[2], v[3]); o.z = cvt_pk_bf16(v[4], v[5]); o.w = cvt_pk_bf16(v[6], v[7]); return o; }
__device__ __forceinline__ void unpack8(const u32x4 w, float (&v)[8]) { v[0] = bflo(w.x); v[1] = bfhi(w.x); v[2] = bflo(w.y); v[3] = bfhi(w.y); v[4] = bflo(w.z); v[5] = bfhi(w.z); v[6] = bflo(w.w); v[7] = bfhi(w.w); }
__device__ __forceinline__ void mfma_pad8(f32x4 (&a)[8]) { asm volatile("s_nop 15\n\ts_nop 7" : "+v"(a[0]), "+v"(a[1]), "+v"(a[2]), "+v"(a[3]), "+v"(a[4]), "+v"(a[5]), "+v"(a[6]), "+v"(a[7])); }
__device__ __forceinline__ void mfma_pad4(f32x4 (&a)[4]) { asm volatile("s_nop 15\n\ts_nop 7" : "+v"(a[0]), "+v"(a[1]), "+v"(a[2]), "+v"(a[3])); }
__device__ __forceinline__ void write_st(LAS unsigned char* stw, f32x4 (&S)[8], int fr, int fq) {
    mfma_pad8(S);
#pragma unroll
    for (int m = 0; m < 8; ++m) { u32x2 w; w.x = cvt_pk_bf16(S[m][0], S[m][1]); w.y = cvt_pk_bf16(S[m][2], S[m][3]); *(LAS u32x2*)(stw + fr * ST128 + (16 * m + 4 * fq) * 2) = w; }
}

__device__ __forceinline__ void gate_issue(u32x4 (&gp)[2], const bf16_t* gate0) {
    const int t_ = ltid(); const bf16_t* p = gate0 + (size_t)(t_ >> 3) * PW + (t_ & 7) * 16;
    gp[0] = *(const u32x4*)p; gp[1] = *(const u32x4*)(p + 8);
}
__device__ __forceinline__ void out_stage(LAS unsigned char* ot, LAS float* part, const f32x4 (&o)[4], const u32x4 (&gp)[2], const float* gnorm, bf16_t* out0, int wv, int lane, int fr, int fq) {
    float s_ = 0.f;
#pragma unroll
    for (int w = 0; w < 8; ++w) s_ += part[w * 64 + lane];
    const float rv = rsqrtf(s_ * (1.f / 128.f) + 1e-6f);
    const float gn = gnorm[wv * 16 + fr];
#pragma unroll
    for (int m = 0; m < 4; ++m)
#pragma unroll
        for (int r = 0; r < 4; ++r) { const int cc = 16 * m + 4 * fq + r; const float x = o[m][r] * __shfl(rv, cc) * gn;
            *(LAS bf16_t*)(ot + cc * ST128 + (wv * 16 + fr) * 2) = (bf16_t)(cvt_pk_bf16(x, x) & 0xffffu); }
    __syncthreads();
    const int t_ = ltid(), cc = t_ >> 3, sg = (t_ & 7) * 16;
#pragma unroll
    for (int hh = 0; hh < 2; ++hh) { float ov[8], gv[8];
        unpack8(*(LAS u32x4*)(ot + cc * ST128 + (sg + hh * 8) * 2), ov); unpack8(gp[hh], gv);
#pragma unroll
        for (int j = 0; j < 8; ++j) ov[j] *= siluf_(gv[j]);
        *(u32x4*)(out0 + (size_t)cc * D + sg + hh * 8) = pack8(ov); }
}

constexpr int H_QT = 0, H_KT = 17408, H_QI = 34816, H_KU = 52224, H_VT = 70656, H_P = 89088, H_DEC = 98304, H_OCT = 98816, H_F4 = 102912, H_PART = 103424, H_RINV = 105472, H_ST = 105728, H_LB = H_ST + 8 * 16 * ST128, H_END = H_LB + 512;
static_assert(H_END <= 147456, "hgrn lds");
template <bool OUT>
__device__ void hgrn_pass(CtxK& c, LAS unsigned char* lds) {
    const int tid = ltid(), wv = __builtin_amdgcn_readfirstlane(tid >> 6), lane = tid & 63, fr = lane & 15, fq = lane >> 4;
    LAS float* dec = (LAS float*)(lds + H_DEC); LAS float* oct = (LAS float*)(lds + H_OCT); LAS float* f4 = (LAS float*)(lds + H_F4);
    LAS float* part = (LAS float*)(lds + H_PART); LAS float* rinv = (LAS float*)(lds + H_RINV);
    LAS unsigned char* stw = lds + H_ST + wv * 16 * ST128;
    {
        const int wu = blockIdx.x, h = wu & 7, g = wu >> 3;
        f32x4 Sacc[8];
#pragma unroll
        for (int m = 0; m < 8; ++m) Sacc[m] = (f32x4){0.f, 0.f, 0.f, 0.f};
        if (OUT) {
            if (g > 0) { const f32x4* sp = (const f32x4*)c.hS + (size_t)(h * 32 + g) * FRAG_F4 + (wv * 8) * 64 + lane;
#pragma unroll
                for (int m = 0; m < 8; ++m) Sacc[m] = sp[m * 64]; }
            write_st(stw, Sacc, fr, fq);
        }
        LAS float* lbs = (LAS float*)(lds + H_LB);
        if (tid < 128) lbs[tid] = c.lb[h * 128 + tid];
        __syncthreads();
        float dsum = 0.f;
        u32x4 pf[8];
#define HP_ISSUE(i_) do { const int tq_ = ltid(), gq_ = tq_ >> 7; if (gq_ < 3 && (OUT || gq_ > 0)) { const bf16_t* b_ = c.proj + (size_t)((g * 8 + (i_)) * 64 + ((tq_ >> 4) & 7) * 8) * PW + h * 128 + (tq_ & 15) * 8 + (gq_ == 1 ? C_HI : C_HF); \
        _Pragma("unroll") for (int tt = 0; tt < 8; ++tt) pf[tt] = *(const u32x4*)(b_ + (size_t)tt * PW); } } while (0)
        HP_ISSUE(0);
        for (int i = 0; i < 8; ++i) {
            const int T0 = (g * 8 + i) * 64;
            const int tp = ltid(), grp = tp >> 7, to = (tp >> 4) & 7, co = tp & 15, c0 = to * 8, d0 = co * 8;
            const bool cum = grp == 2 || (OUT && grp == 0);
            float cs[8][8];
            if (cum) {
                float lbv[8];
                { const f32x4 l0 = *(LAS f32x4*)(lbs + d0), l1 = *(LAS f32x4*)(lbs + d0 + 4);
                  lbv[0] = l0[0]; lbv[1] = l0[1]; lbv[2] = l0[2]; lbv[3] = l0[3]; lbv[4] = l1[0]; lbv[5] = l1[1]; lbv[6] = l1[2]; lbv[7] = l1[3]; }
#pragma unroll
                for (int tt = 0; tt < 8; ++tt) {
                    float fv[8]; unpack8(pf[tt], fv);
#pragma unroll
                    for (int j = 0; j < 8; ++j) { const float lf = __logf(lbv[j] + (1.f - lbv[j]) * sigmoidf_(fv[j])); cs[tt][j] = tt ? cs[tt - 1][j] + lf : lf; }
                }
                if (grp == 2) {
#pragma unroll
                    for (int j = 0; j < 8; ++j) { oct[to * 128 + d0 + j] = cs[7][j]; if (to == 4) f4[d0 + j] = cs[0][j]; }
                }
            }
            __syncthreads();
            if (cum) {
                float pre[8], tot[8], bmid[8];
#pragma unroll
                for (int j = 0; j < 8; ++j) { float p = 0.f, t_ = 0.f, bm = 0.f;
#pragma unroll
                    for (int o = 0; o < 8; ++o) { const float x = oct[o * 128 + d0 + j]; p += o < to ? x : 0.f; bm += o < 4 ? x : 0.f; t_ += x; }
                    pre[j] = p; tot[j] = t_; bmid[j] = bm + f4[d0 + j]; }
                if (grp == 0) {
                    float ebm[8];
#pragma unroll
                    for (int j = 0; j < 8; ++j) ebm[j] = __expf(bmid[j]);
#pragma unroll
                    for (int tt = 0; tt < 8; ++tt) {
                        float qv[8], q1[8], q2[8];
                        unpack8(*(const u32x4*)(c.proj + (size_t)(T0 + c0 + tt) * PW + C_HQ + h * 128 + d0), qv);
#pragma unroll
                        for (int j = 0; j < 8; ++j) { const float q = siluf_(qv[j]) * 0.08838834764831845f; q1[j] = q * __expf(pre[j] + cs[tt][j] - bmid[j]); q2[j] = q1[j] * ebm[j]; }
                        *(LAS u32x4*)(lds + H_QT + (c0 + tt) * ST128 + d0 * 2) = pack8(q1); *(LAS u32x4*)(lds + H_QI + (c0 + tt) * ST128 + d0 * 2) = pack8(q2);
                    }
                } else {
                    if (to == 0) {
#pragma unroll
                        for (int j = 0; j < 8; ++j) dec[d0 + j] = __expf(tot[j]);
                    }
                    if (OUT) {
#pragma unroll
                        for (int tt = 0; tt < 8; ++tt) {
                            float k1[8];
#pragma unroll
                            for (int j = 0; j < 8; ++j) { const float lf = tt ? cs[tt][j] - cs[tt - 1][j] : cs[0][j]; k1[j] = (1.f - __expf(lf)) * __expf(bmid[j] - pre[j] - cs[tt][j]); }
                            *(LAS u32x4*)(lds + H_KT + (c0 + tt) * ST128 + d0 * 2) = pack8(k1);
                        }
                    }
#pragma unroll
                    for (int j = 0; j < 8; ++j) { float col[8];
#pragma unroll
                        for (int tt = 0; tt < 8; ++tt) { const float lf = tt ? cs[tt][j] - cs[tt - 1][j] : cs[0][j]; col[tt] = (1.f - __expf(lf)) * __expf(tot[j] - pre[j] - cs[tt][j]); }
                        *(LAS u32x4*)(lds + H_KU + (d0 + j) * ST64 + c0 * 2) = pack8(col); }
                }
            } else if (grp == 1) {
                float vb[8][8];
#pragma unroll
                for (int tt = 0; tt < 8; ++tt) unpack8(pf[tt], vb[tt]);
#pragma unroll
                for (int j = 0; j < 8; ++j) { float col[8];
#pragma unroll
                    for (int tt = 0; tt < 8; ++tt) col[tt] = vb[tt][j];
                    *(LAS u32x4*)(lds + H_VT + (d0 + j) * ST64 + c0 * 2) = pack8(col); }
            }
            __syncthreads();
            if (i + 1 < 8) HP_ISSUE(i + 1);
            u32x4 gpre[2];
            if (OUT) gate_issue(gpre, c.proj + (size_t)T0 * PW + C_HG + h * 128);
            if (!OUT && tid < 128) dsum += __logf(dec[tid]);
            f32x4 oacc[4];
            if (OUT) {
                { f32x4 sc[2] = {(f32x4){0.f, 0.f, 0.f, 0.f}, (f32x4){0.f, 0.f, 0.f, 0.f}};
                  const int nt = wv & 3, mb = (wv >> 2) * 2;
                  mma_nt<2, 4>(sc, lds + H_KT + mb * 16 * ST128, ST128, lds + H_QT + nt * 16 * ST128, ST128, fr, fq);
#pragma unroll
                  for (int m = 0; m < 2; ++m) { const int cc = nt * 16 + fr, s0 = (mb + m) * 16 + 4 * fq; u32x2 w;
                      w.x = cvt_pk_bf16(s0 + 0 <= cc ? sc[m][0] : 0.f, s0 + 1 <= cc ? sc[m][1] : 0.f); w.y = cvt_pk_bf16(s0 + 2 <= cc ? sc[m][2] : 0.f, s0 + 3 <= cc ? sc[m][3] : 0.f);
                      *(LAS u32x2*)(lds + H_P + cc * ST64 + s0 * 2) = w; } }
                __syncthreads();
#pragma unroll
                for (int m = 0; m < 4; ++m) oacc[m] = (f32x4){0.f, 0.f, 0.f, 0.f};
                mma_nt<4, 2>(oacc, lds + H_P, ST64, lds + H_VT + wv * 16 * ST64, ST64, fr, fq);
                mma_nt<4, 4>(oacc, lds + H_QI, ST128, stw, ST128, fr, fq);
#pragma unroll
                for (int m = 0; m < 4; ++m)
#pragma unroll
                    for (int r = 0; r < 4; ++r) { float q = oacc[m][r] * oacc[m][r]; q += __shfl_xor(q, 1); q += __shfl_xor(q, 2); q += __shfl_xor(q, 4); q += __shfl_xor(q, 8); if (fr == 0) part[wv * 64 + 16 * m + 4 * fq + r] = q; }
            }
#pragma unroll
            for (int m = 0; m < 8; ++m) { const f32x4 dv = *(LAS f32x4*)(dec + 16 * m + 4 * fq); Sacc[m] = Sacc[m] * dv; }
            mma_nt<8, 2>(Sacc, lds + H_KU, ST64, lds + H_VT + wv * 16 * ST64, ST64, fr, fq);
            if (OUT) {
                lds_fence();
                write_st(stw, Sacc, fr, fq);
                __syncthreads();
                out_stage(lds + H_QT, part, oacc, gpre, c.hgrn_onorm_g, c.ocat + (size_t)T0 * D + h * 128, wv, lane, fr, fq);
            }
            __syncthreads();
        }
#undef HP_ISSUE
        if (!OUT) {
            f32x4* sp = (f32x4*)c.hL + (size_t)(h * 32 + g) * FRAG_F4 + (wv * 8) * 64 + lane;
#pragma unroll
            for (int m = 0; m < 8; ++m) sp[m * 64] = Sacc[m];
            if (tid < 128) c.hD[(h * 32 + g) * 128 + tid] = __expf(dsum);
        }
    }
}
__device__ void hgrn_scan(CtxK& c) {
    const int e = blockIdx.x * 512 + ltid();
    if (e >= 8 * FRAG_F4) return;
    const int h = e / FRAG_F4, fi = e % FRAG_F4, m = (fi >> 6) & 7, lane = fi & 63, d0 = 16 * m + 4 * (lane >> 4);
    f32x4 s = {0.f, 0.f, 0.f, 0.f};
    for (int g = 0; g < 31; ++g) {
        const f32x4 dc = *(const f32x4*)(c.hD + (h * 32 + g) * 128 + d0);
        s = s * dc + ((const f32x4*)c.hL)[(size_t)(h * 32 + g) * FRAG_F4 + fi];
        ((f32x4*)c.hS)[(size_t)(h * 32 + g + 1) * FRAG_F4 + fi] = s;
    }
}

constexpr int B_T = 0, B_KBG = 9216, B_KU = 26624, B_VB = 45056, B_QD = 63488, B_AT = 80896, B_SC = 90112, BLOB = 90368;
constexpr int G_ST = BLOB, G_RV = G_ST + 8 * 16 * ST128, G_PART = G_RV + 8 * 16 * ST64, G_RINV = G_PART + 2048, G_END = G_RINV + 256;
static_assert(G_END <= 147456, "gdn lds");
constexpr int P_K = 0, P_Q = 17408, P_BETA = 34816, P_GC = P_BETA + 256, P_EG = P_GC + 256, P_EK = P_EG + 256;

__device__ void gdn_prep(CtxK& c, LAS unsigned char* lds, int h, int g) {
    const int tid = ltid(), wv = __builtin_amdgcn_readfirstlane(tid >> 6), lane = tid & 63, fr = lane & 15, fq = lane >> 4;
    LAS float* sbeta = (LAS float*)(lds + P_BETA); LAS float* sgc = (LAS float*)(lds + P_GC); LAS float* seg = (LAS float*)(lds + P_EG); LAS float* sek = (LAS float*)(lds + P_EK);
    u32x4 raw[11];
#define GR_ISSUE(i_) do { const int tq_ = ltid(); if (tq_ < 384) { const int T_ = (g * 8 + (i_)) * 64 + ((tq_ >> 4) & 7) * 8 - 3; const bf16_t* b_ = c.proj + C_GQKV + (tq_ >> 7) * 1024 + h * 128 + (tq_ & 15) * 8; \
        _Pragma("unroll") for (int r = 0; r < 11; ++r) raw[r] = T_ + r >= 0 ? *(const u32x4*)(b_ + (size_t)(T_ + r) * PW) : (u32x4){0u, 0u, 0u, 0u}; } } while (0)
    GR_ISSUE(0);
    for (int i = 0; i < 8; ++i) {
        const int n = g * 8 + i, T0 = n * 64;
        unsigned char* blob = (unsigned char*)c.gBlob + (size_t)(h * 256 + n) * BLOB;
        if (wv == 0) {
            const float ga = c.gab[(size_t)(T0 + lane) * 16 + h], gb = c.gab[(size_t)(T0 + lane) * 16 + 8 + h];
            const float gl_ = -__expf(c.a_log[h]) * softplusf_(ga + c.dt_bias[h]);
            float gc = gl_;
#pragma unroll
            for (int o = 1; o < 64; o <<= 1) { const float t_ = __shfl_up(gc, o); if (lane >= o) gc += t_; }
            const float glast = __shfl(gc, 63);
            sbeta[lane] = sigmoidf_(gb); sgc[lane] = gc; seg[lane] = __expf(gc); sek[lane] = __expf(glast - gc);
            if (lane == 0) *(float*)(blob + B_SC) = __expf(glast);
        }
        __syncthreads();
        const int tp = ltid(), part = tp >> 7, to = (tp >> 4) & 7, co = tp & 15, c0 = to * 8, d0 = co * 8;
        if (tp < 384) {
            const int chb = part * 1024 + h * 128 + d0;
            float val[8][8];
            {
                float wj[4][8];
#pragma unroll
                for (int j = 0; j < 4; ++j) { const f32x4 a = *(const f32x4*)(c.conv_w + j * 3072 + chb), b = *(const f32x4*)(c.conv_w + j * 3072 + chb + 4);
                    wj[j][0] = a[0]; wj[j][1] = a[1]; wj[j][2] = a[2]; wj[j][3] = a[3]; wj[j][4] = b[0]; wj[j][5] = b[1]; wj[j][6] = b[2]; wj[j][7] = b[3]; }
#pragma unroll
                for (int tt = 0; tt < 8; ++tt) {
                    float a[8] = {0.f, 0.f, 0.f, 0.f, 0.f, 0.f, 0.f, 0.f};
#pragma unroll
                    for (int j = 0; j < 4; ++j) { float xv[8]; unpack8(raw[tt + j], xv);
#pragma unroll
                        for (int jj = 0; jj < 8; ++jj) a[jj] += wj[j][jj] * xv[jj]; }
#pragma unroll
                    for (int jj = 0; jj < 8; ++jj) val[tt][jj] = siluf_(a[jj]);
                }
            }
            if (part < 2) {
#pragma unroll
                for (int tt = 0; tt < 8; ++tt) { float ss = 0.f;
#pragma unroll
                    for (int jj = 0; jj < 8; ++jj) ss += val[tt][jj] * val[tt][jj];
                    ss += __shfl_xor(ss, 1); ss += __shfl_xor(ss, 2); ss += __shfl_xor(ss, 4); ss += __shfl_xor(ss, 8);
                    const float rn = rsqrtf(ss + 1e-6f) * (part == 0 ? 0.08838834764831845f : 1.f);
#pragma unroll
                    for (int jj = 0; jj < 8; ++jj) val[tt][jj] *= rn; }
            }
            if (part == 0) {
#pragma unroll
                for (int tt = 0; tt < 8; ++tt) { const int cc = c0 + tt; *(LAS u32x4*)(lds + P_Q + cc * ST128 + d0 * 2) = pack8(val[tt]);
                    const float e = seg[cc]; float qd[8];
#pragma unroll
                    for (int jj = 0; jj < 8; ++jj) qd[jj] = val[tt][jj] * e;
                    *(u32x4*)(blob + B_QD + cc * ST128 + d0 * 2) = pack8(qd); }
            } else if (part == 1) {
#pragma unroll
                for (int tt = 0; tt < 8; ++tt) { const int cc = c0 + tt; *(LAS u32x4*)(lds + P_K + cc * ST128 + d0 * 2) = pack8(val[tt]);
                    const float e = seg[cc] * sbeta[cc]; float kb[8];
#pragma unroll
                    for (int jj = 0; jj < 8; ++jj) kb[jj] = val[tt][jj] * e;
                    *(u32x4*)(blob + B_KBG + cc * ST128 + d0 * 2) = pack8(kb); }
#pragma unroll
                for (int jj = 0; jj < 8; ++jj) { float col[8];
#pragma unroll
                    for (int tt = 0; tt < 8; ++tt) col[tt] = val[tt][jj] * sek[c0 + tt];
                    *(u32x4*)(blob + B_KU + (d0 + jj) * ST64 + c0 * 2) = pack8(col); }
            } else {
#pragma unroll
                for (int jj = 0; jj < 8; ++jj) { float col[8];
#pragma unroll
                    for (int tt = 0; tt < 8; ++tt) col[tt] = val[tt][jj] * sbeta[c0 + tt];
                    *(u32x4*)(blob + B_VB + (d0 + jj) * ST64 + c0 * 2) = pack8(col); }
            }
        }
        __syncthreads();
        if (i + 1 < 8) GR_ISSUE(i + 1);
        {
            const int nt = wv & 3, mb = (wv >> 2) * 2, jj = nt * 16 + fr;
            f32x4 kk2[2] = {(f32x4){0.f, 0.f, 0.f, 0.f}, (f32x4){0.f, 0.f, 0.f, 0.f}}, at2[2] = {(f32x4){0.f, 0.f, 0.f, 0.f}, (f32x4){0.f, 0.f, 0.f, 0.f}};
            mma_nt<2, 4>(kk2, lds + P_K + mb * 16 * ST128, ST128, lds + P_K + nt * 16 * ST128, ST128, fr, fq);
            mma_nt<2, 4>(at2, lds + P_K + mb * 16 * ST128, ST128, lds + P_Q + nt * 16 * ST128, ST128, fr, fq);
            float* at = c.gAT + (size_t)(h * 256 + n) * 4096;
            const float gj = sgc[jj];
#pragma unroll
            for (int m = 0; m < 2; ++m) { const int i0 = (mb + m) * 16 + 4 * fq; f32x4 av; float pv[4];
#pragma unroll
                for (int r = 0; r < 4; ++r) { const int ii = i0 + r; const float gi = sgc[ii];
                    av[r] = jj < ii ? sbeta[ii] * kk2[m][r] * __expf(gi - gj) : 0.f;
                    pv[r] = ii <= jj ? at2[m][r] * __expf(gj - gi) : 0.f; }
                *(f32x4*)(at + jj * 64 + i0) = av;
                u32x2 w; w.x = cvt_pk_bf16(pv[0], pv[1]); w.y = cvt_pk_bf16(pv[2], pv[3]);
                *(u32x2*)(blob + B_AT + jj * ST64 + i0 * 2) = w; }
        }
        __syncthreads();
    }
}
__device__ void gdn_invert(CtxK& c, LAS unsigned char* lds, int h, int g) {
    const int tid = ltid(), wv = __builtin_amdgcn_readfirstlane(tid >> 6), lane = tid & 63;
    const int n = g * 8 + wv;
    LAS float* at = (LAS float*)(lds + wv * 16384);
    const float* src = c.gAT + (size_t)(h * 256 + n) * 4096;
#pragma unroll
    for (int k = 0; k < 16; ++k) *(LAS f32x4*)(at + (k * 64 + lane) * 4) = *(const f32x4*)(src + (k * 64 + lane) * 4);
    lds_fence();
    float r[64];
    unsigned ata = (unsigned)(size_t)at;
#pragma unroll
    for (int j = 63; j >= 0; --j) {
        float acc = lane == j ? 1.f : 0.f;
        LAS const float* arow = (LAS const float*)(size_t)ata + j * 64;
#pragma unroll
        for (int m4 = ((j + 1) & ~3); m4 < 64; m4 += 4) {
            const f32x4 a = *(LAS const f32x4*)(arow + m4);
#pragma unroll
            for (int q = 0; q < 4; ++q) if (m4 + q > j) acc = __builtin_fmaf(-r[m4 + q], a[q], acc);
        }
        r[j] = acc;
        asm volatile("" : "+v"(ata) : "v"(acc));
    }
    unsigned char* blob = (unsigned char*)c.gBlob + (size_t)(h * 256 + n) * BLOB;
#pragma unroll
    for (int k = 0; k < 8; ++k) { float v8[8];
#pragma unroll
        for (int q = 0; q < 8; ++q) v8[q] = r[k * 8 + q];
        *(u32x4*)(blob + B_T + lane * ST64 + k * 16) = pack8(v8); }
}
template <int MODE>
__device__ void gdn_pass(CtxK& c, LAS unsigned char* lds, int h, int g) {
    const int tid = ltid(), wv = __builtin_amdgcn_readfirstlane(tid >> 6), lane = tid & 63, fr = lane & 15, fq = lane >> 4;
    LAS unsigned char* stw = lds + G_ST + wv * 16 * ST128; LAS unsigned char* rvw = lds + G_RV + wv * 16 * ST64;
    LAS float* part = (LAS float*)(lds + G_PART); LAS float* rinv = (LAS float*)(lds + G_RINV);
    f32x4 Sacc[8];
#pragma unroll
    for (int m = 0; m < 8; ++m) {
        if (MODE == 1) { const int v = 16 * wv + fr, d0 = 16 * m + 4 * fq; Sacc[m] = (f32x4){d0 == v ? 1.f : 0.f, d0 + 1 == v ? 1.f : 0.f, d0 + 2 == v ? 1.f : 0.f, d0 + 3 == v ? 1.f : 0.f}; }
        else Sacc[m] = (f32x4){0.f, 0.f, 0.f, 0.f};
    }
    if (MODE == 2 && g > 0) { const f32x4* sp = (const f32x4*)c.gS + (size_t)(h * 32 + g) * FRAG_F4 + (wv * 8) * 64 + lane;
#pragma unroll
        for (int m = 0; m < 8; ++m) Sacc[m] = sp[m * 64]; }
    write_st(stw, Sacc, fr, fq);
    constexpr int LIM = MODE == 2 ? B_SC : B_QD, NQ = (LIM + 8191) / 8192;
    u32x4 pre[NQ];
    const unsigned char* blob0 = (const unsigned char*)c.gBlob + (size_t)(h * 256 + g * 8) * BLOB;
#define GP_ISSUE(i_) do { const unsigned char* bp_ = blob0 + (size_t)(i_) * BLOB + ltid() * 16; _Pragma("unroll") for (int q = 0; q < NQ; ++q) if (q * 8192 + 8176 < LIM || ltid() * 16 + q * 8192 < LIM) pre[q] = *(const u32x4*)(bp_ + q * 8192); } while (0)
    GP_ISSUE(0);
    for (int i = 0; i < 8; ++i) {
        const int n = g * 8 + i, T0 = n * 64;
        { const int tl = ltid() * 16;
#pragma unroll
          for (int q = 0; q < NQ; ++q) if (q * 8192 + 8176 < LIM || tl + q * 8192 < LIM) *(LAS u32x4*)(lds + tl + q * 8192) = pre[q]; }
        const float dlast = *(const float*)(blob0 + (size_t)i * BLOB + B_SC);
        u32x4 gpre[2];
        if (MODE == 2) gate_issue(gpre, c.proj + (size_t)T0 * PW + C_GG + h * 128);
        __syncthreads();
        if (i + 1 < 8) GP_ISSUE(i + 1);
        { f32x4 R[4];
#pragma unroll
          for (int m = 0; m < 4; ++m) R[m] = (f32x4){0.f, 0.f, 0.f, 0.f};
          mma_nt<4, 4>(R, lds + B_KBG, ST128, stw, ST128, fr, fq);
#pragma unroll
          for (int m = 0; m < 4; ++m) { float x0 = 0.f, x1 = 0.f, x2 = 0.f, x3 = 0.f;
              if (MODE != 1) { const u32x2 vb = *(LAS u32x2*)(lds + B_VB + (16 * wv + fr) * ST64 + (16 * m + 4 * fq) * 2); x0 = bflo(vb.x); x1 = bfhi(vb.x); x2 = bflo(vb.y); x3 = bfhi(vb.y); }
              u32x2 w; w.x = cvt_pk_bf16(x0 - R[m][0], x1 - R[m][1]); w.y = cvt_pk_bf16(x2 - R[m][2], x3 - R[m][3]);
              *(LAS u32x2*)(rvw + fr * ST64 + (16 * m + 4 * fq) * 2) = w; } }
        lds_fence();
        { f32x4 VN[4];
#pragma unroll
          for (int m = 0; m < 4; ++m) VN[m] = (f32x4){0.f, 0.f, 0.f, 0.f};
          mma_nt<4, 2>(VN, lds + B_T, ST64, rvw, ST64, fr, fq);
          mfma_pad4(VN); lds_fence();
#pragma unroll
          for (int m = 0; m < 4; ++m) { u32x2 w; w.x = cvt_pk_bf16(VN[m][0], VN[m][1]); w.y = cvt_pk_bf16(VN[m][2], VN[m][3]); *(LAS u32x2*)(rvw + fr * ST64 + (16 * m + 4 * fq) * 2) = w; } }
        lds_fence();
        f32x4 O[4];
        if (MODE == 2) {
#pragma unroll
            for (int m = 0; m < 4; ++m) O[m] = (f32x4){0.f, 0.f, 0.f, 0.f};
            mma_nt<4, 4>(O, lds + B_QD, ST128, stw, ST128, fr, fq);
            mma_nt<4, 2>(O, lds + B_AT, ST64, rvw, ST64, fr, fq);
#pragma unroll
            for (int m = 0; m < 4; ++m)
#pragma unroll
                for (int r = 0; r < 4; ++r) { float q = O[m][r] * O[m][r]; q += __shfl_xor(q, 1); q += __shfl_xor(q, 2); q += __shfl_xor(q, 4); q += __shfl_xor(q, 8); if (fr == 0) part[wv * 64 + 16 * m + 4 * fq + r] = q; }
        }
#pragma unroll
        for (int m = 0; m < 8; ++m) Sacc[m] = Sacc[m] * dlast;
        mma_nt<8, 2>(Sacc, lds + B_KU, ST64, rvw, ST64, fr, fq);
        lds_fence();
        write_st(stw, Sacc, fr, fq);
        if (MODE == 2) {
            __syncthreads();
            out_stage(lds + B_KBG, part, O, gpre, c.gdn_onorm_g, c.ocat + (size_t)T0 * D + 1024 + h * 128, wv, lane, fr, fq);
        }
        __syncthreads();
    }
#undef GP_ISSUE
    if (MODE == 0) {
        f32x4* sp = (f32x4*)c.gB + (size_t)(h * 32 + g) * FRAG_F4 + (wv * 8) * 64 + lane;
#pragma unroll
        for (int m = 0; m < 8; ++m) sp[m * 64] = Sacc[m];
    }
    if (MODE == 1) {
        mfma_pad8(Sacc);
        LAS bf16_t* img = (LAS bf16_t*)lds;
#pragma unroll
        for (int m = 0; m < 8; ++m)
#pragma unroll
            for (int r = 0; r < 4; ++r) img[(16 * m + 4 * fq + r) * (ST128 / 2) + 16 * wv + fr] = (bf16_t)(cvt_pk_bf16(Sacc[m][r], Sacc[m][r]) & 0xffffu);
        __syncthreads();
        unsigned char* dst = (unsigned char*)c.gM + (size_t)(h * 32 + g) * (128 * ST128);
#pragma unroll
        for (int q = 0; q < 5; ++q) { const int o = tid * 16 + q * 8192; if (q < 4 || o < 128 * ST128) *(u32x4*)(dst + o) = *(LAS u32x4*)(lds + o); }
        __syncthreads();
    }
}
__device__ void gdn_scan(CtxK& c, LAS unsigned char* lds, int h) {
    const int tid = ltid(), wv = __builtin_amdgcn_readfirstlane(tid >> 6), lane = tid & 63, fr = lane & 15, fq = lane >> 4;
    LAS unsigned char* stw = lds + G_ST + wv * 16 * ST128;
    f32x4 Sacc[8], Bn[8]; u32x4 mp[5];
#pragma unroll
    for (int m = 0; m < 8; ++m) Sacc[m] = (f32x4){0.f, 0.f, 0.f, 0.f};
#define GS_ISSUE(g_) do { const unsigned char* src_ = (const unsigned char*)c.gM + (size_t)(h * 32 + (g_)) * (128 * ST128) + tid * 16; \
        _Pragma("unroll") for (int q = 0; q < 5; ++q) if (q < 4 || tid * 16 + q * 8192 < 128 * ST128) mp[q] = *(const u32x4*)(src_ + q * 8192); \
        const f32x4* bp_ = (const f32x4*)c.gB + (size_t)(h * 32 + (g_)) * FRAG_F4 + (wv * 8) * 64 + lane; \
        _Pragma("unroll") for (int m = 0; m < 8; ++m) Bn[m] = bp_[m * 64]; } while (0)
    GS_ISSUE(0);
    for (int g = 0; g < 31; ++g) {
#pragma unroll
        for (int q = 0; q < 5; ++q) if (q < 4 || tid * 16 + q * 8192 < 128 * ST128) *(LAS u32x4*)(lds + tid * 16 + q * 8192) = mp[q];
        write_st(stw, Sacc, fr, fq);
#pragma unroll
        for (int m = 0; m < 8; ++m) Sacc[m] = Bn[m];
        __syncthreads();
        if (g + 1 < 31) GS_ISSUE(g + 1);
        mma_nt<8, 4>(Sacc, lds, ST128, stw, ST128, fr, fq);
        f32x4* sp = (f32x4*)c.gS + (size_t)(h * 32 + g + 1) * FRAG_F4 + (wv * 8) * 64 + lane;
#pragma unroll
        for (int m = 0; m < 8; ++m) sp[m * 64] = Sacc[m];
        __syncthreads();
    }
#undef GS_ISSUE
}
}
__device__ void ph_hgrn1(CtxK& c, LAS unsigned char* lds) { mx::hgrn_pass<false>(c, lds); }
__device__ void ph_hgrn2(CtxK& c, LAS unsigned char* lds) { mx::hgrn_scan(c); }
__device__ void ph_hgrn3(CtxK& c, LAS unsigned char* lds) { mx::hgrn_pass<true>(c, lds); }
__device__ void ph_gdn1(CtxK& c, LAS unsigned char* lds) {
    const int wu = blockIdx.x, h = wu & 7, g = wu >> 3;
    mx::gdn_prep(c, lds, h, g); __syncthreads();
    asm volatile("s_waitcnt vmcnt(0)" ::: "memory"); __syncthreads();
    mx::gdn_invert(c, lds, h, g);
    asm volatile("s_waitcnt vmcnt(0)" ::: "memory"); __syncthreads();
    mx::gdn_pass<0>(c, lds, h, g); __syncthreads();
    mx::gdn_pass<1>(c, lds, h, g); __syncthreads();
}
__device__ void ph_gdn2(CtxK& c, LAS unsigned char* lds) { if (blockIdx.x < 8) mx::gdn_scan(c, lds, blockIdx.x); }
__device__ void ph_gdn3(CtxK& c, LAS unsigned char* lds) { const int wu = blockIdx.x; mx::gdn_pass<2>(c, lds, wu & 7, wu >> 3); }

constexpr int N2_LA = 0, N2_LB = 8192, N2_XH = 16384, N2_XL = N2_XH + 17408, N2_Y = N2_XL + 17408, N2_LOG = N2_Y + 34816, N2_RS = N2_LOG + 64 * 65 * 4, N2_IDX = N2_RS + 256, N2_BIAS = N2_IDX + 2048, N2_END = N2_BIAS + 256;
static_assert(N2_END <= 147456, "norm2 lds");
__device__ void ph_norm2(CtxK& c, LAS unsigned char* lds) {
    const int tid = ltid(), wg = blockIdx.x, lane = tid & 63, wv = __builtin_amdgcn_readfirstlane(tid >> 6), fr = lane & 15, fq = lane >> 4;
    LAS float* la = (LAS float*)(lds + N2_LA); LAS float* lb_ = (LAS float*)(lds + N2_LB); LAS float* lg = (LAS float*)(lds + N2_LOG); LAS float* rs = (LAS float*)(lds + N2_RS);
    LAS int* idxt = (LAS int*)(lds + N2_IDX); LAS float* bias2 = (LAS float*)(lds + N2_BIAS);
    for (int j = tid; j < D; j += 512) { la[j] = c.norm2_g[j] * (1.f + c.mod[4 * D + j]); lb_[j] = c.mod[3 * D + j]; }
    if (tid < 64) bias2[tid] = c.rbias2[tid];
    __syncthreads();
    const int tok0 = wg * 64;
    f32x4 vn[8];
    { const float* xr = c.out + (size_t)(tok0 + wv * 8) * D;
#pragma unroll
      for (int i = 0; i < 8; ++i) vn[i] = *(const f32x4*)(xr + i * 256 + lane * 4); }
    for (int rr = 0; rr < 8; ++rr) {
        const int row = tok0 + wv * 8 + rr;
        f32x4 v[8]; float ss = 0.f;
#pragma unroll
        for (int i = 0; i < 8; ++i) { v[i] = vn[i]; ss += v[i][0] * v[i][0] + v[i][1] * v[i][1] + v[i][2] * v[i][2] + v[i][3] * v[i][3]; }
        if (rr + 1 < 8) { const float* xr = c.out + (size_t)(row + 1) * D;
#pragma unroll
            for (int i = 0; i < 8; ++i) vn[i] = *(const f32x4*)(xr + i * 256 + lane * 4); }
        ss = wave_sum(ss); const float r = rsqrtf(ss * (1.f / D) + 1e-6f);
        if (lane == 0) rs[wv * 8 + rr] = r;
#pragma unroll
        for (int i = 0; i < 8; ++i) { const int e = i * 256 + lane * 4; const f32x4 a = *(LAS f32x4*)(la + e), b = *(LAS f32x4*)(lb_ + e); const f32x4 y = v[i] * r * a + b;
            *(unsigned*)(c.h2 + (size_t)row * D + e) = cvt4_fp8(4.f * y[0], 4.f * y[1], 4.f * y[2], 4.f * y[3]); }
    }
    const int xrow = tid >> 3, xseg = (tid & 7) * 16;
    f32x4 xr_[4]; u32x4 yr_[5];
    auto issue = [&](int ch) {
        const float* xp = c.out + (size_t)(tok0 + xrow) * D + ch * 128 + xseg;
#pragma unroll
        for (int q = 0; q < 4; ++q) xr_[q] = *(const f32x4*)(xp + q * 4);
        const unsigned char* yp = (const unsigned char*)c.rwimg + (size_t)ch * 34816 + tid * 16;
#pragma unroll
        for (int q = 0; q < 4; ++q) yr_[q] = *(const u32x4*)(yp + q * 8192);
        if (tid < 128) yr_[4] = *(const u32x4*)(yp + 32768);
    };
    issue(0);
    f32x4 acc[2] = {(f32x4){0.f, 0.f, 0.f, 0.f}, (f32x4){0.f, 0.f, 0.f, 0.f}};
    const int mt = wv >> 1, nb = (wv & 1) * 2;
    for (int ch = 0; ch < 16; ++ch) {
        __syncthreads();
        { float hi[16], lo[16];
#pragma unroll
          for (int q = 0; q < 4; ++q)
#pragma unroll
              for (int j = 0; j < 4; ++j) { const float x = xr_[q][j]; const float h = __uint_as_float(cvt_pk_bf16(x, x) << 16); hi[q * 4 + j] = h; lo[q * 4 + j] = x - h; }
          float t8[8];
#pragma unroll
          for (int hh = 0; hh < 2; ++hh) {
#pragma unroll
              for (int j = 0; j < 8; ++j) t8[j] = hi[hh * 8 + j];
              *(LAS u32x4*)(lds + N2_XH + xrow * 272 + (xseg + hh * 8) * 2) = mx::pack8(t8);
#pragma unroll
              for (int j = 0; j < 8; ++j) t8[j] = lo[hh * 8 + j];
              *(LAS u32x4*)(lds + N2_XL + xrow * 272 + (xseg + hh * 8) * 2) = mx::pack8(t8); }
#pragma unroll
          for (int q = 0; q < 4; ++q) *(LAS u32x4*)(lds + N2_Y + tid * 16 + q * 8192) = yr_[q];
          if (tid < 128) *(LAS u32x4*)(lds + N2_Y + tid * 16 + 32768) = yr_[4]; }
        __syncthreads();
        if (ch + 1 < 16) issue(ch + 1);
#pragma unroll
        for (int kk = 0; kk < 4; ++kk) {
            const int ko = (kk * 32 + fq * 8) * 2;
            const bf16x8 ah = *(const LAS bf16x8*)(lds + N2_XH + (16 * mt + fr) * 272 + ko), al = *(const LAS bf16x8*)(lds + N2_XL + (16 * mt + fr) * 272 + ko);
#pragma unroll
            for (int n = 0; n < 2; ++n) {
                const bf16x8 bh = *(const LAS bf16x8*)(lds + N2_Y + (16 * (nb + n) + fr) * 272 + ko), bl = *(const LAS bf16x8*)(lds + N2_Y + 17408 + (16 * (nb + n) + fr) * 272 + ko);
                acc[n] = mx::mfma16(ah, bh, acc[n]); acc[n] = mx::mfma16(ah, bl, acc[n]); acc[n] = mx::mfma16(al, bh, acc[n]);
            }
        }
    }
#pragma unroll
    for (int n = 0; n < 2; ++n)
#pragma unroll
        for (int r = 0; r < 4; ++r) lg[(16 * mt + 4 * fq + r) * 65 + 16 * (nb + n) + fr] = acc[n][r];
    __syncthreads();
    const float rb = c.router_bias[lane], b2 = bias2[lane];
    for (int rr = 0; rr < 8; ++rr) {
        const int lr = wv * 8 + rr, t = tok0 + lr;
        const float s = sigmoidf_(lg[lr * 65 + lane] * rs[lr] + b2), b = s + rb;
        int rk = 0;
#pragma unroll
        for (int x = 1; x < 8; ++x) { const float ob = __shfl_xor(b, x); const int ol = lane ^ x; rk += (ob > b || (ob == b && ol < lane)) ? 1 : 0; }
        float gs = rk < 2 ? b : 0.f; gs += __shfl_xor(gs, 1); gs += __shfl_xor(gs, 2); gs += __shfl_xor(gs, 4);
        int grk = 0;
#pragma unroll
        for (int x = 8; x < 64; x += 8) { const float og = __shfl_xor(gs, x); const int ol = lane ^ x; grk += (og > gs || (og == gs && ol < lane)) ? 1 : 0; }
        float mb = grk < 4 ? b : -INFINITY;
        float wsum = 0.f; int myk = -1;
        for (int k = 0; k < TOPK; ++k) {
            float m = mb;
#pragma unroll
            for (int o = 32; o >= 1; o >>= 1) m = fmaxf(m, __shfl_xor(m, o));
            const unsigned long long bal = __ballot(mb == m); const int win = __ffsll((long long)bal) - 1;
            const float sw = __shfl(s, win); wsum += sw;
            if (lane == win) { mb = -INFINITY; myk = k; }
        }
        if (myk >= 0) { c.idx[t * TOPK + myk] = lane; c.wts[t * TOPK + myk] = s / wsum * 2.5f; idxt[lr * TOPK + myk] = lane; }
    }
    __syncthreads();
    if (tid < 64) { int n = 0;
        for (int p = 0; p < 512; ++p) if (idxt[p] == tid) { c.rnk[wg * 512 + p] = n; ++n; }
        c.tile_cnt[wg * 64 + tid] = n; }
}
__device__ void ph_route(CtxK& c, LAS unsigned char* lds) {
    const int tid = ltid(), b = blockIdx.x, e = tid & 63, part = tid >> 6;
    LAS int* psum = (LAS int*)lds; LAS int* pbel = psum + 512; LAS int* tot = pbel + 512; LAS int* offb = tot + 64; LAS int* pst = offb + 64;
    { int sa = 0, sb = 0;
      for (int tl = part * 32; tl < part * 32 + 32; ++tl) { const int v = c.tile_cnt[tl * 64 + e]; sa += v; sb += tl < b ? v : 0; }
      psum[part * 64 + e] = sa; pbel[part * 64 + e] = sb; }
    __syncthreads();
    if (tid < 64) {
        int t_ = 0, o_ = 0;
#pragma unroll
        for (int q = 0; q < 8; ++q) { t_ += psum[q * 64 + e]; o_ += pbel[q * 64 + e]; }
        const int pad = (t_ + 255) & ~255; int inc = pad;
#pragma unroll
        for (int o = 1; o < 64; o <<= 1) { const int x = __shfl_up(inc, o); if (e >= o) inc += x; }
        const int ps = inc - pad;
        tot[e] = t_; offb[e] = o_; pst[e] = ps;
        if (b == 0) {
            const int b0 = ps >> 8, nbe = pad >> 8;
            for (int j = 0; j < nbe; ++j) { c.blk_row[b0 + j] = ps + j * 256; c.blk_exp[b0 + j] = e; }
            const int nbr = __shfl(inc, 63) >> 8;
            c.blk_row[nbr + e] = PROUTED + e * 256; c.blk_exp[nbr + e] = NE;
            if (e == 0) *c.nent = nbr + S / 256;
        }
        c.tok_p[PROUTED + b * 64 + e] = b * 64 + e; c.w_p[PROUTED + b * 64 + e] = 1.f;
    }
    __syncthreads();
    { const int p = b * 512 + tid, ex = c.idx[p], d = pst[ex] + offb[ex] + c.rnk[p];
      c.tok_p[d] = p >> 3; c.w_p[d] = c.wts[p]; c.pos[p] = d; }
    if (b < NE) { const int ps = pst[b], t_ = tot[b], pe = (t_ + 255) & ~255;
        for (int r = t_ + tid; r < pe; r += 512) { c.tok_p[ps + r] = 0; c.w_p[ps + r] = 0.f; } }
}

constexpr int LDS_BYTES = 163840, LDS_MAIN = LDS_BYTES - 16;
static_assert(gm::VBOFF + 512 * 8 <= LDS_MAIN, "lds map");
__global__ void __launch_bounds__(512, 2) k_mega(Ctx c) {
    extern __shared__ __attribute__((aligned(16))) unsigned char smem[];
    LAS unsigned char* lds = (LAS unsigned char*)smem;
    if (ltid() == 0) *(LAS u32x4*)(lds + LDS_MAIN) = (u32x4){0u, 0u, 0u, 0u};
    __syncthreads();
    CtxK* kp = (CtxK*)__builtin_amdgcn_kernarg_segment_ptr();
    (void)xcd_barrier_post(c.bar, (volatile LAS unsigned*)(lds + LDS_MAIN));
#define PHASE(fn) do { const CtxK* kp_ = kp; asm volatile("" : "+s"(kp_)); fn(*kp_, lds); __syncthreads(); } while (0)
#define GRID_BARRIER() do { const CtxK* kp_ = kp; asm volatile("" : "+s"(kp_)); XcdBarrier bb_; bb_.bar = kp_->bar; bb_.x = xb_xcc_id(); bb_.st = (volatile LAS unsigned*)(lds + LDS_MAIN); xcd_barrier(bb_); } while (0)
    PHASE(ph_pro1);      GRID_BARRIER();
    PHASE(ph_norm1);     GRID_BARRIER();
    PHASE(ph_gemm1);     GRID_BARRIER();
    PHASE(ph_hgrn1);     PHASE(ph_gdn1);  GRID_BARRIER();
    PHASE(ph_hgrn2);     PHASE(ph_gdn2);  PHASE(ph_cvt_exp); GRID_BARRIER();
    PHASE(ph_hgrn3);     PHASE(ph_gdn3);  GRID_BARRIER();
    PHASE(ph_gemm2);     GRID_BARRIER();
    PHASE(ph_gemm3);     GRID_BARRIER();
    PHASE(ph_norm2);     GRID_BARRIER();
    PHASE(ph_route);     GRID_BARRIER();
    PHASE(ph_moe_gu);    GRID_BARRIER();
    PHASE(ph_moe_dn);    GRID_BARRIER();
    PHASE(ph_final);
#undef PHASE
#undef GRID_BARRIER
}

extern "C" void kernel_launch(void* const* d_in, const int* in_sizes, int n_in, void* d_out, int out_size, void* d_ws, size_t ws_size, hipStream_t stream) {
    Ctx c{};
    const float** ip = (const float**)&c.x;
    for (int i = 0; i < 25; ++i) ip[i] = (const float*)d_in[i];
    c.out = (float*)d_out;
    char* ws = (char*)d_ws; constexpr size_t MB = 1024 * 1024;
    c.bar = (unsigned*)ws;
    c.modp = (float*)(ws + 64 * 1024); c.mod = (float*)(ws + 320 * 1024); c.lb = (float*)(ws + 384 * 1024);
    c.cnt = (int*)(ws + 392 * 1024); c.nent = (int*)(ws + 396 * 1024); c.blk_row = (int*)(ws + 400 * 1024); c.blk_exp = (int*)(ws + 404 * 1024);
    c.idx = (int*)(ws + 1 * MB); c.wts = (float*)(ws + 2 * MB); c.tok_p = (int*)(ws + 3 * MB); c.w_p = (float*)(ws + 4 * MB); c.pos = (int*)(ws + 5 * MB);
    c.gab = (float*)(ws + 6 * MB); c.gbeta = (float*)(ws + 7 * MB + 0); c.gdec = (float*)(ws + 7 * MB + 512 * 1024);
    c.rwimg = (bf16_t*)(ws + 8 * MB); c.rbias2 = (float*)(ws + 9 * MB); c.tile_cnt = (int*)(ws + 9 * MB + 4096); c.rnk = (int*)(ws + 10 * MB);
    char* big = ws + 16 * MB;
    auto at = [&](size_t mib) { return big + mib * MB; };
    c.dn_t = (unsigned char*)at(0); c.gu_t = (unsigned char*)at(130);
    c.win_t = (bf16_t*)at(0); c.h1 = (bf16_t*)at(48); c.gAT = (float*)at(112);
    c.proj = (bf16_t*)at(390); c.gBlob = (unsigned char*)at(774); c.merged = (bf16_t*)at(774);
    c.gM = (unsigned char*)at(951); c.gB = (float*)at(960); c.hL = (float*)at(976); c.gS = (float*)at(992); c.hS = (float*)at(1008); c.hD = (float*)at(1024);
    c.wa_t = (bf16_t*)at(1025); c.wb_t = (bf16_t*)at(1029); c.wout_t = (bf16_t*)at(1033); c.ocat = (bf16_t*)at(1041);
    c.Y = (unsigned char*)at(130); c.hid = (unsigned char*)at(770); c.h2 = (unsigned char*)at(930);
    static_assert((size_t)NEX * D * FF * 2 <= 130 * MB && (size_t)NEX * 1024 * D * 2 <= 260 * MB && (size_t)PW * D * 2 <= 48 * MB && (size_t)S * D * 2 <= 64 * MB, "map A");
    static_assert((size_t)S * PW * 2 <= 384 * MB && (size_t)2048 * mx::BLOB <= 177 * MB && (size_t)256 * 128 * mx::ST128 <= 9 * MB && (size_t)PTOT * D * 2 <= 640 * MB && (size_t)PTOT * FF * 2 <= 160 * MB, "map B");
    const size_t need = 16 * MB + 1105 * MB;
    if (ws_size < need) { fprintf(stderr, "kernel_launch: workspace too small: %zu < %zu\n", ws_size, need); return; }

    static int grid = 0;
    if (!grid) {
        int dev = 0, cus = 0, per_cu = 0;
        hipGetDevice(&dev); hipDeviceGetAttribute(&cus, hipDeviceAttributeMultiprocessorCount, dev);
        hipFuncSetAttribute((const void*)k_mega, hipFuncAttributeMaxDynamicSharedMemorySize, LDS_BYTES);
        hipOccupancyMaxActiveBlocksPerMultiprocessor(&per_cu, (const void*)k_mega, 512, LDS_BYTES);
        if (per_cu < 1) fprintf(stderr, "kernel_launch: occupancy query reports %d blocks per CU\n", per_cu);
        grid = cus;
        if (grid != 256) { fprintf(stderr, "kernel_launch: built for a 256-CU device (token-mixer units = workgroups); got %d CUs\n", cus); grid = -1; }
    }
    if (grid < 0) return;
    hipMemsetAsync(c.bar, 0, XCD_BAR_WORDS * sizeof(unsigned), stream);
    hipLaunchKernelGGL(k_mega, dim3(grid), dim3(512), LDS_BYTES, stream, c);
}
```

```cpp
#include <hip/hip_runtime.h>
#include <stdint.h>
#include <stdio.h>

#define LAS __attribute__((address_space(3)))
typedef unsigned short bf16_t;
typedef short bf16x8 __attribute__((ext_vector_type(8)));
typedef float f32x4 __attribute__((ext_vector_type(4)));
typedef unsigned u32x4 __attribute__((ext_vector_type(4)));
typedef unsigned u32x2 __attribute__((ext_vector_type(2)));
typedef int v4i __attribute__((ext_vector_type(4)));
typedef int v8i __attribute__((ext_vector_type(8)));

constexpr int S = 16384, D = 2048, INW = 12304, PW = 12288, NE = 64, TOPK = 8, TK = S * TOPK, FF = 512;
constexpr int NEX = NE + 1;
constexpr int PROUTED = 147456, PTOT = PROUTED + S, NBLK_MAX = PROUTED / 256;
constexpr int C_HQ = 0, C_HF = 1024, C_HI = 2048, C_HG = 3072, C_GQKV = 4096, C_GG = 7168, C_MGA = 8192, C_MGB = 10240;
constexpr int WIN_GAB = 7168;

__device__ __forceinline__ float rcpf_(float x) { return __builtin_amdgcn_rcpf(x); }
__device__ __forceinline__ float sigmoidf_(float x) { return rcpf_(1.f + __expf(-x)); }
__device__ __forceinline__ float siluf_(float x) { return x * rcpf_(1.f + __expf(-x)); }
__device__ __forceinline__ float softplusf_(float x) { return x > 20.f ? x : log1pf(expf(x)); }
__device__ __forceinline__ float bf2f(bf16_t b) { return __uint_as_float(((unsigned)b) << 16); }
__device__ __forceinline__ float bflo(unsigned w) { return __uint_as_float(w << 16); }
__device__ __forceinline__ float bfhi(unsigned w) { return __uint_as_float(w & 0xffff0000u); }
__device__ __forceinline__ unsigned cvt_pk_bf16(float lo, float hi) { unsigned r; asm volatile("v_cvt_pk_bf16_f32 %0, %1, %2" : "=v"(r) : "v"(lo), "v"(hi)); return r; }
__device__ __forceinline__ unsigned cvt4_fp8(float a, float b, float c_, float d) {
    a = fminf(fmaxf(a, -448.f), 448.f); b = fminf(fmaxf(b, -448.f), 448.f); c_ = fminf(fmaxf(c_, -448.f), 448.f); d = fminf(fmaxf(d, -448.f), 448.f);
    int w = __builtin_amdgcn_cvt_pk_fp8_f32(a, b, 0, false); w = __builtin_amdgcn_cvt_pk_fp8_f32(c_, d, w, true); return (unsigned)w; }
__device__ __forceinline__ int ltid() { int t = threadIdx.x; asm volatile("" : "+v"(t)); return t; }
__device__ __forceinline__ float wave_sum_dpp(float v) {
    v += __builtin_bit_cast(float, __builtin_amdgcn_update_dpp(0, __builtin_bit_cast(int, v), 0x128, 0xf, 0xf, false));
    v += __builtin_bit_cast(float, __builtin_amdgcn_update_dpp(0, __builtin_bit_cast(int, v), 0x124, 0xf, 0xf, false));
    v += __builtin_bit_cast(float, __builtin_amdgcn_update_dpp(0, __builtin_bit_cast(int, v), 0x122, 0xf, 0xf, false));
    v += __builtin_bit_cast(float, __builtin_amdgcn_update_dpp(0, __builtin_bit_cast(int, v), 0x121, 0xf, 0xf, false));
    const int b = __builtin_bit_cast(int, v);
    return __builtin_bit_cast(float, __builtin_amdgcn_readlane(b, 0)) + __builtin_bit_cast(float, __builtin_amdgcn_readlane(b, 16)) + __builtin_bit_cast(float, __builtin_amdgcn_readlane(b, 32)) + __builtin_bit_cast(float, __builtin_amdgcn_readlane(b, 48));
}
__device__ __forceinline__ float wave_sum(float v) {
#pragma unroll
    for (int o = 32; o >= 1; o >>= 1) v += __shfl_xor(v, o);
    return v;
}


#define XB_TMO      128
#define XB_XCNT(j)  (256  + 64 * (j))
#define XB_XSUB(j)  (1280 + 64 * (j))
#define XB_XGEN(j)  (2304 + 64 * (j))
#define XB_TOP      3328
#define XB_TOPGEN   3392
#define XCD_BAR_WORDS 3456
#define XB_SPIN_CAP (1u << 18)
__device__ __forceinline__ unsigned xb_ld(unsigned* p)              { return __hip_atomic_load(p, __ATOMIC_RELAXED, __HIP_MEMORY_SCOPE_AGENT); }
__device__ __forceinline__ unsigned xb_add(unsigned* p, unsigned v) { return __hip_atomic_fetch_add(p, v, __ATOMIC_RELAXED, __HIP_MEMORY_SCOPE_AGENT); }
__device__ __forceinline__ unsigned xb_xcc_id() { return (unsigned)__builtin_amdgcn_s_getreg((3 << 11) | 20) & 0xFu; }
#define XB_SPIN(cond, bar) do { unsigned _sp = 0; while (cond) { __builtin_amdgcn_s_sleep(1); \
    if ((++_sp & 255u) == 0u) { if (xb_ld(&(bar)[XB_TMO])) break; if (_sp > XB_SPIN_CAP) { atomicAdd(&(bar)[XB_TMO], 1u); break; } } } } while (0)
struct XcdBarrier { unsigned* bar; unsigned x; volatile LAS unsigned* st; };
__device__ __forceinline__ XcdBarrier xcd_barrier_post(unsigned* bar, volatile LAS unsigned* st) {
    XcdBarrier b; b.bar = bar; b.x = xb_xcc_id(); b.st = st;
    if (threadIdx.x == 0) (void)xb_add(&bar[XB_XCNT(b.x)], 1u);
    return b;
}
__device__ __forceinline__ void xcd_barrier_complete(unsigned* bar, unsigned x, unsigned& nloc, unsigned& nx) {
    const unsigned G = gridDim.x * gridDim.y * gridDim.z;
    unsigned sum, cnt, mine, sp = 0u;
    for (;;) {
        sum = 0u; cnt = 0u; mine = 0u;
#pragma unroll
        for (unsigned j = 0; j < 16; ++j) { const unsigned c = xb_ld(&bar[XB_XCNT(j)]); sum += c; cnt += (c > 0u) ? 1u : 0u; mine = (j == x) ? c : mine; }
        if (sum == G) break;
        __builtin_amdgcn_s_sleep(1);
        if ((++sp & 255u) == 0u) { if (xb_ld(&bar[XB_TMO])) break; if (sp > XB_SPIN_CAP) { atomicAdd(&bar[XB_TMO], 1u); break; } }
    }
    nloc = mine > 0u ? mine : 1u; nx = cnt > 0u ? cnt : 1u;
}
__device__ __forceinline__ void xcd_barrier(const XcdBarrier& b) {
    asm volatile("s_waitcnt vmcnt(0)" ::: "memory");
    __syncthreads();
    if (threadIdx.x == 0) {
        unsigned* bar = b.bar;
        __builtin_amdgcn_s_waitcnt(0);
        unsigned nloc = b.st[0], nx = b.st[1];
        if (nloc == 0u) { xcd_barrier_complete(bar, b.x, nloc, nx); b.st[0] = nloc; b.st[1] = nx; }
        const unsigned old = xb_add(&bar[XB_XSUB(b.x)], 1u);
        const unsigned gen = old / nloc;
        if (old + 1u == (gen + 1u) * nloc) {
            __builtin_amdgcn_fence(__ATOMIC_RELEASE, "agent");
            asm volatile("s_waitcnt vmcnt(0)" ::: "memory");
            const unsigned og = xb_add(&bar[XB_TOP], 1u);
            const unsigned tg = og / nx;
            if (og + 1u == (tg + 1u) * nx) xb_add(&bar[XB_TOPGEN], 1u);
            else XB_SPIN(xb_ld(&bar[XB_TOPGEN]) == tg, bar);
            __builtin_amdgcn_fence(__ATOMIC_ACQUIRE, "agent");
            xb_add(&bar[XB_XGEN(b.x)], 1u);
            asm volatile("s_waitcnt vmcnt(0)" ::: "memory");
        } else {
            XB_SPIN(xb_ld(&bar[XB_XGEN(b.x)]) == gen, bar);
            __builtin_amdgcn_fence(__ATOMIC_ACQUIRE, "agent");
            asm volatile("s_waitcnt vmcnt(0)" ::: "memory");
        }
    }
    __syncthreads();
}

namespace gm {
constexpr int BM = 256, BK = 64, HALF = 128, HTB = HALF * BK * 2, STAGE_BYTES = 8 * HTB;
__host__ __device__ __forceinline__ int lds_byte(int r, int c) { const int st = (r >> 4) * 2 + (c >> 5), rr = r & 15, cc = c & 31, ob = rr * 64 + cc * 2; return st * 1024 + (ob ^ (((ob >> 9) & 1) << 5)); }
__host__ __device__ __forceinline__ void stage_rc(int b, int& R, int& C) { const int st = b / 1024, sb = b % 1024, swz = sb ^ (((sb >> 9) & 1) << 5); R = (st >> 1) * 16 + swz / 64; C = (st & 1) * 32 + (swz % 64) / 2; }
__host__ __device__ __forceinline__ int perm32(int rho) { const int n = rho >> 4, i = rho & 15; return 8 * (i >> 2) + 4 * n + (i & 3); }

struct Unit { int pm, pn, aux; const char* Bp; };
constexpr int UOFF = STAGE_BYTES + 256 + 10240, VBOFF = UOFF + 2 * 512 * 16;
__device__ __forceinline__ void put_offs(LAS unsigned char* lds, int ui, unsigned a00, unsigned a01, unsigned a10, unsigned a11) { *(LAS u32x4*)(lds + UOFF + ((ui & 1) * 512 + ltid()) * 16) = (u32x4){a00, a01, a10, a11}; }

template <class Epi, class Sched>
__device__ __forceinline__ void gphase(LAS unsigned char* lds, const char* Abase, const int K, Sched& S, Epi& E) {
    const int tid = ltid(), wid = __builtin_amdgcn_readfirstlane(tid >> 6), lane = tid & 63, wr = wid >> 2, wc = wid & 3, fr = lane & 15, fq = lane >> 4;
    const int nt = K / BK;
    { unsigned vb_[2];
#pragma unroll
      for (int i = 0; i < 2; ++i) { int R, C; stage_rc(tid * 16 + i * 8192, R, C); const int Rb = Epi::PERM ? ((R & ~31) + perm32(R & 31)) : R; vb_[i] = (unsigned)(Rb * K + C) * 2u; }
      *(LAS u32x2*)(lds + VBOFF + tid * 8) = (u32x2){vb_[0], vb_[1]}; }
    const unsigned hstepB = (unsigned)HALF * K * 2;
    const unsigned ldsw = (unsigned)wid * 1024u;
    constexpr bool F8 = Epi::F8; constexpr int KST = F8 ? 16 : 1024;
    const int aoff = lds_byte(wr * 64 + fr, fq * (F8 ? 16 : 8)), boff = lds_byte(wc * 32 + fr, fq * (F8 ? 16 : 8));
#define G_SA(b, h) (((b) * 2 + (h)) * HTB)
#define G_SB(b, h) ((4 + (b) * 2 + (h)) * HTB)
#define G_STAGE_A(bufoff, slot_, half_, kb) do { const char* ab_ = Abase + (kb); const u32x2 p_ = *(const LAS u32x2*)(lds + UOFF + (((slot_) & 1) * 512 + tid) * 16 + (half_) * 8); unsigned p0_ = p_.x, p1_ = p_.y; asm volatile("" : "+v"(p0_), "+v"(p1_)); \
        __builtin_amdgcn_global_load_lds((const unsigned*)(ab_ + p0_), (LAS unsigned*)(lds + (bufoff) + ldsw), 16, 0, 0); \
        __builtin_amdgcn_global_load_lds((const unsigned*)(ab_ + p1_), (LAS unsigned*)(lds + (bufoff) + ldsw + 8192), 16, 0, 0); } while (0)
#define G_STAGE_B(bufoff, bp, kb) do { const char* bb_ = (bp) + (kb); const u32x2 q_ = *(const LAS u32x2*)(lds + VBOFF + tid * 8); unsigned p0_ = q_.x, p1_ = q_.y; asm volatile("" : "+v"(p0_), "+v"(p1_)); \
        __builtin_amdgcn_global_load_lds((const unsigned*)(bb_ + p0_), (LAS unsigned*)(lds + (bufoff) + ldsw), 16, 0, 0); \
        __builtin_amdgcn_global_load_lds((const unsigned*)(bb_ + p1_), (LAS unsigned*)(lds + (bufoff) + ldsw + 8192), 16, 0, 0); } while (0)
#define G_LDA(dst, b, h) do { _Pragma("unroll") for (int m = 0; m < 4; ++m) _Pragma("unroll") for (int k = 0; k < 2; ++k) dst[m][k] = *(const LAS v4i*)(lds + G_SA(b, h) + aoff + m * 2048 + k * KST); } while (0)
#define G_LDB(dst, b, h) do { _Pragma("unroll") for (int n = 0; n < 2; ++n) _Pragma("unroll") for (int k = 0; k < 2; ++k) dst[n][k] = *(const LAS v4i*)(lds + G_SB(b, h) + boff + n * 2048 + k * KST); } while (0)
#define G_CAT(x_) __builtin_shufflevector(x_[0], x_[1], 0, 1, 2, 3, 4, 5, 6, 7)
#define G_MMA(ai, bj, At, Bt) do { __builtin_amdgcn_s_setprio(1); _Pragma("unroll") for (int m = 0; m < 4; ++m) _Pragma("unroll") for (int n = 0; n < 2; ++n) { \
        if constexpr (F8) acc[ai][bj][m][n] = __builtin_amdgcn_mfma_scale_f32_16x16x128_f8f6f4(G_CAT(Bt[n]), G_CAT(At[m]), acc[ai][bj][m][n], 0, 0, 0, Epi::SB, 0, Epi::SA); \
        else { _Pragma("unroll") for (int k = 0; k < 2; ++k) acc[ai][bj][m][n] = __builtin_amdgcn_mfma_f32_16x16x32_bf16(__builtin_bit_cast(bf16x8, Bt[n][k]), __builtin_bit_cast(bf16x8, At[m][k]), acc[ai][bj][m][n], 0, 0, 0); } } \
        __builtin_amdgcn_s_setprio(0); } while (0)
#define G_WAIT_V(n) asm volatile("s_waitcnt vmcnt(" #n ")" ::: "memory")
#define G_WAIT_L(n) asm volatile("s_waitcnt lgkmcnt(" #n ")" ::: "memory")
#define G_BAR __builtin_amdgcn_s_barrier()
#define G_SCHED __builtin_amdgcn_sched_barrier(0)
#define G_ZERO() do { _Pragma("unroll") for (int a = 0; a < 2; ++a) _Pragma("unroll") for (int b = 0; b < 2; ++b) _Pragma("unroll") for (int m = 0; m < 4; ++m) _Pragma("unroll") for (int n = 0; n < 2; ++n) acc[a][b][m][n] = (f32x4){0.f, 0.f, 0.f, 0.f}; } while (0)
    Unit cur, nxt; int ui = 0;
    if (!S.next(lds, 0, cur)) return;
    f32x4 acc[2][2][4][2];
    G_ZERO();
    v4i At[4][2], B0[2][2], B1[2][2];
    G_STAGE_B(G_SB(0, 0), cur.Bp, 0); G_STAGE_B(G_SB(0, 1), cur.Bp + hstepB, 0); G_STAGE_A(G_SA(0, 0), 0, 0, 0); G_STAGE_A(G_SA(0, 1), 0, 1, 0);
    if (wr == 1) G_BAR;
    G_WAIT_V(2); G_BAR;
    G_STAGE_B(G_SB(1, 0), cur.Bp, 128); G_STAGE_A(G_SA(1, 0), 0, 0, 128); G_STAGE_B(G_SB(1, 1), cur.Bp + hstepB, 128);
    G_WAIT_V(6); G_BAR;
    for (;;) {
        bool has_next = false;
#pragma unroll 1
        for (int t = 0; t < nt; t += 2) {
            const bool last = (t == nt - 2);
            const unsigned kb1 = (unsigned)(t + 1) * 128u, kb2 = last ? 0u : (unsigned)(t + 2) * 128u, kb3 = kb2 + 128u;
            const char* b2 = cur.Bp; int s2 = ui;
            if (last) {
                has_next = S.next(lds, ui + 1, nxt); if (!has_next) nxt = cur; else s2 = ui + 1;
                b2 = nxt.Bp; }
            G_LDB(B0, 0, 0); G_LDB(B1, 0, 1); G_SCHED; G_LDA(At, 0, 0); G_STAGE_A(G_SA(1, 1), ui, 1, kb1);
            G_WAIT_V(8); G_WAIT_L(0); G_BAR; G_MMA(0, 0, At, B0); G_MMA(0, 1, At, B1); G_BAR; G_SCHED;
            G_LDA(At, 0, 1); G_STAGE_B(G_SB(0, 0), b2, kb2); G_STAGE_B(G_SB(0, 1), b2 + hstepB, kb2); G_STAGE_A(G_SA(0, 0), s2, 0, kb2);
            G_WAIT_V(8); G_WAIT_L(0); G_BAR; G_MMA(1, 0, At, B0); G_MMA(1, 1, At, B1); G_BAR; G_SCHED;
            G_LDB(B0, 1, 0); G_LDB(B1, 1, 1); G_SCHED; G_LDA(At, 1, 0); G_STAGE_A(G_SA(0, 1), s2, 1, kb2);
            G_WAIT_V(8); G_WAIT_L(0); G_BAR; G_MMA(0, 0, At, B0); G_MMA(0, 1, At, B1); G_BAR; G_SCHED;
            G_LDA(At, 1, 1); G_STAGE_B(G_SB(1, 0), b2, kb3); G_STAGE_B(G_SB(1, 1), b2 + hstepB, kb3); G_STAGE_A(G_SA(1, 0), s2, 0, kb3);
            G_WAIT_V(8); G_WAIT_L(0); G_BAR; G_MMA(1, 0, At, B0); G_MMA(1, 1, At, B1); G_BAR; G_SCHED;
        }
        if (wr == 0) G_BAR;
        { const int tz = ltid(), wz = tz >> 6, lz = tz & 63; E(acc, cur, wz >> 2, wz & 3, lz & 15, lz >> 4); }
        if (!has_next) break;
        if (!E.keep(cur)) G_ZERO();
        cur = nxt; ++ui;
        if (wr == 1) G_BAR;
    }
    G_WAIT_V(0);
    G_BAR;
#undef G_SA
#undef G_SB
#undef G_STAGE_A
#undef G_STAGE_B
#undef G_LDA
#undef G_CAT
#undef G_LDB
#undef G_MMA
#undef G_WAIT_V
#undef G_WAIT_L
#undef G_BAR
#undef G_SCHED
#undef G_ZERO
}

struct DenseSched {
    int nM, nN, nwg, G, c, lda, K, parts; const char* Bt; const char* Bt2;
    __device__ void init(int M, int N, int K_, int lda_, const void* Bt_, const void* Bt2_, int parts_) {
        nM = M / BM; nN = N / BM; nwg = nM * nN; G = gridDim.x; c = blockIdx.x; lda = lda_; K = K_; Bt = (const char*)Bt_; Bt2 = (const char*)Bt2_; parts = parts_;
    }
    __device__ bool next(LAS unsigned char* lds, int i, Unit& u) const {
        const int ti = parts == 2 ? (i >> 1) : i, part = parts == 2 ? (i & 1) : 0;
        const long L = (long)ti * G + c; if (L >= nwg) return false;
        int wgid = (int)L; { const int q = nwg / 8, r = nwg % 8, xcd = wgid % 8, off = wgid / 8; wgid = (xcd < r ? xcd * (q + 1) : r * (q + 1) + (xcd - r) * q) + off; }
        const int nig = 8 * nN, gid = wgid / nig, fm = gid * 8, gsz = (nM - fm) < 8 ? (nM - fm) : 8;
        u.pm = fm + ((wgid % nig) % gsz); u.pn = (wgid % nig) / gsz; u.aux = part;
        u.Bp = (part ? Bt2 : Bt) + (size_t)u.pn * BM * K * 2;
        int R0, C0, R1, C1; { const int tz = ltid(); stage_rc(tz * 16, R0, C0); stage_rc(tz * 16 + 8192, R1, C1); }
        const unsigned rb = (unsigned)u.pm * BM, po = part ? (unsigned)K * 2u : 0u;
        put_offs(lds, i, ((rb + R0) * lda + C0) * 2u + po, ((rb + R1) * lda + C1) * 2u + po, ((rb + HALF + R0) * lda + C0) * 2u + po, ((rb + HALF + R1) * lda + C1) * 2u + po);
        return true;
    }
};
template <bool GATHER, int NN, int KK, int LDA, size_t WSTRIDE>
struct MoeSched {
    static constexpr int MAXU = 24, TBL = STAGE_BYTES, TOK = STAGE_BYTES + 256;
    int nu; const char* W;
    __device__ void init(LAS unsigned char* lds, const int* nent_p, const int* blk_row, const int* blk_exp, const int* tok_p, const void* W_) {
        W = (const char*)W_;
        const int tid = ltid(), G = gridDim.x, c = blockIdx.x, nent = *nent_p;
        const int x = c & 7, slot = c >> 3, nslot = G >> 3, e0 = (int)((long)x * nent / 8), e1 = (int)((long)(x + 1) * nent / 8), tot = (e1 - e0) * NN;
        nu = tot > slot ? (tot - slot + nslot - 1) / nslot : 0; if (nu > MAXU) nu = MAXU;
        LAS int* t_ = (LAS int*)(lds + TBL); LAS int* k_ = (LAS int*)(lds + TOK);
        if (tid < nu) { const int uidx = tid * nslot + slot, ent = e0 + uidx / NN; t_[tid * 2] = blk_row[ent]; t_[tid * 2 + 1] = blk_exp[ent] * 16 + uidx % NN; }
        __syncthreads();
        if (GATHER) { for (int j = tid; j < nu * 256; j += 512) k_[j] = tok_p[t_[(j >> 8) * 2] + (j & 255)]; __syncthreads(); }
    }
    __device__ bool next(LAS unsigned char* lds, int i, Unit& u) const {
        if (i >= nu) return false;
        LAS const int* tbl = (LAS const int*)(lds + TBL); LAS const int* tokt = (LAS const int*)(lds + TOK);
        int R0, C0, R1, C1; { const int tz = ltid(); stage_rc(tz * 16, R0, C0); stage_rc(tz * 16 + 8192, R1, C1); }
        const int rb = __builtin_amdgcn_readfirstlane(tbl[i * 2]), ep = __builtin_amdgcn_readfirstlane(tbl[i * 2 + 1]), e = ep >> 4; u.pn = ep & 15; u.pm = rb; u.aux = e;
        u.Bp = W + (size_t)e * WSTRIDE + (size_t)u.pn * BM * KK * 2;
        if (GATHER) {
            const unsigned t00 = tokt[i * 256 + R0], t01 = tokt[i * 256 + R1], t10 = tokt[i * 256 + HALF + R0], t11 = tokt[i * 256 + HALF + R1];
            put_offs(lds, i, (t00 * LDA + C0) * 2u, (t01 * LDA + C1) * 2u, (t10 * LDA + C0) * 2u, (t11 * LDA + C1) * 2u);
        } else {
            put_offs(lds, i, ((unsigned)(rb + R0) * LDA + C0) * 2u, ((unsigned)(rb + R1) * LDA + C1) * 2u, ((unsigned)(rb + HALF + R0) * LDA + C0) * 2u, ((unsigned)(rb + HALF + R1) * LDA + C1) * 2u);
        }
        return true;
    }
};

struct EpiProj {
    static constexpr bool PERM = true, F8 = false; static constexpr int SA = 0, SB = 0; bf16_t* O;
    __device__ __forceinline__ bool keep(const Unit&) const { return false; }
    __device__ __forceinline__ void operator()(f32x4 (&acc)[2][2][4][2], const Unit& u, int wr, int wc, int fr, int fq) const {
        const int row0 = u.pm * BM + wr * 64 + fr, col0 = u.pn * BM + wc * 32 + 8 * fq;
#pragma unroll
        for (int ai = 0; ai < 2; ++ai)
#pragma unroll
            for (int m = 0; m < 4; ++m) { bf16_t* rowp = O + (size_t)(row0 + ai * HALF + m * 16) * PW + col0;
#pragma unroll
                for (int bj = 0; bj < 2; ++bj) { const f32x4 v0 = acc[ai][bj][m][0], v1 = acc[ai][bj][m][1]; u32x4 w;
                    w.x = cvt_pk_bf16(v0[0], v0[1]); w.y = cvt_pk_bf16(v0[2], v0[3]); w.z = cvt_pk_bf16(v1[0], v1[1]); w.w = cvt_pk_bf16(v1[2], v1[3]);
                    *(u32x4*)(rowp + bj * HALF) = w; } }
    }
};
struct EpiMerge {
    static constexpr bool PERM = true, F8 = false; static constexpr int SA = 0, SB = 0; const bf16_t* proj; bf16_t* O;
    __device__ __forceinline__ bool keep(const Unit& u) const { return u.aux == 0; }
    __device__ __forceinline__ void operator()(f32x4 (&acc)[2][2][4][2], const Unit& u, int wr, int wc, int fr, int fq) const {
        const int row0 = u.pm * BM + wr * 64 + fr, col0 = u.pn * BM + wc * 32 + 8 * fq;
#pragma unroll
        for (int ai = 0; ai < 2; ++ai)
#pragma unroll
            for (int m = 0; m < 4; ++m) { const size_t r = (size_t)(row0 + ai * HALF + m * 16);
#pragma unroll
                for (int bj = 0; bj < 2; ++bj) {
                    const u32x4 gb = *(const u32x4*)(proj + r * PW + C_MGB + col0 + bj * HALF);
                    const f32x4 eb0 = {__expf(-bflo(gb.x)), __expf(-bfhi(gb.x)), __expf(-bflo(gb.y)), __expf(-bfhi(gb.y))};
                    const f32x4 eb1 = {__expf(-bflo(gb.z)), __expf(-bfhi(gb.z)), __expf(-bflo(gb.w)), __expf(-bfhi(gb.w))};
                    if (u.aux == 0) {
                        const u32x4 ga = *(const u32x4*)(proj + r * PW + C_MGA + col0 + bj * HALF);
                        const f32x4 ea0 = {__expf(-bflo(ga.x)), __expf(-bfhi(ga.x)), __expf(-bflo(ga.y)), __expf(-bfhi(ga.y))};
                        const f32x4 ea1 = {__expf(-bflo(ga.z)), __expf(-bfhi(ga.z)), __expf(-bflo(ga.w)), __expf(-bfhi(ga.w))};
#pragma unroll
                        for (int j = 0; j < 4; ++j) { acc[ai][bj][m][0][j] *= (1.f + eb0[j]) * rcpf_(1.f + ea0[j]); acc[ai][bj][m][1][j] *= (1.f + eb1[j]) * rcpf_(1.f + ea1[j]); }
                    } else {
                        f32x4 v0 = acc[ai][bj][m][0], v1 = acc[ai][bj][m][1];
#pragma unroll
                        for (int j = 0; j < 4; ++j) { v0[j] *= rcpf_(1.f + eb0[j]); v1[j] *= rcpf_(1.f + eb1[j]); }
                        u32x4 w; w.x = cvt_pk_bf16(v0[0], v0[1]); w.y = cvt_pk_bf16(v0[2], v0[3]); w.z = cvt_pk_bf16(v1[0], v1[1]); w.w = cvt_pk_bf16(v1[2], v1[3]);
                        *(u32x4*)(O + r * D + col0 + bj * HALF) = w;
                    } } }
    }
};
struct EpiResid {
    static constexpr bool PERM = false, F8 = false; static constexpr int SA = 0, SB = 0; const float* x; const float* gt; float* O;
    __device__ __forceinline__ bool keep(const Unit&) const { return false; }
    __device__ __forceinline__ void operator()(f32x4 (&acc)[2][2][4][2], const Unit& u, int wr, int wc, int fr, int fq) const {
        const int row0 = u.pm * BM + wr * 64 + fr, col0 = u.pn * BM + wc * 32 + 4 * fq;
        f32x4 g[2][2];
#pragma unroll
        for (int bj = 0; bj < 2; ++bj)
#pragma unroll
            for (int n = 0; n < 2; ++n) g[bj][n] = *(const f32x4*)(gt + col0 + bj * HALF + n * 16);
#pragma unroll
        for (int ai = 0; ai < 2; ++ai)
#pragma unroll
            for (int m = 0; m < 4; ++m) { const size_t ro = (size_t)(row0 + ai * HALF + m * 16) * D + col0;
#pragma unroll
                for (int bj = 0; bj < 2; ++bj)
#pragma unroll
                    for (int n = 0; n < 2; ++n) { const f32x4 xv = *(const f32x4*)(x + ro + bj * HALF + n * 16); *(f32x4*)(O + ro + bj * HALF + n * 16) = xv + g[bj][n] * acc[ai][bj][m][n]; } }
    }
};
struct EpiSwiglu {
    static constexpr bool PERM = true, F8 = true; static constexpr int SA = 0x7d7d7d7d, SB = 0x79797979; unsigned char* hid;
    __device__ __forceinline__ bool keep(const Unit&) const { return false; }
    __device__ __forceinline__ void operator()(f32x4 (&acc)[2][2][4][2], const Unit& u, int wr, int wc, int fr, int fq) const {
        const int row0 = u.pm + wr * 64 + fr, j0 = u.pn * 128 + wc * 16 + 4 * fq;
#pragma unroll
        for (int ai = 0; ai < 2; ++ai)
#pragma unroll
            for (int m = 0; m < 4; ++m) { unsigned char* rowp = hid + (unsigned)((row0 + ai * HALF + m * 16) * FF + j0);
#pragma unroll
                for (int bj = 0; bj < 2; ++bj) { const f32x4 g = acc[ai][bj][m][0], up = acc[ai][bj][m][1];
                    *(unsigned*)(rowp + bj * 64) = cvt4_fp8(8.f * siluf_(g[0]) * up[0], 8.f * siluf_(g[1]) * up[1], 8.f * siluf_(g[2]) * up[2], 8.f * siluf_(g[3]) * up[3]); }
                asm volatile("" ::: "memory"); __builtin_amdgcn_sched_barrier(0); }
    }
};
struct EpiDown {
    static constexpr bool PERM = true, F8 = true; static constexpr int SA = 0x7c7c7c7c, SB = 0x7a7a7a7a; unsigned char* Y; const float* w_p;
    __device__ __forceinline__ bool keep(const Unit&) const { return false; }
    __device__ __forceinline__ void operator()(f32x4 (&acc)[2][2][4][2], const Unit& u, int wr, int wc, int fr, int fq) const {
        const int row0 = u.pm + wr * 64 + fr, col0 = u.pn * BM + wc * 32 + 8 * fq;
#pragma unroll
        for (int ai = 0; ai < 2; ++ai)
#pragma unroll
            for (int m = 0; m < 4; ++m) { const int r = row0 + ai * HALF + m * 16; const float wt = w_p[(unsigned)r] * 16.f; unsigned char* rowp = Y + ((unsigned)r * D + col0);
#pragma unroll
                for (int bj = 0; bj < 2; ++bj) { const f32x4 v0 = acc[ai][bj][m][0] * wt, v1 = acc[ai][bj][m][1] * wt;
                    *(u32x2*)(rowp + bj * HALF) = (u32x2){cvt4_fp8(v0[0], v0[1], v0[2], v0[3]), cvt4_fp8(v1[0], v1[1], v1[2], v1[3])}; }
                asm volatile("" ::: "memory"); __builtin_amdgcn_sched_barrier(0); }
    }
};
}

struct Ctx {
    const float *x, *c, *w_ada, *b_ada, *norm1_g, *norm2_g, *w_in, *lb_table, *hgrn_onorm_g, *conv_w, *a_log, *dt_bias, *gdn_onorm_g, *w_bh, *w_bg, *w_out, *w_router, *router_bias,
        *w_eg, *w_eu, *w_ed, *w_sg, *w_su, *w_sd, *normf_g;
    float* out;
    unsigned* bar;
    float *modp, *mod, *lb, *gab;
    int *idx, *cnt, *tok_p, *pos, *blk_row, *blk_exp, *nent;
    float *wts, *w_p;
    bf16_t *win_t, *wa_t, *wb_t, *wout_t, *h1, *proj, *ocat, *merged;
    float *gq, *gk, *gv, *gbeta, *gdec, *oa, *ob;
    float *hL, *hS, *hD;
    float *gAT, *gB, *gS; unsigned char *gBlob, *gM;
    unsigned char *dn_t, *hid, *gu_t, *h2, *Y;
    bf16_t* rwimg; float* rbias2; int *tile_cnt, *rnk;
};

typedef const __attribute__((address_space(4))) Ctx CtxK;

__device__ __forceinline__ void cvt_tile(LAS float* t, const float* srcA, const float* srcB, int ld, int mode, bf16_t* dst, int ldd) {
    const int tid = ltid(), kr = tid >> 6, cl = tid & 63;
    const float* sp = (mode == 1 && cl >= 32) ? (srcB + cl - 32) : (srcA + cl);
    float v[8];
#pragma unroll
    for (int p = 0; p < 8; ++p) v[p] = sp[(size_t)(p * 8 + kr) * ld];
    __syncthreads();
#pragma unroll
    for (int p = 0; p < 8; ++p) t[(p * 8 + kr) * 65 + cl] = v[p];
    __syncthreads();
    const int r = tid >> 3, seg = (tid & 7) * 8;
    const int lc = mode == 1 ? (((r >> 2) & 1) * 32 + 4 * (r >> 3) + (r & 3)) : r;
    float w[8];
#pragma unroll
    for (int j = 0; j < 8; ++j) w[j] = t[(seg + j) * 65 + lc];
    u32x4 o; o.x = cvt_pk_bf16(w[0], w[1]); o.y = cvt_pk_bf16(w[2], w[3]); o.z = cvt_pk_bf16(w[4], w[5]); o.w = cvt_pk_bf16(w[6], w[7]);
    *(u32x4*)(dst + (size_t)r * ldd + seg) = o;
}
__device__ __forceinline__ void cvt_tile8(LAS float* t, const float* srcA, const float* srcB, int ld, int mode, unsigned char* dst, int ldd, float scale) {
    const int tid = ltid(), kr = tid >> 6, cl = tid & 63;
    const float* sp = (mode == 1 && cl >= 32) ? (srcB + cl - 32) : (srcA + cl);
    float v[8];
#pragma unroll
    for (int p = 0; p < 8; ++p) v[p] = sp[(size_t)(p * 8 + kr) * ld];
    __syncthreads();
#pragma unroll
    for (int p = 0; p < 8; ++p) t[(p * 8 + kr) * 65 + cl] = v[p] * scale;
    __syncthreads();
    const int r = tid >> 3, seg = (tid & 7) * 8;
    const int lc = mode == 1 ? (((r >> 2) & 1) * 32 + 4 * (r >> 3) + (r & 3)) : r;
    float w[8];
#pragma unroll
    for (int j = 0; j < 8; ++j) w[j] = t[(seg + j) * 65 + lc];
    *(u32x2*)(dst + (size_t)r * ldd + seg) = (u32x2){cvt4_fp8(w[0], w[1], w[2], w[3]), cvt4_fp8(w[4], w[5], w[6], w[7])};
}
__device__ __forceinline__ void cvt_job(LAS float* t, int tile, const float* src, int ld, int K, bf16_t* dst) {
    const int nkt = K / 64, nt = tile / nkt, kt = tile % nkt;
    cvt_tile(t, src + (size_t)kt * 64 * ld + nt * 64, nullptr, ld, 0, dst + (size_t)nt * 64 * K + kt * 64, K);
}

__device__ void ph_pro1(CtxK& c, LAS unsigned char* lds) {
    const int tid = ltid(), wg = blockIdx.x, G = gridDim.x;
    LAS float* lf = (LAS float*)lds;
    for (int job = wg; job < 192; job += G) {
        const int cc = job % 48, kp = job / 48, q = tid & 63, rg = tid >> 6;
        f32x4 a = {0.f, 0.f, 0.f, 0.f};
        for (int r = rg; r < 512; r += 8) { const int k = kp * 512 + r; const float s = siluf_(c.c[k]); a += s * *(const f32x4*)(c.w_ada + (size_t)k * (6 * D) + cc * 256 + q * 4); }
        __syncthreads();
        *(LAS f32x4*)(lf + (rg * 64 + q) * 4) = a;
        __syncthreads();
        if (tid < 64) { f32x4 s = {0.f, 0.f, 0.f, 0.f};
#pragma unroll
            for (int g = 0; g < 8; ++g) s += *(LAS f32x4*)(lf + (g * 64 + tid) * 4);
            *(f32x4*)(c.modp + (size_t)kp * (6 * D) + cc * 256 + tid * 4) = s; }
    }
    if (wg == G - 1) for (int j = tid; j < 1024; j += 512) c.lb[j] = 1.f / (1.f + expf(c.lb_table[1024 + j] - c.lb_table[j]));
    for (int T = wg; T < 8192; T += G) {
        if (T < 6144) { const int nt = T / 32, kt = T % 32; const int sc = nt * 64 + (nt * 64 >= WIN_GAB ? 16 : 0);
            cvt_tile(lf, c.w_in + (size_t)kt * 64 * INW + sc, nullptr, INW, 0, c.win_t + (size_t)nt * 64 * D + kt * 64, D); }
        else if (T < 6656) cvt_job(lf, T - 6144, c.w_bh, D, 1024, c.wa_t);
        else if (T < 7168) cvt_job(lf, T - 6656, c.w_bg, D, 1024, c.wb_t);
        else cvt_job(lf, T - 7168, c.w_out, D, 2048, c.wout_t);
    }
}
__device__ void ph_norm1(CtxK& c, LAS unsigned char* lds) {
    const int tid = ltid(), wg = blockIdx.x, G = gridDim.x, lane = tid & 63, wv = tid >> 6;
    LAS float* la = (LAS float*)lds;
    LAS float* lb_ = la + D;
    LAS float* lw = lb_ + D;
    for (int j = tid; j < D; j += 512) {
        float sh = c.b_ada[j], sc = c.b_ada[D + j];
#pragma unroll
        for (int p = 0; p < 4; ++p) { sh += c.modp[(size_t)p * 6 * D + j]; sc += c.modp[(size_t)p * 6 * D + D + j]; }
        la[j] = c.norm1_g[j] * (1.f + sc); lb_[j] = sh;
    }
    for (int j = wg * 512 + tid; j < 6 * D; j += G * 512) { float m = c.b_ada[j];
#pragma unroll
        for (int p = 0; p < 4; ++p) m += c.modp[(size_t)p * 6 * D + j];
        c.mod[j] = m; }
    for (int i = tid; i < D * 4; i += 512) { const int e = i >> 2, q = i & 3; const f32x4 w = *(const f32x4*)(c.w_in + (size_t)e * INW + WIN_GAB + q * 4);
        lw[(q * 4 + 0) * D + e] = w[0]; lw[(q * 4 + 1) * D + e] = w[1]; lw[(q * 4 + 2) * D + e] = w[2]; lw[(q * 4 + 3) * D + e] = w[3]; }
    __syncthreads();
    f32x4 vn[8];
    { const float* xr = c.x + (size_t)(wg * 8 + wv) * D;
#pragma unroll
      for (int i = 0; i < 8; ++i) vn[i] = *(const f32x4*)(xr + i * 256 + lane * 4); }
    for (int row = wg * 8 + wv; row < S; row += G * 8) {
        f32x4 v[8]; float ss = 0.f;
#pragma unroll
        for (int i = 0; i < 8; ++i) { v[i] = vn[i]; ss += v[i][0] * v[i][0] + v[i][1] * v[i][1] + v[i][2] * v[i][2] + v[i][3] * v[i][3]; }
        if (row + G * 8 < S) { const float* xr = c.x + (size_t)(row + G * 8) * D;
#pragma unroll
            for (int i = 0; i < 8; ++i) vn[i] = *(const f32x4*)(xr + i * 256 + lane * 4); }
        ss = wave_sum(ss); const float r = rsqrtf(ss * (1.f / D) + 1e-6f);
#pragma unroll
        for (int i = 0; i < 8; ++i) { const int e = i * 256 + lane * 4; const f32x4 a = *(LAS f32x4*)(la + e), b = *(LAS f32x4*)(lb_ + e); v[i] = v[i] * r * a + b;
            u32x2 w; w.x = cvt_pk_bf16(v[i][0], v[i][1]); w.y = cvt_pk_bf16(v[i][2], v[i][3]); *(u32x2*)(c.h1 + (size_t)row * D + e) = w; }
        float mine = 0.f;
        for (int cc = 0; cc < 16; ++cc) { float d = 0.f;
#pragma unroll
            for (int i = 0; i < 8; ++i) { const f32x4 w = *(LAS f32x4*)(lw + cc * D + i * 256 + lane * 4); d += v[i][0] * w[0] + v[i][1] * w[1] + v[i][2] * w[2] + v[i][3] * w[3]; }
            d = wave_sum(d); if (lane == cc) mine = d; }
        if (lane < 16) c.gab[(size_t)row * 16 + lane] = mine;
    }
    { const int id = wg * 512 + tid, i = id >> 6, e = id & 63;
      if (id < D * 64) {
          float sc = c.b_ada[4 * D + i];
#pragma unroll
          for (int p = 0; p < 4; ++p) sc += c.modp[(size_t)p * 6 * D + 4 * D + i];
          const float w = c.norm2_g[i] * (1.f + sc) * c.w_router[id];
          const unsigned hi = cvt_pk_bf16(w, w) & 0xffffu; const float lo = w - __uint_as_float(hi << 16);
          const int ch = i >> 7, kk = i & 127;
          c.rwimg[((ch * 2 + 0) * 64 + e) * 136 + kk] = (bf16_t)hi; c.rwimg[((ch * 2 + 1) * 64 + e) * 136 + kk] = (bf16_t)(cvt_pk_bf16(lo, lo) & 0xffffu);
      } }
    if (wg < 64) {
        __syncthreads();
        float a = 0.f;
        for (int i = tid; i < D; i += 512) { float sh = c.b_ada[3 * D + i];
#pragma unroll
            for (int p = 0; p < 4; ++p) sh += c.modp[(size_t)p * 6 * D + 3 * D + i];
            a += sh * c.w_router[i * 64 + wg]; }
        a = wave_sum(a); if (lane == 0) la[wv] = a; __syncthreads();
        if (tid == 0) c.rbias2[wg] = la[0] + la[1] + la[2] + la[3] + la[4] + la[5] + la[6] + la[7];
    }
}
__device__ void ph_gemm1(CtxK& c, LAS unsigned char* lds) {
    gm::DenseSched Sd; Sd.init(S, PW, D, D, c.win_t, nullptr, 1); gm::EpiProj E{c.proj};
    gm::gphase(lds, (const char*)c.h1, D, Sd, E);
}
__device__ void ph_gemm2(CtxK& c, LAS unsigned char* lds) {
    gm::DenseSched Sd; Sd.init(S, D, 1024, 2048, c.wa_t, c.wb_t, 2); gm::EpiMerge E{c.proj, c.merged};
    gm::gphase(lds, (const char*)c.ocat, 1024, Sd, E);
}
__device__ void ph_gemm3(CtxK& c, LAS unsigned char* lds) {
    gm::DenseSched Sd; Sd.init(S, D, D, D, c.wout_t, nullptr, 1); gm::EpiResid E{c.x, c.mod + 2 * D, c.out};
    gm::gphase(lds, (const char*)c.merged, D, Sd, E);
}
__device__ void ph_moe_gu(CtxK& c, LAS unsigned char* lds) {
    gm::MoeSched<true, 4, D / 2, D / 2, (size_t)1024 * D> Sm; Sm.init(lds, c.nent, c.blk_row, c.blk_exp, c.tok_p, c.gu_t); gm::EpiSwiglu E{c.hid};
    gm::gphase(lds, (const char*)c.h2, D / 2, Sm, E);
}
__device__ void ph_moe_dn(CtxK& c, LAS unsigned char* lds) {
    gm::MoeSched<false, 8, FF / 2, FF / 2, (size_t)D * FF> Sm; Sm.init(lds, c.nent, c.blk_row, c.blk_exp, c.tok_p, c.dn_t); gm::EpiDown E{c.Y, c.w_p};
    gm::gphase(lds, (const char*)c.hid, FF / 2, Sm, E);
}
__device__ void ph_cvt_exp(CtxK& c, LAS unsigned char* lds) {
    LAS float* lf = (LAS float*)lds; const int wg = blockIdx.x - 8, G = gridDim.x - 8;
    if (wg < 0) return;
    constexpr int GU_T = 16 * 32, DN_T = 32 * 8;
    for (int T = wg; T < NEX * (GU_T + DN_T); T += G) {
        if (T < NEX * GU_T) { const int e = T / GU_T, r = T % GU_T, nt = r / 32, kt = r % 32;
            const float* sg = e < NE ? c.w_eg + (size_t)e * D * FF : c.w_sg; const float* su = e < NE ? c.w_eu + (size_t)e * D * FF : c.w_su;
            cvt_tile8(lf, sg + (size_t)kt * 64 * FF + nt * 32, su + (size_t)kt * 64 * FF + nt * 32, FF, 1, c.gu_t + ((size_t)e * 1024 + nt * 64) * D + kt * 64, D, 64.f); }
        else { const int T2 = T - NEX * GU_T, e = T2 / DN_T, r = T2 % DN_T; const float* sd = e < NE ? c.w_ed + (size_t)e * FF * D : c.w_sd;
            { const int nkt = FF / 64, nt = r / nkt, kt = r % nkt; cvt_tile8(lf, sd + (size_t)kt * 64 * D + nt * 64, nullptr, D, 0, c.dn_t + (size_t)e * D * FF + (size_t)nt * 64 * FF + kt * 64, FF, 32.f); } }
    }
}
__device__ void ph_final(CtxK& c, LAS unsigned char* lds) {
    const int tid = ltid(), wg = blockIdx.x, G = gridDim.x, lane = tid & 63, wv = tid >> 6;
    const float* gt2 = c.mod + 5 * D;
    for (int row0 = (wg * 8 + wv) * 2; row0 < S; row0 += G * 16) {
        int p[2][9];
#pragma unroll
        for (int rr = 0; rr < 2; ++rr) {
#pragma unroll
            for (int k = 0; k < 8; ++k) p[rr][k] = c.pos[(row0 + rr) * TOPK + k];
            p[rr][8] = PROUTED + row0 + rr; }
        f32x4 v[2][4][2]; float ss[2] = {0.f, 0.f};
#pragma unroll
        for (int rr = 0; rr < 2; ++rr) {
#pragma unroll
            for (int i = 0; i < 4; ++i) {
                const int e = i * 512 + lane * 8; f32x4 a0 = {0.f, 0.f, 0.f, 0.f}, a1 = {0.f, 0.f, 0.f, 0.f};
#pragma unroll
                for (int k = 0; k < 9; ++k) { const u32x2 y = *(const u32x2*)(c.Y + (size_t)p[rr][k] * D + e);
                    const auto q0 = __builtin_amdgcn_cvt_pk_f32_fp8((int)y.x, false), q1 = __builtin_amdgcn_cvt_pk_f32_fp8((int)y.x, true), q2 = __builtin_amdgcn_cvt_pk_f32_fp8((int)y.y, false), q3 = __builtin_amdgcn_cvt_pk_f32_fp8((int)y.y, true);
                    a0[0] += q0[0]; a0[1] += q0[1]; a0[2] += q1[0]; a0[3] += q1[1]; a1[0] += q2[0]; a1[1] += q2[1]; a1[2] += q3[0]; a1[3] += q3[1]; }
                const float* xp = c.out + (size_t)(row0 + rr) * D + e;
                const f32x4 x0 = *(const f32x4*)xp, x1 = *(const f32x4*)(xp + 4), g0 = *(const f32x4*)(gt2 + e) * 0.0625f, g1 = *(const f32x4*)(gt2 + e + 4) * 0.0625f;
                v[rr][i][0] = x0 + g0 * a0; v[rr][i][1] = x1 + g1 * a1;
#pragma unroll
                for (int j = 0; j < 4; ++j) ss[rr] += v[rr][i][0][j] * v[rr][i][0][j] + v[rr][i][1][j] * v[rr][i][1][j];
            } }
#pragma unroll
        for (int rr = 0; rr < 2; ++rr) {
            const float r = rsqrtf(wave_sum_dpp(ss[rr]) * (1.f / D) + 1e-6f);
#pragma unroll
            for (int i = 0; i < 4; ++i) { const int e = i * 512 + lane * 8; float* op = c.out + (size_t)(row0 + rr) * D + e;
                *(f32x4*)op = v[rr][i][0] * r * *(const f32x4*)(c.normf_g + e); *(f32x4*)(op + 4) = v[rr][i][1] * r * *(const f32x4*)(c.normf_g + e + 4); } }
    }
}

namespace mx {
constexpr int ST128 = 272, ST64 = 144;
constexpr int FRAG_F4 = 8 * 8 * 64;
__device__ __forceinline__ f32x4 mfma16(bf16x8 a, bf16x8 b, f32x4 c) { return __builtin_amdgcn_mfma_f32_16x16x32_bf16(a, b, c, 0, 0, 0); }
template <int MT, int KS>
__device__ __forceinline__ void mma_nt(f32x4 (&acc)[MT], LAS const unsigned char* xs, int sx, LAS const unsigned char* ys, int sy, int fr, int fq) {
#pragma unroll
    for (int kk = 0; kk < KS; ++kk) {
        const bf16x8 b = *(const LAS bf16x8*)(ys + fr * sy + (kk * 32 + fq * 8) * 2);
#pragma unroll
        for (int m = 0; m < MT; ++m) { const bf16x8 a = *(const LAS bf16x8*)(xs + (16 * m + fr) * sx + (kk * 32 + fq * 8) * 2); acc[m] = mfma16(a, b, acc[m]); }
    }
}
__device__ __forceinline__ void lds_fence() { asm volatile("s_waitcnt lgkmcnt(0)" ::: "memory"); }
__device__ __forceinline__ u32x4 pack8(const float (&v)[8]) { u32x4 o; o.x = cvt_pk_bf16(v[0], v[1]); o.y = cvt_pk_bf16(v[2], v[3]); o.z = cvt_pk_bf16(v[4], v[5]); o.w = cvt_pk_bf16(v[6], v[7]); return o; }
__device__ __forceinline__ void unpack8(const u32x4 w, float (&v)[8]) { v[0] = bflo(w.x); v[1] = bfhi(w.x); v[2] = bflo(w.y); v[3] = bfhi(w.y); v[4] = bflo(w.z); v[5] = bfhi(w.z); v[6] = bflo(w.w); v[7] = bfhi(w.w); }
__device__ __forceinline__ void mfma_pad8(f32x4 (&a)[8]) { asm volatile("s_nop 15\n\ts_nop 7" : "+v"(a[0]), "+v"(a[1]), "+v"(a[2]), "+v"(a[3]), "+v"(a[4]), "+v"(a[5]), "+v"(a[6]), "+v"(a[7])); }
__device__ __forceinline__ void mfma_pad4(f32x4 (&a)[4]) { asm volatile("s_nop 15\n\ts_nop 7" : "+v"(a[0]), "+v"(a[1]), "+v"(a[2]), "+v"(a[3])); }
__device__ __forceinline__ void write_st(LAS unsigned char* stw, f32x4 (&S)[8], int fr, int fq) {
    mfma_pad8(S);
#pragma unroll
    for (int m = 0; m < 8; ++m) { u32x2 w; w.x = cvt_pk_bf16(S[m][0], S[m][1]); w.y = cvt_pk_bf16(S[m][2], S[m][3]); *(LAS u32x2*)(stw + fr * ST128 + (16 * m + 4 * fq) * 2) = w; }
}

__device__ __forceinline__ void gate_issue(u32x4 (&gp)[2], const bf16_t* gate0) {
    const int t_ = ltid(); const bf16_t* p = gate0 + (size_t)(t_ >> 3) * PW + (t_ & 7) * 16;
    gp[0] = *(const u32x4*)p; gp[1] = *(const u32x4*)(p + 8);
}
__device__ __forceinline__ void out_stage(LAS unsigned char* ot, LAS float* part, const f32x4 (&o)[4], const u32x4 (&gp)[2], const float* gnorm, bf16_t* out0, int wv, int lane, int fr, int fq) {
    float s_ = 0.f;
#pragma unroll
    for (int w = 0; w < 8; ++w) s_ += part[w * 64 + lane];
    const float rv = rsqrtf(s_ * (1.f / 128.f) + 1e-6f);
    const float gn = gnorm[wv * 16 + fr];
#pragma unroll
    for (int m = 0; m < 4; ++m)
#pragma unroll
        for (int r = 0; r < 4; ++r) { const int cc = 16 * m + 4 * fq + r; const float x = o[m][r] * __shfl(rv, cc) * gn;
            *(LAS bf16_t*)(ot + cc * ST128 + (wv * 16 + fr) * 2) = (bf16_t)(cvt_pk_bf16(x, x) & 0xffffu); }
    __syncthreads();
    const int t_ = ltid(), cc = t_ >> 3, sg = (t_ & 7) * 16;
#pragma unroll
    for (int hh = 0; hh < 2; ++hh) { float ov[8], gv[8];
        unpack8(*(LAS u32x4*)(ot + cc * ST128 + (sg + hh * 8) * 2), ov); unpack8(gp[hh], gv);
#pragma unroll
        for (int j = 0; j < 8; ++j) ov[j] *= siluf_(gv[j]);
        *(u32x4*)(out0 + (size_t)cc * D + sg + hh * 8) = pack8(ov); }
}

constexpr int H_QT = 0, H_KT = 17408, H_QI = 34816, H_KU = 52224, H_VT = 70656, H_P = 89088, H_DEC = 98304, H_OCT = 98816, H_F4 = H_OCT + 8192, H_PART = H_F4 + 512, H_RINV = H_PART + 2048, H_ST = H_RINV + 256, H_LB = H_ST + 8 * 16 * ST128, H_END = H_LB + 512;
static_assert(H_END <= 147456, "hgrn lds");
template <bool OUT>
__device__ void hgrn_pass(CtxK& c, LAS unsigned char* lds) {
    const int tid = ltid(), wv = __builtin_amdgcn_readfirstlane(tid >> 6), lane = tid & 63, fr = lane & 15, fq = lane >> 4;
    LAS float* dec = (LAS float*)(lds + H_DEC); LAS float* oct = (LAS float*)(lds + H_OCT); LAS float* f4 = (LAS float*)(lds + H_F4);
    LAS float* part = (LAS float*)(lds + H_PART); LAS float* rinv = (LAS float*)(lds + H_RINV);
    LAS unsigned char* stw = lds + H_ST + wv * 16 * ST128;
    {
        const int wu = blockIdx.x, h = wu & 7, g = wu >> 3;
        f32x4 Sacc[8];
#pragma unroll
        for (int m = 0; m < 8; ++m) Sacc[m] = (f32x4){0.f, 0.f, 0.f, 0.f};
        if (OUT) {
            if (g > 0) { const f32x4* sp = (const f32x4*)c.hS + (size_t)(h * 32 + g) * FRAG_F4 + (wv * 8) * 64 + lane;
#pragma unroll
                for (int m = 0; m < 8; ++m) Sacc[m] = sp[m * 64]; }
            write_st(stw, Sacc, fr, fq);
        }
        LAS float* lbs = (LAS float*)(lds + H_LB);
        if (tid < 128) lbs[tid] = c.lb[h * 128 + tid];
        __syncthreads();
        float dsum = 0.f;
        u32x4 pf[4], pv[4];
#define HP_ISSUE(i_) do { const int tq_ = ltid(), rl_ = tq_ >> 8; const bf16_t* b_ = c.proj + (size_t)((g * 8 + (i_)) * 64 + ((tq_ >> 4) & 15) * 4) * PW + h * 128 + (tq_ & 15) * 8; \
        if (rl_ == 1 || OUT) { _Pragma("unroll") for (int tt = 0; tt < 4; ++tt) pf[tt] = *(const u32x4*)(b_ + (size_t)tt * PW + C_HF); } \
        if (rl_ == 0) { _Pragma("unroll") for (int tt = 0; tt < 4; ++tt) pv[tt] = *(const u32x4*)(b_ + (size_t)tt * PW + C_HI); } } while (0)
        HP_ISSUE(0);
        for (int i = 0; i < 8; ++i) {
            const int T0 = (g * 8 + i) * 64;
            const int tp = ltid(), role = tp >> 8, tq = (tp >> 4) & 15, co = tp & 15, c0 = tq * 4, d0 = co * 8;
            const bool cum = role == 1 || OUT;
            float cs[4][8];
            if (cum) {
                float lbv[8];
                { const f32x4 l0 = *(LAS f32x4*)(lbs + d0), l1 = *(LAS f32x4*)(lbs + d0 + 4);
                  lbv[0] = l0[0]; lbv[1] = l0[1]; lbv[2] = l0[2]; lbv[3] = l0[3]; lbv[4] = l1[0]; lbv[5] = l1[1]; lbv[6] = l1[2]; lbv[7] = l1[3]; }
#pragma unroll
                for (int tt = 0; tt < 4; ++tt) {
                    float fv[8]; unpack8(pf[tt], fv);
#pragma unroll
                    for (int j = 0; j < 8; ++j) { const float lf = __logf(lbv[j] + (1.f - lbv[j]) * sigmoidf_(fv[j])); cs[tt][j] = tt ? cs[tt - 1][j] + lf : lf; }
                }
                if (role == 1) {
                    *(LAS f32x4*)(oct + tq * 128 + d0) = (f32x4){cs[3][0], cs[3][1], cs[3][2], cs[3][3]}; *(LAS f32x4*)(oct + tq * 128 + d0 + 4) = (f32x4){cs[3][4], cs[3][5], cs[3][6], cs[3][7]};
                    if (tq == 8) { *(LAS f32x4*)(f4 + d0) = (f32x4){cs[0][0], cs[0][1], cs[0][2], cs[0][3]}; *(LAS f32x4*)(f4 + d0 + 4) = (f32x4){cs[0][4], cs[0][5], cs[0][6], cs[0][7]}; }
                }
            }
            if (role == 0) {
#pragma unroll
                for (int j = 0; j < 8; j += 2) { const int wi = j >> 1; u32x2 w0, w1;
                    const unsigned a0 = wi == 0 ? pv[0].x : wi == 1 ? pv[0].y : wi == 2 ? pv[0].z : pv[0].w, a1 = wi == 0 ? pv[1].x : wi == 1 ? pv[1].y : wi == 2 ? pv[1].z : pv[1].w;
                    const unsigned a2 = wi == 0 ? pv[2].x : wi == 1 ? pv[2].y : wi == 2 ? pv[2].z : pv[2].w, a3 = wi == 0 ? pv[3].x : wi == 1 ? pv[3].y : wi == 2 ? pv[3].z : pv[3].w;
                    w0.x = (a0 & 0xffffu) | (a1 << 16); w0.y = (a2 & 0xffffu) | (a3 << 16);
                    w1.x = (a0 >> 16) | (a1 & 0xffff0000u); w1.y = (a2 >> 16) | (a3 & 0xffff0000u);
                    *(LAS u32x2*)(lds + H_VT + (d0 + j) * ST64 + c0 * 2) = w0; *(LAS u32x2*)(lds + H_VT + (d0 + j + 1) * ST64 + c0 * 2) = w1; }
            }
            __syncthreads();
            if (cum) {
                float pre[8], tot[8], bmid[8];
#pragma unroll
                for (int j = 0; j < 8; ++j) { pre[j] = 0.f; tot[j] = 0.f; bmid[j] = 0.f; }
#pragma unroll
                for (int o = 0; o < 16; ++o) { const f32x4 x0 = *(LAS f32x4*)(oct + o * 128 + d0), x1 = *(LAS f32x4*)(oct + o * 128 + d0 + 4);
#pragma unroll
                    for (int j = 0; j < 8; ++j) { const float x = j < 4 ? x0[j] : x1[j - 4]; pre[j] += o < tq ? x : 0.f; bmid[j] += o < 8 ? x : 0.f; tot[j] += x; } }
                { const f32x4 x0 = *(LAS f32x4*)(f4 + d0), x1 = *(LAS f32x4*)(f4 + d0 + 4);
#pragma unroll
                  for (int j = 0; j < 8; ++j) bmid[j] += j < 4 ? x0[j] : x1[j - 4]; }
                if (role == 0) {
                    float ebm[8];
#pragma unroll
                    for (int j = 0; j < 8; ++j) ebm[j] = __expf(bmid[j]);
#pragma unroll
                    for (int tt = 0; tt < 4; ++tt) {
                        float qv[8], q1[8], q2[8];
                        unpack8(*(const u32x4*)(c.proj + (size_t)(T0 + c0 + tt) * PW + C_HQ + h * 128 + d0), qv);
#pragma unroll
                        for (int j = 0; j < 8; ++j) { const float q = siluf_(qv[j]) * 0.08838834764831845f; q1[j] = q * __expf(pre[j] + cs[tt][j] - bmid[j]); q2[j] = q1[j] * ebm[j]; }
                        *(LAS u32x4*)(lds + H_QT + (c0 + tt) * ST128 + d0 * 2) = pack8(q1); *(LAS u32x4*)(lds + H_QI + (c0 + tt) * ST128 + d0 * 2) = pack8(q2);
                    }
                } else {
                    if (tq == 0) {
#pragma unroll
                        for (int j = 0; j < 8; ++j) dec[d0 + j] = __expf(tot[j]);
                    }
                    if (OUT) {
#pragma unroll
                        for (int tt = 0; tt < 4; ++tt) {
                            float k1[8];
#pragma unroll
                            for (int j = 0; j < 8; ++j) { const float lf = tt ? cs[tt][j] - cs[tt - 1][j] : cs[0][j]; k1[j] = (1.f - __expf(lf)) * __expf(bmid[j] - pre[j] - cs[tt][j]); }
                            *(LAS u32x4*)(lds + H_KT + (c0 + tt) * ST128 + d0 * 2) = pack8(k1);
                        }
                    }
#pragma unroll
                    for (int j = 0; j < 8; ++j) { float col[4];
#pragma unroll
                        for (int tt = 0; tt < 4; ++tt) { const float lf = tt ? cs[tt][j] - cs[tt - 1][j] : cs[0][j]; col[tt] = (1.f - __expf(lf)) * __expf(tot[j] - pre[j] - cs[tt][j]); }
                        u32x2 w; w.x = cvt_pk_bf16(col[0], col[1]); w.y = cvt_pk_bf16(col[2], col[3]);
                        *(LAS u32x2*)(lds + H_KU + (d0 + j) * ST64 + c0 * 2) = w; }
                }
            }
            __syncthreads();
            if (i + 1 < 8) HP_ISSUE(i + 1);
            u32x4 gpre[2];
            if (OUT) gate_issue(gpre, c.proj + (size_t)T0 * PW + C_HG + h * 128);
            if (!OUT && tid < 128) dsum += __logf(dec[tid]);
            f32x4 oacc[4];
            if (OUT) {
                { f32x4 sc[2] = {(f32x4){0.f, 0.f, 0.f, 0.f}, (f32x4){0.f, 0.f, 0.f, 0.f}};
                  const int nt = wv & 3, mb = (wv >> 2) * 2;
                  mma_nt<2, 4>(sc, lds + H_KT + mb * 16 * ST128, ST128, lds + H_QT + nt * 16 * ST128, ST128, fr, fq);
#pragma unroll
                  for (int m = 0; m < 2; ++m) { const int cc = nt * 16 + fr, s0 = (mb + m) * 16 + 4 * fq; u32x2 w;
                      w.x = cvt_pk_bf16(s0 + 0 <= cc ? sc[m][0] : 0.f, s0 + 1 <= cc ? sc[m][1] : 0.f); w.y = cvt_pk_bf16(s0 + 2 <= cc ? sc[m][2] : 0.f, s0 + 3 <= cc ? sc[m][3] : 0.f);
                      *(LAS u32x2*)(lds + H_P + cc * ST64 + s0 * 2) = w; } }
                __syncthreads();
#pragma unroll
                for (int m = 0; m < 4; ++m) oacc[m] = (f32x4){0.f, 0.f, 0.f, 0.f};
                mma_nt<4, 2>(oacc, lds + H_P, ST64, lds + H_VT + wv * 16 * ST64, ST64, fr, fq);
                mma_nt<4, 4>(oacc, lds + H_QI, ST128, stw, ST128, fr, fq);
#pragma unroll
                for (int m = 0; m < 4; ++m)
#pragma unroll
                    for (int r = 0; r < 4; ++r) { float q = oacc[m][r] * oacc[m][r]; q += __shfl_xor(q, 1); q += __shfl_xor(q, 2); q += __shfl_xor(q, 4); q += __shfl_xor(q, 8); if (fr == 0) part[wv * 64 + 16 * m + 4 * fq + r] = q; }
            }
#pragma unroll
            for (int m = 0; m < 8; ++m) { const f32x4 dv = *(LAS f32x4*)(dec + 16 * m + 4 * fq); Sacc[m] = Sacc[m] * dv; }
            mma_nt<8, 2>(Sacc, lds + H_KU, ST64, lds + H_VT + wv * 16 * ST64, ST64, fr, fq);
            if (OUT) {
                lds_fence();
                write_st(stw, Sacc, fr, fq);
                __syncthreads();
                out_stage(lds + H_QT, part, oacc, gpre, c.hgrn_onorm_g, c.ocat + (size_t)T0 * D + h * 128, wv, lane, fr, fq);
            }
            __syncthreads();
        }
#undef HP_ISSUE
        if (!OUT) {
            f32x4* sp = (f32x4*)c.hL + (size_t)(h * 32 + g) * FRAG_F4 + (wv * 8) * 64 + lane;
#pragma unroll
            for (int m = 0; m < 8; ++m) sp[m * 64] = Sacc[m];
            if (tid < 128) c.hD[(h * 32 + g) * 128 + tid] = __expf(dsum);
        }
    }
}
__device__ void hgrn_scan(CtxK& c) {
    const int e = blockIdx.x * 512 + ltid();
    if (e >= 8 * FRAG_F4) return;
    const int h = e / FRAG_F4, fi = e % FRAG_F4, m = (fi >> 6) & 7, lane = fi & 63, d0 = 16 * m + 4 * (lane >> 4);
    f32x4 s = {0.f, 0.f, 0.f, 0.f};
    for (int g = 0; g < 31; ++g) {
        const f32x4 dc = *(const f32x4*)(c.hD + (h * 32 + g) * 128 + d0);
        s = s * dc + ((const f32x4*)c.hL)[(size_t)(h * 32 + g) * FRAG_F4 + fi];
        ((f32x4*)c.hS)[(size_t)(h * 32 + g + 1) * FRAG_F4 + fi] = s;
    }
}

constexpr int B_T = 0, B_KBG = 9216, B_KU = 26624, B_VB = 45056, B_QD = 63488, B_AT = 80896, B_SC = 90112, BLOB = 90368;
constexpr int G_ST = BLOB, G_RV = G_ST + 8 * 16 * ST128, G_PART = G_RV + 8 * 16 * ST64, G_RINV = G_PART + 2048, G_END = G_RINV + 256;
static_assert(G_END <= 147456, "gdn lds");
constexpr int P_K = 0, P_Q = 17408, P_BETA = 34816, P_GC = P_BETA + 256, P_EG = P_GC + 256, P_EK = P_EG + 256;

__device__ void gdn_prep(CtxK& c, LAS unsigned char* lds, int h, int g) {
    const int tid = ltid(), wv = __builtin_amdgcn_readfirstlane(tid >> 6), lane = tid & 63, fr = lane & 15, fq = lane >> 4;
    LAS float* sbeta = (LAS float*)(lds + P_BETA); LAS float* sgc = (LAS float*)(lds + P_GC); LAS float* seg = (LAS float*)(lds + P_EG); LAS float* sek = (LAS float*)(lds + P_EK);
    u32x4 raw[11];
#define GR_ISSUE(i_) do { const int tq_ = ltid(); if (tq_ < 384) { const int T_ = (g * 8 + (i_)) * 64 + ((tq_ >> 4) & 7) * 8 - 3; const bf16_t* b_ = c.proj + C_GQKV + (tq_ >> 7) * 1024 + h * 128 + (tq_ & 15) * 8; \
        _Pragma("unroll") for (int r = 0; r < 11; ++r) raw[r] = T_ + r >= 0 ? *(const u32x4*)(b_ + (size_t)(T_ + r) * PW) : (u32x4){0u, 0u, 0u, 0u}; } } while (0)
    GR_ISSUE(0);
    for (int i = 0; i < 8; ++i) {
        const int n = g * 8 + i, T0 = n * 64;
        unsigned char* blob = (unsigned char*)c.gBlob + (size_t)(h * 256 + n) * BLOB;
        if (wv == 0) {
            const float ga = c.gab[(size_t)(T0 + lane) * 16 + h], gb = c.gab[(size_t)(T0 + lane) * 16 + 8 + h];
            const float gl_ = -__expf(c.a_log[h]) * softplusf_(ga + c.dt_bias[h]);
            float gc = gl_;
#pragma unroll
            for (int o = 1; o < 64; o <<= 1) { const float t_ = __shfl_up(gc, o); if (lane >= o) gc += t_; }
            const float glast = __shfl(gc, 63);
            sbeta[lane] = sigmoidf_(gb); sgc[lane] = gc; seg[lane] = __expf(gc); sek[lane] = __expf(glast - gc);
            if (lane == 0) *(float*)(blob + B_SC) = __expf(glast);
        }
        __syncthreads();
        const int tp = ltid(), part = tp >> 7, to = (tp >> 4) & 7, co = tp & 15, c0 = to * 8, d0 = co * 8;
        if (tp < 384) {
            const int chb = part * 1024 + h * 128 + d0;
            float val[8][8];
            {
                float wj[4][8];
#pragma unroll
                for (int j = 0; j < 4; ++j) { const f32x4 a = *(const f32x4*)(c.conv_w + j * 3072 + chb), b = *(const f32x4*)(c.conv_w + j * 3072 + chb + 4);
                    wj[j][0] = a[0]; wj[j][1] = a[1]; wj[j][2] = a[2]; wj[j][3] = a[3]; wj[j][4] = b[0]; wj[j][5] = b[1]; wj[j][6] = b[2]; wj[j][7] = b[3]; }
#pragma unroll
                for (int tt = 0; tt < 8; ++tt) {
                    float a[8] = {0.f, 0.f, 0.f, 0.f, 0.f, 0.f, 0.f, 0.f};
#pragma unroll
                    for (int j = 0; j < 4; ++j) { float xv[8]; unpack8(raw[tt + j], xv);
#pragma unroll
                        for (int jj = 0; jj < 8; ++jj) a[jj] += wj[j][jj] * xv[jj]; }
#pragma unroll
                    for (int jj = 0; jj < 8; ++jj) val[tt][jj] = siluf_(a[jj]);
                }
            }
            if (part < 2) {
#pragma unroll
                for (int tt = 0; tt < 8; ++tt) { float ss = 0.f;
#pragma unroll
                    for (int jj = 0; jj < 8; ++jj) ss += val[tt][jj] * val[tt][jj];
                    ss += __shfl_xor(ss, 1); ss += __shfl_xor(ss, 2); ss += __shfl_xor(ss, 4); ss += __shfl_xor(ss, 8);
                    const float rn = rsqrtf(ss + 1e-6f) * (part == 0 ? 0.08838834764831845f : 1.f);
#pragma unroll
                    for (int jj = 0; jj < 8; ++jj) val[tt][jj] *= rn; }
            }
            if (part == 0) {
#pragma unroll
                for (int tt = 0; tt < 8; ++tt) { const int cc = c0 + tt; *(LAS u32x4*)(lds + P_Q + cc * ST128 + d0 * 2) = pack8(val[tt]);
                    const float e = seg[cc]; float qd[8];
#pragma unroll
                    for (int jj = 0; jj < 8; ++jj) qd[jj] = val[tt][jj] * e;
                    *(u32x4*)(blob + B_QD + cc * ST128 + d0 * 2) = pack8(qd); }
            } else if (part == 1) {
#pragma unroll
                for (int tt = 0; tt < 8; ++tt) { const int cc = c0 + tt; *(LAS u32x4*)(lds + P_K + cc * ST128 + d0 * 2) = pack8(val[tt]);
                    const float e = seg[cc] * sbeta[cc]; float kb[8];
#pragma unroll
                    for (int jj = 0; jj < 8; ++jj) kb[jj] = val[tt][jj] * e;
                    *(u32x4*)(blob + B_KBG + cc * ST128 + d0 * 2) = pack8(kb); }
#pragma unroll
                for (int jj = 0; jj < 8; ++jj) { float col[8];
#pragma unroll
                    for (int tt = 0; tt < 8; ++tt) col[tt] = val[tt][jj] * sek[c0 + tt];
                    *(u32x4*)(blob + B_KU + (d0 + jj) * ST64 + c0 * 2) = pack8(col); }
            } else {
#pragma unroll
                for (int jj = 0; jj < 8; ++jj) { float col[8];
#pragma unroll
                    for (int tt = 0; tt < 8; ++tt) col[tt] = val[tt][jj] * sbeta[c0 + tt];
                    *(u32x4*)(blob + B_VB + (d0 + jj) * ST64 + c0 * 2) = pack8(col); }
            }
        }
        __syncthreads();
        if (i + 1 < 8) GR_ISSUE(i + 1);
        {
            const int nt = wv & 3, mb = (wv >> 2) * 2, jj = nt * 16 + fr;
            f32x4 kk2[2] = {(f32x4){0.f, 0.f, 0.f, 0.f}, (f32x4){0.f, 0.f, 0.f, 0.f}}, at2[2] = {(f32x4){0.f, 0.f, 0.f, 0.f}, (f32x4){0.f, 0.f, 0.f, 0.f}};
            mma_nt<2, 4>(kk2, lds + P_K + mb * 16 * ST128, ST128, lds + P_K + nt * 16 * ST128, ST128, fr, fq);
            mma_nt<2, 4>(at2, lds + P_K + mb * 16 * ST128, ST128, lds + P_Q + nt * 16 * ST128, ST128, fr, fq);
            float* at = c.gAT + (size_t)(h * 256 + n) * 4096;
            const float gj = sgc[jj];
#pragma unroll
            for (int m = 0; m < 2; ++m) { const int i0 = (mb + m) * 16 + 4 * fq; f32x4 av; float pv[4];
#pragma unroll
                for (int r = 0; r < 4; ++r) { const int ii = i0 + r; const float gi = sgc[ii];
                    av[r] = jj < ii ? sbeta[ii] * kk2[m][r] * __expf(gi - gj) : 0.f;
                    pv[r] = ii <= jj ? at2[m][r] * __expf(gj - gi) : 0.f; }
                *(f32x4*)(at + jj * 64 + i0) = av;
                u32x2 w; w.x = cvt_pk_bf16(pv[0], pv[1]); w.y = cvt_pk_bf16(pv[2], pv[3]);
                *(u32x2*)(blob + B_AT + jj * ST64 + i0 * 2) = w; }
        }
        __syncthreads();
    }
}
__device__ void gdn_invert(CtxK& c, LAS unsigned char* lds, int h, int g) {
    const int tid = ltid(), wv = __builtin_amdgcn_readfirstlane(tid >> 6), lane = tid & 63;
    const int n = g * 8 + wv;
    LAS float* at = (LAS float*)(lds + wv * 16384);
    const float* src = c.gAT + (size_t)(h * 256 + n) * 4096;
#pragma unroll
    for (int k = 0; k < 16; ++k) *(LAS f32x4*)(at + (k * 64 + lane) * 4) = *(const f32x4*)(src + (k * 64 + lane) * 4);
    lds_fence();
    float r[64];
    unsigned ata = (unsigned)(size_t)at;
#pragma unroll
    for (int j = 63; j >= 0; --j) {
        float acc = lane == j ? 1.f : 0.f;
        LAS const float* arow = (LAS const float*)(size_t)ata + j * 64;
#pragma unroll
        for (int m4 = ((j + 1) & ~3); m4 < 64; m4 += 4) {
            const f32x4 a = *(LAS const f32x4*)(arow + m4);
#pragma unroll
            for (int q = 0; q < 4; ++q) if (m4 + q > j) acc = __builtin_fmaf(-r[m4 + q], a[q], acc);
        }
        r[j] = acc;
        asm volatile("" : "+v"(ata) : "v"(acc));
    }
    unsigned char* blob = (unsigned char*)c.gBlob + (size_t)(h * 256 + n) * BLOB;
#pragma unroll
    for (int k = 0; k < 8; ++k) { float v8[8];
#pragma unroll
        for (int q = 0; q < 8; ++q) v8[q] = r[k * 8 + q];
        *(u32x4*)(blob + B_T + lane * ST64 + k * 16) = pack8(v8); }
}
template <int MODE>
__device__ void gdn_pass(CtxK& c, LAS unsigned char* lds, int h, int g) {
    const int tid = ltid(), wv = __builtin_amdgcn_readfirstlane(tid >> 6), lane = tid & 63, fr = lane & 15, fq = lane >> 4;
    LAS unsigned char* stw = lds + G_ST + wv * 16 * ST128; LAS unsigned char* rvw = lds + G_RV + wv * 16 * ST64;
    LAS float* part = (LAS float*)(lds + G_PART); LAS float* rinv = (LAS float*)(lds + G_RINV);
    f32x4 Sacc[8];
#pragma unroll
    for (int m = 0; m < 8; ++m) {
        if (MODE == 1) { const int v = 16 * wv + fr, d0 = 16 * m + 4 * fq; Sacc[m] = (f32x4){d0 == v ? 1.f : 0.f, d0 + 1 == v ? 1.f : 0.f, d0 + 2 == v ? 1.f : 0.f, d0 + 3 == v ? 1.f : 0.f}; }
        else Sacc[m] = (f32x4){0.f, 0.f, 0.f, 0.f};
    }
    if (MODE == 2 && g > 0) { const f32x4* sp = (const f32x4*)c.gS + (size_t)(h * 32 + g) * FRAG_F4 + (wv * 8) * 64 + lane;
#pragma unroll
        for (int m = 0; m < 8; ++m) Sacc[m] = sp[m * 64]; }
    write_st(stw, Sacc, fr, fq);
    constexpr int LIM = MODE == 2 ? B_SC : B_QD, NQ = (LIM + 8191) / 8192;
    u32x4 pre[NQ];
    const unsigned char* blob0 = (const unsigned char*)c.gBlob + (size_t)(h * 256 + g * 8) * BLOB;
#define GP_ISSUE(i_) do { const unsigned char* bp_ = blob0 + (size_t)(i_) * BLOB + ltid() * 16; _Pragma("unroll") for (int q = 0; q < NQ; ++q) if (q * 8192 + 8176 < LIM || ltid() * 16 + q * 8192 < LIM) pre[q] = *(const u32x4*)(bp_ + q * 8192); } while (0)
    GP_ISSUE(0);
    for (int i = 0; i < 8; ++i) {
        const int n = g * 8 + i, T0 = n * 64;
        { const int tl = ltid() * 16;
#pragma unroll
          for (int q = 0; q < NQ; ++q) if (q * 8192 + 8176 < LIM || tl + q * 8192 < LIM) *(LAS u32x4*)(lds + tl + q * 8192) = pre[q]; }
        const float dlast = *(const float*)(blob0 + (size_t)i * BLOB + B_SC);
        u32x4 gpre[2];
        if (MODE == 2) gate_issue(gpre, c.proj + (size_t)T0 * PW + C_GG + h * 128);
        __syncthreads();
        if (i + 1 < 8) GP_ISSUE(i + 1);
        { f32x4 R[4];
#pragma unroll
          for (int m = 0; m < 4; ++m) R[m] = (f32x4){0.f, 0.f, 0.f, 0.f};
          mma_nt<4, 4>(R, lds + B_KBG, ST128, stw, ST128, fr, fq);
#pragma unroll
          for (int m = 0; m < 4; ++m) { float x0 = 0.f, x1 = 0.f, x2 = 0.f, x3 = 0.f;
              if (MODE != 1) { const u32x2 vb = *(LAS u32x2*)(lds + B_VB + (16 * wv + fr) * ST64 + (16 * m + 4 * fq) * 2); x0 = bflo(vb.x); x1 = bfhi(vb.x); x2 = bflo(vb.y); x3 = bfhi(vb.y); }
              u32x2 w; w.x = cvt_pk_bf16(x0 - R[m][0], x1 - R[m][1]); w.y = cvt_pk_bf16(x2 - R[m][2], x3 - R[m][3]);
              *(LAS u32x2*)(rvw + fr * ST64 + (16 * m + 4 * fq) * 2) = w; } }
        lds_fence();
        { f32x4 VN[4];
#pragma unroll
          for (int m = 0; m < 4; ++m) VN[m] = (f32x4){0.f, 0.f, 0.f, 0.f};
          mma_nt<4, 2>(VN, lds + B_T, ST64, rvw, ST64, fr, fq);
          mfma_pad4(VN); lds_fence();
#pragma unroll
          for (int m = 0; m < 4; ++m) { u32x2 w; w.x = cvt_pk_bf16(VN[m][0], VN[m][1]); w.y = cvt_pk_bf16(VN[m][2], VN[m][3]); *(LAS u32x2*)(rvw + fr * ST64 + (16 * m + 4 * fq) * 2) = w; } }
        lds_fence();
        f32x4 O[4];
        if (MODE == 2) {
#pragma unroll
            for (int m = 0; m < 4; ++m) O[m] = (f32x4){0.f, 0.f, 0.f, 0.f};
            mma_nt<4, 4>(O, lds + B_QD, ST128, stw, ST128, fr, fq);
            mma_nt<4, 2>(O, lds + B_AT, ST64, rvw, ST64, fr, fq);
#pragma unroll
            for (int m = 0; m < 4; ++m)
#pragma unroll
                for (int r = 0; r < 4; ++r) { float q = O[m][r] * O[m][r]; q += __shfl_xor(q, 1); q += __shfl_xor(q, 2); q += __shfl_xor(q, 4); q += __shfl_xor(q, 8); if (fr == 0) part[wv * 64 + 16 * m + 4 * fq + r] = q; }
        }
#pragma unroll
        for (int m = 0; m < 8; ++m) Sacc[m] = Sacc[m] * dlast;
        mma_nt<8, 2>(Sacc, lds + B_KU, ST64, rvw, ST64, fr, fq);
        lds_fence();
        write_st(stw, Sacc, fr, fq);
        if (MODE == 2) {
            __syncthreads();
            out_stage(lds + B_KBG, part, O, gpre, c.gdn_onorm_g, c.ocat + (size_t)T0 * D + 1024 + h * 128, wv, lane, fr, fq);
        }
        __syncthreads();
    }
#undef GP_ISSUE
    if (MODE == 0) {
        f32x4* sp = (f32x4*)c.gB + (size_t)(h * 32 + g) * FRAG_F4 + (wv * 8) * 64 + lane;
#pragma unroll
        for (int m = 0; m < 8; ++m) sp[m * 64] = Sacc[m];
    }
    if (MODE == 1) {
        mfma_pad8(Sacc);
        LAS bf16_t* img = (LAS bf16_t*)lds;
#pragma unroll
        for (int m = 0; m < 8; ++m)
#pragma unroll
            for (int r = 0; r < 4; ++r) img[(16 * m + 4 * fq + r) * (ST128 / 2) + 16 * wv + fr] = (bf16_t)(cvt_pk_bf16(Sacc[m][r], Sacc[m][r]) & 0xffffu);
        __syncthreads();
        unsigned char* dst = (unsigned char*)c.gM + (size_t)(h * 32 + g) * (128 * ST128);
#pragma unroll
        for (int q = 0; q < 5; ++q) { const int o = tid * 16 + q * 8192; if (q < 4 || o < 128 * ST128) *(u32x4*)(dst + o) = *(LAS u32x4*)(lds + o); }
        __syncthreads();
    }
}
__device__ void gdn_scan(CtxK& c, LAS unsigned char* lds, int h) {
    const int tid = ltid(), wv = __builtin_amdgcn_readfirstlane(tid >> 6), lane = tid & 63, fr = lane & 15, fq = lane >> 4;
    LAS unsigned char* stw = lds + G_ST + wv * 16 * ST128;
    f32x4 Sacc[8], Bn[8]; u32x4 mp[5];
#pragma unroll
    for (int m = 0; m < 8; ++m) Sacc[m] = (f32x4){0.f, 0.f, 0.f, 0.f};
#define GS_ISSUE(g_) do { const unsigned char* src_ = (const unsigned char*)c.gM + (size_t)(h * 32 + (g_)) * (128 * ST128) + tid * 16; \
        _Pragma("unroll") for (int q = 0; q < 5; ++q) if (q < 4 || tid * 16 + q * 8192 < 128 * ST128) mp[q] = *(const u32x4*)(src_ + q * 8192); \
        const f32x4* bp_ = (const f32x4*)c.gB + (size_t)(h * 32 + (g_)) * FRAG_F4 + (wv * 8) * 64 + lane; \
        _Pragma("unroll") for (int m = 0; m < 8; ++m) Bn[m] = bp_[m * 64]; } while (0)
    GS_ISSUE(0);
    for (int g = 0; g < 31; ++g) {
#pragma unroll
        for (int q = 0; q < 5; ++q) if (q < 4 || tid * 16 + q * 8192 < 128 * ST128) *(LAS u32x4*)(lds + tid * 16 + q * 8192) = mp[q];
        write_st(stw, Sacc, fr, fq);
#pragma unroll
        for (int m = 0; m < 8; ++m) Sacc[m] = Bn[m];
        __syncthreads();
        if (g + 1 < 31) GS_ISSUE(g + 1);
        mma_nt<8, 4>(Sacc, lds, ST128, stw, ST128, fr, fq);
        f32x4* sp = (f32x4*)c.gS + (size_t)(h * 32 + g + 1) * FRAG_F4 + (wv * 8) * 64 + lane;
#pragma unroll
        for (int m = 0; m < 8; ++m) sp[m * 64] = Sacc[m];
        __syncthreads();
    }
#undef GS_ISSUE
}
}
__device__ void ph_hgrn1(CtxK& c, LAS unsigned char* lds) { mx::hgrn_pass<false>(c, lds); }
__device__ void ph_hgrn2(CtxK& c, LAS unsigned char* lds) { mx::hgrn_scan(c); }
__device__ void ph_hgrn3(CtxK& c, LAS unsigned char* lds) { mx::hgrn_pass<true>(c, lds); }
__device__ void ph_gdn1(CtxK& c, LAS unsigned char* lds) {
    const int wu = blockIdx.x, h = wu & 7, g = wu >> 3;
    mx::gdn_prep(c, lds, h, g); __syncthreads();
    asm volatile("s_waitcnt vmcnt(0)" ::: "memory"); __syncthreads();
    mx::gdn_invert(c, lds, h, g);
    asm volatile("s_waitcnt vmcnt(0)" ::: "memory"); __syncthreads();
    mx::gdn_pass<0>(c, lds, h, g); __syncthreads();
    mx::gdn_pass<1>(c, lds, h, g); __syncthreads();
}
__device__ void ph_gdn2(CtxK& c, LAS unsigned char* lds) { if (blockIdx.x < 8) mx::gdn_scan(c, lds, blockIdx.x); }
__device__ void ph_gdn3(CtxK& c, LAS unsigned char* lds) { const int wu = blockIdx.x; mx::gdn_pass<2>(c, lds, wu & 7, wu >> 3); }

constexpr int N2_LA = 0, N2_LB = 8192, N2_XH = 16384, N2_XL = N2_XH + 17408, N2_Y = N2_XL + 17408, N2_LOG = N2_Y + 34816, N2_RS = N2_LOG + 64 * 65 * 4, N2_IDX = N2_RS + 256, N2_BIAS = N2_IDX + 2048, N2_END = N2_BIAS + 256;
static_assert(N2_END <= 147456, "norm2 lds");
__device__ void ph_norm2(CtxK& c, LAS unsigned char* lds) {
    const int tid = ltid(), wg = blockIdx.x, lane = tid & 63, wv = __builtin_amdgcn_readfirstlane(tid >> 6), fr = lane & 15, fq = lane >> 4;
    LAS float* la = (LAS float*)(lds + N2_LA); LAS float* lb_ = (LAS float*)(lds + N2_LB); LAS float* lg = (LAS float*)(lds + N2_LOG); LAS float* rs = (LAS float*)(lds + N2_RS);
    LAS int* idxt = (LAS int*)(lds + N2_IDX); LAS float* bias2 = (LAS float*)(lds + N2_BIAS);
    for (int j = tid; j < D; j += 512) { la[j] = c.norm2_g[j] * (1.f + c.mod[4 * D + j]); lb_[j] = c.mod[3 * D + j]; }
    if (tid < 64) bias2[tid] = c.rbias2[tid];
    __syncthreads();
    const int tok0 = wg * 64;
    f32x4 vn[8];
    { const float* xr = c.out + (size_t)(tok0 + wv * 8) * D;
#pragma unroll
      for (int i = 0; i < 8; ++i) vn[i] = *(const f32x4*)(xr + i * 256 + lane * 4); }
    for (int rr = 0; rr < 8; ++rr) {
        const int row = tok0 + wv * 8 + rr;
        f32x4 v[8]; float ss = 0.f;
#pragma unroll
        for (int i = 0; i < 8; ++i) { v[i] = vn[i]; ss += v[i][0] * v[i][0] + v[i][1] * v[i][1] + v[i][2] * v[i][2] + v[i][3] * v[i][3]; }
        if (rr + 1 < 8) { const float* xr = c.out + (size_t)(row + 1) * D;
#pragma unroll
            for (int i = 0; i < 8; ++i) vn[i] = *(const f32x4*)(xr + i * 256 + lane * 4); }
        ss = wave_sum(ss); const float r = rsqrtf(ss * (1.f / D) + 1e-6f);
        if (lane == 0) rs[wv * 8 + rr] = r;
#pragma unroll
        for (int i = 0; i < 8; ++i) { const int e = i * 256 + lane * 4; const f32x4 a = *(LAS f32x4*)(la + e), b = *(LAS f32x4*)(lb_ + e); const f32x4 y = v[i] * r * a + b;
            *(unsigned*)(c.h2 + (size_t)row * D + e) = cvt4_fp8(4.f * y[0], 4.f * y[1], 4.f * y[2], 4.f * y[3]); }
    }
    const int xrow = tid >> 3, xseg = (tid & 7) * 16;
    f32x4 xr_[4]; u32x4 yr_[5];
    auto issue = [&](int ch) {
        const float* xp = c.out + (size_t)(tok0 + xrow) * D + ch * 128 + xseg;
#pragma unroll
        for (int q = 0; q < 4; ++q) xr_[q] = *(const f32x4*)(xp + q * 4);
        const unsigned char* yp = (const unsigned char*)c.rwimg + (size_t)ch * 34816 + tid * 16;
#pragma unroll
        for (int q = 0; q < 4; ++q) yr_[q] = *(const u32x4*)(yp + q * 8192);
        if (tid < 128) yr_[4] = *(const u32x4*)(yp + 32768);
    };
    issue(0);
    f32x4 acc[2] = {(f32x4){0.f, 0.f, 0.f, 0.f}, (f32x4){0.f, 0.f, 0.f, 0.f}};
    const int mt = wv >> 1, nb = (wv & 1) * 2;
    for (int ch = 0; ch < 16; ++ch) {
        __syncthreads();
        { float hi[16], lo[16];
#pragma unroll
          for (int q = 0; q < 4; ++q)
#pragma unroll
              for (int j = 0; j < 4; ++j) { const float x = xr_[q][j]; const float h = __uint_as_float(cvt_pk_bf16(x, x) << 16); hi[q * 4 + j] = h; lo[q * 4 + j] = x - h; }
          float t8[8];
#pragma unroll
          for (int hh = 0; hh < 2; ++hh) {
#pragma unroll
              for (int j = 0; j < 8; ++j) t8[j] = hi[hh * 8 + j];
              *(LAS u32x4*)(lds + N2_XH + xrow * 272 + (xseg + hh * 8) * 2) = mx::pack8(t8);
#pragma unroll
              for (int j = 0; j < 8; ++j) t8[j] = lo[hh * 8 + j];
              *(LAS u32x4*)(lds + N2_XL + xrow * 272 + (xseg + hh * 8) * 2) = mx::pack8(t8); }
#pragma unroll
          for (int q = 0; q < 4; ++q) *(LAS u32x4*)(lds + N2_Y + tid * 16 + q * 8192) = yr_[q];
          if (tid < 128) *(LAS u32x4*)(lds + N2_Y + tid * 16 + 32768) = yr_[4]; }
        __syncthreads();
        if (ch + 1 < 16) issue(ch + 1);
#pragma unroll
        for (int kk = 0; kk < 4; ++kk) {
            const int ko = (kk * 32 + fq * 8) * 2;
            const bf16x8 ah = *(const LAS bf16x8*)(lds + N2_XH + (16 * mt + fr) * 272 + ko), al = *(const LAS bf16x8*)(lds + N2_XL + (16 * mt + fr) * 272 + ko);
#pragma unroll
            for (int n = 0; n < 2; ++n) {
                const bf16x8 bh = *(const LAS bf16x8*)(lds + N2_Y + (16 * (nb + n) + fr) * 272 + ko), bl = *(const LAS bf16x8*)(lds + N2_Y + 17408 + (16 * (nb + n) + fr) * 272 + ko);
                acc[n] = mx::mfma16(ah, bh, acc[n]); acc[n] = mx::mfma16(ah, bl, acc[n]); acc[n] = mx::mfma16(al, bh, acc[n]);
            }
        }
    }
#pragma unroll
    for (int n = 0; n < 2; ++n)
#pragma unroll
        for (int r = 0; r < 4; ++r) lg[(16 * mt + 4 * fq + r) * 65 + 16 * (nb + n) + fr] = acc[n][r];
    __syncthreads();
    const float rb = c.router_bias[lane], b2 = bias2[lane];
    for (int rr = 0; rr < 8; ++rr) {
        const int lr = wv * 8 + rr, t = tok0 + lr;
        const float s = sigmoidf_(lg[lr * 65 + lane] * rs[lr] + b2), b = s + rb;
        int rk = 0;
#pragma unroll
        for (int x = 1; x < 8; ++x) { const float ob = __shfl_xor(b, x); const int ol = lane ^ x; rk += (ob > b || (ob == b && ol < lane)) ? 1 : 0; }
        float gs = rk < 2 ? b : 0.f; gs += __shfl_xor(gs, 1); gs += __shfl_xor(gs, 2); gs += __shfl_xor(gs, 4);
        int grk = 0;
#pragma unroll
        for (int x = 8; x < 64; x += 8) { const float og = __shfl_xor(gs, x); const int ol = lane ^ x; grk += (og > gs || (og == gs && ol < lane)) ? 1 : 0; }
        float mb = grk < 4 ? b : -INFINITY;
        float wsum = 0.f; int myk = -1;
        for (int k = 0; k < TOPK; ++k) {
            float m = mb;
#pragma unroll
            for (int o = 32; o >= 1; o >>= 1) m = fmaxf(m, __shfl_xor(m, o));
            const unsigned long long bal = __ballot(mb == m); const int win = __ffsll((long long)bal) - 1;
            const float sw = __shfl(s, win); wsum += sw;
            if (lane == win) { mb = -INFINITY; myk = k; }
        }
        if (myk >= 0) { c.idx[t * TOPK + myk] = lane; c.wts[t * TOPK + myk] = s / wsum * 2.5f; idxt[lr * TOPK + myk] = lane; }
    }
    __syncthreads();
    if (tid < 64) { int n = 0;
        for (int p = 0; p < 512; ++p) if (idxt[p] == tid) { c.rnk[wg * 512 + p] = n; ++n; }
        c.tile_cnt[wg * 64 + tid] = n; }
}
__device__ void ph_route(CtxK& c, LAS unsigned char* lds) {
    const int tid = ltid(), b = blockIdx.x, e = tid & 63, part = tid >> 6;
    LAS int* psum = (LAS int*)lds; LAS int* pbel = psum + 512; LAS int* tot = pbel + 512; LAS int* offb = tot + 64; LAS int* pst = offb + 64;
    { int sa = 0, sb = 0;
      for (int tl = part * 32; tl < part * 32 + 32; ++tl) { const int v = c.tile_cnt[tl * 64 + e]; sa += v; sb += tl < b ? v : 0; }
      psum[part * 64 + e] = sa; pbel[part * 64 + e] = sb; }
    __syncthreads();
    if (tid < 64) {
        int t_ = 0, o_ = 0;
#pragma unroll
        for (int q = 0; q < 8; ++q) { t_ += psum[q * 64 + e]; o_ += pbel[q * 64 + e]; }
        const int pad = (t_ + 255) & ~255; int inc = pad;
#pragma unroll
        for (int o = 1; o < 64; o <<= 1) { const int x = __shfl_up(inc, o); if (e >= o) inc += x; }
        const int ps = inc - pad;
        tot[e] = t_; offb[e] = o_; pst[e] = ps;
        if (b == 0) {
            const int b0 = ps >> 8, nbe = pad >> 8;
            for (int j = 0; j < nbe; ++j) { c.blk_row[b0 + j] = ps + j * 256; c.blk_exp[b0 + j] = e; }
            const int nbr = __shfl(inc, 63) >> 8;
            c.blk_row[nbr + e] = PROUTED + e * 256; c.blk_exp[nbr + e] = NE;
            if (e == 0) *c.nent = nbr + S / 256;
        }
        c.tok_p[PROUTED + b * 64 + e] = b * 64 + e; c.w_p[PROUTED + b * 64 + e] = 1.f;
    }
    __syncthreads();
    { const int p = b * 512 + tid, ex = c.idx[p], d = pst[ex] + offb[ex] + c.rnk[p];
      c.tok_p[d] = p >> 3; c.w_p[d] = c.wts[p]; c.pos[p] = d; }
    if (b < NE) { const int ps = pst[b], t_ = tot[b], pe = (t_ + 255) & ~255;
        for (int r = t_ + tid; r < pe; r += 512) { c.tok_p[ps + r] = 0; c.w_p[ps + r] = 0.f; } }
}

constexpr int LDS_BYTES = 163840, LDS_MAIN = LDS_BYTES - 16;
static_assert(gm::VBOFF + 512 * 8 <= LDS_MAIN, "lds map");
__global__ void __launch_bounds__(512, 2) k_mega(Ctx c) {
    extern __shared__ __attribute__((aligned(16))) unsigned char smem[];
    LAS unsigned char* lds = (LAS unsigned char*)smem;
    if (ltid() == 0) *(LAS u32x4*)(lds + LDS_MAIN) = (u32x4){0u, 0u, 0u, 0u};
    __syncthreads();
    CtxK* kp = (CtxK*)__builtin_amdgcn_kernarg_segment_ptr();
    (void)xcd_barrier_post(c.bar, (volatile LAS unsigned*)(lds + LDS_MAIN));
#define PHASE(fn) do { const CtxK* kp_ = kp; asm volatile("" : "+s"(kp_)); fn(*kp_, lds); __syncthreads(); } while (0)
#define GRID_BARRIER() do { const CtxK* kp_ = kp; asm volatile("" : "+s"(kp_)); XcdBarrier bb_; bb_.bar = kp_->bar; bb_.x = xb_xcc_id(); bb_.st = (volatile LAS unsigned*)(lds + LDS_MAIN); xcd_barrier(bb_); } while (0)
    PHASE(ph_pro1);      GRID_BARRIER();
    PHASE(ph_norm1);     GRID_BARRIER();
    PHASE(ph_gemm1);     GRID_BARRIER();
    PHASE(ph_hgrn1);     PHASE(ph_gdn1);  GRID_BARRIER();
    PHASE(ph_hgrn2);     PHASE(ph_gdn2);  PHASE(ph_cvt_exp); GRID_BARRIER();
    PHASE(ph_hgrn3);     PHASE(ph_gdn3);  GRID_BARRIER();
    PHASE(ph_gemm2);     GRID_BARRIER();
    PHASE(ph_gemm3);     GRID_BARRIER();
    PHASE(ph_norm2);     GRID_BARRIER();
    PHASE(ph_route);     GRID_BARRIER();
    PHASE(ph_moe_gu);    GRID_BARRIER();
    PHASE(ph_moe_dn);    GRID_BARRIER();
    PHASE(ph_final);
#undef PHASE
#undef GRID_BARRIER
}

extern "C" void kernel_launch(void* const* d_in, const int* in_sizes, int n_in, void* d_out, int out_size, void* d_ws, size_t ws_size, hipStream_t stream) {
    Ctx c{};
    const float** ip = (const float**)&c.x;
    for (int i = 0; i < 25; ++i) ip[i] = (const float*)d_in[i];
    c.out = (float*)d_out;
    char* ws = (char*)d_ws; constexpr size_t MB = 1024 * 1024;
    c.bar = (unsigned*)ws;
    c.modp = (float*)(ws + 64 * 1024); c.mod = (float*)(ws + 320 * 1024); c.lb = (float*)(ws + 384 * 1024);
    c.cnt = (int*)(ws + 392 * 1024); c.nent = (int*)(ws + 396 * 1024); c.blk_row = (int*)(ws + 400 * 1024); c.blk_exp = (int*)(ws + 404 * 1024);
    c.idx = (int*)(ws + 1 * MB); c.wts = (float*)(ws + 2 * MB); c.tok_p = (int*)(ws + 3 * MB); c.w_p = (float*)(ws + 4 * MB); c.pos = (int*)(ws + 5 * MB);
    c.gab = (float*)(ws + 6 * MB); c.gbeta = (float*)(ws + 7 * MB + 0); c.gdec = (float*)(ws + 7 * MB + 512 * 1024);
    c.rwimg = (bf16_t*)(ws + 8 * MB); c.rbias2 = (float*)(ws + 9 * MB); c.tile_cnt = (int*)(ws + 9 * MB + 4096); c.rnk = (int*)(ws + 10 * MB);
    char* big = ws + 16 * MB;
    auto at = [&](size_t mib) { return big + mib * MB; };
    c.dn_t = (unsigned char*)at(0); c.gu_t = (unsigned char*)at(130);
    c.win_t = (bf16_t*)at(0); c.h1 = (bf16_t*)at(48); c.gAT = (float*)at(112);
    c.proj = (bf16_t*)at(390); c.gBlob = (unsigned char*)at(774); c.merged = (bf16_t*)at(774);
    c.gM = (unsigned char*)at(951); c.gB = (float*)at(960); c.hL = (float*)at(976); c.gS = (float*)at(992); c.hS = (float*)at(1008); c.hD = (float*)at(1024);
    c.wa_t = (bf16_t*)at(1025); c.wb_t = (bf16_t*)at(1029); c.wout_t = (bf16_t*)at(1033); c.ocat = (bf16_t*)at(1041);
    c.Y = (unsigned char*)at(130); c.hid = (unsigned char*)at(770); c.h2 = (unsigned char*)at(930);
    static_assert((size_t)NEX * D * FF * 2 <= 130 * MB && (size_t)NEX * 1024 * D * 2 <= 260 * MB && (size_t)PW * D * 2 <= 48 * MB && (size_t)S * D * 2 <= 64 * MB, "map A");
    static_assert((size_t)S * PW * 2 <= 384 * MB && (size_t)2048 * mx::BLOB <= 177 * MB && (size_t)256 * 128 * mx::ST128 <= 9 * MB && (size_t)PTOT * D * 2 <= 640 * MB && (size_t)PTOT * FF * 2 <= 160 * MB, "map B");
    const size_t need = 16 * MB + 1105 * MB;
    if (ws_size < need) { fprintf(stderr, "kernel_launch: workspace too small: %zu < %zu\n", ws_size, need); return; }

    static int grid = 0;
    if (!grid) {
        int dev = 0, cus = 0, per_cu = 0;
        hipGetDevice(&dev); hipDeviceGetAttribute(&cus, hipDeviceAttributeMultiprocessorCount, dev);
        hipFuncSetAttribute((const void*)k_mega, hipFuncAttributeMaxDynamicSharedMemorySize, LDS_BYTES);
        hipOccupancyMaxActiveBlocksPerMultiprocessor(&per_cu, (const void*)k_mega, 512, LDS_BYTES);
        if (per_cu < 1) fprintf(stderr, "kernel_launch: occupancy query reports %d blocks per CU\n", per_cu);
        grid = cus;
        if (grid != 256) { fprintf(stderr, "kernel_launch: built for a 256-CU device (token-mixer units = workgroups); got %d CUs\n", cus); grid = -1; }
    }
    if (grid < 0) return;
    hipMemsetAsync(c.bar, 0, XCD_BAR_WORDS * sizeof(unsigned), stream);
    hipLaunchKernelGGL(k_mega, dim3(grid), dim3(512), LDS_BYTES, stream, c);
}
```

```cpp
#include <hip/hip_runtime.h>
#include <stdint.h>
#include <stdio.h>

#define LAS __attribute__((address_space(3)))
typedef unsigned short bf16_t;
typedef short bf16x8 __attribute__((ext_vector_type(8)));
typedef float f32x4 __attribute__((ext_vector_type(4)));
typedef unsigned u32x4 __attribute__((ext_vector_type(4)));
typedef unsigned u32x2 __attribute__((ext_vector_type(2)));
typedef int v4i __attribute__((ext_vector_type(4)));
typedef int v8i __attribute__((ext_vector_type(8)));

constexpr int S = 16384, D = 2048, INW = 12304, PW = 12288, NE = 64, TOPK = 8, TK = S * TOPK, FF = 512;
constexpr int NEX = NE + 1;
constexpr int PROUTED = 147456, PTOT = PROUTED + S, NBLK_MAX = PROUTED / 256;
constexpr int C_HQ = 0, C_HF = 1024, C_HI = 2048, C_HG = 3072, C_GQKV = 4096, C_GG = 7168, C_MGA = 8192, C_MGB = 10240;
constexpr int WIN_GAB = 7168;

__device__ __forceinline__ float rcpf_(float x) { return __builtin_amdgcn_rcpf(x); }
__device__ __forceinline__ float sigmoidf_(float x) { return rcpf_(1.f + __expf(-x)); }
__device__ __forceinline__ float siluf_(float x) { return x * rcpf_(1.f + __expf(-x)); }
__device__ __forceinline__ float softplusf_(float x) { return x > 20.f ? x : log1pf(expf(x)); }
__device__ __forceinline__ float bf2f(bf16_t b) { return __uint_as_float(((unsigned)b) << 16); }
__device__ __forceinline__ float bflo(unsigned w) { return __uint_as_float(w << 16); }
__device__ __forceinline__ float bfhi(unsigned w) { return __uint_as_float(w & 0xffff0000u); }
__device__ __forceinline__ unsigned cvt_pk_bf16(float lo, float hi) { unsigned r; asm volatile("v_cvt_pk_bf16_f32 %0, %1, %2" : "=v"(r) : "v"(lo), "v"(hi)); return r; }
__device__ __forceinline__ unsigned cvt4_fp8(float a, float b, float c_, float d) {
    a = fminf(fmaxf(a, -448.f), 448.f); b = fminf(fmaxf(b, -448.f), 448.f); c_ = fminf(fmaxf(c_, -448.f), 448.f); d = fminf(fmaxf(d, -448.f), 448.f);
    int w = __builtin_amdgcn_cvt_pk_fp8_f32(a, b, 0, false); w = __builtin_amdgcn_cvt_pk_fp8_f32(c_, d, w, true); return (unsigned)w; }
__device__ __forceinline__ int ltid() { int t = threadIdx.x; asm volatile("" : "+v"(t)); return t; }
template <int CTRL> __device__ __forceinline__ float dppf(float v) { return __builtin_bit_cast(float, __builtin_amdgcn_update_dpp(0, __builtin_bit_cast(int, v), CTRL, 0xf, 0xf, false)); }
__device__ __forceinline__ float wave_max_dpp(float v) {
    v = fmaxf(v, dppf<0x128>(v)); v = fmaxf(v, dppf<0x124>(v)); v = fmaxf(v, dppf<0x122>(v)); v = fmaxf(v, dppf<0x121>(v));
    const int b = __builtin_bit_cast(int, v);
    return fmaxf(fmaxf(__builtin_bit_cast(float, __builtin_amdgcn_readlane(b, 0)), __builtin_bit_cast(float, __builtin_amdgcn_readlane(b, 16))), fmaxf(__builtin_bit_cast(float, __builtin_amdgcn_readlane(b, 32)), __builtin_bit_cast(float, __builtin_amdgcn_readlane(b, 48))));
}
__device__ __forceinline__ float wave_sum_dpp(float v) {
    v += __builtin_bit_cast(float, __builtin_amdgcn_update_dpp(0, __builtin_bit_cast(int, v), 0x128, 0xf, 0xf, false));
    v += __builtin_bit_cast(float, __builtin_amdgcn_update_dpp(0, __builtin_bit_cast(int, v), 0x124, 0xf, 0xf, false));
    v += __builtin_bit_cast(float, __builtin_amdgcn_update_dpp(0, __builtin_bit_cast(int, v), 0x122, 0xf, 0xf, false));
    v += __builtin_bit_cast(float, __builtin_amdgcn_update_dpp(0, __builtin_bit_cast(int, v), 0x121, 0xf, 0xf, false));
    const int b = __builtin_bit_cast(int, v);
    return __builtin_bit_cast(float, __builtin_amdgcn_readlane(b, 0)) + __builtin_bit_cast(float, __builtin_amdgcn_readlane(b, 16)) + __builtin_bit_cast(float, __builtin_amdgcn_readlane(b, 32)) + __builtin_bit_cast(float, __builtin_amdgcn_readlane(b, 48));
}
__device__ __forceinline__ float wave_sum(float v) {
#pragma unroll
    for (int o = 32; o >= 1; o >>= 1) v += __shfl_xor(v, o);
    return v;
}


#define XB_TMO      128
#define XB_XCNT(j)  (256  + 64 * (j))
#define XB_XSUB(j)  (1280 + 64 * (j))
#define XB_XGEN(j)  (2304 + 64 * (j))
#define XB_TOP      3328
#define XB_TOPGEN   3392
#define XCD_BAR_WORDS 3456
#define XB_SPIN_CAP (1u << 18)
__device__ __forceinline__ unsigned xb_ld(unsigned* p)              { return __hip_atomic_load(p, __ATOMIC_RELAXED, __HIP_MEMORY_SCOPE_AGENT); }
__device__ __forceinline__ unsigned xb_add(unsigned* p, unsigned v) { return __hip_atomic_fetch_add(p, v, __ATOMIC_RELAXED, __HIP_MEMORY_SCOPE_AGENT); }
__device__ __forceinline__ unsigned xb_xcc_id() { return (unsigned)__builtin_amdgcn_s_getreg((3 << 11) | 20) & 0xFu; }
#define XB_SPIN(cond, bar) do { unsigned _sp = 0; while (cond) { __builtin_amdgcn_s_sleep(1); \
    if ((++_sp & 255u) == 0u) { if (xb_ld(&(bar)[XB_TMO])) break; if (_sp > XB_SPIN_CAP) { atomicAdd(&(bar)[XB_TMO], 1u); break; } } } } while (0)
struct XcdBarrier { unsigned* bar; unsigned x; volatile LAS unsigned* st; };
__device__ __forceinline__ XcdBarrier xcd_barrier_post(unsigned* bar, volatile LAS unsigned* st) {
    XcdBarrier b; b.bar = bar; b.x = xb_xcc_id(); b.st = st;
    if (threadIdx.x == 0) (void)xb_add(&bar[XB_XCNT(b.x)], 1u);
    return b;
}
__device__ __forceinline__ void xcd_barrier_complete(unsigned* bar, unsigned x, unsigned& nloc, unsigned& nx) {
    const unsigned G = gridDim.x * gridDim.y * gridDim.z;
    unsigned sum, cnt, mine, sp = 0u;
    for (;;) {
        sum = 0u; cnt = 0u; mine = 0u;
#pragma unroll
        for (unsigned j = 0; j < 16; ++j) { const unsigned c = xb_ld(&bar[XB_XCNT(j)]); sum += c; cnt += (c > 0u) ? 1u : 0u; mine = (j == x) ? c : mine; }
        if (sum == G) break;
        __builtin_amdgcn_s_sleep(1);
        if ((++sp & 255u) == 0u) { if (xb_ld(&bar[XB_TMO])) break; if (sp > XB_SPIN_CAP) { atomicAdd(&bar[XB_TMO], 1u); break; } }
    }
    nloc = mine > 0u ? mine : 1u; nx = cnt > 0u ? cnt : 1u;
}
__device__ __forceinline__ void xcd_barrier(const XcdBarrier& b) {
    asm volatile("s_waitcnt vmcnt(0)" ::: "memory");
    __syncthreads();
    if (threadIdx.x == 0) {
        unsigned* bar = b.bar;
        __builtin_amdgcn_s_waitcnt(0);
        unsigned nloc = b.st[0], nx = b.st[1];
        if (nloc == 0u) { xcd_barrier_complete(bar, b.x, nloc, nx); b.st[0] = nloc; b.st[1] = nx; }
        const unsigned old = xb_add(&bar[XB_XSUB(b.x)], 1u);
        const unsigned gen = old / nloc;
        if (old + 1u == (gen + 1u) * nloc) {
            __builtin_amdgcn_fence(__ATOMIC_RELEASE, "agent");
            asm volatile("s_waitcnt vmcnt(0)" ::: "memory");
            const unsigned og = xb_add(&bar[XB_TOP], 1u);
            const unsigned tg = og / nx;
            if (og + 1u == (tg + 1u) * nx) xb_add(&bar[XB_TOPGEN], 1u);
            else XB_SPIN(xb_ld(&bar[XB_TOPGEN]) == tg, bar);
            __builtin_amdgcn_fence(__ATOMIC_ACQUIRE, "agent");
            xb_add(&bar[XB_XGEN(b.x)], 1u);
            asm volatile("s_waitcnt vmcnt(0)" ::: "memory");
        } else {
            XB_SPIN(xb_ld(&bar[XB_XGEN(b.x)]) == gen, bar);
            __builtin_amdgcn_fence(__ATOMIC_ACQUIRE, "agent");
            asm volatile("s_waitcnt vmcnt(0)" ::: "memory");
        }
    }
    __syncthreads();
}

namespace gm {
constexpr int BM = 256, BK = 64, HALF = 128, HTB = HALF * BK * 2, STAGE_BYTES = 8 * HTB;
__host__ __device__ __forceinline__ int lds_byte(int r, int c) { const int st = (r >> 4) * 2 + (c >> 5), rr = r & 15, cc = c & 31, ob = rr * 64 + cc * 2; return st * 1024 + (ob ^ (((ob >> 9) & 1) << 5)); }
__host__ __device__ __forceinline__ void stage_rc(int b, int& R, int& C) { const int st = b / 1024, sb = b % 1024, swz = sb ^ (((sb >> 9) & 1) << 5); R = (st >> 1) * 16 + swz / 64; C = (st & 1) * 32 + (swz % 64) / 2; }
__host__ __device__ __forceinline__ int perm32(int rho) { const int n = rho >> 4, i = rho & 15; return 8 * (i >> 2) + 4 * n + (i & 3); }

struct Unit { int pm, pn, aux; const char* Bp; };
constexpr int UOFF = STAGE_BYTES + 256 + 10240, VBOFF = UOFF + 2 * 512 * 16;
__device__ __forceinline__ void put_offs(LAS unsigned char* lds, int ui, unsigned a00, unsigned a01, unsigned a10, unsigned a11) { *(LAS u32x4*)(lds + UOFF + ((ui & 1) * 512 + ltid()) * 16) = (u32x4){a00, a01, a10, a11}; }

template <class Epi, class Sched>
__device__ __forceinline__ void gphase(LAS unsigned char* lds, const char* Abase, const int K, Sched& S, Epi& E) {
    const int tid = ltid(), wid = __builtin_amdgcn_readfirstlane(tid >> 6), lane = tid & 63, wr = wid >> 2, wc = wid & 3, fr = lane & 15, fq = lane >> 4;
    const int nt = K / BK;
    { unsigned vb_[2];
#pragma unroll
      for (int i = 0; i < 2; ++i) { int R, C; stage_rc(tid * 16 + i * 8192, R, C); const int Rb = Epi::PERM == 2 ? (64 * (R >> 5) + 16 * ((R >> 2) & 3) + 4 * ((R >> 4) & 1) + (R & 3)) : Epi::PERM == 1 ? ((R & ~31) + perm32(R & 31)) : R; vb_[i] = (unsigned)(Rb * K + C) * 2u; }
      *(LAS u32x2*)(lds + VBOFF + tid * 8) = (u32x2){vb_[0], vb_[1]}; }
    const unsigned hstepB = (unsigned)(Epi::PERM == 2 ? 8 : HALF) * K * 2;
    const unsigned ldsw = (unsigned)wid * 1024u;
    constexpr bool F8 = Epi::F8; constexpr int KST = F8 ? 16 : 1024;
    const int aoff = lds_byte(wr * 64 + fr, fq * (F8 ? 16 : 8)), boff = lds_byte(wc * 32 + fr, fq * (F8 ? 16 : 8));
#define G_SA(b, h) (((b) * 2 + (h)) * HTB)
#define G_SB(b, h) ((4 + (b) * 2 + (h)) * HTB)
#define G_STAGE_A(bufoff, slot_, half_, kb) do { const char* ab_ = Abase + (kb); const u32x2 p_ = *(const LAS u32x2*)(lds + UOFF + (((slot_) & 1) * 512 + tid) * 16 + (half_) * 8); unsigned p0_ = p_.x, p1_ = p_.y; asm volatile("" : "+v"(p0_), "+v"(p1_)); \
        __builtin_amdgcn_global_load_lds((const unsigned*)(ab_ + p0_), (LAS unsigned*)(lds + (bufoff) + ldsw), 16, 0, 0); \
        __builtin_amdgcn_global_load_lds((const unsigned*)(ab_ + p1_), (LAS unsigned*)(lds + (bufoff) + ldsw + 8192), 16, 0, 0); } while (0)
#define G_STAGE_B(bufoff, bp, kb) do { const char* bb_ = (bp) + (kb); const u32x2 q_ = *(const LAS u32x2*)(lds + VBOFF + tid * 8); unsigned p0_ = q_.x, p1_ = q_.y; asm volatile("" : "+v"(p0_), "+v"(p1_)); \
        __builtin_amdgcn_global_load_lds((const unsigned*)(bb_ + p0_), (LAS unsigned*)(lds + (bufoff) + ldsw), 16, 0, 0); \
        __builtin_amdgcn_global_load_lds((const unsigned*)(bb_ + p1_), (LAS unsigned*)(lds + (bufoff) + ldsw + 8192), 16, 0, 0); } while (0)
#define G_LDA(dst, b, h) do { _Pragma("unroll") for (int m = 0; m < 4; ++m) _Pragma("unroll") for (int k = 0; k < 2; ++k) dst[m][k] = *(const LAS v4i*)(lds + G_SA(b, h) + aoff + m * 2048 + k * KST); } while (0)
#define G_LDB(dst, b, h) do { _Pragma("unroll") for (int n = 0; n < 2; ++n) _Pragma("unroll") for (int k = 0; k < 2; ++k) dst[n][k] = *(const LAS v4i*)(lds + G_SB(b, h) + boff + n * 2048 + k * KST); } while (0)
#define G_CAT(x_) __builtin_shufflevector(x_[0], x_[1], 0, 1, 2, 3, 4, 5, 6, 7)
#define G_MMA(ai, bj, At, Bt) do { __builtin_amdgcn_s_setprio(1); _Pragma("unroll") for (int m = 0; m < 4; ++m) _Pragma("unroll") for (int n = 0; n < 2; ++n) { \
        if constexpr (F8) acc[ai][bj][m][n] = __builtin_amdgcn_mfma_scale_f32_16x16x128_f8f6f4(G_CAT(Bt[n]), G_CAT(At[m]), acc[ai][bj][m][n], 0, 0, 0, Epi::SB, 0, Epi::SA); \
        else { _Pragma("unroll") for (int k = 0; k < 2; ++k) acc[ai][bj][m][n] = __builtin_amdgcn_mfma_f32_16x16x32_bf16(__builtin_bit_cast(bf16x8, Bt[n][k]), __builtin_bit_cast(bf16x8, At[m][k]), acc[ai][bj][m][n], 0, 0, 0); } } \
        __builtin_amdgcn_s_setprio(0); } while (0)
#define G_WAIT_V(n) asm volatile("s_waitcnt vmcnt(" #n ")" ::: "memory")
#define G_WAIT_L(n) asm volatile("s_waitcnt lgkmcnt(" #n ")" ::: "memory")
#define G_BAR __builtin_amdgcn_s_barrier()
#define G_SCHED __builtin_amdgcn_sched_barrier(0)
#define G_ZERO() do { _Pragma("unroll") for (int a = 0; a < 2; ++a) _Pragma("unroll") for (int b = 0; b < 2; ++b) _Pragma("unroll") for (int m = 0; m < 4; ++m) _Pragma("unroll") for (int n = 0; n < 2; ++n) acc[a][b][m][n] = (f32x4){0.f, 0.f, 0.f, 0.f}; } while (0)
    Unit cur, nxt; int ui = 0;
    if (!S.next(lds, 0, cur)) return;
    f32x4 acc[2][2][4][2];
    G_ZERO();
    v4i At[4][2], B0[2][2], B1[2][2];
    G_STAGE_B(G_SB(0, 0), cur.Bp, 0); G_STAGE_B(G_SB(0, 1), cur.Bp + hstepB, 0); G_STAGE_A(G_SA(0, 0), 0, 0, 0); G_STAGE_A(G_SA(0, 1), 0, 1, 0);
    if (wr == 1) G_BAR;
    G_WAIT_V(2); G_BAR;
    G_STAGE_B(G_SB(1, 0), cur.Bp, 128); G_STAGE_A(G_SA(1, 0), 0, 0, 128); G_STAGE_B(G_SB(1, 1), cur.Bp + hstepB, 128);
    G_WAIT_V(6); G_BAR;
    for (;;) {
        bool has_next = false;
#pragma unroll 1
        for (int t = 0; t < nt; t += 2) {
            const bool last = (t == nt - 2);
            const unsigned kb1 = (unsigned)(t + 1) * 128u, kb2 = last ? 0u : (unsigned)(t + 2) * 128u, kb3 = kb2 + 128u;
            const char* b2 = cur.Bp; int s2 = ui;
            if (last) {
                has_next = S.next(lds, ui + 1, nxt); if (!has_next) nxt = cur; else s2 = ui + 1;
                b2 = nxt.Bp; }
            G_LDB(B0, 0, 0); G_LDB(B1, 0, 1); G_SCHED; G_LDA(At, 0, 0); G_STAGE_A(G_SA(1, 1), ui, 1, kb1);
            G_WAIT_V(8); G_WAIT_L(0); G_BAR; G_MMA(0, 0, At, B0); G_MMA(0, 1, At, B1); G_BAR; G_SCHED;
            G_LDA(At, 0, 1); G_STAGE_B(G_SB(0, 0), b2, kb2); G_STAGE_B(G_SB(0, 1), b2 + hstepB, kb2); G_STAGE_A(G_SA(0, 0), s2, 0, kb2);
            G_WAIT_V(8); G_WAIT_L(0); G_BAR; G_MMA(1, 0, At, B0); G_MMA(1, 1, At, B1); G_BAR; G_SCHED;
            G_LDB(B0, 1, 0); G_LDB(B1, 1, 1); G_SCHED; G_LDA(At, 1, 0); G_STAGE_A(G_SA(0, 1), s2, 1, kb2);
            G_WAIT_V(8); G_WAIT_L(0); G_BAR; G_MMA(0, 0, At, B0); G_MMA(0, 1, At, B1); G_BAR; G_SCHED;
            G_LDA(At, 1, 1); G_STAGE_B(G_SB(1, 0), b2, kb3); G_STAGE_B(G_SB(1, 1), b2 + hstepB, kb3); G_STAGE_A(G_SA(1, 0), s2, 0, kb3);
            G_WAIT_V(8); G_WAIT_L(0); G_BAR; G_MMA(1, 0, At, B0); G_MMA(1, 1, At, B1); G_BAR; G_SCHED;
        }
        if (wr == 0) G_BAR;
        { const int tz = ltid(), wz = tz >> 6, lz = tz & 63; E(acc, cur, wz >> 2, wz & 3, lz & 15, lz >> 4); }
        if (!has_next) break;
        if (!E.keep(cur)) G_ZERO();
        cur = nxt; ++ui;
        if (wr == 1) G_BAR;
    }
    G_WAIT_V(0);
    G_BAR;
#undef G_SA
#undef G_SB
#undef G_STAGE_A
#undef G_STAGE_B
#undef G_LDA
#undef G_CAT
#undef G_LDB
#undef G_MMA
#undef G_WAIT_V
#undef G_WAIT_L
#undef G_BAR
#undef G_SCHED
#undef G_ZERO
}

struct DenseSched {
    int nM, nN, nwg, G, c, lda, K, parts; const char* Bt; const char* Bt2;
    __device__ void init(int M, int N, int K_, int lda_, const void* Bt_, const void* Bt2_, int parts_) {
        nM = M / BM; nN = N / BM; nwg = nM * nN; G = gridDim.x; c = blockIdx.x; lda = lda_; K = K_; Bt = (const char*)Bt_; Bt2 = (const char*)Bt2_; parts = parts_;
    }
    __device__ bool next(LAS unsigned char* lds, int i, Unit& u) const {
        const int ti = parts == 2 ? (i >> 1) : i, part = parts == 2 ? (i & 1) : 0;
        const long L = (long)ti * G + c; if (L >= nwg) return false;
        int wgid = (int)L; { const int q = nwg / 8, r = nwg % 8, xcd = wgid % 8, off = wgid / 8; wgid = (xcd < r ? xcd * (q + 1) : r * (q + 1) + (xcd - r) * q) + off; }
        const int nig = 8 * nN, gid = wgid / nig, fm = gid * 8, gsz = (nM - fm) < 8 ? (nM - fm) : 8;
        u.pm = fm + ((wgid % nig) % gsz); u.pn = (wgid % nig) / gsz; u.aux = part;
        u.Bp = (part ? Bt2 : Bt) + (size_t)u.pn * BM * K * 2;
        int R0, C0, R1, C1; { const int tz = ltid(); stage_rc(tz * 16, R0, C0); stage_rc(tz * 16 + 8192, R1, C1); }
        const unsigned rb = (unsigned)u.pm * BM, po = part ? (unsigned)K * 2u : 0u;
        put_offs(lds, i, ((rb + R0) * lda + C0) * 2u + po, ((rb + R1) * lda + C1) * 2u + po, ((rb + HALF + R0) * lda + C0) * 2u + po, ((rb + HALF + R1) * lda + C1) * 2u + po);
        return true;
    }
};
template <bool GATHER, int NN, int KK, int LDA, size_t WSTRIDE>
struct MoeSched {
    static constexpr int MAXU = 24, TBL = STAGE_BYTES, TOK = STAGE_BYTES + 256;
    int nu; const char* W;
    __device__ void init(LAS unsigned char* lds, const int* nent_p, const int* blk_row, const int* blk_exp, const int* tok_p, const void* W_) {
        W = (const char*)W_;
        const int tid = ltid(), G = gridDim.x, c = blockIdx.x, nent = *nent_p;
        const int x = c & 7, slot = c >> 3, nslot = G >> 3, e0 = (int)((long)x * nent / 8), e1 = (int)((long)(x + 1) * nent / 8), tot = (e1 - e0) * NN;
        nu = tot > slot ? (tot - slot + nslot - 1) / nslot : 0; if (nu > MAXU) nu = MAXU;
        LAS int* t_ = (LAS int*)(lds + TBL); LAS int* k_ = (LAS int*)(lds + TOK);
        if (tid < nu) { const int uidx = tid * nslot + slot, ent = e0 + uidx / NN; t_[tid * 2] = blk_row[ent]; t_[tid * 2 + 1] = blk_exp[ent] * 16 + uidx % NN; }
        __syncthreads();
        if (GATHER) { for (int j = tid; j < nu * 256; j += 512) k_[j] = tok_p[t_[(j >> 8) * 2] + (j & 255)]; __syncthreads(); }
    }
    __device__ bool next(LAS unsigned char* lds, int i, Unit& u) const {
        if (i >= nu) return false;
        LAS const int* tbl = (LAS const int*)(lds + TBL); LAS const int* tokt = (LAS const int*)(lds + TOK);
        int R0, C0, R1, C1; { const int tz = ltid(); stage_rc(tz * 16, R0, C0); stage_rc(tz * 16 + 8192, R1, C1); }
        const int rb = __builtin_amdgcn_readfirstlane(tbl[i * 2]), ep = __builtin_amdgcn_readfirstlane(tbl[i * 2 + 1]), e = ep >> 4; u.pn = ep & 15; u.pm = rb; u.aux = e;
        u.Bp = W + (size_t)e * WSTRIDE + (size_t)u.pn * BM * KK * 2;
        if (GATHER) {
            const unsigned t00 = tokt[i * 256 + R0], t01 = tokt[i * 256 + R1], t10 = tokt[i * 256 + HALF + R0], t11 = tokt[i * 256 + HALF + R1];
            put_offs(lds, i, (t00 * LDA + C0) * 2u, (t01 * LDA + C1) * 2u, (t10 * LDA + C0) * 2u, (t11 * LDA + C1) * 2u);
        } else {
            put_offs(lds, i, ((unsigned)(rb + R0) * LDA + C0) * 2u, ((unsigned)(rb + R1) * LDA + C1) * 2u, ((unsigned)(rb + HALF + R0) * LDA + C0) * 2u, ((unsigned)(rb + HALF + R1) * LDA + C1) * 2u);
        }
        return true;
    }
};

struct EpiProj {
    static constexpr int PERM = 1; static constexpr bool F8 = false; static constexpr int SA = 0, SB = 0; bf16_t* O;
    __device__ __forceinline__ bool keep(const Unit&) const { return false; }
    __device__ __forceinline__ void operator()(f32x4 (&acc)[2][2][4][2], const Unit& u, int wr, int wc, int fr, int fq) const {
        const int row0 = u.pm * BM + wr * 64 + fr, col0 = u.pn * BM + wc * 32 + 8 * fq;
#pragma unroll
        for (int ai = 0; ai < 2; ++ai)
#pragma unroll
            for (int m = 0; m < 4; ++m) { bf16_t* rowp = O + (size_t)(row0 + ai * HALF + m * 16) * PW + col0;
#pragma unroll
                for (int bj = 0; bj < 2; ++bj) { const f32x4 v0 = acc[ai][bj][m][0], v1 = acc[ai][bj][m][1]; u32x4 w;
                    w.x = cvt_pk_bf16(v0[0], v0[1]); w.y = cvt_pk_bf16(v0[2], v0[3]); w.z = cvt_pk_bf16(v1[0], v1[1]); w.w = cvt_pk_bf16(v1[2], v1[3]);
                    *(u32x4*)(rowp + bj * HALF) = w; } }
    }
};
struct EpiMerge {
    static constexpr int PERM = 1; static constexpr bool F8 = false; static constexpr int SA = 0, SB = 0; const bf16_t* proj; bf16_t* O;
    __device__ __forceinline__ bool keep(const Unit& u) const { return u.aux == 0; }
    __device__ __forceinline__ void operator()(f32x4 (&acc)[2][2][4][2], const Unit& u, int wr, int wc, int fr, int fq) const {
        const int row0 = u.pm * BM + wr * 64 + fr, col0 = u.pn * BM + wc * 32 + 8 * fq;
#pragma unroll
        for (int ai = 0; ai < 2; ++ai)
#pragma unroll
            for (int m = 0; m < 4; ++m) { const size_t r = (size_t)(row0 + ai * HALF + m * 16);
#pragma unroll
                for (int bj = 0; bj < 2; ++bj) {
                    const u32x4 gb = *(const u32x4*)(proj + r * PW + C_MGB + col0 + bj * HALF);
                    const f32x4 eb0 = {__expf(-bflo(gb.x)), __expf(-bfhi(gb.x)), __expf(-bflo(gb.y)), __expf(-bfhi(gb.y))};
                    const f32x4 eb1 = {__expf(-bflo(gb.z)), __expf(-bfhi(gb.z)), __expf(-bflo(gb.w)), __expf(-bfhi(gb.w))};
                    if (u.aux == 0) {
                        const u32x4 ga = *(const u32x4*)(proj + r * PW + C_MGA + col0 + bj * HALF);
                        const f32x4 ea0 = {__expf(-bflo(ga.x)), __expf(-bfhi(ga.x)), __expf(-bflo(ga.y)), __expf(-bfhi(ga.y))};
                        const f32x4 ea1 = {__expf(-bflo(ga.z)), __expf(-bfhi(ga.z)), __expf(-bflo(ga.w)), __expf(-bfhi(ga.w))};
#pragma unroll
                        for (int j = 0; j < 4; ++j) { acc[ai][bj][m][0][j] *= (1.f + eb0[j]) * rcpf_(1.f + ea0[j]); acc[ai][bj][m][1][j] *= (1.f + eb1[j]) * rcpf_(1.f + ea1[j]); }
                    } else {
                        f32x4 v0 = acc[ai][bj][m][0], v1 = acc[ai][bj][m][1];
#pragma unroll
                        for (int j = 0; j < 4; ++j) { v0[j] *= rcpf_(1.f + eb0[j]); v1[j] *= rcpf_(1.f + eb1[j]); }
                        u32x4 w; w.x = cvt_pk_bf16(v0[0], v0[1]); w.y = cvt_pk_bf16(v0[2], v0[3]); w.z = cvt_pk_bf16(v1[0], v1[1]); w.w = cvt_pk_bf16(v1[2], v1[3]);
                        *(u32x4*)(O + r * D + col0 + bj * HALF) = w;
                    } } }
    }
};
struct EpiResid {
    static constexpr int PERM = 0; static constexpr bool F8 = false; static constexpr int SA = 0, SB = 0; const float* x; const float* gt; float* O;
    __device__ __forceinline__ bool keep(const Unit&) const { return false; }
    __device__ __forceinline__ void operator()(f32x4 (&acc)[2][2][4][2], const Unit& u, int wr, int wc, int fr, int fq) const {
        const int row0 = u.pm * BM + wr * 64 + fr, col0 = u.pn * BM + wc * 32 + 4 * fq;
        f32x4 g[2][2];
#pragma unroll
        for (int bj = 0; bj < 2; ++bj)
#pragma unroll
            for (int n = 0; n < 2; ++n) g[bj][n] = *(const f32x4*)(gt + col0 + bj * HALF + n * 16);
#pragma unroll
        for (int ai = 0; ai < 2; ++ai)
#pragma unroll
            for (int m = 0; m < 4; ++m) { const size_t ro = (size_t)(row0 + ai * HALF + m * 16) * D + col0;
#pragma unroll
                for (int bj = 0; bj < 2; ++bj)
#pragma unroll
                    for (int n = 0; n < 2; ++n) { const f32x4 xv = *(const f32x4*)(x + ro + bj * HALF + n * 16); *(f32x4*)(O + ro + bj * HALF + n * 16) = xv + g[bj][n] * acc[ai][bj][m][n]; } }
    }
};
struct EpiSwiglu {
    static constexpr int PERM = 2; static constexpr bool F8 = true; static constexpr int SA = 0x7d7d7d7d, SB = 0x79797979; unsigned char* hid;
    __device__ __forceinline__ bool keep(const Unit&) const { return false; }
    __device__ __forceinline__ void operator()(f32x4 (&acc)[2][2][4][2], const Unit& u, int wr, int wc, int fr, int fq) const {
        const int row0 = u.pm + wr * 64 + fr, j0 = u.pn * 128 + wc * 32 + 8 * fq;
#pragma unroll
        for (int ai = 0; ai < 2; ++ai)
#pragma unroll
            for (int m = 0; m < 4; ++m) { unsigned char* rowp = hid + (unsigned)((row0 + ai * HALF + m * 16) * FF + j0);
                unsigned w2[2];
#pragma unroll
                for (int bj = 0; bj < 2; ++bj) { const f32x4 g = acc[ai][bj][m][0], up = acc[ai][bj][m][1];
                    w2[bj] = cvt4_fp8(8.f * siluf_(g[0]) * up[0], 8.f * siluf_(g[1]) * up[1], 8.f * siluf_(g[2]) * up[2], 8.f * siluf_(g[3]) * up[3]); }
                *(u32x2*)rowp = (u32x2){w2[0], w2[1]};
                asm volatile("" ::: "memory"); __builtin_amdgcn_sched_barrier(0); }
    }
};
struct EpiDown {
    static constexpr int PERM = 2; static constexpr bool F8 = true; static constexpr int SA = 0x7c7c7c7c, SB = 0x7a7a7a7a; unsigned char* Y; const float* w_p;
    __device__ __forceinline__ bool keep(const Unit&) const { return false; }
    __device__ __forceinline__ void operator()(f32x4 (&acc)[2][2][4][2], const Unit& u, int wr, int wc, int fr, int fq) const {
        const int row0 = u.pm + wr * 64 + fr, col0 = u.pn * BM + wc * 64 + 16 * fq;
#pragma unroll
        for (int ai = 0; ai < 2; ++ai)
#pragma unroll
            for (int m = 0; m < 4; ++m) { const int r = row0 + ai * HALF + m * 16; const float wt = w_p[(unsigned)r] * 16.f; unsigned char* rowp = Y + ((unsigned)r * D + col0);
                unsigned w4[4];
#pragma unroll
                for (int bj = 0; bj < 2; ++bj) { const f32x4 v0 = acc[ai][bj][m][0] * wt, v1 = acc[ai][bj][m][1] * wt;
                    w4[bj * 2] = cvt4_fp8(v0[0], v0[1], v0[2], v0[3]); w4[bj * 2 + 1] = cvt4_fp8(v1[0], v1[1], v1[2], v1[3]); }
                *(u32x4*)rowp = (u32x4){w4[0], w4[1], w4[2], w4[3]};
                asm volatile("" ::: "memory"); __builtin_amdgcn_sched_barrier(0); }
    }
};
}

struct Ctx {
    const float *x, *c, *w_ada, *b_ada, *norm1_g, *norm2_g, *w_in, *lb_table, *hgrn_onorm_g, *conv_w, *a_log, *dt_bias, *gdn_onorm_g, *w_bh, *w_bg, *w_out, *w_router, *router_bias,
        *w_eg, *w_eu, *w_ed, *w_sg, *w_su, *w_sd, *normf_g;
    float* out;
    unsigned* bar;
    float *modp, *mod, *lb, *gab;
    int *idx, *cnt, *tok_p, *pos, *blk_row, *blk_exp, *nent;
    float *wts, *w_p;
    bf16_t *win_t, *wa_t, *wb_t, *wout_t, *h1, *proj, *ocat, *merged;
    float *gq, *gk, *gv, *gbeta, *gdec, *oa, *ob;
    float *hL, *hS, *hD;
    float *gAT, *gB, *gS; unsigned char *gBlob, *gM;
    unsigned char *dn_t, *hid, *gu_t, *h2, *Y;
    bf16_t* rwimg; float* rbias2; int *tile_cnt, *rnk;
};

typedef const __attribute__((address_space(4))) Ctx CtxK;

__device__ __forceinline__ void cvt_tile(LAS float* t, const float* srcA, const float* srcB, int ld, int mode, bf16_t* dst, int ldd) {
    const int tid = ltid(), kr = tid >> 6, cl = tid & 63;
    const float* sp = (mode == 1 && cl >= 32) ? (srcB + cl - 32) : (srcA + cl);
    float v[8];
#pragma unroll
    for (int p = 0; p < 8; ++p) v[p] = sp[(size_t)(p * 8 + kr) * ld];
    __syncthreads();
#pragma unroll
    for (int p = 0; p < 8; ++p) t[(p * 8 + kr) * 65 + cl] = v[p];
    __syncthreads();
    const int r = tid >> 3, seg = (tid & 7) * 8;
    const int lc = mode == 1 ? (((r >> 2) & 1) * 32 + 4 * (r >> 3) + (r & 3)) : r;
    float w[8];
#pragma unroll
    for (int j = 0; j < 8; ++j) w[j] = t[(seg + j) * 65 + lc];
    u32x4 o; o.x = cvt_pk_bf16(w[0], w[1]); o.y = cvt_pk_bf16(w[2], w[3]); o.z = cvt_pk_bf16(w[4], w[5]); o.w = cvt_pk_bf16(w[6], w[7]);
    *(u32x4*)(dst + (size_t)r * ldd + seg) = o;
}
__device__ __forceinline__ void cvt_tile8(LAS float* t, const float* srcA, const float* srcB, int ld, int mode, unsigned char* dst, int ldd, float scale) {
    const int tid = ltid(), kr = tid >> 6, cl = tid & 63;
    const float* sp = (mode == 1 && cl >= 32) ? (srcB + cl - 32) : (srcA + cl);
    float v[8];
#pragma unroll
    for (int p = 0; p < 8; ++p) v[p] = sp[(size_t)(p * 8 + kr) * ld];
    __syncthreads();
#pragma unroll
    for (int p = 0; p < 8; ++p) t[(p * 8 + kr) * 65 + cl] = v[p] * scale;
    __syncthreads();
    const int r = tid >> 3, seg = (tid & 7) * 8;
    const int lc = mode == 1 ? (((r >> 2) & 1) * 32 + 4 * (r >> 3) + (r & 3)) : r;
    float w[8];
#pragma unroll
    for (int j = 0; j < 8; ++j) w[j] = t[(seg + j) * 65 + lc];
    *(u32x2*)(dst + (size_t)r * ldd + seg) = (u32x2){cvt4_fp8(w[0], w[1], w[2], w[3]), cvt4_fp8(w[4], w[5], w[6], w[7])};
}
__device__ __forceinline__ void cvt_job(LAS float* t, int tile, const float* src, int ld, int K, bf16_t* dst) {
    const int nkt = K / 64, nt = tile / nkt, kt = tile % nkt;
    cvt_tile(t, src + (size_t)kt * 64 * ld + nt * 64, nullptr, ld, 0, dst + (size_t)nt * 64 * K + kt * 64, K);
}

__device__ void ph_pro1(CtxK& c, LAS unsigned char* lds) {
    const int tid = ltid(), wg = blockIdx.x, G = gridDim.x;
    LAS float* lf = (LAS float*)lds;
    for (int job = wg; job < 192; job += G) {
        const int cc = job % 48, kp = job / 48, q = tid & 63, rg = tid >> 6;
        f32x4 a = {0.f, 0.f, 0.f, 0.f};
        for (int r0 = rg; r0 < 512; r0 += 64) { f32x4 w[8]; float s[8];
#pragma unroll
            for (int u = 0; u < 8; ++u) { const int k = kp * 512 + r0 + u * 8; w[u] = *(const f32x4*)(c.w_ada + (size_t)k * (6 * D) + cc * 256 + q * 4); s[u] = c.c[k]; }
#pragma unroll
            for (int u = 0; u < 8; ++u) a += siluf_(s[u]) * w[u]; }
        __syncthreads();
        *(LAS f32x4*)(lf + (rg * 64 + q) * 4) = a;
        __syncthreads();
        if (tid < 64) { f32x4 s = {0.f, 0.f, 0.f, 0.f};
#pragma unroll
            for (int g = 0; g < 8; ++g) s += *(LAS f32x4*)(lf + (g * 64 + tid) * 4);
            *(f32x4*)(c.modp + (size_t)kp * (6 * D) + cc * 256 + tid * 4) = s; }
    }
    if (wg == G - 1) for (int j = tid; j < 1024; j += 512) c.lb[j] = 1.f / (1.f + expf(c.lb_table[1024 + j] - c.lb_table[j]));
    {
        const int kr = tid >> 6, cl = tid & 63, r = tid >> 3, seg = (tid & 7) * 8;
        float v[4][8];
        const int t0 = wg < 192 ? wg : 5376 + (wg - 192), tstep = wg < 192 ? 192 : 64, ntl = wg < 192 ? 28 : 44;
#define P1_DESC(T_) const float* sp_; bf16_t* dp_; int ld_, ldd_; { const int T = (T_); \
            if (T < 6144) { const int nt = T / 32, kt = T % 32, sc = nt * 64 + (nt * 64 >= WIN_GAB ? 16 : 0); sp_ = c.w_in + (size_t)kt * 64 * INW + sc; ld_ = INW; dp_ = c.win_t + (size_t)nt * 64 * D + kt * 64; ldd_ = D; } \
            else { const float* s0_; bf16_t* d0_; int K_, t_; if (T < 6656) { t_ = T - 6144; s0_ = c.w_bh; d0_ = c.wa_t; K_ = 1024; } else if (T < 7168) { t_ = T - 6656; s0_ = c.w_bg; d0_ = c.wb_t; K_ = 1024; } else { t_ = T - 7168; s0_ = c.w_out; d0_ = c.wout_t; K_ = 2048; } \
                const int nkt = K_ / 64, nt = t_ / nkt, kt = t_ % nkt; sp_ = s0_ + (size_t)kt * 64 * D + nt * 64; ld_ = D; dp_ = d0_ + (size_t)nt * 64 * K_ + kt * 64; ldd_ = K_; } }
#define P1_LOAD(i0_) do { _Pragma("unroll") for (int j = 0; j < 4; ++j) { P1_DESC(t0 + ((i0_) + j) * tstep) (void)dp_; (void)ldd_; const float* s_ = sp_ + cl; \
            _Pragma("unroll") for (int p = 0; p < 8; ++p) v[j][p] = s_[(size_t)(p * 8 + kr) * ld_]; } } while (0)
        P1_LOAD(0);
        for (int i0 = 0; i0 < ntl; i0 += 4) {
            __syncthreads();
#pragma unroll
            for (int j = 0; j < 4; ++j)
#pragma unroll
                for (int p = 0; p < 8; ++p) lf[j * 4160 + (p * 8 + kr) * 65 + cl] = v[j][p];
            __syncthreads();
            if (i0 + 4 < ntl) P1_LOAD(i0 + 4);
#pragma unroll
            for (int j = 0; j < 4; ++j) { P1_DESC(t0 + (i0 + j) * tstep) (void)sp_; (void)ld_;
                float w[8];
#pragma unroll
                for (int jj = 0; jj < 8; ++jj) w[jj] = lf[j * 4160 + (seg + jj) * 65 + r];
                u32x4 o; o.x = cvt_pk_bf16(w[0], w[1]); o.y = cvt_pk_bf16(w[2], w[3]); o.z = cvt_pk_bf16(w[4], w[5]); o.w = cvt_pk_bf16(w[6], w[7]);
                *(u32x4*)(dp_ + (size_t)r * ldd_ + seg) = o; }
        }
#undef P1_LOAD
#undef P1_DESC
    }
}
__device__ void ph_norm1(CtxK& c, LAS unsigned char* lds) {
    const int tid = ltid(), wg = blockIdx.x, G = gridDim.x, lane = tid & 63, wv = tid >> 6;
    LAS float* la = (LAS float*)lds;
    LAS float* lb_ = la + D;
    LAS float* lw = lb_ + D;
    for (int j = tid; j < D; j += 512) {
        float sh = c.b_ada[j], sc = c.b_ada[D + j];
#pragma unroll
        for (int p = 0; p < 4; ++p) { sh += c.modp[(size_t)p * 6 * D + j]; sc += c.modp[(size_t)p * 6 * D + D + j]; }
        la[j] = c.norm1_g[j] * (1.f + sc); lb_[j] = sh;
    }
    for (int j = wg * 512 + tid; j < 6 * D; j += G * 512) { float m = c.b_ada[j];
#pragma unroll
        for (int p = 0; p < 4; ++p) m += c.modp[(size_t)p * 6 * D + j];
        c.mod[j] = m; }
    for (int i = tid; i < D * 4; i += 512) { const int e = i >> 2, q = i & 3; const f32x4 w = *(const f32x4*)(c.w_in + (size_t)e * INW + WIN_GAB + q * 4);
        lw[(q * 4 + 0) * D + e] = w[0]; lw[(q * 4 + 1) * D + e] = w[1]; lw[(q * 4 + 2) * D + e] = w[2]; lw[(q * 4 + 3) * D + e] = w[3]; }
    __syncthreads();
    f32x4 vn[8];
    { const float* xr = c.x + (size_t)(wg * 8 + wv) * D;
#pragma unroll
      for (int i = 0; i < 8; ++i) vn[i] = *(const f32x4*)(xr + i * 256 + lane * 4); }
    for (int row = wg * 8 + wv; row < S; row += G * 8) {
        f32x4 v[8]; float ss = 0.f;
#pragma unroll
        for (int i = 0; i < 8; ++i) { v[i] = vn[i]; ss += v[i][0] * v[i][0] + v[i][1] * v[i][1] + v[i][2] * v[i][2] + v[i][3] * v[i][3]; }
        if (row + G * 8 < S) { const float* xr = c.x + (size_t)(row + G * 8) * D;
#pragma unroll
            for (int i = 0; i < 8; ++i) vn[i] = *(const f32x4*)(xr + i * 256 + lane * 4); }
        ss = wave_sum(ss); const float r = rsqrtf(ss * (1.f / D) + 1e-6f);
#pragma unroll
        for (int i = 0; i < 8; ++i) { const int e = i * 256 + lane * 4; const f32x4 a = *(LAS f32x4*)(la + e), b = *(LAS f32x4*)(lb_ + e); v[i] = v[i] * r * a + b;
            u32x2 w; w.x = cvt_pk_bf16(v[i][0], v[i][1]); w.y = cvt_pk_bf16(v[i][2], v[i][3]); *(u32x2*)(c.h1 + (size_t)row * D + e) = w; }
        float mine = 0.f;
        for (int cc = 0; cc < 16; ++cc) { float d = 0.f;
#pragma unroll
            for (int i = 0; i < 8; ++i) { const f32x4 w = *(LAS f32x4*)(lw + cc * D + i * 256 + lane * 4); d += v[i][0] * w[0] + v[i][1] * w[1] + v[i][2] * w[2] + v[i][3] * w[3]; }
            d = wave_sum(d); if (lane == cc) mine = d; }
        if (lane < 16) c.gab[(size_t)row * 16 + lane] = mine;
    }
    { const int id = wg * 512 + tid, i = id >> 6, e = id & 63;
      if (id < D * 64) {
          float sc = c.b_ada[4 * D + i];
#pragma unroll
          for (int p = 0; p < 4; ++p) sc += c.modp[(size_t)p * 6 * D + 4 * D + i];
          const float w = c.norm2_g[i] * (1.f + sc) * c.w_router[id];
          const unsigned hi = cvt_pk_bf16(w, w) & 0xffffu; const float lo = w - __uint_as_float(hi << 16);
          const int ch = i >> 7, kk = i & 127;
          c.rwimg[((ch * 2 + 0) * 64 + e) * 136 + kk] = (bf16_t)hi; c.rwimg[((ch * 2 + 1) * 64 + e) * 136 + kk] = (bf16_t)(cvt_pk_bf16(lo, lo) & 0xffffu);
      } }
    if (wg < 64) {
        __syncthreads();
        float a = 0.f;
        for (int i = tid; i < D; i += 512) { float sh = c.b_ada[3 * D + i];
#pragma unroll
            for (int p = 0; p < 4; ++p) sh += c.modp[(size_t)p * 6 * D + 3 * D + i];
            a += sh * c.w_router[i * 64 + wg]; }
        a = wave_sum(a); if (lane == 0) la[wv] = a; __syncthreads();
        if (tid == 0) c.rbias2[wg] = la[0] + la[1] + la[2] + la[3] + la[4] + la[5] + la[6] + la[7];
    }
}
__device__ void ph_gemm1(CtxK& c, LAS unsigned char* lds) {
    gm::DenseSched Sd; Sd.init(S, PW, D, D, c.win_t, nullptr, 1); gm::EpiProj E{c.proj};
    gm::gphase(lds, (const char*)c.h1, D, Sd, E);
}
__device__ void ph_gemm2(CtxK& c, LAS unsigned char* lds) {
    gm::DenseSched Sd; Sd.init(S, D, 1024, 2048, c.wa_t, c.wb_t, 2); gm::EpiMerge E{c.proj, c.merged};
    gm::gphase(lds, (const char*)c.ocat, 1024, Sd, E);
}
__device__ void ph_gemm3(CtxK& c, LAS unsigned char* lds) {
    gm::DenseSched Sd; Sd.init(S, D, D, D, c.wout_t, nullptr, 1); gm::EpiResid E{c.x, c.mod + 2 * D, c.out};
    gm::gphase(lds, (const char*)c.merged, D, Sd, E);
}
__device__ void ph_moe_gu(CtxK& c, LAS unsigned char* lds) {
    gm::MoeSched<true, 4, D / 2, D / 2, (size_t)1024 * D> Sm; Sm.init(lds, c.nent, c.blk_row, c.blk_exp, c.tok_p, c.gu_t); gm::EpiSwiglu E{c.hid};
    gm::gphase(lds, (const char*)c.h2, D / 2, Sm, E);
}
__device__ void ph_moe_dn(CtxK& c, LAS unsigned char* lds) {
    gm::MoeSched<false, 8, FF / 2, FF / 2, (size_t)D * FF> Sm; Sm.init(lds, c.nent, c.blk_row, c.blk_exp, c.tok_p, c.dn_t); gm::EpiDown E{c.Y, c.w_p};
    gm::gphase(lds, (const char*)c.hid, FF / 2, Sm, E);
}
__device__ void ph_cvt_exp(CtxK& c, LAS unsigned char* lds) {
    LAS float* lf = (LAS float*)lds; const int wg = blockIdx.x - 8, G = gridDim.x - 8;
    if (wg < 0) return;
    constexpr int GU_T = 16 * 32, DN_T = 32 * 8;
    for (int T = wg; T < NEX * (GU_T + DN_T); T += G) {
        if (T < NEX * GU_T) { const int e = T / GU_T, r = T % GU_T, nt = r / 32, kt = r % 32;
            const float* sg = e < NE ? c.w_eg + (size_t)e * D * FF : c.w_sg; const float* su = e < NE ? c.w_eu + (size_t)e * D * FF : c.w_su;
            cvt_tile8(lf, sg + (size_t)kt * 64 * FF + nt * 32, su + (size_t)kt * 64 * FF + nt * 32, FF, 1, c.gu_t + ((size_t)e * 1024 + nt * 64) * D + kt * 64, D, 64.f); }
        else { const int T2 = T - NEX * GU_T, e = T2 / DN_T, r = T2 % DN_T; const float* sd = e < NE ? c.w_ed + (size_t)e * FF * D : c.w_sd;
            { const int nkt = FF / 64, nt = r / nkt, kt = r % nkt; cvt_tile8(lf, sd + (size_t)kt * 64 * D + nt * 64, nullptr, D, 0, c.dn_t + (size_t)e * D * FF + (size_t)nt * 64 * FF + kt * 64, FF, 32.f); } }
    }
}
__device__ void ph_final(CtxK& c, LAS unsigned char* lds) {
    const int tid = ltid(), wg = blockIdx.x, G = gridDim.x, lane = tid & 63, wv = tid >> 6;
    const float* gt2 = c.mod + 5 * D;
    for (int row0 = (wg * 8 + wv) * 2; row0 < S; row0 += G * 16) {
        int p[2][9];
#pragma unroll
        for (int rr = 0; rr < 2; ++rr) {
#pragma unroll
            for (int k = 0; k < 8; ++k) p[rr][k] = c.pos[(row0 + rr) * TOPK + k];
            p[rr][8] = PROUTED + row0 + rr; }
        f32x4 v[2][4][2]; float ss[2] = {0.f, 0.f};
#pragma unroll
        for (int rr = 0; rr < 2; ++rr) {
#pragma unroll
            for (int i = 0; i < 4; ++i) {
                const int e = i * 512 + lane * 8; f32x4 a0 = {0.f, 0.f, 0.f, 0.f}, a1 = {0.f, 0.f, 0.f, 0.f};
#pragma unroll
                for (int k = 0; k < 9; ++k) { const u32x2 y = *(const u32x2*)(c.Y + (size_t)p[rr][k] * D + e);
                    const auto q0 = __builtin_amdgcn_cvt_pk_f32_fp8((int)y.x, false), q1 = __builtin_amdgcn_cvt_pk_f32_fp8((int)y.x, true), q2 = __builtin_amdgcn_cvt_pk_f32_fp8((int)y.y, false), q3 = __builtin_amdgcn_cvt_pk_f32_fp8((int)y.y, true);
                    a0[0] += q0[0]; a0[1] += q0[1]; a0[2] += q1[0]; a0[3] += q1[1]; a1[0] += q2[0]; a1[1] += q2[1]; a1[2] += q3[0]; a1[3] += q3[1]; }
                const float* xp = c.out + (size_t)(row0 + rr) * D + e;
                const f32x4 x0 = *(const f32x4*)xp, x1 = *(const f32x4*)(xp + 4), g0 = *(const f32x4*)(gt2 + e) * 0.0625f, g1 = *(const f32x4*)(gt2 + e + 4) * 0.0625f;
                v[rr][i][0] = x0 + g0 * a0; v[rr][i][1] = x1 + g1 * a1;
#pragma unroll
                for (int j = 0; j < 4; ++j) ss[rr] += v[rr][i][0][j] * v[rr][i][0][j] + v[rr][i][1][j] * v[rr][i][1][j];
            } }
#pragma unroll
        for (int rr = 0; rr < 2; ++rr) {
            const float r = rsqrtf(wave_sum_dpp(ss[rr]) * (1.f / D) + 1e-6f);
#pragma unroll
            for (int i = 0; i < 4; ++i) { const int e = i * 512 + lane * 8; float* op = c.out + (size_t)(row0 + rr) * D + e;
                *(f32x4*)op = v[rr][i][0] * r * *(const f32x4*)(c.normf_g + e); *(f32x4*)(op + 4) = v[rr][i][1] * r * *(const f32x4*)(c.normf_g + e + 4); } }
    }
}

namespace mx {
constexpr int ST128 = 272, ST64 = 144;
constexpr int FRAG_F4 = 8 * 8 * 64;
__device__ __forceinline__ f32x4 mfma16(bf16x8 a, bf16x8 b, f32x4 c) { return __builtin_amdgcn_mfma_f32_16x16x32_bf16(a, b, c, 0, 0, 0); }
template <int MT, int KS>
__device__ __forceinline__ void mma_nt(f32x4 (&acc)[MT], LAS const unsigned char* xs, int sx, LAS const unsigned char* ys, int sy, int fr, int fq) {
#pragma unroll
    for (int kk = 0; kk < KS; ++kk) {
        const bf16x8 b = *(const LAS bf16x8*)(ys + fr * sy + (kk * 32 + fq * 8) * 2);
#pragma unroll
        for (int m = 0; m < MT; ++m) { const bf16x8 a = *(const LAS bf16x8*)(xs + (16 * m + fr) * sx + (kk * 32 + fq * 8) * 2); acc[m] = mfma16(a, b, acc[m]); }
    }
}
__device__ __forceinline__ void lds_fence() { asm volatile("s_waitcnt lgkmcnt(0)" ::: "memory"); }
__device__ __forceinline__ u32x4 pack8(const float (&v)[8]) { u32x4 o; o.x = cvt_pk_bf16(v[0], v[1]); o.y = cvt_pk_bf16(v[2], v[3]); o.z = cvt_pk_bf16(v[4], v[5]); o.w = cvt_pk_bf16(v[6], v[7]); return o; }
__device__ __forceinline__ void unpack8(const u32x4 w, float (&v)[8]) { v[0] = bflo(w.x); v[1] = bfhi(w.x); v[2] = bflo(w.y); v[3] = bfhi(w.y); v[4] = bflo(w.z); v[5] = bfhi(w.z); v[6] = bflo(w.w); v[7] = bfhi(w.w); }
__device__ __forceinline__ void mfma_pad8(f32x4 (&a)[8]) { asm volatile("s_nop 15\n\ts_nop 7" : "+v"(a[0]), "+v"(a[1]), "+v"(a[2]), "+v"(a[3]), "+v"(a[4]), "+v"(a[5]), "+v"(a[6]), "+v"(a[7])); }
__device__ __forceinline__ void mfma_pad4(f32x4 (&a)[4]) { asm volatile("s_nop 15\n\ts_nop 7" : "+v"(a[0]), "+v"(a[1]), "+v"(a[2]), "+v"(a[3])); }
__device__ __forceinline__ void write_st(LAS unsigned char* stw, f32x4 (&S)[8], int fr, int fq) {
    mfma_pad8(S);
#pragma unroll
    for (int m = 0; m < 8; ++m) { u32x2 w; w.x = cvt_pk_bf16(S[m][0], S[m][1]); w.y = cvt_pk_bf16(S[m][2], S[m][3]); *(LAS u32x2*)(stw + fr * ST128 + (16 * m + 4 * fq) * 2) = w; }
}

__device__ __forceinline__ void gate_issue(u32x4 (&gp)[2], const bf16_t* gate0) {
    const int t_ = ltid(); const bf16_t* p = gate0 + (size_t)(t_ >> 3) * PW + (t_ & 7) * 16;
    gp[0] = *(const u32x4*)p; gp[1] = *(const u32x4*)(p + 8);
}
__device__ __forceinline__ void out_stage(LAS unsigned char* ot, LAS float* part, const f32x4 (&o)[4], const u32x4 (&gp)[2], const float* gnorm, bf16_t* out0, int wv, int lane, int fr, int fq) {
    float s_ = 0.f;
#pragma unroll
    for (int w = 0; w < 8; ++w) s_ += part[w * 64 + lane];
    const float rv = rsqrtf(s_ * (1.f / 128.f) + 1e-6f);
    const float gn = gnorm[wv * 16 + fr];
#pragma unroll
    for (int m = 0; m < 4; ++m)
#pragma unroll
        for (int r = 0; r < 4; ++r) { const int cc = 16 * m + 4 * fq + r; const float x = o[m][r] * __shfl(rv, cc) * gn;
            *(LAS bf16_t*)(ot + cc * ST128 + (wv * 16 + fr) * 2) = (bf16_t)(cvt_pk_bf16(x, x) & 0xffffu); }
    __syncthreads();
    const int t_ = ltid(), cc = t_ >> 3, sg = (t_ & 7) * 16;
#pragma unroll
    for (int hh = 0; hh < 2; ++hh) { float ov[8], gv[8];
        unpack8(*(LAS u32x4*)(ot + cc * ST128 + (sg + hh * 8) * 2), ov); unpack8(gp[hh], gv);
#pragma unroll
        for (int j = 0; j < 8; ++j) ov[j] *= siluf_(gv[j]);
        *(u32x4*)(out0 + (size_t)cc * D + sg + hh * 8) = pack8(ov); }
}

constexpr int H_QT = 0, H_KT = 17408, H_QI = 34816, H_KU = 52224, H_VT = 70656, H_P = 89088, H_DEC = 98304, H_OCT = 98816, H_F4 = H_OCT + 8192, H_PART = H_F4 + 512, H_RINV = H_PART + 2048, H_ST = H_RINV + 256, H_LB = H_ST + 8 * 16 * ST128, H_END = H_LB + 512;
static_assert(H_END <= 147456, "hgrn lds");
template <bool OUT>
__device__ void hgrn_pass(CtxK& c, LAS unsigned char* lds) {
    const int tid = ltid(), wv = __builtin_amdgcn_readfirstlane(tid >> 6), lane = tid & 63, fr = lane & 15, fq = lane >> 4;
    LAS float* dec = (LAS float*)(lds + H_DEC); LAS float* oct = (LAS float*)(lds + H_OCT); LAS float* f4 = (LAS float*)(lds + H_F4);
    LAS float* part = (LAS float*)(lds + H_PART); LAS float* rinv = (LAS float*)(lds + H_RINV);
    LAS unsigned char* stw = lds + H_ST + wv * 16 * ST128;
    {
        const int wu = blockIdx.x, h = wu & 7, g = wu >> 3;
        f32x4 Sacc[8];
#pragma unroll
        for (int m = 0; m < 8; ++m) Sacc[m] = (f32x4){0.f, 0.f, 0.f, 0.f};
        if (OUT) {
            if (g > 0) { const f32x4* sp = (const f32x4*)c.hS + (size_t)(h * 32 + g) * FRAG_F4 + (wv * 8) * 64 + lane;
#pragma unroll
                for (int m = 0; m < 8; ++m) Sacc[m] = sp[m * 64]; }
            write_st(stw, Sacc, fr, fq);
        }
        LAS float* lbs = (LAS float*)(lds + H_LB);
        if (tid < 128) lbs[tid] = c.lb[h * 128 + tid];
        __syncthreads();
        float dsum = 0.f;
        u32x4 pf[4], pv[4];
#define HP_ISSUE(i_) do { const int tq_ = ltid(), rl_ = tq_ >> 8; const bf16_t* b_ = c.proj + (size_t)((g * 8 + (i_)) * 64 + ((tq_ >> 4) & 15) * 4) * PW + h * 128 + (tq_ & 15) * 8; \
        if (rl_ == 1 || OUT) { _Pragma("unroll") for (int tt = 0; tt < 4; ++tt) pf[tt] = *(const u32x4*)(b_ + (size_t)tt * PW + C_HF); } \
        if (rl_ == 0) { _Pragma("unroll") for (int tt = 0; tt < 4; ++tt) pv[tt] = *(const u32x4*)(b_ + (size_t)tt * PW + C_HI); } } while (0)
        HP_ISSUE(0);
        for (int i = 0; i < 8; ++i) {
            const int T0 = (g * 8 + i) * 64;
            const int tp = ltid(), role = tp >> 8, tq = (tp >> 4) & 15, co = tp & 15, c0 = tq * 4, d0 = co * 8;
            const bool cum = role == 1 || OUT;
            float cs[4][8];
            if (cum) {
                float lbv[8];
                { const f32x4 l0 = *(LAS f32x4*)(lbs + d0), l1 = *(LAS f32x4*)(lbs + d0 + 4);
                  lbv[0] = l0[0]; lbv[1] = l0[1]; lbv[2] = l0[2]; lbv[3] = l0[3]; lbv[4] = l1[0]; lbv[5] = l1[1]; lbv[6] = l1[2]; lbv[7] = l1[3]; }
#pragma unroll
                for (int tt = 0; tt < 4; ++tt) {
                    float fv[8]; unpack8(pf[tt], fv);
#pragma unroll
                    for (int j = 0; j < 8; ++j) { const float lf = __logf(lbv[j] + (1.f - lbv[j]) * sigmoidf_(fv[j])); cs[tt][j] = tt ? cs[tt - 1][j] + lf : lf; }
                }
                if (role == 1) {
                    *(LAS f32x4*)(oct + tq * 128 + d0) = (f32x4){cs[3][0], cs[3][1], cs[3][2], cs[3][3]}; *(LAS f32x4*)(oct + tq * 128 + d0 + 4) = (f32x4){cs[3][4], cs[3][5], cs[3][6], cs[3][7]};
                    if (tq == 8) { *(LAS f32x4*)(f4 + d0) = (f32x4){cs[0][0], cs[0][1], cs[0][2], cs[0][3]}; *(LAS f32x4*)(f4 + d0 + 4) = (f32x4){cs[0][4], cs[0][5], cs[0][6], cs[0][7]}; }
                }
            }
            if (role == 0) {
#pragma unroll
                for (int j = 0; j < 8; j += 2) { const int wi = j >> 1; u32x2 w0, w1;
                    const unsigned a0 = wi == 0 ? pv[0].x : wi == 1 ? pv[0].y : wi == 2 ? pv[0].z : pv[0].w, a1 = wi == 0 ? pv[1].x : wi == 1 ? pv[1].y : wi == 2 ? pv[1].z : pv[1].w;
                    const unsigned a2 = wi == 0 ? pv[2].x : wi == 1 ? pv[2].y : wi == 2 ? pv[2].z : pv[2].w, a3 = wi == 0 ? pv[3].x : wi == 1 ? pv[3].y : wi == 2 ? pv[3].z : pv[3].w;
                    w0.x = (a0 & 0xffffu) | (a1 << 16); w0.y = (a2 & 0xffffu) | (a3 << 16);
                    w1.x = (a0 >> 16) | (a1 & 0xffff0000u); w1.y = (a2 >> 16) | (a3 & 0xffff0000u);
                    *(LAS u32x2*)(lds + H_VT + (d0 + j) * ST64 + c0 * 2) = w0; *(LAS u32x2*)(lds + H_VT + (d0 + j + 1) * ST64 + c0 * 2) = w1; }
            }
            __syncthreads();
            if (cum) {
                float pre[8], tot[8], bmid[8];
#pragma unroll
                for (int j = 0; j < 8; ++j) { pre[j] = 0.f; tot[j] = 0.f; bmid[j] = 0.f; }
#pragma unroll
                for (int o = 0; o < 16; ++o) { const f32x4 x0 = *(LAS f32x4*)(oct + o * 128 + d0), x1 = *(LAS f32x4*)(oct + o * 128 + d0 + 4);
#pragma unroll
                    for (int j = 0; j < 8; ++j) { const float x = j < 4 ? x0[j] : x1[j - 4]; pre[j] += o < tq ? x : 0.f; bmid[j] += o < 8 ? x : 0.f; tot[j] += x; } }
                { const f32x4 x0 = *(LAS f32x4*)(f4 + d0), x1 = *(LAS f32x4*)(f4 + d0 + 4);
#pragma unroll
                  for (int j = 0; j < 8; ++j) bmid[j] += j < 4 ? x0[j] : x1[j - 4]; }
                if (role == 0) {
                    float ebm[8];
#pragma unroll
                    for (int j = 0; j < 8; ++j) ebm[j] = __expf(bmid[j]);
#pragma unroll
                    for (int tt = 0; tt < 4; ++tt) {
                        float qv[8], q1[8], q2[8];
                        unpack8(*(const u32x4*)(c.proj + (size_t)(T0 + c0 + tt) * PW + C_HQ + h * 128 + d0), qv);
#pragma unroll
                        for (int j = 0; j < 8; ++j) { const float q = siluf_(qv[j]) * 0.08838834764831845f; q1[j] = q * __expf(pre[j] + cs[tt][j] - bmid[j]); q2[j] = q1[j] * ebm[j]; }
                        *(LAS u32x4*)(lds + H_QT + (c0 + tt) * ST128 + d0 * 2) = pack8(q1); *(LAS u32x4*)(lds + H_QI + (c0 + tt) * ST128 + d0 * 2) = pack8(q2);
                    }
                } else {
                    if (tq == 0) {
#pragma unroll
                        for (int j = 0; j < 8; ++j) dec[d0 + j] = __expf(tot[j]);
                    }
                    if (OUT) {
#pragma unroll
                        for (int tt = 0; tt < 4; ++tt) {
                            float k1[8];
#pragma unroll
                            for (int j = 0; j < 8; ++j) { const float lf = tt ? cs[tt][j] - cs[tt - 1][j] : cs[0][j]; k1[j] = (1.f - __expf(lf)) * __expf(bmid[j] - pre[j] - cs[tt][j]); }
                            *(LAS u32x4*)(lds + H_KT + (c0 + tt) * ST128 + d0 * 2) = pack8(k1);
                        }
                    }
#pragma unroll
                    for (int j = 0; j < 8; ++j) { float col[4];
#pragma unroll
                        for (int tt = 0; tt < 4; ++tt) { const float lf = tt ? cs[tt][j] - cs[tt - 1][j] : cs[0][j]; col[tt] = (1.f - __expf(lf)) * __expf(tot[j] - pre[j] - cs[tt][j]); }
                        u32x2 w; w.x = cvt_pk_bf16(col[0], col[1]); w.y = cvt_pk_bf16(col[2], col[3]);
                        *(LAS u32x2*)(lds + H_KU + (d0 + j) * ST64 + c0 * 2) = w; }
                }
            }
            __syncthreads();
            if (i + 1 < 8) HP_ISSUE(i + 1);
            u32x4 gpre[2];
            if (OUT) gate_issue(gpre, c.proj + (size_t)T0 * PW + C_HG + h * 128);
            if (!OUT && tid < 128) dsum += __logf(dec[tid]);
            f32x4 oacc[4];
            if (OUT) {
                { f32x4 sc[2] = {(f32x4){0.f, 0.f, 0.f, 0.f}, (f32x4){0.f, 0.f, 0.f, 0.f}};
                  const int nt = wv & 3, mb = (wv >> 2) * 2;
                  mma_nt<2, 4>(sc, lds + H_KT + mb * 16 * ST128, ST128, lds + H_QT + nt * 16 * ST128, ST128, fr, fq);
#pragma unroll
                  for (int m = 0; m < 2; ++m) { const int cc = nt * 16 + fr, s0 = (mb + m) * 16 + 4 * fq; u32x2 w;
                      w.x = cvt_pk_bf16(s0 + 0 <= cc ? sc[m][0] : 0.f, s0 + 1 <= cc ? sc[m][1] : 0.f); w.y = cvt_pk_bf16(s0 + 2 <= cc ? sc[m][2] : 0.f, s0 + 3 <= cc ? sc[m][3] : 0.f);
                      *(LAS u32x2*)(lds + H_P + cc * ST64 + s0 * 2) = w; } }
                __syncthreads();
#pragma unroll
                for (int m = 0; m < 4; ++m) oacc[m] = (f32x4){0.f, 0.f, 0.f, 0.f};
                mma_nt<4, 2>(oacc, lds + H_P, ST64, lds + H_VT + wv * 16 * ST64, ST64, fr, fq);
                mma_nt<4, 4>(oacc, lds + H_QI, ST128, stw, ST128, fr, fq);
#pragma unroll
                for (int m = 0; m < 4; ++m)
#pragma unroll
                    for (int r = 0; r < 4; ++r) { float q = oacc[m][r] * oacc[m][r]; q += __shfl_xor(q, 1); q += __shfl_xor(q, 2); q += __shfl_xor(q, 4); q += __shfl_xor(q, 8); if (fr == 0) part[wv * 64 + 16 * m + 4 * fq + r] = q; }
            }
#pragma unroll
            for (int m = 0; m < 8; ++m) { const f32x4 dv = *(LAS f32x4*)(dec + 16 * m + 4 * fq); Sacc[m] = Sacc[m] * dv; }
            mma_nt<8, 2>(Sacc, lds + H_KU, ST64, lds + H_VT + wv * 16 * ST64, ST64, fr, fq);
            if (OUT) {
                lds_fence();
                write_st(stw, Sacc, fr, fq);
                __syncthreads();
                out_stage(lds + H_QT, part, oacc, gpre, c.hgrn_onorm_g, c.ocat + (size_t)T0 * D + h * 128, wv, lane, fr, fq);
            }
            __syncthreads();
        }
#undef HP_ISSUE
        if (!OUT) {
            f32x4* sp = (f32x4*)c.hL + (size_t)(h * 32 + g) * FRAG_F4 + (wv * 8) * 64 + lane;
#pragma unroll
            for (int m = 0; m < 8; ++m) sp[m * 64] = Sacc[m];
            if (tid < 128) c.hD[(h * 32 + g) * 128 + tid] = __expf(dsum);
        }
    }
}
__device__ void hgrn_scan(CtxK& c) {
    const int e = blockIdx.x * 512 + ltid();
    if (e >= 8 * FRAG_F4) return;
    const int h = e / FRAG_F4, fi = e % FRAG_F4, m = (fi >> 6) & 7, lane = fi & 63, d0 = 16 * m + 4 * (lane >> 4);
    f32x4 s = {0.f, 0.f, 0.f, 0.f};
    for (int g = 0; g < 31; ++g) {
        const f32x4 dc = *(const f32x4*)(c.hD + (h * 32 + g) * 128 + d0);
        s = s * dc + ((const f32x4*)c.hL)[(size_t)(h * 32 + g) * FRAG_F4 + fi];
        ((f32x4*)c.hS)[(size_t)(h * 32 + g + 1) * FRAG_F4 + fi] = s;
    }
}

constexpr int B_T = 0, B_KBG = 9216, B_KU = 26624, B_VB = 45056, B_QD = 63488, B_AT = 80896, B_SC = 90112, BLOB = 90368;
constexpr int G_ST = BLOB, G_RV = G_ST + 8 * 16 * ST128, G_PART = G_RV + 8 * 16 * ST64, G_RINV = G_PART + 2048, G_END = G_RINV + 256;
static_assert(G_END <= 147456, "gdn lds");
constexpr int P_K = 0, P_Q = 17408, P_BETA = 34816, P_GC = P_BETA + 256, P_EG = P_GC + 256, P_EK = P_EG + 256;

__device__ void gdn_prep(CtxK& c, LAS unsigned char* lds, int h, int g) {
    const int tid = ltid(), wv = __builtin_amdgcn_readfirstlane(tid >> 6), lane = tid & 63, fr = lane & 15, fq = lane >> 4;
    LAS float* sbeta = (LAS float*)(lds + P_BETA); LAS float* sgc = (LAS float*)(lds + P_GC); LAS float* seg = (LAS float*)(lds + P_EG); LAS float* sek = (LAS float*)(lds + P_EK);
    u32x4 raw[11];
#define GR_ISSUE(i_) do { const int tq_ = ltid(); if (tq_ < 384) { const int T_ = (g * 8 + (i_)) * 64 + ((tq_ >> 4) & 7) * 8 - 3; const bf16_t* b_ = c.proj + C_GQKV + (tq_ >> 7) * 1024 + h * 128 + (tq_ & 15) * 8; \
        _Pragma("unroll") for (int r = 0; r < 11; ++r) raw[r] = T_ + r >= 0 ? *(const u32x4*)(b_ + (size_t)(T_ + r) * PW) : (u32x4){0u, 0u, 0u, 0u}; } } while (0)
    GR_ISSUE(0);
    for (int i = 0; i < 8; ++i) {
        const int n = g * 8 + i, T0 = n * 64;
        unsigned char* blob = (unsigned char*)c.gBlob + (size_t)(h * 256 + n) * BLOB;
        if (wv == 0) {
            const float ga = c.gab[(size_t)(T0 + lane) * 16 + h], gb = c.gab[(size_t)(T0 + lane) * 16 + 8 + h];
            const float gl_ = -__expf(c.a_log[h]) * softplusf_(ga + c.dt_bias[h]);
            float gc = gl_;
#pragma unroll
            for (int o = 1; o < 64; o <<= 1) { const float t_ = __shfl_up(gc, o); if (lane >= o) gc += t_; }
            const float glast = __shfl(gc, 63);
            sbeta[lane] = sigmoidf_(gb); sgc[lane] = gc; seg[lane] = __expf(gc); sek[lane] = __expf(glast - gc);
            if (lane == 0) *(float*)(blob + B_SC) = __expf(glast);
        }
        __syncthreads();
        const int tp = ltid(), part = tp >> 7, to = (tp >> 4) & 7, co = tp & 15, c0 = to * 8, d0 = co * 8;
        if (tp < 384) {
            const int chb = part * 1024 + h * 128 + d0;
            float val[8][8];
            {
                float wj[4][8];
#pragma unroll
                for (int j = 0; j < 4; ++j) { const f32x4 a = *(const f32x4*)(c.conv_w + j * 3072 + chb), b = *(const f32x4*)(c.conv_w + j * 3072 + chb + 4);
                    wj[j][0] = a[0]; wj[j][1] = a[1]; wj[j][2] = a[2]; wj[j][3] = a[3]; wj[j][4] = b[0]; wj[j][5] = b[1]; wj[j][6] = b[2]; wj[j][7] = b[3]; }
#pragma unroll
                for (int tt = 0; tt < 8; ++tt) {
                    float a[8] = {0.f, 0.f, 0.f, 0.f, 0.f, 0.f, 0.f, 0.f};
#pragma unroll
                    for (int j = 0; j < 4; ++j) { float xv[8]; unpack8(raw[tt + j], xv);
#pragma unroll
                        for (int jj = 0; jj < 8; ++jj) a[jj] += wj[j][jj] * xv[jj]; }
#pragma unroll
                    for (int jj = 0; jj < 8; ++jj) val[tt][jj] = siluf_(a[jj]);
                }
            }
            if (part < 2) {
#pragma unroll
                for (int tt = 0; tt < 8; ++tt) { float ss = 0.f;
#pragma unroll
                    for (int jj = 0; jj < 8; ++jj) ss += val[tt][jj] * val[tt][jj];
                    ss += __shfl_xor(ss, 1); ss += __shfl_xor(ss, 2); ss += __shfl_xor(ss, 4); ss += __shfl_xor(ss, 8);
                    const float rn = rsqrtf(ss + 1e-6f) * (part == 0 ? 0.08838834764831845f : 1.f);
#pragma unroll
                    for (int jj = 0; jj < 8; ++jj) val[tt][jj] *= rn; }
            }
            if (part == 0) {
#pragma unroll
                for (int tt = 0; tt < 8; ++tt) { const int cc = c0 + tt; *(LAS u32x4*)(lds + P_Q + cc * ST128 + d0 * 2) = pack8(val[tt]);
                    const float e = seg[cc]; float qd[8];
#pragma unroll
                    for (int jj = 0; jj < 8; ++jj) qd[jj] = val[tt][jj] * e;
                    *(u32x4*)(blob + B_QD + cc * ST128 + d0 * 2) = pack8(qd); }
            } else if (part == 1) {
#pragma unroll
                for (int tt = 0; tt < 8; ++tt) { const int cc = c0 + tt; *(LAS u32x4*)(lds + P_K + cc * ST128 + d0 * 2) = pack8(val[tt]);
                    const float e = seg[cc] * sbeta[cc]; float kb[8];
#pragma unroll
                    for (int jj = 0; jj < 8; ++jj) kb[jj] = val[tt][jj] * e;
                    *(u32x4*)(blob + B_KBG + cc * ST128 + d0 * 2) = pack8(kb); }
#pragma unroll
                for (int jj = 0; jj < 8; ++jj) { float col[8];
#pragma unroll
                    for (int tt = 0; tt < 8; ++tt) col[tt] = val[tt][jj] * sek[c0 + tt];
                    *(u32x4*)(blob + B_KU + (d0 + jj) * ST64 + c0 * 2) = pack8(col); }
            } else {
#pragma unroll
                for (int jj = 0; jj < 8; ++jj) { float col[8];
#pragma unroll
                    for (int tt = 0; tt < 8; ++tt) col[tt] = val[tt][jj] * sbeta[c0 + tt];
                    *(u32x4*)(blob + B_VB + (d0 + jj) * ST64 + c0 * 2) = pack8(col); }
            }
        }
        __syncthreads();
        if (i + 1 < 8) GR_ISSUE(i + 1);
        {
            const int nt = wv & 3, mb = (wv >> 2) * 2, jj = nt * 16 + fr;
            f32x4 kk2[2] = {(f32x4){0.f, 0.f, 0.f, 0.f}, (f32x4){0.f, 0.f, 0.f, 0.f}}, at2[2] = {(f32x4){0.f, 0.f, 0.f, 0.f}, (f32x4){0.f, 0.f, 0.f, 0.f}};
            mma_nt<2, 4>(kk2, lds + P_K + mb * 16 * ST128, ST128, lds + P_K + nt * 16 * ST128, ST128, fr, fq);
            mma_nt<2, 4>(at2, lds + P_K + mb * 16 * ST128, ST128, lds + P_Q + nt * 16 * ST128, ST128, fr, fq);
            float* at = c.gAT + (size_t)(h * 256 + n) * 4096;
            const float gj = sgc[jj];
#pragma unroll
            for (int m = 0; m < 2; ++m) { const int i0 = (mb + m) * 16 + 4 * fq; f32x4 av; float pv[4];
#pragma unroll
                for (int r = 0; r < 4; ++r) { const int ii = i0 + r; const float gi = sgc[ii];
                    av[r] = jj < ii ? sbeta[ii] * kk2[m][r] * __expf(gi - gj) : 0.f;
                    pv[r] = ii <= jj ? at2[m][r] * __expf(gj - gi) : 0.f; }
                *(f32x4*)(at + jj * 64 + i0) = av;
                u32x2 w; w.x = cvt_pk_bf16(pv[0], pv[1]); w.y = cvt_pk_bf16(pv[2], pv[3]);
                *(u32x2*)(blob + B_AT + jj * ST64 + i0 * 2) = w; }
        }
        __syncthreads();
    }
}
__device__ void gdn_invert(CtxK& c, LAS unsigned char* lds, int h, int g) {
    const int tid = ltid(), wv = __builtin_amdgcn_readfirstlane(tid >> 6), lane = tid & 63;
    const int n = g * 8 + wv;
    LAS float* at = (LAS float*)(lds + wv * 16384);
    const float* src = c.gAT + (size_t)(h * 256 + n) * 4096;
#pragma unroll
    for (int k = 0; k < 16; ++k) *(LAS f32x4*)(at + (k * 64 + lane) * 4) = *(const f32x4*)(src + (k * 64 + lane) * 4);
    lds_fence();
    float r[64];
    unsigned ata = (unsigned)(size_t)at;
#pragma unroll
    for (int j = 63; j >= 0; --j) {
        float acc = lane == j ? 1.f : 0.f;
        LAS const float* arow = (LAS const float*)(size_t)ata + j * 64;
#pragma unroll
        for (int m4 = ((j + 1) & ~3); m4 < 64; m4 += 4) {
            const f32x4 a = *(LAS const f32x4*)(arow + m4);
#pragma unroll
            for (int q = 0; q < 4; ++q) if (m4 + q > j) acc = __builtin_fmaf(-r[m4 + q], a[q], acc);
        }
        r[j] = acc;
        asm volatile("" : "+v"(ata) : "v"(acc));
    }
    unsigned char* blob = (unsigned char*)c.gBlob + (size_t)(h * 256 + n) * BLOB;
#pragma unroll
    for (int k = 0; k < 8; ++k) { float v8[8];
#pragma unroll
        for (int q = 0; q < 8; ++q) v8[q] = r[k * 8 + q];
        *(u32x4*)(blob + B_T + lane * ST64 + k * 16) = pack8(v8); }
}
template <int MODE>
__device__ void gdn_pass(CtxK& c, LAS unsigned char* lds, int h, int g) {
    const int tid = ltid(), wv = __builtin_amdgcn_readfirstlane(tid >> 6), lane = tid & 63, fr = lane & 15, fq = lane >> 4;
    LAS unsigned char* stw = lds + G_ST + wv * 16 * ST128; LAS unsigned char* rvw = lds + G_RV + wv * 16 * ST64;
    LAS float* part = (LAS float*)(lds + G_PART); LAS float* rinv = (LAS float*)(lds + G_RINV);
    f32x4 Sacc[8];
#pragma unroll
    for (int m = 0; m < 8; ++m) {
        if (MODE == 1) { const int v = 16 * wv + fr, d0 = 16 * m + 4 * fq; Sacc[m] = (f32x4){d0 == v ? 1.f : 0.f, d0 + 1 == v ? 1.f : 0.f, d0 + 2 == v ? 1.f : 0.f, d0 + 3 == v ? 1.f : 0.f}; }
        else Sacc[m] = (f32x4){0.f, 0.f, 0.f, 0.f};
    }
    if (MODE == 2 && g > 0) { const f32x4* sp = (const f32x4*)c.gS + (size_t)(h * 32 + g) * FRAG_F4 + (wv * 8) * 64 + lane;
#pragma unroll
        for (int m = 0; m < 8; ++m) Sacc[m] = sp[m * 64]; }
    write_st(stw, Sacc, fr, fq);
    constexpr int LIM = MODE == 2 ? B_SC : B_QD, NQ = (LIM + 8191) / 8192;
    u32x4 pre[NQ];
    const unsigned char* blob0 = (const unsigned char*)c.gBlob + (size_t)(h * 256 + g * 8) * BLOB;
#define GP_ISSUE(i_) do { const unsigned char* bp_ = blob0 + (size_t)(i_) * BLOB + ltid() * 16; _Pragma("unroll") for (int q = 0; q < NQ; ++q) if (q * 8192 + 8176 < LIM || ltid() * 16 + q * 8192 < LIM) pre[q] = *(const u32x4*)(bp_ + q * 8192); } while (0)
    GP_ISSUE(0);
    for (int i = 0; i < 8; ++i) {
        const int n = g * 8 + i, T0 = n * 64;
        { const int tl = ltid() * 16;
#pragma unroll
          for (int q = 0; q < NQ; ++q) if (q * 8192 + 8176 < LIM || tl + q * 8192 < LIM) *(LAS u32x4*)(lds + tl + q * 8192) = pre[q]; }
        const float dlast = *(const float*)(blob0 + (size_t)i * BLOB + B_SC);
        u32x4 gpre[2];
        if (MODE == 2) gate_issue(gpre, c.proj + (size_t)T0 * PW + C_GG + h * 128);
        __syncthreads();
        if (i + 1 < 8) GP_ISSUE(i + 1);
        { f32x4 R[4];
#pragma unroll
          for (int m = 0; m < 4; ++m) R[m] = (f32x4){0.f, 0.f, 0.f, 0.f};
          mma_nt<4, 4>(R, lds + B_KBG, ST128, stw, ST128, fr, fq);
#pragma unroll
          for (int m = 0; m < 4; ++m) { float x0 = 0.f, x1 = 0.f, x2 = 0.f, x3 = 0.f;
              if (MODE != 1) { const u32x2 vb = *(LAS u32x2*)(lds + B_VB + (16 * wv + fr) * ST64 + (16 * m + 4 * fq) * 2); x0 = bflo(vb.x); x1 = bfhi(vb.x); x2 = bflo(vb.y); x3 = bfhi(vb.y); }
              u32x2 w; w.x = cvt_pk_bf16(x0 - R[m][0], x1 - R[m][1]); w.y = cvt_pk_bf16(x2 - R[m][2], x3 - R[m][3]);
              *(LAS u32x2*)(rvw + fr * ST64 + (16 * m + 4 * fq) * 2) = w; } }
        lds_fence();
        { f32x4 VN[4];
#pragma unroll
          for (int m = 0; m < 4; ++m) VN[m] = (f32x4){0.f, 0.f, 0.f, 0.f};
          mma_nt<4, 2>(VN, lds + B_T, ST64, rvw, ST64, fr, fq);
          mfma_pad4(VN); lds_fence();
#pragma unroll
          for (int m = 0; m < 4; ++m) { u32x2 w; w.x = cvt_pk_bf16(VN[m][0], VN[m][1]); w.y = cvt_pk_bf16(VN[m][2], VN[m][3]); *(LAS u32x2*)(rvw + fr * ST64 + (16 * m + 4 * fq) * 2) = w; } }
        lds_fence();
        f32x4 O[4];
        if (MODE == 2) {
#pragma unroll
            for (int m = 0; m < 4; ++m) O[m] = (f32x4){0.f, 0.f, 0.f, 0.f};
            mma_nt<4, 4>(O, lds + B_QD, ST128, stw, ST128, fr, fq);
            mma_nt<4, 2>(O, lds + B_AT, ST64, rvw, ST64, fr, fq);
#pragma unroll
            for (int m = 0; m < 4; ++m)
#pragma unroll
                for (int r = 0; r < 4; ++r) { float q = O[m][r] * O[m][r]; q += __shfl_xor(q, 1); q += __shfl_xor(q, 2); q += __shfl_xor(q, 4); q += __shfl_xor(q, 8); if (fr == 0) part[wv * 64 + 16 * m + 4 * fq + r] = q; }
        }
#pragma unroll
        for (int m = 0; m < 8; ++m) Sacc[m] = Sacc[m] * dlast;
        mma_nt<8, 2>(Sacc, lds + B_KU, ST64, rvw, ST64, fr, fq);
        lds_fence();
        write_st(stw, Sacc, fr, fq);
        if (MODE == 2) {
            __syncthreads();
            out_stage(lds + B_KBG, part, O, gpre, c.gdn_onorm_g, c.ocat + (size_t)T0 * D + 1024 + h * 128, wv, lane, fr, fq);
        }
        __syncthreads();
    }
#undef GP_ISSUE
    if (MODE == 0) {
        f32x4* sp = (f32x4*)c.gB + (size_t)(h * 32 + g) * FRAG_F4 + (wv * 8) * 64 + lane;
#pragma unroll
        for (int m = 0; m < 8; ++m) sp[m * 64] = Sacc[m];
    }
    if (MODE == 1) {
        mfma_pad8(Sacc);
        LAS bf16_t* img = (LAS bf16_t*)lds;
#pragma unroll
        for (int m = 0; m < 8; ++m)
#pragma unroll
            for (int r = 0; r < 4; ++r) img[(16 * m + 4 * fq + r) * (ST128 / 2) + 16 * wv + fr] = (bf16_t)(cvt_pk_bf16(Sacc[m][r], Sacc[m][r]) & 0xffffu);
        __syncthreads();
        unsigned char* dst = (unsigned char*)c.gM + (size_t)(h * 32 + g) * (128 * ST128);
#pragma unroll
        for (int q = 0; q < 5; ++q) { const int o = tid * 16 + q * 8192; if (q < 4 || o < 128 * ST128) *(u32x4*)(dst + o) = *(LAS u32x4*)(lds + o); }
        __syncthreads();
    }
}
__device__ void gdn_scan(CtxK& c, LAS unsigned char* lds, int h) {
    const int tid = ltid(), wv = __builtin_amdgcn_readfirstlane(tid >> 6), lane = tid & 63, fr = lane & 15, fq = lane >> 4;
    LAS unsigned char* stw = lds + G_ST + wv * 16 * ST128;
    f32x4 Sacc[8], Bn[8]; u32x4 mp[5];
#pragma unroll
    for (int m = 0; m < 8; ++m) Sacc[m] = (f32x4){0.f, 0.f, 0.f, 0.f};
#define GS_ISSUE(g_) do { const unsigned char* src_ = (const unsigned char*)c.gM + (size_t)(h * 32 + (g_)) * (128 * ST128) + tid * 16; \
        _Pragma("unroll") for (int q = 0; q < 5; ++q) if (q < 4 || tid * 16 + q * 8192 < 128 * ST128) mp[q] = *(const u32x4*)(src_ + q * 8192); \
        const f32x4* bp_ = (const f32x4*)c.gB + (size_t)(h * 32 + (g_)) * FRAG_F4 + (wv * 8) * 64 + lane; \
        _Pragma("unroll") for (int m = 0; m < 8; ++m) Bn[m] = bp_[m * 64]; } while (0)
    GS_ISSUE(0);
    for (int g = 0; g < 31; ++g) {
#pragma unroll
        for (int q = 0; q < 5; ++q) if (q < 4 || tid * 16 + q * 8192 < 128 * ST128) *(LAS u32x4*)(lds + tid * 16 + q * 8192) = mp[q];
        write_st(stw, Sacc, fr, fq);
#pragma unroll
        for (int m = 0; m < 8; ++m) Sacc[m] = Bn[m];
        __syncthreads();
        if (g + 1 < 31) GS_ISSUE(g + 1);
        mma_nt<8, 4>(Sacc, lds, ST128, stw, ST128, fr, fq);
        f32x4* sp = (f32x4*)c.gS + (size_t)(h * 32 + g + 1) * FRAG_F4 + (wv * 8) * 64 + lane;
#pragma unroll
        for (int m = 0; m < 8; ++m) sp[m * 64] = Sacc[m];
        __syncthreads();
    }
#undef GS_ISSUE
}
}
__device__ void ph_hgrn1(CtxK& c, LAS unsigned char* lds) { mx::hgrn_pass<false>(c, lds); }
__device__ void ph_hgrn2(CtxK& c, LAS unsigned char* lds) { mx::hgrn_scan(c); }
__device__ void ph_hgrn3(CtxK& c, LAS unsigned char* lds) { mx::hgrn_pass<true>(c, lds); }
__device__ void ph_gdn1(CtxK& c, LAS unsigned char* lds) {
    const int wu = blockIdx.x, h = wu & 7, g = wu >> 3;
    mx::gdn_prep(c, lds, h, g); __syncthreads();
    asm volatile("s_waitcnt vmcnt(0)" ::: "memory"); __syncthreads();
    mx::gdn_invert(c, lds, h, g);
    asm volatile("s_waitcnt vmcnt(0)" ::: "memory"); __syncthreads();
    mx::gdn_pass<0>(c, lds, h, g); __syncthreads();
    mx::gdn_pass<1>(c, lds, h, g); __syncthreads();
}
__device__ void ph_gdn2(CtxK& c, LAS unsigned char* lds) { if (blockIdx.x < 8) mx::gdn_scan(c, lds, blockIdx.x); }
__device__ void ph_gdn3(CtxK& c, LAS unsigned char* lds) { const int wu = blockIdx.x; mx::gdn_pass<2>(c, lds, wu & 7, wu >> 3); }

constexpr int N2_LA = 0, N2_LB = 8192, N2_XH = 16384, N2_XL = N2_XH + 17408, N2_Y = N2_XL + 17408, N2_LOG = N2_Y + 34816, N2_RS = N2_LOG + 64 * 65 * 4, N2_IDX = N2_RS + 256, N2_BIAS = N2_IDX + 2048, N2_END = N2_BIAS + 256;
static_assert(N2_END <= 147456, "norm2 lds");
__device__ void ph_norm2(CtxK& c, LAS unsigned char* lds) {
    const int tid = ltid(), wg = blockIdx.x, lane = tid & 63, wv = __builtin_amdgcn_readfirstlane(tid >> 6), fr = lane & 15, fq = lane >> 4;
    LAS float* la = (LAS float*)(lds + N2_LA); LAS float* lb_ = (LAS float*)(lds + N2_LB); LAS float* lg = (LAS float*)(lds + N2_LOG); LAS float* rs = (LAS float*)(lds + N2_RS);
    LAS int* idxt = (LAS int*)(lds + N2_IDX); LAS float* bias2 = (LAS float*)(lds + N2_BIAS);
    for (int j = tid; j < D; j += 512) { la[j] = c.norm2_g[j] * (1.f + c.mod[4 * D + j]); lb_[j] = c.mod[3 * D + j]; }
    if (tid < 64) bias2[tid] = c.rbias2[tid];
    __syncthreads();
    const int tok0 = wg * 64;
    f32x4 vn[8];
    { const float* xr = c.out + (size_t)(tok0 + wv * 8) * D;
#pragma unroll
      for (int i = 0; i < 8; ++i) vn[i] = *(const f32x4*)(xr + i * 256 + lane * 4); }
    for (int rr = 0; rr < 8; ++rr) {
        const int row = tok0 + wv * 8 + rr;
        f32x4 v[8]; float ss = 0.f;
#pragma unroll
        for (int i = 0; i < 8; ++i) { v[i] = vn[i]; ss += v[i][0] * v[i][0] + v[i][1] * v[i][1] + v[i][2] * v[i][2] + v[i][3] * v[i][3]; }
        if (rr + 1 < 8) { const float* xr = c.out + (size_t)(row + 1) * D;
#pragma unroll
            for (int i = 0; i < 8; ++i) vn[i] = *(const f32x4*)(xr + i * 256 + lane * 4); }
        ss = wave_sum(ss); const float r = rsqrtf(ss * (1.f / D) + 1e-6f);
        if (lane == 0) rs[wv * 8 + rr] = r;
#pragma unroll
        for (int i = 0; i < 8; ++i) { const int e = i * 256 + lane * 4; const f32x4 a = *(LAS f32x4*)(la + e), b = *(LAS f32x4*)(lb_ + e); const f32x4 y = v[i] * r * a + b;
            *(unsigned*)(c.h2 + (size_t)row * D + e) = cvt4_fp8(4.f * y[0], 4.f * y[1], 4.f * y[2], 4.f * y[3]); }
    }
    const int xrow = tid >> 3, xseg = (tid & 7) * 16;
    f32x4 xr_[4]; u32x4 yr_[5];
    auto issue = [&](int ch) {
        const float* xp = c.out + (size_t)(tok0 + xrow) * D + ch * 128 + xseg;
#pragma unroll
        for (int q = 0; q < 4; ++q) xr_[q] = *(const f32x4*)(xp + q * 4);
        const unsigned char* yp = (const unsigned char*)c.rwimg + (size_t)ch * 34816 + tid * 16;
#pragma unroll
        for (int q = 0; q < 4; ++q) yr_[q] = *(const u32x4*)(yp + q * 8192);
        if (tid < 128) yr_[4] = *(const u32x4*)(yp + 32768);
    };
    issue(0);
    f32x4 acc[2] = {(f32x4){0.f, 0.f, 0.f, 0.f}, (f32x4){0.f, 0.f, 0.f, 0.f}};
    const int mt = wv >> 1, nb = (wv & 1) * 2;
    for (int ch = 0; ch < 16; ++ch) {
        __syncthreads();
        { float hi[16], lo[16];
#pragma unroll
          for (int q = 0; q < 4; ++q)
#pragma unroll
              for (int j = 0; j < 4; ++j) { const float x = xr_[q][j]; const float h = __uint_as_float(cvt_pk_bf16(x, x) << 16); hi[q * 4 + j] = h; lo[q * 4 + j] = x - h; }
          float t8[8];
#pragma unroll
          for (int hh = 0; hh < 2; ++hh) {
#pragma unroll
              for (int j = 0; j < 8; ++j) t8[j] = hi[hh * 8 + j];
              *(LAS u32x4*)(lds + N2_XH + xrow * 272 + (xseg + hh * 8) * 2) = mx::pack8(t8);
#pragma unroll
              for (int j = 0; j < 8; ++j) t8[j] = lo[hh * 8 + j];
              *(LAS u32x4*)(lds + N2_XL + xrow * 272 + (xseg + hh * 8) * 2) = mx::pack8(t8); }
#pragma unroll
          for (int q = 0; q < 4; ++q) *(LAS u32x4*)(lds + N2_Y + tid * 16 + q * 8192) = yr_[q];
          if (tid < 128) *(LAS u32x4*)(lds + N2_Y + tid * 16 + 32768) = yr_[4]; }
        __syncthreads();
        if (ch + 1 < 16) issue(ch + 1);
#pragma unroll
        for (int kk = 0; kk < 4; ++kk) {
            const int ko = (kk * 32 + fq * 8) * 2;
            const bf16x8 ah = *(const LAS bf16x8*)(lds + N2_XH + (16 * mt + fr) * 272 + ko), al = *(const LAS bf16x8*)(lds + N2_XL + (16 * mt + fr) * 272 + ko);
#pragma unroll
            for (int n = 0; n < 2; ++n) {
                const bf16x8 bh = *(const LAS bf16x8*)(lds + N2_Y + (16 * (nb + n) + fr) * 272 + ko), bl = *(const LAS bf16x8*)(lds + N2_Y + 17408 + (16 * (nb + n) + fr) * 272 + ko);
                acc[n] = mx::mfma16(ah, bh, acc[n]); acc[n] = mx::mfma16(ah, bl, acc[n]); acc[n] = mx::mfma16(al, bh, acc[n]);
            }
        }
    }
#pragma unroll
    for (int n = 0; n < 2; ++n)
#pragma unroll
        for (int r = 0; r < 4; ++r) lg[(16 * mt + 4 * fq + r) * 65 + 16 * (nb + n) + fr] = acc[n][r];
    __syncthreads();
    const float rb = c.router_bias[lane], b2 = bias2[lane];
    for (int rr = 0; rr < 8; rr += 2) {
        float s[2], bb[2], mb[2], wsum[2] = {0.f, 0.f}; int myk[2] = {-1, -1};
#pragma unroll
        for (int u = 0; u < 2; ++u) {
            const int lr = wv * 8 + rr + u;
            s[u] = sigmoidf_(lg[lr * 65 + lane] * rs[lr] + b2); const float b = s[u] + rb; bb[u] = b;
            const float m7 = dppf<0x141>(b);
            const float o1 = dppf<0xB1>(b), o2 = dppf<0x4E>(b), o3 = dppf<0x1B>(b), o6 = dppf<0xB1>(m7), o5 = dppf<0x4E>(m7), o4 = dppf<0x1B>(m7);
            int rk = 0;
#define TK_CMP(ov, x) rk += ((ov) > b || ((ov) == b && (lane ^ (x)) < lane)) ? 1 : 0
            TK_CMP(o1, 1); TK_CMP(o2, 2); TK_CMP(o3, 3); TK_CMP(o4, 4); TK_CMP(o5, 5); TK_CMP(o6, 6); TK_CMP(m7, 7);
#undef TK_CMP
            float gs = rk < 2 ? b : 0.f; gs += dppf<0xB1>(gs); gs += dppf<0x4E>(gs); gs += dppf<0x141>(gs);
            int grk = 0; const int gi = lane >> 3;
#pragma unroll
            for (int j = 0; j < 8; ++j) { const float og = __builtin_bit_cast(float, __builtin_amdgcn_readlane(__builtin_bit_cast(int, gs), j * 8)); grk += (og > gs || (og == gs && j < gi)) ? 1 : 0; }
            mb[u] = grk < 4 ? b : -INFINITY; }
#pragma unroll
        for (int k = 0; k < TOPK; ++k)
#pragma unroll
            for (int u = 0; u < 2; ++u) {
                const float m = wave_max_dpp(mb[u]);
                const unsigned long long bal = __ballot(mb[u] == m); const int win = __builtin_amdgcn_readfirstlane(__ffsll((long long)bal) - 1);
                wsum[u] += __builtin_bit_cast(float, __builtin_amdgcn_readlane(__builtin_bit_cast(int, s[u]), win));
                if (lane == win) { mb[u] = -INFINITY; myk[u] = k; } }
#pragma unroll
        for (int u = 0; u < 2; ++u) { const int lr = wv * 8 + rr + u, t = tok0 + lr;
            if (myk[u] >= 0) { c.idx[t * TOPK + myk[u]] = lane; c.wts[t * TOPK + myk[u]] = s[u] / wsum[u] * 2.5f; idxt[lr * TOPK + myk[u]] = lane; } }
    }
    __syncthreads();
    { const int myexp = idxt[tid]; int rank = 0, cntl = 0;
      for (int e = 0; e < 64; ++e) {
          const unsigned long long bal = __ballot(myexp == e);
          const int below = __builtin_amdgcn_mbcnt_hi((unsigned)(bal >> 32), __builtin_amdgcn_mbcnt_lo((unsigned)bal, 0u));
          if (myexp == e) rank = below;
          if (lane == e) cntl = __popcll(bal); }
      LAS int* wcnt = (LAS int*)(lds + N2_XH);
      wcnt[wv * 64 + lane] = cntl;
      __syncthreads();
      int base = 0;
      for (int w = 0; w < wv; ++w) base += wcnt[w * 64 + myexp];
      c.rnk[wg * 512 + tid] = base + rank;
      if (tid < 64) { int n = 0;
#pragma unroll
          for (int w = 0; w < 8; ++w) n += wcnt[w * 64 + tid];
          c.tile_cnt[wg * 64 + tid] = n; } }
}
__device__ void ph_route(CtxK& c, LAS unsigned char* lds) {
    const int tid = ltid(), b = blockIdx.x, e = tid & 63, part = tid >> 6;
    LAS int* psum = (LAS int*)lds; LAS int* pbel = psum + 512; LAS int* tot = pbel + 512; LAS int* offb = tot + 64; LAS int* pst = offb + 64;
    { int sa = 0, sb = 0;
      for (int tl = part * 32; tl < part * 32 + 32; ++tl) { const int v = c.tile_cnt[tl * 64 + e]; sa += v; sb += tl < b ? v : 0; }
      psum[part * 64 + e] = sa; pbel[part * 64 + e] = sb; }
    __syncthreads();
    if (tid < 64) {
        int t_ = 0, o_ = 0;
#pragma unroll
        for (int q = 0; q < 8; ++q) { t_ += psum[q * 64 + e]; o_ += pbel[q * 64 + e]; }
        const int pad = (t_ + 255) & ~255; int inc = pad;
#pragma unroll
        for (int o = 1; o < 64; o <<= 1) { const int x = __shfl_up(inc, o); if (e >= o) inc += x; }
        const int ps = inc - pad;
        tot[e] = t_; offb[e] = o_; pst[e] = ps;
        if (b == 0) {
            const int b0 = ps >> 8, nbe = pad >> 8;
            for (int j = 0; j < nbe; ++j) { c.blk_row[b0 + j] = ps + j * 256; c.blk_exp[b0 + j] = e; }
            const int nbr = __shfl(inc, 63) >> 8;
            c.blk_row[nbr + e] = PROUTED + e * 256; c.blk_exp[nbr + e] = NE;
            if (e == 0) *c.nent = nbr + S / 256;
        }
        c.tok_p[PROUTED + b * 64 + e] = b * 64 + e; c.w_p[PROUTED + b * 64 + e] = 1.f;
    }
    __syncthreads();
    { const int p = b * 512 + tid, ex = c.idx[p], d = pst[ex] + offb[ex] + c.rnk[p];
      c.tok_p[d] = p >> 3; c.w_p[d] = c.wts[p]; c.pos[p] = d; }
    if (b < NE) { const int ps = pst[b], t_ = tot[b], pe = (t_ + 255) & ~255;
        for (int r = t_ + tid; r < pe; r += 512) { c.tok_p[ps + r] = 0; c.w_p[ps + r] = 0.f; } }
}

constexpr int LDS_BYTES = 163840, LDS_MAIN = LDS_BYTES - 16;
static_assert(gm::VBOFF + 512 * 8 <= LDS_MAIN, "lds map");
__global__ void __launch_bounds__(512, 2) k_mega(Ctx c) {
    extern __shared__ __attribute__((aligned(16))) unsigned char smem[];
    LAS unsigned char* lds = (LAS unsigned char*)smem;
    if (ltid() == 0) *(LAS u32x4*)(lds + LDS_MAIN) = (u32x4){0u, 0u, 0u, 0u};
    __syncthreads();
    CtxK* kp = (CtxK*)__builtin_amdgcn_kernarg_segment_ptr();
    (void)xcd_barrier_post(c.bar, (volatile LAS unsigned*)(lds + LDS_MAIN));
#define PHASE(fn) do { const CtxK* kp_ = kp; asm volatile("" : "+s"(kp_)); fn(*kp_, lds); __syncthreads(); } while (0)
#define GRID_BARRIER() do { const CtxK* kp_ = kp; asm volatile("" : "+s"(kp_)); XcdBarrier bb_; bb_.bar = kp_->bar; bb_.x = xb_xcc_id(); bb_.st = (volatile LAS unsigned*)(lds + LDS_MAIN); xcd_barrier(bb_); } while (0)
    PHASE(ph_pro1);      GRID_BARRIER();
    PHASE(ph_norm1);     GRID_BARRIER();
    PHASE(ph_gemm1);     GRID_BARRIER();
    PHASE(ph_hgrn1);     PHASE(ph_gdn1);  GRID_BARRIER();
    PHASE(ph_hgrn2);     PHASE(ph_gdn2);  PHASE(ph_cvt_exp); GRID_BARRIER();
    PHASE(ph_hgrn3);     PHASE(ph_gdn3);  GRID_BARRIER();
    PHASE(ph_gemm2);     GRID_BARRIER();
    PHASE(ph_gemm3);     GRID_BARRIER();
    PHASE(ph_norm2);     GRID_BARRIER();
    PHASE(ph_route);     GRID_BARRIER();
    PHASE(ph_moe_gu);    GRID_BARRIER();
    PHASE(ph_moe_dn);    GRID_BARRIER();
    PHASE(ph_final);
#undef PHASE
#undef GRID_BARRIER
}

extern "C" void kernel_launch(void* const* d_in, const int* in_sizes, int n_in, void* d_out, int out_size, void* d_ws, size_t ws_size, hipStream_t stream) {
    Ctx c{};
    const float** ip = (const float**)&c.x;
    for (int i = 0; i < 25; ++i) ip[i] = (const float*)d_in[i];
    c.out = (float*)d_out;
    char* ws = (char*)d_ws; constexpr size_t MB = 1024 * 1024;
    c.bar = (unsigned*)ws;
    c.modp = (float*)(ws + 64 * 1024); c.mod = (float*)(ws + 320 * 1024); c.lb = (float*)(ws + 384 * 1024);
    c.cnt = (int*)(ws + 392 * 1024); c.nent = (int*)(ws + 396 * 1024); c.blk_row = (int*)(ws + 400 * 1024); c.blk_exp = (int*)(ws + 404 * 1024);
    c.idx = (int*)(ws + 1 * MB); c.wts = (float*)(ws + 2 * MB); c.tok_p = (int*)(ws + 3 * MB); c.w_p = (float*)(ws + 4 * MB); c.pos = (int*)(ws + 5 * MB);
    c.gab = (float*)(ws + 6 * MB); c.gbeta = (float*)(ws + 7 * MB + 0); c.gdec = (float*)(ws + 7 * MB + 512 * 1024);
    c.rwimg = (bf16_t*)(ws + 8 * MB); c.rbias2 = (float*)(ws + 9 * MB); c.tile_cnt = (int*)(ws + 9 * MB + 4096); c.rnk = (int*)(ws + 10 * MB);
    char* big = ws + 16 * MB;
    auto at = [&](size_t mib) { return big + mib * MB; };
    c.dn_t = (unsigned char*)at(0); c.gu_t = (unsigned char*)at(130);
    c.win_t = (bf16_t*)at(0); c.h1 = (bf16_t*)at(48); c.gAT = (float*)at(112);
    c.proj = (bf16_t*)at(390); c.gBlob = (unsigned char*)at(774); c.merged = (bf16_t*)at(774);
    c.gM = (unsigned char*)at(951); c.gB = (float*)at(960); c.hL = (float*)at(976); c.gS = (float*)at(992); c.hS = (float*)at(1008); c.hD = (float*)at(1024);
    c.wa_t = (bf16_t*)at(1025); c.wb_t = (bf16_t*)at(1029); c.wout_t = (bf16_t*)at(1033); c.ocat = (bf16_t*)at(1041);
    c.Y = (unsigned char*)at(130); c.hid = (unsigned char*)at(770); c.h2 = (unsigned char*)at(930);
    static_assert((size_t)NEX * D * FF * 2 <= 130 * MB && (size_t)NEX * 1024 * D * 2 <= 260 * MB && (size_t)PW * D * 2 <= 48 * MB && (size_t)S * D * 2 <= 64 * MB, "map A");
    static_assert((size_t)S * PW * 2 <= 384 * MB && (size_t)2048 * mx::BLOB <= 177 * MB && (size_t)256 * 128 * mx::ST128 <= 9 * MB && (size_t)PTOT * D * 2 <= 640 * MB && (size_t)PTOT * FF * 2 <= 160 * MB, "map B");
    const size_t need = 16 * MB + 1105 * MB;
    if (ws_size < need) { fprintf(stderr, "kernel_launch: workspace too small: %zu < %zu\n", ws_size, need); return; }

    static int grid = 0;
    if (!grid) {
        int dev = 0, cus = 0, per_cu = 0;
        hipGetDevice(&dev); hipDeviceGetAttribute(&cus, hipDeviceAttributeMultiprocessorCount, dev);
        hipFuncSetAttribute((const void*)k_mega, hipFuncAttributeMaxDynamicSharedMemorySize, LDS_BYTES);
        hipOccupancyMaxActiveBlocksPerMultiprocessor(&per_cu, (const void*)k_mega, 512, LDS_BYTES);
        if (per_cu < 1) fprintf(stderr, "kernel_launch: occupancy query reports %d blocks per CU\n", per_cu);
        grid = cus;
        if (grid != 256) { fprintf(stderr, "kernel_launch: built for a 256-CU device (token-mixer units = workgroups); got %d CUs\n", cus); grid = -1; }
    }
    if (grid < 0) return;
    hipMemsetAsync(c.bar, 0, XCD_BAR_WORDS * sizeof(unsigned), stream);
    hipLaunchKernelGGL(k_mega, dim3(grid), dim3(512), LDS_BYTES, stream, c);
}
```

```cpp
#include <hip/hip_runtime.h>
#include <stdint.h>
#include <stdio.h>

#define LAS __attribute__((address_space(3)))
typedef unsigned short bf16_t;
typedef short bf16x8 __attribute__((ext_vector_type(8)));
typedef float f32x4 __attribute__((ext_vector_type(4)));
typedef unsigned u32x4 __attribute__((ext_vector_type(4)));
typedef unsigned u32x2 __attribute__((ext_vector_type(2)));
typedef int v4i __attribute__((ext_vector_type(4)));
typedef int v8i __attribute__((ext_vector_type(8)));

constexpr int S = 16384, D = 2048, INW = 12304, PW = 12288, NE = 64, TOPK = 8, TK = S * TOPK, FF = 512;
constexpr int NEX = NE + 1;
constexpr int PROUTED = 147456, PTOT = PROUTED + S, NBLK_MAX = PROUTED / 256;
constexpr int C_HQ = 0, C_HF = 1024, C_HI = 2048, C_HG = 3072, C_GQKV = 4096, C_GG = 7168, C_MGA = 8192, C_MGB = 10240;
constexpr int WIN_GAB = 7168;

__device__ __forceinline__ float rcpf_(float x) { return __builtin_amdgcn_rcpf(x); }
__device__ __forceinline__ float sigmoidf_(float x) { return rcpf_(1.f + __expf(-x)); }
__device__ __forceinline__ float siluf_(float x) { return x * rcpf_(1.f + __expf(-x)); }
__device__ __forceinline__ float softplusf_(float x) { return x > 20.f ? x : log1pf(expf(x)); }
__device__ __forceinline__ float bf2f(bf16_t b) { return __uint_as_float(((unsigned)b) << 16); }
__device__ __forceinline__ float bflo(unsigned w) { return __uint_as_float(w << 16); }
__device__ __forceinline__ float bfhi(unsigned w) { return __uint_as_float(w & 0xffff0000u); }
__device__ __forceinline__ unsigned cvt_pk_bf16(float lo, float hi) { unsigned r; asm volatile("v_cvt_pk_bf16_f32 %0, %1, %2" : "=v"(r) : "v"(lo), "v"(hi)); return r; }
__device__ __forceinline__ unsigned cvt4_fp8(float a, float b, float c_, float d) {
    a = fminf(fmaxf(a, -448.f), 448.f); b = fminf(fmaxf(b, -448.f), 448.f); c_ = fminf(fmaxf(c_, -448.f), 448.f); d = fminf(fmaxf(d, -448.f), 448.f);
    int w = __builtin_amdgcn_cvt_pk_fp8_f32(a, b, 0, false); w = __builtin_amdgcn_cvt_pk_fp8_f32(c_, d, w, true); return (unsigned)w; }
__device__ __forceinline__ int ltid() { int t = threadIdx.x; asm volatile("" : "+v"(t)); return t; }
template <int CTRL> __device__ __forceinline__ float dppf(float v) { return __builtin_bit_cast(float, __builtin_amdgcn_update_dpp(0, __builtin_bit_cast(int, v), CTRL, 0xf, 0xf, false)); }
__device__ __forceinline__ float wave_max_dpp(float v) {
    v = fmaxf(v, dppf<0x128>(v)); v = fmaxf(v, dppf<0x124>(v)); v = fmaxf(v, dppf<0x122>(v)); v = fmaxf(v, dppf<0x121>(v));
    const int b = __builtin_bit_cast(int, v);
    return fmaxf(fmaxf(__builtin_bit_cast(float, __builtin_amdgcn_readlane(b, 0)), __builtin_bit_cast(float, __builtin_amdgcn_readlane(b, 16))), fmaxf(__builtin_bit_cast(float, __builtin_amdgcn_readlane(b, 32)), __builtin_bit_cast(float, __builtin_amdgcn_readlane(b, 48))));
}
__device__ __forceinline__ float wave_sum_dpp(float v) {
    v += __builtin_bit_cast(float, __builtin_amdgcn_update_dpp(0, __builtin_bit_cast(int, v), 0x128, 0xf, 0xf, false));
    v += __builtin_bit_cast(float, __builtin_amdgcn_update_dpp(0, __builtin_bit_cast(int, v), 0x124, 0xf, 0xf, false));
    v += __builtin_bit_cast(float, __builtin_amdgcn_update_dpp(0, __builtin_bit_cast(int, v), 0x122, 0xf, 0xf, false));
    v += __builtin_bit_cast(float, __builtin_amdgcn_update_dpp(0, __builtin_bit_cast(int, v), 0x121, 0xf, 0xf, false));
    const int b = __builtin_bit_cast(int, v);
    return __builtin_bit_cast(float, __builtin_amdgcn_readlane(b, 0)) + __builtin_bit_cast(float, __builtin_amdgcn_readlane(b, 16)) + __builtin_bit_cast(float, __builtin_amdgcn_readlane(b, 32)) + __builtin_bit_cast(float, __builtin_amdgcn_readlane(b, 48));
}
__device__ __forceinline__ float wave_sum(float v) {
#pragma unroll
    for (int o = 32; o >= 1; o >>= 1) v += __shfl_xor(v, o);
    return v;
}


#define XB_TMO      128
#define XB_XCNT(j)  (256  + 64 * (j))
#define XB_XSUB(j)  (1280 + 64 * (j))
#define XB_XGEN(j)  (2304 + 64 * (j))
#define XB_TOP      3328
#define XB_TOPGEN   3392
#define XCD_BAR_WORDS 3456
#define XB_SPIN_CAP (1u << 18)
__device__ __forceinline__ unsigned xb_ld(unsigned* p)              { return __hip_atomic_load(p, __ATOMIC_RELAXED, __HIP_MEMORY_SCOPE_AGENT); }
__device__ __forceinline__ unsigned xb_add(unsigned* p, unsigned v) { return __hip_atomic_fetch_add(p, v, __ATOMIC_RELAXED, __HIP_MEMORY_SCOPE_AGENT); }
__device__ __forceinline__ unsigned xb_xcc_id() { return (unsigned)__builtin_amdgcn_s_getreg((3 << 11) | 20) & 0xFu; }
#define XB_SPIN(cond, bar) do { unsigned _sp = 0; while (cond) { __builtin_amdgcn_s_sleep(1); \
    if ((++_sp & 255u) == 0u) { if (xb_ld(&(bar)[XB_TMO])) break; if (_sp > XB_SPIN_CAP) { atomicAdd(&(bar)[XB_TMO], 1u); break; } } } } while (0)
struct XcdBarrier { unsigned* bar; unsigned x; volatile LAS unsigned* st; };
__device__ __forceinline__ XcdBarrier xcd_barrier_post(unsigned* bar, volatile LAS unsigned* st) {
    XcdBarrier b; b.bar = bar; b.x = xb_xcc_id(); b.st = st;
    if (threadIdx.x == 0) (void)xb_add(&bar[XB_XCNT(b.x)], 1u);
    return b;
}
__device__ __forceinline__ void xcd_barrier_complete(unsigned* bar, unsigned x, unsigned& nloc, unsigned& nx) {
    const unsigned G = gridDim.x * gridDim.y * gridDim.z;
    unsigned sum, cnt, mine, sp = 0u;
    for (;;) {
        sum = 0u; cnt = 0u; mine = 0u;
#pragma unroll
        for (unsigned j = 0; j < 16; ++j) { const unsigned c = xb_ld(&bar[XB_XCNT(j)]); sum += c; cnt += (c > 0u) ? 1u : 0u; mine = (j == x) ? c : mine; }
        if (sum == G) break;
        __builtin_amdgcn_s_sleep(1);
        if ((++sp & 255u) == 0u) { if (xb_ld(&bar[XB_TMO])) break; if (sp > XB_SPIN_CAP) { atomicAdd(&bar[XB_TMO], 1u); break; } }
    }
    nloc = mine > 0u ? mine : 1u; nx = cnt > 0u ? cnt : 1u;
}
__device__ __forceinline__ void xcd_barrier(const XcdBarrier& b) {
    asm volatile("s_waitcnt vmcnt(0)" ::: "memory");
    __syncthreads();
    if (threadIdx.x == 0) {
        unsigned* bar = b.bar;
        __builtin_amdgcn_s_waitcnt(0);
        unsigned nloc = b.st[0], nx = b.st[1];
        if (nloc == 0u) { xcd_barrier_complete(bar, b.x, nloc, nx); b.st[0] = nloc; b.st[1] = nx; }
        const unsigned old = xb_add(&bar[XB_XSUB(b.x)], 1u);
        const unsigned gen = old / nloc;
        if (old + 1u == (gen + 1u) * nloc) {
            __builtin_amdgcn_fence(__ATOMIC_RELEASE, "agent");
            asm volatile("s_waitcnt vmcnt(0)" ::: "memory");
            const unsigned og = xb_add(&bar[XB_TOP], 1u);
            const unsigned tg = og / nx;
            if (og + 1u == (tg + 1u) * nx) xb_add(&bar[XB_TOPGEN], 1u);
            else XB_SPIN(xb_ld(&bar[XB_TOPGEN]) == tg, bar);
            __builtin_amdgcn_fence(__ATOMIC_ACQUIRE, "agent");
            xb_add(&bar[XB_XGEN(b.x)], 1u);
            asm volatile("s_waitcnt vmcnt(0)" ::: "memory");
        } else {
            XB_SPIN(xb_ld(&bar[XB_XGEN(b.x)]) == gen, bar);
            __builtin_amdgcn_fence(__ATOMIC_ACQUIRE, "agent");
            asm volatile("s_waitcnt vmcnt(0)" ::: "memory");
        }
    }
    __syncthreads();
}

namespace gm {
constexpr int BM = 256, BK = 64, HALF = 128, HTB = HALF * BK * 2, STAGE_BYTES = 8 * HTB;
__host__ __device__ __forceinline__ int lds_byte(int r, int c) { const int st = (r >> 4) * 2 + (c >> 5), rr = r & 15, cc = c & 31, ob = rr * 64 + cc * 2; return st * 1024 + (ob ^ (((ob >> 9) & 1) << 5)); }
__host__ __device__ __forceinline__ void stage_rc(int b, int& R, int& C) { const int st = b / 1024, sb = b % 1024, swz = sb ^ (((sb >> 9) & 1) << 5); R = (st >> 1) * 16 + swz / 64; C = (st & 1) * 32 + (swz % 64) / 2; }
__host__ __device__ __forceinline__ int perm32(int rho) { const int n = rho >> 4, i = rho & 15; return 8 * (i >> 2) + 4 * n + (i & 3); }

struct Unit { int pm, pn, aux; const char* Bp; };
constexpr int UOFF = STAGE_BYTES + 256 + 10240, VBOFF = UOFF + 2 * 512 * 16;
__device__ __forceinline__ void put_offs(LAS unsigned char* lds, int ui, unsigned a00, unsigned a01, unsigned a10, unsigned a11) { *(LAS u32x4*)(lds + UOFF + ((ui & 1) * 512 + ltid()) * 16) = (u32x4){a00, a01, a10, a11}; }

template <class Epi, class Sched>
__device__ __forceinline__ void gphase(LAS unsigned char* lds, const char* Abase, const int K, Sched& S, Epi& E) {
    const int tid = ltid(), wid = __builtin_amdgcn_readfirstlane(tid >> 6), lane = tid & 63, wr = wid >> 2, wc = wid & 3, fr = lane & 15, fq = lane >> 4;
    const int nt = K / BK;
    { unsigned vb_[2];
#pragma unroll
      for (int i = 0; i < 2; ++i) { int R, C; stage_rc(tid * 16 + i * 8192, R, C); const int Rb = Epi::PERM == 2 ? (64 * (R >> 5) + 16 * ((R >> 2) & 3) + 4 * ((R >> 4) & 1) + (R & 3)) : Epi::PERM == 1 ? ((R & ~31) + perm32(R & 31)) : R; vb_[i] = (unsigned)(Rb * K + C) * 2u; }
      *(LAS u32x2*)(lds + VBOFF + tid * 8) = (u32x2){vb_[0], vb_[1]}; }
    const unsigned hstepB = (unsigned)(Epi::PERM == 2 ? 8 : HALF) * K * 2;
    const unsigned ldsw = (unsigned)wid * 1024u;
    constexpr bool F8 = Epi::F8; constexpr int KST = F8 ? 16 : 1024;
    const int aoff = lds_byte(wr * 64 + fr, fq * (F8 ? 16 : 8)), boff = lds_byte(wc * 32 + fr, fq * (F8 ? 16 : 8));
#define G_SA(b, h) (((b) * 2 + (h)) * HTB)
#define G_SB(b, h) ((4 + (b) * 2 + (h)) * HTB)
#define G_STAGE_A(bufoff, slot_, half_, kb) do { const char* ab_ = Abase + (kb); const u32x2 p_ = *(const LAS u32x2*)(lds + UOFF + (((slot_) & 1) * 512 + tid) * 16 + (half_) * 8); unsigned p0_ = p_.x, p1_ = p_.y; asm volatile("" : "+v"(p0_), "+v"(p1_)); \
        __builtin_amdgcn_global_load_lds((const unsigned*)(ab_ + p0_), (LAS unsigned*)(lds + (bufoff) + ldsw), 16, 0, 0); \
        __builtin_amdgcn_global_load_lds((const unsigned*)(ab_ + p1_), (LAS unsigned*)(lds + (bufoff) + ldsw + 8192), 16, 0, 0); } while (0)
#define G_STAGE_B(bufoff, bp, kb) do { const char* bb_ = (bp) + (kb); const u32x2 q_ = *(const LAS u32x2*)(lds + VBOFF + tid * 8); unsigned p0_ = q_.x, p1_ = q_.y; asm volatile("" : "+v"(p0_), "+v"(p1_)); \
        __builtin_amdgcn_global_load_lds((const unsigned*)(bb_ + p0_), (LAS unsigned*)(lds + (bufoff) + ldsw), 16, 0, 0); \
        __builtin_amdgcn_global_load_lds((const unsigned*)(bb_ + p1_), (LAS unsigned*)(lds + (bufoff) + ldsw + 8192), 16, 0, 0); } while (0)
#define G_LDA(dst, b, h) do { _Pragma("unroll") for (int m = 0; m < 4; ++m) _Pragma("unroll") for (int k = 0; k < 2; ++k) dst[m][k] = *(const LAS v4i*)(lds + G_SA(b, h) + aoff + m * 2048 + k * KST); } while (0)
#define G_LDB(dst, b, h) do { _Pragma("unroll") for (int n = 0; n < 2; ++n) _Pragma("unroll") for (int k = 0; k < 2; ++k) dst[n][k] = *(const LAS v4i*)(lds + G_SB(b, h) + boff + n * 2048 + k * KST); } while (0)
#define G_CAT(x_) __builtin_shufflevector(x_[0], x_[1], 0, 1, 2, 3, 4, 5, 6, 7)
#define G_MMA(ai, bj, At, Bt) do { __builtin_amdgcn_s_setprio(1); _Pragma("unroll") for (int m = 0; m < 4; ++m) _Pragma("unroll") for (int n = 0; n < 2; ++n) { \
        if constexpr (F8) acc[ai][bj][m][n] = __builtin_amdgcn_mfma_scale_f32_16x16x128_f8f6f4(G_CAT(Bt[n]), G_CAT(At[m]), acc[ai][bj][m][n], 0, 0, 0, Epi::SB, 0, Epi::SA); \
        else { _Pragma("unroll") for (int k = 0; k < 2; ++k) acc[ai][bj][m][n] = __builtin_amdgcn_mfma_f32_16x16x32_bf16(__builtin_bit_cast(bf16x8, Bt[n][k]), __builtin_bit_cast(bf16x8, At[m][k]), acc[ai][bj][m][n], 0, 0, 0); } } \
        __builtin_amdgcn_s_setprio(0); } while (0)
#define G_WAIT_V(n) asm volatile("s_waitcnt vmcnt(" #n ")" ::: "memory")
#define G_WAIT_L(n) asm volatile("s_waitcnt lgkmcnt(" #n ")" ::: "memory")
#define G_BAR __builtin_amdgcn_s_barrier()
#define G_SCHED __builtin_amdgcn_sched_barrier(0)
#define G_ZERO() do { _Pragma("unroll") for (int a = 0; a < 2; ++a) _Pragma("unroll") for (int b = 0; b < 2; ++b) _Pragma("unroll") for (int m = 0; m < 4; ++m) _Pragma("unroll") for (int n = 0; n < 2; ++n) acc[a][b][m][n] = (f32x4){0.f, 0.f, 0.f, 0.f}; } while (0)
    Unit cur, nxt; int ui = 0;
    if (!S.next(lds, 0, cur)) return;
    f32x4 acc[2][2][4][2];
    G_ZERO();
    v4i At[4][2], B0[2][2], B1[2][2];
    G_STAGE_B(G_SB(0, 0), cur.Bp, 0); G_STAGE_B(G_SB(0, 1), cur.Bp + hstepB, 0); G_STAGE_A(G_SA(0, 0), 0, 0, 0); G_STAGE_A(G_SA(0, 1), 0, 1, 0);
    if (wr == 1) G_BAR;
    G_WAIT_V(2); G_BAR;
    G_STAGE_B(G_SB(1, 0), cur.Bp, 128); G_STAGE_A(G_SA(1, 0), 0, 0, 128); G_STAGE_B(G_SB(1, 1), cur.Bp + hstepB, 128);
    G_WAIT_V(6); G_BAR;
    for (;;) {
        bool has_next = false;
#pragma unroll 1
        for (int t = 0; t < nt; t += 2) {
            const bool last = (t == nt - 2);
            const unsigned kb1 = (unsigned)(t + 1) * 128u, kb2 = last ? 0u : (unsigned)(t + 2) * 128u, kb3 = kb2 + 128u;
            const char* b2 = cur.Bp; int s2 = ui;
            if (last) {
                has_next = S.next(lds, ui + 1, nxt); if (!has_next) nxt = cur; else s2 = ui + 1;
                b2 = nxt.Bp; }
            G_LDB(B0, 0, 0); G_LDB(B1, 0, 1); G_SCHED; G_LDA(At, 0, 0); G_STAGE_A(G_SA(1, 1), ui, 1, kb1);
            G_WAIT_V(8); G_WAIT_L(0); G_BAR; G_MMA(0, 0, At, B0); G_MMA(0, 1, At, B1); G_BAR; G_SCHED;
            G_LDA(At, 0, 1); G_STAGE_B(G_SB(0, 0), b2, kb2); G_STAGE_B(G_SB(0, 1), b2 + hstepB, kb2); G_STAGE_A(G_SA(0, 0), s2, 0, kb2);
            G_WAIT_V(8); G_WAIT_L(0); G_BAR; G_MMA(1, 0, At, B0); G_MMA(1, 1, At, B1); G_BAR; G_SCHED;
            G_LDB(B0, 1, 0); G_LDB(B1, 1, 1); G_SCHED; G_LDA(At, 1, 0); G_STAGE_A(G_SA(0, 1), s2, 1, kb2);
            G_WAIT_V(8); G_WAIT_L(0); G_BAR; G_MMA(0, 0, At, B0); G_MMA(0, 1, At, B1); G_BAR; G_SCHED;
            G_LDA(At, 1, 1); G_STAGE_B(G_SB(1, 0), b2, kb3); G_STAGE_B(G_SB(1, 1), b2 + hstepB, kb3); G_STAGE_A(G_SA(1, 0), s2, 0, kb3);
            G_WAIT_V(8); G_WAIT_L(0); G_BAR; G_MMA(1, 0, At, B0); G_MMA(1, 1, At, B1); G_BAR; G_SCHED;
        }
        if (wr == 0) G_BAR;
        { const int tz = ltid(), wz = tz >> 6, lz = tz & 63; E(acc, cur, wz >> 2, wz & 3, lz & 15, lz >> 4); }
        if (!has_next) break;
        if (!E.keep(cur)) G_ZERO();
        cur = nxt; ++ui;
        if (wr == 1) G_BAR;
    }
    G_WAIT_V(0);
    G_BAR;
#undef G_SA
#undef G_SB
#undef G_STAGE_A
#undef G_STAGE_B
#undef G_LDA
#undef G_CAT
#undef G_LDB
#undef G_MMA
#undef G_WAIT_V
#undef G_WAIT_L
#undef G_BAR
#undef G_SCHED
#undef G_ZERO
}

struct DenseSched {
    int nM, nN, nwg, G, c, lda, K, parts; const char* Bt; const char* Bt2;
    __device__ void init(int M, int N, int K_, int lda_, const void* Bt_, const void* Bt2_, int parts_) {
        nM = M / BM; nN = N / BM; nwg = nM * nN; G = gridDim.x; c = blockIdx.x; lda = lda_; K = K_; Bt = (const char*)Bt_; Bt2 = (const char*)Bt2_; parts = parts_;
    }
    __device__ bool next(LAS unsigned char* lds, int i, Unit& u) const {
        const int ti = parts == 2 ? (i >> 1) : i, part = parts == 2 ? (i & 1) : 0;
        const long L = (long)ti * G + c; if (L >= nwg) return false;
        int wgid = (int)L; { const int q = nwg / 8, r = nwg % 8, xcd = wgid % 8, off = wgid / 8; wgid = (xcd < r ? xcd * (q + 1) : r * (q + 1) + (xcd - r) * q) + off; }
        const int nig = 8 * nN, gid = wgid / nig, fm = gid * 8, gsz = (nM - fm) < 8 ? (nM - fm) : 8;
        u.pm = fm + ((wgid % nig) % gsz); u.pn = (wgid % nig) / gsz; u.aux = part;
        u.Bp = (part ? Bt2 : Bt) + (size_t)u.pn * BM * K * 2;
        int R0, C0, R1, C1; { const int tz = ltid(); stage_rc(tz * 16, R0, C0); stage_rc(tz * 16 + 8192, R1, C1); }
        const unsigned rb = (unsigned)u.pm * BM, po = part ? (unsigned)K * 2u : 0u;
        put_offs(lds, i, ((rb + R0) * lda + C0) * 2u + po, ((rb + R1) * lda + C1) * 2u + po, ((rb + HALF + R0) * lda + C0) * 2u + po, ((rb + HALF + R1) * lda + C1) * 2u + po);
        return true;
    }
};
template <bool GATHER, int NN, int KK, int LDA, size_t WSTRIDE>
struct MoeSched {
    static constexpr int MAXU = 24, TBL = STAGE_BYTES, TOK = STAGE_BYTES + 256;
    int nu; const char* W;
    __device__ void init(LAS unsigned char* lds, const int* nent_p, const int* blk_row, const int* blk_exp, const int* tok_p, const void* W_) {
        W = (const char*)W_;
        const int tid = ltid(), G = gridDim.x, c = blockIdx.x, nent = *nent_p;
        const int x = c & 7, slot = c >> 3, nslot = G >> 3, e0 = (int)((long)x * nent / 8), e1 = (int)((long)(x + 1) * nent / 8), tot = (e1 - e0) * NN;
        nu = tot > slot ? (tot - slot + nslot - 1) / nslot : 0; if (nu > MAXU) nu = MAXU;
        LAS int* t_ = (LAS int*)(lds + TBL); LAS int* k_ = (LAS int*)(lds + TOK);
        if (tid < nu) { const int uidx = tid * nslot + slot, ent = e0 + uidx / NN; t_[tid * 2] = blk_row[ent]; t_[tid * 2 + 1] = blk_exp[ent] * 16 + uidx % NN; }
        __syncthreads();
        if (GATHER) { for (int j = tid; j < nu * 256; j += 512) k_[j] = tok_p[t_[(j >> 8) * 2] + (j & 255)]; __syncthreads(); }
    }
    __device__ bool next(LAS unsigned char* lds, int i, Unit& u) const {
        if (i >= nu) return false;
        LAS const int* tbl = (LAS const int*)(lds + TBL); LAS const int* tokt = (LAS const int*)(lds + TOK);
        int R0, C0, R1, C1; { const int tz = ltid(); stage_rc(tz * 16, R0, C0); stage_rc(tz * 16 + 8192, R1, C1); }
        const int rb = __builtin_amdgcn_readfirstlane(tbl[i * 2]), ep = __builtin_amdgcn_readfirstlane(tbl[i * 2 + 1]), e = ep >> 4; u.pn = ep & 15; u.pm = rb; u.aux = e;
        u.Bp = W + (size_t)e * WSTRIDE + (size_t)u.pn * BM * KK * 2;
        if (GATHER) {
            const unsigned t00 = tokt[i * 256 + R0], t01 = tokt[i * 256 + R1], t10 = tokt[i * 256 + HALF + R0], t11 = tokt[i * 256 + HALF + R1];
            put_offs(lds, i, (t00 * LDA + C0) * 2u, (t01 * LDA + C1) * 2u, (t10 * LDA + C0) * 2u, (t11 * LDA + C1) * 2u);
        } else {
            put_offs(lds, i, ((unsigned)(rb + R0) * LDA + C0) * 2u, ((unsigned)(rb + R1) * LDA + C1) * 2u, ((unsigned)(rb + HALF + R0) * LDA + C0) * 2u, ((unsigned)(rb + HALF + R1) * LDA + C1) * 2u);
        }
        return true;
    }
};

struct EpiProj {
    static constexpr int PERM = 1; static constexpr bool F8 = false; static constexpr int SA = 0, SB = 0; bf16_t* O;
    __device__ __forceinline__ bool keep(const Unit&) const { return false; }
    __device__ __forceinline__ void operator()(f32x4 (&acc)[2][2][4][2], const Unit& u, int wr, int wc, int fr, int fq) const {
        const int row0 = u.pm * BM + wr * 64 + fr, col0 = u.pn * BM + wc * 32 + 8 * fq;
#pragma unroll
        for (int ai = 0; ai < 2; ++ai)
#pragma unroll
            for (int m = 0; m < 4; ++m) { bf16_t* rowp = O + (size_t)(row0 + ai * HALF + m * 16) * PW + col0;
#pragma unroll
                for (int bj = 0; bj < 2; ++bj) { const f32x4 v0 = acc[ai][bj][m][0], v1 = acc[ai][bj][m][1]; u32x4 w;
                    w.x = cvt_pk_bf16(v0[0], v0[1]); w.y = cvt_pk_bf16(v0[2], v0[3]); w.z = cvt_pk_bf16(v1[0], v1[1]); w.w = cvt_pk_bf16(v1[2], v1[3]);
                    *(u32x4*)(rowp + bj * HALF) = w; } }
    }
};
struct EpiMerge {
    static constexpr int PERM = 1; static constexpr bool F8 = false; static constexpr int SA = 0, SB = 0; const bf16_t* proj; bf16_t* O;
    __device__ __forceinline__ bool keep(const Unit& u) const { return u.aux == 0; }
    __device__ __forceinline__ void operator()(f32x4 (&acc)[2][2][4][2], const Unit& u, int wr, int wc, int fr, int fq) const {
        const int row0 = u.pm * BM + wr * 64 + fr, col0 = u.pn * BM + wc * 32 + 8 * fq;
#pragma unroll
        for (int ai = 0; ai < 2; ++ai)
#pragma unroll
            for (int m = 0; m < 4; ++m) { const size_t r = (size_t)(row0 + ai * HALF + m * 16);
#pragma unroll
                for (int bj = 0; bj < 2; ++bj) {
                    const u32x4 gb = *(const u32x4*)(proj + r * PW + C_MGB + col0 + bj * HALF);
                    const f32x4 eb0 = {__expf(-bflo(gb.x)), __expf(-bfhi(gb.x)), __expf(-bflo(gb.y)), __expf(-bfhi(gb.y))};
                    const f32x4 eb1 = {__expf(-bflo(gb.z)), __expf(-bfhi(gb.z)), __expf(-bflo(gb.w)), __expf(-bfhi(gb.w))};
                    if (u.aux == 0) {
                        const u32x4 ga = *(const u32x4*)(proj + r * PW + C_MGA + col0 + bj * HALF);
                        const f32x4 ea0 = {__expf(-bflo(ga.x)), __expf(-bfhi(ga.x)), __expf(-bflo(ga.y)), __expf(-bfhi(ga.y))};
                        const f32x4 ea1 = {__expf(-bflo(ga.z)), __expf(-bfhi(ga.z)), __expf(-bflo(ga.w)), __expf(-bfhi(ga.w))};
#pragma unroll
                        for (int j = 0; j < 4; ++j) { acc[ai][bj][m][0][j] *= (1.f + eb0[j]) * rcpf_(1.f + ea0[j]); acc[ai][bj][m][1][j] *= (1.f + eb1[j]) * rcpf_(1.f + ea1[j]); }
                    } else {
                        f32x4 v0 = acc[ai][bj][m][0], v1 = acc[ai][bj][m][1];
#pragma unroll
                        for (int j = 0; j < 4; ++j) { v0[j] *= rcpf_(1.f + eb0[j]); v1[j] *= rcpf_(1.f + eb1[j]); }
                        u32x4 w; w.x = cvt_pk_bf16(v0[0], v0[1]); w.y = cvt_pk_bf16(v0[2], v0[3]); w.z = cvt_pk_bf16(v1[0], v1[1]); w.w = cvt_pk_bf16(v1[2], v1[3]);
                        *(u32x4*)(O + r * D + col0 + bj * HALF) = w;
                    } } }
    }
};
struct EpiResid {
    static constexpr int PERM = 0; static constexpr bool F8 = false; static constexpr int SA = 0, SB = 0; const float* x; const float* gt; float* O;
    __device__ __forceinline__ bool keep(const Unit&) const { return false; }
    __device__ __forceinline__ void operator()(f32x4 (&acc)[2][2][4][2], const Unit& u, int wr, int wc, int fr, int fq) const {
        const int row0 = u.pm * BM + wr * 64 + fr, col0 = u.pn * BM + wc * 32 + 4 * fq;
        f32x4 g[2][2];
#pragma unroll
        for (int bj = 0; bj < 2; ++bj)
#pragma unroll
            for (int n = 0; n < 2; ++n) g[bj][n] = *(const f32x4*)(gt + col0 + bj * HALF + n * 16);
#pragma unroll
        for (int ai = 0; ai < 2; ++ai)
#pragma unroll
            for (int m = 0; m < 4; ++m) { const size_t ro = (size_t)(row0 + ai * HALF + m * 16) * D + col0;
#pragma unroll
                for (int bj = 0; bj < 2; ++bj)
#pragma unroll
                    for (int n = 0; n < 2; ++n) { const f32x4 xv = *(const f32x4*)(x + ro + bj * HALF + n * 16); *(f32x4*)(O + ro + bj * HALF + n * 16) = xv + g[bj][n] * acc[ai][bj][m][n]; } }
    }
};
struct EpiSwiglu {
    static constexpr int PERM = 2; static constexpr bool F8 = true; static constexpr int SA = 0x7d7d7d7d, SB = 0x79797979; unsigned char* hid;
    __device__ __forceinline__ bool keep(const Unit&) const { return false; }
    __device__ __forceinline__ void operator()(f32x4 (&acc)[2][2][4][2], const Unit& u, int wr, int wc, int fr, int fq) const {
        const int row0 = u.pm + wr * 64 + fr, j0 = u.pn * 128 + wc * 32 + 8 * fq;
#pragma unroll
        for (int ai = 0; ai < 2; ++ai)
#pragma unroll
            for (int m = 0; m < 4; ++m) { unsigned char* rowp = hid + (unsigned)((row0 + ai * HALF + m * 16) * FF + j0);
                unsigned w2[2];
#pragma unroll
                for (int bj = 0; bj < 2; ++bj) { const f32x4 g = acc[ai][bj][m][0], up = acc[ai][bj][m][1];
                    w2[bj] = cvt4_fp8(8.f * siluf_(g[0]) * up[0], 8.f * siluf_(g[1]) * up[1], 8.f * siluf_(g[2]) * up[2], 8.f * siluf_(g[3]) * up[3]); }
                *(u32x2*)rowp = (u32x2){w2[0], w2[1]};
                asm volatile("" ::: "memory"); __builtin_amdgcn_sched_barrier(0); }
    }
};
struct EpiDown {
    static constexpr int PERM = 2; static constexpr bool F8 = true; static constexpr int SA = 0x7c7c7c7c, SB = 0x7a7a7a7a; unsigned char* Y; const float* w_p;
    __device__ __forceinline__ bool keep(const Unit&) const { return false; }
    __device__ __forceinline__ void operator()(f32x4 (&acc)[2][2][4][2], const Unit& u, int wr, int wc, int fr, int fq) const {
        const int row0 = u.pm + wr * 64 + fr, col0 = u.pn * BM + wc * 64 + 16 * fq;
#pragma unroll
        for (int ai = 0; ai < 2; ++ai)
#pragma unroll
            for (int m = 0; m < 4; ++m) { const int r = row0 + ai * HALF + m * 16; const float wt = w_p[(unsigned)r] * 16.f; unsigned char* rowp = Y + ((unsigned)r * D + col0);
                unsigned w4[4];
#pragma unroll
                for (int bj = 0; bj < 2; ++bj) { const f32x4 v0 = acc[ai][bj][m][0] * wt, v1 = acc[ai][bj][m][1] * wt;
                    w4[bj * 2] = cvt4_fp8(v0[0], v0[1], v0[2], v0[3]); w4[bj * 2 + 1] = cvt4_fp8(v1[0], v1[1], v1[2], v1[3]); }
                *(u32x4*)rowp = (u32x4){w4[0], w4[1], w4[2], w4[3]};
                asm volatile("" ::: "memory"); __builtin_amdgcn_sched_barrier(0); }
    }
};
}

struct Ctx {
    const float *x, *c, *w_ada, *b_ada, *norm1_g, *norm2_g, *w_in, *lb_table, *hgrn_onorm_g, *conv_w, *a_log, *dt_bias, *gdn_onorm_g, *w_bh, *w_bg, *w_out, *w_router, *router_bias,
        *w_eg, *w_eu, *w_ed, *w_sg, *w_su, *w_sd, *normf_g;
    float* out;
    unsigned* bar;
    float *modp, *mod, *lb, *gab;
    int *idx, *cnt, *tok_p, *pos, *blk_row, *blk_exp, *nent;
    float *wts, *w_p;
    bf16_t *win_t, *wa_t, *wb_t, *wout_t, *h1, *proj, *ocat, *merged;
    float *gq, *gk, *gv, *gbeta, *gdec, *oa, *ob;
    float *hL, *hS, *hD;
    float *gAT, *gB, *gS; unsigned char *gBlob, *gM;
    unsigned char *dn_t, *hid, *gu_t, *h2, *Y;
    bf16_t* rwimg; float* rbias2; int *tile_cnt, *rnk;
};

typedef const __attribute__((address_space(4))) Ctx CtxK;

__device__ __forceinline__ void cvt_tile(LAS float* t, const float* srcA, const float* srcB, int ld, int mode, bf16_t* dst, int ldd) {
    const int tid = ltid(), kr = tid >> 6, cl = tid & 63;
    const float* sp = (mode == 1 && cl >= 32) ? (srcB + cl - 32) : (srcA + cl);
    float v[8];
#pragma unroll
    for (int p = 0; p < 8; ++p) v[p] = sp[(size_t)(p * 8 + kr) * ld];
    __syncthreads();
#pragma unroll
    for (int p = 0; p < 8; ++p) t[(p * 8 + kr) * 65 + cl] = v[p];
    __syncthreads();
    const int r = tid >> 3, seg = (tid & 7) * 8;
    const int lc = mode == 1 ? (((r >> 2) & 1) * 32 + 4 * (r >> 3) + (r & 3)) : r;
    float w[8];
#pragma unroll
    for (int j = 0; j < 8; ++j) w[j] = t[(seg + j) * 65 + lc];
    u32x4 o; o.x = cvt_pk_bf16(w[0], w[1]); o.y = cvt_pk_bf16(w[2], w[3]); o.z = cvt_pk_bf16(w[4], w[5]); o.w = cvt_pk_bf16(w[6], w[7]);
    *(u32x4*)(dst + (size_t)r * ldd + seg) = o;
}
__device__ __forceinline__ void cvt_tile8(LAS float* t, const float* srcA, const float* srcB, int ld, int mode, unsigned char* dst, int ldd, float scale) {
    const int tid = ltid(), kr = tid >> 6, cl = tid & 63;
    const float* sp = (mode == 1 && cl >= 32) ? (srcB + cl - 32) : (srcA + cl);
    float v[8];
#pragma unroll
    for (int p = 0; p < 8; ++p) v[p] = sp[(size_t)(p * 8 + kr) * ld];
    __syncthreads();
#pragma unroll
    for (int p = 0; p < 8; ++p) t[(p * 8 + kr) * 65 + cl] = v[p] * scale;
    __syncthreads();
    const int r = tid >> 3, seg = (tid & 7) * 8;
    const int lc = mode == 1 ? (((r >> 2) & 1) * 32 + 4 * (r >> 3) + (r & 3)) : r;
    float w[8];
#pragma unroll
    for (int j = 0; j < 8; ++j) w[j] = t[(seg + j) * 65 + lc];
    *(u32x2*)(dst + (size_t)r * ldd + seg) = (u32x2){cvt4_fp8(w[0], w[1], w[2], w[3]), cvt4_fp8(w[4], w[5], w[6], w[7])};
}
__device__ __forceinline__ void cvt_job(LAS float* t, int tile, const float* src, int ld, int K, bf16_t* dst) {
    const int nkt = K / 64, nt = tile / nkt, kt = tile % nkt;
    cvt_tile(t, src + (size_t)kt * 64 * ld + nt * 64, nullptr, ld, 0, dst + (size_t)nt * 64 * K + kt * 64, K);
}

__device__ void ph_pro1(CtxK& c, LAS unsigned char* lds) {
    const int tid = ltid(), wg = blockIdx.x, G = gridDim.x;
    LAS float* lf = (LAS float*)lds;
    for (int job = wg; job < 192; job += G) {
        const int cc = job % 48, kp = job / 48, q = tid & 63, rg = tid >> 6;
        f32x4 a = {0.f, 0.f, 0.f, 0.f};
        for (int r0 = rg; r0 < 512; r0 += 64) { f32x4 w[8]; float s[8];
#pragma unroll
            for (int u = 0; u < 8; ++u) { const int k = kp * 512 + r0 + u * 8; w[u] = *(const f32x4*)(c.w_ada + (size_t)k * (6 * D) + cc * 256 + q * 4); s[u] = c.c[k]; }
#pragma unroll
            for (int u = 0; u < 8; ++u) a += siluf_(s[u]) * w[u]; }
        __syncthreads();
        *(LAS f32x4*)(lf + (rg * 64 + q) * 4) = a;
        __syncthreads();
        if (tid < 64) { f32x4 s = {0.f, 0.f, 0.f, 0.f};
#pragma unroll
            for (int g = 0; g < 8; ++g) s += *(LAS f32x4*)(lf + (g * 64 + tid) * 4);
            *(f32x4*)(c.modp + (size_t)kp * (6 * D) + cc * 256 + tid * 4) = s; }
    }
    if (wg == G - 1) for (int j = tid; j < 1024; j += 512) c.lb[j] = 1.f / (1.f + expf(c.lb_table[1024 + j] - c.lb_table[j]));
    {
        const int kr = tid >> 6, cl = tid & 63, r = tid >> 3, seg = (tid & 7) * 8;
        float v[4][8];
        const int t0 = wg < 192 ? wg : 5376 + (wg - 192), tstep = wg < 192 ? 192 : 64, ntl = wg < 192 ? 28 : 44;
#define P1_DESC(T_) const float* sp_; bf16_t* dp_; int ld_, ldd_; { const int T = (T_); \
            if (T < 6144) { const int nt = T / 32, kt = T % 32, sc = nt * 64 + (nt * 64 >= WIN_GAB ? 16 : 0); sp_ = c.w_in + (size_t)kt * 64 * INW + sc; ld_ = INW; dp_ = c.win_t + (size_t)nt * 64 * D + kt * 64; ldd_ = D; } \
            else { const float* s0_; bf16_t* d0_; int K_, t_; if (T < 6656) { t_ = T - 6144; s0_ = c.w_bh; d0_ = c.wa_t; K_ = 1024; } else if (T < 7168) { t_ = T - 6656; s0_ = c.w_bg; d0_ = c.wb_t; K_ = 1024; } else { t_ = T - 7168; s0_ = c.w_out; d0_ = c.wout_t; K_ = 2048; } \
                const int nkt = K_ / 64, nt = t_ / nkt, kt = t_ % nkt; sp_ = s0_ + (size_t)kt * 64 * D + nt * 64; ld_ = D; dp_ = d0_ + (size_t)nt * 64 * K_ + kt * 64; ldd_ = K_; } }
#define P1_LOAD(i0_) do { _Pragma("unroll") for (int j = 0; j < 4; ++j) { P1_DESC(t0 + ((i0_) + j) * tstep) (void)dp_; (void)ldd_; const float* s_ = sp_ + cl; \
            _Pragma("unroll") for (int p = 0; p < 8; ++p) v[j][p] = s_[(size_t)(p * 8 + kr) * ld_]; } } while (0)
        P1_LOAD(0);
        for (int i0 = 0; i0 < ntl; i0 += 4) {
            __syncthreads();
#pragma unroll
            for (int j = 0; j < 4; ++j)
#pragma unroll
                for (int p = 0; p < 8; ++p) lf[j * 4160 + (p * 8 + kr) * 65 + cl] = v[j][p];
            __syncthreads();
            if (i0 + 4 < ntl) P1_LOAD(i0 + 4);
#pragma unroll
            for (int j = 0; j < 4; ++j) { P1_DESC(t0 + (i0 + j) * tstep) (void)sp_; (void)ld_;
                float w[8];
#pragma unroll
                for (int jj = 0; jj < 8; ++jj) w[jj] = lf[j * 4160 + (seg + jj) * 65 + r];
                u32x4 o; o.x = cvt_pk_bf16(w[0], w[1]); o.y = cvt_pk_bf16(w[2], w[3]); o.z = cvt_pk_bf16(w[4], w[5]); o.w = cvt_pk_bf16(w[6], w[7]);
                *(u32x4*)(dp_ + (size_t)r * ldd_ + seg) = o; }
        }
#undef P1_LOAD
#undef P1_DESC
    }
}
__device__ void ph_norm1(CtxK& c, LAS unsigned char* lds) {
    const int tid = ltid(), wg = blockIdx.x, G = gridDim.x, lane = tid & 63, wv = tid >> 6;
    LAS float* la = (LAS float*)lds;
    LAS float* lb_ = la + D;
    LAS float* lw = lb_ + D;
    for (int j = tid; j < D; j += 512) {
        float sh = c.b_ada[j], sc = c.b_ada[D + j];
#pragma unroll
        for (int p = 0; p < 4; ++p) { sh += c.modp[(size_t)p * 6 * D + j]; sc += c.modp[(size_t)p * 6 * D + D + j]; }
        la[j] = c.norm1_g[j] * (1.f + sc); lb_[j] = sh;
    }
    for (int j = wg * 512 + tid; j < 6 * D; j += G * 512) { float m = c.b_ada[j];
#pragma unroll
        for (int p = 0; p < 4; ++p) m += c.modp[(size_t)p * 6 * D + j];
        c.mod[j] = m; }
    for (int i = tid; i < D * 4; i += 512) { const int e = i >> 2, q = i & 3; const f32x4 w = *(const f32x4*)(c.w_in + (size_t)e * INW + WIN_GAB + q * 4);
        lw[(q * 4 + 0) * D + e] = w[0]; lw[(q * 4 + 1) * D + e] = w[1]; lw[(q * 4 + 2) * D + e] = w[2]; lw[(q * 4 + 3) * D + e] = w[3]; }
    __syncthreads();
    f32x4 vn[8];
    { const float* xr = c.x + (size_t)(wg * 8 + wv) * D;
#pragma unroll
      for (int i = 0; i < 8; ++i) vn[i] = *(const f32x4*)(xr + i * 256 + lane * 4); }
    for (int row = wg * 8 + wv; row < S; row += G * 8) {
        f32x4 v[8]; float ss = 0.f;
#pragma unroll
        for (int i = 0; i < 8; ++i) { v[i] = vn[i]; ss += v[i][0] * v[i][0] + v[i][1] * v[i][1] + v[i][2] * v[i][2] + v[i][3] * v[i][3]; }
        if (row + G * 8 < S) { const float* xr = c.x + (size_t)(row + G * 8) * D;
#pragma unroll
            for (int i = 0; i < 8; ++i) vn[i] = *(const f32x4*)(xr + i * 256 + lane * 4); }
        ss = wave_sum(ss); const float r = rsqrtf(ss * (1.f / D) + 1e-6f);
#pragma unroll
        for (int i = 0; i < 8; ++i) { const int e = i * 256 + lane * 4; const f32x4 a = *(LAS f32x4*)(la + e), b = *(LAS f32x4*)(lb_ + e); v[i] = v[i] * r * a + b;
            u32x2 w; w.x = cvt_pk_bf16(v[i][0], v[i][1]); w.y = cvt_pk_bf16(v[i][2], v[i][3]); *(u32x2*)(c.h1 + (size_t)row * D + e) = w; }
        float mine = 0.f;
        for (int cc = 0; cc < 16; ++cc) { float d = 0.f;
#pragma unroll
            for (int i = 0; i < 8; ++i) { const f32x4 w = *(LAS f32x4*)(lw + cc * D + i * 256 + lane * 4); d += v[i][0] * w[0] + v[i][1] * w[1] + v[i][2] * w[2] + v[i][3] * w[3]; }
            d = wave_sum(d); if (lane == cc) mine = d; }
        if (lane < 16) c.gab[(size_t)row * 16 + lane] = mine;
    }
    { const int id = wg * 512 + tid, i = id >> 6, e = id & 63;
      if (id < D * 64) {
          float sc = c.b_ada[4 * D + i];
#pragma unroll
          for (int p = 0; p < 4; ++p) sc += c.modp[(size_t)p * 6 * D + 4 * D + i];
          const float w = c.norm2_g[i] * (1.f + sc) * c.w_router[id];
          const unsigned hi = cvt_pk_bf16(w, w) & 0xffffu; const float lo = w - __uint_as_float(hi << 16);
          const int ch = i >> 7, kk = i & 127;
          c.rwimg[((ch * 2 + 0) * 64 + e) * 136 + kk] = (bf16_t)hi; c.rwimg[((ch * 2 + 1) * 64 + e) * 136 + kk] = (bf16_t)(cvt_pk_bf16(lo, lo) & 0xffffu);
      } }
    if (wg < 64) {
        __syncthreads();
        float a = 0.f;
        for (int i = tid; i < D; i += 512) { float sh = c.b_ada[3 * D + i];
#pragma unroll
            for (int p = 0; p < 4; ++p) sh += c.modp[(size_t)p * 6 * D + 3 * D + i];
            a += sh * c.w_router[i * 64 + wg]; }
        a = wave_sum(a); if (lane == 0) la[wv] = a; __syncthreads();
        if (tid == 0) c.rbias2[wg] = la[0] + la[1] + la[2] + la[3] + la[4] + la[5] + la[6] + la[7];
    }
}
__device__ void ph_gemm1(CtxK& c, LAS unsigned char* lds) {
    gm::DenseSched Sd; Sd.init(S, PW, D, D, c.win_t, nullptr, 1); gm::EpiProj E{c.proj};
    gm::gphase(lds, (const char*)c.h1, D, Sd, E);
}
__device__ void ph_gemm2(CtxK& c, LAS unsigned char* lds) {
    gm::DenseSched Sd; Sd.init(S, D, 1024, 2048, c.wa_t, c.wb_t, 2); gm::EpiMerge E{c.proj, c.merged};
    gm::gphase(lds, (const char*)c.ocat, 1024, Sd, E);
}
__device__ void ph_gemm3(CtxK& c, LAS unsigned char* lds) {
    gm::DenseSched Sd; Sd.init(S, D, D, D, c.wout_t, nullptr, 1); gm::EpiResid E{c.x, c.mod + 2 * D, c.out};
    gm::gphase(lds, (const char*)c.merged, D, Sd, E);
}
__device__ void ph_moe_gu(CtxK& c, LAS unsigned char* lds) {
    gm::MoeSched<true, 4, D / 2, D / 2, (size_t)1024 * D> Sm; Sm.init(lds, c.nent, c.blk_row, c.blk_exp, c.tok_p, c.gu_t); gm::EpiSwiglu E{c.hid};
    gm::gphase(lds, (const char*)c.h2, D / 2, Sm, E);
}
__device__ void ph_moe_dn(CtxK& c, LAS unsigned char* lds) {
    gm::MoeSched<false, 8, FF / 2, FF / 2, (size_t)D * FF> Sm; Sm.init(lds, c.nent, c.blk_row, c.blk_exp, c.tok_p, c.dn_t); gm::EpiDown E{c.Y, c.w_p};
    gm::gphase(lds, (const char*)c.hid, FF / 2, Sm, E);
}
__device__ void ph_cvt_exp(CtxK& c, LAS unsigned char* lds) {
    LAS float* lf = (LAS float*)lds; const int wg = blockIdx.x - 8, G = gridDim.x - 8;
    if (wg < 0) return;
    const int tid = ltid(), kr = tid >> 6, cl = tid & 63, r = tid >> 3, seg = (tid & 7) * 8;
    constexpr int NG_GU = NEX * 128, NGRP = NEX * 192;
    float v[4][8];
#define CE_DESC(q_) const float* sp_; unsigned char* dp_; int ld_, ldd_, js_, jd_, mode_; float scale_; { const int gq_ = (q_); \
        if (gq_ < NG_GU) { const int e = gq_ >> 7, rr = gq_ & 127, ng = rr >> 5, kt = rr & 31; const float* sg = e < NE ? c.w_eg + (size_t)e * D * FF : c.w_sg; const float* su = e < NE ? c.w_eu + (size_t)e * D * FF : c.w_su; \
            sp_ = (cl >= 32 ? su + cl - 32 : sg + cl) + (size_t)kt * 64 * FF + ng * 128; ld_ = FF; js_ = 32; dp_ = c.gu_t + ((size_t)e * 1024 + ng * 256) * D + kt * 64; ldd_ = D; jd_ = 64 * D; mode_ = 1; scale_ = 64.f; } \
        else { const int q2 = gq_ - NG_GU, e = q2 >> 6, rr = q2 & 63, ng = rr >> 3, kt = rr & 7; const float* sd = e < NE ? c.w_ed + (size_t)e * FF * D : c.w_sd; \
            sp_ = sd + cl + (size_t)kt * 64 * D + ng * 256; ld_ = D; js_ = 64; dp_ = c.dn_t + (size_t)e * D * FF + (size_t)ng * 256 * FF + kt * 64; ldd_ = FF; jd_ = 64 * FF; mode_ = 0; scale_ = 32.f; } }
#define CE_LOAD(q_) do { CE_DESC(q_) (void)dp_; (void)ldd_; (void)jd_; (void)mode_; (void)scale_; \
        _Pragma("unroll") for (int j = 0; j < 4; ++j) _Pragma("unroll") for (int p = 0; p < 8; ++p) v[j][p] = sp_[(size_t)(p * 8 + kr) * ld_ + j * js_]; } while (0)
    if (wg < NGRP) CE_LOAD(wg);
    for (int q = wg; q < NGRP; q += G) {
        CE_DESC(q) (void)sp_; (void)ld_; (void)js_;
        __syncthreads();
#pragma unroll
        for (int j = 0; j < 4; ++j)
#pragma unroll
            for (int p = 0; p < 8; ++p) lf[j * 4160 + (p * 8 + kr) * 65 + cl] = v[j][p] * scale_;
        __syncthreads();
        if (q + G < NGRP) CE_LOAD(q + G);
        const int lc = mode_ == 1 ? (((r >> 2) & 1) * 32 + 4 * (r >> 3) + (r & 3)) : r;
#pragma unroll
        for (int j = 0; j < 4; ++j) { float w[8];
#pragma unroll
            for (int jj = 0; jj < 8; ++jj) w[jj] = lf[j * 4160 + (seg + jj) * 65 + lc];
            *(u32x2*)(dp_ + (size_t)j * jd_ + (size_t)r * ldd_ + seg) = (u32x2){cvt4_fp8(w[0], w[1], w[2], w[3]), cvt4_fp8(w[4], w[5], w[6], w[7])}; }
    }
#undef CE_LOAD
#undef CE_DESC
}
__device__ void ph_final(CtxK& c, LAS unsigned char* lds) {
    const int tid = ltid(), wg = blockIdx.x, G = gridDim.x, lane = tid & 63, wv = tid >> 6;
    const float* gt2 = c.mod + 5 * D;
    for (int row0 = (wg * 8 + wv) * 2; row0 < S; row0 += G * 16) {
        int p[2][9];
#pragma unroll
        for (int rr = 0; rr < 2; ++rr) {
#pragma unroll
            for (int k = 0; k < 8; ++k) p[rr][k] = c.pos[(row0 + rr) * TOPK + k];
            p[rr][8] = PROUTED + row0 + rr; }
        f32x4 v[2][4][2]; float ss[2] = {0.f, 0.f};
#pragma unroll
        for (int rr = 0; rr < 2; ++rr) {
#pragma unroll
            for (int i = 0; i < 4; ++i) {
                const int e = i * 512 + lane * 8; f32x4 a0 = {0.f, 0.f, 0.f, 0.f}, a1 = {0.f, 0.f, 0.f, 0.f};
#pragma unroll
                for (int k = 0; k < 9; ++k) { const u32x2 y = *(const u32x2*)(c.Y + (size_t)p[rr][k] * D + e);
                    const auto q0 = __builtin_amdgcn_cvt_pk_f32_fp8((int)y.x, false), q1 = __builtin_amdgcn_cvt_pk_f32_fp8((int)y.x, true), q2 = __builtin_amdgcn_cvt_pk_f32_fp8((int)y.y, false), q3 = __builtin_amdgcn_cvt_pk_f32_fp8((int)y.y, true);
                    a0[0] += q0[0]; a0[1] += q0[1]; a0[2] += q1[0]; a0[3] += q1[1]; a1[0] += q2[0]; a1[1] += q2[1]; a1[2] += q3[0]; a1[3] += q3[1]; }
                const float* xp = c.out + (size_t)(row0 + rr) * D + e;
                const f32x4 x0 = *(const f32x4*)xp, x1 = *(const f32x4*)(xp + 4), g0 = *(const f32x4*)(gt2 + e) * 0.0625f, g1 = *(const f32x4*)(gt2 + e + 4) * 0.0625f;
                v[rr][i][0] = x0 + g0 * a0; v[rr][i][1] = x1 + g1 * a1;
#pragma unroll
                for (int j = 0; j < 4; ++j) ss[rr] += v[rr][i][0][j] * v[rr][i][0][j] + v[rr][i][1][j] * v[rr][i][1][j];
            } }
#pragma unroll
        for (int rr = 0; rr < 2; ++rr) {
            const float r = rsqrtf(wave_sum_dpp(ss[rr]) * (1.f / D) + 1e-6f);
#pragma unroll
            for (int i = 0; i < 4; ++i) { const int e = i * 512 + lane * 8; float* op = c.out + (size_t)(row0 + rr) * D + e;
                *(f32x4*)op = v[rr][i][0] * r * *(const f32x4*)(c.normf_g + e); *(f32x4*)(op + 4) = v[rr][i][1] * r * *(const f32x4*)(c.normf_g + e + 4); } }
    }
}

namespace mx {
constexpr int ST128 = 272, ST64 = 144;
constexpr int FRAG_F4 = 8 * 8 * 64;
__device__ __forceinline__ f32x4 mfma16(bf16x8 a, bf16x8 b, f32x4 c) { return __builtin_amdgcn_mfma_f32_16x16x32_bf16(a, b, c, 0, 0, 0); }
template <int MT, int KS>
__device__ __forceinline__ void mma_nt(f32x4 (&acc)[MT], LAS const unsigned char* xs, int sx, LAS const unsigned char* ys, int sy, int fr, int fq) {
#pragma unroll
    for (int kk = 0; kk < KS; ++kk) {
        const bf16x8 b = *(const LAS bf16x8*)(ys + fr * sy + (kk * 32 + fq * 8) * 2);
#pragma unroll
        for (int m = 0; m < MT; ++m) { const bf16x8 a = *(const LAS bf16x8*)(xs + (16 * m + fr) * sx + (kk * 32 + fq * 8) * 2); acc[m] = mfma16(a, b, acc[m]); }
    }
}
__device__ __forceinline__ void lds_fence() { asm volatile("s_waitcnt lgkmcnt(0)" ::: "memory"); }
__device__ __forceinline__ u32x4 pack8(const float (&v)[8]) { u32x4 o; o.x = cvt_pk_bf16(v[0], v[1]); o.y = cvt_pk_bf16(v[2], v[3]); o.z = cvt_pk_bf16(v[4], v[5]); o.w = cvt_pk_bf16(v[6], v[7]); return o; }
__device__ __forceinline__ void unpack8(const u32x4 w, float (&v)[8]) { v[0] = bflo(w.x); v[1] = bfhi(w.x); v[2] = bflo(w.y); v[3] = bfhi(w.y); v[4] = bflo(w.z); v[5] = bfhi(w.z); v[6] = bflo(w.w); v[7] = bfhi(w.w); }
__device__ __forceinline__ void mfma_pad8(f32x4 (&a)[8]) { asm volatile("s_nop 15\n\ts_nop 7" : "+v"(a[0]), "+v"(a[1]), "+v"(a[2]), "+v"(a[3]), "+v"(a[4]), "+v"(a[5]), "+v"(a[6]), "+v"(a[7])); }
__device__ __forceinline__ void mfma_pad4(f32x4 (&a)[4]) { asm volatile("s_nop 15\n\ts_nop 7" : "+v"(a[0]), "+v"(a[1]), "+v"(a[2]), "+v"(a[3])); }
__device__ __forceinline__ void write_st(LAS unsigned char* stw, f32x4 (&S)[8], int fr, int fq) {
    mfma_pad8(S);
#pragma unroll
    for (int m = 0; m < 8; ++m) { u32x2 w; w.x = cvt_pk_bf16(S[m][0], S[m][1]); w.y = cvt_pk_bf16(S[m][2], S[m][3]); *(LAS u32x2*)(stw + fr * ST128 + (16 * m + 4 * fq) * 2) = w; }
}

__device__ __forceinline__ void gate_issue(u32x4 (&gp)[2], const bf16_t* gate0) {
    const int t_ = ltid(); const bf16_t* p = gate0 + (size_t)(t_ >> 3) * PW + (t_ & 7) * 16;
    gp[0] = *(const u32x4*)p; gp[1] = *(const u32x4*)(p + 8);
}
__device__ __forceinline__ void out_stage(LAS unsigned char* ot, LAS float* part, const f32x4 (&o)[4], const u32x4 (&gp)[2], const float* gnorm, bf16_t* out0, int wv, int lane, int fr, int fq) {
    float s_ = 0.f;
#pragma unroll
    for (int w = 0; w < 8; ++w) s_ += part[w * 64 + lane];
    const float rv = rsqrtf(s_ * (1.f / 128.f) + 1e-6f);
    const float gn = gnorm[wv * 16 + fr];
#pragma unroll
    for (int m = 0; m < 4; ++m)
#pragma unroll
        for (int r = 0; r < 4; ++r) { const int cc = 16 * m + 4 * fq + r; const float x = o[m][r] * __shfl(rv, cc) * gn;
            *(LAS bf16_t*)(ot + cc * ST128 + (wv * 16 + fr) * 2) = (bf16_t)(cvt_pk_bf16(x, x) & 0xffffu); }
    __syncthreads();
    const int t_ = ltid(), cc = t_ >> 3, sg = (t_ & 7) * 16;
#pragma unroll
    for (int hh = 0; hh < 2; ++hh) { float ov[8], gv[8];
        unpack8(*(LAS u32x4*)(ot + cc * ST128 + (sg + hh * 8) * 2), ov); unpack8(gp[hh], gv);
#pragma unroll
        for (int j = 0; j < 8; ++j) ov[j] *= siluf_(gv[j]);
        *(u32x4*)(out0 + (size_t)cc * D + sg + hh * 8) = pack8(ov); }
}

constexpr int H_QT = 0, H_KT = 17408, H_QI = 34816, H_KU = 52224, H_VT = 70656, H_P = 89088, H_DEC = 98304, H_OCT = 98816, H_F4 = H_OCT + 8192, H_PART = H_F4 + 512, H_RINV = H_PART + 2048, H_ST = H_RINV + 256, H_LB = H_ST + 8 * 16 * ST128, H_END = H_LB + 512;
static_assert(H_END <= 147456, "hgrn lds");
template <bool OUT>
__device__ void hgrn_pass(CtxK& c, LAS unsigned char* lds) {
    const int tid = ltid(), wv = __builtin_amdgcn_readfirstlane(tid >> 6), lane = tid & 63, fr = lane & 15, fq = lane >> 4;
    LAS float* dec = (LAS float*)(lds + H_DEC); LAS float* oct = (LAS float*)(lds + H_OCT); LAS float* f4 = (LAS float*)(lds + H_F4);
    LAS float* part = (LAS float*)(lds + H_PART); LAS float* rinv = (LAS float*)(lds + H_RINV);
    LAS unsigned char* stw = lds + H_ST + wv * 16 * ST128;
    {
        const int wu = blockIdx.x, h = wu & 7, g = wu >> 3;
        f32x4 Sacc[8];
#pragma unroll
        for (int m = 0; m < 8; ++m) Sacc[m] = (f32x4){0.f, 0.f, 0.f, 0.f};
        if (OUT) {
            if (g > 0) { const f32x4* sp = (const f32x4*)c.hS + (size_t)(h * 32 + g) * FRAG_F4 + (wv * 8) * 64 + lane;
#pragma unroll
                for (int m = 0; m < 8; ++m) Sacc[m] = sp[m * 64]; }
            write_st(stw, Sacc, fr, fq);
        }
        LAS float* lbs = (LAS float*)(lds + H_LB);
        if (tid < 128) lbs[tid] = c.lb[h * 128 + tid];
        __syncthreads();
        float dsum = 0.f;
        u32x4 pf[4], pv[4];
#define HP_ISSUE(i_) do { const int tq_ = ltid(), rl_ = tq_ >> 8; const bf16_t* b_ = c.proj + (size_t)((g * 8 + (i_)) * 64 + ((tq_ >> 4) & 15) * 4) * PW + h * 128 + (tq_ & 15) * 8; \
        if (rl_ == 1 || OUT) { _Pragma("unroll") for (int tt = 0; tt < 4; ++tt) pf[tt] = *(const u32x4*)(b_ + (size_t)tt * PW + C_HF); } \
        if (rl_ == 0) { _Pragma("unroll") for (int tt = 0; tt < 4; ++tt) pv[tt] = *(const u32x4*)(b_ + (size_t)tt * PW + C_HI); } } while (0)
        HP_ISSUE(0);
        for (int i = 0; i < 8; ++i) {
            const int T0 = (g * 8 + i) * 64;
            const int tp = ltid(), role = tp >> 8, tq = (tp >> 4) & 15, co = tp & 15, c0 = tq * 4, d0 = co * 8;
            const bool cum = role == 1 || OUT;
            float cs[4][8];
            if (cum) {
                float lbv[8];
                { const f32x4 l0 = *(LAS f32x4*)(lbs + d0), l1 = *(LAS f32x4*)(lbs + d0 + 4);
                  lbv[0] = l0[0]; lbv[1] = l0[1]; lbv[2] = l0[2]; lbv[3] = l0[3]; lbv[4] = l1[0]; lbv[5] = l1[1]; lbv[6] = l1[2]; lbv[7] = l1[3]; }
#pragma unroll
                for (int tt = 0; tt < 4; ++tt) {
                    float fv[8]; unpack8(pf[tt], fv);
#pragma unroll
                    for (int j = 0; j < 8; ++j) { const float lf = __logf(lbv[j] + (1.f - lbv[j]) * sigmoidf_(fv[j])); cs[tt][j] = tt ? cs[tt - 1][j] + lf : lf; }
                }
                if (role == 1) {
                    *(LAS f32x4*)(oct + tq * 128 + d0) = (f32x4){cs[3][0], cs[3][1], cs[3][2], cs[3][3]}; *(LAS f32x4*)(oct + tq * 128 + d0 + 4) = (f32x4){cs[3][4], cs[3][5], cs[3][6], cs[3][7]};
                    if (tq == 8) { *(LAS f32x4*)(f4 + d0) = (f32x4){cs[0][0], cs[0][1], cs[0][2], cs[0][3]}; *(LAS f32x4*)(f4 + d0 + 4) = (f32x4){cs[0][4], cs[0][5], cs[0][6], cs[0][7]}; }
                }
            }
            if (role == 0) {
#pragma unroll
                for (int j = 0; j < 8; j += 2) { const int wi = j >> 1; u32x2 w0, w1;
                    const unsigned a0 = wi == 0 ? pv[0].x : wi == 1 ? pv[0].y : wi == 2 ? pv[0].z : pv[0].w, a1 = wi == 0 ? pv[1].x : wi == 1 ? pv[1].y : wi == 2 ? pv[1].z : pv[1].w;
                    const unsigned a2 = wi == 0 ? pv[2].x : wi == 1 ? pv[2].y : wi == 2 ? pv[2].z : pv[2].w, a3 = wi == 0 ? pv[3].x : wi == 1 ? pv[3].y : wi == 2 ? pv[3].z : pv[3].w;
                    w0.x = (a0 & 0xffffu) | (a1 << 16); w0.y = (a2 & 0xffffu) | (a3 << 16);
                    w1.x = (a0 >> 16) | (a1 & 0xffff0000u); w1.y = (a2 >> 16) | (a3 & 0xffff0000u);
                    *(LAS u32x2*)(lds + H_VT + (d0 + j) * ST64 + c0 * 2) = w0; *(LAS u32x2*)(lds + H_VT + (d0 + j + 1) * ST64 + c0 * 2) = w1; }
            }
            __syncthreads();
            if (cum) {
                float pre[8], tot[8], bmid[8];
#pragma unroll
                for (int j = 0; j < 8; ++j) { pre[j] = 0.f; tot[j] = 0.f; bmid[j] = 0.f; }
#pragma unroll
                for (int o = 0; o < 16; ++o) { const f32x4 x0 = *(LAS f32x4*)(oct + o * 128 + d0), x1 = *(LAS f32x4*)(oct + o * 128 + d0 + 4);
#pragma unroll
                    for (int j = 0; j < 8; ++j) { const float x = j < 4 ? x0[j] : x1[j - 4]; pre[j] += o < tq ? x : 0.f; bmid[j] += o < 8 ? x : 0.f; tot[j] += x; } }
                { const f32x4 x0 = *(LAS f32x4*)(f4 + d0), x1 = *(LAS f32x4*)(f4 + d0 + 4);
#pragma unroll
                  for (int j = 0; j < 8; ++j) bmid[j] += j < 4 ? x0[j] : x1[j - 4]; }
                if (role == 0) {
                    float ebm[8];
#pragma unroll
                    for (int j = 0; j < 8; ++j) ebm[j] = __expf(bmid[j]);
#pragma unroll
                    for (int tt = 0; tt < 4; ++tt) {
                        float qv[8], q1[8], q2[8];
                        unpack8(*(const u32x4*)(c.proj + (size_t)(T0 + c0 + tt) * PW + C_HQ + h * 128 + d0), qv);
#pragma unroll
                        for (int j = 0; j < 8; ++j) { const float q = siluf_(qv[j]) * 0.08838834764831845f; q1[j] = q * __expf(pre[j] + cs[tt][j] - bmid[j]); q2[j] = q1[j] * ebm[j]; }
                        *(LAS u32x4*)(lds + H_QT + (c0 + tt) * ST128 + d0 * 2) = pack8(q1); *(LAS u32x4*)(lds + H_QI + (c0 + tt) * ST128 + d0 * 2) = pack8(q2);
                    }
                } else {
                    if (tq == 0) {
#pragma unroll
                        for (int j = 0; j < 8; ++j) dec[d0 + j] = __expf(tot[j]);
                    }
                    if (OUT) {
#pragma unroll
                        for (int tt = 0; tt < 4; ++tt) {
                            float k1[8];
#pragma unroll
                            for (int j = 0; j < 8; ++j) { const float lf = tt ? cs[tt][j] - cs[tt - 1][j] : cs[0][j]; k1[j] = (1.f - __expf(lf)) * __expf(bmid[j] - pre[j] - cs[tt][j]); }
                            *(LAS u32x4*)(lds + H_KT + (c0 + tt) * ST128 + d0 * 2) = pack8(k1);
                        }
                    }
#pragma unroll
                    for (int j = 0; j < 8; ++j) { float col[4];
#pragma unroll
                        for (int tt = 0; tt < 4; ++tt) { const float lf = tt ? cs[tt][j] - cs[tt - 1][j] : cs[0][j]; col[tt] = (1.f - __expf(lf)) * __expf(tot[j] - pre[j] - cs[tt][j]); }
                        u32x2 w; w.x = cvt_pk_bf16(col[0], col[1]); w.y = cvt_pk_bf16(col[2], col[3]);
                        *(LAS u32x2*)(lds + H_KU + (d0 + j) * ST64 + c0 * 2) = w; }
                }
            }
            __syncthreads();
            if (i + 1 < 8) HP_ISSUE(i + 1);
            u32x4 gpre[2];
            if (OUT) gate_issue(gpre, c.proj + (size_t)T0 * PW + C_HG + h * 128);
            if (!OUT && tid < 128) dsum += __logf(dec[tid]);
            f32x4 oacc[4];
            if (OUT) {
                { f32x4 sc[2] = {(f32x4){0.f, 0.f, 0.f, 0.f}, (f32x4){0.f, 0.f, 0.f, 0.f}};
                  const int nt = wv & 3, mb = (wv >> 2) * 2;
                  mma_nt<2, 4>(sc, lds + H_KT + mb * 16 * ST128, ST128, lds + H_QT + nt * 16 * ST128, ST128, fr, fq);
#pragma unroll
                  for (int m = 0; m < 2; ++m) { const int cc = nt * 16 + fr, s0 = (mb + m) * 16 + 4 * fq; u32x2 w;
                      w.x = cvt_pk_bf16(s0 + 0 <= cc ? sc[m][0] : 0.f, s0 + 1 <= cc ? sc[m][1] : 0.f); w.y = cvt_pk_bf16(s0 + 2 <= cc ? sc[m][2] : 0.f, s0 + 3 <= cc ? sc[m][3] : 0.f);
                      *(LAS u32x2*)(lds + H_P + cc * ST64 + s0 * 2) = w; } }
                __syncthreads();
#pragma unroll
                for (int m = 0; m < 4; ++m) oacc[m] = (f32x4){0.f, 0.f, 0.f, 0.f};
                mma_nt<4, 2>(oacc, lds + H_P, ST64, lds + H_VT + wv * 16 * ST64, ST64, fr, fq);
                mma_nt<4, 4>(oacc, lds + H_QI, ST128, stw, ST128, fr, fq);
#pragma unroll
                for (int m = 0; m < 4; ++m)
#pragma unroll
                    for (int r = 0; r < 4; ++r) { float q = oacc[m][r] * oacc[m][r]; q += __shfl_xor(q, 1); q += __shfl_xor(q, 2); q += __shfl_xor(q, 4); q += __shfl_xor(q, 8); if (fr == 0) part[wv * 64 + 16 * m + 4 * fq + r] = q; }
            }
#pragma unroll
            for (int m = 0; m < 8; ++m) { const f32x4 dv = *(LAS f32x4*)(dec + 16 * m + 4 * fq); Sacc[m] = Sacc[m] * dv; }
            mma_nt<8, 2>(Sacc, lds + H_KU, ST64, lds + H_VT + wv * 16 * ST64, ST64, fr, fq);
            if (OUT) {
                lds_fence();
                write_st(stw, Sacc, fr, fq);
                __syncthreads();
                out_stage(lds + H_QT, part, oacc, gpre, c.hgrn_onorm_g, c.ocat + (size_t)T0 * D + h * 128, wv, lane, fr, fq);
            }
            __syncthreads();
        }
#undef HP_ISSUE
        if (!OUT) {
            f32x4* sp = (f32x4*)c.hL + (size_t)(h * 32 + g) * FRAG_F4 + (wv * 8) * 64 + lane;
#pragma unroll
            for (int m = 0; m < 8; ++m) sp[m * 64] = Sacc[m];
            if (tid < 128) c.hD[(h * 32 + g) * 128 + tid] = __expf(dsum);
        }
    }
}
__device__ void hgrn_scan(CtxK& c) {
    const int e = blockIdx.x * 512 + ltid();
    if (e >= 8 * FRAG_F4) return;
    const int h = e / FRAG_F4, fi = e % FRAG_F4, m = (fi >> 6) & 7, lane = fi & 63, d0 = 16 * m + 4 * (lane >> 4);
    f32x4 s = {0.f, 0.f, 0.f, 0.f};
    for (int g0 = 0; g0 < 31; g0 += 8) {
        f32x4 dc[8], hl[8];
#pragma unroll
        for (int u = 0; u < 8; ++u) if (g0 + u < 31) { dc[u] = *(const f32x4*)(c.hD + (h * 32 + g0 + u) * 128 + d0); hl[u] = ((const f32x4*)c.hL)[(size_t)(h * 32 + g0 + u) * FRAG_F4 + fi]; }
#pragma unroll
        for (int u = 0; u < 8; ++u) if (g0 + u < 31) { s = s * dc[u] + hl[u]; ((f32x4*)c.hS)[(size_t)(h * 32 + g0 + u + 1) * FRAG_F4 + fi] = s; }
    }
}

constexpr int B_T = 0, B_KBG = 9216, B_KU = 26624, B_VB = 45056, B_QD = 63488, B_AT = 80896, B_SC = 90112, BLOB = 90368;
constexpr int G_ST = BLOB, G_RV = G_ST + 8 * 16 * ST128, G_PART = G_RV + 8 * 16 * ST64, G_RINV = G_PART + 2048, G_END = G_RINV + 256;
static_assert(G_END <= 147456, "gdn lds");
constexpr int P_K = 0, P_Q = 17408, P_BETA = 34816, P_GC = P_BETA + 256, P_EG = P_GC + 256, P_EK = P_EG + 256;

__device__ void gdn_prep(CtxK& c, LAS unsigned char* lds, int h, int g) {
    const int tid = ltid(), wv = __builtin_amdgcn_readfirstlane(tid >> 6), lane = tid & 63, fr = lane & 15, fq = lane >> 4;
    LAS float* sbeta = (LAS float*)(lds + P_BETA); LAS float* sgc = (LAS float*)(lds + P_GC); LAS float* seg = (LAS float*)(lds + P_EG); LAS float* sek = (LAS float*)(lds + P_EK);
    u32x4 raw[11];
#define GR_ISSUE(i_) do { const int tq_ = ltid(); if (tq_ < 384) { const int T_ = (g * 8 + (i_)) * 64 + ((tq_ >> 4) & 7) * 8 - 3; const bf16_t* b_ = c.proj + C_GQKV + (tq_ >> 7) * 1024 + h * 128 + (tq_ & 15) * 8; \
        _Pragma("unroll") for (int r = 0; r < 11; ++r) raw[r] = T_ + r >= 0 ? *(const u32x4*)(b_ + (size_t)(T_ + r) * PW) : (u32x4){0u, 0u, 0u, 0u}; } } while (0)
    GR_ISSUE(0);
    for (int i = 0; i < 8; ++i) {
        const int n = g * 8 + i, T0 = n * 64;
        unsigned char* blob = (unsigned char*)c.gBlob + (size_t)(h * 256 + n) * BLOB;
        if (wv == 0) {
            const float ga = c.gab[(size_t)(T0 + lane) * 16 + h], gb = c.gab[(size_t)(T0 + lane) * 16 + 8 + h];
            const float gl_ = -__expf(c.a_log[h]) * softplusf_(ga + c.dt_bias[h]);
            float gc = gl_;
#pragma unroll
            for (int o = 1; o < 64; o <<= 1) { const float t_ = __shfl_up(gc, o); if (lane >= o) gc += t_; }
            const float glast = __shfl(gc, 63);
            sbeta[lane] = sigmoidf_(gb); sgc[lane] = gc; seg[lane] = __expf(gc); sek[lane] = __expf(glast - gc);
            if (lane == 0) *(float*)(blob + B_SC) = __expf(glast);
        }
        __syncthreads();
        const int tp = ltid(), part = tp >> 7, to = (tp >> 4) & 7, co = tp & 15, c0 = to * 8, d0 = co * 8;
        if (tp < 384) {
            const int chb = part * 1024 + h * 128 + d0;
            float val[8][8];
            {
                float wj[4][8];
#pragma unroll
                for (int j = 0; j < 4; ++j) { const f32x4 a = *(const f32x4*)(c.conv_w + j * 3072 + chb), b = *(const f32x4*)(c.conv_w + j * 3072 + chb + 4);
                    wj[j][0] = a[0]; wj[j][1] = a[1]; wj[j][2] = a[2]; wj[j][3] = a[3]; wj[j][4] = b[0]; wj[j][5] = b[1]; wj[j][6] = b[2]; wj[j][7] = b[3]; }
#pragma unroll
                for (int tt = 0; tt < 8; ++tt) {
                    float a[8] = {0.f, 0.f, 0.f, 0.f, 0.f, 0.f, 0.f, 0.f};
#pragma unroll
                    for (int j = 0; j < 4; ++j) { float xv[8]; unpack8(raw[tt + j], xv);
#pragma unroll
                        for (int jj = 0; jj < 8; ++jj) a[jj] += wj[j][jj] * xv[jj]; }
#pragma unroll
                    for (int jj = 0; jj < 8; ++jj) val[tt][jj] = siluf_(a[jj]);
                }
            }
            if (part < 2) {
#pragma unroll
                for (int tt = 0; tt < 8; ++tt) { float ss = 0.f;
#pragma unroll
                    for (int jj = 0; jj < 8; ++jj) ss += val[tt][jj] * val[tt][jj];
                    ss += __shfl_xor(ss, 1); ss += __shfl_xor(ss, 2); ss += __shfl_xor(ss, 4); ss += __shfl_xor(ss, 8);
                    const float rn = rsqrtf(ss + 1e-6f) * (part == 0 ? 0.08838834764831845f : 1.f);
#pragma unroll
                    for (int jj = 0; jj < 8; ++jj) val[tt][jj] *= rn; }
            }
            if (part == 0) {
#pragma unroll
                for (int tt = 0; tt < 8; ++tt) { const int cc = c0 + tt; *(LAS u32x4*)(lds + P_Q + cc * ST128 + d0 * 2) = pack8(val[tt]);
                    const float e = seg[cc]; float qd[8];
#pragma unroll
                    for (int jj = 0; jj < 8; ++jj) qd[jj] = val[tt][jj] * e;
                    *(u32x4*)(blob + B_QD + cc * ST128 + d0 * 2) = pack8(qd); }
            } else if (part == 1) {
#pragma unroll
                for (int tt = 0; tt < 8; ++tt) { const int cc = c0 + tt; *(LAS u32x4*)(lds + P_K + cc * ST128 + d0 * 2) = pack8(val[tt]);
                    const float e = seg[cc] * sbeta[cc]; float kb[8];
#pragma unroll
                    for (int jj = 0; jj < 8; ++jj) kb[jj] = val[tt][jj] * e;
                    *(u32x4*)(blob + B_KBG + cc * ST128 + d0 * 2) = pack8(kb); }
#pragma unroll
                for (int jj = 0; jj < 8; ++jj) { float col[8];
#pragma unroll
                    for (int tt = 0; tt < 8; ++tt) col[tt] = val[tt][jj] * sek[c0 + tt];
                    *(u32x4*)(blob + B_KU + (d0 + jj) * ST64 + c0 * 2) = pack8(col); }
            } else {
#pragma unroll
                for (int jj = 0; jj < 8; ++jj) { float col[8];
#pragma unroll
                    for (int tt = 0; tt < 8; ++tt) col[tt] = val[tt][jj] * sbeta[c0 + tt];
                    *(u32x4*)(blob + B_VB + (d0 + jj) * ST64 + c0 * 2) = pack8(col); }
            }
        }
        __syncthreads();
        if (i + 1 < 8) GR_ISSUE(i + 1);
        {
            const int nt = wv & 3, mb = (wv >> 2) * 2, jj = nt * 16 + fr;
            f32x4 kk2[2] = {(f32x4){0.f, 0.f, 0.f, 0.f}, (f32x4){0.f, 0.f, 0.f, 0.f}}, at2[2] = {(f32x4){0.f, 0.f, 0.f, 0.f}, (f32x4){0.f, 0.f, 0.f, 0.f}};
            mma_nt<2, 4>(kk2, lds + P_K + mb * 16 * ST128, ST128, lds + P_K + nt * 16 * ST128, ST128, fr, fq);
            mma_nt<2, 4>(at2, lds + P_K + mb * 16 * ST128, ST128, lds + P_Q + nt * 16 * ST128, ST128, fr, fq);
            float* at = c.gAT + (size_t)(h * 256 + n) * 4096;
            const float gj = sgc[jj];
#pragma unroll
            for (int m = 0; m < 2; ++m) { const int i0 = (mb + m) * 16 + 4 * fq; f32x4 av; float pv[4];
#pragma unroll
                for (int r = 0; r < 4; ++r) { const int ii = i0 + r; const float gi = sgc[ii];
                    av[r] = jj < ii ? sbeta[ii] * kk2[m][r] * __expf(gi - gj) : 0.f;
                    pv[r] = ii <= jj ? at2[m][r] * __expf(gj - gi) : 0.f; }
                *(f32x4*)(at + jj * 64 + i0) = av;
                u32x2 w; w.x = cvt_pk_bf16(pv[0], pv[1]); w.y = cvt_pk_bf16(pv[2], pv[3]);
                *(u32x2*)(blob + B_AT + jj * ST64 + i0 * 2) = w; }
        }
        __syncthreads();
    }
}
__device__ void gdn_invert(CtxK& c, LAS unsigned char* lds, int h, int g) {
    const int tid = ltid(), wv = __builtin_amdgcn_readfirstlane(tid >> 6), lane = tid & 63;
    const int n = g * 8 + wv;
    LAS float* at = (LAS float*)(lds + wv * 16384);
    const float* src = c.gAT + (size_t)(h * 256 + n) * 4096;
#pragma unroll
    for (int k = 0; k < 16; ++k) *(LAS f32x4*)(at + (k * 64 + lane) * 4) = *(const f32x4*)(src + (k * 64 + lane) * 4);
    lds_fence();
    float r[64];
    unsigned ata = (unsigned)(size_t)at;
#pragma unroll
    for (int j = 63; j >= 0; --j) {
        float acc = lane == j ? 1.f : 0.f;
        LAS const float* arow = (LAS const float*)(size_t)ata + j * 64;
#pragma unroll
        for (int m4 = ((j + 1) & ~3); m4 < 64; m4 += 4) {
            const f32x4 a = *(LAS const f32x4*)(arow + m4);
#pragma unroll
            for (int q = 0; q < 4; ++q) if (m4 + q > j) acc = __builtin_fmaf(-r[m4 + q], a[q], acc);
        }
        r[j] = acc;
        asm volatile("" : "+v"(ata) : "v"(acc));
    }
    unsigned char* blob = (unsigned char*)c.gBlob + (size_t)(h * 256 + n) * BLOB;
#pragma unroll
    for (int k = 0; k < 8; ++k) { float v8[8];
#pragma unroll
        for (int q = 0; q < 8; ++q) v8[q] = r[k * 8 + q];
        *(u32x4*)(blob + B_T + lane * ST64 + k * 16) = pack8(v8); }
}
template <int MODE>
__device__ void gdn_pass(CtxK& c, LAS unsigned char* lds, int h, int g) {
    const int tid = ltid(), wv = __builtin_amdgcn_readfirstlane(tid >> 6), lane = tid & 63, fr = lane & 15, fq = lane >> 4;
    LAS unsigned char* stw = lds + G_ST + wv * 16 * ST128; LAS unsigned char* rvw = lds + G_RV + wv * 16 * ST64;
    LAS float* part = (LAS float*)(lds + G_PART); LAS float* rinv = (LAS float*)(lds + G_RINV);
    f32x4 Sacc[8];
#pragma unroll
    for (int m = 0; m < 8; ++m) {
        if (MODE == 1) { const int v = 16 * wv + fr, d0 = 16 * m + 4 * fq; Sacc[m] = (f32x4){d0 == v ? 1.f : 0.f, d0 + 1 == v ? 1.f : 0.f, d0 + 2 == v ? 1.f : 0.f, d0 + 3 == v ? 1.f : 0.f}; }
        else Sacc[m] = (f32x4){0.f, 0.f, 0.f, 0.f};
    }
    if (MODE == 2 && g > 0) { const f32x4* sp = (const f32x4*)c.gS + (size_t)(h * 32 + g) * FRAG_F4 + (wv * 8) * 64 + lane;
#pragma unroll
        for (int m = 0; m < 8; ++m) Sacc[m] = sp[m * 64]; }
    write_st(stw, Sacc, fr, fq);
    constexpr int LIM = MODE == 2 ? B_SC : B_QD, NQ = (LIM + 8191) / 8192;
    u32x4 pre[NQ];
    const unsigned char* blob0 = (const unsigned char*)c.gBlob + (size_t)(h * 256 + g * 8) * BLOB;
#define GP_ISSUE(i_) do { const unsigned char* bp_ = blob0 + (size_t)(i_) * BLOB + ltid() * 16; _Pragma("unroll") for (int q = 0; q < NQ; ++q) if (q * 8192 + 8176 < LIM || ltid() * 16 + q * 8192 < LIM) pre[q] = *(const u32x4*)(bp_ + q * 8192); } while (0)
    GP_ISSUE(0);
    for (int i = 0; i < 8; ++i) {
        const int n = g * 8 + i, T0 = n * 64;
        { const int tl = ltid() * 16;
#pragma unroll
          for (int q = 0; q < NQ; ++q) if (q * 8192 + 8176 < LIM || tl + q * 8192 < LIM) *(LAS u32x4*)(lds + tl + q * 8192) = pre[q]; }
        const float dlast = *(const float*)(blob0 + (size_t)i * BLOB + B_SC);
        u32x4 gpre[2];
        if (MODE == 2) gate_issue(gpre, c.proj + (size_t)T0 * PW + C_GG + h * 128);
        __syncthreads();
        if (i + 1 < 8) GP_ISSUE(i + 1);
        { f32x4 R[4];
#pragma unroll
          for (int m = 0; m < 4; ++m) R[m] = (f32x4){0.f, 0.f, 0.f, 0.f};
          mma_nt<4, 4>(R, lds + B_KBG, ST128, stw, ST128, fr, fq);
#pragma unroll
          for (int m = 0; m < 4; ++m) { float x0 = 0.f, x1 = 0.f, x2 = 0.f, x3 = 0.f;
              if (MODE != 1) { const u32x2 vb = *(LAS u32x2*)(lds + B_VB + (16 * wv + fr) * ST64 + (16 * m + 4 * fq) * 2); x0 = bflo(vb.x); x1 = bfhi(vb.x); x2 = bflo(vb.y); x3 = bfhi(vb.y); }
              u32x2 w; w.x = cvt_pk_bf16(x0 - R[m][0], x1 - R[m][1]); w.y = cvt_pk_bf16(x2 - R[m][2], x3 - R[m][3]);
              *(LAS u32x2*)(rvw + fr * ST64 + (16 * m + 4 * fq) * 2) = w; } }
        lds_fence();
        { f32x4 VN[4];
#pragma unroll
          for (int m = 0; m < 4; ++m) VN[m] = (f32x4){0.f, 0.f, 0.f, 0.f};
          mma_nt<4, 2>(VN, lds + B_T, ST64, rvw, ST64, fr, fq);
          mfma_pad4(VN); lds_fence();
#pragma unroll
          for (int m = 0; m < 4; ++m) { u32x2 w; w.x = cvt_pk_bf16(VN[m][0], VN[m][1]); w.y = cvt_pk_bf16(VN[m][2], VN[m][3]); *(LAS u32x2*)(rvw + fr * ST64 + (16 * m + 4 * fq) * 2) = w; } }
        lds_fence();
        f32x4 O[4];
        if (MODE == 2) {
#pragma unroll
            for (int m = 0; m < 4; ++m) O[m] = (f32x4){0.f, 0.f, 0.f, 0.f};
            mma_nt<4, 4>(O, lds + B_QD, ST128, stw, ST128, fr, fq);
            mma_nt<4, 2>(O, lds + B_AT, ST64, rvw, ST64, fr, fq);
#pragma unroll
            for (int m = 0; m < 4; ++m)
#pragma unroll
                for (int r = 0; r < 4; ++r) { float q = O[m][r] * O[m][r]; q += __shfl_xor(q, 1); q += __shfl_xor(q, 2); q += __shfl_xor(q, 4); q += __shfl_xor(q, 8); if (fr == 0) part[wv * 64 + 16 * m + 4 * fq + r] = q; }
        }
#pragma unroll
        for (int m = 0; m < 8; ++m) Sacc[m] = Sacc[m] * dlast;
        mma_nt<8, 2>(Sacc, lds + B_KU, ST64, rvw, ST64, fr, fq);
        lds_fence();
        write_st(stw, Sacc, fr, fq);
        if (MODE == 2) {
            __syncthreads();
            out_stage(lds + B_KBG, part, O, gpre, c.gdn_onorm_g, c.ocat + (size_t)T0 * D + 1024 + h * 128, wv, lane, fr, fq);
        }
        __syncthreads();
    }
#undef GP_ISSUE
    if (MODE == 0) {
        f32x4* sp = (f32x4*)c.gB + (size_t)(h * 32 + g) * FRAG_F4 + (wv * 8) * 64 + lane;
#pragma unroll
        for (int m = 0; m < 8; ++m) sp[m * 64] = Sacc[m];
    }
    if (MODE == 1) {
        mfma_pad8(Sacc);
        LAS bf16_t* img = (LAS bf16_t*)lds;
#pragma unroll
        for (int m = 0; m < 8; ++m)
#pragma unroll
            for (int r = 0; r < 4; ++r) img[(16 * m + 4 * fq + r) * (ST128 / 2) + 16 * wv + fr] = (bf16_t)(cvt_pk_bf16(Sacc[m][r], Sacc[m][r]) & 0xffffu);
        __syncthreads();
        unsigned char* dst = (unsigned char*)c.gM + (size_t)(h * 32 + g) * (128 * ST128);
#pragma unroll
        for (int q = 0; q < 5; ++q) { const int o = tid * 16 + q * 8192; if (q < 4 || o < 128 * ST128) *(u32x4*)(dst + o) = *(LAS u32x4*)(lds + o); }
        __syncthreads();
    }
}
__device__ void gdn_scan(CtxK& c, LAS unsigned char* lds, int h) {
    const int tid = ltid(), wv = __builtin_amdgcn_readfirstlane(tid >> 6), lane = tid & 63, fr = lane & 15, fq = lane >> 4;
    LAS unsigned char* stw = lds + G_ST + wv * 16 * ST128;
    f32x4 Sacc[8], Bn[8]; u32x4 mp[5];
#pragma unroll
    for (int m = 0; m < 8; ++m) Sacc[m] = (f32x4){0.f, 0.f, 0.f, 0.f};
#define GS_ISSUE(g_) do { const unsigned char* src_ = (const unsigned char*)c.gM + (size_t)(h * 32 + (g_)) * (128 * ST128) + tid * 16; \
        _Pragma("unroll") for (int q = 0; q < 5; ++q) if (q < 4 || tid * 16 + q * 8192 < 128 * ST128) mp[q] = *(const u32x4*)(src_ + q * 8192); \
        const f32x4* bp_ = (const f32x4*)c.gB + (size_t)(h * 32 + (g_)) * FRAG_F4 + (wv * 8) * 64 + lane; \
        _Pragma("unroll") for (int m = 0; m < 8; ++m) Bn[m] = bp_[m * 64]; } while (0)
    GS_ISSUE(0);
    for (int g = 0; g < 31; ++g) {
#pragma unroll
        for (int q = 0; q < 5; ++q) if (q < 4 || tid * 16 + q * 8192 < 128 * ST128) *(LAS u32x4*)(lds + tid * 16 + q * 8192) = mp[q];
        write_st(stw, Sacc, fr, fq);
#pragma unroll
        for (int m = 0; m < 8; ++m) Sacc[m] = Bn[m];
        __syncthreads();
        if (g + 1 < 31) GS_ISSUE(g + 1);
        mma_nt<8, 4>(Sacc, lds, ST128, stw, ST128, fr, fq);
        f32x4* sp = (f32x4*)c.gS + (size_t)(h * 32 + g + 1) * FRAG_F4 + (wv * 8) * 64 + lane;
#pragma unroll
        for (int m = 0; m < 8; ++m) sp[m * 64] = Sacc[m];
        __syncthreads();
    }
#undef GS_ISSUE
}
}
__device__ void ph_hgrn1(CtxK& c, LAS unsigned char* lds) { mx::hgrn_pass<false>(c, lds); }
__device__ void ph_hgrn2(CtxK& c, LAS unsigned char* lds) { mx::hgrn_scan(c); }
__device__ void ph_hgrn3(CtxK& c, LAS unsigned char* lds) { mx::hgrn_pass<true>(c, lds); }
__device__ void ph_gdn1(CtxK& c, LAS unsigned char* lds) {
    const int wu = blockIdx.x, h = wu & 7, g = wu >> 3;
    mx::gdn_prep(c, lds, h, g); __syncthreads();
    asm volatile("s_waitcnt vmcnt(0)" ::: "memory"); __syncthreads();
    mx::gdn_invert(c, lds, h, g);
    asm volatile("s_waitcnt vmcnt(0)" ::: "memory"); __syncthreads();
    mx::gdn_pass<0>(c, lds, h, g); __syncthreads();
    mx::gdn_pass<1>(c, lds, h, g); __syncthreads();
}
__device__ void ph_gdn2(CtxK& c, LAS unsigned char* lds) { if (blockIdx.x < 8) mx::gdn_scan(c, lds, blockIdx.x); }
__device__ void ph_gdn3(CtxK& c, LAS unsigned char* lds) { const int wu = blockIdx.x; mx::gdn_pass<2>(c, lds, wu & 7, wu >> 3); }

constexpr int N2_LA = 0, N2_LB = 8192, N2_XH = 16384, N2_XL = N2_XH + 17408, N2_Y = N2_XL + 17408, N2_LOG = N2_Y + 34816, N2_RS = N2_LOG + 64 * 65 * 4, N2_IDX = N2_RS + 256, N2_BIAS = N2_IDX + 2048, N2_END = N2_BIAS + 256;
static_assert(N2_END <= 147456, "norm2 lds");
__device__ void ph_norm2(CtxK& c, LAS unsigned char* lds) {
    const int tid = ltid(), wg = blockIdx.x, lane = tid & 63, wv = __builtin_amdgcn_readfirstlane(tid >> 6), fr = lane & 15, fq = lane >> 4;
    LAS float* la = (LAS float*)(lds + N2_LA); LAS float* lb_ = (LAS float*)(lds + N2_LB); LAS float* lg = (LAS float*)(lds + N2_LOG); LAS float* rs = (LAS float*)(lds + N2_RS);
    LAS int* idxt = (LAS int*)(lds + N2_IDX); LAS float* bias2 = (LAS float*)(lds + N2_BIAS);
    for (int j = tid; j < D; j += 512) { la[j] = c.norm2_g[j] * (1.f + c.mod[4 * D + j]); lb_[j] = c.mod[3 * D + j]; }
    if (tid < 64) bias2[tid] = c.rbias2[tid];
    __syncthreads();
    const int tok0 = wg * 64;
    f32x4 vn[8];
    { const float* xr = c.out + (size_t)(tok0 + wv * 8) * D;
#pragma unroll
      for (int i = 0; i < 8; ++i) vn[i] = *(const f32x4*)(xr + i * 256 + lane * 4); }
    for (int rr = 0; rr < 8; ++rr) {
        const int row = tok0 + wv * 8 + rr;
        f32x4 v[8]; float ss = 0.f;
#pragma unroll
        for (int i = 0; i < 8; ++i) { v[i] = vn[i]; ss += v[i][0] * v[i][0] + v[i][1] * v[i][1] + v[i][2] * v[i][2] + v[i][3] * v[i][3]; }
        if (rr + 1 < 8) { const float* xr = c.out + (size_t)(row + 1) * D;
#pragma unroll
            for (int i = 0; i < 8; ++i) vn[i] = *(const f32x4*)(xr + i * 256 + lane * 4); }
        ss = wave_sum(ss); const float r = rsqrtf(ss * (1.f / D) + 1e-6f);
        if (lane == 0) rs[wv * 8 + rr] = r;
#pragma unroll
        for (int i = 0; i < 8; ++i) { const int e = i * 256 + lane * 4; const f32x4 a = *(LAS f32x4*)(la + e), b = *(LAS f32x4*)(lb_ + e); const f32x4 y = v[i] * r * a + b;
            *(unsigned*)(c.h2 + (size_t)row * D + e) = cvt4_fp8(4.f * y[0], 4.f * y[1], 4.f * y[2], 4.f * y[3]); }
    }
    const int xrow = tid >> 3, xseg = (tid & 7) * 16;
    f32x4 xr_[4]; u32x4 yr_[5];
    auto issue = [&](int ch) {
        const float* xp = c.out + (size_t)(tok0 + xrow) * D + ch * 128 + xseg;
#pragma unroll
        for (int q = 0; q < 4; ++q) xr_[q] = *(const f32x4*)(xp + q * 4);
        const unsigned char* yp = (const unsigned char*)c.rwimg + (size_t)ch * 34816 + tid * 16;
#pragma unroll
        for (int q = 0; q < 4; ++q) yr_[q] = *(const u32x4*)(yp + q * 8192);
        if (tid < 128) yr_[4] = *(const u32x4*)(yp + 32768);
    };
    issue(0);
    f32x4 acc[2] = {(f32x4){0.f, 0.f, 0.f, 0.f}, (f32x4){0.f, 0.f, 0.f, 0.f}};
    const int mt = wv >> 1, nb = (wv & 1) * 2;
    for (int ch = 0; ch < 16; ++ch) {
        __syncthreads();
        { float hi[16], lo[16];
#pragma unroll
          for (int q = 0; q < 4; ++q)
#pragma unroll
              for (int j = 0; j < 4; ++j) { const float x = xr_[q][j]; const float h = __uint_as_float(cvt_pk_bf16(x, x) << 16); hi[q * 4 + j] = h; lo[q * 4 + j] = x - h; }
          float t8[8];
#pragma unroll
          for (int hh = 0; hh < 2; ++hh) {
#pragma unroll
              for (int j = 0; j < 8; ++j) t8[j] = hi[hh * 8 + j];
              *(LAS u32x4*)(lds + N2_XH + xrow * 272 + (xseg + hh * 8) * 2) = mx::pack8(t8);
#pragma unroll
              for (int j = 0; j < 8; ++j) t8[j] = lo[hh * 8 + j];
              *(LAS u32x4*)(lds + N2_XL + xrow * 272 + (xseg + hh * 8) * 2) = mx::pack8(t8); }
#pragma unroll
          for (int q = 0; q < 4; ++q) *(LAS u32x4*)(lds + N2_Y + tid * 16 + q * 8192) = yr_[q];
          if (tid < 128) *(LAS u32x4*)(lds + N2_Y + tid * 16 + 32768) = yr_[4]; }
        __syncthreads();
        if (ch + 1 < 16) issue(ch + 1);
#pragma unroll
        for (int kk = 0; kk < 4; ++kk) {
            const int ko = (kk * 32 + fq * 8) * 2;
            const bf16x8 ah = *(const LAS bf16x8*)(lds + N2_XH + (16 * mt + fr) * 272 + ko), al = *(const LAS bf16x8*)(lds + N2_XL + (16 * mt + fr) * 272 + ko);
#pragma unroll
            for (int n = 0; n < 2; ++n) {
                const bf16x8 bh = *(const LAS bf16x8*)(lds + N2_Y + (16 * (nb + n) + fr) * 272 + ko), bl = *(const LAS bf16x8*)(lds + N2_Y + 17408 + (16 * (nb + n) + fr) * 272 + ko);
                acc[n] = mx::mfma16(ah, bh, acc[n]); acc[n] = mx::mfma16(ah, bl, acc[n]); acc[n] = mx::mfma16(al, bh, acc[n]);
            }
        }
    }
#pragma unroll
    for (int n = 0; n < 2; ++n)
#pragma unroll
        for (int r = 0; r < 4; ++r) lg[(16 * mt + 4 * fq + r) * 65 + 16 * (nb + n) + fr] = acc[n][r];
    __syncthreads();
    const float rb = c.router_bias[lane], b2 = bias2[lane];
    for (int rr = 0; rr < 8; rr += 2) {
        float s[2], bb[2], mb[2], wsum[2] = {0.f, 0.f}; int myk[2] = {-1, -1};
#pragma unroll
        for (int u = 0; u < 2; ++u) {
            const int lr = wv * 8 + rr + u;
            s[u] = sigmoidf_(lg[lr * 65 + lane] * rs[lr] + b2); const float b = s[u] + rb; bb[u] = b;
            const float m7 = dppf<0x141>(b);
            const float o1 = dppf<0xB1>(b), o2 = dppf<0x4E>(b), o3 = dppf<0x1B>(b), o6 = dppf<0xB1>(m7), o5 = dppf<0x4E>(m7), o4 = dppf<0x1B>(m7);
            int rk = 0;
#define TK_CMP(ov, x) rk += ((ov) > b || ((ov) == b && (lane ^ (x)) < lane)) ? 1 : 0
            TK_CMP(o1, 1); TK_CMP(o2, 2); TK_CMP(o3, 3); TK_CMP(o4, 4); TK_CMP(o5, 5); TK_CMP(o6, 6); TK_CMP(m7, 7);
#undef TK_CMP
            float gs = rk < 2 ? b : 0.f; gs += dppf<0xB1>(gs); gs += dppf<0x4E>(gs); gs += dppf<0x141>(gs);
            int grk = 0; const int gi = lane >> 3;
#pragma unroll
            for (int j = 0; j < 8; ++j) { const float og = __builtin_bit_cast(float, __builtin_amdgcn_readlane(__builtin_bit_cast(int, gs), j * 8)); grk += (og > gs || (og == gs && j < gi)) ? 1 : 0; }
            mb[u] = grk < 4 ? b : -INFINITY; }
#pragma unroll
        for (int k = 0; k < TOPK; ++k)
#pragma unroll
            for (int u = 0; u < 2; ++u) {
                const float m = wave_max_dpp(mb[u]);
                const unsigned long long bal = __ballot(mb[u] == m); const int win = __builtin_amdgcn_readfirstlane(__ffsll((long long)bal) - 1);
                wsum[u] += __builtin_bit_cast(float, __builtin_amdgcn_readlane(__builtin_bit_cast(int, s[u]), win));
                if (lane == win) { mb[u] = -INFINITY; myk[u] = k; } }
#pragma unroll
        for (int u = 0; u < 2; ++u) { const int lr = wv * 8 + rr + u, t = tok0 + lr;
            if (myk[u] >= 0) { c.idx[t * TOPK + myk[u]] = lane; c.wts[t * TOPK + myk[u]] = s[u] / wsum[u] * 2.5f; idxt[lr * TOPK + myk[u]] = lane; } }
    }
    __syncthreads();
    { const int myexp = idxt[tid]; int rank = 0, cntl = 0;
      for (int e = 0; e < 64; ++e) {
          const unsigned long long bal = __ballot(myexp == e);
          const int below = __builtin_amdgcn_mbcnt_hi((unsigned)(bal >> 32), __builtin_amdgcn_mbcnt_lo((unsigned)bal, 0u));
          if (myexp == e) rank = below;
          if (lane == e) cntl = __popcll(bal); }
      LAS int* wcnt = (LAS int*)(lds + N2_XH);
      wcnt[wv * 64 + lane] = cntl;
      __syncthreads();
      int base = 0;
      for (int w = 0; w < wv; ++w) base += wcnt[w * 64 + myexp];
      c.rnk[wg * 512 + tid] = base + rank;
      if (tid < 64) { int n = 0;
#pragma unroll
          for (int w = 0; w < 8; ++w) n += wcnt[w * 64 + tid];
          c.tile_cnt[wg * 64 + tid] = n; } }
}
__device__ void ph_route(CtxK& c, LAS unsigned char* lds) {
    const int tid = ltid(), b = blockIdx.x, e = tid & 63, part = tid >> 6;
    LAS int* psum = (LAS int*)lds; LAS int* pbel = psum + 512; LAS int* tot = pbel + 512; LAS int* offb = tot + 64; LAS int* pst = offb + 64;
    { int sa = 0, sb = 0;
      for (int tl = part * 32; tl < part * 32 + 32; ++tl) { const int v = c.tile_cnt[tl * 64 + e]; sa += v; sb += tl < b ? v : 0; }
      psum[part * 64 + e] = sa; pbel[part * 64 + e] = sb; }
    __syncthreads();
    if (tid < 64) {
        int t_ = 0, o_ = 0;
#pragma unroll
        for (int q = 0; q < 8; ++q) { t_ += psum[q * 64 + e]; o_ += pbel[q * 64 + e]; }
        const int pad = (t_ + 255) & ~255; int inc = pad;
#pragma unroll
        for (int o = 1; o < 64; o <<= 1) { const int x = __shfl_up(inc, o); if (e >= o) inc += x; }
        const int ps = inc - pad;
        tot[e] = t_; offb[e] = o_; pst[e] = ps;
        if (b == 0) {
            const int b0 = ps >> 8, nbe = pad >> 8;
            for (int j = 0; j < nbe; ++j) { c.blk_row[b0 + j] = ps + j * 256; c.blk_exp[b0 + j] = e; }
            const int nbr = __shfl(inc, 63) >> 8;
            c.blk_row[nbr + e] = PROUTED + e * 256; c.blk_exp[nbr + e] = NE;
            if (e == 0) *c.nent = nbr + S / 256;
        }
        c.tok_p[PROUTED + b * 64 + e] = b * 64 + e; c.w_p[PROUTED + b * 64 + e] = 1.f;
    }
    __syncthreads();
    { const int p = b * 512 + tid, ex = c.idx[p], d = pst[ex] + offb[ex] + c.rnk[p];
      c.tok_p[d] = p >> 3; c.w_p[d] = c.wts[p]; c.pos[p] = d; }
    if (b < NE) { const int ps = pst[b], t_ = tot[b], pe = (t_ + 255) & ~255;
        for (int r = t_ + tid; r < pe; r += 512) { c.tok_p[ps + r] = 0; c.w_p[ps + r] = 0.f; } }
}

constexpr int LDS_BYTES = 163840, LDS_MAIN = LDS_BYTES - 16;
static_assert(gm::VBOFF + 512 * 8 <= LDS_MAIN, "lds map");
__global__ void __launch_bounds__(512, 2) k_mega(Ctx c) {
    extern __shared__ __attribute__((aligned(16))) unsigned char smem[];
    LAS unsigned char* lds = (LAS unsigned char*)smem;
    if (ltid() == 0) *(LAS u32x4*)(lds + LDS_MAIN) = (u32x4){0u, 0u, 0u, 0u};
    __syncthreads();
    CtxK* kp = (CtxK*)__builtin_amdgcn_kernarg_segment_ptr();
    (void)xcd_barrier_post(c.bar, (volatile LAS unsigned*)(lds + LDS_MAIN));
#define PHASE(fn) do { const CtxK* kp_ = kp; asm volatile("" : "+s"(kp_)); fn(*kp_, lds); __syncthreads(); } while (0)
#define GRID_BARRIER() do { const CtxK* kp_ = kp; asm volatile("" : "+s"(kp_)); XcdBarrier bb_; bb_.bar = kp_->bar; bb_.x = xb_xcc_id(); bb_.st = (volatile LAS unsigned*)(lds + LDS_MAIN); xcd_barrier(bb_); } while (0)
    PHASE(ph_pro1);      GRID_BARRIER();
    PHASE(ph_norm1);     GRID_BARRIER();
    PHASE(ph_gemm1);     GRID_BARRIER();
    PHASE(ph_hgrn1);     PHASE(ph_gdn1);  GRID_BARRIER();
    PHASE(ph_hgrn2);     PHASE(ph_gdn2);  PHASE(ph_cvt_exp); GRID_BARRIER();
    PHASE(ph_hgrn3);     PHASE(ph_gdn3);  GRID_BARRIER();
    PHASE(ph_gemm2);     GRID_BARRIER();
    PHASE(ph_gemm3);     GRID_BARRIER();
    PHASE(ph_norm2);     GRID_BARRIER();
    PHASE(ph_route);     GRID_BARRIER();
    PHASE(ph_moe_gu);    GRID_BARRIER();
    PHASE(ph_moe_dn);    GRID_BARRIER();
    PHASE(ph_final);
#undef PHASE
#undef GRID_BARRIER
}

extern "C" void kernel_launch(void* const* d_in, const int* in_sizes, int n_in, void* d_out, int out_size, void* d_ws, size_t ws_size, hipStream_t stream) {
    Ctx c{};
    const float** ip = (const float**)&c.x;
    for (int i = 0; i < 25; ++i) ip[i] = (const float*)d_in[i];
    c.out = (float*)d_out;
    char* ws = (char*)d_ws; constexpr size_t MB = 1024 * 1024;
    c.bar = (unsigned*)ws;
    c.modp = (float*)(ws + 64 * 1024); c.mod = (float*)(ws + 320 * 1024); c.lb = (float*)(ws + 384 * 1024);
    c.cnt = (int*)(ws + 392 * 1024); c.nent = (int*)(ws + 396 * 1024); c.blk_row = (int*)(ws + 400 * 1024); c.blk_exp = (int*)(ws + 404 * 1024);
    c.idx = (int*)(ws + 1 * MB); c.wts = (float*)(ws + 2 * MB); c.tok_p = (int*)(ws + 3 * MB); c.w_p = (float*)(ws + 4 * MB); c.pos = (int*)(ws + 5 * MB);
    c.gab = (float*)(ws + 6 * MB); c.gbeta = (float*)(ws + 7 * MB + 0); c.gdec = (float*)(ws + 7 * MB + 512 * 1024);
    c.rwimg = (bf16_t*)(ws + 8 * MB); c.rbias2 = (float*)(ws + 9 * MB); c.tile_cnt = (int*)(ws + 9 * MB + 4096); c.rnk = (int*)(ws + 10 * MB);
    char* big = ws + 16 * MB;
    auto at = [&](size_t mib) { return big + mib * MB; };
    c.dn_t = (unsigned char*)at(0); c.gu_t = (unsigned char*)at(130);
    c.win_t = (bf16_t*)at(0); c.h1 = (bf16_t*)at(48); c.gAT = (float*)at(112);
    c.proj = (bf16_t*)at(390); c.gBlob = (unsigned char*)at(774); c.merged = (bf16_t*)at(774);
    c.gM = (unsigned char*)at(951); c.gB = (float*)at(960); c.hL = (float*)at(976); c.gS = (float*)at(992); c.hS = (float*)at(1008); c.hD = (float*)at(1024);
    c.wa_t = (bf16_t*)at(1025); c.wb_t = (bf16_t*)at(1029); c.wout_t = (bf16_t*)at(1033); c.ocat = (bf16_t*)at(1041);
    c.Y = (unsigned char*)at(130); c.hid = (unsigned char*)at(770); c.h2 = (unsigned char*)at(930);
    static_assert((size_t)NEX * D * FF * 2 <= 130 * MB && (size_t)NEX * 1024 * D * 2 <= 260 * MB && (size_t)PW * D * 2 <= 48 * MB && (size_t)S * D * 2 <= 64 * MB, "map A");
    static_assert((size_t)S * PW * 2 <= 384 * MB && (size_t)2048 * mx::BLOB <= 177 * MB && (size_t)256 * 128 * mx::ST128 <= 9 * MB && (size_t)PTOT * D * 2 <= 640 * MB && (size_t)PTOT * FF * 2 <= 160 * MB, "map B");
    const size_t need = 16 * MB + 1105 * MB;
    if (ws_size < need) { fprintf(stderr, "kernel_launch: workspace too small: %zu < %zu\n", ws_size, need); return; }

    static int grid = 0;
    if (!grid) {
        int dev = 0, cus = 0, per_cu = 0;
        hipGetDevice(&dev); hipDeviceGetAttribute(&cus, hipDeviceAttributeMultiprocessorCount, dev);
        hipFuncSetAttribute((const void*)k_mega, hipFuncAttributeMaxDynamicSharedMemorySize, LDS_BYTES);
        hipOccupancyMaxActiveBlocksPerMultiprocessor(&per_cu, (const void*)k_mega, 512, LDS_BYTES);
        if (per_cu < 1) fprintf(stderr, "kernel_launch: occupancy query reports %d blocks per CU\n", per_cu);
        grid = cus;
        if (grid != 256) { fprintf(stderr, "kernel_launch: built for a 256-CU device (token-mixer units = workgroups); got %d CUs\n", cus); grid = -1; }
    }
    if (grid < 0) return;
    hipMemsetAsync(c.bar, 0, XCD_BAR_WORDS * sizeof(unsigned), stream);
    hipLaunchKernelGGL(k_mega, dim3(grid), dim3(512), LDS_BYTES, stream, c);
}
```

```cpp
#include <hip/hip_runtime.h>
#include <stdint.h>
#include <stdio.h>

#define LAS __attribute__((address_space(3)))
typedef unsigned short bf16_t;
typedef short bf16x8 __attribute__((ext_vector_type(8)));
typedef float f32x4 __attribute__((ext_vector_type(4)));
typedef unsigned u32x4 __attribute__((ext_vector_type(4)));
typedef unsigned u32x2 __attribute__((ext_vector_type(2)));
typedef int v4i __attribute__((ext_vector_type(4)));
typedef int v8i __attribute__((ext_vector_type(8)));

constexpr int S = 16384, D = 2048, INW = 12304, PW = 12288, NE = 64, TOPK = 8, TK = S * TOPK, FF = 512;
constexpr int NEX = NE + 1;
constexpr int PROUTED = 147456, PTOT = PROUTED + S, NBLK_MAX = PROUTED / 256;
constexpr int C_HQ = 0, C_HF = 1024, C_HI = 2048, C_HG = 3072, C_GQKV = 4096, C_GG = 7168, C_MGA = 8192, C_MGB = 10240;
constexpr int WIN_GAB = 7168;

__device__ __forceinline__ float rcpf_(float x) { return __builtin_amdgcn_rcpf(x); }
__device__ __forceinline__ float sigmoidf_(float x) { return rcpf_(1.f + __expf(-x)); }
__device__ __forceinline__ float siluf_(float x) { return x * rcpf_(1.f + __expf(-x)); }
__device__ __forceinline__ float softplusf_(float x) { return x > 20.f ? x : log1pf(expf(x)); }
__device__ __forceinline__ float bf2f(bf16_t b) { return __uint_as_float(((unsigned)b) << 16); }
__device__ __forceinline__ float bflo(unsigned w) { return __uint_as_float(w << 16); }
__device__ __forceinline__ float bfhi(unsigned w) { return __uint_as_float(w & 0xffff0000u); }
__device__ __forceinline__ unsigned cvt_pk_bf16(float lo, float hi) { unsigned r; asm volatile("v_cvt_pk_bf16_f32 %0, %1, %2" : "=v"(r) : "v"(lo), "v"(hi)); return r; }
__device__ __forceinline__ unsigned cvt4_fp8(float a, float b, float c_, float d) {
    a = fminf(fmaxf(a, -448.f), 448.f); b = fminf(fmaxf(b, -448.f), 448.f); c_ = fminf(fmaxf(c_, -448.f), 448.f); d = fminf(fmaxf(d, -448.f), 448.f);
    int w = __builtin_amdgcn_cvt_pk_fp8_f32(a, b, 0, false); w = __builtin_amdgcn_cvt_pk_fp8_f32(c_, d, w, true); return (unsigned)w; }
__device__ __forceinline__ int ltid() { int t = threadIdx.x; asm volatile("" : "+v"(t)); return t; }
template <int CTRL> __device__ __forceinline__ float dppf(float v) { return __builtin_bit_cast(float, __builtin_amdgcn_update_dpp(0, __builtin_bit_cast(int, v), CTRL, 0xf, 0xf, false)); }
__device__ __forceinline__ float wave_max_dpp(float v) {
    v = fmaxf(v, dppf<0x128>(v)); v = fmaxf(v, dppf<0x124>(v)); v = fmaxf(v, dppf<0x122>(v)); v = fmaxf(v, dppf<0x121>(v));
    const int b = __builtin_bit_cast(int, v);
    return fmaxf(fmaxf(__builtin_bit_cast(float, __builtin_amdgcn_readlane(b, 0)), __builtin_bit_cast(float, __builtin_amdgcn_readlane(b, 16))), fmaxf(__builtin_bit_cast(float, __builtin_amdgcn_readlane(b, 32)), __builtin_bit_cast(float, __builtin_amdgcn_readlane(b, 48))));
}
__device__ __forceinline__ float wave_sum_dpp(float v) {
    v += __builtin_bit_cast(float, __builtin_amdgcn_update_dpp(0, __builtin_bit_cast(int, v), 0x128, 0xf, 0xf, false));
    v += __builtin_bit_cast(float, __builtin_amdgcn_update_dpp(0, __builtin_bit_cast(int, v), 0x124, 0xf, 0xf, false));
    v += __builtin_bit_cast(float, __builtin_amdgcn_update_dpp(0, __builtin_bit_cast(int, v), 0x122, 0xf, 0xf, false));
    v += __builtin_bit_cast(float, __builtin_amdgcn_update_dpp(0, __builtin_bit_cast(int, v), 0x121, 0xf, 0xf, false));
    const int b = __builtin_bit_cast(int, v);
    return __builtin_bit_cast(float, __builtin_amdgcn_readlane(b, 0)) + __builtin_bit_cast(float, __builtin_amdgcn_readlane(b, 16)) + __builtin_bit_cast(float, __builtin_amdgcn_readlane(b, 32)) + __builtin_bit_cast(float, __builtin_amdgcn_readlane(b, 48));
}
__device__ __forceinline__ float wave_sum(float v) {
#pragma unroll
    for (int o = 32; o >= 1; o >>= 1) v += __shfl_xor(v, o);
    return v;
}


#define XB_TMO      128
#define XB_XCNT(j)  (256  + 64 * (j))
#define XB_XSUB(j)  (1280 + 64 * (j))
#define XB_XGEN(j)  (2304 + 64 * (j))
#define XB_TOP      3328
#define XB_TOPGEN   3392
#define XCD_BAR_WORDS 3456
#define XB_SPIN_CAP (1u << 18)
__device__ __forceinline__ unsigned xb_ld(unsigned* p)              { return __hip_atomic_load(p, __ATOMIC_RELAXED, __HIP_MEMORY_SCOPE_AGENT); }
__device__ __forceinline__ unsigned xb_add(unsigned* p, unsigned v) { return __hip_atomic_fetch_add(p, v, __ATOMIC_RELAXED, __HIP_MEMORY_SCOPE_AGENT); }
__device__ __forceinline__ unsigned xb_xcc_id() { return (unsigned)__builtin_amdgcn_s_getreg((3 << 11) | 20) & 0xFu; }
#define XB_SPIN(cond, bar) do { unsigned _sp = 0; while (cond) { __builtin_amdgcn_s_sleep(1); \
    if ((++_sp & 255u) == 0u) { if (xb_ld(&(bar)[XB_TMO])) break; if (_sp > XB_SPIN_CAP) { atomicAdd(&(bar)[XB_TMO], 1u); break; } } } } while (0)
struct XcdBarrier { unsigned* bar; unsigned x; volatile LAS unsigned* st; };
__device__ __forceinline__ XcdBarrier xcd_barrier_post(unsigned* bar, volatile LAS unsigned* st) {
    XcdBarrier b; b.bar = bar; b.x = xb_xcc_id(); b.st = st;
    if (threadIdx.x == 0) (void)xb_add(&bar[XB_XCNT(b.x)], 1u);
    return b;
}
__device__ __forceinline__ void xcd_barrier_complete(unsigned* bar, unsigned x, unsigned& nloc, unsigned& nx) {
    const unsigned G = gridDim.x * gridDim.y * gridDim.z;
    unsigned sum, cnt, mine, sp = 0u;
    for (;;) {
        sum = 0u; cnt = 0u; mine = 0u;
#pragma unroll
        for (unsigned j = 0; j < 16; ++j) { const unsigned c = xb_ld(&bar[XB_XCNT(j)]); sum += c; cnt += (c > 0u) ? 1u : 0u; mine = (j == x) ? c : mine; }
        if (sum == G) break;
        __builtin_amdgcn_s_sleep(1);
        if ((++sp & 255u) == 0u) { if (xb_ld(&bar[XB_TMO])) break; if (sp > XB_SPIN_CAP) { atomicAdd(&bar[XB_TMO], 1u); break; } }
    }
    nloc = mine > 0u ? mine : 1u; nx = cnt > 0u ? cnt : 1u;
}
__device__ __forceinline__ void xcd_barrier(const XcdBarrier& b) {
    asm volatile("s_waitcnt vmcnt(0)" ::: "memory");
    __syncthreads();
    if (threadIdx.x == 0) {
        unsigned* bar = b.bar;
        __builtin_amdgcn_s_waitcnt(0);
        unsigned nloc = b.st[0], nx = b.st[1];
        if (nloc == 0u) { xcd_barrier_complete(bar, b.x, nloc, nx); b.st[0] = nloc; b.st[1] = nx; }
        const unsigned old = xb_add(&bar[XB_XSUB(b.x)], 1u);
        const unsigned gen = old / nloc;
        if (old + 1u == (gen + 1u) * nloc) {
            __builtin_amdgcn_fence(__ATOMIC_RELEASE, "agent");
            asm volatile("s_waitcnt vmcnt(0)" ::: "memory");
            const unsigned og = xb_add(&bar[XB_TOP], 1u);
            const unsigned tg = og / nx;
            if (og + 1u == (tg + 1u) * nx) xb_add(&bar[XB_TOPGEN], 1u);
            else XB_SPIN(xb_ld(&bar[XB_TOPGEN]) == tg, bar);
            __builtin_amdgcn_fence(__ATOMIC_ACQUIRE, "agent");
            xb_add(&bar[XB_XGEN(b.x)], 1u);
            asm volatile("s_waitcnt vmcnt(0)" ::: "memory");
        } else {
            XB_SPIN(xb_ld(&bar[XB_XGEN(b.x)]) == gen, bar);
            __builtin_amdgcn_fence(__ATOMIC_ACQUIRE, "agent");
            asm volatile("s_waitcnt vmcnt(0)" ::: "memory");
        }
    }
    __syncthreads();
}

namespace gm {
constexpr int BM = 256, BK = 64, HALF = 128, HTB = HALF * BK * 2, STAGE_BYTES = 8 * HTB;
__host__ __device__ __forceinline__ int lds_byte(int r, int c) { const int st = (r >> 4) * 2 + (c >> 5), rr = r & 15, cc = c & 31, ob = rr * 64 + cc * 2; return st * 1024 + (ob ^ (((ob >> 9) & 1) << 5)); }
__host__ __device__ __forceinline__ void stage_rc(int b, int& R, int& C) { const int st = b / 1024, sb = b % 1024, swz = sb ^ (((sb >> 9) & 1) << 5); R = (st >> 1) * 16 + swz / 64; C = (st & 1) * 32 + (swz % 64) / 2; }
__host__ __device__ __forceinline__ int perm32(int rho) { const int n = rho >> 4, i = rho & 15; return 8 * (i >> 2) + 4 * n + (i & 3); }

struct Unit { int pm, pn, aux; const char* Bp; };
constexpr int UOFF = STAGE_BYTES + 256 + 10240, VBOFF = UOFF + 2 * 512 * 16;
__device__ __forceinline__ void put_offs(LAS unsigned char* lds, int ui, unsigned a00, unsigned a01, unsigned a10, unsigned a11) { *(LAS u32x4*)(lds + UOFF + ((ui & 1) * 512 + ltid()) * 16) = (u32x4){a00, a01, a10, a11}; }

template <class Epi, class Sched>
__device__ __forceinline__ void gphase(LAS unsigned char* lds, const char* Abase, const int K, Sched& S, Epi& E) {
    const int tid = ltid(), wid = __builtin_amdgcn_readfirstlane(tid >> 6), lane = tid & 63, wr = wid >> 2, wc = wid & 3, fr = lane & 15, fq = lane >> 4;
    const int nt = K / BK;
    { unsigned vb_[2];
#pragma unroll
      for (int i = 0; i < 2; ++i) { int R, C; stage_rc(tid * 16 + i * 8192, R, C); const int Rb = Epi::PERM == 2 ? (64 * (R >> 5) + 16 * ((R >> 2) & 3) + 4 * ((R >> 4) & 1) + (R & 3)) : Epi::PERM == 1 ? ((R & ~31) + perm32(R & 31)) : R; vb_[i] = (unsigned)(Rb * K + C) * 2u; }
      *(LAS u32x2*)(lds + VBOFF + tid * 8) = (u32x2){vb_[0], vb_[1]}; }
    const unsigned hstepB = (unsigned)(Epi::PERM == 2 ? 8 : HALF) * K * 2;
    const unsigned ldsw = (unsigned)wid * 1024u;
    constexpr bool F8 = Epi::F8; constexpr int KST = F8 ? 16 : 1024;
    const int aoff = lds_byte(wr * 64 + fr, fq * (F8 ? 16 : 8)), boff = lds_byte(wc * 32 + fr, fq * (F8 ? 16 : 8));
#define G_SA(b, h) (((b) * 2 + (h)) * HTB)
#define G_SB(b, h) ((4 + (b) * 2 + (h)) * HTB)
#define G_STAGE_A(bufoff, slot_, half_, kb) do { const char* ab_ = Abase + (kb); const u32x2 p_ = *(const LAS u32x2*)(lds + UOFF + (((slot_) & 1) * 512 + tid) * 16 + (half_) * 8); unsigned p0_ = p_.x, p1_ = p_.y; asm volatile("" : "+v"(p0_), "+v"(p1_)); \
        __builtin_amdgcn_global_load_lds((const unsigned*)(ab_ + p0_), (LAS unsigned*)(lds + (bufoff) + ldsw), 16, 0, 0); \
        __builtin_amdgcn_global_load_lds((const unsigned*)(ab_ + p1_), (LAS unsigned*)(lds + (bufoff) + ldsw + 8192), 16, 0, 0); } while (0)
#define G_STAGE_B(bufoff, bp, kb) do { const char* bb_ = (bp) + (kb); const u32x2 q_ = *(const LAS u32x2*)(lds + VBOFF + tid * 8); unsigned p0_ = q_.x, p1_ = q_.y; asm volatile("" : "+v"(p0_), "+v"(p1_)); \
        __builtin_amdgcn_global_load_lds((const unsigned*)(bb_ + p0_), (LAS unsigned*)(lds + (bufoff) + ldsw), 16, 0, 0); \
        __builtin_amdgcn_global_load_lds((const unsigned*)(bb_ + p1_), (LAS unsigned*)(lds + (bufoff) + ldsw + 8192), 16, 0, 0); } while (0)
#define G_LDA(dst, b, h) do { _Pragma("unroll") for (int m = 0; m < 4; ++m) _Pragma("unroll") for (int k = 0; k < 2; ++k) dst[m][k] = *(const LAS v4i*)(lds + G_SA(b, h) + aoff + m * 2048 + k * KST); } while (0)
#define G_LDB(dst, b, h) do { _Pragma("unroll") for (int n = 0; n < 2; ++n) _Pragma("unroll") for (int k = 0; k < 2; ++k) dst[n][k] = *(const LAS v4i*)(lds + G_SB(b, h) + boff + n * 2048 + k * KST); } while (0)
#define G_CAT(x_) __builtin_shufflevector(x_[0], x_[1], 0, 1, 2, 3, 4, 5, 6, 7)
#define G_MMA(ai, bj, At, Bt) do { __builtin_amdgcn_s_setprio(1); _Pragma("unroll") for (int m = 0; m < 4; ++m) _Pragma("unroll") for (int n = 0; n < 2; ++n) { \
        if constexpr (F8) acc[ai][bj][m][n] = __builtin_amdgcn_mfma_scale_f32_16x16x128_f8f6f4(G_CAT(Bt[n]), G_CAT(At[m]), acc[ai][bj][m][n], 0, 0, 0, Epi::SB, 0, Epi::SA); \
        else { _Pragma("unroll") for (int k = 0; k < 2; ++k) acc[ai][bj][m][n] = __builtin_amdgcn_mfma_f32_16x16x32_bf16(__builtin_bit_cast(bf16x8, Bt[n][k]), __builtin_bit_cast(bf16x8, At[m][k]), acc[ai][bj][m][n], 0, 0, 0); } } \
        __builtin_amdgcn_s_setprio(0); } while (0)
#define G_WAIT_V(n) asm volatile("s_waitcnt vmcnt(" #n ")" ::: "memory")
#define G_WAIT_L(n) asm volatile("s_waitcnt lgkmcnt(" #n ")" ::: "memory")
#define G_BAR __builtin_amdgcn_s_barrier()
#define G_SCHED __builtin_amdgcn_sched_barrier(0)
#define G_ZERO() do { _Pragma("unroll") for (int a = 0; a < 2; ++a) _Pragma("unroll") for (int b = 0; b < 2; ++b) _Pragma("unroll") for (int m = 0; m < 4; ++m) _Pragma("unroll") for (int n = 0; n < 2; ++n) acc[a][b][m][n] = (f32x4){0.f, 0.f, 0.f, 0.f}; } while (0)
    Unit cur, nxt; int ui = 0;
    if (!S.next(lds, 0, cur)) return;
    f32x4 acc[2][2][4][2];
    G_ZERO();
    v4i At[4][2], B0[2][2], B1[2][2];
    G_STAGE_B(G_SB(0, 0), cur.Bp, 0); G_STAGE_B(G_SB(0, 1), cur.Bp + hstepB, 0); G_STAGE_A(G_SA(0, 0), 0, 0, 0); G_STAGE_A(G_SA(0, 1), 0, 1, 0);
    if (wr == 1) G_BAR;
    G_WAIT_V(2); G_BAR;
    G_STAGE_B(G_SB(1, 0), cur.Bp, 128); G_STAGE_A(G_SA(1, 0), 0, 0, 128); G_STAGE_B(G_SB(1, 1), cur.Bp + hstepB, 128);
    G_WAIT_V(6); G_BAR;
    for (;;) {
        bool has_next = false;
#pragma unroll 1
        for (int t = 0; t < nt; t += 2) {
            const bool last = (t == nt - 2);
            const unsigned kb1 = (unsigned)(t + 1) * 128u, kb2 = last ? 0u : (unsigned)(t + 2) * 128u, kb3 = kb2 + 128u;
            const char* b2 = cur.Bp; int s2 = ui;
            if (last) {
                has_next = S.next(lds, ui + 1, nxt); if (!has_next) nxt = cur; else s2 = ui + 1;
                b2 = nxt.Bp; }
            G_LDB(B0, 0, 0); G_LDB(B1, 0, 1); G_SCHED; G_LDA(At, 0, 0); G_STAGE_A(G_SA(1, 1), ui, 1, kb1);
            G_WAIT_V(8); G_WAIT_L(0); G_BAR; G_MMA(0, 0, At, B0); G_MMA(0, 1, At, B1); G_BAR; G_SCHED;
            G_LDA(At, 0, 1); G_STAGE_B(G_SB(0, 0), b2, kb2); G_STAGE_B(G_SB(0, 1), b2 + hstepB, kb2); G_STAGE_A(G_SA(0, 0), s2, 0, kb2);
            G_WAIT_V(8); G_WAIT_L(0); G_BAR; G_MMA(1, 0, At, B0); G_MMA(1, 1, At, B1); G_BAR; G_SCHED;
            G_LDB(B0, 1, 0); G_LDB(B1, 1, 1); G_SCHED; G_LDA(At, 1, 0); G_STAGE_A(G_SA(0, 1), s2, 1, kb2);
            G_WAIT_V(8); G_WAIT_L(0); G_BAR; G_MMA(0, 0, At, B0); G_MMA(0, 1, At, B1); G_BAR; G_SCHED;
            G_LDA(At, 1, 1); G_STAGE_B(G_SB(1, 0), b2, kb3); G_STAGE_B(G_SB(1, 1), b2 + hstepB, kb3); G_STAGE_A(G_SA(1, 0), s2, 0, kb3);
            G_WAIT_V(8); G_WAIT_L(0); G_BAR; G_MMA(1, 0, At, B0); G_MMA(1, 1, At, B1); G_BAR; G_SCHED;
        }
        if (wr == 0) G_BAR;
        { const int tz = ltid(), wz = tz >> 6, lz = tz & 63; E(acc, cur, wz >> 2, wz & 3, lz & 15, lz >> 4); }
        if (!has_next) break;
        if (!E.keep(cur)) G_ZERO();
        cur = nxt; ++ui;
        if (wr == 1) G_BAR;
    }
    G_WAIT_V(0);
    G_BAR;
#undef G_SA
#undef G_SB
#undef G_STAGE_A
#undef G_STAGE_B
#undef G_LDA
#undef G_CAT
#undef G_LDB
#undef G_MMA
#undef G_WAIT_V
#undef G_WAIT_L
#undef G_BAR
#undef G_SCHED
#undef G_ZERO
}

struct DenseSched {
    int nM, nN, nwg, G, c, lda, K, parts; const char* Bt; const char* Bt2;
    __device__ void init(int M, int N, int K_, int lda_, const void* Bt_, const void* Bt2_, int parts_) {
        nM = M / BM; nN = N / BM; nwg = nM * nN; G = gridDim.x; c = blockIdx.x; lda = lda_; K = K_; Bt = (const char*)Bt_; Bt2 = (const char*)Bt2_; parts = parts_;
    }
    __device__ bool next(LAS unsigned char* lds, int i, Unit& u) const {
        const int ti = parts == 2 ? (i >> 1) : i, part = parts == 2 ? (i & 1) : 0;
        const long L = (long)ti * G + c; if (L >= nwg) return false;
        int wgid = (int)L; { const int q = nwg / 8, r = nwg % 8, xcd = wgid % 8, off = wgid / 8; wgid = (xcd < r ? xcd * (q + 1) : r * (q + 1) + (xcd - r) * q) + off; }
        const int nig = 8 * nN, gid = wgid / nig, fm = gid * 8, gsz = (nM - fm) < 8 ? (nM - fm) : 8;
        u.pm = fm + ((wgid % nig) % gsz); u.pn = (wgid % nig) / gsz; u.aux = part;
        u.Bp = (part ? Bt2 : Bt) + (size_t)u.pn * BM * K * 2;
        int R0, C0, R1, C1; { const int tz = ltid(); stage_rc(tz * 16, R0, C0); stage_rc(tz * 16 + 8192, R1, C1); }
        const unsigned rb = (unsigned)u.pm * BM, po = part ? (unsigned)K * 2u : 0u;
        put_offs(lds, i, ((rb + R0) * lda + C0) * 2u + po, ((rb + R1) * lda + C1) * 2u + po, ((rb + HALF + R0) * lda + C0) * 2u + po, ((rb + HALF + R1) * lda + C1) * 2u + po);
        return true;
    }
};
template <bool GATHER, int NN, int KK, int LDA, size_t WSTRIDE>
struct MoeSched {
    static constexpr int MAXU = 24, TBL = STAGE_BYTES, TOK = STAGE_BYTES + 256;
    int nu; const char* W; const float* wp;
    __device__ void init(LAS unsigned char* lds, const int* nent_p, const int* blk_row, const int* blk_exp, const int* tok_p, const void* W_) {
        W = (const char*)W_; wp = nullptr;
        const int tid = ltid(), G = gridDim.x, c = blockIdx.x, nent = *nent_p;
        const int x = c & 7, slot = c >> 3, nslot = G >> 3, e0 = (int)((long)x * nent / 8), e1 = (int)((long)(x + 1) * nent / 8), tot = (e1 - e0) * NN;
        nu = tot > slot ? (tot - slot + nslot - 1) / nslot : 0; if (nu > MAXU) nu = MAXU;
        LAS int* t_ = (LAS int*)(lds + TBL); LAS int* k_ = (LAS int*)(lds + TOK);
        if (tid < nu) { const int uidx = tid * nslot + slot, ent = e0 + uidx / NN; t_[tid * 2] = blk_row[ent]; t_[tid * 2 + 1] = blk_exp[ent] * 16 + uidx % NN; }
        __syncthreads();
        if (GATHER) { for (int j = tid; j < nu * 256; j += 512) k_[j] = tok_p[t_[(j >> 8) * 2] + (j & 255)]; __syncthreads(); }
    }
    __device__ bool next(LAS unsigned char* lds, int i, Unit& u) const {
        if (i >= nu) return false;
        LAS const int* tbl = (LAS const int*)(lds + TBL); LAS const int* tokt = (LAS const int*)(lds + TOK);
        int R0, C0, R1, C1; { const int tz = ltid(); stage_rc(tz * 16, R0, C0); stage_rc(tz * 16 + 8192, R1, C1); }
        const int rb = __builtin_amdgcn_readfirstlane(tbl[i * 2]), ep = __builtin_amdgcn_readfirstlane(tbl[i * 2 + 1]), e = ep >> 4; u.pn = ep & 15; u.pm = rb; u.aux = e;
        u.Bp = W + (size_t)e * WSTRIDE + (size_t)u.pn * BM * KK * 2;
        if (GATHER) {
            const unsigned t00 = tokt[i * 256 + R0], t01 = tokt[i * 256 + R1], t10 = tokt[i * 256 + HALF + R0], t11 = tokt[i * 256 + HALF + R1];
            put_offs(lds, i, (t00 * LDA + C0) * 2u, (t01 * LDA + C1) * 2u, (t10 * LDA + C0) * 2u, (t11 * LDA + C1) * 2u);
        } else {
            u.aux = i & 1;
            { const int tz = ltid(); if (tz < 256) __builtin_amdgcn_global_load_lds((const unsigned*)(wp + rb + tz), (LAS unsigned*)(lds + TOK + (i & 1) * 1024 + (tz >> 6) * 256), 4, 0, 0); }
            put_offs(lds, i, ((unsigned)(rb + R0) * LDA + C0) * 2u, ((unsigned)(rb + R1) * LDA + C1) * 2u, ((unsigned)(rb + HALF + R0) * LDA + C0) * 2u, ((unsigned)(rb + HALF + R1) * LDA + C1) * 2u);
        }
        return true;
    }
};

struct EpiProj {
    static constexpr int PERM = 1; static constexpr bool F8 = false; static constexpr int SA = 0, SB = 0; bf16_t* O;
    __device__ __forceinline__ bool keep(const Unit&) const { return false; }
    __device__ __forceinline__ void operator()(f32x4 (&acc)[2][2][4][2], const Unit& u, int wr, int wc, int fr, int fq) const {
        const int row0 = u.pm * BM + wr * 64 + fr, col0 = u.pn * BM + wc * 32 + 8 * fq;
#pragma unroll
        for (int ai = 0; ai < 2; ++ai)
#pragma unroll
            for (int m = 0; m < 4; ++m) { bf16_t* rowp = O + (size_t)(row0 + ai * HALF + m * 16) * PW + col0;
#pragma unroll
                for (int bj = 0; bj < 2; ++bj) { const f32x4 v0 = acc[ai][bj][m][0], v1 = acc[ai][bj][m][1]; u32x4 w;
                    w.x = cvt_pk_bf16(v0[0], v0[1]); w.y = cvt_pk_bf16(v0[2], v0[3]); w.z = cvt_pk_bf16(v1[0], v1[1]); w.w = cvt_pk_bf16(v1[2], v1[3]);
                    *(u32x4*)(rowp + bj * HALF) = w; } }
    }
};
struct EpiMerge {
    static constexpr int PERM = 1; static constexpr bool F8 = false; static constexpr int SA = 0, SB = 0; const bf16_t* proj; bf16_t* O;
    __device__ __forceinline__ bool keep(const Unit& u) const { return u.aux == 0; }
    __device__ __forceinline__ void operator()(f32x4 (&acc)[2][2][4][2], const Unit& u, int wr, int wc, int fr, int fq) const {
        const int row0 = u.pm * BM + wr * 64 + fr, col0 = u.pn * BM + wc * 32 + 8 * fq;
#pragma unroll
        for (int ai = 0; ai < 2; ++ai)
#pragma unroll
            for (int m = 0; m < 4; ++m) { const size_t r = (size_t)(row0 + ai * HALF + m * 16);
#pragma unroll
                for (int bj = 0; bj < 2; ++bj) {
                    const u32x4 gb = *(const u32x4*)(proj + r * PW + C_MGB + col0 + bj * HALF);
                    const f32x4 eb0 = {__expf(-bflo(gb.x)), __expf(-bfhi(gb.x)), __expf(-bflo(gb.y)), __expf(-bfhi(gb.y))};
                    const f32x4 eb1 = {__expf(-bflo(gb.z)), __expf(-bfhi(gb.z)), __expf(-bflo(gb.w)), __expf(-bfhi(gb.w))};
                    if (u.aux == 0) {
                        const u32x4 ga = *(const u32x4*)(proj + r * PW + C_MGA + col0 + bj * HALF);
                        const f32x4 ea0 = {__expf(-bflo(ga.x)), __expf(-bfhi(ga.x)), __expf(-bflo(ga.y)), __expf(-bfhi(ga.y))};
                        const f32x4 ea1 = {__expf(-bflo(ga.z)), __expf(-bfhi(ga.z)), __expf(-bflo(ga.w)), __expf(-bfhi(ga.w))};
#pragma unroll
                        for (int j = 0; j < 4; ++j) { acc[ai][bj][m][0][j] *= (1.f + eb0[j]) * rcpf_(1.f + ea0[j]); acc[ai][bj][m][1][j] *= (1.f + eb1[j]) * rcpf_(1.f + ea1[j]); }
                    } else {
                        f32x4 v0 = acc[ai][bj][m][0], v1 = acc[ai][bj][m][1];
#pragma unroll
                        for (int j = 0; j < 4; ++j) { v0[j] *= rcpf_(1.f + eb0[j]); v1[j] *= rcpf_(1.f + eb1[j]); }
                        u32x4 w; w.x = cvt_pk_bf16(v0[0], v0[1]); w.y = cvt_pk_bf16(v0[2], v0[3]); w.z = cvt_pk_bf16(v1[0], v1[1]); w.w = cvt_pk_bf16(v1[2], v1[3]);
                        *(u32x4*)(O + r * D + col0 + bj * HALF) = w;
                    } } }
    }
};
struct EpiResid {
    static constexpr int PERM = 0; static constexpr bool F8 = false; static constexpr int SA = 0, SB = 0; const float* x; const float* gt; float* O;
    __device__ __forceinline__ bool keep(const Unit&) const { return false; }
    __device__ __forceinline__ void operator()(f32x4 (&acc)[2][2][4][2], const Unit& u, int wr, int wc, int fr, int fq) const {
        const int row0 = u.pm * BM + wr * 64 + fr, col0 = u.pn * BM + wc * 32 + 4 * fq;
        f32x4 g[2][2];
#pragma unroll
        for (int bj = 0; bj < 2; ++bj)
#pragma unroll
            for (int n = 0; n < 2; ++n) g[bj][n] = *(const f32x4*)(gt + col0 + bj * HALF + n * 16);
#pragma unroll
        for (int ai = 0; ai < 2; ++ai)
#pragma unroll
            for (int m = 0; m < 4; ++m) { const size_t ro = (size_t)(row0 + ai * HALF + m * 16) * D + col0;
#pragma unroll
                for (int bj = 0; bj < 2; ++bj)
#pragma unroll
                    for (int n = 0; n < 2; ++n) { const f32x4 xv = *(const f32x4*)(x + ro + bj * HALF + n * 16); *(f32x4*)(O + ro + bj * HALF + n * 16) = xv + g[bj][n] * acc[ai][bj][m][n]; } }
    }
};
struct EpiSwiglu {
    static constexpr int PERM = 2; static constexpr bool F8 = true; static constexpr int SA = 0x7d7d7d7d, SB = 0x79797979; unsigned char* hid;
    __device__ __forceinline__ bool keep(const Unit&) const { return false; }
    __device__ __forceinline__ void operator()(f32x4 (&acc)[2][2][4][2], const Unit& u, int wr, int wc, int fr, int fq) const {
        const int row0 = u.pm + wr * 64 + fr, j0 = u.pn * 128 + wc * 32 + 8 * fq;
#pragma unroll
        for (int ai = 0; ai < 2; ++ai)
#pragma unroll
            for (int m = 0; m < 4; ++m) { unsigned char* rowp = hid + (unsigned)((row0 + ai * HALF + m * 16) * FF + j0);
                unsigned w2[2];
#pragma unroll
                for (int bj = 0; bj < 2; ++bj) { const f32x4 g = acc[ai][bj][m][0], up = acc[ai][bj][m][1];
                    w2[bj] = cvt4_fp8(8.f * siluf_(g[0]) * up[0], 8.f * siluf_(g[1]) * up[1], 8.f * siluf_(g[2]) * up[2], 8.f * siluf_(g[3]) * up[3]); }
                *(u32x2*)rowp = (u32x2){w2[0], w2[1]};
                asm volatile("" ::: "memory"); __builtin_amdgcn_sched_barrier(0); }
    }
};
struct EpiDown {
    static constexpr int PERM = 2; static constexpr bool F8 = true; static constexpr int SA = 0x7c7c7c7c, SB = 0x7a7a7a7a; unsigned char* Y; LAS const float* wl;
    __device__ __forceinline__ bool keep(const Unit&) const { return false; }
    __device__ __forceinline__ void operator()(f32x4 (&acc)[2][2][4][2], const Unit& u, int wr, int wc, int fr, int fq) const {
        const int row0 = u.pm + wr * 64 + fr, col0 = u.pn * BM + wc * 64 + 16 * fq;
#pragma unroll
        for (int ai = 0; ai < 2; ++ai)
#pragma unroll
            for (int m = 0; m < 4; ++m) { const int r = row0 + ai * HALF + m * 16; const float wt = wl[u.aux * 256 + wr * 64 + fr + ai * HALF + m * 16] * 16.f; unsigned char* rowp = Y + ((unsigned)r * D + col0);
                unsigned w4[4];
#pragma unroll
                for (int bj = 0; bj < 2; ++bj) { const f32x4 v0 = acc[ai][bj][m][0] * wt, v1 = acc[ai][bj][m][1] * wt;
                    w4[bj * 2] = cvt4_fp8(v0[0], v0[1], v0[2], v0[3]); w4[bj * 2 + 1] = cvt4_fp8(v1[0], v1[1], v1[2], v1[3]); }
                *(u32x4*)rowp = (u32x4){w4[0], w4[1], w4[2], w4[3]};
                asm volatile("" ::: "memory"); __builtin_amdgcn_sched_barrier(0); }
    }
};
}

struct Ctx {
    const float *x, *c, *w_ada, *b_ada, *norm1_g, *norm2_g, *w_in, *lb_table, *hgrn_onorm_g, *conv_w, *a_log, *dt_bias, *gdn_onorm_g, *w_bh, *w_bg, *w_out, *w_router, *router_bias,
        *w_eg, *w_eu, *w_ed, *w_sg, *w_su, *w_sd, *normf_g;
    float* out;
    unsigned* bar;
    float *modp, *mod, *lb, *gab;
    int *idx, *cnt, *tok_p, *pos, *blk_row, *blk_exp, *nent;
    float *wts, *w_p;
    bf16_t *win_t, *wa_t, *wb_t, *wout_t, *h1, *proj, *ocat, *merged;
    float *gq, *gk, *gv, *gbeta, *gdec, *oa, *ob;
    float *hL, *hS, *hD;
    float *gAT, *gB, *gS; unsigned char *gBlob, *gM;
    unsigned char *dn_t, *hid, *gu_t, *h2, *Y;
    bf16_t* rwimg; float* rbias2; int *tile_cnt, *rnk;
};

typedef const __attribute__((address_space(4))) Ctx CtxK;

__device__ __forceinline__ void cvt_tile(LAS float* t, const float* srcA, const float* srcB, int ld, int mode, bf16_t* dst, int ldd) {
    const int tid = ltid(), kr = tid >> 6, cl = tid & 63;
    const float* sp = (mode == 1 && cl >= 32) ? (srcB + cl - 32) : (srcA + cl);
    float v[8];
#pragma unroll
    for (int p = 0; p < 8; ++p) v[p] = sp[(size_t)(p * 8 + kr) * ld];
    __syncthreads();
#pragma unroll
    for (int p = 0; p < 8; ++p) t[(p * 8 + kr) * 65 + cl] = v[p];
    __syncthreads();
    const int r = tid >> 3, seg = (tid & 7) * 8;
    const int lc = mode == 1 ? (((r >> 2) & 1) * 32 + 4 * (r >> 3) + (r & 3)) : r;
    float w[8];
#pragma unroll
    for (int j = 0; j < 8; ++j) w[j] = t[(seg + j) * 65 + lc];
    u32x4 o; o.x = cvt_pk_bf16(w[0], w[1]); o.y = cvt_pk_bf16(w[2], w[3]); o.z = cvt_pk_bf16(w[4], w[5]); o.w = cvt_pk_bf16(w[6], w[7]);
    *(u32x4*)(dst + (size_t)r * ldd + seg) = o;
}
__device__ __forceinline__ void cvt_tile8(LAS float* t, const float* srcA, const float* srcB, int ld, int mode, unsigned char* dst, int ldd, float scale) {
    const int tid = ltid(), kr = tid >> 6, cl = tid & 63;
    const float* sp = (mode == 1 && cl >= 32) ? (srcB + cl - 32) : (srcA + cl);
    float v[8];
#pragma unroll
    for (int p = 0; p < 8; ++p) v[p] = sp[(size_t)(p * 8 + kr) * ld];
    __syncthreads();
#pragma unroll
    for (int p = 0; p < 8; ++p) t[(p * 8 + kr) * 65 + cl] = v[p] * scale;
    __syncthreads();
    const int r = tid >> 3, seg = (tid & 7) * 8;
    const int lc = mode == 1 ? (((r >> 2) & 1) * 32 + 4 * (r >> 3) + (r & 3)) : r;
    float w[8];
#pragma unroll
    for (int j = 0; j < 8; ++j) w[j] = t[(seg + j) * 65 + lc];
    *(u32x2*)(dst + (size_t)r * ldd + seg) = (u32x2){cvt4_fp8(w[0], w[1], w[2], w[3]), cvt4_fp8(w[4], w[5], w[6], w[7])};
}
__device__ __forceinline__ void cvt_job(LAS float* t, int tile, const float* src, int ld, int K, bf16_t* dst) {
    const int nkt = K / 64, nt = tile / nkt, kt = tile % nkt;
    cvt_tile(t, src + (size_t)kt * 64 * ld + nt * 64, nullptr, ld, 0, dst + (size_t)nt * 64 * K + kt * 64, K);
}

__device__ void ph_pro1(CtxK& c, LAS unsigned char* lds) {
    const int tid = ltid(), wg = blockIdx.x, G = gridDim.x;
    LAS float* lf = (LAS float*)lds;
    for (int job = wg; job < 192; job += G) {
        const int cc = job % 48, kp = job / 48, q = tid & 63, rg = tid >> 6;
        f32x4 a = {0.f, 0.f, 0.f, 0.f};
        for (int r0 = rg; r0 < 512; r0 += 256) { f32x4 w[32]; float s[32];
#pragma unroll
            for (int u = 0; u < 32; ++u) { const int k = kp * 512 + r0 + u * 8; w[u] = *(const f32x4*)(c.w_ada + (size_t)k * (6 * D) + cc * 256 + q * 4); s[u] = c.c[k]; }
#pragma unroll
            for (int u = 0; u < 32; ++u) a += siluf_(s[u]) * w[u]; }
        __syncthreads();
        *(LAS f32x4*)(lf + (rg * 64 + q) * 4) = a;
        __syncthreads();
        if (tid < 64) { f32x4 s = {0.f, 0.f, 0.f, 0.f};
#pragma unroll
            for (int g = 0; g < 8; ++g) s += *(LAS f32x4*)(lf + (g * 64 + tid) * 4);
            *(f32x4*)(c.modp + (size_t)kp * (6 * D) + cc * 256 + tid * 4) = s; }
    }
    if (wg == G - 1) for (int j = tid; j < 1024; j += 512) c.lb[j] = 1.f / (1.f + expf(c.lb_table[1024 + j] - c.lb_table[j]));
    {
        const int kr = tid >> 6, cl = tid & 63, r = tid >> 3, seg = (tid & 7) * 8;
        float v[8][8];
        const int t0 = wg < 192 ? wg : 5376 + (wg - 192), tstep = wg < 192 ? 192 : 64, ntl = wg < 192 ? 28 : 44;
#define P1_DESC(T_) const float* sp_; bf16_t* dp_; int ld_, ldd_; { const int T = (T_); \
            if (T < 6144) { const int nt = T / 32, kt = T % 32, sc = nt * 64 + (nt * 64 >= WIN_GAB ? 16 : 0); sp_ = c.w_in + (size_t)kt * 64 * INW + sc; ld_ = INW; dp_ = c.win_t + (size_t)nt * 64 * D + kt * 64; ldd_ = D; } \
            else { const float* s0_; bf16_t* d0_; int K_, t_; if (T < 6656) { t_ = T - 6144; s0_ = c.w_bh; d0_ = c.wa_t; K_ = 1024; } else if (T < 7168) { t_ = T - 6656; s0_ = c.w_bg; d0_ = c.wb_t; K_ = 1024; } else { t_ = T - 7168; s0_ = c.w_out; d0_ = c.wout_t; K_ = 2048; } \
                const int nkt = K_ / 64, nt = t_ / nkt, kt = t_ % nkt; sp_ = s0_ + (size_t)kt * 64 * D + nt * 64; ld_ = D; dp_ = d0_ + (size_t)nt * 64 * K_ + kt * 64; ldd_ = K_; } }
#define P1_LOAD(i0_) do { _Pragma("unroll") for (int j = 0; j < 8; ++j) if ((i0_) + j < ntl) { P1_DESC(t0 + ((i0_) + j) * tstep) (void)dp_; (void)ldd_; const float* s_ = sp_ + cl; \
            _Pragma("unroll") for (int p = 0; p < 8; ++p) v[j][p] = s_[(size_t)(p * 8 + kr) * ld_]; } } while (0)
        P1_LOAD(0);
        for (int i0 = 0; i0 < ntl; i0 += 8) {
            __syncthreads();
#pragma unroll
            for (int j = 0; j < 8; ++j) if (i0 + j < ntl) {
#pragma unroll
                for (int p = 0; p < 8; ++p) lf[j * 4160 + (p * 8 + kr) * 65 + cl] = v[j][p]; }
            __syncthreads();
            if (i0 + 8 < ntl) P1_LOAD(i0 + 8);
#pragma unroll
            for (int j = 0; j < 8; ++j) if (i0 + j < ntl) { P1_DESC(t0 + (i0 + j) * tstep) (void)sp_; (void)ld_;
                float w[8];
#pragma unroll
                for (int jj = 0; jj < 8; ++jj) w[jj] = lf[j * 4160 + (seg + jj) * 65 + r];
                u32x4 o; o.x = cvt_pk_bf16(w[0], w[1]); o.y = cvt_pk_bf16(w[2], w[3]); o.z = cvt_pk_bf16(w[4], w[5]); o.w = cvt_pk_bf16(w[6], w[7]);
                *(u32x4*)(dp_ + (size_t)r * ldd_ + seg) = o; }
        }
#undef P1_LOAD
#undef P1_DESC
    }
}
__device__ void ph_norm1(CtxK& c, LAS unsigned char* lds) {
    const int tid = ltid(), wg = blockIdx.x, G = gridDim.x, lane = tid & 63, wv = tid >> 6;
    LAS float* la = (LAS float*)lds;
    LAS float* lb_ = la + D;
    LAS float* lw = lb_ + D;
    for (int j = tid; j < D; j += 512) {
        float sh = c.b_ada[j], sc = c.b_ada[D + j];
#pragma unroll
        for (int p = 0; p < 4; ++p) { sh += c.modp[(size_t)p * 6 * D + j]; sc += c.modp[(size_t)p * 6 * D + D + j]; }
        la[j] = c.norm1_g[j] * (1.f + sc); lb_[j] = sh;
    }
    for (int j = wg * 512 + tid; j < 6 * D; j += G * 512) { float m = c.b_ada[j];
#pragma unroll
        for (int p = 0; p < 4; ++p) m += c.modp[(size_t)p * 6 * D + j];
        c.mod[j] = m; }
    for (int i = tid; i < D * 4; i += 512) { const int e = i >> 2, q = i & 3; const f32x4 w = *(const f32x4*)(c.w_in + (size_t)e * INW + WIN_GAB + q * 4);
        lw[(q * 4 + 0) * D + e] = w[0]; lw[(q * 4 + 1) * D + e] = w[1]; lw[(q * 4 + 2) * D + e] = w[2]; lw[(q * 4 + 3) * D + e] = w[3]; }
    __syncthreads();
    f32x4 vn[8];
    { const float* xr = c.x + (size_t)(wg * 8 + wv) * D;
#pragma unroll
      for (int i = 0; i < 8; ++i) vn[i] = *(const f32x4*)(xr + i * 256 + lane * 4); }
    for (int row = wg * 8 + wv; row < S; row += G * 8) {
        f32x4 v[8]; float ss = 0.f;
#pragma unroll
        for (int i = 0; i < 8; ++i) { v[i] = vn[i]; ss += v[i][0] * v[i][0] + v[i][1] * v[i][1] + v[i][2] * v[i][2] + v[i][3] * v[i][3]; }
        if (row + G * 8 < S) { const float* xr = c.x + (size_t)(row + G * 8) * D;
#pragma unroll
            for (int i = 0; i < 8; ++i) vn[i] = *(const f32x4*)(xr + i * 256 + lane * 4); }
        ss = wave_sum(ss); const float r = rsqrtf(ss * (1.f / D) + 1e-6f);
#pragma unroll
        for (int i = 0; i < 8; ++i) { const int e = i * 256 + lane * 4; const f32x4 a = *(LAS f32x4*)(la + e), b = *(LAS f32x4*)(lb_ + e); v[i] = v[i] * r * a + b;
            u32x2 w; w.x = cvt_pk_bf16(v[i][0], v[i][1]); w.y = cvt_pk_bf16(v[i][2], v[i][3]); *(u32x2*)(c.h1 + (size_t)row * D + e) = w; }
        float mine = 0.f;
        for (int cc = 0; cc < 16; ++cc) { float d = 0.f;
#pragma unroll
            for (int i = 0; i < 8; ++i) { const f32x4 w = *(LAS f32x4*)(lw + cc * D + i * 256 + lane * 4); d += v[i][0] * w[0] + v[i][1] * w[1] + v[i][2] * w[2] + v[i][3] * w[3]; }
            d = wave_sum_dpp(d); if (lane == cc) mine = d; }
        if (lane < 16) c.gab[(size_t)row * 16 + lane] = mine;
    }
    { const int id = wg * 512 + tid, i = id >> 6, e = id & 63;
      if (id < D * 64) {
          float sc = c.b_ada[4 * D + i];
#pragma unroll
          for (int p = 0; p < 4; ++p) sc += c.modp[(size_t)p * 6 * D + 4 * D + i];
          const float w = c.norm2_g[i] * (1.f + sc) * c.w_router[id];
          const unsigned hi = cvt_pk_bf16(w, w) & 0xffffu; const float lo = w - __uint_as_float(hi << 16);
          const int ch = i >> 7, kk = i & 127;
          c.rwimg[((ch * 2 + 0) * 64 + e) * 136 + kk] = (bf16_t)hi; c.rwimg[((ch * 2 + 1) * 64 + e) * 136 + kk] = (bf16_t)(cvt_pk_bf16(lo, lo) & 0xffffu);
      } }
    if (wg < 64) {
        __syncthreads();
        float a = 0.f;
        for (int i = tid; i < D; i += 512) { float sh = c.b_ada[3 * D + i];
#pragma unroll
            for (int p = 0; p < 4; ++p) sh += c.modp[(size_t)p * 6 * D + 3 * D + i];
            a += sh * c.w_router[i * 64 + wg]; }
        a = wave_sum(a); if (lane == 0) la[wv] = a; __syncthreads();
        if (tid == 0) c.rbias2[wg] = la[0] + la[1] + la[2] + la[3] + la[4] + la[5] + la[6] + la[7];
    }
}
__device__ void ph_gemm1(CtxK& c, LAS unsigned char* lds) {
    gm::DenseSched Sd; Sd.init(S, PW, D, D, c.win_t, nullptr, 1); gm::EpiProj E{c.proj};
    gm::gphase(lds, (const char*)c.h1, D, Sd, E);
}
__device__ void ph_gemm2(CtxK& c, LAS unsigned char* lds) {
    gm::DenseSched Sd; Sd.init(S, D, 1024, 2048, c.wa_t, c.wb_t, 2); gm::EpiMerge E{c.proj, c.merged};
    gm::gphase(lds, (const char*)c.ocat, 1024, Sd, E);
}
__device__ void ph_gemm3(CtxK& c, LAS unsigned char* lds) {
    gm::DenseSched Sd; Sd.init(S, D, D, D, c.wout_t, nullptr, 1); gm::EpiResid E{c.x, c.mod + 2 * D, c.out};
    gm::gphase(lds, (const char*)c.merged, D, Sd, E);
}
__device__ void ph_moe_gu(CtxK& c, LAS unsigned char* lds) {
    gm::MoeSched<true, 4, D / 2, D / 2, (size_t)1024 * D> Sm; Sm.init(lds, c.nent, c.blk_row, c.blk_exp, c.tok_p, c.gu_t); gm::EpiSwiglu E{c.hid};
    gm::gphase(lds, (const char*)c.h2, D / 2, Sm, E);
}
__device__ void ph_moe_dn(CtxK& c, LAS unsigned char* lds) {
    gm::MoeSched<false, 8, FF / 2, FF / 2, (size_t)D * FF> Sm; Sm.init(lds, c.nent, c.blk_row, c.blk_exp, c.tok_p, c.dn_t); Sm.wp = c.w_p; gm::EpiDown E{c.Y, (LAS const float*)(lds + Sm.TOK)};
    gm::gphase(lds, (const char*)c.hid, FF / 2, Sm, E);
}
__device__ void ph_cvt_exp(CtxK& c, LAS unsigned char* lds) {
    LAS float* lf = (LAS float*)lds; const int wg = blockIdx.x - 8, G = gridDim.x - 8;
    if (wg < 0) return;
    const int tid = ltid(), kr = tid >> 6, cl = tid & 63, r = tid >> 3, seg = (tid & 7) * 8;
    constexpr int NG_GU = NEX * 128, NGRP = NEX * 192;
    float v[4][8];
#define CE_DESC(q_) const float* sp_; unsigned char* dp_; int ld_, ldd_, js_, jd_, mode_; float scale_; { const int gq_ = (q_); \
        if (gq_ < NG_GU) { const int e = gq_ >> 7, rr = gq_ & 127, ng = rr >> 5, kt = rr & 31; const float* sg = e < NE ? c.w_eg + (size_t)e * D * FF : c.w_sg; const float* su = e < NE ? c.w_eu + (size_t)e * D * FF : c.w_su; \
            sp_ = (cl >= 32 ? su + cl - 32 : sg + cl) + (size_t)kt * 64 * FF + ng * 128; ld_ = FF; js_ = 32; dp_ = c.gu_t + ((size_t)e * 1024 + ng * 256) * D + kt * 64; ldd_ = D; jd_ = 64 * D; mode_ = 1; scale_ = 64.f; } \
        else { const int q2 = gq_ - NG_GU, e = q2 >> 6, rr = q2 & 63, ng = rr >> 3, kt = rr & 7; const float* sd = e < NE ? c.w_ed + (size_t)e * FF * D : c.w_sd; \
            sp_ = sd + cl + (size_t)kt * 64 * D + ng * 256; ld_ = D; js_ = 64; dp_ = c.dn_t + (size_t)e * D * FF + (size_t)ng * 256 * FF + kt * 64; ldd_ = FF; jd_ = 64 * FF; mode_ = 0; scale_ = 32.f; } }
#define CE_LOAD(q_) do { CE_DESC(q_) (void)dp_; (void)ldd_; (void)jd_; (void)mode_; (void)scale_; \
        _Pragma("unroll") for (int j = 0; j < 4; ++j) _Pragma("unroll") for (int p = 0; p < 8; ++p) v[j][p] = sp_[(size_t)(p * 8 + kr) * ld_ + j * js_]; } while (0)
    if (wg < NGRP) CE_LOAD(wg);
    for (int q = wg; q < NGRP; q += G) {
        CE_DESC(q) (void)sp_; (void)ld_; (void)js_;
        __syncthreads();
#pragma unroll
        for (int j = 0; j < 4; ++j)
#pragma unroll
            for (int p = 0; p < 8; ++p) lf[j * 4160 + (p * 8 + kr) * 65 + cl] = v[j][p] * scale_;
        __syncthreads();
        if (q + G < NGRP) CE_LOAD(q + G);
        const int lc = mode_ == 1 ? (((r >> 2) & 1) * 32 + 4 * (r >> 3) + (r & 3)) : r;
#pragma unroll
        for (int j = 0; j < 4; ++j) { float w[8];
#pragma unroll
            for (int jj = 0; jj < 8; ++jj) w[jj] = lf[j * 4160 + (seg + jj) * 65 + lc];
            *(u32x2*)(dp_ + (size_t)j * jd_ + (size_t)r * ldd_ + seg) = (u32x2){cvt4_fp8(w[0], w[1], w[2], w[3]), cvt4_fp8(w[4], w[5], w[6], w[7])}; }
    }
#undef CE_LOAD
#undef CE_DESC
}
__device__ void ph_final(CtxK& c, LAS unsigned char* lds) {
    const int tid = ltid(), wg = blockIdx.x, G = gridDim.x, lane = tid & 63, wv = tid >> 6;
    const float* gt2 = c.mod + 5 * D;
    for (int row0 = (wg * 8 + wv) * 2; row0 < S; row0 += G * 16) {
        int p[2][9];
#pragma unroll
        for (int rr = 0; rr < 2; ++rr) {
#pragma unroll
            for (int k = 0; k < 8; ++k) p[rr][k] = c.pos[(row0 + rr) * TOPK + k];
            p[rr][8] = PROUTED + row0 + rr; }
        f32x4 v[2][4][2]; float ss[2] = {0.f, 0.f};
#pragma unroll
        for (int rr = 0; rr < 2; ++rr) {
#pragma unroll
            for (int i = 0; i < 4; ++i) {
                const int e = i * 512 + lane * 8; f32x4 a0 = {0.f, 0.f, 0.f, 0.f}, a1 = {0.f, 0.f, 0.f, 0.f};
#pragma unroll
                for (int k = 0; k < 9; ++k) { const u32x2 y = *(const u32x2*)(c.Y + (size_t)p[rr][k] * D + e);
                    const auto q0 = __builtin_amdgcn_cvt_pk_f32_fp8((int)y.x, false), q1 = __builtin_amdgcn_cvt_pk_f32_fp8((int)y.x, true), q2 = __builtin_amdgcn_cvt_pk_f32_fp8((int)y.y, false), q3 = __builtin_amdgcn_cvt_pk_f32_fp8((int)y.y, true);
                    a0[0] += q0[0]; a0[1] += q0[1]; a0[2] += q1[0]; a0[3] += q1[1]; a1[0] += q2[0]; a1[1] += q2[1]; a1[2] += q3[0]; a1[3] += q3[1]; }
                const float* xp = c.out + (size_t)(row0 + rr) * D + e;
                const f32x4 x0 = *(const f32x4*)xp, x1 = *(const f32x4*)(xp + 4), g0 = *(const f32x4*)(gt2 + e) * 0.0625f, g1 = *(const f32x4*)(gt2 + e + 4) * 0.0625f;
                v[rr][i][0] = x0 + g0 * a0; v[rr][i][1] = x1 + g1 * a1;
#pragma unroll
                for (int j = 0; j < 4; ++j) ss[rr] += v[rr][i][0][j] * v[rr][i][0][j] + v[rr][i][1][j] * v[rr][i][1][j];
            } }
#pragma unroll
        for (int rr = 0; rr < 2; ++rr) {
            const float r = rsqrtf(wave_sum_dpp(ss[rr]) * (1.f / D) + 1e-6f);
#pragma unroll
            for (int i = 0; i < 4; ++i) { const int e = i * 512 + lane * 8; float* op = c.out + (size_t)(row0 + rr) * D + e;
                *(f32x4*)op = v[rr][i][0] * r * *(const f32x4*)(c.normf_g + e); *(f32x4*)(op + 4) = v[rr][i][1] * r * *(const f32x4*)(c.normf_g + e + 4); } }
    }
}

namespace mx {
constexpr int ST128 = 272, ST64 = 144;
constexpr int FRAG_F4 = 8 * 8 * 64;
__device__ __forceinline__ f32x4 mfma16(bf16x8 a, bf16x8 b, f32x4 c) { return __builtin_amdgcn_mfma_f32_16x16x32_bf16(a, b, c, 0, 0, 0); }
template <int MT, int KS>
__device__ __forceinline__ void mma_nt(f32x4 (&acc)[MT], LAS const unsigned char* xs, int sx, LAS const unsigned char* ys, int sy, int fr, int fq) {
#pragma unroll
    for (int kk = 0; kk < KS; ++kk) {
        const bf16x8 b = *(const LAS bf16x8*)(ys + fr * sy + (kk * 32 + fq * 8) * 2);
#pragma unroll
        for (int m = 0; m < MT; ++m) { const bf16x8 a = *(const LAS bf16x8*)(xs + (16 * m + fr) * sx + (kk * 32 + fq * 8) * 2); acc[m] = mfma16(a, b, acc[m]); }
    }
}
__device__ __forceinline__ void lds_fence() { asm volatile("s_waitcnt lgkmcnt(0)" ::: "memory"); }
__device__ __forceinline__ u32x4 pack8(const float (&v)[8]) { u32x4 o; o.x = cvt_pk_bf16(v[0], v[1]); o.y = cvt_pk_bf16(v[2], v[3]); o.z = cvt_pk_bf16(v[4], v[5]); o.w = cvt_pk_bf16(v[6], v[7]); return o; }
__device__ __forceinline__ void unpack8(const u32x4 w, float (&v)[8]) { v[0] = bflo(w.x); v[1] = bfhi(w.x); v[2] = bflo(w.y); v[3] = bfhi(w.y); v[4] = bflo(w.z); v[5] = bfhi(w.z); v[6] = bflo(w.w); v[7] = bfhi(w.w); }
__device__ __forceinline__ void mfma_pad8(f32x4 (&a)[8]) { asm volatile("s_nop 15\n\ts_nop 7" : "+v"(a[0]), "+v"(a[1]), "+v"(a[2]), "+v"(a[3]), "+v"(a[4]), "+v"(a[5]), "+v"(a[6]), "+v"(a[7])); }
__device__ __forceinline__ void mfma_pad4(f32x4 (&a)[4]) { asm volatile("s_nop 15\n\ts_nop 7" : "+v"(a[0]), "+v"(a[1]), "+v"(a[2]), "+v"(a[3])); }
__device__ __forceinline__ void write_st(LAS unsigned char* stw, f32x4 (&S)[8], int fr, int fq) {
    mfma_pad8(S);
#pragma unroll
    for (int m = 0; m < 8; ++m) { u32x2 w; w.x = cvt_pk_bf16(S[m][0], S[m][1]); w.y = cvt_pk_bf16(S[m][2], S[m][3]); *(LAS u32x2*)(stw + fr * ST128 + (16 * m + 4 * fq) * 2) = w; }
}

__device__ __forceinline__ void gate_issue(u32x4 (&gp)[2], const bf16_t* gate0) {
    const int t_ = ltid(); const bf16_t* p = gate0 + (size_t)(t_ >> 3) * PW + (t_ & 7) * 16;
    gp[0] = *(const u32x4*)p; gp[1] = *(const u32x4*)(p + 8);
}
__device__ __forceinline__ void out_stage(LAS unsigned char* ot, LAS float* part, const f32x4 (&o)[4], const u32x4 (&gp)[2], const float* gnorm, bf16_t* out0, int wv, int lane, int fr, int fq) {
    float s_ = 0.f;
#pragma unroll
    for (int w = 0; w < 8; ++w) s_ += part[w * 64 + lane];
    const float rv = rsqrtf(s_ * (1.f / 128.f) + 1e-6f);
    const float gn = gnorm[wv * 16 + fr];
#pragma unroll
    for (int m = 0; m < 4; ++m)
#pragma unroll
        for (int r = 0; r < 4; ++r) { const int cc = 16 * m + 4 * fq + r; const float x = o[m][r] * __shfl(rv, cc) * gn;
            *(LAS bf16_t*)(ot + cc * ST128 + (wv * 16 + fr) * 2) = (bf16_t)(cvt_pk_bf16(x, x) & 0xffffu); }
    __syncthreads();
    const int t_ = ltid(), cc = t_ >> 3, sg = (t_ & 7) * 16;
#pragma unroll
    for (int hh = 0; hh < 2; ++hh) { float ov[8], gv[8];
        unpack8(*(LAS u32x4*)(ot + cc * ST128 + (sg + hh * 8) * 2), ov); unpack8(gp[hh], gv);
#pragma unroll
        for (int j = 0; j < 8; ++j) ov[j] *= siluf_(gv[j]);
        *(u32x4*)(out0 + (size_t)cc * D + sg + hh * 8) = pack8(ov); }
}

constexpr int H_QT = 0, H_KT = 17408, H_QI = 34816, H_KU = 52224, H_VT = 70656, H_P = 89088, H_DEC = 98304, H_OCT = 98816, H_F4 = H_OCT + 8192, H_PART = H_F4 + 512, H_RINV = H_PART + 2048, H_ST = H_RINV + 256, H_LB = H_ST + 8 * 16 * ST128, H_END = H_LB + 512;
static_assert(H_END <= 147456, "hgrn lds");
template <bool OUT>
__device__ void hgrn_pass(CtxK& c, LAS unsigned char* lds) {
    const int tid = ltid(), wv = __builtin_amdgcn_readfirstlane(tid >> 6), lane = tid & 63, fr = lane & 15, fq = lane >> 4;
    LAS float* dec = (LAS float*)(lds + H_DEC); LAS float* oct = (LAS float*)(lds + H_OCT); LAS float* f4 = (LAS float*)(lds + H_F4);
    LAS float* part = (LAS float*)(lds + H_PART); LAS float* rinv = (LAS float*)(lds + H_RINV);
    LAS unsigned char* stw = lds + H_ST + wv * 16 * ST128;
    {
        const int wu = blockIdx.x, h = wu & 7, g = wu >> 3;
        f32x4 Sacc[8];
#pragma unroll
        for (int m = 0; m < 8; ++m) Sacc[m] = (f32x4){0.f, 0.f, 0.f, 0.f};
        if (OUT) {
            if (g > 0) { const f32x4* sp = (const f32x4*)c.hS + (size_t)(h * 32 + g) * FRAG_F4 + (wv * 8) * 64 + lane;
#pragma unroll
                for (int m = 0; m < 8; ++m) Sacc[m] = sp[m * 64]; }
            write_st(stw, Sacc, fr, fq);
        }
        LAS float* lbs = (LAS float*)(lds + H_LB);
        if (tid < 128) lbs[tid] = c.lb[h * 128 + tid];
        __syncthreads();
        float dsum = 0.f;
        u32x4 pf[4], pv[4];
#define HP_ISSUE(i_) do { const int tq_ = ltid(), rl_ = tq_ >> 8; const bf16_t* b_ = c.proj + (size_t)((g * 8 + (i_)) * 64 + ((tq_ >> 4) & 15) * 4) * PW + h * 128 + (tq_ & 15) * 8; \
        if (rl_ == 1 || OUT) { _Pragma("unroll") for (int tt = 0; tt < 4; ++tt) pf[tt] = *(const u32x4*)(b_ + (size_t)tt * PW + C_HF); } \
        if (rl_ == 0) { _Pragma("unroll") for (int tt = 0; tt < 4; ++tt) pv[tt] = *(const u32x4*)(b_ + (size_t)tt * PW + C_HI); } } while (0)
        HP_ISSUE(0);
        for (int i = 0; i < 8; ++i) {
            const int T0 = (g * 8 + i) * 64;
            const int tp = ltid(), role = tp >> 8, tq = (tp >> 4) & 15, co = tp & 15, c0 = tq * 4, d0 = co * 8;
            const bool cum = role == 1 || OUT;
            float cs[4][8];
            if (cum) {
                float lbv[8];
                { const f32x4 l0 = *(LAS f32x4*)(lbs + d0), l1 = *(LAS f32x4*)(lbs + d0 + 4);
                  lbv[0] = l0[0]; lbv[1] = l0[1]; lbv[2] = l0[2]; lbv[3] = l0[3]; lbv[4] = l1[0]; lbv[5] = l1[1]; lbv[6] = l1[2]; lbv[7] = l1[3]; }
#pragma unroll
                for (int tt = 0; tt < 4; ++tt) {
                    float fv[8]; unpack8(pf[tt], fv);
#pragma unroll
                    for (int j = 0; j < 8; ++j) { const float lf = __logf(lbv[j] + (1.f - lbv[j]) * sigmoidf_(fv[j])); cs[tt][j] = tt ? cs[tt - 1][j] + lf : lf; }
                }
                if (role == 1) {
                    *(LAS f32x4*)(oct + tq * 128 + d0) = (f32x4){cs[3][0], cs[3][1], cs[3][2], cs[3][3]}; *(LAS f32x4*)(oct + tq * 128 + d0 + 4) = (f32x4){cs[3][4], cs[3][5], cs[3][6], cs[3][7]};
                    if (tq == 8) { *(LAS f32x4*)(f4 + d0) = (f32x4){cs[0][0], cs[0][1], cs[0][2], cs[0][3]}; *(LAS f32x4*)(f4 + d0 + 4) = (f32x4){cs[0][4], cs[0][5], cs[0][6], cs[0][7]}; }
                }
            }
            if (role == 0) {
#pragma unroll
                for (int j = 0; j < 8; j += 2) { const int wi = j >> 1; u32x2 w0, w1;
                    const unsigned a0 = wi == 0 ? pv[0].x : wi == 1 ? pv[0].y : wi == 2 ? pv[0].z : pv[0].w, a1 = wi == 0 ? pv[1].x : wi == 1 ? pv[1].y : wi == 2 ? pv[1].z : pv[1].w;
                    const unsigned a2 = wi == 0 ? pv[2].x : wi == 1 ? pv[2].y : wi == 2 ? pv[2].z : pv[2].w, a3 = wi == 0 ? pv[3].x : wi == 1 ? pv[3].y : wi == 2 ? pv[3].z : pv[3].w;
                    w0.x = (a0 & 0xffffu) | (a1 << 16); w0.y = (a2 & 0xffffu) | (a3 << 16);
                    w1.x = (a0 >> 16) | (a1 & 0xffff0000u); w1.y = (a2 >> 16) | (a3 & 0xffff0000u);
                    *(LAS u32x2*)(lds + H_VT + (d0 + j) * ST64 + c0 * 2) = w0; *(LAS u32x2*)(lds + H_VT + (d0 + j + 1) * ST64 + c0 * 2) = w1; }
            }
            __syncthreads();
            if (cum) {
                float pre[8], tot[8], bmid[8];
#pragma unroll
                for (int j = 0; j < 8; ++j) { pre[j] = 0.f; tot[j] = 0.f; bmid[j] = 0.f; }
#pragma unroll
                for (int o = 0; o < 16; ++o) { const f32x4 x0 = *(LAS f32x4*)(oct + o * 128 + d0), x1 = *(LAS f32x4*)(oct + o * 128 + d0 + 4);
#pragma unroll
                    for (int j = 0; j < 8; ++j) { const float x = j < 4 ? x0[j] : x1[j - 4]; pre[j] += o < tq ? x : 0.f; bmid[j] += o < 8 ? x : 0.f; tot[j] += x; } }
                { const f32x4 x0 = *(LAS f32x4*)(f4 + d0), x1 = *(LAS f32x4*)(f4 + d0 + 4);
#pragma unroll
                  for (int j = 0; j < 8; ++j) bmid[j] += j < 4 ? x0[j] : x1[j - 4]; }
                if (role == 0) {
                    float ebm[8];
#pragma unroll
                    for (int j = 0; j < 8; ++j) ebm[j] = __expf(bmid[j]);
#pragma unroll
                    for (int tt = 0; tt < 4; ++tt) {
                        float qv[8], q1[8], q2[8];
                        unpack8(*(const u32x4*)(c.proj + (size_t)(T0 + c0 + tt) * PW + C_HQ + h * 128 + d0), qv);
#pragma unroll
                        for (int j = 0; j < 8; ++j) { const float q = siluf_(qv[j]) * 0.08838834764831845f; q1[j] = q * __expf(pre[j] + cs[tt][j] - bmid[j]); q2[j] = q1[j] * ebm[j]; }
                        *(LAS u32x4*)(lds + H_QT + (c0 + tt) * ST128 + d0 * 2) = pack8(q1); *(LAS u32x4*)(lds + H_QI + (c0 + tt) * ST128 + d0 * 2) = pack8(q2);
                    }
                } else {
                    if (tq == 0) {
#pragma unroll
                        for (int j = 0; j < 8; ++j) dec[d0 + j] = __expf(tot[j]);
                    }
                    if (OUT) {
#pragma unroll
                        for (int tt = 0; tt < 4; ++tt) {
                            float k1[8];
#pragma unroll
                            for (int j = 0; j < 8; ++j) { const float lf = tt ? cs[tt][j] - cs[tt - 1][j] : cs[0][j]; k1[j] = (1.f - __expf(lf)) * __expf(bmid[j] - pre[j] - cs[tt][j]); }
                            *(LAS u32x4*)(lds + H_KT + (c0 + tt) * ST128 + d0 * 2) = pack8(k1);
                        }
                    }
#pragma unroll
                    for (int j = 0; j < 8; ++j) { float col[4];
#pragma unroll
                        for (int tt = 0; tt < 4; ++tt) { const float lf = tt ? cs[tt][j] - cs[tt - 1][j] : cs[0][j]; col[tt] = (1.f - __expf(lf)) * __expf(tot[j] - pre[j] - cs[tt][j]); }
                        u32x2 w; w.x = cvt_pk_bf16(col[0], col[1]); w.y = cvt_pk_bf16(col[2], col[3]);
                        *(LAS u32x2*)(lds + H_KU + (d0 + j) * ST64 + c0 * 2) = w; }
                }
            }
            __syncthreads();
            if (i + 1 < 8) HP_ISSUE(i + 1);
            u32x4 gpre[2];
            if (OUT) gate_issue(gpre, c.proj + (size_t)T0 * PW + C_HG + h * 128);
            if (!OUT && tid < 128) dsum += __logf(dec[tid]);
            f32x4 oacc[4];
            if (OUT) {
                { f32x4 sc[2] = {(f32x4){0.f, 0.f, 0.f, 0.f}, (f32x4){0.f, 0.f, 0.f, 0.f}};
                  const int nt = wv & 3, mb = (wv >> 2) * 2;
                  mma_nt<2, 4>(sc, lds + H_KT + mb * 16 * ST128, ST128, lds + H_QT + nt * 16 * ST128, ST128, fr, fq);
#pragma unroll
                  for (int m = 0; m < 2; ++m) { const int cc = nt * 16 + fr, s0 = (mb + m) * 16 + 4 * fq; u32x2 w;
                      w.x = cvt_pk_bf16(s0 + 0 <= cc ? sc[m][0] : 0.f, s0 + 1 <= cc ? sc[m][1] : 0.f); w.y = cvt_pk_bf16(s0 + 2 <= cc ? sc[m][2] : 0.f, s0 + 3 <= cc ? sc[m][3] : 0.f);
                      *(LAS u32x2*)(lds + H_P + cc * ST64 + s0 * 2) = w; } }
                __syncthreads();
#pragma unroll
                for (int m = 0; m < 4; ++m) oacc[m] = (f32x4){0.f, 0.f, 0.f, 0.f};
                mma_nt<4, 2>(oacc, lds + H_P, ST64, lds + H_VT + wv * 16 * ST64, ST64, fr, fq);
                mma_nt<4, 4>(oacc, lds + H_QI, ST128, stw, ST128, fr, fq);
#pragma unroll
                for (int m = 0; m < 4; ++m)
#pragma unroll
                    for (int r = 0; r < 4; ++r) { float q = oacc[m][r] * oacc[m][r]; q += __shfl_xor(q, 1); q += __shfl_xor(q, 2); q += __shfl_xor(q, 4); q += __shfl_xor(q, 8); if (fr == 0) part[wv * 64 + 16 * m + 4 * fq + r] = q; }
            }
#pragma unroll
            for (int m = 0; m < 8; ++m) { const f32x4 dv = *(LAS f32x4*)(dec + 16 * m + 4 * fq); Sacc[m] = Sacc[m] * dv; }
            mma_nt<8, 2>(Sacc, lds + H_KU, ST64, lds + H_VT + wv * 16 * ST64, ST64, fr, fq);
            if (OUT) {
                lds_fence();
                write_st(stw, Sacc, fr, fq);
                __syncthreads();
                out_stage(lds + H_QT, part, oacc, gpre, c.hgrn_onorm_g, c.ocat + (size_t)T0 * D + h * 128, wv, lane, fr, fq);
            }
            __syncthreads();
        }
#undef HP_ISSUE
        if (!OUT) {
            f32x4* sp = (f32x4*)c.hL + (size_t)(h * 32 + g) * FRAG_F4 + (wv * 8) * 64 + lane;
#pragma unroll
            for (int m = 0; m < 8; ++m) sp[m * 64] = Sacc[m];
            if (tid < 128) c.hD[(h * 32 + g) * 128 + tid] = __expf(dsum);
        }
    }
}
__device__ void hgrn_scan(CtxK& c) {
    if (ltid() >= 128) return;
    const int e = blockIdx.x * 128 + ltid();
    if (e >= 8 * FRAG_F4) return;
    const int h = e / FRAG_F4, fi = e % FRAG_F4, m = (fi >> 6) & 7, lane = fi & 63, d0 = 16 * m + 4 * (lane >> 4);
    f32x4 s = {0.f, 0.f, 0.f, 0.f};
    for (int g0 = 0; g0 < 31; g0 += 16) {
        f32x4 dc[16], hl[16];
#pragma unroll
        for (int u = 0; u < 16; ++u) if (g0 + u < 31) { dc[u] = *(const f32x4*)(c.hD + (h * 32 + g0 + u) * 128 + d0); hl[u] = ((const f32x4*)c.hL)[(size_t)(h * 32 + g0 + u) * FRAG_F4 + fi]; }
#pragma unroll
        for (int u = 0; u < 16; ++u) if (g0 + u < 31) { s = s * dc[u] + hl[u]; ((f32x4*)c.hS)[(size_t)(h * 32 + g0 + u + 1) * FRAG_F4 + fi] = s; }
    }
}

constexpr int B_T = 0, B_KBG = 9216, B_KU = 26624, B_VB = 45056, B_QD = 63488, B_AT = 80896, B_SC = 90112, BLOB = 90368;
constexpr int G_ST = BLOB, G_RV = G_ST + 8 * 16 * ST128, G_PART = G_RV + 8 * 16 * ST64, G_RINV = G_PART + 2048, G_END = G_RINV + 256;
static_assert(G_END <= 147456, "gdn lds");
constexpr int P_K = 0, P_Q = 17408, P_BETA = 34816, P_GC = P_BETA + 256, P_EG = P_GC + 256, P_EK = P_EG + 256;

__device__ void gdn_prep(CtxK& c, LAS unsigned char* lds, int h, int g) {
    const int tid = ltid(), wv = __builtin_amdgcn_readfirstlane(tid >> 6), lane = tid & 63, fr = lane & 15, fq = lane >> 4;
    LAS float* sbeta = (LAS float*)(lds + P_BETA); LAS float* sgc = (LAS float*)(lds + P_GC); LAS float* seg = (LAS float*)(lds + P_EG); LAS float* sek = (LAS float*)(lds + P_EK);
    u32x4 raw[11];
#define GR_ISSUE(i_) do { const int tq_ = ltid(); if (tq_ < 384) { const int T_ = (g * 8 + (i_)) * 64 + ((tq_ >> 4) & 7) * 8 - 3; const bf16_t* b_ = c.proj + C_GQKV + (tq_ >> 7) * 1024 + h * 128 + (tq_ & 15) * 8; \
        _Pragma("unroll") for (int r = 0; r < 11; ++r) raw[r] = T_ + r >= 0 ? *(const u32x4*)(b_ + (size_t)(T_ + r) * PW) : (u32x4){0u, 0u, 0u, 0u}; } } while (0)
    GR_ISSUE(0);
    for (int i = 0; i < 8; ++i) {
        const int n = g * 8 + i, T0 = n * 64;
        unsigned char* blob = (unsigned char*)c.gBlob + (size_t)(h * 256 + n) * BLOB;
        if (wv == 0) {
            const float ga = c.gab[(size_t)(T0 + lane) * 16 + h], gb = c.gab[(size_t)(T0 + lane) * 16 + 8 + h];
            const float gl_ = -__expf(c.a_log[h]) * softplusf_(ga + c.dt_bias[h]);
            float gc = gl_;
#pragma unroll
            for (int o = 1; o < 64; o <<= 1) { const float t_ = __shfl_up(gc, o); if (lane >= o) gc += t_; }
            const float glast = __shfl(gc, 63);
            sbeta[lane] = sigmoidf_(gb); sgc[lane] = gc; seg[lane] = __expf(gc); sek[lane] = __expf(glast - gc);
            if (lane == 0) *(float*)(blob + B_SC) = __expf(glast);
        }
        __syncthreads();
        const int tp = ltid(), part = tp >> 7, to = (tp >> 4) & 7, co = tp & 15, c0 = to * 8, d0 = co * 8;
        if (tp < 384) {
            const int chb = part * 1024 + h * 128 + d0;
            float val[8][8];
            {
                float wj[4][8];
#pragma unroll
                for (int j = 0; j < 4; ++j) { const f32x4 a = *(const f32x4*)(c.conv_w + j * 3072 + chb), b = *(const f32x4*)(c.conv_w + j * 3072 + chb + 4);
                    wj[j][0] = a[0]; wj[j][1] = a[1]; wj[j][2] = a[2]; wj[j][3] = a[3]; wj[j][4] = b[0]; wj[j][5] = b[1]; wj[j][6] = b[2]; wj[j][7] = b[3]; }
#pragma unroll
                for (int tt = 0; tt < 8; ++tt) {
                    float a[8] = {0.f, 0.f, 0.f, 0.f, 0.f, 0.f, 0.f, 0.f};
#pragma unroll
                    for (int j = 0; j < 4; ++j) { float xv[8]; unpack8(raw[tt + j], xv);
#pragma unroll
                        for (int jj = 0; jj < 8; ++jj) a[jj] += wj[j][jj] * xv[jj]; }
#pragma unroll
                    for (int jj = 0; jj < 8; ++jj) val[tt][jj] = siluf_(a[jj]);
                }
            }
            if (part < 2) {
#pragma unroll
                for (int tt = 0; tt < 8; ++tt) { float ss = 0.f;
#pragma unroll
                    for (int jj = 0; jj < 8; ++jj) ss += val[tt][jj] * val[tt][jj];
                    ss += __shfl_xor(ss, 1); ss += __shfl_xor(ss, 2); ss += __shfl_xor(ss, 4); ss += __shfl_xor(ss, 8);
                    const float rn = rsqrtf(ss + 1e-6f) * (part == 0 ? 0.08838834764831845f : 1.f);
#pragma unroll
                    for (int jj = 0; jj < 8; ++jj) val[tt][jj] *= rn; }
            }
            if (part == 0) {
#pragma unroll
                for (int tt = 0; tt < 8; ++tt) { const int cc = c0 + tt; *(LAS u32x4*)(lds + P_Q + cc * ST128 + d0 * 2) = pack8(val[tt]);
                    const float e = seg[cc]; float qd[8];
#pragma unroll
                    for (int jj = 0; jj < 8; ++jj) qd[jj] = val[tt][jj] * e;
                    *(u32x4*)(blob + B_QD + cc * ST128 + d0 * 2) = pack8(qd); }
            } else if (part == 1) {
#pragma unroll
                for (int tt = 0; tt < 8; ++tt) { const int cc = c0 + tt; *(LAS u32x4*)(lds + P_K + cc * ST128 + d0 * 2) = pack8(val[tt]);
                    const float e = seg[cc] * sbeta[cc]; float kb[8];
#pragma unroll
                    for (int jj = 0; jj < 8; ++jj) kb[jj] = val[tt][jj] * e;
                    *(u32x4*)(blob + B_KBG + cc * ST128 + d0 * 2) = pack8(kb); }
#pragma unroll
                for (int jj = 0; jj < 8; ++jj) { float col[8];
#pragma unroll
                    for (int tt = 0; tt < 8; ++tt) col[tt] = val[tt][jj] * sek[c0 + tt];
                    *(u32x4*)(blob + B_KU + (d0 + jj) * ST64 + c0 * 2) = pack8(col); }
            } else {
#pragma unroll
                for (int jj = 0; jj < 8; ++jj) { float col[8];
#pragma unroll
                    for (int tt = 0; tt < 8; ++tt) col[tt] = val[tt][jj] * sbeta[c0 + tt];
                    *(u32x4*)(blob + B_VB + (d0 + jj) * ST64 + c0 * 2) = pack8(col); }
            }
        }
        __syncthreads();
        if (i + 1 < 8) GR_ISSUE(i + 1);
        {
            const int nt = wv & 3, mb = (wv >> 2) * 2, jj = nt * 16 + fr;
            f32x4 kk2[2] = {(f32x4){0.f, 0.f, 0.f, 0.f}, (f32x4){0.f, 0.f, 0.f, 0.f}}, at2[2] = {(f32x4){0.f, 0.f, 0.f, 0.f}, (f32x4){0.f, 0.f, 0.f, 0.f}};
            mma_nt<2, 4>(kk2, lds + P_K + mb * 16 * ST128, ST128, lds + P_K + nt * 16 * ST128, ST128, fr, fq);
            mma_nt<2, 4>(at2, lds + P_K + mb * 16 * ST128, ST128, lds + P_Q + nt * 16 * ST128, ST128, fr, fq);
            float* at = c.gAT + (size_t)(h * 256 + n) * 4096;
            const float gj = sgc[jj];
#pragma unroll
            for (int m = 0; m < 2; ++m) { const int i0 = (mb + m) * 16 + 4 * fq; f32x4 av; float pv[4];
#pragma unroll
                for (int r = 0; r < 4; ++r) { const int ii = i0 + r; const float gi = sgc[ii];
                    av[r] = jj < ii ? sbeta[ii] * kk2[m][r] * __expf(gi - gj) : 0.f;
                    pv[r] = ii <= jj ? at2[m][r] * __expf(gj - gi) : 0.f; }
                *(f32x4*)(at + jj * 64 + i0) = av;
                u32x2 w; w.x = cvt_pk_bf16(pv[0], pv[1]); w.y = cvt_pk_bf16(pv[2], pv[3]);
                *(u32x2*)(blob + B_AT + jj * ST64 + i0 * 2) = w; }
        }
        __syncthreads();
    }
}
__device__ void gdn_invert(CtxK& c, LAS unsigned char* lds, int h, int g) {
    const int tid = ltid(), wv = __builtin_amdgcn_readfirstlane(tid >> 6), lane = tid & 63;
    const int n = g * 8 + wv;
    LAS float* at = (LAS float*)(lds + wv * 16384);
    const float* src = c.gAT + (size_t)(h * 256 + n) * 4096;
#pragma unroll
    for (int k = 0; k < 16; ++k) *(LAS f32x4*)(at + (k * 64 + lane) * 4) = *(const f32x4*)(src + (k * 64 + lane) * 4);
    lds_fence();
    float r[64];
    unsigned ata = (unsigned)(size_t)at;
#pragma unroll
    for (int j = 63; j >= 0; --j) {
        float acc = lane == j ? 1.f : 0.f;
        LAS const float* arow = (LAS const float*)(size_t)ata + j * 64;
#pragma unroll
        for (int m4 = ((j + 1) & ~3); m4 < 64; m4 += 4) {
            const f32x4 a = *(LAS const f32x4*)(arow + m4);
#pragma unroll
            for (int q = 0; q < 4; ++q) if (m4 + q > j) acc = __builtin_fmaf(-r[m4 + q], a[q], acc);
        }
        r[j] = acc;
        asm volatile("" : "+v"(ata) : "v"(acc));
    }
    unsigned char* blob = (unsigned char*)c.gBlob + (size_t)(h * 256 + n) * BLOB;
#pragma unroll
    for (int k = 0; k < 8; ++k) { float v8[8];
#pragma unroll
        for (int q = 0; q < 8; ++q) v8[q] = r[k * 8 + q];
        *(u32x4*)(blob + B_T + lane * ST64 + k * 16) = pack8(v8); }
}
template <int MODE>
__device__ void gdn_pass(CtxK& c, LAS unsigned char* lds, int h, int g) {
    const int tid = ltid(), wv = __builtin_amdgcn_readfirstlane(tid >> 6), lane = tid & 63, fr = lane & 15, fq = lane >> 4;
    LAS unsigned char* stw = lds + G_ST + wv * 16 * ST128; LAS unsigned char* rvw = lds + G_RV + wv * 16 * ST64;
    LAS float* part = (LAS float*)(lds + G_PART); LAS float* rinv = (LAS float*)(lds + G_RINV);
    f32x4 Sacc[8];
#pragma unroll
    for (int m = 0; m < 8; ++m) {
        if (MODE == 1) { const int v = 16 * wv + fr, d0 = 16 * m + 4 * fq; Sacc[m] = (f32x4){d0 == v ? 1.f : 0.f, d0 + 1 == v ? 1.f : 0.f, d0 + 2 == v ? 1.f : 0.f, d0 + 3 == v ? 1.f : 0.f}; }
        else Sacc[m] = (f32x4){0.f, 0.f, 0.f, 0.f};
    }
    if (MODE == 2 && g > 0) { const f32x4* sp = (const f32x4*)c.gS + (size_t)(h * 32 + g) * FRAG_F4 + (wv * 8) * 64 + lane;
#pragma unroll
        for (int m = 0; m < 8; ++m) Sacc[m] = sp[m * 64]; }
    write_st(stw, Sacc, fr, fq);
    constexpr int LIM = MODE == 2 ? B_SC : B_QD, NQ = (LIM + 8191) / 8192;
    u32x4 pre[NQ];
    const unsigned char* blob0 = (const unsigned char*)c.gBlob + (size_t)(h * 256 + g * 8) * BLOB;
#define GP_ISSUE(i_) do { const unsigned char* bp_ = blob0 + (size_t)(i_) * BLOB + ltid() * 16; _Pragma("unroll") for (int q = 0; q < NQ; ++q) if (q * 8192 + 8176 < LIM || ltid() * 16 + q * 8192 < LIM) pre[q] = *(const u32x4*)(bp_ + q * 8192); } while (0)
    GP_ISSUE(0);
    for (int i = 0; i < 8; ++i) {
        const int n = g * 8 + i, T0 = n * 64;
        { const int tl = ltid() * 16;
#pragma unroll
          for (int q = 0; q < NQ; ++q) if (q * 8192 + 8176 < LIM || tl + q * 8192 < LIM) *(LAS u32x4*)(lds + tl + q * 8192) = pre[q]; }
        const float dlast = *(const float*)(blob0 + (size_t)i * BLOB + B_SC);
        u32x4 gpre[2];
        if (MODE == 2) gate_issue(gpre, c.proj + (size_t)T0 * PW + C_GG + h * 128);
        __syncthreads();
        if (i + 1 < 8) GP_ISSUE(i + 1);
        { f32x4 R[4];
#pragma unroll
          for (int m = 0; m < 4; ++m) R[m] = (f32x4){0.f, 0.f, 0.f, 0.f};
          mma_nt<4, 4>(R, lds + B_KBG, ST128, stw, ST128, fr, fq);
#pragma unroll
          for (int m = 0; m < 4; ++m) { float x0 = 0.f, x1 = 0.f, x2 = 0.f, x3 = 0.f;
              if (MODE != 1) { const u32x2 vb = *(LAS u32x2*)(lds + B_VB + (16 * wv + fr) * ST64 + (16 * m + 4 * fq) * 2); x0 = bflo(vb.x); x1 = bfhi(vb.x); x2 = bflo(vb.y); x3 = bfhi(vb.y); }
              u32x2 w; w.x = cvt_pk_bf16(x0 - R[m][0], x1 - R[m][1]); w.y = cvt_pk_bf16(x2 - R[m][2], x3 - R[m][3]);
              *(LAS u32x2*)(rvw + fr * ST64 + (16 * m + 4 * fq) * 2) = w; } }
        lds_fence();
        { f32x4 VN[4];
#pragma unroll
          for (int m = 0; m < 4; ++m) VN[m] = (f32x4){0.f, 0.f, 0.f, 0.f};
          mma_nt<4, 2>(VN, lds + B_T, ST64, rvw, ST64, fr, fq);
          mfma_pad4(VN); lds_fence();
#pragma unroll
          for (int m = 0; m < 4; ++m) { u32x2 w; w.x = cvt_pk_bf16(VN[m][0], VN[m][1]); w.y = cvt_pk_bf16(VN[m][2], VN[m][3]); *(LAS u32x2*)(rvw + fr * ST64 + (16 * m + 4 * fq) * 2) = w; } }
        lds_fence();
        f32x4 O[4];
        if (MODE == 2) {
#pragma unroll
            for (int m = 0; m < 4; ++m) O[m] = (f32x4){0.f, 0.f, 0.f, 0.f};
            mma_nt<4, 4>(O, lds + B_QD, ST128, stw, ST128, fr, fq);
            mma_nt<4, 2>(O, lds + B_AT, ST64, rvw, ST64, fr, fq);
#pragma unroll
            for (int m = 0; m < 4; ++m)
#pragma unroll
                for (int r = 0; r < 4; ++r) { float q = O[m][r] * O[m][r]; q += __shfl_xor(q, 1); q += __shfl_xor(q, 2); q += __shfl_xor(q, 4); q += __shfl_xor(q, 8); if (fr == 0) part[wv * 64 + 16 * m + 4 * fq + r] = q; }
        }
#pragma unroll
        for (int m = 0; m < 8; ++m) Sacc[m] = Sacc[m] * dlast;
        mma_nt<8, 2>(Sacc, lds + B_KU, ST64, rvw, ST64, fr, fq);
        lds_fence();
        write_st(stw, Sacc, fr, fq);
        if (MODE == 2) {
            __syncthreads();
            out_stage(lds + B_KBG, part, O, gpre, c.gdn_onorm_g, c.ocat + (size_t)T0 * D + 1024 + h * 128, wv, lane, fr, fq);
        }
        __syncthreads();
    }
#undef GP_ISSUE
    if (MODE == 0) {
        f32x4* sp = (f32x4*)c.gB + (size_t)(h * 32 + g) * FRAG_F4 + (wv * 8) * 64 + lane;
#pragma unroll
        for (int m = 0; m < 8; ++m) sp[m * 64] = Sacc[m];
    }
    if (MODE == 1) {
        mfma_pad8(Sacc);
        LAS bf16_t* img = (LAS bf16_t*)lds;
#pragma unroll
        for (int m = 0; m < 8; ++m)
#pragma unroll
            for (int r = 0; r < 4; ++r) img[(16 * m + 4 * fq + r) * (ST128 / 2) + 16 * wv + fr] = (bf16_t)(cvt_pk_bf16(Sacc[m][r], Sacc[m][r]) & 0xffffu);
        __syncthreads();
        unsigned char* dst = (unsigned char*)c.gM + (size_t)(h * 32 + g) * (128 * ST128);
#pragma unroll
        for (int q = 0; q < 5; ++q) { const int o = tid * 16 + q * 8192; if (q < 4 || o < 128 * ST128) *(u32x4*)(dst + o) = *(LAS u32x4*)(lds + o); }
        __syncthreads();
    }
}
__device__ void gdn_scan(CtxK& c, LAS unsigned char* lds, int h) {
    const int tid = ltid(), wv = __builtin_amdgcn_readfirstlane(tid >> 6), lane = tid & 63, fr = lane & 15, fq = lane >> 4;
    LAS unsigned char* stw = lds + G_ST + wv * 16 * ST128;
    f32x4 Sacc[8], Bn[8]; u32x4 mp[5];
#pragma unroll
    for (int m = 0; m < 8; ++m) Sacc[m] = (f32x4){0.f, 0.f, 0.f, 0.f};
#define GS_ISSUE(g_) do { const unsigned char* src_ = (const unsigned char*)c.gM + (size_t)(h * 32 + (g_)) * (128 * ST128) + tid * 16; \
        _Pragma("unroll") for (int q = 0; q < 5; ++q) if (q < 4 || tid * 16 + q * 8192 < 128 * ST128) mp[q] = *(const u32x4*)(src_ + q * 8192); \
        const f32x4* bp_ = (const f32x4*)c.gB + (size_t)(h * 32 + (g_)) * FRAG_F4 + (wv * 8) * 64 + lane; \
        _Pragma("unroll") for (int m = 0; m < 8; ++m) Bn[m] = bp_[m * 64]; } while (0)
    GS_ISSUE(0);
    for (int g = 0; g < 31; ++g) {
#pragma unroll
        for (int q = 0; q < 5; ++q) if (q < 4 || tid * 16 + q * 8192 < 128 * ST128) *(LAS u32x4*)(lds + tid * 16 + q * 8192) = mp[q];
        write_st(stw, Sacc, fr, fq);
#pragma unroll
        for (int m = 0; m < 8; ++m) Sacc[m] = Bn[m];
        __syncthreads();
        if (g + 1 < 31) GS_ISSUE(g + 1);
        mma_nt<8, 4>(Sacc, lds, ST128, stw, ST128, fr, fq);
        f32x4* sp = (f32x4*)c.gS + (size_t)(h * 32 + g + 1) * FRAG_F4 + (wv * 8) * 64 + lane;
#pragma unroll
        for (int m = 0; m < 8; ++m) sp[m * 64] = Sacc[m];
        __syncthreads();
    }
#undef GS_ISSUE
}
}
__device__ void ph_hgrn1(CtxK& c, LAS unsigned char* lds) { mx::hgrn_pass<false>(c, lds); }
__device__ void ph_hgrn2(CtxK& c, LAS unsigned char* lds) { mx::hgrn_scan(c); }
__device__ void ph_hgrn3(CtxK& c, LAS unsigned char* lds) { mx::hgrn_pass<true>(c, lds); }
__device__ void ph_gdn1(CtxK& c, LAS unsigned char* lds) {
    const int wu = blockIdx.x, h = wu & 7, g = wu >> 3;
    mx::gdn_prep(c, lds, h, g); __syncthreads();
    asm volatile("s_waitcnt vmcnt(0)" ::: "memory"); __syncthreads();
    mx::gdn_invert(c, lds, h, g);
    asm volatile("s_waitcnt vmcnt(0)" ::: "memory"); __syncthreads();
    mx::gdn_pass<0>(c, lds, h, g); __syncthreads();
    mx::gdn_pass<1>(c, lds, h, g); __syncthreads();
}
__device__ void ph_gdn2(CtxK& c, LAS unsigned char* lds) { if (blockIdx.x < 8) mx::gdn_scan(c, lds, blockIdx.x); }
__device__ void ph_gdn3(CtxK& c, LAS unsigned char* lds) { const int wu = blockIdx.x; mx::gdn_pass<2>(c, lds, wu & 7, wu >> 3); }

constexpr int N2_LA = 0, N2_LB = 8192, N2_XH = 16384, N2_XL = N2_XH + 17408, N2_Y = N2_XL + 17408, N2_LOG = N2_Y + 34816, N2_RS = N2_LOG + 64 * 65 * 4, N2_IDX = N2_RS + 256, N2_BIAS = N2_IDX + 2048, N2_END = N2_BIAS + 256;
static_assert(N2_END <= 147456, "norm2 lds");
__device__ void ph_norm2(CtxK& c, LAS unsigned char* lds) {
    const int tid = ltid(), wg = blockIdx.x, lane = tid & 63, wv = __builtin_amdgcn_readfirstlane(tid >> 6), fr = lane & 15, fq = lane >> 4;
    LAS float* la = (LAS float*)(lds + N2_LA); LAS float* lb_ = (LAS float*)(lds + N2_LB); LAS float* lg = (LAS float*)(lds + N2_LOG); LAS float* rs = (LAS float*)(lds + N2_RS);
    LAS int* idxt = (LAS int*)(lds + N2_IDX); LAS float* bias2 = (LAS float*)(lds + N2_BIAS);
    for (int j = tid; j < D; j += 512) { la[j] = c.norm2_g[j] * (1.f + c.mod[4 * D + j]); lb_[j] = c.mod[3 * D + j]; }
    if (tid < 64) bias2[tid] = c.rbias2[tid];
    __syncthreads();
    const int tok0 = wg * 64;
    f32x4 vn[8];
    { const float* xr = c.out + (size_t)(tok0 + wv * 8) * D;
#pragma unroll
      for (int i = 0; i < 8; ++i) vn[i] = *(const f32x4*)(xr + i * 256 + lane * 4); }
    for (int rr = 0; rr < 8; ++rr) {
        const int row = tok0 + wv * 8 + rr;
        f32x4 v[8]; float ss = 0.f;
#pragma unroll
        for (int i = 0; i < 8; ++i) { v[i] = vn[i]; ss += v[i][0] * v[i][0] + v[i][1] * v[i][1] + v[i][2] * v[i][2] + v[i][3] * v[i][3]; }
        if (rr + 1 < 8) { const float* xr = c.out + (size_t)(row + 1) * D;
#pragma unroll
            for (int i = 0; i < 8; ++i) vn[i] = *(const f32x4*)(xr + i * 256 + lane * 4); }
        ss = wave_sum(ss); const float r = rsqrtf(ss * (1.f / D) + 1e-6f);
        if (lane == 0) rs[wv * 8 + rr] = r;
#pragma unroll
        for (int i = 0; i < 8; ++i) { const int e = i * 256 + lane * 4; const f32x4 a = *(LAS f32x4*)(la + e), b = *(LAS f32x4*)(lb_ + e); const f32x4 y = v[i] * r * a + b;
            *(unsigned*)(c.h2 + (size_t)row * D + e) = cvt4_fp8(4.f * y[0], 4.f * y[1], 4.f * y[2], 4.f * y[3]); }
    }
    const int xrow = tid >> 3, xseg = (tid & 7) * 16;
    f32x4 xr_[4]; u32x4 yr_[5];
    auto issue = [&](int ch) {
        const float* xp = c.out + (size_t)(tok0 + xrow) * D + ch * 128 + xseg;
#pragma unroll
        for (int q = 0; q < 4; ++q) xr_[q] = *(const f32x4*)(xp + q * 4);
        const unsigned char* yp = (const unsigned char*)c.rwimg + (size_t)ch * 34816 + tid * 16;
#pragma unroll
        for (int q = 0; q < 4; ++q) yr_[q] = *(const u32x4*)(yp + q * 8192);
        if (tid < 128) yr_[4] = *(const u32x4*)(yp + 32768);
    };
    issue(0);
    f32x4 acc[2] = {(f32x4){0.f, 0.f, 0.f, 0.f}, (f32x4){0.f, 0.f, 0.f, 0.f}};
    const int mt = wv >> 1, nb = (wv & 1) * 2;
    for (int ch = 0; ch < 16; ++ch) {
        __syncthreads();
        { float hi[16], lo[16];
#pragma unroll
          for (int q = 0; q < 4; ++q)
#pragma unroll
              for (int j = 0; j < 4; ++j) { const float x = xr_[q][j]; const float h = __uint_as_float(cvt_pk_bf16(x, x) << 16); hi[q * 4 + j] = h; lo[q * 4 + j] = x - h; }
          float t8[8];
#pragma unroll
          for (int hh = 0; hh < 2; ++hh) {
#pragma unroll
              for (int j = 0; j < 8; ++j) t8[j] = hi[hh * 8 + j];
              *(LAS u32x4*)(lds + N2_XH + xrow * 272 + (xseg + hh * 8) * 2) = mx::pack8(t8);
#pragma unroll
              for (int j = 0; j < 8; ++j) t8[j] = lo[hh * 8 + j];
              *(LAS u32x4*)(lds + N2_XL + xrow * 272 + (xseg + hh * 8) * 2) = mx::pack8(t8); }
#pragma unroll
          for (int q = 0; q < 4; ++q) *(LAS u32x4*)(lds + N2_Y + tid * 16 + q * 8192) = yr_[q];
          if (tid < 128) *(LAS u32x4*)(lds + N2_Y + tid * 16 + 32768) = yr_[4]; }
        __syncthreads();
        if (ch + 1 < 16) issue(ch + 1);
#pragma unroll
        for (int kk = 0; kk < 4; ++kk) {
            const int ko = (kk * 32 + fq * 8) * 2;
            const bf16x8 ah = *(const LAS bf16x8*)(lds + N2_XH + (16 * mt + fr) * 272 + ko), al = *(const LAS bf16x8*)(lds + N2_XL + (16 * mt + fr) * 272 + ko);
#pragma unroll
            for (int n = 0; n < 2; ++n) {
                const bf16x8 bh = *(const LAS bf16x8*)(lds + N2_Y + (16 * (nb + n) + fr) * 272 + ko), bl = *(const LAS bf16x8*)(lds + N2_Y + 17408 + (16 * (nb + n) + fr) * 272 + ko);
                acc[n] = mx::mfma16(ah, bh, acc[n]); acc[n] = mx::mfma16(ah, bl, acc[n]); acc[n] = mx::mfma16(al, bh, acc[n]);
            }
        }
    }
#pragma unroll
    for (int n = 0; n < 2; ++n)
#pragma unroll
        for (int r = 0; r < 4; ++r) lg[(16 * mt + 4 * fq + r) * 65 + 16 * (nb + n) + fr] = acc[n][r];
    __syncthreads();
    const float rb = c.router_bias[lane], b2 = bias2[lane];
    for (int rr = 0; rr < 8; rr += 2) {
        float s[2], bb[2], mb[2], wsum[2] = {0.f, 0.f}; int myk[2] = {-1, -1};
#pragma unroll
        for (int u = 0; u < 2; ++u) {
            const int lr = wv * 8 + rr + u;
            s[u] = sigmoidf_(lg[lr * 65 + lane] * rs[lr] + b2); const float b = s[u] + rb; bb[u] = b;
            const float m7 = dppf<0x141>(b);
            const float o1 = dppf<0xB1>(b), o2 = dppf<0x4E>(b), o3 = dppf<0x1B>(b), o6 = dppf<0xB1>(m7), o5 = dppf<0x4E>(m7), o4 = dppf<0x1B>(m7);
            int rk = 0;
#define TK_CMP(ov, x) rk += ((ov) > b || ((ov) == b && (lane ^ (x)) < lane)) ? 1 : 0
            TK_CMP(o1, 1); TK_CMP(o2, 2); TK_CMP(o3, 3); TK_CMP(o4, 4); TK_CMP(o5, 5); TK_CMP(o6, 6); TK_CMP(m7, 7);
#undef TK_CMP
            float gs = rk < 2 ? b : 0.f; gs += dppf<0xB1>(gs); gs += dppf<0x4E>(gs); gs += dppf<0x141>(gs);
            int grk = 0; const int gi = lane >> 3;
#pragma unroll
            for (int j = 0; j < 8; ++j) { const float og = __builtin_bit_cast(float, __builtin_amdgcn_readlane(__builtin_bit_cast(int, gs), j * 8)); grk += (og > gs || (og == gs && j < gi)) ? 1 : 0; }
            mb[u] = grk < 4 ? b : -INFINITY; }
#pragma unroll
        for (int k = 0; k < TOPK; ++k)
#pragma unroll
            for (int u = 0; u < 2; ++u) {
                const float m = wave_max_dpp(mb[u]);
                const unsigned long long bal = __ballot(mb[u] == m); const int win = __builtin_amdgcn_readfirstlane(__ffsll((long long)bal) - 1);
                wsum[u] += __builtin_bit_cast(float, __builtin_amdgcn_readlane(__builtin_bit_cast(int, s[u]), win));
                if (lane == win) { mb[u] = -INFINITY; myk[u] = k; } }
#pragma unroll
        for (int u = 0; u < 2; ++u) { const int lr = wv * 8 + rr + u, t = tok0 + lr;
            if (myk[u] >= 0) { c.idx[t * TOPK + myk[u]] = lane; c.wts[t * TOPK + myk[u]] = s[u] / wsum[u] * 2.5f; idxt[lr * TOPK + myk[u]] = lane; } }
    }
    __syncthreads();
    { const int myexp = idxt[tid]; int rank = 0, cntl = 0;
      for (int e = 0; e < 64; ++e) {
          const unsigned long long bal = __ballot(myexp == e);
          const int below = __builtin_amdgcn_mbcnt_hi((unsigned)(bal >> 32), __builtin_amdgcn_mbcnt_lo((unsigned)bal, 0u));
          if (myexp == e) rank = below;
          if (lane == e) cntl = __popcll(bal); }
      LAS int* wcnt = (LAS int*)(lds + N2_XH);
      wcnt[wv * 64 + lane] = cntl;
      __syncthreads();
      int base = 0;
      for (int w = 0; w < wv; ++w) base += wcnt[w * 64 + myexp];
      c.rnk[wg * 512 + tid] = base + rank;
      if (tid < 64) { int n = 0;
#pragma unroll
          for (int w = 0; w < 8; ++w) n += wcnt[w * 64 + tid];
          c.tile_cnt[wg * 64 + tid] = n; } }
}
__device__ void ph_route(CtxK& c, LAS unsigned char* lds) {
    const int tid = ltid(), b = blockIdx.x, e = tid & 63, part = tid >> 6;
    LAS int* psum = (LAS int*)lds; LAS int* pbel = psum + 512; LAS int* tot = pbel + 512; LAS int* offb = tot + 64; LAS int* pst = offb + 64;
    { int sa = 0, sb = 0;
      for (int tl = part * 32; tl < part * 32 + 32; ++tl) { const int v = c.tile_cnt[tl * 64 + e]; sa += v; sb += tl < b ? v : 0; }
      psum[part * 64 + e] = sa; pbel[part * 64 + e] = sb; }
    __syncthreads();
    if (tid < 64) {
        int t_ = 0, o_ = 0;
#pragma unroll
        for (int q = 0; q < 8; ++q) { t_ += psum[q * 64 + e]; o_ += pbel[q * 64 + e]; }
        const int pad = (t_ + 255) & ~255; int inc = pad;
#pragma unroll
        for (int o = 1; o < 64; o <<= 1) { const int x = __shfl_up(inc, o); if (e >= o) inc += x; }
        const int ps = inc - pad;
        tot[e] = t_; offb[e] = o_; pst[e] = ps;
        if (b == 0) {
            const int b0 = ps >> 8, nbe = pad >> 8;
            for (int j = 0; j < nbe; ++j) { c.blk_row[b0 + j] = ps + j * 256; c.blk_exp[b0 + j] = e; }
            const int nbr = __shfl(inc, 63) >> 8;
            c.blk_row[nbr + e] = PROUTED + e * 256; c.blk_exp[nbr + e] = NE;
            if (e == 0) *c.nent = nbr + S / 256;
        }
        c.tok_p[PROUTED + b * 64 + e] = b * 64 + e; c.w_p[PROUTED + b * 64 + e] = 1.f;
    }
    __syncthreads();
    { const int p = b * 512 + tid, ex = c.idx[p], d = pst[ex] + offb[ex] + c.rnk[p];
      c.tok_p[d] = p >> 3; c.w_p[d] = c.wts[p]; c.pos[p] = d; }
    if (b < NE) { const int ps = pst[b], t_ = tot[b], pe = (t_ + 255) & ~255;
        for (int r = t_ + tid; r < pe; r += 512) { c.tok_p[ps + r] = 0; c.w_p[ps + r] = 0.f; } }
}

constexpr int LDS_BYTES = 163840, LDS_MAIN = LDS_BYTES - 16;
static_assert(gm::VBOFF + 512 * 8 <= LDS_MAIN, "lds map");
__global__ void __launch_bounds__(512, 2) k_mega(Ctx c) {
    extern __shared__ __attribute__((aligned(16))) unsigned char smem[];
    LAS unsigned char* lds = (LAS unsigned char*)smem;
    if (ltid() == 0) *(LAS u32x4*)(lds + LDS_MAIN) = (u32x4){0u, 0u, 0u, 0u};
    __syncthreads();
    CtxK* kp = (CtxK*)__builtin_amdgcn_kernarg_segment_ptr();
    (void)xcd_barrier_post(c.bar, (volatile LAS unsigned*)(lds + LDS_MAIN));
#define PHASE(fn) do { const CtxK* kp_ = kp; asm volatile("" : "+s"(kp_)); fn(*kp_, lds); __syncthreads(); } while (0)
#define GRID_BARRIER() do { const CtxK* kp_ = kp; asm volatile("" : "+s"(kp_)); XcdBarrier bb_; bb_.bar = kp_->bar; bb_.x = xb_xcc_id(); bb_.st = (volatile LAS unsigned*)(lds + LDS_MAIN); xcd_barrier(bb_); } while (0)
    PHASE(ph_pro1);      GRID_BARRIER();
    PHASE(ph_norm1);     GRID_BARRIER();
    PHASE(ph_gemm1);     GRID_BARRIER();
    PHASE(ph_hgrn1);     PHASE(ph_gdn1);  GRID_BARRIER();
    PHASE(ph_hgrn2);     PHASE(ph_gdn2);  PHASE(ph_cvt_exp); GRID_BARRIER();
    PHASE(ph_hgrn3);     PHASE(ph_gdn3);  GRID_BARRIER();
    PHASE(ph_gemm2);     GRID_BARRIER();
    PHASE(ph_gemm3);     GRID_BARRIER();
    PHASE(ph_norm2);     GRID_BARRIER();
    PHASE(ph_route);     GRID_BARRIER();
    PHASE(ph_moe_gu);    GRID_BARRIER();
    PHASE(ph_moe_dn);    GRID_BARRIER();
    PHASE(ph_final);
#undef PHASE
#undef GRID_BARRIER
}

extern "C" void kernel_launch(void* const* d_in, const int* in_sizes, int n_in, void* d_out, int out_size, void* d_ws, size_t ws_size, hipStream_t stream) {
    Ctx c{};
    const float** ip = (const float**)&c.x;
    for (int i = 0; i < 25; ++i) ip[i] = (const float*)d_in[i];
    c.out = (float*)d_out;
    char* ws = (char*)d_ws; constexpr size_t MB = 1024 * 1024;
    c.bar = (unsigned*)ws;
    c.modp = (float*)(ws + 64 * 1024); c.mod = (float*)(ws + 320 * 1024); c.lb = (float*)(ws + 384 * 1024);
    c.cnt = (int*)(ws + 392 * 1024); c.nent = (int*)(ws + 396 * 1024); c.blk_row = (int*)(ws + 400 * 1024); c.blk_exp = (int*)(ws + 404 * 1024);
    c.idx = (int*)(ws + 1 * MB); c.wts = (float*)(ws + 2 * MB); c.tok_p = (int*)(ws + 3 * MB); c.w_p = (float*)(ws + 4 * MB); c.pos = (int*)(ws + 5 * MB);
    c.gab = (float*)(ws + 6 * MB); c.gbeta = (float*)(ws + 7 * MB + 0); c.gdec = (float*)(ws + 7 * MB + 512 * 1024);
    c.rwimg = (bf16_t*)(ws + 8 * MB); c.rbias2 = (float*)(ws + 9 * MB); c.tile_cnt = (int*)(ws + 9 * MB + 4096); c.rnk = (int*)(ws + 10 * MB);
    char* big = ws + 16 * MB;
    auto at = [&](size_t mib) { return big + mib * MB; };
    c.dn_t = (unsigned char*)at(0); c.gu_t = (unsigned char*)at(130);
    c.win_t = (bf16_t*)at(0); c.h1 = (bf16_t*)at(48); c.gAT = (float*)at(112);
    c.proj = (bf16_t*)at(390); c.gBlob = (unsigned char*)at(774); c.merged = (bf16_t*)at(774);
    c.gM = (unsigned char*)at(951); c.gB = (float*)at(960); c.hL = (float*)at(976); c.gS = (float*)at(992); c.hS = (float*)at(1008); c.hD = (float*)at(1024);
    c.wa_t = (bf16_t*)at(1025); c.wb_t = (bf16_t*)at(1029); c.wout_t = (bf16_t*)at(1033); c.ocat = (bf16_t*)at(1041);
    c.Y = (unsigned char*)at(130); c.hid = (unsigned char*)at(770); c.h2 = (unsigned char*)at(930);
    static_assert((size_t)NEX * D * FF * 2 <= 130 * MB && (size_t)NEX * 1024 * D * 2 <= 260 * MB && (size_t)PW * D * 2 <= 48 * MB && (size_t)S * D * 2 <= 64 * MB, "map A");
    static_assert((size_t)S * PW * 2 <= 384 * MB && (size_t)2048 * mx::BLOB <= 177 * MB && (size_t)256 * 128 * mx::ST128 <= 9 * MB && (size_t)PTOT * D * 2 <= 640 * MB && (size_t)PTOT * FF * 2 <= 160 * MB, "map B");
    const size_t need = 16 * MB + 1105 * MB;
    if (ws_size < need) { fprintf(stderr, "kernel_launch: workspace too small: %zu < %zu\n", ws_size, need); return; }

    static int grid = 0;
    if (!grid) {
        int dev = 0, cus = 0, per_cu = 0;
        hipGetDevice(&dev); hipDeviceGetAttribute(&cus, hipDeviceAttributeMultiprocessorCount, dev);
        hipFuncSetAttribute((const void*)k_mega, hipFuncAttributeMaxDynamicSharedMemorySize, LDS_BYTES);
        hipOccupancyMaxActiveBlocksPerMultiprocessor(&per_cu, (const void*)k_mega, 512, LDS_BYTES);
        if (per_cu < 1) fprintf(stderr, "kernel_launch: occupancy query reports %d blocks per CU\n", per_cu);
        grid = cus;
        if (grid != 256) { fprintf(stderr, "kernel_launch: built for a 256-CU device (token-mixer units = workgroups); got %d CUs\n", cus); grid = -1; }
    }
    if (grid < 0) return;
    hipMemsetAsync(c.bar, 0, XCD_BAR_WORDS * sizeof(unsigned), stream);
    hipLaunchKernelGGL(k_mega, dim3(grid), dim3(512), LDS_BYTES, stream, c);
}
```

```cpp
#include <hip/hip_runtime.h>
#include <stdint.h>
#include <stdio.h>

#define LAS __attribute__((address_space(3)))
typedef unsigned short bf16_t;
typedef short bf16x8 __attribute__((ext_vector_type(8)));
typedef float f32x4 __attribute__((ext_vector_type(4)));
typedef unsigned u32x4 __attribute__((ext_vector_type(4)));
typedef unsigned u32x2 __attribute__((ext_vector_type(2)));
typedef int v4i __attribute__((ext_vector_type(4)));
typedef int v8i __attribute__((ext_vector_type(8)));

constexpr int S = 16384, D = 2048, INW = 12304, PW = 12288, NE = 64, TOPK = 8, TK = S * TOPK, FF = 512;
constexpr int NEX = NE + 1;
constexpr int PROUTED = 147456, PTOT = PROUTED + S, NBLK_MAX = PROUTED / 256;
constexpr int C_HQ = 0, C_HF = 1024, C_HI = 2048, C_HG = 3072, C_GQKV = 4096, C_GG = 7168, C_MGA = 8192, C_MGB = 10240;
constexpr int WIN_GAB = 7168;

__device__ __forceinline__ float rcpf_(float x) { return __builtin_amdgcn_rcpf(x); }
__device__ __forceinline__ float sigmoidf_(float x) { return rcpf_(1.f + __expf(-x)); }
__device__ __forceinline__ float siluf_(float x) { return x * rcpf_(1.f + __expf(-x)); }
__device__ __forceinline__ float softplusf_(float x) { return x > 20.f ? x : log1pf(expf(x)); }
__device__ __forceinline__ float bf2f(bf16_t b) { return __uint_as_float(((unsigned)b) << 16); }
__device__ __forceinline__ float bflo(unsigned w) { return __uint_as_float(w << 16); }
__device__ __forceinline__ float bfhi(unsigned w) { return __uint_as_float(w & 0xffff0000u); }
__device__ __forceinline__ unsigned cvt_pk_bf16(float lo, float hi) { unsigned r; asm volatile("v_cvt_pk_bf16_f32 %0, %1, %2" : "=v"(r) : "v"(lo), "v"(hi)); return r; }
__device__ __forceinline__ unsigned cvt4_fp8(float a, float b, float c_, float d) {
    a = fminf(fmaxf(a, -448.f), 448.f); b = fminf(fmaxf(b, -448.f), 448.f); c_ = fminf(fmaxf(c_, -448.f), 448.f); d = fminf(fmaxf(d, -448.f), 448.f);
    int w = __builtin_amdgcn_cvt_pk_fp8_f32(a, b, 0, false); w = __builtin_amdgcn_cvt_pk_fp8_f32(c_, d, w, true); return (unsigned)w; }
__device__ __forceinline__ int ltid() { int t = threadIdx.x; asm volatile("" : "+v"(t)); return t; }
template <int CTRL> __device__ __forceinline__ float dppf(float v) { return __builtin_bit_cast(float, __builtin_amdgcn_update_dpp(0, __builtin_bit_cast(int, v), CTRL, 0xf, 0xf, false)); }
__device__ __forceinline__ float row16_sum(float v) {
    v += dppf<0xB1>(v); v += dppf<0x4E>(v); v += dppf<0x141>(v); v += dppf<0x140>(v); return v;
}
__device__ __forceinline__ float wave_max_dpp(float v) {
    v = fmaxf(v, dppf<0x128>(v)); v = fmaxf(v, dppf<0x124>(v)); v = fmaxf(v, dppf<0x122>(v)); v = fmaxf(v, dppf<0x121>(v));
    const int b = __builtin_bit_cast(int, v);
    return fmaxf(fmaxf(__builtin_bit_cast(float, __builtin_amdgcn_readlane(b, 0)), __builtin_bit_cast(float, __builtin_amdgcn_readlane(b, 16))), fmaxf(__builtin_bit_cast(float, __builtin_amdgcn_readlane(b, 32)), __builtin_bit_cast(float, __builtin_amdgcn_readlane(b, 48))));
}
__device__ __forceinline__ float wave_sum_dpp(float v) {
    v += __builtin_bit_cast(float, __builtin_amdgcn_update_dpp(0, __builtin_bit_cast(int, v), 0x128, 0xf, 0xf, false));
    v += __builtin_bit_cast(float, __builtin_amdgcn_update_dpp(0, __builtin_bit_cast(int, v), 0x124, 0xf, 0xf, false));
    v += __builtin_bit_cast(float, __builtin_amdgcn_update_dpp(0, __builtin_bit_cast(int, v), 0x122, 0xf, 0xf, false));
    v += __builtin_bit_cast(float, __builtin_amdgcn_update_dpp(0, __builtin_bit_cast(int, v), 0x121, 0xf, 0xf, false));
    const int b = __builtin_bit_cast(int, v);
    return __builtin_bit_cast(float, __builtin_amdgcn_readlane(b, 0)) + __builtin_bit_cast(float, __builtin_amdgcn_readlane(b, 16)) + __builtin_bit_cast(float, __builtin_amdgcn_readlane(b, 32)) + __builtin_bit_cast(float, __builtin_amdgcn_readlane(b, 48));
}
__device__ __forceinline__ float wave_sum(float v) {
#pragma unroll
    for (int o = 32; o >= 1; o >>= 1) v += __shfl_xor(v, o);
    return v;
}


#define XB_TMO      128
#define XB_XCNT(j)  (256  + 64 * (j))
#define XB_XSUB(j)  (1280 + 64 * (j))
#define XB_XGEN(j)  (2304 + 64 * (j))
#define XB_TOP      3328
#define XB_TOPGEN   3392
#define XCD_BAR_WORDS 3456
#define XB_SPIN_CAP (1u << 18)
__device__ __forceinline__ unsigned xb_ld(unsigned* p)              { return __hip_atomic_load(p, __ATOMIC_RELAXED, __HIP_MEMORY_SCOPE_AGENT); }
__device__ __forceinline__ unsigned xb_add(unsigned* p, unsigned v) { return __hip_atomic_fetch_add(p, v, __ATOMIC_RELAXED, __HIP_MEMORY_SCOPE_AGENT); }
__device__ __forceinline__ unsigned xb_xcc_id() { return (unsigned)__builtin_amdgcn_s_getreg((3 << 11) | 20) & 0xFu; }
#define XB_SPIN(cond, bar) do { unsigned _sp = 0; while (cond) { __builtin_amdgcn_s_sleep(1); \
    if ((++_sp & 255u) == 0u) { if (xb_ld(&(bar)[XB_TMO])) break; if (_sp > XB_SPIN_CAP) { atomicAdd(&(bar)[XB_TMO], 1u); break; } } } } while (0)
struct XcdBarrier { unsigned* bar; unsigned x; volatile LAS unsigned* st; };
__device__ __forceinline__ XcdBarrier xcd_barrier_post(unsigned* bar, volatile LAS unsigned* st) {
    XcdBarrier b; b.bar = bar; b.x = xb_xcc_id(); b.st = st;
    if (threadIdx.x == 0) (void)xb_add(&bar[XB_XCNT(b.x)], 1u);
    return b;
}
__device__ __forceinline__ void xcd_barrier_complete(unsigned* bar, unsigned x, unsigned& nloc, unsigned& nx) {
    const unsigned G = gridDim.x * gridDim.y * gridDim.z;
    unsigned sum, cnt, mine, sp = 0u;
    for (;;) {
        sum = 0u; cnt = 0u; mine = 0u;
#pragma unroll
        for (unsigned j = 0; j < 16; ++j) { const unsigned c = xb_ld(&bar[XB_XCNT(j)]); sum += c; cnt += (c > 0u) ? 1u : 0u; mine = (j == x) ? c : mine; }
        if (sum == G) break;
        __builtin_amdgcn_s_sleep(1);
        if ((++sp & 255u) == 0u) { if (xb_ld(&bar[XB_TMO])) break; if (sp > XB_SPIN_CAP) { atomicAdd(&bar[XB_TMO], 1u); break; } }
    }
    nloc = mine > 0u ? mine : 1u; nx = cnt > 0u ? cnt : 1u;
}
__device__ __forceinline__ void xcd_barrier(const XcdBarrier& b) {
    asm volatile("s_waitcnt vmcnt(0)" ::: "memory");
    __syncthreads();
    if (threadIdx.x == 0) {
        unsigned* bar = b.bar;
        __builtin_amdgcn_s_waitcnt(0);
        unsigned nloc = b.st[0], nx = b.st[1];
        if (nloc == 0u) { xcd_barrier_complete(bar, b.x, nloc, nx); b.st[0] = nloc; b.st[1] = nx; }
        const unsigned old = xb_add(&bar[XB_XSUB(b.x)], 1u);
        const unsigned gen = old / nloc;
        if (old + 1u == (gen + 1u) * nloc) {
            __builtin_amdgcn_fence(__ATOMIC_RELEASE, "agent");
            asm volatile("s_waitcnt vmcnt(0)" ::: "memory");
            const unsigned og = xb_add(&bar[XB_TOP], 1u);
            const unsigned tg = og / nx;
            if (og + 1u == (tg + 1u) * nx) xb_add(&bar[XB_TOPGEN], 1u);
            else XB_SPIN(xb_ld(&bar[XB_TOPGEN]) == tg, bar);
            __builtin_amdgcn_fence(__ATOMIC_ACQUIRE, "agent");
            xb_add(&bar[XB_XGEN(b.x)], 1u);
            asm volatile("s_waitcnt vmcnt(0)" ::: "memory");
        } else {
            XB_SPIN(xb_ld(&bar[XB_XGEN(b.x)]) == gen, bar);
            __builtin_amdgcn_fence(__ATOMIC_ACQUIRE, "agent");
            asm volatile("s_waitcnt vmcnt(0)" ::: "memory");
        }
    }
    __syncthreads();
}

namespace gm {
constexpr int BM = 256, BK = 64, HALF = 128, HTB = HALF * BK * 2, STAGE_BYTES = 8 * HTB;
template <int SW = 5> __host__ __device__ __forceinline__ int lds_byte(int r, int c) { const int st = (r >> 4) * 2 + (c >> 5), rr = r & 15, cc = c & 31, ob = rr * 64 + cc * 2; return st * 1024 + (ob ^ (((ob >> 9) & 1) << SW)); }
template <int SW = 5> __host__ __device__ __forceinline__ void stage_rc(int b, int& R, int& C) { const int st = b / 1024, sb = b % 1024, swz = sb ^ (((sb >> 9) & 1) << SW); R = (st >> 1) * 16 + swz / 64; C = (st & 1) * 32 + (swz % 64) / 2; }
__host__ __device__ __forceinline__ int perm32(int rho) { const int n = rho >> 4, i = rho & 15; return 8 * (i >> 2) + 4 * n + (i & 3); }

struct Unit { int pm, pn, aux; const char* Bp; };
constexpr int UOFF = STAGE_BYTES + 256 + 10240, VBOFF = UOFF + 2 * 512 * 16;
__device__ __forceinline__ void put_offs(LAS unsigned char* lds, int ui, unsigned a00, unsigned a01, unsigned a10, unsigned a11) { *(LAS u32x4*)(lds + UOFF + ((ui & 1) * 512 + ltid()) * 16) = (u32x4){a00, a01, a10, a11}; }

template <class Epi, class Sched>
__device__ __forceinline__ void gphase(LAS unsigned char* lds, const char* Abase, const int K, Sched& S, Epi& E) {
    const int tid = ltid(), wid = __builtin_amdgcn_readfirstlane(tid >> 6), lane = tid & 63, wr = wid >> 2, wc = wid & 3, fr = lane & 15, fq = lane >> 4;
    const int nt = K / BK;
    { unsigned vb_[2];
#pragma unroll
      for (int i = 0; i < 2; ++i) { int R, C; stage_rc<Epi::F8 ? 4 : 5>(tid * 16 + i * 8192, R, C); const int Rb = Epi::PERM == 2 ? (64 * (R >> 5) + 16 * ((R >> 2) & 3) + 4 * ((R >> 4) & 1) + (R & 3)) : Epi::PERM == 1 ? ((R & ~31) + perm32(R & 31)) : R; vb_[i] = (unsigned)(Rb * K + C) * 2u; }
      *(LAS u32x2*)(lds + VBOFF + tid * 8) = (u32x2){vb_[0], vb_[1]}; }
    const unsigned hstepB = (unsigned)(Epi::PERM == 2 ? 8 : HALF) * K * 2;
    const unsigned ldsw = (unsigned)wid * 1024u;
    constexpr bool F8 = Epi::F8; constexpr int KST = F8 ? 16 : 1024;
    const int aoff = lds_byte<F8 ? 4 : 5>(wr * 64 + fr, fq * (F8 ? 16 : 8)), boff = lds_byte<F8 ? 4 : 5>(wc * 32 + fr, fq * (F8 ? 16 : 8));
    const int aoff1 = aoff ^ 16, boff1 = boff ^ 16;
#define G_SA(b, h) (((b) * 2 + (h)) * HTB)
#define G_SB(b, h) ((4 + (b) * 2 + (h)) * HTB)
#define G_STAGE_A(bufoff, slot_, half_, kb) do { const char* ab_ = Abase + (kb); const u32x2 p_ = *(const LAS u32x2*)(lds + UOFF + (((slot_) & 1) * 512 + tid) * 16 + (half_) * 8); unsigned p0_ = p_.x, p1_ = p_.y; asm volatile("" : "+v"(p0_), "+v"(p1_)); \
        __builtin_amdgcn_global_load_lds((const unsigned*)(ab_ + p0_), (LAS unsigned*)(lds + (bufoff) + ldsw), 16, 0, 0); \
        __builtin_amdgcn_global_load_lds((const unsigned*)(ab_ + p1_), (LAS unsigned*)(lds + (bufoff) + ldsw + 8192), 16, 0, 0); } while (0)
#define G_STAGE_B(bufoff, bp, kb) do { const char* bb_ = (bp) + (kb); const u32x2 q_ = *(const LAS u32x2*)(lds + VBOFF + tid * 8); unsigned p0_ = q_.x, p1_ = q_.y; asm volatile("" : "+v"(p0_), "+v"(p1_)); \
        __builtin_amdgcn_global_load_lds((const unsigned*)(bb_ + p0_), (LAS unsigned*)(lds + (bufoff) + ldsw), 16, 0, 0); \
        __builtin_amdgcn_global_load_lds((const unsigned*)(bb_ + p1_), (LAS unsigned*)(lds + (bufoff) + ldsw + 8192), 16, 0, 0); } while (0)
#define G_LDA(dst, b, h) do { _Pragma("unroll") for (int m = 0; m < 4; ++m) _Pragma("unroll") for (int k = 0; k < 2; ++k) dst[m][k] = *(const LAS v4i*)(lds + G_SA(b, h) + (F8 ? (k ? aoff1 : aoff) : aoff + k * KST) + m * 2048); } while (0)
#define G_LDB(dst, b, h) do { _Pragma("unroll") for (int n = 0; n < 2; ++n) _Pragma("unroll") for (int k = 0; k < 2; ++k) dst[n][k] = *(const LAS v4i*)(lds + G_SB(b, h) + (F8 ? (k ? boff1 : boff) : boff + k * KST) + n * 2048); } while (0)
#define G_CAT(x_) __builtin_shufflevector(x_[0], x_[1], 0, 1, 2, 3, 4, 5, 6, 7)
#define G_MMA(ai, bj, At, Bt) do { __builtin_amdgcn_s_setprio(1); _Pragma("unroll") for (int m = 0; m < 4; ++m) _Pragma("unroll") for (int n = 0; n < 2; ++n) { \
        if constexpr (F8) acc[ai][bj][m][n] = __builtin_amdgcn_mfma_scale_f32_16x16x128_f8f6f4(G_CAT(Bt[n]), G_CAT(At[m]), acc[ai][bj][m][n], 0, 0, 0, 0, 0, 0);   \
        else { _Pragma("unroll") for (int k = 0; k < 2; ++k) acc[ai][bj][m][n] = __builtin_amdgcn_mfma_f32_16x16x32_bf16(__builtin_bit_cast(bf16x8, Bt[n][k]), __builtin_bit_cast(bf16x8, At[m][k]), acc[ai][bj][m][n], 0, 0, 0); } } \
        __builtin_amdgcn_s_setprio(0); } while (0)
#define G_WAIT_V(n) asm volatile("s_waitcnt vmcnt(" #n ")" ::: "memory")
#define G_WAIT_L(n) asm volatile("s_waitcnt lgkmcnt(" #n ")" ::: "memory")
#define G_BAR __builtin_amdgcn_s_barrier()
#define G_SCHED __builtin_amdgcn_sched_barrier(0)
#define G_ZERO() do { _Pragma("unroll") for (int a = 0; a < 2; ++a) _Pragma("unroll") for (int b = 0; b < 2; ++b) _Pragma("unroll") for (int m = 0; m < 4; ++m) _Pragma("unroll") for (int n = 0; n < 2; ++n) acc[a][b][m][n] = (f32x4){0.f, 0.f, 0.f, 0.f}; } while (0)
    Unit cur, nxt; int ui = 0;
    if (!S.next(lds, 0, cur)) return;
    f32x4 acc[2][2][4][2];
    G_ZERO();
    v4i At[4][2], B0[2][2], B1[2][2];
    G_STAGE_B(G_SB(0, 0), cur.Bp, 0); G_STAGE_B(G_SB(0, 1), cur.Bp + hstepB, 0); G_STAGE_A(G_SA(0, 0), 0, 0, 0); G_STAGE_A(G_SA(0, 1), 0, 1, 0);
    if (wr == 1) G_BAR;
    G_WAIT_V(2); G_BAR;
    G_STAGE_B(G_SB(1, 0), cur.Bp, 128); G_STAGE_A(G_SA(1, 0), 0, 0, 128); G_STAGE_B(G_SB(1, 1), cur.Bp + hstepB, 128);
    G_WAIT_V(6); G_BAR;
    for (;;) {
        bool has_next = false;
#pragma unroll 1
        for (int t = 0; t < nt; t += 2) {
            const bool last = (t == nt - 2);
            const unsigned kb1 = (unsigned)(t + 1) * 128u, kb2 = last ? 0u : (unsigned)(t + 2) * 128u, kb3 = kb2 + 128u;
            const char* b2 = cur.Bp; int s2 = ui;
            if (last) {
                has_next = S.next(lds, ui + 1, nxt); if (!has_next) nxt = cur; else s2 = ui + 1;
                b2 = nxt.Bp; }
            G_LDB(B0, 0, 0); G_LDB(B1, 0, 1); G_SCHED; G_LDA(At, 0, 0); G_STAGE_A(G_SA(1, 1), ui, 1, kb1);
            G_WAIT_V(8); G_WAIT_L(0); G_BAR; G_MMA(0, 0, At, B0); G_MMA(0, 1, At, B1); G_BAR; G_SCHED;
            G_LDA(At, 0, 1); G_STAGE_B(G_SB(0, 0), b2, kb2); G_STAGE_B(G_SB(0, 1), b2 + hstepB, kb2); G_STAGE_A(G_SA(0, 0), s2, 0, kb2);
            G_WAIT_V(8); G_WAIT_L(0); G_BAR; G_MMA(1, 0, At, B0); G_MMA(1, 1, At, B1); G_BAR; G_SCHED;
            G_LDB(B0, 1, 0); G_LDB(B1, 1, 1); G_SCHED; G_LDA(At, 1, 0); G_STAGE_A(G_SA(0, 1), s2, 1, kb2);
            G_WAIT_V(8); G_WAIT_L(0); G_BAR; G_MMA(0, 0, At, B0); G_MMA(0, 1, At, B1); G_BAR; G_SCHED;
            G_LDA(At, 1, 1); G_STAGE_B(G_SB(1, 0), b2, kb3); G_STAGE_B(G_SB(1, 1), b2 + hstepB, kb3); G_STAGE_A(G_SA(1, 0), s2, 0, kb3);
            G_WAIT_V(8); G_WAIT_L(0); G_BAR; G_MMA(1, 0, At, B0); G_MMA(1, 1, At, B1); G_BAR; G_SCHED;
        }
        if (wr == 0) G_BAR;
        { const int tz = ltid(), wz = tz >> 6, lz = tz & 63; E(acc, cur, wz >> 2, wz & 3, lz & 15, lz >> 4); }
        if (!has_next) break;
        if (!E.keep(cur)) G_ZERO();
        cur = nxt; ++ui;
        if (wr == 1) G_BAR;
    }
    G_WAIT_V(0);
    G_BAR;
#undef G_SA
#undef G_SB
#undef G_STAGE_A
#undef G_STAGE_B
#undef G_LDA
#undef G_CAT
#undef G_LDB
#undef G_MMA
#undef G_WAIT_V
#undef G_WAIT_L
#undef G_BAR
#undef G_SCHED
#undef G_ZERO
}

struct DenseSched {
    int nM, nN, nwg, G, c, lda, K, parts; const char* Bt; const char* Bt2;
    __device__ void init(int M, int N, int K_, int lda_, const void* Bt_, const void* Bt2_, int parts_) {
        nM = M / BM; nN = N / BM; nwg = nM * nN; G = gridDim.x; c = blockIdx.x; lda = lda_; K = K_; Bt = (const char*)Bt_; Bt2 = (const char*)Bt2_; parts = parts_;
    }
    __device__ bool next(LAS unsigned char* lds, int i, Unit& u) const {
        const int ti = parts == 2 ? (i >> 1) : i, part = parts == 2 ? (i & 1) : 0;
        const long L = (long)ti * G + c; if (L >= nwg) return false;
        int wgid = (int)L; { const int q = nwg / 8, r = nwg % 8, xcd = wgid % 8, off = wgid / 8; wgid = (xcd < r ? xcd * (q + 1) : r * (q + 1) + (xcd - r) * q) + off; }
        const int nig = 8 * nN, gid = wgid / nig, fm = gid * 8, gsz = (nM - fm) < 8 ? (nM - fm) : 8;
        u.pm = fm + ((wgid % nig) % gsz); u.pn = (wgid % nig) / gsz; u.aux = part;
        u.Bp = (part ? Bt2 : Bt) + (size_t)u.pn * BM * K * 2;
        int R0, C0, R1, C1; { const int tz = ltid(); stage_rc(tz * 16, R0, C0); stage_rc(tz * 16 + 8192, R1, C1); }
        const unsigned rb = (unsigned)u.pm * BM, po = part ? (unsigned)K * 2u : 0u;
        put_offs(lds, i, ((rb + R0) * lda + C0) * 2u + po, ((rb + R1) * lda + C1) * 2u + po, ((rb + HALF + R0) * lda + C0) * 2u + po, ((rb + HALF + R1) * lda + C1) * 2u + po);
        return true;
    }
};
template <bool GATHER, int NN, int KK, int LDA, size_t WSTRIDE>
struct MoeSched {
    static constexpr int MAXU = 24, TBL = STAGE_BYTES, TOK = STAGE_BYTES + 256;
    int nu; const char* W; const float* wp;
    __device__ void init(LAS unsigned char* lds, const int* nent_p, const int* blk_row, const int* blk_exp, const int* tok_p, const void* W_) {
        W = (const char*)W_; wp = nullptr;
        const int tid = ltid(), G = gridDim.x, c = blockIdx.x, nent = *nent_p;
        const int x = c & 7, slot = c >> 3, nslot = G >> 3, e0 = (int)((long)x * nent / 8), e1 = (int)((long)(x + 1) * nent / 8), tot = (e1 - e0) * NN;
        nu = tot > slot ? (tot - slot + nslot - 1) / nslot : 0; if (nu > MAXU) nu = MAXU;
        LAS int* t_ = (LAS int*)(lds + TBL); LAS int* k_ = (LAS int*)(lds + TOK);
        if (tid < nu) { const int uidx = tid * nslot + slot, ent = e0 + uidx / NN; t_[tid * 2] = blk_row[ent]; t_[tid * 2 + 1] = blk_exp[ent] * 16 + uidx % NN; }
        __syncthreads();
        if (GATHER) { for (int j = tid; j < nu * 256; j += 512) k_[j] = tok_p[t_[(j >> 8) * 2] + (j & 255)]; __syncthreads(); }
    }
    __device__ bool next(LAS unsigned char* lds, int i, Unit& u) const {
        if (i >= nu) return false;
        LAS const int* tbl = (LAS const int*)(lds + TBL); LAS const int* tokt = (LAS const int*)(lds + TOK);
        int R0, C0, R1, C1; { const int tz = ltid(); stage_rc<4>(tz * 16, R0, C0); stage_rc<4>(tz * 16 + 8192, R1, C1); }
        const int rb = __builtin_amdgcn_readfirstlane(tbl[i * 2]), ep = __builtin_amdgcn_readfirstlane(tbl[i * 2 + 1]), e = ep >> 4; u.pn = ep & 15; u.pm = rb; u.aux = e;
        u.Bp = W + (size_t)e * WSTRIDE + (size_t)u.pn * BM * KK * 2;
        if (GATHER) {
            const unsigned t00 = tokt[i * 256 + R0], t01 = tokt[i * 256 + R1], t10 = tokt[i * 256 + HALF + R0], t11 = tokt[i * 256 + HALF + R1];
            put_offs(lds, i, (t00 * LDA + C0) * 2u, (t01 * LDA + C1) * 2u, (t10 * LDA + C0) * 2u, (t11 * LDA + C1) * 2u);
        } else {
            u.aux = i & 1;
            { const int tz = ltid(); if (tz < 256) __builtin_amdgcn_global_load_lds((const unsigned*)(wp + rb + tz), (LAS unsigned*)(lds + TOK + (i & 1) * 1024 + (tz >> 6) * 256), 4, 0, 0); }
            put_offs(lds, i, ((unsigned)(rb + R0) * LDA + C0) * 2u, ((unsigned)(rb + R1) * LDA + C1) * 2u, ((unsigned)(rb + HALF + R0) * LDA + C0) * 2u, ((unsigned)(rb + HALF + R1) * LDA + C1) * 2u);
        }
        return true;
    }
};

struct EpiProj {
    static constexpr int PERM = 1; static constexpr bool F8 = false; static constexpr int SA = 0, SB = 0; bf16_t* O;
    __device__ __forceinline__ bool keep(const Unit&) const { return false; }
    __device__ __forceinline__ void operator()(f32x4 (&acc)[2][2][4][2], const Unit& u, int wr, int wc, int fr, int fq) const {
        const int row0 = u.pm * BM + wr * 64 + fr, col0 = u.pn * BM + wc * 32 + 8 * fq;
#pragma unroll
        for (int ai = 0; ai < 2; ++ai)
#pragma unroll
            for (int m = 0; m < 4; ++m) { bf16_t* rowp = O + (size_t)(row0 + ai * HALF + m * 16) * PW + col0;
#pragma unroll
                for (int bj = 0; bj < 2; ++bj) { const f32x4 v0 = acc[ai][bj][m][0], v1 = acc[ai][bj][m][1]; u32x4 w;
                    w.x = cvt_pk_bf16(v0[0], v0[1]); w.y = cvt_pk_bf16(v0[2], v0[3]); w.z = cvt_pk_bf16(v1[0], v1[1]); w.w = cvt_pk_bf16(v1[2], v1[3]);
                    *(u32x4*)(rowp + bj * HALF) = w; } }
    }
};
struct EpiMerge {
    static constexpr int PERM = 1; static constexpr bool F8 = false; static constexpr int SA = 0, SB = 0; const bf16_t* proj; bf16_t* O;
    __device__ __forceinline__ bool keep(const Unit& u) const { return u.aux == 0; }
    __device__ __forceinline__ void operator()(f32x4 (&acc)[2][2][4][2], const Unit& u, int wr, int wc, int fr, int fq) const {
        const int row0 = u.pm * BM + wr * 64 + fr, col0 = u.pn * BM + wc * 32 + 8 * fq;
        if (u.aux == 0) {
#pragma unroll
            for (int ai = 0; ai < 2; ++ai) {
                u32x4 gav[4][2], gbw[4][2];
#pragma unroll
                for (int m = 0; m < 4; ++m)
#pragma unroll
                    for (int bj = 0; bj < 2; ++bj) { const bf16_t* gp = proj + (size_t)(row0 + ai * HALF + m * 16) * PW + col0 + bj * HALF; gbw[m][bj] = *(const u32x4*)(gp + C_MGB); gav[m][bj] = *(const u32x4*)(gp + C_MGA); }
                __builtin_amdgcn_sched_barrier(0);
#pragma unroll
                for (int m = 0; m < 4; ++m)
#pragma unroll
                    for (int bj = 0; bj < 2; ++bj) { const u32x4 gb = gbw[m][bj], ga = gav[m][bj];
                        const f32x4 eb0 = {__expf(-bflo(gb.x)), __expf(-bfhi(gb.x)), __expf(-bflo(gb.y)), __expf(-bfhi(gb.y))};
                        const f32x4 eb1 = {__expf(-bflo(gb.z)), __expf(-bfhi(gb.z)), __expf(-bflo(gb.w)), __expf(-bfhi(gb.w))};
                        const f32x4 ea0 = {__expf(-bflo(ga.x)), __expf(-bfhi(ga.x)), __expf(-bflo(ga.y)), __expf(-bfhi(ga.y))};
                        const f32x4 ea1 = {__expf(-bflo(ga.z)), __expf(-bfhi(ga.z)), __expf(-bflo(ga.w)), __expf(-bfhi(ga.w))};
#pragma unroll
                        for (int j = 0; j < 4; ++j) { acc[ai][bj][m][0][j] *= (1.f + eb0[j]) * rcpf_(1.f + ea0[j]); acc[ai][bj][m][1][j] *= (1.f + eb1[j]) * rcpf_(1.f + ea1[j]); } } }
        } else {
            u32x4 gbv[2][4][2];
#pragma unroll
            for (int ai = 0; ai < 2; ++ai)
#pragma unroll
                for (int m = 0; m < 4; ++m)
#pragma unroll
                    for (int bj = 0; bj < 2; ++bj) gbv[ai][m][bj] = *(const u32x4*)(proj + (size_t)(row0 + ai * HALF + m * 16) * PW + C_MGB + col0 + bj * HALF);
            __builtin_amdgcn_sched_barrier(0);
#pragma unroll
            for (int ai = 0; ai < 2; ++ai)
#pragma unroll
                for (int m = 0; m < 4; ++m) { const size_t r = (size_t)(row0 + ai * HALF + m * 16);
#pragma unroll
                    for (int bj = 0; bj < 2; ++bj) { const u32x4 gb = gbv[ai][m][bj];
                        const f32x4 eb0 = {__expf(-bflo(gb.x)), __expf(-bfhi(gb.x)), __expf(-bflo(gb.y)), __expf(-bfhi(gb.y))};
                        const f32x4 eb1 = {__expf(-bflo(gb.z)), __expf(-bfhi(gb.z)), __expf(-bflo(gb.w)), __expf(-bfhi(gb.w))};
                        f32x4 v0 = acc[ai][bj][m][0], v1 = acc[ai][bj][m][1];
#pragma unroll
                        for (int j = 0; j < 4; ++j) { v0[j] *= rcpf_(1.f + eb0[j]); v1[j] *= rcpf_(1.f + eb1[j]); }
                        u32x4 w; w.x = cvt_pk_bf16(v0[0], v0[1]); w.y = cvt_pk_bf16(v0[2], v0[3]); w.z = cvt_pk_bf16(v1[0], v1[1]); w.w = cvt_pk_bf16(v1[2], v1[3]);
                        *(u32x4*)(O + r * D + col0 + bj * HALF) = w; } }
        }
    }
};
struct EpiResid {
    static constexpr int PERM = 0; static constexpr bool F8 = false; static constexpr int SA = 0, SB = 0; const float* x; const float* gt; float* O;
    __device__ __forceinline__ bool keep(const Unit&) const { return false; }
    __device__ __forceinline__ void operator()(f32x4 (&acc)[2][2][4][2], const Unit& u, int wr, int wc, int fr, int fq) const {
        const int row0 = u.pm * BM + wr * 64 + fr, col0 = u.pn * BM + wc * 32 + 4 * fq;
        f32x4 g[2][2];
#pragma unroll
        for (int bj = 0; bj < 2; ++bj)
#pragma unroll
            for (int n = 0; n < 2; ++n) g[bj][n] = *(const f32x4*)(gt + col0 + bj * HALF + n * 16);
#pragma unroll
        for (int ai = 0; ai < 2; ++ai) {
            f32x4 xv[4][2][2];
#pragma unroll
            for (int m = 0; m < 4; ++m) { const size_t ro = (size_t)(row0 + ai * HALF + m * 16) * D + col0;
#pragma unroll
                for (int bj = 0; bj < 2; ++bj)
#pragma unroll
                    for (int n = 0; n < 2; ++n) xv[m][bj][n] = *(const f32x4*)(x + ro + bj * HALF + n * 16); }
            __builtin_amdgcn_sched_barrier(0);
#pragma unroll
            for (int m = 0; m < 4; ++m) { const size_t ro = (size_t)(row0 + ai * HALF + m * 16) * D + col0;
#pragma unroll
                for (int bj = 0; bj < 2; ++bj)
#pragma unroll
                    for (int n = 0; n < 2; ++n) *(f32x4*)(O + ro + bj * HALF + n * 16) = xv[m][bj][n] + g[bj][n] * acc[ai][bj][m][n]; } }
    }
};
struct EpiSwiglu {
    static constexpr int PERM = 2; static constexpr bool F8 = true; static constexpr int SA = 0x7f7f7f7f, SB = 0x7f7f7f7f; unsigned char* hid;
    __device__ __forceinline__ bool keep(const Unit&) const { return false; }
    __device__ __forceinline__ void operator()(f32x4 (&acc)[2][2][4][2], const Unit& u, int wr, int wc, int fr, int fq) const {
        const int row0 = u.pm + wr * 64 + fr, j0 = u.pn * 128 + wc * 32 + 8 * fq;
#pragma unroll
        for (int ai = 0; ai < 2; ++ai)
#pragma unroll
            for (int m = 0; m < 4; ++m) { unsigned char* rowp = hid + (unsigned)((row0 + ai * HALF + m * 16) * FF + j0);
                unsigned w2[2];
#pragma unroll
                for (int bj = 0; bj < 2; ++bj) { const f32x4 g = acc[ai][bj][m][0] * 0.00390625f, up = acc[ai][bj][m][1] * 0.03125f;
                    w2[bj] = cvt4_fp8(siluf_(g[0]) * up[0], siluf_(g[1]) * up[1], siluf_(g[2]) * up[2], siluf_(g[3]) * up[3]); }
                *(u32x2*)rowp = (u32x2){w2[0], w2[1]};
                asm volatile("" ::: "memory"); __builtin_amdgcn_sched_barrier(0); }
    }
};
struct EpiDown {
    static constexpr int PERM = 2; static constexpr bool F8 = true; static constexpr int SA = 0x7f7f7f7f, SB = 0x7f7f7f7f; unsigned char* Y; LAS const float* wl;
    __device__ __forceinline__ bool keep(const Unit&) const { return false; }
    __device__ __forceinline__ void operator()(f32x4 (&acc)[2][2][4][2], const Unit& u, int wr, int wc, int fr, int fq) const {
        const int row0 = u.pm + wr * 64 + fr, col0 = u.pn * BM + wc * 64 + 16 * fq;
#pragma unroll
        for (int ai = 0; ai < 2; ++ai)
#pragma unroll
            for (int m = 0; m < 4; ++m) { const int r = row0 + ai * HALF + m * 16; const float wt = wl[u.aux * 256 + wr * 64 + fr + ai * HALF + m * 16] * 0.0625f  ; unsigned char* rowp = Y + ((unsigned)r * D + col0);
                unsigned w4[4];
#pragma unroll
                for (int bj = 0; bj < 2; ++bj) { const f32x4 v0 = acc[ai][bj][m][0] * wt, v1 = acc[ai][bj][m][1] * wt;
                    w4[bj * 2] = cvt4_fp8(v0[0], v0[1], v0[2], v0[3]); w4[bj * 2 + 1] = cvt4_fp8(v1[0], v1[1], v1[2], v1[3]); }
                *(u32x4*)rowp = (u32x4){w4[0], w4[1], w4[2], w4[3]};
                asm volatile("" ::: "memory"); __builtin_amdgcn_sched_barrier(0); }
    }
};
}

struct Ctx {
    const float *x, *c, *w_ada, *b_ada, *norm1_g, *norm2_g, *w_in, *lb_table, *hgrn_onorm_g, *conv_w, *a_log, *dt_bias, *gdn_onorm_g, *w_bh, *w_bg, *w_out, *w_router, *router_bias,
        *w_eg, *w_eu, *w_ed, *w_sg, *w_su, *w_sd, *normf_g;
    float* out;
    unsigned* bar;
    float *modp, *mod, *lb, *gab;
    int *idx, *cnt, *tok_p, *pos, *blk_row, *blk_exp, *nent;
    float *wts, *w_p;
    bf16_t *win_t, *wa_t, *wb_t, *wout_t, *h1, *proj, *ocat, *merged;
    float *gq, *gk, *gv, *gbeta, *gdec, *oa, *ob;
    float *hL, *hS, *hD;
    float *gAT, *gB, *gS; unsigned char *gBlob, *gM;
    unsigned char *dn_t, *hid, *gu_t, *h2, *Y;
    bf16_t* rwimg; float* rbias2; int *tile_cnt, *rnk;
};

typedef const __attribute__((address_space(4))) Ctx CtxK;

__device__ __forceinline__ void cvt_tile(LAS float* t, const float* srcA, const float* srcB, int ld, int mode, bf16_t* dst, int ldd) {
    const int tid = ltid(), kr = tid >> 6, cl = tid & 63;
    const float* sp = (mode == 1 && cl >= 32) ? (srcB + cl - 32) : (srcA + cl);
    float v[8];
#pragma unroll
    for (int p = 0; p < 8; ++p) v[p] = sp[(size_t)(p * 8 + kr) * ld];
    __syncthreads();
#pragma unroll
    for (int p = 0; p < 8; ++p) t[(p * 8 + kr) * 65 + cl] = v[p];
    __syncthreads();
    const int r = tid >> 3, seg = (tid & 7) * 8;
    const int lc = mode == 1 ? (((r >> 2) & 1) * 32 + 4 * (r >> 3) + (r & 3)) : r;
    float w[8];
#pragma unroll
    for (int j = 0; j < 8; ++j) w[j] = t[(seg + j) * 65 + lc];
    u32x4 o; o.x = cvt_pk_bf16(w[0], w[1]); o.y = cvt_pk_bf16(w[2], w[3]); o.z = cvt_pk_bf16(w[4], w[5]); o.w = cvt_pk_bf16(w[6], w[7]);
    *(u32x4*)(dst + (size_t)r * ldd + seg) = o;
}
__device__ __forceinline__ void cvt_tile8(LAS float* t, const float* srcA, const float* srcB, int ld, int mode, unsigned char* dst, int ldd, float scale) {
    const int tid = ltid(), kr = tid >> 6, cl = tid & 63;
    const float* sp = (mode == 1 && cl >= 32) ? (srcB + cl - 32) : (srcA + cl);
    float v[8];
#pragma unroll
    for (int p = 0; p < 8; ++p) v[p] = sp[(size_t)(p * 8 + kr) * ld];
    __syncthreads();
#pragma unroll
    for (int p = 0; p < 8; ++p) t[(p * 8 + kr) * 65 + cl] = v[p] * scale;
    __syncthreads();
    const int r = tid >> 3, seg = (tid & 7) * 8;
    const int lc = mode == 1 ? (((r >> 2) & 1) * 32 + 4 * (r >> 3) + (r & 3)) : r;
    float w[8];
#pragma unroll
    for (int j = 0; j < 8; ++j) w[j] = t[(seg + j) * 65 + lc];
    *(u32x2*)(dst + (size_t)r * ldd + seg) = (u32x2){cvt4_fp8(w[0], w[1], w[2], w[3]), cvt4_fp8(w[4], w[5], w[6], w[7])};
}
__device__ __forceinline__ void cvt_job(LAS float* t, int tile, const float* src, int ld, int K, bf16_t* dst) {
    const int nkt = K / 64, nt = tile / nkt, kt = tile % nkt;
    cvt_tile(t, src + (size_t)kt * 64 * ld + nt * 64, nullptr, ld, 0, dst + (size_t)nt * 64 * K + kt * 64, K);
}

__device__ void ph_pro1(CtxK& c, LAS unsigned char* lds) {
    const int tid = ltid(), wg = blockIdx.x, G = gridDim.x;
    LAS float* lf = (LAS float*)lds;
    for (int job = wg; job < 192; job += G) {
        const int cc = job % 48, kp = job / 48, q = tid & 63, rg = tid >> 6;
        f32x4 a = {0.f, 0.f, 0.f, 0.f};
        for (int r0 = rg; r0 < 512; r0 += 256) { f32x4 w[32]; float s[32];
#pragma unroll
            for (int u = 0; u < 32; ++u) { const int k = kp * 512 + r0 + u * 8; w[u] = *(const f32x4*)(c.w_ada + (size_t)k * (6 * D) + cc * 256 + q * 4); s[u] = c.c[k]; }
#pragma unroll
            for (int u = 0; u < 32; ++u) a += siluf_(s[u]) * w[u]; }
        __syncthreads();
        *(LAS f32x4*)(lf + (rg * 64 + q) * 4) = a;
        __syncthreads();
        if (tid < 64) { f32x4 s = {0.f, 0.f, 0.f, 0.f};
#pragma unroll
            for (int g = 0; g < 8; ++g) s += *(LAS f32x4*)(lf + (g * 64 + tid) * 4);
            *(f32x4*)(c.modp + (size_t)kp * (6 * D) + cc * 256 + tid * 4) = s; }
    }
    if (wg == G - 1) for (int j = tid; j < 1024; j += 512) c.lb[j] = 1.f / (1.f + expf(c.lb_table[1024 + j] - c.lb_table[j]));
    {
        const int kr = tid >> 6, cl = tid & 63, r = tid >> 3, seg = (tid & 7) * 8;
        float v[8][8];
        const int g0 = wg < 192 ? wg : 1344 + (wg - 192), gstep = wg < 192 ? 192 : 64, ntl = wg < 192 ? 28 : 44;
#define P1_DESC(I_) const float* sp_; bf16_t* dp_; int ld_, ldd_; { const int q_ = g0 + ((I_) >> 2) * gstep, j4_ = (I_) & 3; \
            if (q_ < 1536) { const int nt = (q_ >> 5) * 4 + j4_, kt = q_ & 31, sc = nt * 64 + (nt * 64 >= WIN_GAB ? 16 : 0); sp_ = c.w_in + (size_t)kt * 64 * INW + sc; ld_ = INW; dp_ = c.win_t + (size_t)nt * 64 * D + kt * 64; ldd_ = D; } \
            else { const float* s0_; bf16_t* d0_; int K_, nt, kt; if (q_ < 1664) { const int qq = q_ - 1536; s0_ = c.w_bh; d0_ = c.wa_t; K_ = 1024; nt = (qq >> 4) * 4 + j4_; kt = qq & 15; } \
                else if (q_ < 1792) { const int qq = q_ - 1664; s0_ = c.w_bg; d0_ = c.wb_t; K_ = 1024; nt = (qq >> 4) * 4 + j4_; kt = qq & 15; } else { const int qq = q_ - 1792; s0_ = c.w_out; d0_ = c.wout_t; K_ = 2048; nt = (qq >> 5) * 4 + j4_; kt = qq & 31; } \
                sp_ = s0_ + (size_t)kt * 64 * D + nt * 64; ld_ = D; dp_ = d0_ + (size_t)nt * 64 * K_ + kt * 64; ldd_ = K_; } }
#define P1_LOAD(i0_) do { _Pragma("unroll") for (int j = 0; j < 8; ++j) if ((i0_) + j < ntl) { P1_DESC((i0_) + j) (void)dp_; (void)ldd_; const float* s_ = sp_ + cl; \
            _Pragma("unroll") for (int p = 0; p < 8; ++p) v[j][p] = s_[(size_t)(p * 8 + kr) * ld_]; } } while (0)
        P1_LOAD(0);
        for (int i0 = 0; i0 < ntl; i0 += 8) {
            __syncthreads();
#pragma unroll
            for (int j = 0; j < 8; ++j) if (i0 + j < ntl) {
#pragma unroll
                for (int p = 0; p < 8; ++p) lf[j * 4160 + (p * 8 + kr) * 65 + cl] = v[j][p]; }
            __syncthreads();
            if (i0 + 8 < ntl) P1_LOAD(i0 + 8);
#pragma unroll
            for (int j = 0; j < 8; ++j) if (i0 + j < ntl) { P1_DESC(i0 + j) (void)sp_; (void)ld_;
                float w[8];
#pragma unroll
                for (int jj = 0; jj < 8; ++jj) w[jj] = lf[j * 4160 + (seg + jj) * 65 + r];
                u32x4 o; o.x = cvt_pk_bf16(w[0], w[1]); o.y = cvt_pk_bf16(w[2], w[3]); o.z = cvt_pk_bf16(w[4], w[5]); o.w = cvt_pk_bf16(w[6], w[7]);
                *(u32x4*)(dp_ + (size_t)r * ldd_ + seg) = o; }
        }
#undef P1_LOAD
#undef P1_DESC
    }
}
__device__ void ph_norm1(CtxK& c, LAS unsigned char* lds) {
    const int tid = ltid(), wg = blockIdx.x, G = gridDim.x, lane = tid & 63, wv = tid >> 6;
    LAS float* la = (LAS float*)lds;
    LAS float* lb_ = la + D;
    LAS float* lw = lb_ + D;
    for (int j = tid; j < D; j += 512) {
        float sh = c.b_ada[j], sc = c.b_ada[D + j];
#pragma unroll
        for (int p = 0; p < 4; ++p) { sh += c.modp[(size_t)p * 6 * D + j]; sc += c.modp[(size_t)p * 6 * D + D + j]; }
        la[j] = c.norm1_g[j] * (1.f + sc); lb_[j] = sh;
    }
    for (int j = wg * 512 + tid; j < 6 * D; j += G * 512) { float m = c.b_ada[j];
#pragma unroll
        for (int p = 0; p < 4; ++p) m += c.modp[(size_t)p * 6 * D + j];
        c.mod[j] = m; }
    for (int i = tid; i < D * 4; i += 512) { const int e = i >> 2, q = i & 3; const f32x4 w = *(const f32x4*)(c.w_in + (size_t)e * INW + WIN_GAB + q * 4);
        lw[(q * 4 + 0) * D + e] = w[0]; lw[(q * 4 + 1) * D + e] = w[1]; lw[(q * 4 + 2) * D + e] = w[2]; lw[(q * 4 + 3) * D + e] = w[3]; }
    __syncthreads();
    f32x4 vn[8];
    { const float* xr = c.x + (size_t)(wg * 8 + wv) * D;
#pragma unroll
      for (int i = 0; i < 8; ++i) vn[i] = *(const f32x4*)(xr + i * 256 + lane * 4); }
    for (int row = wg * 8 + wv; row < S; row += G * 8) {
        f32x4 v[8]; float ss = 0.f;
#pragma unroll
        for (int i = 0; i < 8; ++i) { v[i] = vn[i]; ss += v[i][0] * v[i][0] + v[i][1] * v[i][1] + v[i][2] * v[i][2] + v[i][3] * v[i][3]; }
        if (row + G * 8 < S) { const float* xr = c.x + (size_t)(row + G * 8) * D;
#pragma unroll
            for (int i = 0; i < 8; ++i) vn[i] = *(const f32x4*)(xr + i * 256 + lane * 4); }
        ss = wave_sum(ss); const float r = rsqrtf(ss * (1.f / D) + 1e-6f);
#pragma unroll
        for (int i = 0; i < 8; ++i) { const int e = i * 256 + lane * 4; const f32x4 a = *(LAS f32x4*)(la + e), b = *(LAS f32x4*)(lb_ + e); v[i] = v[i] * r * a + b;
            u32x2 w; w.x = cvt_pk_bf16(v[i][0], v[i][1]); w.y = cvt_pk_bf16(v[i][2], v[i][3]); *(u32x2*)(c.h1 + (size_t)row * D + e) = w; }
        float mine = 0.f;
        for (int cc = 0; cc < 16; ++cc) { float d = 0.f;
#pragma unroll
            for (int i = 0; i < 8; ++i) { const f32x4 w = *(LAS f32x4*)(lw + cc * D + i * 256 + lane * 4); d += v[i][0] * w[0] + v[i][1] * w[1] + v[i][2] * w[2] + v[i][3] * w[3]; }
            d = wave_sum_dpp(d); if (lane == cc) mine = d; }
        if (lane < 16) c.gab[(size_t)row * 16 + lane] = mine;
    }
    { const int id = wg * 512 + tid, i = id >> 6, e = id & 63;
      if (id < D * 64) {
          float sc = c.b_ada[4 * D + i];
#pragma unroll
          for (int p = 0; p < 4; ++p) sc += c.modp[(size_t)p * 6 * D + 4 * D + i];
          const float w = c.norm2_g[i] * (1.f + sc) * c.w_router[id];
          const unsigned hi = cvt_pk_bf16(w, w) & 0xffffu; const float lo = w - __uint_as_float(hi << 16);
          const int ch = i >> 7, kk = i & 127;
          c.rwimg[((ch * 2 + 0) * 64 + e) * 136 + kk] = (bf16_t)hi; c.rwimg[((ch * 2 + 1) * 64 + e) * 136 + kk] = (bf16_t)(cvt_pk_bf16(lo, lo) & 0xffffu);
      } }
    if (wg < 64) {
        __syncthreads();
        float a = 0.f;
        for (int i = tid; i < D; i += 512) { float sh = c.b_ada[3 * D + i];
#pragma unroll
            for (int p = 0; p < 4; ++p) sh += c.modp[(size_t)p * 6 * D + 3 * D + i];
            a += sh * c.w_router[i * 64 + wg]; }
        a = wave_sum(a); if (lane == 0) la[wv] = a; __syncthreads();
        if (tid == 0) c.rbias2[wg] = la[0] + la[1] + la[2] + la[3] + la[4] + la[5] + la[6] + la[7];
    }
}
__device__ void ph_gemm1(CtxK& c, LAS unsigned char* lds) {
    gm::DenseSched Sd; Sd.init(S, PW, D, D, c.win_t, nullptr, 1); gm::EpiProj E{c.proj};
    gm::gphase(lds, (const char*)c.h1, D, Sd, E);
}
__device__ void ph_gemm2(CtxK& c, LAS unsigned char* lds) {
    gm::DenseSched Sd; Sd.init(S, D, 1024, 2048, c.wa_t, c.wb_t, 2); gm::EpiMerge E{c.proj, c.merged};
    gm::gphase(lds, (const char*)c.ocat, 1024, Sd, E);
}
__device__ void ph_gemm3(CtxK& c, LAS unsigned char* lds) {
    gm::DenseSched Sd; Sd.init(S, D, D, D, c.wout_t, nullptr, 1); gm::EpiResid E{c.x, c.mod + 2 * D, c.out};
    gm::gphase(lds, (const char*)c.merged, D, Sd, E);
}
__device__ void ph_moe_gu(CtxK& c, LAS unsigned char* lds) {
    gm::MoeSched<true, 4, D / 2, D / 2, (size_t)1024 * D> Sm; Sm.init(lds, c.nent, c.blk_row, c.blk_exp, c.tok_p, c.gu_t); gm::EpiSwiglu E{c.hid};
    gm::gphase(lds, (const char*)c.h2, D / 2, Sm, E);
}
__device__ void ph_moe_dn(CtxK& c, LAS unsigned char* lds) {
    gm::MoeSched<false, 8, FF / 2, FF / 2, (size_t)D * FF> Sm; Sm.init(lds, c.nent, c.blk_row, c.blk_exp, c.tok_p, c.dn_t); Sm.wp = c.w_p; gm::EpiDown E{c.Y, (LAS const float*)(lds + Sm.TOK)};
    gm::gphase(lds, (const char*)c.hid, FF / 2, Sm, E);
}
__device__ void ph_cvt_exp(CtxK& c, LAS unsigned char* lds) {
    LAS float* lf = (LAS float*)lds; const int wg = blockIdx.x - 8, G = gridDim.x - 8;
    if (wg < 0) return;
    const int tid = ltid(), kr = tid >> 6, cl = tid & 63, r = tid >> 3, seg = (tid & 7) * 8;
    constexpr int NG_GU = NEX * 128, NGRP = NEX * 192;
    float v[4][8];
#define CE_DESC(q_) const float* sp_; unsigned char* dp_; int ld_, ldd_, js_, jd_, mode_; float scale_; { const int gq_ = (q_); \
        if (gq_ < NG_GU) { const int e = gq_ >> 7, rr = gq_ & 127, ng = rr >> 5, kt = rr & 31; const float* sg = e < NE ? c.w_eg + (size_t)e * D * FF : c.w_sg; const float* su = e < NE ? c.w_eu + (size_t)e * D * FF : c.w_su; \
            sp_ = (cl >= 32 ? su + cl - 32 : sg + cl) + (size_t)kt * 64 * FF + ng * 128; ld_ = FF; js_ = 32; dp_ = c.gu_t + ((size_t)e * 1024 + ng * 256) * D + kt * 64; ldd_ = D; jd_ = 64 * D; mode_ = 1; scale_ = 64.f; } \
        else { const int q2 = gq_ - NG_GU, e = q2 >> 6, rr = q2 & 63, ng = rr >> 3, kt = rr & 7; const float* sd = e < NE ? c.w_ed + (size_t)e * FF * D : c.w_sd; \
            sp_ = sd + cl + (size_t)kt * 64 * D + ng * 256; ld_ = D; js_ = 64; dp_ = c.dn_t + (size_t)e * D * FF + (size_t)ng * 256 * FF + kt * 64; ldd_ = FF; jd_ = 64 * FF; mode_ = 0; scale_ = 32.f; } }
#define CE_LOAD(q_) do { CE_DESC(q_) (void)dp_; (void)ldd_; (void)jd_; (void)mode_; (void)scale_; \
        _Pragma("unroll") for (int j = 0; j < 4; ++j) _Pragma("unroll") for (int p = 0; p < 8; ++p) v[j][p] = sp_[(size_t)(p * 8 + kr) * ld_ + j * js_]; } while (0)
    if (wg < NGRP) CE_LOAD(wg);
    for (int q = wg; q < NGRP; q += G) {
        CE_DESC(q) (void)sp_; (void)ld_; (void)js_;
        __syncthreads();
#pragma unroll
        for (int j = 0; j < 4; ++j)
#pragma unroll
            for (int p = 0; p < 8; ++p) lf[j * 4160 + (p * 8 + kr) * 65 + cl] = v[j][p] * scale_;
        __syncthreads();
        if (q + G < NGRP) CE_LOAD(q + G);
        const int lc = mode_ == 1 ? (((r >> 2) & 1) * 32 + 4 * (r >> 3) + (r & 3)) : r;
#pragma unroll
        for (int j = 0; j < 4; ++j) { float w[8];
#pragma unroll
            for (int jj = 0; jj < 8; ++jj) w[jj] = lf[j * 4160 + (seg + jj) * 65 + lc];
            *(u32x2*)(dp_ + (size_t)j * jd_ + (size_t)r * ldd_ + seg) = (u32x2){cvt4_fp8(w[0], w[1], w[2], w[3]), cvt4_fp8(w[4], w[5], w[6], w[7])}; }
    }
#undef CE_LOAD
#undef CE_DESC
}
__device__ void ph_final(CtxK& c, LAS unsigned char* lds) {
    const int tid = ltid(), wg = blockIdx.x, G = gridDim.x, lane = tid & 63, wv = tid >> 6;
    const float* gt2 = c.mod + 5 * D;
    int pn[2][8];
#pragma unroll
    for (int rr = 0; rr < 2; ++rr)
#pragma unroll
        for (int k = 0; k < 8; ++k) pn[rr][k] = c.pos[((wg * 8 + wv) * 2 + rr) * TOPK + k];
    for (int row0 = (wg * 8 + wv) * 2; row0 < S; row0 += G * 16) {
        int p[2][9];
#pragma unroll
        for (int rr = 0; rr < 2; ++rr) {
#pragma unroll
            for (int k = 0; k < 8; ++k) p[rr][k] = pn[rr][k];
            p[rr][8] = PROUTED + row0 + rr; }
        if (row0 + G * 16 < S) {
#pragma unroll
            for (int rr = 0; rr < 2; ++rr)
#pragma unroll
                for (int k = 0; k < 8; ++k) pn[rr][k] = c.pos[(row0 + G * 16 + rr) * TOPK + k]; }
        f32x4 v[2][4][2]; float ss[2] = {0.f, 0.f};
#pragma unroll
        for (int rr = 0; rr < 2; ++rr) {
#pragma unroll
            for (int i = 0; i < 4; ++i) {
                const int e = i * 512 + lane * 8; f32x4 a0 = {0.f, 0.f, 0.f, 0.f}, a1 = {0.f, 0.f, 0.f, 0.f};
#pragma unroll
                for (int k = 0; k < 9; ++k) { const u32x2 y = *(const u32x2*)(c.Y + (size_t)p[rr][k] * D + e);
                    const auto q0 = __builtin_amdgcn_cvt_pk_f32_fp8((int)y.x, false), q1 = __builtin_amdgcn_cvt_pk_f32_fp8((int)y.x, true), q2 = __builtin_amdgcn_cvt_pk_f32_fp8((int)y.y, false), q3 = __builtin_amdgcn_cvt_pk_f32_fp8((int)y.y, true);
                    a0[0] += q0[0]; a0[1] += q0[1]; a0[2] += q1[0]; a0[3] += q1[1]; a1[0] += q2[0]; a1[1] += q2[1]; a1[2] += q3[0]; a1[3] += q3[1]; }
                const float* xp = c.out + (size_t)(row0 + rr) * D + e;
                const f32x4 x0 = *(const f32x4*)xp, x1 = *(const f32x4*)(xp + 4), g0 = *(const f32x4*)(gt2 + e) * 0.0625f, g1 = *(const f32x4*)(gt2 + e + 4) * 0.0625f;
                v[rr][i][0] = x0 + g0 * a0; v[rr][i][1] = x1 + g1 * a1;
#pragma unroll
                for (int j = 0; j < 4; ++j) ss[rr] += v[rr][i][0][j] * v[rr][i][0][j] + v[rr][i][1][j] * v[rr][i][1][j];
            } }
        f32x4 gw[4][2];
#pragma unroll
        for (int i = 0; i < 4; ++i) { const int e = i * 512 + lane * 8; gw[i][0] = *(const f32x4*)(c.normf_g + e); gw[i][1] = *(const f32x4*)(c.normf_g + e + 4); }
#pragma unroll
        for (int rr = 0; rr < 2; ++rr) {
            const float r = rsqrtf(wave_sum_dpp(ss[rr]) * (1.f / D) + 1e-6f);
#pragma unroll
            for (int i = 0; i < 4; ++i) { const int e = i * 512 + lane * 8; float* op = c.out + (size_t)(row0 + rr) * D + e;
                *(f32x4*)op = v[rr][i][0] * r * gw[i][0]; *(f32x4*)(op + 4) = v[rr][i][1] * r * gw[i][1]; } }
    }
}

namespace mx {
constexpr int ST128 = 272, ST64 = 144;
constexpr int FRAG_F4 = 8 * 8 * 64;
__device__ __forceinline__ f32x4 mfma16(bf16x8 a, bf16x8 b, f32x4 c) { return __builtin_amdgcn_mfma_f32_16x16x32_bf16(a, b, c, 0, 0, 0); }
template <int MT, int KS>
__device__ __forceinline__ void mma_nt(f32x4 (&acc)[MT], LAS const unsigned char* xs, int sx, LAS const unsigned char* ys, int sy, int fr, int fq) {
#pragma unroll
    for (int kk = 0; kk < KS; ++kk) {
        const bf16x8 b = *(const LAS bf16x8*)(ys + fr * sy + (kk * 32 + fq * 8) * 2);
#pragma unroll
        for (int m = 0; m < MT; ++m) { const bf16x8 a = *(const LAS bf16x8*)(xs + (16 * m + fr) * sx + (kk * 32 + fq * 8) * 2); acc[m] = mfma16(a, b, acc[m]); }
    }
}
__device__ __forceinline__ void lds_fence() { asm volatile("s_waitcnt lgkmcnt(0)" ::: "memory"); }
__device__ __forceinline__ u32x4 pack8(const float (&v)[8]) { u32x4 o; o.x = cvt_pk_bf16(v[0], v[1]); o.y = cvt_pk_bf16(v[2], v[3]); o.z = cvt_pk_bf16(v[4], v[5]); o.w = cvt_pk_bf16(v[6], v[7]); return o; }
__device__ __forceinline__ void unpack8(const u32x4 w, float (&v)[8]) { v[0] = bflo(w.x); v[1] = bfhi(w.x); v[2] = bflo(w.y); v[3] = bfhi(w.y); v[4] = bflo(w.z); v[5] = bfhi(w.z); v[6] = bflo(w.w); v[7] = bfhi(w.w); }
__device__ __forceinline__ void mfma_pad8(f32x4 (&a)[8]) { asm volatile("s_nop 15\n\ts_nop 7" : "+v"(a[0]), "+v"(a[1]), "+v"(a[2]), "+v"(a[3]), "+v"(a[4]), "+v"(a[5]), "+v"(a[6]), "+v"(a[7])); }
__device__ __forceinline__ void mfma_pad4(f32x4 (&a)[4]) { asm volatile("s_nop 15\n\ts_nop 7" : "+v"(a[0]), "+v"(a[1]), "+v"(a[2]), "+v"(a[3])); }
__device__ __forceinline__ void write_st(LAS unsigned char* stw, f32x4 (&S)[8], int fr, int fq) {
    mfma_pad8(S);
#pragma unroll
    for (int m = 0; m < 8; ++m) { u32x2 w; w.x = cvt_pk_bf16(S[m][0], S[m][1]); w.y = cvt_pk_bf16(S[m][2], S[m][3]); *(LAS u32x2*)(stw + fr * ST128 + (16 * m + 4 * fq) * 2) = w; }
}

__device__ __forceinline__ void gate_issue(u32x4 (&gp)[2], const bf16_t* gate0) {
    const int t_ = ltid(); const bf16_t* p = gate0 + (size_t)(t_ >> 3) * PW + (t_ & 7) * 16;
    gp[0] = *(const u32x4*)p; gp[1] = *(const u32x4*)(p + 8);
}
__device__ __forceinline__ void out_stage(LAS unsigned char* ot, LAS float* part, LAS float* rinv, const f32x4 (&o)[4], const u32x4 (&gp)[2], const float gn, bf16_t* out0, int wv, int lane, int fr, int fq) {
    float s_ = 0.f;
#pragma unroll
    for (int w = 0; w < 8; ++w) s_ += part[w * 64 + lane];
    const float rv = rsqrtf(s_ * (1.f / 128.f) + 1e-6f);
    rinv[lane] = rv; lds_fence();
#pragma unroll
    for (int m = 0; m < 4; ++m)
    { const f32x4 rq = *(LAS const f32x4*)(rinv + 16 * m + 4 * fq);
#pragma unroll
        for (int r = 0; r < 4; ++r) { const int cc = 16 * m + 4 * fq + r; const float x = o[m][r] * rq[r] * gn;
            *(LAS bf16_t*)(ot + cc * ST128 + (wv * 16 + fr) * 2) = (bf16_t)(cvt_pk_bf16(x, x) & 0xffffu); } }
    __syncthreads();
    const int t_ = ltid(), cc = t_ >> 3, sg = (t_ & 7) * 16;
#pragma unroll
    for (int hh = 0; hh < 2; ++hh) { float ov[8], gv[8];
        unpack8(*(LAS u32x4*)(ot + cc * ST128 + (sg + hh * 8) * 2), ov); unpack8(gp[hh], gv);
#pragma unroll
        for (int j = 0; j < 8; ++j) ov[j] *= siluf_(gv[j]);
        *(u32x4*)(out0 + (size_t)cc * D + sg + hh * 8) = pack8(ov); }
}

constexpr int H_QT = 0, H_KT = 17408, H_QI = 34816, H_KU = 52224, H_VT = 70656, H_P = 89088, H_DEC = 98304, H_OCT = 98816, H_F4 = H_OCT + 8192, H_PART = H_F4 + 512, H_RINV = H_PART + 2048, H_ST = H_RINV + 256, H_LB = H_ST + 8 * 16 * ST128, H_END = H_LB + 512;
static_assert(H_END <= 147456, "hgrn lds");
template <bool OUT>
__device__ void hgrn_pass(CtxK& c, LAS unsigned char* lds) {
    const int tid = ltid(), wv = __builtin_amdgcn_readfirstlane(tid >> 6), lane = tid & 63, fr = lane & 15, fq = lane >> 4;
    LAS float* dec = (LAS float*)(lds + H_DEC); LAS float* oct = (LAS float*)(lds + H_OCT); LAS float* f4 = (LAS float*)(lds + H_F4);
    LAS float* part = (LAS float*)(lds + H_PART); LAS float* rinv = (LAS float*)(lds + H_RINV);
    LAS unsigned char* stw = lds + H_ST + wv * 16 * ST128;
    {
        const int wu = blockIdx.x, h = wu & 7, g = wu >> 3;
        f32x4 Sacc[8];
#pragma unroll
        for (int m = 0; m < 8; ++m) Sacc[m] = (f32x4){0.f, 0.f, 0.f, 0.f};
        if (OUT) {
            if (g > 0) { const f32x4* sp = (const f32x4*)c.hS + (size_t)(h * 32 + g) * FRAG_F4 + (wv * 8) * 64 + lane;
#pragma unroll
                for (int m = 0; m < 8; ++m) Sacc[m] = sp[m * 64]; }
            write_st(stw, Sacc, fr, fq);
        }
        LAS float* lbs = (LAS float*)(lds + H_LB);
        if (tid < 128) lbs[tid] = c.lb[h * 128 + tid];
        __syncthreads();
        const float gnw = OUT ? c.hgrn_onorm_g[wv * 16 + fr] : 0.f;
        float dsum = 0.f;
        u32x4 pf[4], pv[4], pq[4];
#define HP_ISSUE(i_) do { const int tq_ = ltid(), rl_ = tq_ >> 8; const bf16_t* b_ = c.proj + (size_t)((g * 8 + (i_)) * 64 + ((tq_ >> 4) & 15) * 4) * PW + h * 128 + (tq_ & 15) * 8; \
        if (rl_ == 1 || OUT) { _Pragma("unroll") for (int tt = 0; tt < 4; ++tt) pf[tt] = *(const u32x4*)(b_ + (size_t)tt * PW + C_HF); } \
        if (rl_ == 0) { _Pragma("unroll") for (int tt = 0; tt < 4; ++tt) pv[tt] = *(const u32x4*)(b_ + (size_t)tt * PW + C_HI); \
            if (OUT) { _Pragma("unroll") for (int tt = 0; tt < 4; ++tt) pq[tt] = *(const u32x4*)(b_ + (size_t)tt * PW + C_HQ); } } } while (0)
        HP_ISSUE(0);
        for (int i = 0; i < 8; ++i) {
            const int T0 = (g * 8 + i) * 64;
            const int tp = ltid(), role = tp >> 8, tq = (tp >> 4) & 15, co = tp & 15, c0 = tq * 4, d0 = co * 8;
            const bool cum = role == 1 || OUT;
            float cs[4][8];
            if (cum) {
                float lbv[8];
                { const f32x4 l0 = *(LAS f32x4*)(lbs + d0), l1 = *(LAS f32x4*)(lbs + d0 + 4);
                  lbv[0] = l0[0]; lbv[1] = l0[1]; lbv[2] = l0[2]; lbv[3] = l0[3]; lbv[4] = l1[0]; lbv[5] = l1[1]; lbv[6] = l1[2]; lbv[7] = l1[3]; }
#pragma unroll
                for (int tt = 0; tt < 4; ++tt) {
                    float fv[8]; unpack8(pf[tt], fv);
#pragma unroll
                    for (int j = 0; j < 8; ++j) { const float lf = __logf(lbv[j] + (1.f - lbv[j]) * sigmoidf_(fv[j])); cs[tt][j] = tt ? cs[tt - 1][j] + lf : lf; }
                }
                if (role == 1) {
                    *(LAS f32x4*)(oct + tq * 128 + d0) = (f32x4){cs[3][0], cs[3][1], cs[3][2], cs[3][3]}; *(LAS f32x4*)(oct + tq * 128 + d0 + 4) = (f32x4){cs[3][4], cs[3][5], cs[3][6], cs[3][7]};
                    if (tq == 8) { *(LAS f32x4*)(f4 + d0) = (f32x4){cs[0][0], cs[0][1], cs[0][2], cs[0][3]}; *(LAS f32x4*)(f4 + d0 + 4) = (f32x4){cs[0][4], cs[0][5], cs[0][6], cs[0][7]}; }
                }
            }
            if (role == 0) {
#pragma unroll
                for (int j = 0; j < 8; j += 2) { const int wi = j >> 1; u32x2 w0, w1;
                    const unsigned a0 = wi == 0 ? pv[0].x : wi == 1 ? pv[0].y : wi == 2 ? pv[0].z : pv[0].w, a1 = wi == 0 ? pv[1].x : wi == 1 ? pv[1].y : wi == 2 ? pv[1].z : pv[1].w;
                    const unsigned a2 = wi == 0 ? pv[2].x : wi == 1 ? pv[2].y : wi == 2 ? pv[2].z : pv[2].w, a3 = wi == 0 ? pv[3].x : wi == 1 ? pv[3].y : wi == 2 ? pv[3].z : pv[3].w;
                    w0.x = (a0 & 0xffffu) | (a1 << 16); w0.y = (a2 & 0xffffu) | (a3 << 16);
                    w1.x = (a0 >> 16) | (a1 & 0xffff0000u); w1.y = (a2 >> 16) | (a3 & 0xffff0000u);
                    *(LAS u32x2*)(lds + H_VT + (d0 + j) * ST64 + c0 * 2) = w0; *(LAS u32x2*)(lds + H_VT + (d0 + j + 1) * ST64 + c0 * 2) = w1; }
            }
            __syncthreads();
            if (cum) {
                float pre[8], tot[8], bmid[8];
#pragma unroll
                for (int j = 0; j < 8; ++j) { pre[j] = 0.f; tot[j] = 0.f; bmid[j] = 0.f; }
#pragma unroll
                for (int o = 0; o < 16; ++o) { const f32x4 x0 = *(LAS f32x4*)(oct + o * 128 + d0), x1 = *(LAS f32x4*)(oct + o * 128 + d0 + 4);
#pragma unroll
                    for (int j = 0; j < 8; ++j) { const float x = j < 4 ? x0[j] : x1[j - 4]; pre[j] += o < tq ? x : 0.f; bmid[j] += o < 8 ? x : 0.f; tot[j] += x; } }
                { const f32x4 x0 = *(LAS f32x4*)(f4 + d0), x1 = *(LAS f32x4*)(f4 + d0 + 4);
#pragma unroll
                  for (int j = 0; j < 8; ++j) bmid[j] += j < 4 ? x0[j] : x1[j - 4]; }
                if (role == 0) {
                    float ebm[8];
#pragma unroll
                    for (int j = 0; j < 8; ++j) ebm[j] = __expf(bmid[j]);
#pragma unroll
                    for (int tt = 0; tt < 4; ++tt) {
                        float qv[8], q1[8], q2[8];
                        unpack8(pq[tt], qv);
#pragma unroll
                        for (int j = 0; j < 8; ++j) { const float q = siluf_(qv[j]) * 0.08838834764831845f; q1[j] = q * __expf(pre[j] + cs[tt][j] - bmid[j]); q2[j] = q1[j] * ebm[j]; }
                        *(LAS u32x4*)(lds + H_QT + (c0 + tt) * ST128 + d0 * 2) = pack8(q1); *(LAS u32x4*)(lds + H_QI + (c0 + tt) * ST128 + d0 * 2) = pack8(q2);
                    }
                } else {
                    if (tq == 0) {
#pragma unroll
                        for (int j = 0; j < 8; ++j) dec[d0 + j] = __expf(tot[j]);
                    }
                    if (OUT) {
#pragma unroll
                        for (int tt = 0; tt < 4; ++tt) {
                            float k1[8];
#pragma unroll
                            for (int j = 0; j < 8; ++j) { const float lf = tt ? cs[tt][j] - cs[tt - 1][j] : cs[0][j]; k1[j] = (1.f - __expf(lf)) * __expf(bmid[j] - pre[j] - cs[tt][j]); }
                            *(LAS u32x4*)(lds + H_KT + (c0 + tt) * ST128 + d0 * 2) = pack8(k1);
                        }
                    }
#pragma unroll
                    for (int j = 0; j < 8; ++j) { float col[4];
#pragma unroll
                        for (int tt = 0; tt < 4; ++tt) { const float lf = tt ? cs[tt][j] - cs[tt - 1][j] : cs[0][j]; col[tt] = (1.f - __expf(lf)) * __expf(tot[j] - pre[j] - cs[tt][j]); }
                        u32x2 w; w.x = cvt_pk_bf16(col[0], col[1]); w.y = cvt_pk_bf16(col[2], col[3]);
                        *(LAS u32x2*)(lds + H_KU + (d0 + j) * ST64 + c0 * 2) = w; }
                }
            }
            __syncthreads();
            if (i + 1 < 8) HP_ISSUE(i + 1);
            u32x4 gpre[2];
            if (OUT) gate_issue(gpre, c.proj + (size_t)T0 * PW + C_HG + h * 128);
            if (!OUT && tid < 128) dsum += __logf(dec[tid]);
            f32x4 oacc[4];
            if (OUT) {
                { f32x4 sc[2] = {(f32x4){0.f, 0.f, 0.f, 0.f}, (f32x4){0.f, 0.f, 0.f, 0.f}};
                  const int nt = wv & 3, mb = (wv >> 2) * 2;
                  mma_nt<2, 4>(sc, lds + H_KT + mb * 16 * ST128, ST128, lds + H_QT + nt * 16 * ST128, ST128, fr, fq);
#pragma unroll
                  for (int m = 0; m < 2; ++m) { const int cc = nt * 16 + fr, s0 = (mb + m) * 16 + 4 * fq; u32x2 w;
                      w.x = cvt_pk_bf16(s0 + 0 <= cc ? sc[m][0] : 0.f, s0 + 1 <= cc ? sc[m][1] : 0.f); w.y = cvt_pk_bf16(s0 + 2 <= cc ? sc[m][2] : 0.f, s0 + 3 <= cc ? sc[m][3] : 0.f);
                      *(LAS u32x2*)(lds + H_P + cc * ST64 + s0 * 2) = w; } }
                __syncthreads();
#pragma unroll
                for (int m = 0; m < 4; ++m) oacc[m] = (f32x4){0.f, 0.f, 0.f, 0.f};
                mma_nt<4, 2>(oacc, lds + H_P, ST64, lds + H_VT + wv * 16 * ST64, ST64, fr, fq);
                mma_nt<4, 4>(oacc, lds + H_QI, ST128, stw, ST128, fr, fq);
#pragma unroll
                for (int m = 0; m < 4; ++m)
#pragma unroll
                    for (int r = 0; r < 4; ++r) { const float q = row16_sum(oacc[m][r] * oacc[m][r]); if (fr == 0) part[wv * 64 + 16 * m + 4 * fq + r] = q; }
            }
#pragma unroll
            for (int m = 0; m < 8; ++m) { const f32x4 dv = *(LAS f32x4*)(dec + 16 * m + 4 * fq); Sacc[m] = Sacc[m] * dv; }
            mma_nt<8, 2>(Sacc, lds + H_KU, ST64, lds + H_VT + wv * 16 * ST64, ST64, fr, fq);
            if (OUT) {
                lds_fence();
                write_st(stw, Sacc, fr, fq);
                __syncthreads();
                out_stage(lds + H_QT, part, rinv, oacc, gpre, gnw, c.ocat + (size_t)T0 * D + h * 128, wv, lane, fr, fq);
            }
            __syncthreads();
        }
#undef HP_ISSUE
        if (!OUT) {
            f32x4* sp = (f32x4*)c.hL + (size_t)(h * 32 + g) * FRAG_F4 + (wv * 8) * 64 + lane;
#pragma unroll
            for (int m = 0; m < 8; ++m) sp[m * 64] = Sacc[m];
            if (tid < 128) c.hD[(h * 32 + g) * 128 + tid] = __expf(dsum);
        }
    }
}
__device__ void hgrn_scan(CtxK& c) {
    if (ltid() >= 128) return;
    const int e = blockIdx.x * 128 + ltid();
    if (e >= 8 * FRAG_F4) return;
    const int h = e / FRAG_F4, fi = e % FRAG_F4, m = (fi >> 6) & 7, lane = fi & 63, d0 = 16 * m + 4 * (lane >> 4);
    f32x4 s = {0.f, 0.f, 0.f, 0.f};
    for (int g0 = 0; g0 < 31; g0 += 16) {
        f32x4 dc[16], hl[16];
#pragma unroll
        for (int u = 0; u < 16; ++u) if (g0 + u < 31) { dc[u] = *(const f32x4*)(c.hD + (h * 32 + g0 + u) * 128 + d0); hl[u] = ((const f32x4*)c.hL)[(size_t)(h * 32 + g0 + u) * FRAG_F4 + fi]; }
#pragma unroll
        for (int u = 0; u < 16; ++u) if (g0 + u < 31) { s = s * dc[u] + hl[u]; ((f32x4*)c.hS)[(size_t)(h * 32 + g0 + u + 1) * FRAG_F4 + fi] = s; }
    }
}

constexpr int B_T = 0, B_KBG = 9216, B_KU = 26624, B_VB = 45056, B_QD = 63488, B_AT = 80896, B_SC = 90112, BLOB = 90368;
constexpr int G_ST = BLOB, G_RV = G_ST + 8 * 16 * ST128, G_PART = G_RV + 8 * 16 * ST64, G_RINV = G_PART + 2048, G_END = G_RINV + 256;
static_assert(G_END <= 147456, "gdn lds");
constexpr int P_K = 0, P_Q = 17408, P_BETA = 34816, P_GC = P_BETA + 256, P_EG = P_GC + 256, P_EK = P_EG + 256, P_CW = P_EK + 256;

__device__ void gdn_prep(CtxK& c, LAS unsigned char* lds, int h, int g) {
    const int tid = ltid(), wv = __builtin_amdgcn_readfirstlane(tid >> 6), lane = tid & 63, fr = lane & 15, fq = lane >> 4;
    LAS float* sbeta = (LAS float*)(lds + P_BETA); LAS float* sgc = (LAS float*)(lds + P_GC); LAS float* seg = (LAS float*)(lds + P_EG); LAS float* sek = (LAS float*)(lds + P_EK);
    u32x4 raw[11];
#define GR_ISSUE(i_) do { const int tq_ = ltid(); if (tq_ < 384) { const int T_ = (g * 8 + (i_)) * 64 + ((tq_ >> 4) & 7) * 8 - 3; const bf16_t* b_ = c.proj + C_GQKV + (tq_ >> 7) * 1024 + h * 128 + (tq_ & 15) * 8; \
        _Pragma("unroll") for (int r = 0; r < 11; ++r) raw[r] = T_ + r >= 0 ? *(const u32x4*)(b_ + (size_t)(T_ + r) * PW) : (u32x4){0u, 0u, 0u, 0u}; } } while (0)
    GR_ISSUE(0);
    LAS float* scw = (LAS float*)(lds + P_CW);
    for (int j = tid; j < 1536; j += 512) { const int tap = j / 384, r_ = j % 384; scw[j] = c.conv_w[tap * 3072 + (r_ >> 7) * 1024 + h * 128 + (r_ & 127)]; }
    const float nea = -__expf(c.a_log[h]), dtb = c.dt_bias[h];
    float gan = 0.f, gbn = 0.f;
    if (wv == 0) { gan = c.gab[(size_t)(g * 512 + lane) * 16 + h]; gbn = c.gab[(size_t)(g * 512 + lane) * 16 + 8 + h]; }
    for (int i = 0; i < 8; ++i) {
        const int n = g * 8 + i, T0 = n * 64;
        unsigned char* blob = (unsigned char*)c.gBlob + (size_t)(h * 256 + n) * BLOB;
        if (wv == 0) {
            const float ga = gan, gb = gbn;
            if (i + 1 < 8) { gan = c.gab[(size_t)(T0 + 64 + lane) * 16 + h]; gbn = c.gab[(size_t)(T0 + 64 + lane) * 16 + 8 + h]; }
            const float gl_ = nea * softplusf_(ga + dtb);
            float gc = gl_;
#pragma unroll
            for (int o = 1; o < 64; o <<= 1) { const float t_ = __shfl_up(gc, o); if (lane >= o) gc += t_; }
            const float glast = __shfl(gc, 63);
            sbeta[lane] = sigmoidf_(gb); sgc[lane] = gc; seg[lane] = __expf(gc); sek[lane] = __expf(glast - gc);
            if (lane == 0) *(float*)(blob + B_SC) = __expf(glast);
        }
        __syncthreads();
        const int tp = ltid(), part = tp >> 7, to = (tp >> 4) & 7, co = tp & 15, c0 = to * 8, d0 = co * 8;
        if (tp < 384) {
            const int chb = part * 1024 + h * 128 + d0;
            float val[8][8];
            {
                float wj[4][8];
#pragma unroll
                for (int j = 0; j < 4; ++j) { const f32x4 a = *(LAS const f32x4*)(scw + j * 384 + part * 128 + d0), b = *(LAS const f32x4*)(scw + j * 384 + part * 128 + d0 + 4);
                    wj[j][0] = a[0]; wj[j][1] = a[1]; wj[j][2] = a[2]; wj[j][3] = a[3]; wj[j][4] = b[0]; wj[j][5] = b[1]; wj[j][6] = b[2]; wj[j][7] = b[3]; }
#pragma unroll
                for (int tt = 0; tt < 8; ++tt) {
                    float a[8] = {0.f, 0.f, 0.f, 0.f, 0.f, 0.f, 0.f, 0.f};
#pragma unroll
                    for (int j = 0; j < 4; ++j) { float xv[8]; unpack8(raw[tt + j], xv);
#pragma unroll
                        for (int jj = 0; jj < 8; ++jj) a[jj] += wj[j][jj] * xv[jj]; }
#pragma unroll
                    for (int jj = 0; jj < 8; ++jj) val[tt][jj] = siluf_(a[jj]);
                }
            }
            if (part < 2) {
#pragma unroll
                for (int tt = 0; tt < 8; ++tt) { float ss = 0.f;
#pragma unroll
                    for (int jj = 0; jj < 8; ++jj) ss += val[tt][jj] * val[tt][jj];
                    ss = row16_sum(ss);
                    const float rn = rsqrtf(ss + 1e-6f) * (part == 0 ? 0.08838834764831845f : 1.f);
#pragma unroll
                    for (int jj = 0; jj < 8; ++jj) val[tt][jj] *= rn; }
            }
            if (part == 0) {
#pragma unroll
                for (int tt = 0; tt < 8; ++tt) { const int cc = c0 + tt; *(LAS u32x4*)(lds + P_Q + cc * ST128 + d0 * 2) = pack8(val[tt]);
                    const float e = seg[cc]; float qd[8];
#pragma unroll
                    for (int jj = 0; jj < 8; ++jj) qd[jj] = val[tt][jj] * e;
                    *(u32x4*)(blob + B_QD + cc * ST128 + d0 * 2) = pack8(qd); }
            } else if (part == 1) {
#pragma unroll
                for (int tt = 0; tt < 8; ++tt) { const int cc = c0 + tt; *(LAS u32x4*)(lds + P_K + cc * ST128 + d0 * 2) = pack8(val[tt]);
                    const float e = seg[cc] * sbeta[cc]; float kb[8];
#pragma unroll
                    for (int jj = 0; jj < 8; ++jj) kb[jj] = val[tt][jj] * e;
                    *(u32x4*)(blob + B_KBG + cc * ST128 + d0 * 2) = pack8(kb); }
#pragma unroll
                for (int jj = 0; jj < 8; ++jj) { float col[8];
#pragma unroll
                    for (int tt = 0; tt < 8; ++tt) col[tt] = val[tt][jj] * sek[c0 + tt];
                    *(u32x4*)(blob + B_KU + (d0 + jj) * ST64 + c0 * 2) = pack8(col); }
            } else {
#pragma unroll
                for (int jj = 0; jj < 8; ++jj) { float col[8];
#pragma unroll
                    for (int tt = 0; tt < 8; ++tt) col[tt] = val[tt][jj] * sbeta[c0 + tt];
                    *(u32x4*)(blob + B_VB + (d0 + jj) * ST64 + c0 * 2) = pack8(col); }
            }
        }
        __syncthreads();
        if (i + 1 < 8) GR_ISSUE(i + 1);
        {
            const int nt = wv & 3, mb = (wv >> 2) * 2, jj = nt * 16 + fr;
            f32x4 kk2[2] = {(f32x4){0.f, 0.f, 0.f, 0.f}, (f32x4){0.f, 0.f, 0.f, 0.f}}, at2[2] = {(f32x4){0.f, 0.f, 0.f, 0.f}, (f32x4){0.f, 0.f, 0.f, 0.f}};
            mma_nt<2, 4>(kk2, lds + P_K + mb * 16 * ST128, ST128, lds + P_K + nt * 16 * ST128, ST128, fr, fq);
            mma_nt<2, 4>(at2, lds + P_K + mb * 16 * ST128, ST128, lds + P_Q + nt * 16 * ST128, ST128, fr, fq);
            float* at = c.gAT + (size_t)(h * 256 + n) * 4096;
            const float gj = sgc[jj];
#pragma unroll
            for (int m = 0; m < 2; ++m) { const int i0 = (mb + m) * 16 + 4 * fq; f32x4 av; float pv[4];
#pragma unroll
                for (int r = 0; r < 4; ++r) { const int ii = i0 + r; const float gi = sgc[ii];
                    av[r] = jj < ii ? sbeta[ii] * kk2[m][r] * __expf(gi - gj) : 0.f;
                    pv[r] = ii <= jj ? at2[m][r] * __expf(gj - gi) : 0.f; }
                *(f32x4*)(at + jj * 64 + i0) = av;
                u32x2 w; w.x = cvt_pk_bf16(pv[0], pv[1]); w.y = cvt_pk_bf16(pv[2], pv[3]);
                *(u32x2*)(blob + B_AT + jj * ST64 + i0 * 2) = w; }
        }
        __syncthreads();
    }
}
__device__ void gdn_invert(CtxK& c, LAS unsigned char* lds, int h, int g) {
    const int tid = ltid(), wv = __builtin_amdgcn_readfirstlane(tid >> 6), lane = tid & 63;
    const int n = g * 8 + wv;
    LAS float* at = (LAS float*)(lds + wv * 16384);
    const float* src = c.gAT + (size_t)(h * 256 + n) * 4096;
#pragma unroll
    for (int k = 0; k < 16; ++k) *(LAS f32x4*)(at + (k * 64 + lane) * 4) = *(const f32x4*)(src + (k * 64 + lane) * 4);
    lds_fence();
    float r[64];
    unsigned ata = (unsigned)(size_t)at;
#pragma unroll
    for (int j = 63; j >= 0; --j) {
        float acc = lane == j ? 1.f : 0.f;
        LAS const float* arow = (LAS const float*)(size_t)ata + j * 64;
#pragma unroll
        for (int m4 = ((j + 1) & ~3); m4 < 64; m4 += 4) {
            const f32x4 a = *(LAS const f32x4*)(arow + m4);
#pragma unroll
            for (int q = 0; q < 4; ++q) if (m4 + q > j) acc = __builtin_fmaf(-r[m4 + q], a[q], acc);
        }
        r[j] = acc;
        asm volatile("" : "+v"(ata) : "v"(acc));
    }
    unsigned char* blob = (unsigned char*)c.gBlob + (size_t)(h * 256 + n) * BLOB;
#pragma unroll
    for (int k = 0; k < 8; ++k) { float v8[8];
#pragma unroll
        for (int q = 0; q < 8; ++q) v8[q] = r[k * 8 + q];
        *(u32x4*)(blob + B_T + lane * ST64 + k * 16) = pack8(v8); }
}
template <int MODE>
__device__ void gdn_pass(CtxK& c, LAS unsigned char* lds, int h, int g) {
    const int tid = ltid(), wv = __builtin_amdgcn_readfirstlane(tid >> 6), lane = tid & 63, fr = lane & 15, fq = lane >> 4;
    LAS unsigned char* stw = lds + G_ST + wv * 16 * ST128; LAS unsigned char* rvw = lds + G_RV + wv * 16 * ST64;
    LAS float* part = (LAS float*)(lds + G_PART); LAS float* rinv = (LAS float*)(lds + G_RINV);
    f32x4 Sacc[8];
#pragma unroll
    for (int m = 0; m < 8; ++m) {
        if (MODE == 1) { const int v = 16 * wv + fr, d0 = 16 * m + 4 * fq; Sacc[m] = (f32x4){d0 == v ? 1.f : 0.f, d0 + 1 == v ? 1.f : 0.f, d0 + 2 == v ? 1.f : 0.f, d0 + 3 == v ? 1.f : 0.f}; }
        else Sacc[m] = (f32x4){0.f, 0.f, 0.f, 0.f};
    }
    if (MODE == 2 && g > 0) { const f32x4* sp = (const f32x4*)c.gS + (size_t)(h * 32 + g) * FRAG_F4 + (wv * 8) * 64 + lane;
#pragma unroll
        for (int m = 0; m < 8; ++m) Sacc[m] = sp[m * 64]; }
    write_st(stw, Sacc, fr, fq);
    const float gnw = MODE == 2 ? c.gdn_onorm_g[wv * 16 + fr] : 0.f;
    constexpr int LIM = MODE == 2 ? B_SC : B_QD, NQ = (LIM + 8191) / 8192;
    u32x4 pre[NQ];
    const unsigned char* blob0 = (const unsigned char*)c.gBlob + (size_t)(h * 256 + g * 8) * BLOB;
#define GP_ISSUE(i_) do { const unsigned char* bp_ = blob0 + (size_t)(i_) * BLOB + ltid() * 16; _Pragma("unroll") for (int q = 0; q < NQ; ++q) if (q * 8192 + 8176 < LIM || ltid() * 16 + q * 8192 < LIM) pre[q] = *(const u32x4*)(bp_ + q * 8192); } while (0)
    GP_ISSUE(0);
    for (int i = 0; i < 8; ++i) {
        const int n = g * 8 + i, T0 = n * 64;
        { const int tl = ltid() * 16;
#pragma unroll
          for (int q = 0; q < NQ; ++q) if (q * 8192 + 8176 < LIM || tl + q * 8192 < LIM) *(LAS u32x4*)(lds + tl + q * 8192) = pre[q]; }
        const float dlast = *(const float*)(blob0 + (size_t)i * BLOB + B_SC);
        u32x4 gpre[2];
        if (MODE == 2) gate_issue(gpre, c.proj + (size_t)T0 * PW + C_GG + h * 128);
        __syncthreads();
        if (i + 1 < 8) GP_ISSUE(i + 1);
        { f32x4 R[4];
#pragma unroll
          for (int m = 0; m < 4; ++m) R[m] = (f32x4){0.f, 0.f, 0.f, 0.f};
          mma_nt<4, 4>(R, lds + B_KBG, ST128, stw, ST128, fr, fq);
#pragma unroll
          for (int m = 0; m < 4; ++m) { float x0 = 0.f, x1 = 0.f, x2 = 0.f, x3 = 0.f;
              if (MODE != 1) { const u32x2 vb = *(LAS u32x2*)(lds + B_VB + (16 * wv + fr) * ST64 + (16 * m + 4 * fq) * 2); x0 = bflo(vb.x); x1 = bfhi(vb.x); x2 = bflo(vb.y); x3 = bfhi(vb.y); }
              u32x2 w; w.x = cvt_pk_bf16(x0 - R[m][0], x1 - R[m][1]); w.y = cvt_pk_bf16(x2 - R[m][2], x3 - R[m][3]);
              *(LAS u32x2*)(rvw + fr * ST64 + (16 * m + 4 * fq) * 2) = w; } }
        lds_fence();
        { f32x4 VN[4];
#pragma unroll
          for (int m = 0; m < 4; ++m) VN[m] = (f32x4){0.f, 0.f, 0.f, 0.f};
          mma_nt<4, 2>(VN, lds + B_T, ST64, rvw, ST64, fr, fq);
          mfma_pad4(VN); lds_fence();
#pragma unroll
          for (int m = 0; m < 4; ++m) { u32x2 w; w.x = cvt_pk_bf16(VN[m][0], VN[m][1]); w.y = cvt_pk_bf16(VN[m][2], VN[m][3]); *(LAS u32x2*)(rvw + fr * ST64 + (16 * m + 4 * fq) * 2) = w; } }
        lds_fence();
        f32x4 O[4];
        if (MODE == 2) {
#pragma unroll
            for (int m = 0; m < 4; ++m) O[m] = (f32x4){0.f, 0.f, 0.f, 0.f};
            mma_nt<4, 4>(O, lds + B_QD, ST128, stw, ST128, fr, fq);
            mma_nt<4, 2>(O, lds + B_AT, ST64, rvw, ST64, fr, fq);
#pragma unroll
            for (int m = 0; m < 4; ++m)
#pragma unroll
                for (int r = 0; r < 4; ++r) { const float q = row16_sum(O[m][r] * O[m][r]); if (fr == 0) part[wv * 64 + 16 * m + 4 * fq + r] = q; }
        }
#pragma unroll
        for (int m = 0; m < 8; ++m) Sacc[m] = Sacc[m] * dlast;
        mma_nt<8, 2>(Sacc, lds + B_KU, ST64, rvw, ST64, fr, fq);
        lds_fence();
        write_st(stw, Sacc, fr, fq);
        if (MODE == 2) {
            __syncthreads();
            out_stage(lds + B_KBG, part, rinv, O, gpre, gnw, c.ocat + (size_t)T0 * D + 1024 + h * 128, wv, lane, fr, fq);
        }
        __syncthreads();
    }
#undef GP_ISSUE
    if (MODE == 0) {
        f32x4* sp = (f32x4*)c.gB + (size_t)(h * 32 + g) * FRAG_F4 + (wv * 8) * 64 + lane;
#pragma unroll
        for (int m = 0; m < 8; ++m) sp[m * 64] = Sacc[m];
    }
    if (MODE == 1) {
        mfma_pad8(Sacc);
        LAS bf16_t* img = (LAS bf16_t*)lds;
#pragma unroll
        for (int m = 0; m < 8; ++m)
#pragma unroll
            for (int r = 0; r < 4; ++r) img[(16 * m + 4 * fq + r) * (ST128 / 2) + 16 * wv + fr] = (bf16_t)(cvt_pk_bf16(Sacc[m][r], Sacc[m][r]) & 0xffffu);
        __syncthreads();
        unsigned char* dst = (unsigned char*)c.gM + (size_t)(h * 32 + g) * (128 * ST128);
#pragma unroll
        for (int q = 0; q < 5; ++q) { const int o = tid * 16 + q * 8192; if (q < 4 || o < 128 * ST128) *(u32x4*)(dst + o) = *(LAS u32x4*)(lds + o); }
        __syncthreads();
    }
}
__device__ void gdn_scan(CtxK& c, LAS unsigned char* lds, int h) {
    const int tid = ltid(), wv = __builtin_amdgcn_readfirstlane(tid >> 6), lane = tid & 63, fr = lane & 15, fq = lane >> 4;
    LAS unsigned char* stw = lds + G_ST + wv * 16 * ST128;
    f32x4 Sacc[8], Bn[8]; u32x4 mp[5];
#pragma unroll
    for (int m = 0; m < 8; ++m) Sacc[m] = (f32x4){0.f, 0.f, 0.f, 0.f};
#define GS_ISSUE(g_) do { const unsigned char* src_ = (const unsigned char*)c.gM + (size_t)(h * 32 + (g_)) * (128 * ST128) + tid * 16; \
        _Pragma("unroll") for (int q = 0; q < 5; ++q) if (q < 4 || tid * 16 + q * 8192 < 128 * ST128) mp[q] = *(const u32x4*)(src_ + q * 8192); \
        const f32x4* bp_ = (const f32x4*)c.gB + (size_t)(h * 32 + (g_)) * FRAG_F4 + (wv * 8) * 64 + lane; \
        _Pragma("unroll") for (int m = 0; m < 8; ++m) Bn[m] = bp_[m * 64]; } while (0)
    GS_ISSUE(0);
    for (int g = 0; g < 31; ++g) {
#pragma unroll
        for (int q = 0; q < 5; ++q) if (q < 4 || tid * 16 + q * 8192 < 128 * ST128) *(LAS u32x4*)(lds + tid * 16 + q * 8192) = mp[q];
        write_st(stw, Sacc, fr, fq);
#pragma unroll
        for (int m = 0; m < 8; ++m) Sacc[m] = Bn[m];
        __syncthreads();
        if (g + 1 < 31) GS_ISSUE(g + 1);
        mma_nt<8, 4>(Sacc, lds, ST128, stw, ST128, fr, fq);
        f32x4* sp = (f32x4*)c.gS + (size_t)(h * 32 + g + 1) * FRAG_F4 + (wv * 8) * 64 + lane;
#pragma unroll
        for (int m = 0; m < 8; ++m) sp[m * 64] = Sacc[m];
        __syncthreads();
    }
#undef GS_ISSUE
}
}
__device__ void ph_hgrn1(CtxK& c, LAS unsigned char* lds) { mx::hgrn_pass<false>(c, lds); }
__device__ void ph_hgrn2(CtxK& c, LAS unsigned char* lds) { mx::hgrn_scan(c); }
__device__ void ph_hgrn3(CtxK& c, LAS unsigned char* lds) { mx::hgrn_pass<true>(c, lds); }
__device__ void ph_gdn1(CtxK& c, LAS unsigned char* lds) {
    const int wu = blockIdx.x, h = wu & 7, g = wu >> 3;
    mx::gdn_prep(c, lds, h, g); __syncthreads();
    asm volatile("s_waitcnt vmcnt(0)" ::: "memory"); __syncthreads();
    mx::gdn_invert(c, lds, h, g);
    asm volatile("s_waitcnt vmcnt(0)" ::: "memory"); __syncthreads();
    mx::gdn_pass<0>(c, lds, h, g); __syncthreads();
    mx::gdn_pass<1>(c, lds, h, g); __syncthreads();
}
__device__ void ph_gdn2(CtxK& c, LAS unsigned char* lds) { if (blockIdx.x < 8) mx::gdn_scan(c, lds, blockIdx.x); }
__device__ void ph_gdn3(CtxK& c, LAS unsigned char* lds) { const int wu = blockIdx.x; mx::gdn_pass<2>(c, lds, wu & 7, wu >> 3); }

constexpr int N2_LA = 0, N2_LB = 8192, N2_XH = 16384, N2_XL = N2_XH + 17408, N2_Y = N2_XL + 17408, N2_LOG = N2_Y + 34816, N2_RS = N2_LOG + 64 * 65 * 4, N2_IDX = N2_RS + 256, N2_BIAS = N2_IDX + 2048, N2_END = N2_BIAS + 256;
static_assert(N2_END <= 147456, "norm2 lds");
__device__ void ph_norm2(CtxK& c, LAS unsigned char* lds) {
    const int tid = ltid(), wg = blockIdx.x, lane = tid & 63, wv = __builtin_amdgcn_readfirstlane(tid >> 6), fr = lane & 15, fq = lane >> 4;
    LAS float* la = (LAS float*)(lds + N2_LA); LAS float* lb_ = (LAS float*)(lds + N2_LB); LAS float* lg = (LAS float*)(lds + N2_LOG); LAS float* rs = (LAS float*)(lds + N2_RS);
    LAS int* idxt = (LAS int*)(lds + N2_IDX); LAS float* bias2 = (LAS float*)(lds + N2_BIAS);
    for (int j = tid; j < D; j += 512) { la[j] = c.norm2_g[j] * (1.f + c.mod[4 * D + j]); lb_[j] = c.mod[3 * D + j]; }
    if (tid < 64) bias2[tid] = c.rbias2[tid];
    __syncthreads();
    const int tok0 = wg * 64;
    f32x4 vn[8];
    { const float* xr = c.out + (size_t)(tok0 + wv * 8) * D;
#pragma unroll
      for (int i = 0; i < 8; ++i) vn[i] = *(const f32x4*)(xr + i * 256 + lane * 4); }
    for (int rr = 0; rr < 8; ++rr) {
        const int row = tok0 + wv * 8 + rr;
        f32x4 v[8]; float ss = 0.f;
#pragma unroll
        for (int i = 0; i < 8; ++i) { v[i] = vn[i]; ss += v[i][0] * v[i][0] + v[i][1] * v[i][1] + v[i][2] * v[i][2] + v[i][3] * v[i][3]; }
        if (rr + 1 < 8) { const float* xr = c.out + (size_t)(row + 1) * D;
#pragma unroll
            for (int i = 0; i < 8; ++i) vn[i] = *(const f32x4*)(xr + i * 256 + lane * 4); }
        ss = wave_sum(ss); const float r = rsqrtf(ss * (1.f / D) + 1e-6f);
        if (lane == 0) rs[wv * 8 + rr] = r;
#pragma unroll
        for (int i = 0; i < 8; ++i) { const int e = i * 256 + lane * 4; const f32x4 a = *(LAS f32x4*)(la + e), b = *(LAS f32x4*)(lb_ + e); const f32x4 y = v[i] * r * a + b;
            *(unsigned*)(c.h2 + (size_t)row * D + e) = cvt4_fp8(4.f * y[0], 4.f * y[1], 4.f * y[2], 4.f * y[3]); }
    }
    const int xrow = tid >> 3, xseg = (tid & 7) * 16;
    f32x4 xr_[4]; u32x4 yr_[5];
    auto issue = [&](int ch) {
        const float* xp = c.out + (size_t)(tok0 + xrow) * D + ch * 128 + xseg;
#pragma unroll
        for (int q = 0; q < 4; ++q) xr_[q] = *(const f32x4*)(xp + q * 4);
        const unsigned char* yp = (const unsigned char*)c.rwimg + (size_t)ch * 34816 + tid * 16;
#pragma unroll
        for (int q = 0; q < 4; ++q) yr_[q] = *(const u32x4*)(yp + q * 8192);
        if (tid < 128) yr_[4] = *(const u32x4*)(yp + 32768);
    };
    issue(0);
    f32x4 acc[2] = {(f32x4){0.f, 0.f, 0.f, 0.f}, (f32x4){0.f, 0.f, 0.f, 0.f}};
    const int mt = wv >> 1, nb = (wv & 1) * 2;
    for (int ch = 0; ch < 16; ++ch) {
        __syncthreads();
        { float hi[16], lo[16];
#pragma unroll
          for (int q = 0; q < 4; ++q)
#pragma unroll
              for (int j = 0; j < 4; ++j) { const float x = xr_[q][j]; const float h = __uint_as_float(cvt_pk_bf16(x, x) << 16); hi[q * 4 + j] = h; lo[q * 4 + j] = x - h; }
          float t8[8];
#pragma unroll
          for (int hh = 0; hh < 2; ++hh) {
#pragma unroll
              for (int j = 0; j < 8; ++j) t8[j] = hi[hh * 8 + j];
              *(LAS u32x4*)(lds + N2_XH + xrow * 272 + (xseg + hh * 8) * 2) = mx::pack8(t8);
#pragma unroll
              for (int j = 0; j < 8; ++j) t8[j] = lo[hh * 8 + j];
              *(LAS u32x4*)(lds + N2_XL + xrow * 272 + (xseg + hh * 8) * 2) = mx::pack8(t8); }
#pragma unroll
          for (int q = 0; q < 4; ++q) *(LAS u32x4*)(lds + N2_Y + tid * 16 + q * 8192) = yr_[q];
          if (tid < 128) *(LAS u32x4*)(lds + N2_Y + tid * 16 + 32768) = yr_[4]; }
        __syncthreads();
        if (ch + 1 < 16) issue(ch + 1);
#pragma unroll
        for (int kk = 0; kk < 4; ++kk) {
            const int ko = (kk * 32 + fq * 8) * 2;
            const bf16x8 ah = *(const LAS bf16x8*)(lds + N2_XH + (16 * mt + fr) * 272 + ko), al = *(const LAS bf16x8*)(lds + N2_XL + (16 * mt + fr) * 272 + ko);
#pragma unroll
            for (int n = 0; n < 2; ++n) {
                const bf16x8 bh = *(const LAS bf16x8*)(lds + N2_Y + (16 * (nb + n) + fr) * 272 + ko), bl = *(const LAS bf16x8*)(lds + N2_Y + 17408 + (16 * (nb + n) + fr) * 272 + ko);
                acc[n] = mx::mfma16(ah, bh, acc[n]); acc[n] = mx::mfma16(ah, bl, acc[n]); acc[n] = mx::mfma16(al, bh, acc[n]);
            }
        }
    }
#pragma unroll
    for (int n = 0; n < 2; ++n)
#pragma unroll
        for (int r = 0; r < 4; ++r) lg[(16 * mt + 4 * fq + r) * 65 + 16 * (nb + n) + fr] = acc[n][r];
    __syncthreads();
    const float rb = c.router_bias[lane], b2 = bias2[lane];
    for (int rr = 0; rr < 8; rr += 2) {
        float s[2], bb[2], mb[2], wsum[2] = {0.f, 0.f}; int myk[2] = {-1, -1};
#pragma unroll
        for (int u = 0; u < 2; ++u) {
            const int lr = wv * 8 + rr + u;
            s[u] = sigmoidf_(lg[lr * 65 + lane] * rs[lr] + b2); const float b = s[u] + rb; bb[u] = b;
            const float m7 = dppf<0x141>(b);
            const float o1 = dppf<0xB1>(b), o2 = dppf<0x4E>(b), o3 = dppf<0x1B>(b), o6 = dppf<0xB1>(m7), o5 = dppf<0x4E>(m7), o4 = dppf<0x1B>(m7);
            int rk = 0;
#define TK_CMP(ov, x) rk += ((ov) > b || ((ov) == b && (lane ^ (x)) < lane)) ? 1 : 0
            TK_CMP(o1, 1); TK_CMP(o2, 2); TK_CMP(o3, 3); TK_CMP(o4, 4); TK_CMP(o5, 5); TK_CMP(o6, 6); TK_CMP(m7, 7);
#undef TK_CMP
            float gs = rk < 2 ? b : 0.f; gs += dppf<0xB1>(gs); gs += dppf<0x4E>(gs); gs += dppf<0x141>(gs);
            int grk = 0; const int gi = lane >> 3;
#pragma unroll
            for (int j = 0; j < 8; ++j) { const float og = __builtin_bit_cast(float, __builtin_amdgcn_readlane(__builtin_bit_cast(int, gs), j * 8)); grk += (og > gs || (og == gs && j < gi)) ? 1 : 0; }
            mb[u] = grk < 4 ? b : -INFINITY; }
#pragma unroll
        for (int k = 0; k < TOPK; ++k)
#pragma unroll
            for (int u = 0; u < 2; ++u) {
                const float m = wave_max_dpp(mb[u]);
                const unsigned long long bal = __ballot(mb[u] == m); const int win = __builtin_amdgcn_readfirstlane(__ffsll((long long)bal) - 1);
                wsum[u] += __builtin_bit_cast(float, __builtin_amdgcn_readlane(__builtin_bit_cast(int, s[u]), win));
                if (lane == win) { mb[u] = -INFINITY; myk[u] = k; } }
#pragma unroll
        for (int u = 0; u < 2; ++u) { const int lr = wv * 8 + rr + u, t = tok0 + lr;
            if (myk[u] >= 0) { c.idx[t * TOPK + myk[u]] = lane; c.wts[t * TOPK + myk[u]] = s[u] / wsum[u] * 2.5f; idxt[lr * TOPK + myk[u]] = lane; } }
    }
    __syncthreads();
    { const int myexp = idxt[tid]; int rank = 0, cntl = 0;
      for (int e = 0; e < 64; ++e) {
          const unsigned long long bal = __ballot(myexp == e);
          const int below = __builtin_amdgcn_mbcnt_hi((unsigned)(bal >> 32), __builtin_amdgcn_mbcnt_lo((unsigned)bal, 0u));
          if (myexp == e) rank = below;
          if (lane == e) cntl = __popcll(bal); }
      LAS int* wcnt = (LAS int*)(lds + N2_XH);
      wcnt[wv * 64 + lane] = cntl;
      __syncthreads();
      int base = 0;
      for (int w = 0; w < wv; ++w) base += wcnt[w * 64 + myexp];
      c.rnk[wg * 512 + tid] = base + rank;
      if (tid < 64) { int n = 0;
#pragma unroll
          for (int w = 0; w < 8; ++w) n += wcnt[w * 64 + tid];
          c.tile_cnt[wg * 64 + tid] = n; } }
}
__device__ void ph_route(CtxK& c, LAS unsigned char* lds) {
    const int tid = ltid(), b = blockIdx.x, e = tid & 63, part = tid >> 6;
    LAS int* psum = (LAS int*)lds; LAS int* pbel = psum + 512; LAS int* tot = pbel + 512; LAS int* offb = tot + 64; LAS int* pst = offb + 64;
    { int sa = 0, sb = 0;
      for (int tl = part * 32; tl < part * 32 + 32; ++tl) { const int v = c.tile_cnt[tl * 64 + e]; sa += v; sb += tl < b ? v : 0; }
      psum[part * 64 + e] = sa; pbel[part * 64 + e] = sb; }
    __syncthreads();
    if (tid < 64) {
        int t_ = 0, o_ = 0;
#pragma unroll
        for (int q = 0; q < 8; ++q) { t_ += psum[q * 64 + e]; o_ += pbel[q * 64 + e]; }
        const int pad = (t_ + 255) & ~255; int inc = pad;
#pragma unroll
        for (int o = 1; o < 64; o <<= 1) { const int x = __shfl_up(inc, o); if (e >= o) inc += x; }
        const int ps = inc - pad;
        tot[e] = t_; offb[e] = o_; pst[e] = ps;
        if (b == 0) {
            const int b0 = ps >> 8, nbe = pad >> 8;
            for (int j = 0; j < nbe; ++j) { c.blk_row[b0 + j] = ps + j * 256; c.blk_exp[b0 + j] = e; }
            const int nbr = __shfl(inc, 63) >> 8;
            c.blk_row[nbr + e] = PROUTED + e * 256; c.blk_exp[nbr + e] = NE;
            if (e == 0) *c.nent = nbr + S / 256;
        }
        c.tok_p[PROUTED + b * 64 + e] = b * 64 + e; c.w_p[PROUTED + b * 64 + e] = 1.f;
    }
    __syncthreads();
    { const int p = b * 512 + tid, ex = c.idx[p], d = pst[ex] + offb[ex] + c.rnk[p];
      c.tok_p[d] = p >> 3; c.w_p[d] = c.wts[p]; c.pos[p] = d; }
    if (b < NE) { const int ps = pst[b], t_ = tot[b], pe = (t_ + 255) & ~255;
        for (int r = t_ + tid; r < pe; r += 512) { c.tok_p[ps + r] = 0; c.w_p[ps + r] = 0.f; } }
}

constexpr int LDS_BYTES = 163840, LDS_MAIN = LDS_BYTES - 16;
static_assert(gm::VBOFF + 512 * 8 <= LDS_MAIN, "lds map");
__global__ void __launch_bounds__(512, 2) k_mega(Ctx c) {
    extern __shared__ __attribute__((aligned(16))) unsigned char smem[];
    LAS unsigned char* lds = (LAS unsigned char*)smem;
    if (ltid() == 0) *(LAS u32x4*)(lds + LDS_MAIN) = (u32x4){0u, 0u, 0u, 0u};
    __syncthreads();
    CtxK* kp = (CtxK*)__builtin_amdgcn_kernarg_segment_ptr();
    (void)xcd_barrier_post(c.bar, (volatile LAS unsigned*)(lds + LDS_MAIN));
#define PHASE(fn) do { const CtxK* kp_ = kp; asm volatile("" : "+s"(kp_)); fn(*kp_, lds); __syncthreads(); } while (0)
#define GRID_BARRIER() do { const CtxK* kp_ = kp; asm volatile("" : "+s"(kp_)); XcdBarrier bb_; bb_.bar = kp_->bar; bb_.x = xb_xcc_id(); bb_.st = (volatile LAS unsigned*)(lds + LDS_MAIN); xcd_barrier(bb_); } while (0)
    PHASE(ph_pro1);      GRID_BARRIER();
    PHASE(ph_norm1);     GRID_BARRIER();
    PHASE(ph_gemm1);     GRID_BARRIER();
    PHASE(ph_hgrn1);     PHASE(ph_gdn1);  GRID_BARRIER();
    PHASE(ph_hgrn2);     PHASE(ph_gdn2);  PHASE(ph_cvt_exp); GRID_BARRIER();
    PHASE(ph_hgrn3);     PHASE(ph_gdn3);  GRID_BARRIER();
    PHASE(ph_gemm2);     GRID_BARRIER();
    PHASE(ph_gemm3);     GRID_BARRIER();
    PHASE(ph_norm2);     GRID_BARRIER();
    PHASE(ph_route);     GRID_BARRIER();
    PHASE(ph_moe_gu);    GRID_BARRIER();
    PHASE(ph_moe_dn);    GRID_BARRIER();
    PHASE(ph_final);
#undef PHASE
#undef GRID_BARRIER
}

extern "C" void kernel_launch(void* const* d_in, const int* in_sizes, int n_in, void* d_out, int out_size, void* d_ws, size_t ws_size, hipStream_t stream) {
    Ctx c{};
    const float** ip = (const float**)&c.x;
    for (int i = 0; i < 25; ++i) ip[i] = (const float*)d_in[i];
    c.out = (float*)d_out;
    char* ws = (char*)d_ws; constexpr size_t MB = 1024 * 1024;
    c.bar = (unsigned*)ws;
    c.modp = (float*)(ws + 64 * 1024); c.mod = (float*)(ws + 320 * 1024); c.lb = (float*)(ws + 384 * 1024);
    c.cnt = (int*)(ws + 392 * 1024); c.nent = (int*)(ws + 396 * 1024); c.blk_row = (int*)(ws + 400 * 1024); c.blk_exp = (int*)(ws + 404 * 1024);
    c.idx = (int*)(ws + 1 * MB); c.wts = (float*)(ws + 2 * MB); c.tok_p = (int*)(ws + 3 * MB); c.w_p = (float*)(ws + 4 * MB); c.pos = (int*)(ws + 5 * MB);
    c.gab = (float*)(ws + 6 * MB); c.gbeta = (float*)(ws + 7 * MB + 0); c.gdec = (float*)(ws + 7 * MB + 512 * 1024);
    c.rwimg = (bf16_t*)(ws + 8 * MB); c.rbias2 = (float*)(ws + 9 * MB); c.tile_cnt = (int*)(ws + 9 * MB + 4096); c.rnk = (int*)(ws + 10 * MB);
    char* big = ws + 16 * MB;
    auto at = [&](size_t mib) { return big + mib * MB; };
    c.dn_t = (unsigned char*)at(0); c.gu_t = (unsigned char*)at(130);
    c.win_t = (bf16_t*)at(0); c.h1 = (bf16_t*)at(48); c.gAT = (float*)at(112);
    c.proj = (bf16_t*)at(390); c.gBlob = (unsigned char*)at(774); c.merged = (bf16_t*)at(774);
    c.gM = (unsigned char*)at(951); c.gB = (float*)at(960); c.hL = (float*)at(976); c.gS = (float*)at(992); c.hS = (float*)at(1008); c.hD = (float*)at(1024);
    c.wa_t = (bf16_t*)at(1025); c.wb_t = (bf16_t*)at(1029); c.wout_t = (bf16_t*)at(1033); c.ocat = (bf16_t*)at(1041);
    c.Y = (unsigned char*)at(130); c.hid = (unsigned char*)at(770); c.h2 = (unsigned char*)at(930);
    static_assert((size_t)NEX * D * FF * 2 <= 130 * MB && (size_t)NEX * 1024 * D * 2 <= 260 * MB && (size_t)PW * D * 2 <= 48 * MB && (size_t)S * D * 2 <= 64 * MB, "map A");
    static_assert((size_t)S * PW * 2 <= 384 * MB && (size_t)2048 * mx::BLOB <= 177 * MB && (size_t)256 * 128 * mx::ST128 <= 9 * MB && (size_t)PTOT * D * 2 <= 640 * MB && (size_t)PTOT * FF * 2 <= 160 * MB, "map B");
    const size_t need = 16 * MB + 1105 * MB;
    if (ws_size < need) { fprintf(stderr, "kernel_launch: workspace too small: %zu < %zu\n", ws_size, need); return; }

    static int grid = 0;
    if (!grid) {
        int dev = 0, cus = 0, per_cu = 0;
        hipGetDevice(&dev); hipDeviceGetAttribute(&cus, hipDeviceAttributeMultiprocessorCount, dev);
        hipFuncSetAttribute((const void*)k_mega, hipFuncAttributeMaxDynamicSharedMemorySize, LDS_BYTES);
        hipOccupancyMaxActiveBlocksPerMultiprocessor(&per_cu, (const void*)k_mega, 512, LDS_BYTES);
        if (per_cu < 1) fprintf(stderr, "kernel_launch: occupancy query reports %d blocks per CU\n", per_cu);
        grid = cus;
        if (grid != 256) { fprintf(stderr, "kernel_launch: built for a 256-CU device (token-mixer units = workgroups); got %d CUs\n", cus); grid = -1; }
    }
    if (grid < 0) return;
    hipMemsetAsync(c.bar, 0, XCD_BAR_WORDS * sizeof(unsigned), stream);
    hipLaunchKernelGGL(k_mega, dim3(grid), dim3(512), LDS_BYTES, stream, c);
}
```

```cpp
#include <hip/hip_runtime.h>
#include <stdint.h>
#include <stdio.h>

#define LAS __attribute__((address_space(3)))
typedef unsigned short bf16_t;
typedef short bf16x8 __attribute__((ext_vector_type(8)));
typedef float f32x4 __attribute__((ext_vector_type(4)));
typedef unsigned u32x4 __attribute__((ext_vector_type(4)));
typedef unsigned u32x2 __attribute__((ext_vector_type(2)));
typedef int v4i __attribute__((ext_vector_type(4)));
typedef int v8i __attribute__((ext_vector_type(8)));

constexpr int S = 16384, D = 2048, INW = 12304, PW = 12288, NE = 64, TOPK = 8, TK = S * TOPK, FF = 512;
constexpr int NEX = NE + 1;
constexpr int PROUTED = 147456, PTOT = PROUTED + S, NBLK_MAX = PROUTED / 256;
constexpr int C_HQ = 0, C_HF = 1024, C_HI = 2048, C_HG = 3072, C_GQKV = 4096, C_GG = 7168, C_MGA = 8192, C_MGB = 10240;
constexpr int WIN_GAB = 7168;

__device__ __forceinline__ float rcpf_(float x) { return __builtin_amdgcn_rcpf(x); }
__device__ __forceinline__ float sigmoidf_(float x) { return rcpf_(1.f + __expf(-x)); }
__device__ __forceinline__ float siluf_(float x) { return x * rcpf_(1.f + __expf(-x)); }
__device__ __forceinline__ float softplusf_(float x) { return x > 20.f ? x : log1pf(expf(x)); }
__device__ __forceinline__ float bf2f(bf16_t b) { return __uint_as_float(((unsigned)b) << 16); }
__device__ __forceinline__ float bflo(unsigned w) { return __uint_as_float(w << 16); }
__device__ __forceinline__ float bfhi(unsigned w) { return __uint_as_float(w & 0xffff0000u); }
__device__ __forceinline__ unsigned cvt_pk_bf16(float lo, float hi) { unsigned r; asm volatile("v_cvt_pk_bf16_f32 %0, %1, %2" : "=v"(r) : "v"(lo), "v"(hi)); return r; }
__device__ __forceinline__ unsigned cvt4_fp8(float a, float b, float c_, float d) {
    a = fminf(fmaxf(a, -448.f), 448.f); b = fminf(fmaxf(b, -448.f), 448.f); c_ = fminf(fmaxf(c_, -448.f), 448.f); d = fminf(fmaxf(d, -448.f), 448.f);
    int w = __builtin_amdgcn_cvt_pk_fp8_f32(a, b, 0, false); w = __builtin_amdgcn_cvt_pk_fp8_f32(c_, d, w, true); return (unsigned)w; }
__device__ __forceinline__ int ltid() { int t = threadIdx.x; asm volatile("" : "+v"(t)); return t; }
template <int CTRL> __device__ __forceinline__ float dppf(float v) { return __builtin_bit_cast(float, __builtin_amdgcn_update_dpp(0, __builtin_bit_cast(int, v), CTRL, 0xf, 0xf, false)); }
__device__ __forceinline__ float row16_sum(float v) {
    v += dppf<0xB1>(v); v += dppf<0x4E>(v); v += dppf<0x141>(v); v += dppf<0x140>(v); return v;
}
template <int CTRL, int ROWS> __device__ __forceinline__ float dppz(float v) { return __builtin_bit_cast(float, __builtin_amdgcn_update_dpp(0, __builtin_bit_cast(int, v), CTRL, ROWS, 0xf, false)); }
__device__ __forceinline__ float wave_scan_dpp(float v) {
    v += dppz<0x111, 0xf>(v); v += dppz<0x112, 0xf>(v); v += dppz<0x114, 0xf>(v); v += dppz<0x118, 0xf>(v);
    v += dppz<0x142, 0xa>(v); v += dppz<0x143, 0xc>(v); return v;
}
__device__ __forceinline__ float wave_max_dpp(float v) {
    v = fmaxf(v, dppf<0x128>(v)); v = fmaxf(v, dppf<0x124>(v)); v = fmaxf(v, dppf<0x122>(v)); v = fmaxf(v, dppf<0x121>(v));
    const int b = __builtin_bit_cast(int, v);
    return fmaxf(fmaxf(__builtin_bit_cast(float, __builtin_amdgcn_readlane(b, 0)), __builtin_bit_cast(float, __builtin_amdgcn_readlane(b, 16))), fmaxf(__builtin_bit_cast(float, __builtin_amdgcn_readlane(b, 32)), __builtin_bit_cast(float, __builtin_amdgcn_readlane(b, 48))));
}
__device__ __forceinline__ float wave_sum_dpp(float v) {
    v += __builtin_bit_cast(float, __builtin_amdgcn_update_dpp(0, __builtin_bit_cast(int, v), 0x128, 0xf, 0xf, false));
    v += __builtin_bit_cast(float, __builtin_amdgcn_update_dpp(0, __builtin_bit_cast(int, v), 0x124, 0xf, 0xf, false));
    v += __builtin_bit_cast(float, __builtin_amdgcn_update_dpp(0, __builtin_bit_cast(int, v), 0x122, 0xf, 0xf, false));
    v += __builtin_bit_cast(float, __builtin_amdgcn_update_dpp(0, __builtin_bit_cast(int, v), 0x121, 0xf, 0xf, false));
    const int b = __builtin_bit_cast(int, v);
    return __builtin_bit_cast(float, __builtin_amdgcn_readlane(b, 0)) + __builtin_bit_cast(float, __builtin_amdgcn_readlane(b, 16)) + __builtin_bit_cast(float, __builtin_amdgcn_readlane(b, 32)) + __builtin_bit_cast(float, __builtin_amdgcn_readlane(b, 48));
}
__device__ __forceinline__ float wave_sum(float v) {
#pragma unroll
    for (int o = 32; o >= 1; o >>= 1) v += __shfl_xor(v, o);
    return v;
}


#define XB_TMO      128
#define XB_XCNT(j)  (256  + 64 * (j))
#define XB_XSUB(j)  (1280 + 64 * (j))
#define XB_XGEN(j)  (2304 + 64 * (j))
#define XB_TOP      3328
#define XB_TOPGEN   3392
#define XCD_BAR_WORDS 3456
#define XB_SPIN_CAP (1u << 18)
__device__ __forceinline__ unsigned xb_ld(unsigned* p)              { return __hip_atomic_load(p, __ATOMIC_RELAXED, __HIP_MEMORY_SCOPE_AGENT); }
__device__ __forceinline__ unsigned xb_add(unsigned* p, unsigned v) { return __hip_atomic_fetch_add(p, v, __ATOMIC_RELAXED, __HIP_MEMORY_SCOPE_AGENT); }
__device__ __forceinline__ unsigned xb_xcc_id() { return (unsigned)__builtin_amdgcn_s_getreg((3 << 11) | 20) & 0xFu; }
#define XB_SPIN(cond, bar) do { unsigned _sp = 0; while (cond) { __builtin_amdgcn_s_sleep(1); \
    if ((++_sp & 255u) == 0u) { if (xb_ld(&(bar)[XB_TMO])) break; if (_sp > XB_SPIN_CAP) { atomicAdd(&(bar)[XB_TMO], 1u); break; } } } } while (0)
struct XcdBarrier { unsigned* bar; unsigned x; volatile LAS unsigned* st; };
__device__ __forceinline__ XcdBarrier xcd_barrier_post(unsigned* bar, volatile LAS unsigned* st) {
    XcdBarrier b; b.bar = bar; b.x = xb_xcc_id(); b.st = st;
    if (threadIdx.x == 0) (void)xb_add(&bar[XB_XCNT(b.x)], 1u);
    return b;
}
__device__ __forceinline__ void xcd_barrier_complete(unsigned* bar, unsigned x, unsigned& nloc, unsigned& nx) {
    const unsigned G = gridDim.x * gridDim.y * gridDim.z;
    unsigned sum, cnt, mine, sp = 0u;
    for (;;) {
        sum = 0u; cnt = 0u; mine = 0u;
#pragma unroll
        for (unsigned j = 0; j < 16; ++j) { const unsigned c = xb_ld(&bar[XB_XCNT(j)]); sum += c; cnt += (c > 0u) ? 1u : 0u; mine = (j == x) ? c : mine; }
        if (sum == G) break;
        __builtin_amdgcn_s_sleep(1);
        if ((++sp & 255u) == 0u) { if (xb_ld(&bar[XB_TMO])) break; if (sp > XB_SPIN_CAP) { atomicAdd(&bar[XB_TMO], 1u); break; } }
    }
    nloc = mine > 0u ? mine : 1u; nx = cnt > 0u ? cnt : 1u;
}
__device__ __forceinline__ void xcd_barrier(const XcdBarrier& b) {
    asm volatile("s_waitcnt vmcnt(0)" ::: "memory");
    __syncthreads();
    if (threadIdx.x == 0) {
        unsigned* bar = b.bar;
        __builtin_amdgcn_s_waitcnt(0);
        unsigned nloc = b.st[0], nx = b.st[1];
        if (nloc == 0u) { xcd_barrier_complete(bar, b.x, nloc, nx); b.st[0] = nloc; b.st[1] = nx; }
        const unsigned old = xb_add(&bar[XB_XSUB(b.x)], 1u);
        const unsigned gen = old / nloc;
        if (old + 1u == (gen + 1u) * nloc) {
            __builtin_amdgcn_fence(__ATOMIC_RELEASE, "agent");
            asm volatile("s_waitcnt vmcnt(0)" ::: "memory");
            const unsigned og = xb_add(&bar[XB_TOP], 1u);
            const unsigned tg = og / nx;
            if (og + 1u == (tg + 1u) * nx) xb_add(&bar[XB_TOPGEN], 1u);
            else XB_SPIN(xb_ld(&bar[XB_TOPGEN]) == tg, bar);
            __builtin_amdgcn_fence(__ATOMIC_ACQUIRE, "agent");
            xb_add(&bar[XB_XGEN(b.x)], 1u);
            asm volatile("s_waitcnt vmcnt(0)" ::: "memory");
        } else {
            XB_SPIN(xb_ld(&bar[XB_XGEN(b.x)]) == gen, bar);
            __builtin_amdgcn_fence(__ATOMIC_ACQUIRE, "agent");
            asm volatile("s_waitcnt vmcnt(0)" ::: "memory");
        }
    }
    __syncthreads();
}

namespace gm {
constexpr int BM = 256, BK = 64, HALF = 128, HTB = HALF * BK * 2, STAGE_BYTES = 8 * HTB;
template <int SW = 5> __host__ __device__ __forceinline__ int lds_byte(int r, int c) { const int st = (r >> 4) * 2 + (c >> 5), rr = r & 15, cc = c & 31, ob = rr * 64 + cc * 2; return st * 1024 + (ob ^ (((ob >> 9) & 1) << SW)); }
template <int SW = 5> __host__ __device__ __forceinline__ void stage_rc(int b, int& R, int& C) { const int st = b / 1024, sb = b % 1024, swz = sb ^ (((sb >> 9) & 1) << SW); R = (st >> 1) * 16 + swz / 64; C = (st & 1) * 32 + (swz % 64) / 2; }
__host__ __device__ __forceinline__ int perm32(int rho) { const int n = rho >> 4, i = rho & 15; return 8 * (i >> 2) + 4 * n + (i & 3); }

struct Unit { int pm, pn, aux; const char* Bp; };
constexpr int UOFF = STAGE_BYTES + 256 + 10240, VBOFF = UOFF + 2 * 512 * 16;
__device__ __forceinline__ void put_offs(LAS unsigned char* lds, int ui, unsigned a00, unsigned a01, unsigned a10, unsigned a11) { *(LAS u32x4*)(lds + UOFF + ((ui & 1) * 512 + ltid()) * 16) = (u32x4){a00, a01, a10, a11}; }

template <class Epi, class Sched>
__device__ __forceinline__ void gphase(LAS unsigned char* lds, const char* Abase, const int K, Sched& S, Epi& E) {
    const int tid = ltid(), wid = __builtin_amdgcn_readfirstlane(tid >> 6), lane = tid & 63, wr = wid >> 2, wc = wid & 3, fr = lane & 15, fq = lane >> 4;
    const int nt = K / BK;
    unsigned vbr0 = 0, vbr1 = 0;
    { unsigned vb_[2];
#pragma unroll
      for (int i = 0; i < 2; ++i) { int R, C; stage_rc<Epi::F8 ? 4 : 5>(tid * 16 + i * 8192, R, C); const int Rb = Epi::PERM == 2 ? (64 * (R >> 5) + 16 * ((R >> 2) & 3) + 4 * ((R >> 4) & 1) + (R & 3)) : Epi::PERM == 1 ? ((R & ~31) + perm32(R & 31)) : R; vb_[i] = (unsigned)(Rb * K + C) * 2u; }
      *(LAS u32x2*)(lds + VBOFF + tid * 8) = (u32x2){vb_[0], vb_[1]}; vbr0 = vb_[0]; vbr1 = vb_[1]; }
    const unsigned hstepB = (unsigned)(Epi::PERM == 2 ? 8 : HALF) * K * 2;
    const unsigned ldsw = (unsigned)wid * 1024u;
    constexpr bool F8 = Epi::F8; constexpr int KST = F8 ? 16 : 1024;
    const int aoff = lds_byte<F8 ? 4 : 5>(wr * 64 + fr, fq * (F8 ? 16 : 8)), boff = lds_byte<F8 ? 4 : 5>(wc * 32 + fr, fq * (F8 ? 16 : 8));
    const int aoff1 = aoff ^ 16, boff1 = boff ^ 16;
#define G_SA(b, h) (((b) * 2 + (h)) * HTB)
#define G_SB(b, h) ((4 + (b) * 2 + (h)) * HTB)
#define G_STAGE_A(bufoff, slot_, half_, kb) do { const char* ab_ = Abase + (kb); unsigned p0_, p1_; \
        if constexpr (Sched::DENSE) { ab_ += (((slot_) == ui) ? uoc : uon) + (unsigned)(half_) * hstepA; p0_ = var0; p1_ = var1; } \
        else { const u32x2 p_ = *(const LAS u32x2*)(lds + UOFF + (((slot_) & 1) * 512 + tid) * 16 + (half_) * 8); p0_ = p_.x; p1_ = p_.y; asm volatile("" : "+v"(p0_), "+v"(p1_)); } \
        __builtin_amdgcn_global_load_lds((const unsigned*)(ab_ + p0_), (LAS unsigned*)(lds + (bufoff) + ldsw), 16, 0, 0); \
        __builtin_amdgcn_global_load_lds((const unsigned*)(ab_ + p1_), (LAS unsigned*)(lds + (bufoff) + ldsw + 8192), 16, 0, 0); } while (0)
#define G_STAGE_B(bufoff, bp, kb) do { const char* bb_ = (bp) + (kb); unsigned p0_, p1_; if constexpr (Epi::F8) { const u32x2 q_ = *(const LAS u32x2*)(lds + VBOFF + tid * 8); p0_ = q_.x; p1_ = q_.y; asm volatile("" : "+v"(p0_), "+v"(p1_)); } else { p0_ = vbr0; p1_ = vbr1; } \
        __builtin_amdgcn_global_load_lds((const unsigned*)(bb_ + p0_), (LAS unsigned*)(lds + (bufoff) + ldsw), 16, 0, 0); \
        __builtin_amdgcn_global_load_lds((const unsigned*)(bb_ + p1_), (LAS unsigned*)(lds + (bufoff) + ldsw + 8192), 16, 0, 0); } while (0)
#define G_LDA(dst, b, h) do { _Pragma("unroll") for (int m = 0; m < 4; ++m) _Pragma("unroll") for (int k = 0; k < 2; ++k) dst[m][k] = *(const LAS v4i*)(lds + G_SA(b, h) + (F8 ? (k ? aoff1 : aoff) : aoff + k * KST) + m * 2048); } while (0)
#define G_LDB(dst, b, h) do { _Pragma("unroll") for (int n = 0; n < 2; ++n) _Pragma("unroll") for (int k = 0; k < 2; ++k) dst[n][k] = *(const LAS v4i*)(lds + G_SB(b, h) + (F8 ? (k ? boff1 : boff) : boff + k * KST) + n * 2048); } while (0)
#define G_CAT(x_) __builtin_shufflevector(x_[0], x_[1], 0, 1, 2, 3, 4, 5, 6, 7)
#define G_MMA(ai, bj, At, Bt) do { __builtin_amdgcn_s_setprio(1); _Pragma("unroll") for (int m = 0; m < 4; ++m) _Pragma("unroll") for (int n = 0; n < 2; ++n) { \
        if constexpr (F8) acc[ai][bj][m][n] = __builtin_amdgcn_mfma_scale_f32_16x16x128_f8f6f4(G_CAT(Bt[n]), G_CAT(At[m]), acc[ai][bj][m][n], 0, 0, 0, 0, 0, 0);   \
        else { _Pragma("unroll") for (int k = 0; k < 2; ++k) acc[ai][bj][m][n] = __builtin_amdgcn_mfma_f32_16x16x32_bf16(__builtin_bit_cast(bf16x8, Bt[n][k]), __builtin_bit_cast(bf16x8, At[m][k]), acc[ai][bj][m][n], 0, 0, 0); } } \
        __builtin_amdgcn_s_setprio(0); } while (0)
#define G_WAIT_V(n) asm volatile("s_waitcnt vmcnt(" #n ")" ::: "memory")
#define G_WAIT_L(n) asm volatile("s_waitcnt lgkmcnt(" #n ")" ::: "memory")
#define G_BAR __builtin_amdgcn_s_barrier()
#define G_SCHED __builtin_amdgcn_sched_barrier(0)
#define G_ZERO() do { _Pragma("unroll") for (int a = 0; a < 2; ++a) _Pragma("unroll") for (int b = 0; b < 2; ++b) _Pragma("unroll") for (int m = 0; m < 4; ++m) _Pragma("unroll") for (int n = 0; n < 2; ++n) acc[a][b][m][n] = (f32x4){0.f, 0.f, 0.f, 0.f}; } while (0)
    Unit cur, nxt; int ui = 0;
    if (!S.next(lds, 0, cur)) return;
    unsigned var0 = 0, var1 = 0, uoc = 0, uon = 0, hstepA = 0;
    if constexpr (Sched::DENSE) { int R0, C0, R1, C1; stage_rc<Epi::F8 ? 4 : 5>(tid * 16, R0, C0); stage_rc<Epi::F8 ? 4 : 5>(tid * 16 + 8192, R1, C1); var0 = (unsigned)(R0 * S.ldA() + C0) * 2u; var1 = (unsigned)(R1 * S.ldA() + C1) * 2u;
        hstepA = (unsigned)HALF * S.ldA() * 2u; uoc = S.uoff(cur, K); uon = uoc; }
    f32x4 acc[2][2][4][2];
    G_ZERO();
    v4i At[4][2], B0[2][2], B1[2][2];
    G_STAGE_B(G_SB(0, 0), cur.Bp, 0); G_STAGE_B(G_SB(0, 1), cur.Bp + hstepB, 0); G_STAGE_A(G_SA(0, 0), 0, 0, 0); G_STAGE_A(G_SA(0, 1), 0, 1, 0);
    if (wr == 1) G_BAR;
    G_WAIT_V(2); G_BAR;
    G_STAGE_B(G_SB(1, 0), cur.Bp, 128); G_STAGE_A(G_SA(1, 0), 0, 0, 128); G_STAGE_B(G_SB(1, 1), cur.Bp + hstepB, 128);
    G_WAIT_V(6); G_BAR;
    for (;;) {
        bool has_next = false;
#pragma unroll 1
        for (int t = 0; t < nt; t += 2) {
            const bool last = (t == nt - 2);
            const unsigned kb1 = (unsigned)(t + 1) * 128u, kb2 = last ? 0u : (unsigned)(t + 2) * 128u, kb3 = kb2 + 128u;
            const char* b2 = cur.Bp; int s2 = ui;
            if (last) {
                has_next = S.next(lds, ui + 1, nxt); if (!has_next) nxt = cur; else s2 = ui + 1;
                if constexpr (Sched::DENSE) uon = S.uoff(nxt, K);
                b2 = nxt.Bp; }
            G_LDB(B0, 0, 0); G_LDB(B1, 0, 1); G_SCHED; G_LDA(At, 0, 0); G_STAGE_A(G_SA(1, 1), ui, 1, kb1);
            G_WAIT_V(8); G_WAIT_L(0); G_BAR; G_MMA(0, 0, At, B0); G_MMA(0, 1, At, B1); G_BAR; G_SCHED;
            G_LDA(At, 0, 1); G_STAGE_B(G_SB(0, 0), b2, kb2); G_STAGE_B(G_SB(0, 1), b2 + hstepB, kb2); G_STAGE_A(G_SA(0, 0), s2, 0, kb2);
            G_WAIT_V(8); G_WAIT_L(0); G_BAR; G_MMA(1, 0, At, B0); G_MMA(1, 1, At, B1); G_BAR; G_SCHED;
            G_LDB(B0, 1, 0); G_LDB(B1, 1, 1); G_SCHED; G_LDA(At, 1, 0); G_STAGE_A(G_SA(0, 1), s2, 1, kb2);
            G_WAIT_V(8); G_WAIT_L(0); G_BAR; G_MMA(0, 0, At, B0); G_MMA(0, 1, At, B1); G_BAR; G_SCHED;
            G_LDA(At, 1, 1); G_STAGE_B(G_SB(1, 0), b2, kb3); G_STAGE_B(G_SB(1, 1), b2 + hstepB, kb3); G_STAGE_A(G_SA(1, 0), s2, 0, kb3);
            G_WAIT_V(8); G_WAIT_L(0); G_BAR; G_MMA(1, 0, At, B0); G_MMA(1, 1, At, B1); G_BAR; G_SCHED;
        }
        if (wr == 0) G_BAR;
        { const int tz = ltid(), wz = tz >> 6, lz = tz & 63; E(acc, cur, wz >> 2, wz & 3, lz & 15, lz >> 4); }
        if (!has_next) break;
        if (!E.keep(cur)) G_ZERO();
        cur = nxt; ++ui; uoc = uon;
        if (wr == 1) G_BAR;
    }
    G_WAIT_V(0);
    G_BAR;
#undef G_SA
#undef G_SB
#undef G_STAGE_A
#undef G_STAGE_B
#undef G_LDA
#undef G_CAT
#undef G_LDB
#undef G_MMA
#undef G_WAIT_V
#undef G_WAIT_L
#undef G_BAR
#undef G_SCHED
#undef G_ZERO
}

template <int NM, int NN, int PARTS, int KK, int LDAE>
struct DenseSched {
    static constexpr bool DENSE = true;
    static_assert(NM % 8 == 0 && (NM * NN) % 8 == 0, "tile grid");
    __device__ __forceinline__ int ldA() const { return LDAE; }
    __device__ __forceinline__ unsigned uoff(const Unit& u, int) const { return (unsigned)u.pm * BM * LDAE * 2u + (u.aux ? (unsigned)KK * 2u : 0u); }
    int c; const char* Bt; const char* Bt2;
    __device__ void init(const void* Bt_, const void* Bt2_) { c = blockIdx.x; Bt = (const char*)Bt_; Bt2 = (const char*)Bt2_; }
    __device__ bool next(LAS unsigned char*, int i, Unit& u) const {
        const int ti = PARTS == 2 ? (i >> 1) : i, part = PARTS == 2 ? (i & 1) : 0;
        const int L = ti * 256 + c; if (L >= NM * NN) return false;
        const int wgid = (L & 7) * (NM * NN / 8) + (L >> 3);
        constexpr int nig = 8 * NN; const int gid = wgid / nig, rem = wgid % nig;
        u.pm = gid * 8 + (rem & 7); u.pn = rem >> 3; u.aux = part;
        u.Bp = (part ? Bt2 : Bt) + (size_t)u.pn * BM * KK * 2;
        return true;
    }
};
template <bool GATHER, int NN, int KK, int LDA, size_t WSTRIDE>
struct MoeSched {
    static constexpr bool DENSE = !GATHER;
    __device__ __forceinline__ int ldA() const { return LDA; }
    __device__ __forceinline__ unsigned uoff(const Unit& u, int) const { return (unsigned)u.pm * LDA * 2u; }
    static constexpr int MAXU = 24, TBL = STAGE_BYTES, TOK = STAGE_BYTES + 256;
    int nu; const char* W; const float* wp;
    __device__ void init(LAS unsigned char* lds, const int* nent_p, const int* blk_row, const int* blk_exp, const int* tok_p, const void* W_) {
        W = (const char*)W_; wp = nullptr;
        const int tid = ltid(), G = gridDim.x, c = blockIdx.x, nent = *nent_p;
        const int x = c & 7, slot = c >> 3, nslot = G >> 3, e0 = (int)((long)x * nent / 8), e1 = (int)((long)(x + 1) * nent / 8), tot = (e1 - e0) * NN;
        nu = tot > slot ? (tot - slot + nslot - 1) / nslot : 0; if (nu > MAXU) nu = MAXU;
        LAS int* t_ = (LAS int*)(lds + TBL); LAS int* k_ = (LAS int*)(lds + TOK);
        if (tid < nu) { const int uidx = tid * nslot + slot, ent = e0 + uidx / NN; t_[tid * 2] = blk_row[ent]; t_[tid * 2 + 1] = blk_exp[ent] * 16 + uidx % NN; }
        __syncthreads();
        if (GATHER) { for (int j = tid; j < nu * 256; j += 512) k_[j] = tok_p[t_[(j >> 8) * 2] + (j & 255)]; __syncthreads(); }
    }
    __device__ bool next(LAS unsigned char* lds, int i, Unit& u) const {
        if (i >= nu) return false;
        LAS const int* tbl = (LAS const int*)(lds + TBL); LAS const int* tokt = (LAS const int*)(lds + TOK);
        int R0, C0, R1, C1; { const int tz = ltid(); stage_rc<4>(tz * 16, R0, C0); stage_rc<4>(tz * 16 + 8192, R1, C1); }
        const int rb = __builtin_amdgcn_readfirstlane(tbl[i * 2]), ep = __builtin_amdgcn_readfirstlane(tbl[i * 2 + 1]), e = ep >> 4; u.pn = ep & 15; u.pm = rb; u.aux = e;
        u.Bp = W + (size_t)e * WSTRIDE + (size_t)u.pn * BM * KK * 2;
        if (GATHER) {
            const unsigned t00 = tokt[i * 256 + R0], t01 = tokt[i * 256 + R1], t10 = tokt[i * 256 + HALF + R0], t11 = tokt[i * 256 + HALF + R1];
            put_offs(lds, i, (t00 * LDA + C0) * 2u, (t01 * LDA + C1) * 2u, (t10 * LDA + C0) * 2u, (t11 * LDA + C1) * 2u);
        } else {
            u.aux = i & 1;
            { const int tz = ltid(); if (tz < 256) __builtin_amdgcn_global_load_lds((const unsigned*)(wp + rb + tz), (LAS unsigned*)(lds + TOK + (i & 1) * 1024 + (tz >> 6) * 256), 4, 0, 0); }
        }
        return true;
    }
};

struct EpiProj {
    static constexpr int PERM = 1; static constexpr bool F8 = false; static constexpr int SA = 0, SB = 0; bf16_t* O;
    __device__ __forceinline__ bool keep(const Unit&) const { return false; }
    __device__ __forceinline__ void operator()(f32x4 (&acc)[2][2][4][2], const Unit& u, int wr, int wc, int fr, int fq) const {
        const int row0 = u.pm * BM + wr * 64 + fr, col0 = u.pn * BM + wc * 32 + 8 * fq;
#pragma unroll
        for (int ai = 0; ai < 2; ++ai)
#pragma unroll
            for (int m = 0; m < 4; ++m) { bf16_t* rowp = O + (size_t)(row0 + ai * HALF + m * 16) * PW + col0;
#pragma unroll
                for (int bj = 0; bj < 2; ++bj) { const f32x4 v0 = acc[ai][bj][m][0], v1 = acc[ai][bj][m][1]; u32x4 w;
                    w.x = cvt_pk_bf16(v0[0], v0[1]); w.y = cvt_pk_bf16(v0[2], v0[3]); w.z = cvt_pk_bf16(v1[0], v1[1]); w.w = cvt_pk_bf16(v1[2], v1[3]);
                    *(u32x4*)(rowp + bj * HALF) = w; } }
    }
};
struct EpiMerge {
    static constexpr int PERM = 1; static constexpr bool F8 = false; static constexpr int SA = 0, SB = 0; const bf16_t* proj; bf16_t* O;
    __device__ __forceinline__ bool keep(const Unit& u) const { return u.aux == 0; }
    __device__ __forceinline__ void operator()(f32x4 (&acc)[2][2][4][2], const Unit& u, int wr, int wc, int fr, int fq) const {
        const int row0 = u.pm * BM + wr * 64 + fr, col0 = u.pn * BM + wc * 32 + 8 * fq;
        if (u.aux == 0) {
#pragma unroll
            for (int ai = 0; ai < 2; ++ai) {
                u32x4 gav[4][2], gbw[4][2];
#pragma unroll
                for (int m = 0; m < 4; ++m)
#pragma unroll
                    for (int bj = 0; bj < 2; ++bj) { const bf16_t* gp = proj + (size_t)(row0 + ai * HALF + m * 16) * PW + col0 + bj * HALF; gbw[m][bj] = *(const u32x4*)(gp + C_MGB); gav[m][bj] = *(const u32x4*)(gp + C_MGA); }
                __builtin_amdgcn_sched_barrier(0);
#pragma unroll
                for (int m = 0; m < 4; ++m)
#pragma unroll
                    for (int bj = 0; bj < 2; ++bj) { const u32x4 gb = gbw[m][bj], ga = gav[m][bj];
                        const f32x4 eb0 = {__expf(-bflo(gb.x)), __expf(-bfhi(gb.x)), __expf(-bflo(gb.y)), __expf(-bfhi(gb.y))};
                        const f32x4 eb1 = {__expf(-bflo(gb.z)), __expf(-bfhi(gb.z)), __expf(-bflo(gb.w)), __expf(-bfhi(gb.w))};
                        const f32x4 ea0 = {__expf(-bflo(ga.x)), __expf(-bfhi(ga.x)), __expf(-bflo(ga.y)), __expf(-bfhi(ga.y))};
                        const f32x4 ea1 = {__expf(-bflo(ga.z)), __expf(-bfhi(ga.z)), __expf(-bflo(ga.w)), __expf(-bfhi(ga.w))};
#pragma unroll
                        for (int j = 0; j < 4; ++j) { acc[ai][bj][m][0][j] *= (1.f + eb0[j]) * rcpf_(1.f + ea0[j]); acc[ai][bj][m][1][j] *= (1.f + eb1[j]) * rcpf_(1.f + ea1[j]); } } }
        } else {
            u32x4 gbv[2][4][2];
#pragma unroll
            for (int ai = 0; ai < 2; ++ai)
#pragma unroll
                for (int m = 0; m < 4; ++m)
#pragma unroll
                    for (int bj = 0; bj < 2; ++bj) gbv[ai][m][bj] = *(const u32x4*)(proj + (size_t)(row0 + ai * HALF + m * 16) * PW + C_MGB + col0 + bj * HALF);
            __builtin_amdgcn_sched_barrier(0);
#pragma unroll
            for (int ai = 0; ai < 2; ++ai)
#pragma unroll
                for (int m = 0; m < 4; ++m) { const size_t r = (size_t)(row0 + ai * HALF + m * 16);
#pragma unroll
                    for (int bj = 0; bj < 2; ++bj) { const u32x4 gb = gbv[ai][m][bj];
                        const f32x4 eb0 = {__expf(-bflo(gb.x)), __expf(-bfhi(gb.x)), __expf(-bflo(gb.y)), __expf(-bfhi(gb.y))};
                        const f32x4 eb1 = {__expf(-bflo(gb.z)), __expf(-bfhi(gb.z)), __expf(-bflo(gb.w)), __expf(-bfhi(gb.w))};
                        f32x4 v0 = acc[ai][bj][m][0], v1 = acc[ai][bj][m][1];
#pragma unroll
                        for (int j = 0; j < 4; ++j) { v0[j] *= rcpf_(1.f + eb0[j]); v1[j] *= rcpf_(1.f + eb1[j]); }
                        u32x4 w; w.x = cvt_pk_bf16(v0[0], v0[1]); w.y = cvt_pk_bf16(v0[2], v0[3]); w.z = cvt_pk_bf16(v1[0], v1[1]); w.w = cvt_pk_bf16(v1[2], v1[3]);
                        *(u32x4*)(O + r * D + col0 + bj * HALF) = w; } }
        }
    }
};
struct EpiResid {
    static constexpr int PERM = 0; static constexpr bool F8 = false; static constexpr int SA = 0, SB = 0; const float* x; const float* gt; float* O;
    __device__ __forceinline__ bool keep(const Unit&) const { return false; }
    __device__ __forceinline__ void operator()(f32x4 (&acc)[2][2][4][2], const Unit& u, int wr, int wc, int fr, int fq) const {
        const int row0 = u.pm * BM + wr * 64 + fr, col0 = u.pn * BM + wc * 32 + 4 * fq;
        f32x4 g[2][2];
#pragma unroll
        for (int bj = 0; bj < 2; ++bj)
#pragma unroll
            for (int n = 0; n < 2; ++n) g[bj][n] = *(const f32x4*)(gt + col0 + bj * HALF + n * 16);
#pragma unroll
        for (int ai = 0; ai < 2; ++ai) {
            f32x4 xv[4][2][2];
#pragma unroll
            for (int m = 0; m < 4; ++m) { const size_t ro = (size_t)(row0 + ai * HALF + m * 16) * D + col0;
#pragma unroll
                for (int bj = 0; bj < 2; ++bj)
#pragma unroll
                    for (int n = 0; n < 2; ++n) xv[m][bj][n] = *(const f32x4*)(x + ro + bj * HALF + n * 16); }
            __builtin_amdgcn_sched_barrier(0);
#pragma unroll
            for (int m = 0; m < 4; ++m) { const size_t ro = (size_t)(row0 + ai * HALF + m * 16) * D + col0;
#pragma unroll
                for (int bj = 0; bj < 2; ++bj)
#pragma unroll
                    for (int n = 0; n < 2; ++n) *(f32x4*)(O + ro + bj * HALF + n * 16) = xv[m][bj][n] + g[bj][n] * acc[ai][bj][m][n]; } }
    }
};
struct EpiSwiglu {
    static constexpr int PERM = 2; static constexpr bool F8 = true; static constexpr int SA = 0x7f7f7f7f, SB = 0x7f7f7f7f; unsigned char* hid;
    __device__ __forceinline__ bool keep(const Unit&) const { return false; }
    __device__ __forceinline__ void operator()(f32x4 (&acc)[2][2][4][2], const Unit& u, int wr, int wc, int fr, int fq) const {
        const int row0 = u.pm + wr * 64 + fr, j0 = u.pn * 128 + wc * 32 + 8 * fq;
#pragma unroll
        for (int ai = 0; ai < 2; ++ai)
#pragma unroll
            for (int m = 0; m < 4; ++m) { unsigned char* rowp = hid + (unsigned)((row0 + ai * HALF + m * 16) * FF + j0);
                unsigned w2[2];
#pragma unroll
                for (int bj = 0; bj < 2; ++bj) { const f32x4 g = acc[ai][bj][m][0] * 0.00390625f, up = acc[ai][bj][m][1] * 0.03125f;
                    w2[bj] = cvt4_fp8(siluf_(g[0]) * up[0], siluf_(g[1]) * up[1], siluf_(g[2]) * up[2], siluf_(g[3]) * up[3]); }
                *(u32x2*)rowp = (u32x2){w2[0], w2[1]};
                asm volatile("" ::: "memory"); __builtin_amdgcn_sched_barrier(0); }
    }
};
struct EpiDown {
    static constexpr int PERM = 2; static constexpr bool F8 = true; static constexpr int SA = 0x7f7f7f7f, SB = 0x7f7f7f7f; unsigned char* Y; LAS const float* wl;
    __device__ __forceinline__ bool keep(const Unit&) const { return false; }
    __device__ __forceinline__ void operator()(f32x4 (&acc)[2][2][4][2], const Unit& u, int wr, int wc, int fr, int fq) const {
        const int row0 = u.pm + wr * 64 + fr, col0 = u.pn * BM + wc * 64 + 16 * fq;
#pragma unroll
        for (int ai = 0; ai < 2; ++ai)
#pragma unroll
            for (int m = 0; m < 4; ++m) { const int r = row0 + ai * HALF + m * 16; const float wt = wl[u.aux * 256 + wr * 64 + fr + ai * HALF + m * 16] * 0.0625f  ; unsigned char* rowp = Y + ((unsigned)r * D + col0);
                unsigned w4[4];
#pragma unroll
                for (int bj = 0; bj < 2; ++bj) { const f32x4 v0 = acc[ai][bj][m][0] * wt, v1 = acc[ai][bj][m][1] * wt;
                    w4[bj * 2] = cvt4_fp8(v0[0], v0[1], v0[2], v0[3]); w4[bj * 2 + 1] = cvt4_fp8(v1[0], v1[1], v1[2], v1[3]); }
                *(u32x4*)rowp = (u32x4){w4[0], w4[1], w4[2], w4[3]};
                asm volatile("" ::: "memory"); __builtin_amdgcn_sched_barrier(0); }
    }
};
}

struct Ctx {
    const float *x, *c, *w_ada, *b_ada, *norm1_g, *norm2_g, *w_in, *lb_table, *hgrn_onorm_g, *conv_w, *a_log, *dt_bias, *gdn_onorm_g, *w_bh, *w_bg, *w_out, *w_router, *router_bias,
        *w_eg, *w_eu, *w_ed, *w_sg, *w_su, *w_sd, *normf_g;
    float* out;
    unsigned* bar;
    float *modp, *mod, *lb, *gab;
    int *idx, *cnt, *tok_p, *pos, *blk_row, *blk_exp, *nent;
    float *wts, *w_p;
    bf16_t *win_t, *wa_t, *wb_t, *wout_t, *h1, *proj, *ocat, *merged;
    float *gq, *gk, *gv, *gbeta, *gdec, *oa, *ob;
    float *hL, *hS, *hD;
    float *gAT, *gB, *gS; unsigned char *gBlob, *gM;
    unsigned char *dn_t, *hid, *gu_t, *h2, *Y;
    bf16_t* rwimg; float* rbias2; int *tile_cnt, *rnk;
};

typedef const __attribute__((address_space(4))) Ctx CtxK;

__device__ __forceinline__ void cvt_tile(LAS float* t, const float* srcA, const float* srcB, int ld, int mode, bf16_t* dst, int ldd) {
    const int tid = ltid(), kr = tid >> 6, cl = tid & 63;
    const float* sp = (mode == 1 && cl >= 32) ? (srcB + cl - 32) : (srcA + cl);
    float v[8];
#pragma unroll
    for (int p = 0; p < 8; ++p) v[p] = sp[(size_t)(p * 8 + kr) * ld];
    __syncthreads();
#pragma unroll
    for (int p = 0; p < 8; ++p) t[(p * 8 + kr) * 65 + cl] = v[p];
    __syncthreads();
    const int r = tid >> 3, seg = (tid & 7) * 8;
    const int lc = mode == 1 ? (((r >> 2) & 1) * 32 + 4 * (r >> 3) + (r & 3)) : r;
    float w[8];
#pragma unroll
    for (int j = 0; j < 8; ++j) w[j] = t[(seg + j) * 65 + lc];
    u32x4 o; o.x = cvt_pk_bf16(w[0], w[1]); o.y = cvt_pk_bf16(w[2], w[3]); o.z = cvt_pk_bf16(w[4], w[5]); o.w = cvt_pk_bf16(w[6], w[7]);
    *(u32x4*)(dst + (size_t)r * ldd + seg) = o;
}
__device__ __forceinline__ void cvt_tile8(LAS float* t, const float* srcA, const float* srcB, int ld, int mode, unsigned char* dst, int ldd, float scale) {
    const int tid = ltid(), kr = tid >> 6, cl = tid & 63;
    const float* sp = (mode == 1 && cl >= 32) ? (srcB + cl - 32) : (srcA + cl);
    float v[8];
#pragma unroll
    for (int p = 0; p < 8; ++p) v[p] = sp[(size_t)(p * 8 + kr) * ld];
    __syncthreads();
#pragma unroll
    for (int p = 0; p < 8; ++p) t[(p * 8 + kr) * 65 + cl] = v[p] * scale;
    __syncthreads();
    const int r = tid >> 3, seg = (tid & 7) * 8;
    const int lc = mode == 1 ? (((r >> 2) & 1) * 32 + 4 * (r >> 3) + (r & 3)) : r;
    float w[8];
#pragma unroll
    for (int j = 0; j < 8; ++j) w[j] = t[(seg + j) * 65 + lc];
    *(u32x2*)(dst + (size_t)r * ldd + seg) = (u32x2){cvt4_fp8(w[0], w[1], w[2], w[3]), cvt4_fp8(w[4], w[5], w[6], w[7])};
}
__device__ __forceinline__ void cvt_job(LAS float* t, int tile, const float* src, int ld, int K, bf16_t* dst) {
    const int nkt = K / 64, nt = tile / nkt, kt = tile % nkt;
    cvt_tile(t, src + (size_t)kt * 64 * ld + nt * 64, nullptr, ld, 0, dst + (size_t)nt * 64 * K + kt * 64, K);
}

__device__ void ph_pro1(CtxK& c, LAS unsigned char* lds) {
    const int tid = ltid(), wg = blockIdx.x, G = gridDim.x;
    LAS float* lf = (LAS float*)lds;
    for (int job = wg; job < 192; job += G) {
        const int cc = job % 48, kp = job / 48, q = tid & 63, rg = tid >> 6;
        f32x4 a = {0.f, 0.f, 0.f, 0.f};
        for (int r0 = rg; r0 < 512; r0 += 256) { f32x4 w[32]; float s[32];
#pragma unroll
            for (int u = 0; u < 32; ++u) { const int k = kp * 512 + r0 + u * 8; w[u] = *(const f32x4*)(c.w_ada + (size_t)k * (6 * D) + cc * 256 + q * 4); s[u] = c.c[k]; }
#pragma unroll
            for (int u = 0; u < 32; ++u) a += siluf_(s[u]) * w[u]; }
        __syncthreads();
        *(LAS f32x4*)(lf + (rg * 64 + q) * 4) = a;
        __syncthreads();
        if (tid < 64) { f32x4 s = {0.f, 0.f, 0.f, 0.f};
#pragma unroll
            for (int g = 0; g < 8; ++g) s += *(LAS f32x4*)(lf + (g * 64 + tid) * 4);
            *(f32x4*)(c.modp + (size_t)kp * (6 * D) + cc * 256 + tid * 4) = s; }
    }
    if (wg == G - 1) for (int j = tid; j < 1024; j += 512) c.lb[j] = 1.f / (1.f + expf(c.lb_table[1024 + j] - c.lb_table[j]));
    {
        const int rr = tid >> 4, c4 = (tid & 15) * 4, r = tid >> 3, seg = (tid & 7) * 8;
        f32x4 v[8][2];
        const int t0 = wg < 192 ? wg : 5376 + (wg - 192), tstep = wg < 192 ? 192 : 64, ntl = wg < 192 ? 28 : 44;
#define P1_DESC(T_) const float* sp_; bf16_t* dp_; int ld_, ldd_; { const int T = (T_); \
            if (T < 6144) { const int nt = T / 32, kt = T % 32, sc = nt * 64 + (nt * 64 >= WIN_GAB ? 16 : 0); sp_ = c.w_in + (size_t)kt * 64 * INW + sc; ld_ = INW; dp_ = c.win_t + (size_t)nt * 64 * D + kt * 64; ldd_ = D; } \
            else { const float* s0_; bf16_t* d0_; int K_, t_; if (T < 6656) { t_ = T - 6144; s0_ = c.w_bh; d0_ = c.wa_t; K_ = 1024; } else if (T < 7168) { t_ = T - 6656; s0_ = c.w_bg; d0_ = c.wb_t; K_ = 1024; } else { t_ = T - 7168; s0_ = c.w_out; d0_ = c.wout_t; K_ = 2048; } \
                const int nkt = K_ / 64, nt = t_ / nkt, kt = t_ % nkt; sp_ = s0_ + (size_t)kt * 64 * D + nt * 64; ld_ = D; dp_ = d0_ + (size_t)nt * 64 * K_ + kt * 64; ldd_ = K_; } }
#define P1_LOAD(i0_) do { _Pragma("unroll") for (int j = 0; j < 8; ++j) if ((i0_) + j < ntl) { P1_DESC(t0 + ((i0_) + j) * tstep) (void)dp_; (void)ldd_; const float* s_ = sp_ + (size_t)rr * ld_ + c4; \
            v[j][0] = *(const f32x4*)s_; v[j][1] = *(const f32x4*)(s_ + (size_t)32 * ld_); } } while (0)
        P1_LOAD(0);
        for (int i0 = 0; i0 < ntl; i0 += 8) {
            __syncthreads();
#pragma unroll
            for (int j = 0; j < 8; ++j) if (i0 + j < ntl) {
#pragma unroll
                for (int hh = 0; hh < 2; ++hh)
#pragma unroll
                    for (int e = 0; e < 4; ++e) lf[j * 4160 + (rr + 32 * hh) * 65 + c4 + e] = v[j][hh][e]; }
            __syncthreads();
            if (i0 + 8 < ntl) P1_LOAD(i0 + 8);
#pragma unroll
            for (int j = 0; j < 8; ++j) if (i0 + j < ntl) { P1_DESC(t0 + (i0 + j) * tstep) (void)sp_; (void)ld_;
                float w[8];
#pragma unroll
                for (int jj = 0; jj < 8; ++jj) w[jj] = lf[j * 4160 + (seg + jj) * 65 + r];
                u32x4 o; o.x = cvt_pk_bf16(w[0], w[1]); o.y = cvt_pk_bf16(w[2], w[3]); o.z = cvt_pk_bf16(w[4], w[5]); o.w = cvt_pk_bf16(w[6], w[7]);
                *(u32x4*)(dp_ + (size_t)r * ldd_ + seg) = o; }
        }
#undef P1_LOAD
#undef P1_DESC
    }
}
__device__ void ph_norm1(CtxK& c, LAS unsigned char* lds) {
    const int tid = ltid(), wg = blockIdx.x, G = gridDim.x, lane = tid & 63, wv = tid >> 6;
    LAS float* la = (LAS float*)lds;
    LAS float* lb_ = la + D;
    LAS float* lw = lb_ + D;
    for (int j = tid; j < D; j += 512) {
        float sh = c.b_ada[j], sc = c.b_ada[D + j];
#pragma unroll
        for (int p = 0; p < 4; ++p) { sh += c.modp[(size_t)p * 6 * D + j]; sc += c.modp[(size_t)p * 6 * D + D + j]; }
        la[j] = c.norm1_g[j] * (1.f + sc); lb_[j] = sh;
    }
    for (int j = wg * 512 + tid; j < 6 * D; j += G * 512) { float m = c.b_ada[j];
#pragma unroll
        for (int p = 0; p < 4; ++p) m += c.modp[(size_t)p * 6 * D + j];
        c.mod[j] = m; }
    for (int i = tid; i < D * 4; i += 512) { const int e = i >> 2, q = i & 3; const f32x4 w = *(const f32x4*)(c.w_in + (size_t)e * INW + WIN_GAB + q * 4);
        lw[(q * 4 + 0) * D + e] = w[0]; lw[(q * 4 + 1) * D + e] = w[1]; lw[(q * 4 + 2) * D + e] = w[2]; lw[(q * 4 + 3) * D + e] = w[3]; }
    __syncthreads();
    f32x4 vn[8];
    { const float* xr = c.x + (size_t)(wg * 8 + wv) * D;
#pragma unroll
      for (int i = 0; i < 8; ++i) vn[i] = *(const f32x4*)(xr + i * 256 + lane * 4); }
    for (int row = wg * 8 + wv; row < S; row += G * 8) {
        f32x4 v[8]; float ss = 0.f;
#pragma unroll
        for (int i = 0; i < 8; ++i) { v[i] = vn[i]; ss += v[i][0] * v[i][0] + v[i][1] * v[i][1] + v[i][2] * v[i][2] + v[i][3] * v[i][3]; }
        if (row + G * 8 < S) { const float* xr = c.x + (size_t)(row + G * 8) * D;
#pragma unroll
            for (int i = 0; i < 8; ++i) vn[i] = *(const f32x4*)(xr + i * 256 + lane * 4); }
        ss = wave_sum(ss); const float r = rsqrtf(ss * (1.f / D) + 1e-6f);
#pragma unroll
        for (int i = 0; i < 8; ++i) { const int e = i * 256 + lane * 4; const f32x4 a = *(LAS f32x4*)(la + e), b = *(LAS f32x4*)(lb_ + e); v[i] = v[i] * r * a + b;
            u32x2 w; w.x = cvt_pk_bf16(v[i][0], v[i][1]); w.y = cvt_pk_bf16(v[i][2], v[i][3]); *(u32x2*)(c.h1 + (size_t)row * D + e) = w; }
        float mine = 0.f;
        for (int cc = 0; cc < 16; ++cc) { float d = 0.f;
#pragma unroll
            for (int i = 0; i < 8; ++i) { const f32x4 w = *(LAS f32x4*)(lw + cc * D + i * 256 + lane * 4); d += v[i][0] * w[0] + v[i][1] * w[1] + v[i][2] * w[2] + v[i][3] * w[3]; }
            d = wave_sum_dpp(d); if (lane == cc) mine = d; }
        if (lane < 16) c.gab[(size_t)row * 16 + lane] = mine;
    }
    { const int id = wg * 512 + tid, i = id >> 6, e = id & 63;
      if (id < D * 64) {
          float sc = c.b_ada[4 * D + i];
#pragma unroll
          for (int p = 0; p < 4; ++p) sc += c.modp[(size_t)p * 6 * D + 4 * D + i];
          const float w = c.norm2_g[i] * (1.f + sc) * c.w_router[id];
          const unsigned hi = cvt_pk_bf16(w, w) & 0xffffu; const float lo = w - __uint_as_float(hi << 16);
          const int ch = i >> 7, kk = i & 127;
          c.rwimg[((ch * 2 + 0) * 64 + e) * 136 + kk] = (bf16_t)hi; c.rwimg[((ch * 2 + 1) * 64 + e) * 136 + kk] = (bf16_t)(cvt_pk_bf16(lo, lo) & 0xffffu);
      } }
    if (wg < 64) {
        __syncthreads();
        float a = 0.f;
        for (int i = tid; i < D; i += 512) { float sh = c.b_ada[3 * D + i];
#pragma unroll
            for (int p = 0; p < 4; ++p) sh += c.modp[(size_t)p * 6 * D + 3 * D + i];
            a += sh * c.w_router[i * 64 + wg]; }
        a = wave_sum(a); if (lane == 0) la[wv] = a; __syncthreads();
        if (tid == 0) c.rbias2[wg] = la[0] + la[1] + la[2] + la[3] + la[4] + la[5] + la[6] + la[7];
    }
}
__device__ void ph_gemm1(CtxK& c, LAS unsigned char* lds) {
    gm::DenseSched<S / 256, PW / 256, 1, D, D> Sd; Sd.init(c.win_t, nullptr); gm::EpiProj E{c.proj};
    gm::gphase(lds, (const char*)c.h1, D, Sd, E);
}
__device__ void ph_gemm2(CtxK& c, LAS unsigned char* lds) {
    gm::DenseSched<S / 256, D / 256, 2, 1024, 2048> Sd; Sd.init(c.wa_t, c.wb_t); gm::EpiMerge E{c.proj, c.merged};
    gm::gphase(lds, (const char*)c.ocat, 1024, Sd, E);
}
__device__ void ph_gemm3(CtxK& c, LAS unsigned char* lds) {
    gm::DenseSched<S / 256, D / 256, 1, D, D> Sd; Sd.init(c.wout_t, nullptr); gm::EpiResid E{c.x, c.mod + 2 * D, c.out};
    gm::gphase(lds, (const char*)c.merged, D, Sd, E);
}
__device__ void ph_moe_gu(CtxK& c, LAS unsigned char* lds) {
    gm::MoeSched<true, 4, D / 2, D / 2, (size_t)1024 * D> Sm; Sm.init(lds, c.nent, c.blk_row, c.blk_exp, c.tok_p, c.gu_t); gm::EpiSwiglu E{c.hid};
    gm::gphase(lds, (const char*)c.h2, D / 2, Sm, E);
}
__device__ void ph_moe_dn(CtxK& c, LAS unsigned char* lds) {
    gm::MoeSched<false, 8, FF / 2, FF / 2, (size_t)D * FF> Sm; Sm.init(lds, c.nent, c.blk_row, c.blk_exp, c.tok_p, c.dn_t); Sm.wp = c.w_p; gm::EpiDown E{c.Y, (LAS const float*)(lds + Sm.TOK)};
    gm::gphase(lds, (const char*)c.hid, FF / 2, Sm, E);
}
__device__ void ph_cvt_exp(CtxK& c, LAS unsigned char* lds) {
    LAS float* lf = (LAS float*)lds; const int wg = blockIdx.x - 8, G = gridDim.x - 8;
    if (wg < 0) return;
    const int tid = ltid(), tr = tid >> 4, c4 = (tid & 15) * 4, r = tid >> 3, seg = (tid & 7) * 8;
    constexpr int NG_GU = NEX * 128, NGRP = NEX * 192;
    f32x4 v[4][2];
#define CE_DESC(q_) const float* sp_; unsigned char* dp_; int ld_, ldd_, js_, jd_, mode_; float scale_; { const int gq_ = (q_); \
        if (gq_ < NG_GU) { const int e = gq_ >> 7, rr = gq_ & 127, ng = rr >> 5, kt = rr & 31; const float* sg = e < NE ? c.w_eg + (size_t)e * D * FF : c.w_sg; const float* su = e < NE ? c.w_eu + (size_t)e * D * FF : c.w_su; \
            sp_ = (c4 >= 32 ? su + c4 - 32 : sg + c4) + (size_t)(kt * 64 + tr) * FF + ng * 128; ld_ = FF; js_ = 32; dp_ = c.gu_t + ((size_t)e * 1024 + ng * 256) * D + kt * 64; ldd_ = D; jd_ = 64 * D; mode_ = 1; scale_ = 64.f; } \
        else { const int q2 = gq_ - NG_GU, e = q2 >> 6, rr = q2 & 63, ng = rr >> 3, kt = rr & 7; const float* sd = e < NE ? c.w_ed + (size_t)e * FF * D : c.w_sd; \
            sp_ = sd + c4 + (size_t)(kt * 64 + tr) * D + ng * 256; ld_ = D; js_ = 64; dp_ = c.dn_t + (size_t)e * D * FF + (size_t)ng * 256 * FF + kt * 64; ldd_ = FF; jd_ = 64 * FF; mode_ = 0; scale_ = 32.f; } }
#define CE_LOAD(q_) do { CE_DESC(q_) (void)dp_; (void)ldd_; (void)jd_; (void)mode_; (void)scale_; \
        _Pragma("unroll") for (int j = 0; j < 4; ++j) { v[j][0] = *(const f32x4*)(sp_ + j * js_); v[j][1] = *(const f32x4*)(sp_ + (size_t)32 * ld_ + j * js_); } } while (0)
    if (wg < NGRP) CE_LOAD(wg);
    for (int q = wg; q < NGRP; q += G) {
        CE_DESC(q) (void)sp_; (void)ld_; (void)js_;
        __syncthreads();
#pragma unroll
        for (int j = 0; j < 4; ++j)
#pragma unroll
            for (int hh = 0; hh < 2; ++hh)
#pragma unroll
                for (int e = 0; e < 4; ++e) lf[j * 4160 + (tr + 32 * hh) * 65 + c4 + e] = v[j][hh][e] * scale_;
        __syncthreads();
        if (q + G < NGRP) CE_LOAD(q + G);
        const int lc = mode_ == 1 ? (((r >> 2) & 1) * 32 + 4 * (r >> 3) + (r & 3)) : r;
#pragma unroll
        for (int j = 0; j < 4; ++j) { float w[8];
#pragma unroll
            for (int jj = 0; jj < 8; ++jj) w[jj] = lf[j * 4160 + (seg + jj) * 65 + lc];
            *(u32x2*)(dp_ + (size_t)j * jd_ + (size_t)r * ldd_ + seg) = (u32x2){cvt4_fp8(w[0], w[1], w[2], w[3]), cvt4_fp8(w[4], w[5], w[6], w[7])}; }
    }
#undef CE_LOAD
#undef CE_DESC
}
__device__ void ph_final(CtxK& c, LAS unsigned char* lds) {
    const int tid = ltid(), wg = blockIdx.x, G = gridDim.x, lane = tid & 63, wv = tid >> 6;
    const float* gt2 = c.mod + 5 * D;
    int pn[2][8];
#pragma unroll
    for (int rr = 0; rr < 2; ++rr)
#pragma unroll
        for (int k = 0; k < 8; ++k) pn[rr][k] = c.pos[((wg * 8 + wv) * 2 + rr) * TOPK + k];
    for (int row0 = (wg * 8 + wv) * 2; row0 < S; row0 += G * 16) {
        int p[2][9];
#pragma unroll
        for (int rr = 0; rr < 2; ++rr) {
#pragma unroll
            for (int k = 0; k < 8; ++k) p[rr][k] = pn[rr][k];
            p[rr][8] = PROUTED + row0 + rr; }
        if (row0 + G * 16 < S) {
#pragma unroll
            for (int rr = 0; rr < 2; ++rr)
#pragma unroll
                for (int k = 0; k < 8; ++k) pn[rr][k] = c.pos[(row0 + G * 16 + rr) * TOPK + k]; }
        f32x4 v[2][4][2]; float ss[2] = {0.f, 0.f};
#pragma unroll
        for (int rr = 0; rr < 2; ++rr) {
#pragma unroll
            for (int i = 0; i < 4; ++i) {
                const int e = i * 512 + lane * 8; f32x4 a0 = {0.f, 0.f, 0.f, 0.f}, a1 = {0.f, 0.f, 0.f, 0.f};
#pragma unroll
                for (int k = 0; k < 9; ++k) { const u32x2 y = *(const u32x2*)(c.Y + (size_t)p[rr][k] * D + e);
                    const auto q0 = __builtin_amdgcn_cvt_pk_f32_fp8((int)y.x, false), q1 = __builtin_amdgcn_cvt_pk_f32_fp8((int)y.x, true), q2 = __builtin_amdgcn_cvt_pk_f32_fp8((int)y.y, false), q3 = __builtin_amdgcn_cvt_pk_f32_fp8((int)y.y, true);
                    a0[0] += q0[0]; a0[1] += q0[1]; a0[2] += q1[0]; a0[3] += q1[1]; a1[0] += q2[0]; a1[1] += q2[1]; a1[2] += q3[0]; a1[3] += q3[1]; }
                const float* xp = c.out + (size_t)(row0 + rr) * D + e;
                const f32x4 x0 = *(const f32x4*)xp, x1 = *(const f32x4*)(xp + 4), g0 = *(const f32x4*)(gt2 + e) * 0.0625f, g1 = *(const f32x4*)(gt2 + e + 4) * 0.0625f;
                v[rr][i][0] = x0 + g0 * a0; v[rr][i][1] = x1 + g1 * a1;
#pragma unroll
                for (int j = 0; j < 4; ++j) ss[rr] += v[rr][i][0][j] * v[rr][i][0][j] + v[rr][i][1][j] * v[rr][i][1][j];
            } }
        f32x4 gw[4][2];
#pragma unroll
        for (int i = 0; i < 4; ++i) { const int e = i * 512 + lane * 8; gw[i][0] = *(const f32x4*)(c.normf_g + e); gw[i][1] = *(const f32x4*)(c.normf_g + e + 4); }
#pragma unroll
        for (int rr = 0; rr < 2; ++rr) {
            const float r = rsqrtf(wave_sum_dpp(ss[rr]) * (1.f / D) + 1e-6f);
#pragma unroll
            for (int i = 0; i < 4; ++i) { const int e = i * 512 + lane * 8; float* op = c.out + (size_t)(row0 + rr) * D + e;
                *(f32x4*)op = v[rr][i][0] * r * gw[i][0]; *(f32x4*)(op + 4) = v[rr][i][1] * r * gw[i][1]; } }
    }
}

namespace mx {
constexpr int ST128 = 272, ST64 = 144;
constexpr int FRAG_F4 = 8 * 8 * 64;
__device__ __forceinline__ f32x4 mfma16(bf16x8 a, bf16x8 b, f32x4 c) { return __builtin_amdgcn_mfma_f32_16x16x32_bf16(a, b, c, 0, 0, 0); }
template <int MT, int KS>
__device__ __forceinline__ void mma_nt(f32x4 (&acc)[MT], LAS const unsigned char* xs, int sx, LAS const unsigned char* ys, int sy, int fr, int fq) {
#pragma unroll
    for (int kk = 0; kk < KS; ++kk) {
        const bf16x8 b = *(const LAS bf16x8*)(ys + fr * sy + (kk * 32 + fq * 8) * 2);
#pragma unroll
        for (int m = 0; m < MT; ++m) { const bf16x8 a = *(const LAS bf16x8*)(xs + (16 * m + fr) * sx + (kk * 32 + fq * 8) * 2); acc[m] = mfma16(a, b, acc[m]); }
    }
}
__device__ __forceinline__ void lds_fence() { asm volatile("s_waitcnt lgkmcnt(0)" ::: "memory"); }
__device__ __forceinline__ u32x4 pack8(const float (&v)[8]) { u32x4 o; o.x = cvt_pk_bf16(v[0], v[1]); o.y = cvt_pk_bf16(v[2], v[3]); o.z = cvt_pk_bf16(v[4], v[5]); o.w = cvt_pk_bf16(v[6], v[7]); return o; }
__device__ __forceinline__ void unpack8(const u32x4 w, float (&v)[8]) { v[0] = bflo(w.x); v[1] = bfhi(w.x); v[2] = bflo(w.y); v[3] = bfhi(w.y); v[4] = bflo(w.z); v[5] = bfhi(w.z); v[6] = bflo(w.w); v[7] = bfhi(w.w); }
__device__ __forceinline__ void mfma_pad8(f32x4 (&a)[8]) { asm volatile("s_nop 15\n\ts_nop 7" : "+v"(a[0]), "+v"(a[1]), "+v"(a[2]), "+v"(a[3]), "+v"(a[4]), "+v"(a[5]), "+v"(a[6]), "+v"(a[7])); }
__device__ __forceinline__ void mfma_pad4(f32x4 (&a)[4]) { asm volatile("s_nop 15\n\ts_nop 7" : "+v"(a[0]), "+v"(a[1]), "+v"(a[2]), "+v"(a[3])); }
__device__ __forceinline__ void write_st(LAS unsigned char* stw, f32x4 (&S)[8], int fr, int fq) {
    mfma_pad8(S);
#pragma unroll
    for (int m = 0; m < 8; ++m) { u32x2 w; w.x = cvt_pk_bf16(S[m][0], S[m][1]); w.y = cvt_pk_bf16(S[m][2], S[m][3]); *(LAS u32x2*)(stw + fr * ST128 + (16 * m + 4 * fq) * 2) = w; }
}

__device__ __forceinline__ void gate_issue(u32x4 (&gp)[2], const bf16_t* gate0) {
    const int t_ = ltid(); const bf16_t* p = gate0 + (size_t)(t_ >> 3) * PW + (t_ & 7) * 16;
    gp[0] = *(const u32x4*)p; gp[1] = *(const u32x4*)(p + 8);
}
__device__ __forceinline__ void out_stage(LAS unsigned char* ot, LAS float* part, LAS float* rinv, const f32x4 (&o)[4], const u32x4 (&gp)[2], const float gn, bf16_t* out0, int wv, int lane, int fr, int fq) {
    float s_ = 0.f;
#pragma unroll
    for (int w = 0; w < 8; ++w) s_ += part[w * 64 + lane];
    const float rv = rsqrtf(s_ * (1.f / 128.f) + 1e-6f);
    rinv[lane] = rv; lds_fence();
#pragma unroll
    for (int m = 0; m < 4; ++m)
    { const f32x4 rq = *(LAS const f32x4*)(rinv + 16 * m + 4 * fq);
#pragma unroll
        for (int r = 0; r < 4; ++r) { const int cc = 16 * m + 4 * fq + r; const float x = o[m][r] * rq[r] * gn;
            *(LAS bf16_t*)(ot + cc * ST128 + (wv * 16 + fr) * 2) = (bf16_t)(cvt_pk_bf16(x, x) & 0xffffu); } }
    __syncthreads();
    const int t_ = ltid(), cc = t_ >> 3, sg = (t_ & 7) * 16;
#pragma unroll
    for (int hh = 0; hh < 2; ++hh) { float ov[8], gv[8];
        unpack8(*(LAS u32x4*)(ot + cc * ST128 + (sg + hh * 8) * 2), ov); unpack8(gp[hh], gv);
#pragma unroll
        for (int j = 0; j < 8; ++j) ov[j] *= siluf_(gv[j]);
        *(u32x4*)(out0 + (size_t)cc * D + sg + hh * 8) = pack8(ov); }
}

constexpr int H_QT = 0, H_KT = 17408, H_QI = 34816, H_KU = 52224, H_VT = 70656, H_P = 89088, H_DEC = 98304, H_OCT = 98816, H_F4 = H_OCT + 8192, H_PART = H_F4 + 512, H_RINV = H_PART + 2048, H_ST = H_RINV + 256, H_LB = H_ST + 8 * 16 * ST128, H_END = H_LB + 512;
static_assert(H_END <= 147456, "hgrn lds");
template <bool OUT>
__device__ void hgrn_pass(CtxK& c, LAS unsigned char* lds) {
    const int tid = ltid(), wv = __builtin_amdgcn_readfirstlane(tid >> 6), lane = tid & 63, fr = lane & 15, fq = lane >> 4;
    LAS float* dec = (LAS float*)(lds + H_DEC); LAS float* oct = (LAS float*)(lds + H_OCT); LAS float* f4 = (LAS float*)(lds + H_F4);
    LAS float* part = (LAS float*)(lds + H_PART); LAS float* rinv = (LAS float*)(lds + H_RINV);
    LAS unsigned char* stw = lds + H_ST + wv * 16 * ST128;
    {
        const int wu = blockIdx.x, h = wu & 7, g = wu >> 3;
        f32x4 Sacc[8];
#pragma unroll
        for (int m = 0; m < 8; ++m) Sacc[m] = (f32x4){0.f, 0.f, 0.f, 0.f};
        if (OUT) {
            if (g > 0) { const f32x4* sp = (const f32x4*)c.hS + (size_t)(h * 32 + g) * FRAG_F4 + (wv * 8) * 64 + lane;
#pragma unroll
                for (int m = 0; m < 8; ++m) Sacc[m] = sp[m * 64]; }
            write_st(stw, Sacc, fr, fq);
        }
        LAS float* lbs = (LAS float*)(lds + H_LB);
        if (tid < 128) lbs[tid] = c.lb[h * 128 + tid];
        __syncthreads();
        const float gnw = OUT ? c.hgrn_onorm_g[wv * 16 + fr] : 0.f;
        float dsum = 0.f;
        u32x4 pf[4], pv[4], pq[4];
#define HP_ISSUE(i_) do { const int tq_ = ltid(), rl_ = tq_ >> 8; const bf16_t* b_ = c.proj + (size_t)((g * 8 + (i_)) * 64 + ((tq_ >> 4) & 15) * 4) * PW + h * 128 + (tq_ & 15) * 8; \
        if (rl_ == 1 || OUT) { _Pragma("unroll") for (int tt = 0; tt < 4; ++tt) pf[tt] = *(const u32x4*)(b_ + (size_t)tt * PW + C_HF); } \
        if (rl_ == 0) { _Pragma("unroll") for (int tt = 0; tt < 4; ++tt) pv[tt] = *(const u32x4*)(b_ + (size_t)tt * PW + C_HI); \
            if (OUT) { _Pragma("unroll") for (int tt = 0; tt < 4; ++tt) pq[tt] = *(const u32x4*)(b_ + (size_t)tt * PW + C_HQ); } } } while (0)
        HP_ISSUE(0);
        for (int i = 0; i < 8; ++i) {
            const int T0 = (g * 8 + i) * 64;
            const int tp = ltid(), role = tp >> 8, tq = (tp >> 4) & 15, co = tp & 15, c0 = tq * 4, d0 = co * 8;
            const bool cum = role == 1 || OUT;
            float cs[4][8];
            if (cum) {
                float lbv[8];
                { const f32x4 l0 = *(LAS f32x4*)(lbs + d0), l1 = *(LAS f32x4*)(lbs + d0 + 4);
                  lbv[0] = l0[0]; lbv[1] = l0[1]; lbv[2] = l0[2]; lbv[3] = l0[3]; lbv[4] = l1[0]; lbv[5] = l1[1]; lbv[6] = l1[2]; lbv[7] = l1[3]; }
#pragma unroll
                for (int tt = 0; tt < 4; ++tt) {
                    float fv[8]; unpack8(pf[tt], fv);
#pragma unroll
                    for (int j = 0; j < 8; ++j) { const float lf = __logf(lbv[j] + (1.f - lbv[j]) * sigmoidf_(fv[j])); cs[tt][j] = tt ? cs[tt - 1][j] + lf : lf; }
                }
                if (role == 1) {
                    *(LAS f32x4*)(oct + tq * 128 + d0) = (f32x4){cs[3][0], cs[3][1], cs[3][2], cs[3][3]}; *(LAS f32x4*)(oct + tq * 128 + d0 + 4) = (f32x4){cs[3][4], cs[3][5], cs[3][6], cs[3][7]};
                    if (tq == 8) { *(LAS f32x4*)(f4 + d0) = (f32x4){cs[0][0], cs[0][1], cs[0][2], cs[0][3]}; *(LAS f32x4*)(f4 + d0 + 4) = (f32x4){cs[0][4], cs[0][5], cs[0][6], cs[0][7]}; }
                }
            }
            if (role == 0) {
#pragma unroll
                for (int j = 0; j < 8; j += 2) { const int wi = j >> 1; u32x2 w0, w1;
                    const unsigned a0 = wi == 0 ? pv[0].x : wi == 1 ? pv[0].y : wi == 2 ? pv[0].z : pv[0].w, a1 = wi == 0 ? pv[1].x : wi == 1 ? pv[1].y : wi == 2 ? pv[1].z : pv[1].w;
                    const unsigned a2 = wi == 0 ? pv[2].x : wi == 1 ? pv[2].y : wi == 2 ? pv[2].z : pv[2].w, a3 = wi == 0 ? pv[3].x : wi == 1 ? pv[3].y : wi == 2 ? pv[3].z : pv[3].w;
                    w0.x = (a0 & 0xffffu) | (a1 << 16); w0.y = (a2 & 0xffffu) | (a3 << 16);
                    w1.x = (a0 >> 16) | (a1 & 0xffff0000u); w1.y = (a2 >> 16) | (a3 & 0xffff0000u);
                    *(LAS u32x2*)(lds + H_VT + (d0 + j) * ST64 + c0 * 2) = w0; *(LAS u32x2*)(lds + H_VT + (d0 + j + 1) * ST64 + c0 * 2) = w1; }
            }
            __syncthreads();
            if (cum) {
                float pre[8], tot[8], bmid[8];
#pragma unroll
                for (int j = 0; j < 8; ++j) { pre[j] = 0.f; tot[j] = 0.f; bmid[j] = 0.f; }
#pragma unroll
                for (int o = 0; o < 16; ++o) { const f32x4 x0 = *(LAS f32x4*)(oct + o * 128 + d0), x1 = *(LAS f32x4*)(oct + o * 128 + d0 + 4);
#pragma unroll
                    for (int j = 0; j < 8; ++j) { const float x = j < 4 ? x0[j] : x1[j - 4]; pre[j] += o < tq ? x : 0.f; bmid[j] += o < 8 ? x : 0.f; tot[j] += x; } }
                { const f32x4 x0 = *(LAS f32x4*)(f4 + d0), x1 = *(LAS f32x4*)(f4 + d0 + 4);
#pragma unroll
                  for (int j = 0; j < 8; ++j) bmid[j] += j < 4 ? x0[j] : x1[j - 4]; }
                if (role == 0) {
                    float ebm[8];
#pragma unroll
                    for (int j = 0; j < 8; ++j) ebm[j] = __expf(bmid[j]);
#pragma unroll
                    for (int tt = 0; tt < 4; ++tt) {
                        float qv[8], q1[8], q2[8];
                        unpack8(pq[tt], qv);
#pragma unroll
                        for (int j = 0; j < 8; ++j) { const float q = siluf_(qv[j]) * 0.08838834764831845f; q1[j] = q * __expf(pre[j] + cs[tt][j] - bmid[j]); q2[j] = q1[j] * ebm[j]; }
                        *(LAS u32x4*)(lds + H_QT + (c0 + tt) * ST128 + d0 * 2) = pack8(q1); *(LAS u32x4*)(lds + H_QI + (c0 + tt) * ST128 + d0 * 2) = pack8(q2);
                    }
                } else {
                    if (tq == 0) {
#pragma unroll
                        for (int j = 0; j < 8; ++j) dec[d0 + j] = __expf(tot[j]);
                    }
                    float kk[4][8];
                    if (OUT) {
#pragma unroll
                        for (int tt = 0; tt < 4; ++tt) {
#pragma unroll
                            for (int j = 0; j < 8; ++j) { const float lf = tt ? cs[tt][j] - cs[tt - 1][j] : cs[0][j]; kk[tt][j] = (1.f - __expf(lf)) * __expf(bmid[j] - pre[j] - cs[tt][j]); }
                            *(LAS u32x4*)(lds + H_KT + (c0 + tt) * ST128 + d0 * 2) = pack8(kk[tt]);
                        }
                    }
#pragma unroll
                    for (int j = 0; j < 8; ++j) { float col[4]; const float e8 = OUT ? __expf(tot[j] - bmid[j]) : 0.f;
#pragma unroll
                        for (int tt = 0; tt < 4; ++tt) { if (OUT) col[tt] = kk[tt][j] * e8; else { const float lf = tt ? cs[tt][j] - cs[tt - 1][j] : cs[0][j]; col[tt] = (1.f - __expf(lf)) * __expf(tot[j] - pre[j] - cs[tt][j]); } }
                        u32x2 w; w.x = cvt_pk_bf16(col[0], col[1]); w.y = cvt_pk_bf16(col[2], col[3]);
                        *(LAS u32x2*)(lds + H_KU + (d0 + j) * ST64 + c0 * 2) = w; }
                }
            }
            __syncthreads();
            if (i + 1 < 8) HP_ISSUE(i + 1);
            u32x4 gpre[2];
            if (OUT) gate_issue(gpre, c.proj + (size_t)T0 * PW + C_HG + h * 128);
            if (!OUT && tid < 128) dsum += __logf(dec[tid]);
            f32x4 oacc[4];
            if (OUT) {
                { f32x4 sc[2] = {(f32x4){0.f, 0.f, 0.f, 0.f}, (f32x4){0.f, 0.f, 0.f, 0.f}};
                  const int nt = wv & 3, mb = (wv >> 2) * 2;
                  mma_nt<2, 4>(sc, lds + H_KT + mb * 16 * ST128, ST128, lds + H_QT + nt * 16 * ST128, ST128, fr, fq);
#pragma unroll
                  for (int m = 0; m < 2; ++m) { const int cc = nt * 16 + fr, s0 = (mb + m) * 16 + 4 * fq; u32x2 w;
                      w.x = cvt_pk_bf16(s0 + 0 <= cc ? sc[m][0] : 0.f, s0 + 1 <= cc ? sc[m][1] : 0.f); w.y = cvt_pk_bf16(s0 + 2 <= cc ? sc[m][2] : 0.f, s0 + 3 <= cc ? sc[m][3] : 0.f);
                      *(LAS u32x2*)(lds + H_P + cc * ST64 + s0 * 2) = w; } }
                __syncthreads();
#pragma unroll
                for (int m = 0; m < 4; ++m) oacc[m] = (f32x4){0.f, 0.f, 0.f, 0.f};
                mma_nt<4, 2>(oacc, lds + H_P, ST64, lds + H_VT + wv * 16 * ST64, ST64, fr, fq);
                mma_nt<4, 4>(oacc, lds + H_QI, ST128, stw, ST128, fr, fq);
#pragma unroll
                for (int m = 0; m < 4; ++m)
#pragma unroll
                    for (int r = 0; r < 4; ++r) { const float q = row16_sum(oacc[m][r] * oacc[m][r]); if (fr == 0) part[wv * 64 + 16 * m + 4 * fq + r] = q; }
            }
#pragma unroll
            for (int m = 0; m < 8; ++m) { const f32x4 dv = *(LAS f32x4*)(dec + 16 * m + 4 * fq); Sacc[m] = Sacc[m] * dv; }
            mma_nt<8, 2>(Sacc, lds + H_KU, ST64, lds + H_VT + wv * 16 * ST64, ST64, fr, fq);
            if (OUT) {
                lds_fence();
                write_st(stw, Sacc, fr, fq);
                __syncthreads();
                out_stage(lds + H_QT, part, rinv, oacc, gpre, gnw, c.ocat + (size_t)T0 * D + h * 128, wv, lane, fr, fq);
            }
            __syncthreads();
        }
#undef HP_ISSUE
        if (!OUT) {
            f32x4* sp = (f32x4*)c.hL + (size_t)(h * 32 + g) * FRAG_F4 + (wv * 8) * 64 + lane;
#pragma unroll
            for (int m = 0; m < 8; ++m) sp[m * 64] = Sacc[m];
            if (tid < 128) c.hD[(h * 32 + g) * 128 + tid] = __expf(dsum);
        }
    }
}
__device__ void hgrn_scan(CtxK& c) {
    if (ltid() >= 128) return;
    const int e = blockIdx.x * 128 + ltid();
    if (e >= 8 * FRAG_F4) return;
    const int h = e / FRAG_F4, fi = e % FRAG_F4, m = (fi >> 6) & 7, lane = fi & 63, d0 = 16 * m + 4 * (lane >> 4);
    f32x4 s = {0.f, 0.f, 0.f, 0.f};
    for (int g0 = 0; g0 < 31; g0 += 16) {
        f32x4 dc[16], hl[16];
#pragma unroll
        for (int u = 0; u < 16; ++u) if (g0 + u < 31) { dc[u] = *(const f32x4*)(c.hD + (h * 32 + g0 + u) * 128 + d0); hl[u] = ((const f32x4*)c.hL)[(size_t)(h * 32 + g0 + u) * FRAG_F4 + fi]; }
#pragma unroll
        for (int u = 0; u < 16; ++u) if (g0 + u < 31) { s = s * dc[u] + hl[u]; ((f32x4*)c.hS)[(size_t)(h * 32 + g0 + u + 1) * FRAG_F4 + fi] = s; }
    }
}

constexpr int B_T = 0, B_KBG = 9216, B_KU = 26624, B_VB = 45056, B_QD = 63488, B_AT = 80896, B_SC = 90112, BLOB = 90368;
constexpr int G_ST = BLOB, G_RV = G_ST + 8 * 16 * ST128, G_PART = G_RV + 8 * 16 * ST64, G_RINV = G_PART + 2048, G_END = G_RINV + 256;
static_assert(G_END <= 147456, "gdn lds");
constexpr int P_K = 0, P_Q = 17408, P_BETA = 34816, P_GC = P_BETA + 256, P_EG = P_GC + 256, P_EK = P_EG + 256, P_CW = P_EK + 256;

__device__ void gdn_prep(CtxK& c, LAS unsigned char* lds, int h, int g) {
    const int tid = ltid(), wv = __builtin_amdgcn_readfirstlane(tid >> 6), lane = tid & 63, fr = lane & 15, fq = lane >> 4;
    LAS float* sbeta = (LAS float*)(lds + P_BETA); LAS float* sgc = (LAS float*)(lds + P_GC); LAS float* seg = (LAS float*)(lds + P_EG); LAS float* sek = (LAS float*)(lds + P_EK);
    u32x4 raw[11];
#define GR_ISSUE(i_) do { const int tq_ = ltid(); if (tq_ < 384) { const int T_ = (g * 8 + (i_)) * 64 + ((tq_ >> 4) & 7) * 8 - 3; const bf16_t* b_ = c.proj + C_GQKV + (tq_ >> 7) * 1024 + h * 128 + (tq_ & 15) * 8; \
        _Pragma("unroll") for (int r = 0; r < 11; ++r) raw[r] = T_ + r >= 0 ? *(const u32x4*)(b_ + (size_t)(T_ + r) * PW) : (u32x4){0u, 0u, 0u, 0u}; } } while (0)
    GR_ISSUE(0);
    LAS float* scw = (LAS float*)(lds + P_CW);
    for (int j = tid; j < 1536; j += 512) { const int tap = j / 384, r_ = j % 384; scw[j] = c.conv_w[tap * 3072 + (r_ >> 7) * 1024 + h * 128 + (r_ & 127)]; }
    const float nea = -__expf(c.a_log[h]), dtb = c.dt_bias[h];
    float gan = 0.f, gbn = 0.f;
    if (wv == 0) { gan = c.gab[(size_t)(g * 512 + lane) * 16 + h]; gbn = c.gab[(size_t)(g * 512 + lane) * 16 + 8 + h]; }
    for (int i = 0; i < 8; ++i) {
        const int n = g * 8 + i, T0 = n * 64;
        unsigned char* blob = (unsigned char*)c.gBlob + (size_t)(h * 256 + n) * BLOB;
        if (wv == 0) {
            const float ga = gan, gb = gbn;
            if (i + 1 < 8) { gan = c.gab[(size_t)(T0 + 64 + lane) * 16 + h]; gbn = c.gab[(size_t)(T0 + 64 + lane) * 16 + 8 + h]; }
            const float gl_ = nea * softplusf_(ga + dtb);
            float gc = gl_;
            gc = wave_scan_dpp(gc);
            const float glast = __builtin_bit_cast(float, __builtin_amdgcn_readlane(__builtin_bit_cast(int, gc), 63));
            sbeta[lane] = sigmoidf_(gb); sgc[lane] = gc; seg[lane] = __expf(gc); sek[lane] = __expf(glast - gc);
            if (lane == 0) *(float*)(blob + B_SC) = __expf(glast);
        }
        __syncthreads();
        const int tp = ltid(), part = tp >> 7, to = (tp >> 4) & 7, co = tp & 15, c0 = to * 8, d0 = co * 8;
        if (tp < 384) {
            const int chb = part * 1024 + h * 128 + d0;
            float val[8][8];
            {
                float wj[4][8];
#pragma unroll
                for (int j = 0; j < 4; ++j) { const f32x4 a = *(LAS const f32x4*)(scw + j * 384 + part * 128 + d0), b = *(LAS const f32x4*)(scw + j * 384 + part * 128 + d0 + 4);
                    wj[j][0] = a[0]; wj[j][1] = a[1]; wj[j][2] = a[2]; wj[j][3] = a[3]; wj[j][4] = b[0]; wj[j][5] = b[1]; wj[j][6] = b[2]; wj[j][7] = b[3]; }
#pragma unroll
                for (int tt = 0; tt < 8; ++tt) {
                    float a[8] = {0.f, 0.f, 0.f, 0.f, 0.f, 0.f, 0.f, 0.f};
#pragma unroll
                    for (int j = 0; j < 4; ++j) { float xv[8]; unpack8(raw[tt + j], xv);
#pragma unroll
                        for (int jj = 0; jj < 8; ++jj) a[jj] += wj[j][jj] * xv[jj]; }
#pragma unroll
                    for (int jj = 0; jj < 8; ++jj) val[tt][jj] = siluf_(a[jj]);
                }
            }
            if (part < 2) {
#pragma unroll
                for (int tt = 0; tt < 8; ++tt) { float ss = 0.f;
#pragma unroll
                    for (int jj = 0; jj < 8; ++jj) ss += val[tt][jj] * val[tt][jj];
                    ss = row16_sum(ss);
                    const float rn = rsqrtf(ss + 1e-6f) * (part == 0 ? 0.08838834764831845f : 1.f);
#pragma unroll
                    for (int jj = 0; jj < 8; ++jj) val[tt][jj] *= rn; }
            }
            if (part == 0) {
#pragma unroll
                for (int tt = 0; tt < 8; ++tt) { const int cc = c0 + tt; *(LAS u32x4*)(lds + P_Q + cc * ST128 + d0 * 2) = pack8(val[tt]);
                    const float e = seg[cc]; float qd[8];
#pragma unroll
                    for (int jj = 0; jj < 8; ++jj) qd[jj] = val[tt][jj] * e;
                    *(u32x4*)(blob + B_QD + cc * ST128 + d0 * 2) = pack8(qd); }
            } else if (part == 1) {
#pragma unroll
                for (int tt = 0; tt < 8; ++tt) { const int cc = c0 + tt; *(LAS u32x4*)(lds + P_K + cc * ST128 + d0 * 2) = pack8(val[tt]);
                    const float e = seg[cc] * sbeta[cc]; float kb[8];
#pragma unroll
                    for (int jj = 0; jj < 8; ++jj) kb[jj] = val[tt][jj] * e;
                    *(u32x4*)(blob + B_KBG + cc * ST128 + d0 * 2) = pack8(kb); }
#pragma unroll
                for (int jj = 0; jj < 8; ++jj) { float col[8];
#pragma unroll
                    for (int tt = 0; tt < 8; ++tt) col[tt] = val[tt][jj] * sek[c0 + tt];
                    *(u32x4*)(blob + B_KU + (d0 + jj) * ST64 + c0 * 2) = pack8(col); }
            } else {
#pragma unroll
                for (int jj = 0; jj < 8; ++jj) { float col[8];
#pragma unroll
                    for (int tt = 0; tt < 8; ++tt) col[tt] = val[tt][jj] * sbeta[c0 + tt];
                    *(u32x4*)(blob + B_VB + (d0 + jj) * ST64 + c0 * 2) = pack8(col); }
            }
        }
        __syncthreads();
        if (i + 1 < 8) GR_ISSUE(i + 1);
        {
            const int nt = wv & 3, mb = (wv >> 2) * 2, jj = nt * 16 + fr;
            f32x4 kk2[2] = {(f32x4){0.f, 0.f, 0.f, 0.f}, (f32x4){0.f, 0.f, 0.f, 0.f}}, at2[2] = {(f32x4){0.f, 0.f, 0.f, 0.f}, (f32x4){0.f, 0.f, 0.f, 0.f}};
            mma_nt<2, 4>(kk2, lds + P_K + mb * 16 * ST128, ST128, lds + P_K + nt * 16 * ST128, ST128, fr, fq);
            mma_nt<2, 4>(at2, lds + P_K + mb * 16 * ST128, ST128, lds + P_Q + nt * 16 * ST128, ST128, fr, fq);
            float* at = c.gAT + (size_t)(h * 256 + n) * 4096;
            const float gj = sgc[jj];
#pragma unroll
            for (int m = 0; m < 2; ++m) { const int i0 = (mb + m) * 16 + 4 * fq; f32x4 av; float pv[4];
#pragma unroll
                for (int r = 0; r < 4; ++r) { const int ii = i0 + r; const float gi = sgc[ii];
                    const float ex = __expf(jj < ii ? gi - gj : gj - gi);
                    av[r] = jj < ii ? sbeta[ii] * kk2[m][r] * ex : 0.f;
                    pv[r] = ii <= jj ? at2[m][r] * ex : 0.f; }
                *(f32x4*)(at + jj * 64 + i0) = av;
                u32x2 w; w.x = cvt_pk_bf16(pv[0], pv[1]); w.y = cvt_pk_bf16(pv[2], pv[3]);
                *(u32x2*)(blob + B_AT + jj * ST64 + i0 * 2) = w; }
        }
        __syncthreads();
    }
}
__device__ void gdn_invert(CtxK& c, LAS unsigned char* lds, int h, int g) {
    const int tid = ltid(), wv = __builtin_amdgcn_readfirstlane(tid >> 6), lane = tid & 63;
    const int n = g * 8 + wv;
    LAS float* at = (LAS float*)(lds + wv * 16384);
    const float* src = c.gAT + (size_t)(h * 256 + n) * 4096;
#pragma unroll
    for (int k = 0; k < 16; ++k) *(LAS f32x4*)(at + (k * 64 + lane) * 4) = *(const f32x4*)(src + (k * 64 + lane) * 4);
    lds_fence();
    float r[64];
    unsigned ata = (unsigned)(size_t)at;
#pragma unroll
    for (int j = 63; j >= 0; --j) {
        float ac0 = lane == j ? 1.f : 0.f, ac1 = 0.f;
        LAS const float* arow = (LAS const float*)(size_t)ata + j * 64;
#pragma unroll
        for (int m4 = ((j + 1) & ~3); m4 < 64; m4 += 4) {
            const f32x4 a = *(LAS const f32x4*)(arow + m4);
            if (m4 + 0 > j) ac0 = __builtin_fmaf(-r[m4 + 0], a[0], ac0);
            if (m4 + 1 > j) ac1 = __builtin_fmaf(-r[m4 + 1], a[1], ac1);
            if (m4 + 2 > j) ac0 = __builtin_fmaf(-r[m4 + 2], a[2], ac0);
            if (m4 + 3 > j) ac1 = __builtin_fmaf(-r[m4 + 3], a[3], ac1);
        }
        const float acc = ac0 + ac1;
        r[j] = acc;
        asm volatile("" : "+v"(ata) : "v"(acc));
    }
    unsigned char* blob = (unsigned char*)c.gBlob + (size_t)(h * 256 + n) * BLOB;
#pragma unroll
    for (int k = 0; k < 8; ++k) { float v8[8];
#pragma unroll
        for (int q = 0; q < 8; ++q) v8[q] = r[k * 8 + q];
        *(u32x4*)(blob + B_T + lane * ST64 + k * 16) = pack8(v8); }
}
template <int MODE>
__device__ void gdn_pass(CtxK& c, LAS unsigned char* lds, int h, int g) {
    const int tid = ltid(), wv = __builtin_amdgcn_readfirstlane(tid >> 6), lane = tid & 63, fr = lane & 15, fq = lane >> 4;
    LAS unsigned char* stw = lds + G_ST + wv * 16 * ST128; LAS unsigned char* rvw = lds + G_RV + wv * 16 * ST64;
    LAS float* part = (LAS float*)(lds + G_PART); LAS float* rinv = (LAS float*)(lds + G_RINV);
    f32x4 Sacc[8];
#pragma unroll
    for (int m = 0; m < 8; ++m) {
        if (MODE == 1) { const int v = 16 * wv + fr, d0 = 16 * m + 4 * fq; Sacc[m] = (f32x4){d0 == v ? 1.f : 0.f, d0 + 1 == v ? 1.f : 0.f, d0 + 2 == v ? 1.f : 0.f, d0 + 3 == v ? 1.f : 0.f}; }
        else Sacc[m] = (f32x4){0.f, 0.f, 0.f, 0.f};
    }
    if (MODE == 2 && g > 0) { const f32x4* sp = (const f32x4*)c.gS + (size_t)(h * 32 + g) * FRAG_F4 + (wv * 8) * 64 + lane;
#pragma unroll
        for (int m = 0; m < 8; ++m) Sacc[m] = sp[m * 64]; }
    write_st(stw, Sacc, fr, fq);
    const float gnw = MODE == 2 ? c.gdn_onorm_g[wv * 16 + fr] : 0.f;
    constexpr int LIM = MODE == 2 ? B_SC : B_QD, NQ = (LIM + 8191) / 8192;
    u32x4 pre[NQ];
    const unsigned char* blob0 = (const unsigned char*)c.gBlob + (size_t)(h * 256 + g * 8) * BLOB;
#define GP_ISSUE(i_) do { const unsigned char* bp_ = blob0 + (size_t)(i_) * BLOB + ltid() * 16; _Pragma("unroll") for (int q = 0; q < NQ; ++q) if (q * 8192 + 8176 < LIM || ltid() * 16 + q * 8192 < LIM) pre[q] = *(const u32x4*)(bp_ + q * 8192); } while (0)
    GP_ISSUE(0);
    for (int i = 0; i < 8; ++i) {
        const int n = g * 8 + i, T0 = n * 64;
        { const int tl = ltid() * 16;
#pragma unroll
          for (int q = 0; q < NQ; ++q) if (q * 8192 + 8176 < LIM || tl + q * 8192 < LIM) *(LAS u32x4*)(lds + tl + q * 8192) = pre[q]; }
        const float dlast = *(const float*)(blob0 + (size_t)i * BLOB + B_SC);
        u32x4 gpre[2];
        if (MODE == 2) gate_issue(gpre, c.proj + (size_t)T0 * PW + C_GG + h * 128);
        __syncthreads();
        if (i + 1 < 8) GP_ISSUE(i + 1);
        { f32x4 R[4];
#pragma unroll
          for (int m = 0; m < 4; ++m) R[m] = (f32x4){0.f, 0.f, 0.f, 0.f};
          mma_nt<4, 4>(R, lds + B_KBG, ST128, stw, ST128, fr, fq);
#pragma unroll
          for (int m = 0; m < 4; ++m) { float x0 = 0.f, x1 = 0.f, x2 = 0.f, x3 = 0.f;
              if (MODE != 1) { const u32x2 vb = *(LAS u32x2*)(lds + B_VB + (16 * wv + fr) * ST64 + (16 * m + 4 * fq) * 2); x0 = bflo(vb.x); x1 = bfhi(vb.x); x2 = bflo(vb.y); x3 = bfhi(vb.y); }
              u32x2 w; w.x = cvt_pk_bf16(x0 - R[m][0], x1 - R[m][1]); w.y = cvt_pk_bf16(x2 - R[m][2], x3 - R[m][3]);
              *(LAS u32x2*)(rvw + fr * ST64 + (16 * m + 4 * fq) * 2) = w; } }
        lds_fence();
        { f32x4 VN[4];
#pragma unroll
          for (int m = 0; m < 4; ++m) VN[m] = (f32x4){0.f, 0.f, 0.f, 0.f};
          mma_nt<4, 2>(VN, lds + B_T, ST64, rvw, ST64, fr, fq);
          mfma_pad4(VN); lds_fence();
#pragma unroll
          for (int m = 0; m < 4; ++m) { u32x2 w; w.x = cvt_pk_bf16(VN[m][0], VN[m][1]); w.y = cvt_pk_bf16(VN[m][2], VN[m][3]); *(LAS u32x2*)(rvw + fr * ST64 + (16 * m + 4 * fq) * 2) = w; } }
        lds_fence();
        f32x4 O[4];
        if (MODE == 2) {
#pragma unroll
            for (int m = 0; m < 4; ++m) O[m] = (f32x4){0.f, 0.f, 0.f, 0.f};
            mma_nt<4, 4>(O, lds + B_QD, ST128, stw, ST128, fr, fq);
            mma_nt<4, 2>(O, lds + B_AT, ST64, rvw, ST64, fr, fq);
#pragma unroll
            for (int m = 0; m < 4; ++m)
#pragma unroll
                for (int r = 0; r < 4; ++r) { const float q = row16_sum(O[m][r] * O[m][r]); if (fr == 0) part[wv * 64 + 16 * m + 4 * fq + r] = q; }
        }
#pragma unroll
        for (int m = 0; m < 8; ++m) Sacc[m] = Sacc[m] * dlast;
        mma_nt<8, 2>(Sacc, lds + B_KU, ST64, rvw, ST64, fr, fq);
        lds_fence();
        write_st(stw, Sacc, fr, fq);
        if (MODE == 2) {
            __syncthreads();
            out_stage(lds + B_KBG, part, rinv, O, gpre, gnw, c.ocat + (size_t)T0 * D + 1024 + h * 128, wv, lane, fr, fq);
        }
        __syncthreads();
    }
#undef GP_ISSUE
    if (MODE == 0) {
        f32x4* sp = (f32x4*)c.gB + (size_t)(h * 32 + g) * FRAG_F4 + (wv * 8) * 64 + lane;
#pragma unroll
        for (int m = 0; m < 8; ++m) sp[m * 64] = Sacc[m];
    }
    if (MODE == 1) {
        mfma_pad8(Sacc);
        LAS bf16_t* img = (LAS bf16_t*)lds;
#pragma unroll
        for (int m = 0; m < 8; ++m)
#pragma unroll
            for (int r = 0; r < 4; ++r) img[(16 * m + 4 * fq + r) * (ST128 / 2) + 16 * wv + fr] = (bf16_t)(cvt_pk_bf16(Sacc[m][r], Sacc[m][r]) & 0xffffu);
        __syncthreads();
        unsigned char* dst = (unsigned char*)c.gM + (size_t)(h * 32 + g) * (128 * ST128);
#pragma unroll
        for (int q = 0; q < 5; ++q) { const int o = tid * 16 + q * 8192; if (q < 4 || o < 128 * ST128) *(u32x4*)(dst + o) = *(LAS u32x4*)(lds + o); }
        __syncthreads();
    }
}
__device__ void gdn_scan(CtxK& c, LAS unsigned char* lds, int h) {
    const int tid = ltid(), wv = __builtin_amdgcn_readfirstlane(tid >> 6), lane = tid & 63, fr = lane & 15, fq = lane >> 4;
    LAS unsigned char* stw = lds + G_ST + wv * 16 * ST128;
    f32x4 Sacc[8], Bn[8]; u32x4 mp[5];
#pragma unroll
    for (int m = 0; m < 8; ++m) Sacc[m] = (f32x4){0.f, 0.f, 0.f, 0.f};
#define GS_ISSUE(g_) do { const unsigned char* src_ = (const unsigned char*)c.gM + (size_t)(h * 32 + (g_)) * (128 * ST128) + tid * 16; \
        _Pragma("unroll") for (int q = 0; q < 5; ++q) if (q < 4 || tid * 16 + q * 8192 < 128 * ST128) mp[q] = *(const u32x4*)(src_ + q * 8192); \
        const f32x4* bp_ = (const f32x4*)c.gB + (size_t)(h * 32 + (g_)) * FRAG_F4 + (wv * 8) * 64 + lane; \
        _Pragma("unroll") for (int m = 0; m < 8; ++m) Bn[m] = bp_[m * 64]; } while (0)
    GS_ISSUE(0);
    for (int g = 0; g < 31; ++g) {
#pragma unroll
        for (int q = 0; q < 5; ++q) if (q < 4 || tid * 16 + q * 8192 < 128 * ST128) *(LAS u32x4*)(lds + tid * 16 + q * 8192) = mp[q];
        write_st(stw, Sacc, fr, fq);
#pragma unroll
        for (int m = 0; m < 8; ++m) Sacc[m] = Bn[m];
        __syncthreads();
        if (g + 1 < 31) GS_ISSUE(g + 1);
        mma_nt<8, 4>(Sacc, lds, ST128, stw, ST128, fr, fq);
        f32x4* sp = (f32x4*)c.gS + (size_t)(h * 32 + g + 1) * FRAG_F4 + (wv * 8) * 64 + lane;
#pragma unroll
        for (int m = 0; m < 8; ++m) sp[m * 64] = Sacc[m];
        __syncthreads();
    }
#undef GS_ISSUE
}
}
__device__ void ph_hgrn1(CtxK& c, LAS unsigned char* lds) { mx::hgrn_pass<false>(c, lds); }
__device__ void ph_hgrn2(CtxK& c, LAS unsigned char* lds) { mx::hgrn_scan(c); }
__device__ void ph_hgrn3(CtxK& c, LAS unsigned char* lds) { mx::hgrn_pass<true>(c, lds); }
__device__ void ph_gdn1(CtxK& c, LAS unsigned char* lds) {
    const int wu = blockIdx.x, h = wu & 7, g = wu >> 3;
    mx::gdn_prep(c, lds, h, g); __syncthreads();
    asm volatile("s_waitcnt vmcnt(0)" ::: "memory"); __syncthreads();
    mx::gdn_invert(c, lds, h, g);
    asm volatile("s_waitcnt vmcnt(0)" ::: "memory"); __syncthreads();
    mx::gdn_pass<0>(c, lds, h, g); __syncthreads();
    mx::gdn_pass<1>(c, lds, h, g); __syncthreads();
}
__device__ void ph_gdn2(CtxK& c, LAS unsigned char* lds) { if (blockIdx.x < 8) mx::gdn_scan(c, lds, blockIdx.x); }
__device__ void ph_gdn3(CtxK& c, LAS unsigned char* lds) { const int wu = blockIdx.x; mx::gdn_pass<2>(c, lds, wu & 7, wu >> 3); }

constexpr int N2_LA = 0, N2_LB = 8192, N2_XH = 16384, N2_XL = N2_XH + 17408, N2_Y = N2_XL + 17408, N2_LOG = N2_Y + 34816, N2_RS = N2_LOG + 64 * 65 * 4, N2_IDX = N2_RS + 256, N2_BIAS = N2_IDX + 2048, N2_END = N2_BIAS + 256;
static_assert(N2_END <= 147456, "norm2 lds");
__device__ void ph_norm2(CtxK& c, LAS unsigned char* lds) {
    const int tid = ltid(), wg = blockIdx.x, lane = tid & 63, wv = __builtin_amdgcn_readfirstlane(tid >> 6), fr = lane & 15, fq = lane >> 4;
    LAS float* la = (LAS float*)(lds + N2_LA); LAS float* lb_ = (LAS float*)(lds + N2_LB); LAS float* lg = (LAS float*)(lds + N2_LOG); LAS float* rs = (LAS float*)(lds + N2_RS);
    LAS int* idxt = (LAS int*)(lds + N2_IDX); LAS float* bias2 = (LAS float*)(lds + N2_BIAS);
    for (int j = tid; j < D; j += 512) { la[j] = c.norm2_g[j] * (1.f + c.mod[4 * D + j]); lb_[j] = c.mod[3 * D + j]; }
    if (tid < 64) bias2[tid] = c.rbias2[tid];
    __syncthreads();
    const int tok0 = wg * 64;
    f32x4 vn[8];
    { const float* xr = c.out + (size_t)(tok0 + wv * 8) * D;
#pragma unroll
      for (int i = 0; i < 8; ++i) vn[i] = *(const f32x4*)(xr + i * 256 + lane * 4); }
    for (int rr = 0; rr < 8; ++rr) {
        const int row = tok0 + wv * 8 + rr;
        f32x4 v[8]; float ss = 0.f;
#pragma unroll
        for (int i = 0; i < 8; ++i) { v[i] = vn[i]; ss += v[i][0] * v[i][0] + v[i][1] * v[i][1] + v[i][2] * v[i][2] + v[i][3] * v[i][3]; }
        if (rr + 1 < 8) { const float* xr = c.out + (size_t)(row + 1) * D;
#pragma unroll
            for (int i = 0; i < 8; ++i) vn[i] = *(const f32x4*)(xr + i * 256 + lane * 4); }
        ss = wave_sum(ss); const float r = rsqrtf(ss * (1.f / D) + 1e-6f);
        if (lane == 0) rs[wv * 8 + rr] = r;
#pragma unroll
        for (int i = 0; i < 8; ++i) { const int e = i * 256 + lane * 4; const f32x4 a = *(LAS f32x4*)(la + e), b = *(LAS f32x4*)(lb_ + e); const f32x4 y = v[i] * r * a + b;
            *(unsigned*)(c.h2 + (size_t)row * D + e) = cvt4_fp8(4.f * y[0], 4.f * y[1], 4.f * y[2], 4.f * y[3]); }
    }
    const int xrow = tid >> 3, xseg = (tid & 7) * 16;
    f32x4 xr_[4]; u32x4 yr_[5];
    auto issue = [&](int ch) {
        const float* xp = c.out + (size_t)(tok0 + xrow) * D + ch * 128 + xseg;
#pragma unroll
        for (int q = 0; q < 4; ++q) xr_[q] = *(const f32x4*)(xp + q * 4);
        const unsigned char* yp = (const unsigned char*)c.rwimg + (size_t)ch * 34816 + tid * 16;
#pragma unroll
        for (int q = 0; q < 4; ++q) yr_[q] = *(const u32x4*)(yp + q * 8192);
        if (tid < 128) yr_[4] = *(const u32x4*)(yp + 32768);
    };
    issue(0);
    f32x4 acc[2] = {(f32x4){0.f, 0.f, 0.f, 0.f}, (f32x4){0.f, 0.f, 0.f, 0.f}};
    const int mt = wv >> 1, nb = (wv & 1) * 2;
    for (int ch = 0; ch < 16; ++ch) {
        __syncthreads();
        { float hi[16], lo[16];
#pragma unroll
          for (int q = 0; q < 4; ++q)
#pragma unroll
              for (int j = 0; j < 4; ++j) { const float x = xr_[q][j]; const float h = __uint_as_float(cvt_pk_bf16(x, x) << 16); hi[q * 4 + j] = h; lo[q * 4 + j] = x - h; }
          float t8[8];
#pragma unroll
          for (int hh = 0; hh < 2; ++hh) {
#pragma unroll
              for (int j = 0; j < 8; ++j) t8[j] = hi[hh * 8 + j];
              *(LAS u32x4*)(lds + N2_XH + xrow * 272 + (xseg + hh * 8) * 2) = mx::pack8(t8);
#pragma unroll
              for (int j = 0; j < 8; ++j) t8[j] = lo[hh * 8 + j];
              *(LAS u32x4*)(lds + N2_XL + xrow * 272 + (xseg + hh * 8) * 2) = mx::pack8(t8); }
#pragma unroll
          for (int q = 0; q < 4; ++q) *(LAS u32x4*)(lds + N2_Y + tid * 16 + q * 8192) = yr_[q];
          if (tid < 128) *(LAS u32x4*)(lds + N2_Y + tid * 16 + 32768) = yr_[4]; }
        __syncthreads();
        if (ch + 1 < 16) issue(ch + 1);
#pragma unroll
        for (int kk = 0; kk < 4; ++kk) {
            const int ko = (kk * 32 + fq * 8) * 2;
            const bf16x8 ah = *(const LAS bf16x8*)(lds + N2_XH + (16 * mt + fr) * 272 + ko), al = *(const LAS bf16x8*)(lds + N2_XL + (16 * mt + fr) * 272 + ko);
#pragma unroll
            for (int n = 0; n < 2; ++n) {
                const bf16x8 bh = *(const LAS bf16x8*)(lds + N2_Y + (16 * (nb + n) + fr) * 272 + ko), bl = *(const LAS bf16x8*)(lds + N2_Y + 17408 + (16 * (nb + n) + fr) * 272 + ko);
                acc[n] = mx::mfma16(ah, bh, acc[n]); acc[n] = mx::mfma16(ah, bl, acc[n]); acc[n] = mx::mfma16(al, bh, acc[n]);
            }
        }
    }
#pragma unroll
    for (int n = 0; n < 2; ++n)
#pragma unroll
        for (int r = 0; r < 4; ++r) lg[(16 * mt + 4 * fq + r) * 65 + 16 * (nb + n) + fr] = acc[n][r];
    __syncthreads();
    const float rb = c.router_bias[lane], b2 = bias2[lane];
    for (int rr = 0; rr < 8; rr += 2) {
        float s[2], bb[2], mb[2], wsum[2] = {0.f, 0.f}; int myk[2] = {-1, -1};
#pragma unroll
        for (int u = 0; u < 2; ++u) {
            const int lr = wv * 8 + rr + u;
            s[u] = sigmoidf_(lg[lr * 65 + lane] * rs[lr] + b2); const float b = s[u] + rb; bb[u] = b;
            const float m7 = dppf<0x141>(b);
            const float o1 = dppf<0xB1>(b), o2 = dppf<0x4E>(b), o3 = dppf<0x1B>(b), o6 = dppf<0xB1>(m7), o5 = dppf<0x4E>(m7), o4 = dppf<0x1B>(m7);
            int rk = 0;
#define TK_CMP(ov, x) rk += ((ov) > b || ((ov) == b && (lane ^ (x)) < lane)) ? 1 : 0
            TK_CMP(o1, 1); TK_CMP(o2, 2); TK_CMP(o3, 3); TK_CMP(o4, 4); TK_CMP(o5, 5); TK_CMP(o6, 6); TK_CMP(m7, 7);
#undef TK_CMP
            float gs = rk < 2 ? b : 0.f; gs += dppf<0xB1>(gs); gs += dppf<0x4E>(gs); gs += dppf<0x141>(gs);
            int grk = 0; const int gi = lane >> 3;
#pragma unroll
            for (int j = 0; j < 8; ++j) { const float og = __builtin_bit_cast(float, __builtin_amdgcn_readlane(__builtin_bit_cast(int, gs), j * 8)); grk += (og > gs || (og == gs && j < gi)) ? 1 : 0; }
            mb[u] = grk < 4 ? b : -INFINITY; }
#pragma unroll
        for (int k = 0; k < TOPK; ++k)
#pragma unroll
            for (int u = 0; u < 2; ++u) {
                const float m = wave_max_dpp(mb[u]);
                const unsigned long long bal = __ballot(mb[u] == m); const int win = __builtin_amdgcn_readfirstlane(__ffsll((long long)bal) - 1);
                wsum[u] += __builtin_bit_cast(float, __builtin_amdgcn_readlane(__builtin_bit_cast(int, s[u]), win));
                if (lane == win) { mb[u] = -INFINITY; myk[u] = k; } }
#pragma unroll
        for (int u = 0; u < 2; ++u) { const int lr = wv * 8 + rr + u, t = tok0 + lr;
            if (myk[u] >= 0) { c.idx[t * TOPK + myk[u]] = lane; c.wts[t * TOPK + myk[u]] = s[u] / wsum[u] * 2.5f; idxt[lr * TOPK + myk[u]] = lane; } }
    }
    __syncthreads();
    { const int myexp = idxt[tid]; int rank = 0, cntl = 0;
      for (int e = 0; e < 64; ++e) {
          const unsigned long long bal = __ballot(myexp == e);
          const int below = __builtin_amdgcn_mbcnt_hi((unsigned)(bal >> 32), __builtin_amdgcn_mbcnt_lo((unsigned)bal, 0u));
          if (myexp == e) rank = below;
          if (lane == e) cntl = __popcll(bal); }
      LAS int* wcnt = (LAS int*)(lds + N2_XH);
      wcnt[wv * 64 + lane] = cntl;
      __syncthreads();
      int base = 0;
      for (int w = 0; w < wv; ++w) base += wcnt[w * 64 + myexp];
      c.rnk[wg * 512 + tid] = base + rank;
      if (tid < 64) { int n = 0;
#pragma unroll
          for (int w = 0; w < 8; ++w) n += wcnt[w * 64 + tid];
          c.tile_cnt[wg * 64 + tid] = n; } }
}
__device__ void ph_route(CtxK& c, LAS unsigned char* lds) {
    const int tid = ltid(), b = blockIdx.x, e = tid & 63, part = tid >> 6;
    LAS int* psum = (LAS int*)lds; LAS int* pbel = psum + 512; LAS int* tot = pbel + 512; LAS int* offb = tot + 64; LAS int* pst = offb + 64;
    { int sa = 0, sb = 0;
      for (int tl = part * 32; tl < part * 32 + 32; ++tl) { const int v = c.tile_cnt[tl * 64 + e]; sa += v; sb += tl < b ? v : 0; }
      psum[part * 64 + e] = sa; pbel[part * 64 + e] = sb; }
    __syncthreads();
    if (tid < 64) {
        int t_ = 0, o_ = 0;
#pragma unroll
        for (int q = 0; q < 8; ++q) { t_ += psum[q * 64 + e]; o_ += pbel[q * 64 + e]; }
        const int pad = (t_ + 255) & ~255; int inc = pad;
#pragma unroll
        for (int o = 1; o < 64; o <<= 1) { const int x = __shfl_up(inc, o); if (e >= o) inc += x; }
        const int ps = inc - pad;
        tot[e] = t_; offb[e] = o_; pst[e] = ps;
        if (b == 0) {
            const int b0 = ps >> 8, nbe = pad >> 8;
            for (int j = 0; j < nbe; ++j) { c.blk_row[b0 + j] = ps + j * 256; c.blk_exp[b0 + j] = e; }
            const int nbr = __shfl(inc, 63) >> 8;
            c.blk_row[nbr + e] = PROUTED + e * 256; c.blk_exp[nbr + e] = NE;
            if (e == 0) *c.nent = nbr + S / 256;
        }
        c.tok_p[PROUTED + b * 64 + e] = b * 64 + e; c.w_p[PROUTED + b * 64 + e] = 1.f;
    }
    __syncthreads();
    { const int p = b * 512 + tid, ex = c.idx[p], d = pst[ex] + offb[ex] + c.rnk[p];
      c.tok_p[d] = p >> 3; c.w_p[d] = c.wts[p]; c.pos[p] = d; }
    if (b < NE) { const int ps = pst[b], t_ = tot[b], pe = (t_ + 255) & ~255;
        for (int r = t_ + tid; r < pe; r += 512) { c.tok_p[ps + r] = 0; c.w_p[ps + r] = 0.f; } }
}

constexpr int LDS_BYTES = 163840, LDS_MAIN = LDS_BYTES - 16;
static_assert(gm::VBOFF + 512 * 8 <= LDS_MAIN, "lds map");
__global__ void __launch_bounds__(512, 2) k_mega(Ctx c) {
    extern __shared__ __attribute__((aligned(16))) unsigned char smem[];
    LAS unsigned char* lds = (LAS unsigned char*)smem;
    if (ltid() == 0) *(LAS u32x4*)(lds + LDS_MAIN) = (u32x4){0u, 0u, 0u, 0u};
    __syncthreads();
    CtxK* kp = (CtxK*)__builtin_amdgcn_kernarg_segment_ptr();
    (void)xcd_barrier_post(c.bar, (volatile LAS unsigned*)(lds + LDS_MAIN));
#define PHASE(fn) do { const CtxK* kp_ = kp; asm volatile("" : "+s"(kp_)); fn(*kp_, lds); __syncthreads(); } while (0)
#define GRID_BARRIER() do { const CtxK* kp_ = kp; asm volatile("" : "+s"(kp_)); XcdBarrier bb_; bb_.bar = kp_->bar; bb_.x = xb_xcc_id(); bb_.st = (volatile LAS unsigned*)(lds + LDS_MAIN); xcd_barrier(bb_); } while (0)
    PHASE(ph_pro1);      GRID_BARRIER();
    PHASE(ph_norm1);     GRID_BARRIER();
    PHASE(ph_gemm1);     GRID_BARRIER();
    PHASE(ph_hgrn1);     PHASE(ph_gdn1);  GRID_BARRIER();
    PHASE(ph_hgrn2);     PHASE(ph_gdn2);  PHASE(ph_cvt_exp); GRID_BARRIER();
    PHASE(ph_hgrn3);     PHASE(ph_gdn3);  GRID_BARRIER();
    PHASE(ph_gemm2);     GRID_BARRIER();
    PHASE(ph_gemm3);     GRID_BARRIER();
    PHASE(ph_norm2);     GRID_BARRIER();
    PHASE(ph_route);     GRID_BARRIER();
    PHASE(ph_moe_gu);    GRID_BARRIER();
    PHASE(ph_moe_dn);    GRID_BARRIER();
    PHASE(ph_final);
#undef PHASE
#undef GRID_BARRIER
}

extern "C" void kernel_launch(void* const* d_in, const int* in_sizes, int n_in, void* d_out, int out_size, void* d_ws, size_t ws_size, hipStream_t stream) {
    Ctx c{};
    const float** ip = (const float**)&c.x;
    for (int i = 0; i < 25; ++i) ip[i] = (const float*)d_in[i];
    c.out = (float*)d_out;
    char* ws = (char*)d_ws; constexpr size_t MB = 1024 * 1024;
    c.bar = (unsigned*)ws;
    c.modp = (float*)(ws + 64 * 1024); c.mod = (float*)(ws + 320 * 1024); c.lb = (float*)(ws + 384 * 1024);
    c.cnt = (int*)(ws + 392 * 1024); c.nent = (int*)(ws + 396 * 1024); c.blk_row = (int*)(ws + 400 * 1024); c.blk_exp = (int*)(ws + 404 * 1024);
    c.idx = (int*)(ws + 1 * MB); c.wts = (float*)(ws + 2 * MB); c.tok_p = (int*)(ws + 3 * MB); c.w_p = (float*)(ws + 4 * MB); c.pos = (int*)(ws + 5 * MB);
    c.gab = (float*)(ws + 6 * MB); c.gbeta = (float*)(ws + 7 * MB + 0); c.gdec = (float*)(ws + 7 * MB + 512 * 1024);
    c.rwimg = (bf16_t*)(ws + 8 * MB); c.rbias2 = (float*)(ws + 9 * MB); c.tile_cnt = (int*)(ws + 9 * MB + 4096); c.rnk = (int*)(ws + 10 * MB);
    char* big = ws + 16 * MB;
    auto at = [&](size_t mib) { return big + mib * MB; };
    c.dn_t = (unsigned char*)at(0); c.gu_t = (unsigned char*)at(130);
    c.win_t = (bf16_t*)at(0); c.h1 = (bf16_t*)at(48); c.gAT = (float*)at(112);
    c.proj = (bf16_t*)at(390); c.gBlob = (unsigned char*)at(774); c.merged = (bf16_t*)at(774);
    c.gM = (unsigned char*)at(951); c.gB = (float*)at(960); c.hL = (float*)at(976); c.gS = (float*)at(992); c.hS = (float*)at(1008); c.hD = (float*)at(1024);
    c.wa_t = (bf16_t*)at(1025); c.wb_t = (bf16_t*)at(1029); c.wout_t = (bf16_t*)at(1033); c.ocat = (bf16_t*)at(1041);
    c.Y = (unsigned char*)at(130); c.hid = (unsigned char*)at(770); c.h2 = (unsigned char*)at(930);
    static_assert((size_t)NEX * D * FF * 2 <= 130 * MB && (size_t)NEX * 1024 * D * 2 <= 260 * MB && (size_t)PW * D * 2 <= 48 * MB && (size_t)S * D * 2 <= 64 * MB, "map A");
    static_assert((size_t)S * PW * 2 <= 384 * MB && (size_t)2048 * mx::BLOB <= 177 * MB && (size_t)256 * 128 * mx::ST128 <= 9 * MB && (size_t)PTOT * D * 2 <= 640 * MB && (size_t)PTOT * FF * 2 <= 160 * MB, "map B");
    const size_t need = 16 * MB + 1105 * MB;
    if (ws_size < need) { fprintf(stderr, "kernel_launch: workspace too small: %zu < %zu\n", ws_size, need); return; }

    static int grid = 0;
    if (!grid) {
        int dev = 0, cus = 0, per_cu = 0;
        hipGetDevice(&dev); hipDeviceGetAttribute(&cus, hipDeviceAttributeMultiprocessorCount, dev);
        hipFuncSetAttribute((const void*)k_mega, hipFuncAttributeMaxDynamicSharedMemorySize, LDS_BYTES);
        hipOccupancyMaxActiveBlocksPerMultiprocessor(&per_cu, (const void*)k_mega, 512, LDS_BYTES);
        if (per_cu < 1) fprintf(stderr, "kernel_launch: occupancy query reports %d blocks per CU\n", per_cu);
        grid = cus;
        if (grid != 256) { fprintf(stderr, "kernel_launch: built for a 256-CU device (token-mixer units = workgroups); got %d CUs\n", cus); grid = -1; }
    }
    if (grid < 0) return;
    hipMemsetAsync(c.bar, 0, XCD_BAR_WORDS * sizeof(unsigned), stream);
    hipLaunchKernelGGL(k_mega, dim3(grid), dim3(512), LDS_BYTES, stream, c);
}
```
